# Optimizing an MI355X kernel written in HIP

```python
import jax, jax.numpy as jnp
from jax import lax
import numpy as np

D_MODEL = 1024
BATCH = 2
SEQ = 8192
DEPTH = 1

CHUNK = 64
MEM_LEN = 256
MIX_DIM = D_MODEL
GLA_HEADS = 4
GLA_DV = MIX_DIM // 2 // GLA_HEADS
GLA_DK = GLA_DV // 2
GLA_GATE_RANK = 16
GLA_TAU = 16.0
SB_HEADS = 8
SB_HD = MIX_DIM // 2 // SB_HEADS
SB_BLOCK = 128
MEM_HEADS = 4
MEM_HD = D_MODEL // MEM_HEADS
N_EXPERTS = 32
TOP_K = 4
D_EXPERT = D_MODEL
SWIGLU_LIMIT = 7.0
SWIGLU_ALPHA = 1.702
EXPERT_BLOCK = 128
EPS = 1e-5

Q_G = GLA_HEADS * GLA_DK
V_G = GLA_HEADS * GLA_DV
SB_W = SB_HEADS * SB_HD
IN_SPLITS = (Q_G, Q_G, V_G, GLA_GATE_RANK, V_G, SB_W, SB_W, SB_W)
IN_DIM = sum(IN_SPLITS)
IN_OFFSETS = tuple(int(v) for v in np.cumsum(IN_SPLITS)[:-1])

kernel_name = "hybrid_gla_stickbreak_moe_block"


def rmsnorm(x, g):
    xf = x.astype(jnp.float32)
    y = xf * lax.rsqrt(jnp.mean(xf * xf, axis=-1, keepdims=True) + EPS)
    return (y * g.astype(jnp.float32)).astype(x.dtype)


def gla_group(q, k, v, log_a):
    B, S, H, dk = q.shape
    dv = v.shape[-1]
    nc = S // CHUNK
    qc = q.reshape(B, nc, CHUNK, H, dk)
    kc = k.astype(jnp.float32).reshape(B, nc, CHUNK, H, dk)
    vc = v.astype(jnp.float32).reshape(B, nc, CHUNK, H, dv)
    G = jnp.cumsum(log_a.astype(jnp.float32).reshape(B, nc, CHUNK, H, dk), axis=2)
    G_end = G[:, :, -1]
    k_dec = kc * jnp.exp(G_end[:, :, None] - G)
    U = jnp.einsum('bnshd,bnshv->bnhdv', k_dec, vc)
    decay = jnp.exp(G_end)

    def step(state, inp):
        d, u = inp
        state = d[..., None] * state + u
        return state, state

    init = jnp.zeros((B, H, dk, dv), jnp.float32)
    _, states = lax.scan(step, init, (jnp.moveaxis(decay, 1, 0), jnp.moveaxis(U, 1, 0)))
    states = jnp.moveaxis(states, 0, 1)
    o = jnp.einsum('bnthd,bnhdv->bnthv', qc.astype(jnp.float32), states)
    return o.reshape(B, S, H, dv).astype(q.dtype)


def stick_breaking_group(q, k, v):
    B, S, H, d = q.shape
    scale = d ** -0.5
    outs = []
    for i in range(S // SB_BLOCK):
        t0 = i * SB_BLOCK
        L = t0 + SB_BLOCK
        qb = q[:, t0:L]
        kb = k[:, :L]
        vb = v[:, :L].astype(jnp.float32)
        z = jnp.einsum('bthd,bshd->bhts', qb, kb).astype(jnp.float32) * scale
        t_pos = t0 + jnp.arange(SB_BLOCK)
        s_pos = jnp.arange(L)
        mask = s_pos[None, :] < t_pos[:, None]
        log_1mb = jnp.where(mask, jax.nn.log_sigmoid(-z), 0.0)
        suffix = lax.cumsum(log_1mb, axis=3, reverse=True) - log_1mb
        A = jnp.where(mask, jnp.exp(jax.nn.log_sigmoid(z) + suffix), 0.0)
        outs.append(jnp.einsum('bhts,bshd->bthd', A, vb))
    return jnp.concatenate(outs, axis=1).astype(q.dtype)


def memory_cross_attention(hq, m, w_mq, w_mk, w_mv, w_mo):
    B, S, _ = hq.shape
    M = m.shape[1]
    q = (hq @ w_mq).reshape(B, S, MEM_HEADS, MEM_HD)
    k = (m @ w_mk).reshape(B, M, MEM_HEADS, MEM_HD)
    v = (m @ w_mv).reshape(B, M, MEM_HEADS, MEM_HD)
    s = jnp.einsum('bthd,bmhd->bhtm', q, k).astype(jnp.float32) * (MEM_HD ** -0.5)
    p = jax.nn.softmax(s, axis=-1).astype(v.dtype)
    o = jnp.einsum('bhtm,bmhd->bthd', p, v).reshape(B, S, MEM_HEADS * MEM_HD)
    return o @ w_mo


def moe_ffn(h, w_router, b_router, w_gu, b_gu, w_down, b_down):
    B, S, D = h.shape
    N = B * S
    hf = h.reshape(N, D)
    logits = (hf @ w_router + b_router).astype(jnp.float32)
    top_vals, top_idx = lax.top_k(logits, TOP_K)
    gates = jax.nn.softmax(top_vals, axis=-1).astype(h.dtype)

    NK = N * TOP_K
    flat_e = top_idx.reshape(NK).astype(jnp.int32)
    flat_w = gates.reshape(NK)
    flat_tok = jnp.repeat(jnp.arange(N, dtype=jnp.int32), TOP_K)
    order = jnp.argsort(flat_e)
    sorted_e = flat_e[order]
    counts = jnp.bincount(flat_e, length=N_EXPERTS).astype(jnp.int32)
    padded = ((counts + EXPERT_BLOCK - 1) // EXPERT_BLOCK) * EXPERT_BLOCK
    pad_end = jnp.cumsum(padded)
    pad_start = pad_end - padded
    start = jnp.cumsum(counts) - counts
    rank = jnp.arange(NK, dtype=jnp.int32) - start[sorted_e]
    dest = pad_start[sorted_e] + rank

    n_blocks = -(-(NK + N_EXPERTS * (EXPERT_BLOCK - 1)) // EXPERT_BLOCK)
    M = n_blocks * EXPERT_BLOCK
    slot_tok = jnp.full((M,), N, jnp.int32).at[dest].set(flat_tok[order])
    slot_w = jnp.zeros((M,), h.dtype).at[dest].set(flat_w[order])
    block_start = jnp.arange(n_blocks, dtype=jnp.int32) * EXPERT_BLOCK
    block_expert = jnp.minimum(jnp.sum(block_start[:, None] >= pad_end[None, :], axis=1), N_EXPERTS - 1).astype(jnp.int32)

    h_pad = jnp.concatenate([hf, jnp.zeros((1, D), hf.dtype)], axis=0)
    xs = h_pad[slot_tok].reshape(n_blocks, EXPERT_BLOCK, D)

    def expert_block(args):
        xb, e = args
        gu = xb @ w_gu[e] + b_gu[e]
        gate, lin = gu[:, :D_EXPERT], gu[:, D_EXPERT:]
        gate = jnp.minimum(gate, SWIGLU_LIMIT)
        lin = jnp.clip(lin, -SWIGLU_LIMIT, SWIGLU_LIMIT)
        act = (lin + 1.0) * (gate * jax.nn.sigmoid(SWIGLU_ALPHA * gate))
        return act @ w_down[e] + b_down[e]

    ys = lax.map(expert_block, (xs, block_expert)).reshape(M, D) * slot_w[:, None]
    out = jax.ops.segment_sum(ys, slot_tok, num_segments=N + 1)[:N]
    return out.reshape(B, S, D)


def setup_inputs(seed: int = 0) -> dict:
    key = jax.random.key(seed)
    ks = jax.random.split(key, 24)

    def nrm(k, shape, scale):
        return jax.random.normal(k, shape, jnp.float32) * scale

    def gain(k, shape):
        return 1.0 + 0.05 * jax.random.normal(k, shape, jnp.float32)

    L = DEPTH
    return {
        'x': nrm(ks[0], (BATCH, SEQ, D_MODEL), 1.0),
        'mem': nrm(ks[1], (BATCH, MEM_LEN, D_MODEL), 1.0),
        'g_mix': gain(ks[2], (L, D_MODEL)),
        'w_in': nrm(ks[3], (L, D_MODEL, IN_DIM), D_MODEL ** -0.5),
        'w_gla_gate': nrm(ks[4], (L, GLA_GATE_RANK, Q_G), GLA_GATE_RANK ** -0.5),
        'b_gla_gate': nrm(ks[5], (L, Q_G), 0.5),
        'g_gla_head': gain(ks[6], (L, GLA_DV)),
        'w_out': nrm(ks[7], (L, MIX_DIM, D_MODEL), MIX_DIM ** -0.5),
        'g_mem_q': gain(ks[8], (L, D_MODEL)),
        'g_mem_kv': gain(ks[9], (L, D_MODEL)),
        'w_mq': nrm(ks[10], (L, D_MODEL, MEM_HEADS * MEM_HD), D_MODEL ** -0.5),
        'w_mk': nrm(ks[11], (L, D_MODEL, MEM_HEADS * MEM_HD), D_MODEL ** -0.5),
        'w_mv': nrm(ks[12], (L, D_MODEL, MEM_HEADS * MEM_HD), D_MODEL ** -0.5),
        'w_mo': nrm(ks[13], (L, MEM_HEADS * MEM_HD, D_MODEL), (MEM_HEADS * MEM_HD) ** -0.5),
        'g_ffn': gain(ks[14], (L, D_MODEL)),
        'w_router': nrm(ks[15], (L, D_MODEL, N_EXPERTS), D_MODEL ** -0.5),
        'b_router': nrm(ks[16], (L, N_EXPERTS), 0.01),
        'w_gu': nrm(ks[17], (L, N_EXPERTS, D_MODEL, 2 * D_EXPERT), D_MODEL ** -0.5),
        'b_gu': nrm(ks[18], (L, N_EXPERTS, 2 * D_EXPERT), 0.02),
        'w_down': nrm(ks[19], (L, N_EXPERTS, D_EXPERT, D_MODEL), D_EXPERT ** -0.5),
        'b_down': nrm(ks[20], (L, N_EXPERTS, D_MODEL), 0.02),
        'g_final': gain(ks[21], (D_MODEL,)),
    }


def reference(x, mem, g_mix, w_in, w_gla_gate, b_gla_gate, g_gla_head, w_out,
              g_mem_q, g_mem_kv, w_mq, w_mk, w_mv, w_mo,
              g_ffn, w_router, b_router, w_gu, b_gu, w_down, b_down, g_final):
    B, S, _ = x.shape
    for l in range(DEPTH):
        h = rmsnorm(x, g_mix[l])
        proj = h @ w_in[l]
        qg, kg, vg, glr, rg, qs, ks_, vs = jnp.split(proj, IN_OFFSETS, axis=-1)

        log_a = jax.nn.log_sigmoid((glr @ w_gla_gate[l] + b_gla_gate[l]).astype(jnp.float32)) / GLA_TAU
        o_gla = gla_group(qg.reshape(B, S, GLA_HEADS, GLA_DK) * (GLA_DK ** -0.5),
                          kg.reshape(B, S, GLA_HEADS, GLA_DK),
                          vg.reshape(B, S, GLA_HEADS, GLA_DV),
                          log_a.reshape(B, S, GLA_HEADS, GLA_DK))
        o_gla = rmsnorm(o_gla, g_gla_head[l]).reshape(B, S, V_G) * jax.nn.silu(rg)

        o_sb = stick_breaking_group(qs.reshape(B, S, SB_HEADS, SB_HD),
                                    ks_.reshape(B, S, SB_HEADS, SB_HD),
                                    vs.reshape(B, S, SB_HEADS, SB_HD)).reshape(B, S, SB_W)

        x = x + jnp.concatenate([o_gla, o_sb], axis=-1) @ w_out[l]

        x = x + memory_cross_attention(rmsnorm(x, g_mem_q[l]), rmsnorm(mem, g_mem_kv[l]),
                                       w_mq[l], w_mk[l], w_mv[l], w_mo[l])

        x = x + moe_ffn(rmsnorm(x, g_ffn[l]), w_router[l], b_router[l],
                        w_gu[l], b_gu[l], w_down[l], b_down[l])
    return rmsnorm(x, g_final)
```

```cpp
#include <hip/hip_runtime.h>
#include <cstdio>
#include <cstdint>

typedef unsigned short bf16_t;
typedef short bf16x8 __attribute__((ext_vector_type(8)));
typedef float f32x4 __attribute__((ext_vector_type(4)));
typedef unsigned u32x4 __attribute__((ext_vector_type(4)));
typedef unsigned u32x2 __attribute__((ext_vector_type(2)));

constexpr int NB = 2, SEQ = 8192, NTOK = NB * SEQ, DM = 1024, MEML = 256;
constexpr int NEXP = 32, TOPK = 4, NASSIGN = NTOK * TOPK;
constexpr int PROJ_LD = 3328;
constexpr int C_QG = 0, C_KG = 256, C_VG = 512, C_RG = 1024, C_QS = 1536, C_KS = 2048, C_VS = 2560, C_GLR = 3072;
constexpr float LOG2E = 1.4426950408889634f;
constexpr float EPS = 1e-5f;

__device__ __forceinline__ unsigned f2bf(float f) { unsigned u = __float_as_uint(f); return (u + 0x7fffu + ((u >> 16) & 1u)) >> 16; }
__device__ __forceinline__ unsigned pk2(float lo, float hi) { return f2bf(lo) | (f2bf(hi) << 16); }
__device__ __forceinline__ float bf2f(bf16_t h) { return __uint_as_float(((unsigned)h) << 16); }
__device__ __forceinline__ float bflo(unsigned w) { return __uint_as_float(w << 16); }
__device__ __forceinline__ float bfhi(unsigned w) { return __uint_as_float(w & 0xffff0000u); }

constexpr size_t MiB = 1u << 20;
constexpr size_t WS_CTL = 0;
constexpr size_t WS_WIN = 1 * MiB;
constexpr size_t WS_WOUT = 8 * MiB;
constexpr size_t WS_WQ = 10 * MiB;
constexpr size_t WS_WKV = 12 * MiB;
constexpr size_t WS_WMO = 16 * MiB;
constexpr size_t WS_WR = 18 * MiB;
constexpr size_t WS_WGU = 20 * MiB;
constexpr size_t WS_WDN = 148 * MiB;
constexpr size_t WS_XN = 212 * MiB;
constexpr size_t WS_MEMN = 244 * MiB;
constexpr size_t WS_KV = 245 * MiB;
constexpr size_t WS_BS = 247 * MiB;
constexpr size_t WS_BO = 251 * MiB;
constexpr size_t WS_PROJ = 256 * MiB;
constexpr size_t WS_LA = 360 * MiB;
constexpr size_t WS_ORAW = 376 * MiB;
constexpr size_t WS_MIX = 408 * MiB;
constexpr size_t WS_S = 440 * MiB;
constexpr size_t WS_P = 504 * MiB;
constexpr size_t WS_LG = 536 * MiB;
constexpr size_t WS_TOKE = 538 * MiB;
constexpr size_t WS_TOKR = 539 * MiB;
constexpr size_t WS_TOKW = 540 * MiB;
constexpr size_t WS_LIST = 541 * MiB;
constexpr size_t WS_ACT = 544 * MiB;
constexpr size_t WS_YS = 674 * MiB;
constexpr size_t WS_END = 804 * MiB;
constexpr int CW_CNT = 1024;

template <int MAP> __device__ __forceinline__ int srccol(int n, float& sc) {
    sc = 1.f;
    if (MAP == 0) return n;
    if (MAP == 1) {
        if (n < 256) { sc = 0.125f; return n; }
        if (n < 1024) return n;
        if (n < 3072) { if (n >= C_QS && n < C_KS) sc = 0.125f * LOG2E; return n + 16; }
        if (n < 3088) return 1024 + (n - 3072);
        return -1;
    }
    { const int ct = n >> 8, w = n & 255; return (w < 128) ? (128 * ct + w) : (1024 + 128 * ct + (w - 128)); }
}
template <int MAP>
__global__ void __launch_bounds__(256) k_conv_t(const float* __restrict__ src, bf16_t* __restrict__ dst, const float* __restrict__ gain,
                                               int ldsrc, int K, int nrows, int nmat, size_t sms, size_t dms) {
    const int kc8 = K / 8;
    const size_t total = (size_t)nmat * nrows * kc8;
    for (size_t idx = (size_t)blockIdx.x * blockDim.x + threadIdx.x; idx < total; idx += (size_t)gridDim.x * blockDim.x) {
        const int n = (int)(idx % nrows); const size_t t = idx / nrows; const int kc = (int)(t % kc8); const int mat = (int)(t / kc8);
        float sc; const int c = srccol<MAP>(n, sc);
        u32x4 o = {0u, 0u, 0u, 0u};
        if (c >= 0) {
            const float* s = src + (size_t)mat * sms + (size_t)(kc * 8) * ldsrc + c;
            float v[8];
#pragma unroll
            for (int j = 0; j < 8; ++j) v[j] = s[(size_t)j * ldsrc] * (gain ? gain[kc * 8 + j] : 1.f) * sc;
            o.x = pk2(v[0], v[1]); o.y = pk2(v[2], v[3]); o.z = pk2(v[4], v[5]); o.w = pk2(v[6], v[7]);
        }
        *(u32x4*)(dst + (size_t)mat * dms + (size_t)n * K + kc * 8) = o;
    }
}
__global__ void __launch_bounds__(256) k_conv_n(const float* __restrict__ src, bf16_t* __restrict__ dst, const float* __restrict__ gain, int K, int nrows, float sc) {
    const int kc8 = K / 8; const size_t total = (size_t)nrows * kc8;
    for (size_t idx = (size_t)blockIdx.x * blockDim.x + threadIdx.x; idx < total; idx += (size_t)gridDim.x * blockDim.x) {
        const int kc = (int)(idx % kc8), n = (int)(idx / kc8);
        const float g = gain[n] * sc; const f32x4 a = *(const f32x4*)(src + (size_t)n * K + kc * 8), b = *(const f32x4*)(src + (size_t)n * K + kc * 8 + 4);
        u32x4 o; o.x = pk2(a.x * g, a.y * g); o.y = pk2(a.z * g, a.w * g); o.z = pk2(b.x * g, b.y * g); o.w = pk2(b.z * g, b.w * g);
        *(u32x4*)(dst + (size_t)n * K + kc * 8) = o;
    }
}

__device__ __forceinline__ float wave_sum(float v) {
#pragma unroll
    for (int o = 1; o < 64; o <<= 1) v += __shfl_xor(v, o);
    return v;
}
__global__ void __launch_bounds__(256) k_rms(const float* __restrict__ x, bf16_t* __restrict__ out, int nrows) {
    const int lane = threadIdx.x & 63; const int gw = (blockIdx.x * blockDim.x + threadIdx.x) >> 6, ngw = (gridDim.x * blockDim.x) >> 6;
    for (int row = gw; row < nrows; row += ngw) {
        const f32x4* xr = (const f32x4*)(x + (size_t)row * DM) + lane; f32x4 v[4]; float s = 0.f;
#pragma unroll
        for (int j = 0; j < 4; ++j) { v[j] = xr[64 * j]; s += v[j].x * v[j].x + v[j].y * v[j].y + v[j].z * v[j].z + v[j].w * v[j].w; }
        const float rstd = 1.0f / sqrtf(wave_sum(s) * (1.f / DM) + EPS);
        u32x2* o = (u32x2*)(out + (size_t)row * DM) + lane;
#pragma unroll
        for (int j = 0; j < 4; ++j) { u32x2 w; w.x = pk2(v[j].x * rstd, v[j].y * rstd); w.y = pk2(v[j].z * rstd, v[j].w * rstd); o[64 * j] = w; }
    }
}

struct GUnit { const char* a; const char* b; int row0, col0, e, valid, aux; };

template <class Sched, class Epi>
__device__ __forceinline__ void sgemm_body(unsigned char* lds, const Sched& S, const Epi& E) {
    const int tid = threadIdx.x, wid = tid >> 6, lane = tid & 63, wr = wid >> 2, wc = wid & 3, fr = lane & 15, fq = lane >> 4;
    unsigned char* SA = lds; unsigned char* SB = lds + 16384;
    GUnit u;
    for (int i = 0; S.next(i, u); ++i) {
        f32x4 acc[2][2][4][2];
#pragma unroll
        for (int a = 0; a < 2; ++a)
#pragma unroll
            for (int b = 0; b < 2; ++b)
#pragma unroll
                for (int m = 0; m < 4; ++m)
#pragma unroll
                    for (int n = 0; n < 2; ++n) acc[a][b][m][n] = (f32x4){0.f, 0.f, 0.f, 0.f};
        unsigned aoff[2], boff[2];
#pragma unroll
        for (int p = 0; p < 2; ++p) { const int b = tid * 16 + p * 8192, r = b >> 6, c = (b & 63) >> 1; aoff[p] = S.a_off(u, r) + c * 2; boff[p] = r * S.ldb + c * 2; }
        const int nk = S.K / 32;
        for (int kt = 0; kt < nk; ++kt) {
            u32x4 ra[2], rb[2];
#pragma unroll
            for (int p = 0; p < 2; ++p) { ra[p] = *(const u32x4*)(u.a + aoff[p] + kt * 64); rb[p] = *(const u32x4*)(u.b + boff[p] + kt * 64); }
#pragma unroll
            for (int p = 0; p < 2; ++p) { *(u32x4*)(SA + tid * 16 + p * 8192) = ra[p]; *(u32x4*)(SB + tid * 16 + p * 8192) = rb[p]; }
            __syncthreads();
            bf16x8 Af[2][4], Bf[2][2];
#pragma unroll
            for (int ai = 0; ai < 2; ++ai)
#pragma unroll
                for (int m = 0; m < 4; ++m) Af[ai][m] = *(const bf16x8*)(SA + (128 * ai + 64 * wr + 16 * m + fr) * 64 + fq * 16);
#pragma unroll
            for (int bj = 0; bj < 2; ++bj)
#pragma unroll
                for (int n = 0; n < 2; ++n) Bf[bj][n] = *(const bf16x8*)(SB + (128 * bj + 32 * wc + 16 * n + fr) * 64 + fq * 16);
#pragma unroll
            for (int ai = 0; ai < 2; ++ai)
#pragma unroll
                for (int bj = 0; bj < 2; ++bj)
#pragma unroll
                    for (int m = 0; m < 4; ++m)
#pragma unroll
                        for (int n = 0; n < 2; ++n) acc[ai][bj][m][n] = __builtin_amdgcn_mfma_f32_16x16x32_bf16(Bf[bj][n], Af[ai][m], acc[ai][bj][m][n], 0, 0, 0);
            __syncthreads();
        }
        E(acc, u, wr, wc, fr, fq);
    }
}
#define EPI_ROWS(r) for (int ai = 0; ai < 2; ++ai) for (int m = 0; m < 4; ++m) { const int r = 128 * ai + 64 * wr + 16 * m + fr;
#define EPI_COLS(c) for (int bj = 0; bj < 2; ++bj) for (int n = 0; n < 2; ++n) { const int c = 128 * bj + 32 * wc + 16 * n + 4 * fq; const f32x4 v = acc[ai][bj][m][n];
#define EPI_END }

struct DenseSched {
    const char* A; const char* Bt; unsigned lda, ldb; int K; int nM, nN; int pm_per_b; size_t zB; int G, c;
    __device__ __forceinline__ bool next(int i, GUnit& u) const {
        const long L = (long)i * G + c; if (L >= (long)nM * nN) return false;
        const int pm = (int)(L / nN), pn = (int)(L % nN);
        u.a = A + (size_t)pm * 256 * lda; u.b = Bt + (size_t)(pm / pm_per_b) * zB + (size_t)pn * 256 * ldb; u.row0 = pm * 256; u.col0 = pn * 256; u.e = 0; u.valid = 256; u.aux = 0; return true;
    }
    __device__ __forceinline__ unsigned a_off(const GUnit&, int r) const { return (unsigned)r * lda; }
};
struct SchedWqk {
    const char* kv; const char* wq; unsigned lda, ldb; int K; int G, c, pad;
    __device__ __forceinline__ bool next(int i, GUnit& u) const {
        const int L = i * G + c; if (L >= 32) return false; const int z = L >> 2, pn = L & 3, b = z >> 2, h = z & 3;
        u.a = kv + (size_t)b * 256 * 4096 + h * 512; u.b = wq + (size_t)pn * 256 * 2048 + h * 512; u.row0 = z * 256; u.col0 = pn * 256; u.e = 0; u.valid = 256; u.aux = 0; return true;
    }
    __device__ __forceinline__ unsigned a_off(const GUnit&, int r) const { return (unsigned)r * lda; }
};
struct SchedVo {
    const char* wmo; const char* kv; unsigned lda, ldb; int K; int G, c, pad;
    __device__ __forceinline__ bool next(int i, GUnit& u) const {
        const int L = i * G + c; if (L >= 32) return false; const int z = L >> 2, pm = L & 3, b = z >> 2, h = z & 3;
        u.a = wmo + (size_t)pm * 256 * 2048 + h * 512; u.b = kv + (size_t)b * 256 * 4096 + 2048 + h * 512; u.row0 = b * 1024 + pm * 256; u.col0 = h * 256; u.e = 0; u.valid = 256; u.aux = 0; return true;
    }
    __device__ __forceinline__ unsigned a_off(const GUnit&, int r) const { return (unsigned)r * lda; }
};
struct MoeSched {
    const char* A; const char* Bt; unsigned lda, ldb; int K; int nN; size_t zB;
    const int* cnt; const int* list; int gather; int G, c, pad;
    __device__ __forceinline__ bool next(int i, GUnit& u) const {
        const int L = i * G + c; const int T = L / nN, pn = L % nN;
        int tiles = 0, start = 0;
        for (int e = 0; e < NEXP; ++e) { const int ce = cnt[e]; const int te = (ce + 255) >> 8;
            if (T < tiles + te) { const int rt = T - tiles; u.e = e; u.valid = min(256, ce - rt * 256); u.row0 = start + rt * 256; u.col0 = pn * 256; u.aux = rt * 256;
                u.a = gather ? A : A + (size_t)u.row0 * lda; u.b = Bt + (size_t)e * zB + (size_t)pn * 256 * ldb; return true; }
            tiles += te; start += ce; }
        return false;
    }
    __device__ __forceinline__ unsigned a_off(const GUnit& u, int r) const {
        if (!gather) return (unsigned)r * lda;
        const int rr = r < u.valid ? r : 0; const int tok = list[u.e * NTOK + u.aux + rr]; return (unsigned)tok * lda;
    }
};

struct EpiBf16 { bf16_t* O; int ldc, pad;
    __device__ __forceinline__ void operator()(const f32x4 (&acc)[2][2][4][2], const GUnit& u, int wr, int wc, int fr, int fq) const {
        EPI_ROWS(r) EPI_COLS(c) u32x2 w; w.x = pk2(v[0], v[1]); w.y = pk2(v[2], v[3]); *(u32x2*)(O + (size_t)(u.row0 + r) * ldc + u.col0 + c) = w; EPI_END EPI_END } };
struct EpiF32 { float* O; int ldc, pad;
    __device__ __forceinline__ void operator()(const f32x4 (&acc)[2][2][4][2], const GUnit& u, int wr, int wc, int fr, int fq) const {
        EPI_ROWS(r) EPI_COLS(c) *(f32x4*)(O + (size_t)(u.row0 + r) * ldc + u.col0 + c) = v; EPI_END EPI_END } };
struct EpiResid { const float* base; float* out; int ldc, pad;
    __device__ __forceinline__ void operator()(const f32x4 (&acc)[2][2][4][2], const GUnit& u, int wr, int wc, int fr, int fq) const {
        EPI_ROWS(r) EPI_COLS(c) const size_t o = (size_t)(u.row0 + r) * ldc + u.col0 + c; *(f32x4*)(out + o) = *(const f32x4*)(base + o) + v; EPI_END EPI_END } };
struct EpiGU { const float* bgu; bf16_t* act;
    __device__ __forceinline__ void operator()(const f32x4 (&acc)[2][2][4][2], const GUnit& u, int wr, int wc, int fr, int fq) const {
        const int pn = u.col0 >> 8; const float* bg = bgu + (size_t)u.e * 2048;
        for (int ai = 0; ai < 2; ++ai) for (int m = 0; m < 4; ++m) { const int r = 128 * ai + 64 * wr + 16 * m + fr; if (r >= u.valid) continue;
            for (int n = 0; n < 2; ++n) { const int c = 32 * wc + 16 * n + 4 * fq; const int col = 128 * pn + c;
                const f32x4 g = acc[ai][0][m][n] + *(const f32x4*)(bg + col), l = acc[ai][1][m][n] + *(const f32x4*)(bg + 1024 + col); float o[4];
#pragma unroll
                for (int j = 0; j < 4; ++j) { const float gg = fminf(g[j], 7.0f), ll = fminf(fmaxf(l[j], -7.0f), 7.0f); o[j] = (ll + 1.0f) * (gg / (1.0f + __expf(-1.702f * gg))); }
                u32x2 w; w.x = pk2(o[0], o[1]); w.y = pk2(o[2], o[3]); *(u32x2*)(act + (size_t)(u.row0 + r) * 1024 + col) = w; } } } };
struct EpiDown { const float* bdn; bf16_t* ys;
    __device__ __forceinline__ void operator()(const f32x4 (&acc)[2][2][4][2], const GUnit& u, int wr, int wc, int fr, int fq) const {
        const float* bd = bdn + (size_t)u.e * 1024;
        for (int ai = 0; ai < 2; ++ai) for (int m = 0; m < 4; ++m) { const int r = 128 * ai + 64 * wr + 16 * m + fr; if (r >= u.valid) continue;
            EPI_COLS(c) const int col = u.col0 + c; const f32x4 y = v + *(const f32x4*)(bd + col); u32x2 w; w.x = pk2(y[0], y[1]); w.y = pk2(y[2], y[3]); *(u32x2*)(ys + (size_t)(u.row0 + r) * 1024 + col) = w; EPI_END } } };

template <class Sched, class Epi>
__global__ void __launch_bounds__(512) k_gemm(Sched S, Epi E) {
    __shared__ __attribute__((aligned(16))) unsigned char lds[32768];
    S.G = gridDim.x; S.c = blockIdx.x;
    sgemm_body(lds, S, E);
}

__global__ void __launch_bounds__(256) k_alpha(const bf16_t* __restrict__ proj, const float* __restrict__ wg, const float* __restrict__ bg, float* __restrict__ alpha) {
    const int idx = blockIdx.x * blockDim.x + threadIdx.x; if (idx >= NTOK * 256) return;
    const int t = idx >> 8, j = idx & 255; float u = bg[j];
    for (int i = 0; i < 16; ++i) u += bf2f(proj[(size_t)t * PROJ_LD + C_GLR + i]) * wg[i * 256 + j];
    const float ls = fminf(u, 0.f) - log1pf(__expf(-fabsf(u)));
    alpha[idx] = __expf(ls * (1.0f / 16.0f));
}
__global__ void __launch_bounds__(128) k_gla_naive(const bf16_t* __restrict__ proj, const float* __restrict__ alpha, float* __restrict__ oraw) {
    const int b = blockIdx.x >> 2, h = blockIdx.x & 3, dv = threadIdx.x;
    float S[64];
#pragma unroll
    for (int i = 0; i < 64; ++i) S[i] = 0.f;
    for (int c = 0; c < SEQ / 64; ++c) {
        for (int s = 0; s < 64; ++s) { const size_t t = (size_t)b * SEQ + c * 64 + s; const bf16_t* pr = proj + t * PROJ_LD;
            const float vv = bf2f(pr[C_VG + h * 128 + dv]); const float* al = alpha + t * 256 + h * 64;
#pragma unroll
            for (int i = 0; i < 64; ++i) S[i] = al[i] * S[i] + bf2f(pr[C_KG + h * 64 + i]) * vv; }
        for (int s = 0; s < 64; ++s) { const size_t t = (size_t)b * SEQ + c * 64 + s; const bf16_t* pr = proj + t * PROJ_LD; float o = 0.f;
#pragma unroll
            for (int i = 0; i < 64; ++i) o += bf2f(pr[C_QG + h * 64 + i]) * S[i];
            oraw[t * 512 + h * 128 + dv] = o; }
    }
}
__global__ void __launch_bounds__(256) k_gla_norm(const float* __restrict__ oraw, const bf16_t* __restrict__ proj, const float* __restrict__ ghead, bf16_t* __restrict__ mix) {
    const int idx = blockIdx.x * blockDim.x + threadIdx.x; if (idx >= NTOK * 4) return;
    const int t = idx >> 2, h = idx & 3; const float* o = oraw + (size_t)t * 512 + h * 128; float s = 0.f;
    for (int i = 0; i < 128; ++i) s += o[i] * o[i];
    const float rstd = 1.0f / sqrtf(s * (1.f / 128.f) + EPS);
    for (int i = 0; i < 128; ++i) { const float rg = bf2f(proj[(size_t)t * PROJ_LD + C_RG + h * 128 + i]); const float y = o[i] * rstd * ghead[i] * (rg / (1.0f + __expf(-rg)));
        mix[(size_t)t * 1024 + h * 128 + i] = (bf16_t)f2bf(y); }
}
__global__ void __launch_bounds__(256) k_sb_naive(const bf16_t* __restrict__ proj, bf16_t* __restrict__ mix) {
    const int idx = blockIdx.x * blockDim.x + threadIdx.x; if (idx >= NTOK * 8) return;
    const int tt = idx % SEQ, bh = idx / SEQ, b = bh >> 3, h = bh & 7; const size_t t = (size_t)b * SEQ + tt;
    float q[64], o[64];
#pragma unroll
    for (int d = 0; d < 64; ++d) { q[d] = bf2f(proj[t * PROJ_LD + C_QS + h * 64 + d]); o[d] = 0.f; }
    float D = 1.0f;
    for (int s = tt - 1; s >= 0; --s) { const bf16_t* pr = proj + ((size_t)b * SEQ + s) * PROJ_LD; float z = 0.f;
#pragma unroll
        for (int d = 0; d < 64; ++d) z += q[d] * bf2f(pr[C_KS + h * 64 + d]);
        const float e = exp2f(fminf(z, 126.0f)); D = D + D * e; const float A = e * (1.0f / D);
#pragma unroll
        for (int d = 0; d < 64; ++d) o[d] += A * bf2f(pr[C_VS + h * 64 + d]);
        if (!(D < 3.0e38f)) break; }
#pragma unroll
    for (int d = 0; d < 64; ++d) mix[t * 1024 + 512 + h * 64 + d] = (bf16_t)f2bf(o[d]);
}
__global__ void __launch_bounds__(256) k_softmax(const float* __restrict__ S, bf16_t* __restrict__ P) {
    const int lane = threadIdx.x & 63; const int gw = (blockIdx.x * blockDim.x + threadIdx.x) >> 6;
    if (gw >= NTOK * 4) return;
    const f32x4 v = *((const f32x4*)(S + (size_t)gw * 256) + lane);
    float m = fmaxf(fmaxf(v.x, v.y), fmaxf(v.z, v.w));
#pragma unroll
    for (int o = 1; o < 64; o <<= 1) m = fmaxf(m, __shfl_xor(m, o));
    const float e0 = exp2f(v.x - m), e1 = exp2f(v.y - m), e2 = exp2f(v.z - m), e3 = exp2f(v.w - m);
    const float inv = 1.0f / wave_sum(e0 + e1 + e2 + e3);
    u32x2 w; w.x = pk2(e0 * inv, e1 * inv); w.y = pk2(e2 * inv, e3 * inv); *((u32x2*)(P + (size_t)gw * 256) + lane) = w;
}
__global__ void __launch_bounds__(256) k_router_logits(const bf16_t* __restrict__ xn, const bf16_t* __restrict__ wr, const float* __restrict__ br, float* __restrict__ lg) {
    const int idx = blockIdx.x * blockDim.x + threadIdx.x; if (idx >= NTOK * NEXP) return;
    const int t = idx >> 5, e = idx & 31; const u32x4* a = (const u32x4*)(xn + (size_t)t * DM); const u32x4* w = (const u32x4*)(wr + (size_t)e * DM); float s = 0.f;
    for (int i = 0; i < DM / 8; ++i) { const u32x4 x = a[i], y = w[i];
        s += bflo(x.x) * bflo(y.x) + bfhi(x.x) * bfhi(y.x) + bflo(x.y) * bflo(y.y) + bfhi(x.y) * bfhi(y.y) + bflo(x.z) * bflo(y.z) + bfhi(x.z) * bfhi(y.z) + bflo(x.w) * bflo(y.w) + bfhi(x.w) * bfhi(y.w); }
    lg[idx] = s + br[e];
}
__global__ void __launch_bounds__(256) k_router_topk(const float* __restrict__ lg, int* __restrict__ cnt, int* __restrict__ list, int* __restrict__ toke, int* __restrict__ tokr, float* __restrict__ tokw) {
    const int t = blockIdx.x * blockDim.x + threadIdx.x; if (t >= NTOK) return;
    float v[NEXP];
#pragma unroll
    for (int e = 0; e < NEXP; ++e) v[e] = lg[(size_t)t * NEXP + e];
    float tv[4]; int ti[4];
#pragma unroll
    for (int k = 0; k < 4; ++k) { float best = -INFINITY; int bi = 0;
#pragma unroll
        for (int e = 0; e < NEXP; ++e) { if (v[e] > best) { best = v[e]; bi = e; } }
        tv[k] = best; ti[k] = bi;
#pragma unroll
        for (int e = 0; e < NEXP; ++e) if (e == bi) v[e] = -INFINITY; }
    const float e1 = __expf(tv[1] - tv[0]), e2 = __expf(tv[2] - tv[0]), e3 = __expf(tv[3] - tv[0]); const float inv = 1.0f / (1.0f + e1 + e2 + e3);
    const float g[4] = {inv, e1 * inv, e2 * inv, e3 * inv};
#pragma unroll
    for (int k = 0; k < 4; ++k) { const int r = atomicAdd(&cnt[ti[k]], 1); list[ti[k] * NTOK + r] = t; toke[t * 4 + k] = ti[k]; tokr[t * 4 + k] = r; tokw[t * 4 + k] = g[k]; }
}
__global__ void __launch_bounds__(256) k_combine(float* __restrict__ xio, const bf16_t* __restrict__ ys, const int* __restrict__ cnt, const int* __restrict__ toke, const int* __restrict__ tokr,
                                                 const float* __restrict__ tokw, const float* __restrict__ gfin) {
    const int lane = threadIdx.x & 63; const int t = (blockIdx.x * blockDim.x + threadIdx.x) >> 6; if (t >= NTOK) return;
    f32x4* xr = (f32x4*)(xio + (size_t)t * DM) + lane; f32x4 v[4];
#pragma unroll
    for (int j = 0; j < 4; ++j) v[j] = xr[64 * j];
    for (int k = 0; k < 4; ++k) { const int e = toke[t * 4 + k], r = tokr[t * 4 + k]; const float w = tokw[t * 4 + k]; int start = 0; for (int i = 0; i < e; ++i) start += cnt[i];
        const u32x2* yr = (const u32x2*)(ys + (size_t)(start + r) * DM) + lane;
#pragma unroll
        for (int j = 0; j < 4; ++j) { const u32x2 y = yr[64 * j]; v[j].x += w * bflo(y.x); v[j].y += w * bfhi(y.x); v[j].z += w * bflo(y.y); v[j].w += w * bfhi(y.y); } }
    float s = 0.f;
#pragma unroll
    for (int j = 0; j < 4; ++j) s += v[j].x * v[j].x + v[j].y * v[j].y + v[j].z * v[j].z + v[j].w * v[j].w;
    const float rstd = 1.0f / sqrtf(wave_sum(s) * (1.f / DM) + EPS);
#pragma unroll
    for (int j = 0; j < 4; ++j) { const f32x4 g = *((const f32x4*)gfin + lane + 64 * j); xr[64 * j] = v[j] * rstd * g; }
}

extern "C" void kernel_launch(void* const* d_in, const int* in_sizes, int n_in, void* d_out, int out_size, void* d_ws, size_t ws_size, hipStream_t stream) {
    if (n_in != 22 || in_sizes[0] != NTOK * DM || out_size != NTOK * DM || ws_size < WS_END) { fprintf(stderr, "kernel_launch: unexpected shapes (n_in %d, ws %zu)\n", n_in, ws_size); return; }
    const float* x = (const float*)d_in[0]; const float* mem = (const float*)d_in[1]; const float* g_mix = (const float*)d_in[2]; const float* w_in = (const float*)d_in[3];
    const float* w_gla_gate = (const float*)d_in[4]; const float* b_gla_gate = (const float*)d_in[5]; const float* g_gla_head = (const float*)d_in[6]; const float* w_out = (const float*)d_in[7];
    const float* g_mem_q = (const float*)d_in[8]; const float* g_mem_kv = (const float*)d_in[9]; const float* w_mq = (const float*)d_in[10]; const float* w_mk = (const float*)d_in[11];
    const float* w_mv = (const float*)d_in[12]; const float* w_mo = (const float*)d_in[13]; const float* g_ffn = (const float*)d_in[14]; const float* w_router = (const float*)d_in[15];
    const float* b_router = (const float*)d_in[16]; const float* w_gu = (const float*)d_in[17]; const float* b_gu = (const float*)d_in[18]; const float* w_down = (const float*)d_in[19];
    const float* b_down = (const float*)d_in[20]; const float* g_final = (const float*)d_in[21];
    unsigned char* ws = (unsigned char*)d_ws; float* out = (float*)d_out;
    bf16_t* Wt_in = (bf16_t*)(ws + WS_WIN); bf16_t* Wt_out = (bf16_t*)(ws + WS_WOUT); bf16_t* Wq = (bf16_t*)(ws + WS_WQ); bf16_t* Wt_kv = (bf16_t*)(ws + WS_WKV);
    bf16_t* Wt_mo = (bf16_t*)(ws + WS_WMO); bf16_t* Wt_r = (bf16_t*)(ws + WS_WR); bf16_t* Wt_gu = (bf16_t*)(ws + WS_WGU); bf16_t* Wt_dn = (bf16_t*)(ws + WS_WDN);
    bf16_t* xn = (bf16_t*)(ws + WS_XN); bf16_t* memn = (bf16_t*)(ws + WS_MEMN); bf16_t* kv = (bf16_t*)(ws + WS_KV); bf16_t* Bs = (bf16_t*)(ws + WS_BS); bf16_t* Bo = (bf16_t*)(ws + WS_BO);
    bf16_t* proj = (bf16_t*)(ws + WS_PROJ); float* alpha = (float*)(ws + WS_LA); float* oraw = (float*)(ws + WS_ORAW); bf16_t* mix = (bf16_t*)(ws + WS_MIX);
    float* Sc = (float*)(ws + WS_S); bf16_t* P = (bf16_t*)(ws + WS_P); float* lg = (float*)(ws + WS_LG); int* toke = (int*)(ws + WS_TOKE); int* tokr = (int*)(ws + WS_TOKR);
    float* tokw = (float*)(ws + WS_TOKW); int* list = (int*)(ws + WS_LIST); bf16_t* act = (bf16_t*)(ws + WS_ACT); bf16_t* ys = (bf16_t*)(ws + WS_YS);
    int* cnt = (int*)(ws + WS_CTL) + CW_CNT;

    (void)hipMemsetAsync(ws + WS_CTL, 0, 1 * MiB, stream);
    k_conv_t<1><<<2048, 256, 0, stream>>>(w_in, Wt_in, g_mix, 3088, 1024, 3328, 1, 0, 0);
    k_conv_t<0><<<1024, 256, 0, stream>>>(w_out, Wt_out, nullptr, 1024, 1024, 1024, 1, 0, 0);
    k_conv_n<<<1024, 256, 0, stream>>>(w_mq, Wq, g_mem_q, 1024, 1024, LOG2E / 16.0f);
    k_conv_t<0><<<1024, 256, 0, stream>>>(w_mk, Wt_kv, g_mem_kv, 1024, 1024, 1024, 1, 0, 0);
    k_conv_t<0><<<1024, 256, 0, stream>>>(w_mv, Wt_kv + (size_t)1024 * 1024, g_mem_kv, 1024, 1024, 1024, 1, 0, 0);
    k_conv_t<0><<<1024, 256, 0, stream>>>(w_mo, Wt_mo, nullptr, 1024, 1024, 1024, 1, 0, 0);
    k_conv_t<0><<<64, 256, 0, stream>>>(w_router, Wt_r, g_ffn, 32, 1024, 32, 1, 0, 0);
    k_conv_t<2><<<8192, 256, 0, stream>>>(w_gu, Wt_gu, g_ffn, 2048, 1024, 2048, 32, (size_t)1024 * 2048, (size_t)2048 * 1024);
    k_conv_t<0><<<8192, 256, 0, stream>>>(w_down, Wt_dn, nullptr, 1024, 1024, 1024, 32, (size_t)1024 * 1024, (size_t)1024 * 1024);
    k_rms<<<2048, 256, 0, stream>>>(x, xn, NTOK);
    k_rms<<<128, 256, 0, stream>>>(mem, memn, NB * MEML);
    { DenseSched S{(const char*)xn, (const char*)Wt_in, 2048u, 2048u, 1024, 64, 13, 1 << 30, 0, 0, 0}; EpiBf16 E{proj, PROJ_LD, 0}; k_gemm<<<832, 512, 0, stream>>>(S, E); }
    { DenseSched S{(const char*)memn, (const char*)Wt_kv, 2048u, 2048u, 1024, 2, 8, 1 << 30, 0, 0, 0}; EpiBf16 E{kv, 2048, 0}; k_gemm<<<16, 512, 0, stream>>>(S, E); }
    { SchedWqk S{(const char*)kv, (const char*)Wq, 4096u, 2048u, 256, 0, 0, 0}; EpiBf16 E{Bs, 1024, 0}; k_gemm<<<32, 512, 0, stream>>>(S, E); }
    { SchedVo S{(const char*)Wt_mo, (const char*)kv, 2048u, 4096u, 256, 0, 0, 0}; EpiBf16 E{Bo, 1024, 0}; k_gemm<<<32, 512, 0, stream>>>(S, E); }
    k_alpha<<<NTOK, 256, 0, stream>>>(proj, w_gla_gate, b_gla_gate, alpha);
    k_gla_naive<<<8, 128, 0, stream>>>(proj, alpha, oraw);
    k_gla_norm<<<NTOK * 4 / 256, 256, 0, stream>>>(oraw, proj, g_gla_head, mix);
    k_sb_naive<<<NTOK * 8 / 256, 256, 0, stream>>>(proj, mix);
    { DenseSched S{(const char*)mix, (const char*)Wt_out, 2048u, 2048u, 1024, 64, 4, 1 << 30, 0, 0, 0}; EpiResid E{x, out, 1024, 0}; k_gemm<<<256, 512, 0, stream>>>(S, E); }
    k_rms<<<2048, 256, 0, stream>>>(out, xn, NTOK);
    { DenseSched S{(const char*)xn, (const char*)Bs, 2048u, 2048u, 1024, 64, 4, 32, (size_t)1024 * 2048, 0, 0}; EpiF32 E{Sc, 1024, 0}; k_gemm<<<256, 512, 0, stream>>>(S, E); }
    k_softmax<<<NTOK * 4 / 4, 256, 0, stream>>>(Sc, P);
    { DenseSched S{(const char*)P, (const char*)Bo, 2048u, 2048u, 1024, 64, 4, 32, (size_t)1024 * 2048, 0, 0}; EpiResid E{out, out, 1024, 0}; k_gemm<<<256, 512, 0, stream>>>(S, E); }
    k_rms<<<2048, 256, 0, stream>>>(out, xn, NTOK);
    k_router_logits<<<NTOK * NEXP / 256, 256, 0, stream>>>(xn, Wt_r, b_router, lg);
    k_router_topk<<<NTOK / 256, 256, 0, stream>>>(lg, cnt, list, toke, tokr, tokw);
    { MoeSched S{(const char*)xn, (const char*)Wt_gu, 2048u, 2048u, 1024, 8, (size_t)2048 * 2048, cnt, list, 1, 0, 0, 0}; EpiGU E{b_gu, act}; k_gemm<<<288 * 8, 512, 0, stream>>>(S, E); }
    { MoeSched S{(const char*)act, (const char*)Wt_dn, 2048u, 2048u, 1024, 4, (size_t)1024 * 2048, cnt, list, 0, 0, 0, 0}; EpiDown E{b_down, ys}; k_gemm<<<288 * 4, 512, 0, stream>>>(S, E); }
    k_combine<<<NTOK / 4, 256, 0, stream>>>(out, ys, cnt, toke, tokr, tokw, g_final);
}
```

```cpp
#include <hip/hip_runtime.h>
#include <cstdio>
#include <cstdint>
#ifndef USE_NAIVE_GLA
#define USE_NAIVE_GLA 0
#endif
#ifndef USE_NAIVE_SB
#define USE_NAIVE_SB 0
#endif

typedef unsigned short bf16_t;
typedef short bf16x8 __attribute__((ext_vector_type(8)));
typedef float f32x4 __attribute__((ext_vector_type(4)));
typedef unsigned u32x4 __attribute__((ext_vector_type(4)));
typedef unsigned u32x2 __attribute__((ext_vector_type(2)));

constexpr int NB = 2, SEQ = 8192, NTOK = NB * SEQ, DM = 1024, MEML = 256;
constexpr int NEXP = 32, TOPK = 4, NASSIGN = NTOK * TOPK;
constexpr int PROJ_LD = 3328;
constexpr int C_QG = 0, C_KG = 256, C_VG = 512, C_RG = 1024, C_QS = 1536, C_KS = 2048, C_VS = 2560, C_GLR = 3072;
constexpr float LOG2E = 1.4426950408889634f;
constexpr float EPS = 1e-5f;

__device__ __forceinline__ unsigned f2bf(float f) { unsigned u = __float_as_uint(f); return (u + 0x7fffu + ((u >> 16) & 1u)) >> 16; }
__device__ __forceinline__ unsigned pk2(float lo, float hi) { return f2bf(lo) | (f2bf(hi) << 16); }
__device__ __forceinline__ float bf2f(bf16_t h) { return __uint_as_float(((unsigned)h) << 16); }
__device__ __forceinline__ float bflo(unsigned w) { return __uint_as_float(w << 16); }
__device__ __forceinline__ float bfhi(unsigned w) { return __uint_as_float(w & 0xffff0000u); }

constexpr size_t MiB = 1u << 20;
constexpr size_t WS_CTL = 0;
constexpr size_t WS_WIN = 1 * MiB;
constexpr size_t WS_WOUT = 8 * MiB;
constexpr size_t WS_WQ = 10 * MiB;
constexpr size_t WS_WKV = 12 * MiB;
constexpr size_t WS_WMO = 16 * MiB;
constexpr size_t WS_WR = 18 * MiB;
constexpr size_t WS_WGU = 20 * MiB;
constexpr size_t WS_WDN = 148 * MiB;
constexpr size_t WS_XN = 212 * MiB;
constexpr size_t WS_MEMN = 244 * MiB;
constexpr size_t WS_KV = 245 * MiB;
constexpr size_t WS_BS = 247 * MiB;
constexpr size_t WS_BO = 251 * MiB;
constexpr size_t WS_PROJ = 256 * MiB;
constexpr size_t WS_LA = 360 * MiB;
constexpr size_t WS_ORAW = 376 * MiB;
constexpr size_t WS_MIX = 408 * MiB;
constexpr size_t WS_S = 440 * MiB;
constexpr size_t WS_P = 504 * MiB;
constexpr size_t WS_LG = 536 * MiB;
constexpr size_t WS_TOKE = 538 * MiB;
constexpr size_t WS_TOKR = 539 * MiB;
constexpr size_t WS_TOKW = 540 * MiB;
constexpr size_t WS_LIST = 541 * MiB;
constexpr size_t WS_ACT = 544 * MiB;
constexpr size_t WS_YS = 674 * MiB;
constexpr size_t WS_END = 804 * MiB;
constexpr int CW_CNT = 1024;

template <int MAP> __device__ __forceinline__ int srccol(int n, float& sc) {
    sc = 1.f;
    if (MAP == 0) return n;
    if (MAP == 1) {
        if (n < 256) { sc = 0.125f; return n; }
        if (n < 1024) return n;
        if (n < 3072) { if (n >= C_QS && n < C_KS) sc = 0.125f * LOG2E; return n + 16; }
        if (n < 3088) return 1024 + (n - 3072);
        return -1;
    }
    { const int ct = n >> 8, w = n & 255; return (w < 128) ? (128 * ct + w) : (1024 + 128 * ct + (w - 128)); }
}
template <int MAP>
__global__ void __launch_bounds__(256) k_conv_t(const float* __restrict__ src, bf16_t* __restrict__ dst, const float* __restrict__ gain,
                                               int ldsrc, int K, int nrows, int nmat, size_t sms, size_t dms) {
    const int kc8 = K / 8;
    const size_t total = (size_t)nmat * nrows * kc8;
    for (size_t idx = (size_t)blockIdx.x * blockDim.x + threadIdx.x; idx < total; idx += (size_t)gridDim.x * blockDim.x) {
        const int n = (int)(idx % nrows); const size_t t = idx / nrows; const int kc = (int)(t % kc8); const int mat = (int)(t / kc8);
        float sc; const int c = srccol<MAP>(n, sc);
        u32x4 o = {0u, 0u, 0u, 0u};
        if (c >= 0) {
            const float* s = src + (size_t)mat * sms + (size_t)(kc * 8) * ldsrc + c;
            float v[8];
#pragma unroll
            for (int j = 0; j < 8; ++j) v[j] = s[(size_t)j * ldsrc] * (gain ? gain[kc * 8 + j] : 1.f) * sc;
            o.x = pk2(v[0], v[1]); o.y = pk2(v[2], v[3]); o.z = pk2(v[4], v[5]); o.w = pk2(v[6], v[7]);
        }
        *(u32x4*)(dst + (size_t)mat * dms + (size_t)n * K + kc * 8) = o;
    }
}
__global__ void __launch_bounds__(256) k_conv_n(const float* __restrict__ src, bf16_t* __restrict__ dst, const float* __restrict__ gain, int K, int nrows, float sc) {
    const int kc8 = K / 8; const size_t total = (size_t)nrows * kc8;
    for (size_t idx = (size_t)blockIdx.x * blockDim.x + threadIdx.x; idx < total; idx += (size_t)gridDim.x * blockDim.x) {
        const int kc = (int)(idx % kc8), n = (int)(idx / kc8);
        const float g = gain[n] * sc; const f32x4 a = *(const f32x4*)(src + (size_t)n * K + kc * 8), b = *(const f32x4*)(src + (size_t)n * K + kc * 8 + 4);
        u32x4 o; o.x = pk2(a.x * g, a.y * g); o.y = pk2(a.z * g, a.w * g); o.z = pk2(b.x * g, b.y * g); o.w = pk2(b.z * g, b.w * g);
        *(u32x4*)(dst + (size_t)n * K + kc * 8) = o;
    }
}

__device__ __forceinline__ float wave_sum(float v) {
#pragma unroll
    for (int o = 1; o < 64; o <<= 1) v += __shfl_xor(v, o);
    return v;
}
__global__ void __launch_bounds__(256) k_rms(const float* __restrict__ x, bf16_t* __restrict__ out, int nrows) {
    const int lane = threadIdx.x & 63; const int gw = (blockIdx.x * blockDim.x + threadIdx.x) >> 6, ngw = (gridDim.x * blockDim.x) >> 6;
    for (int row = gw; row < nrows; row += ngw) {
        const f32x4* xr = (const f32x4*)(x + (size_t)row * DM) + lane; f32x4 v[4]; float s = 0.f;
#pragma unroll
        for (int j = 0; j < 4; ++j) { v[j] = xr[64 * j]; s += v[j].x * v[j].x + v[j].y * v[j].y + v[j].z * v[j].z + v[j].w * v[j].w; }
        const float rstd = 1.0f / sqrtf(wave_sum(s) * (1.f / DM) + EPS);
        u32x2* o = (u32x2*)(out + (size_t)row * DM) + lane;
#pragma unroll
        for (int j = 0; j < 4; ++j) { u32x2 w; w.x = pk2(v[j].x * rstd, v[j].y * rstd); w.y = pk2(v[j].z * rstd, v[j].w * rstd); o[64 * j] = w; }
    }
}

struct GUnit { const char* a; const char* b; int row0, col0, e, valid, aux; };

template <class Sched, class Epi>
__device__ __forceinline__ void sgemm_body(unsigned char* lds, const Sched& S, const Epi& E) {
    const int tid = threadIdx.x, wid = tid >> 6, lane = tid & 63, wr = wid >> 2, wc = wid & 3, fr = lane & 15, fq = lane >> 4;
    unsigned char* SA = lds; unsigned char* SB = lds + 16384;
    GUnit u;
    for (int i = 0; S.next(i, u); ++i) {
        f32x4 acc[2][2][4][2];
#pragma unroll
        for (int a = 0; a < 2; ++a)
#pragma unroll
            for (int b = 0; b < 2; ++b)
#pragma unroll
                for (int m = 0; m < 4; ++m)
#pragma unroll
                    for (int n = 0; n < 2; ++n) acc[a][b][m][n] = (f32x4){0.f, 0.f, 0.f, 0.f};
        unsigned aoff[2], boff[2];
#pragma unroll
        for (int p = 0; p < 2; ++p) { const int b = tid * 16 + p * 8192, r = b >> 6, c = (b & 63) >> 1; aoff[p] = S.a_off(u, r) + c * 2; boff[p] = r * S.ldb + c * 2; }
        const int nk = S.K / 32;
        for (int kt = 0; kt < nk; ++kt) {
            u32x4 ra[2], rb[2];
#pragma unroll
            for (int p = 0; p < 2; ++p) { ra[p] = *(const u32x4*)(u.a + aoff[p] + kt * 64); rb[p] = *(const u32x4*)(u.b + boff[p] + kt * 64); }
#pragma unroll
            for (int p = 0; p < 2; ++p) { *(u32x4*)(SA + tid * 16 + p * 8192) = ra[p]; *(u32x4*)(SB + tid * 16 + p * 8192) = rb[p]; }
            __syncthreads();
            bf16x8 Af[2][4], Bf[2][2];
#pragma unroll
            for (int ai = 0; ai < 2; ++ai)
#pragma unroll
                for (int m = 0; m < 4; ++m) Af[ai][m] = *(const bf16x8*)(SA + (128 * ai + 64 * wr + 16 * m + fr) * 64 + fq * 16);
#pragma unroll
            for (int bj = 0; bj < 2; ++bj)
#pragma unroll
                for (int n = 0; n < 2; ++n) Bf[bj][n] = *(const bf16x8*)(SB + (128 * bj + 32 * wc + 16 * n + fr) * 64 + fq * 16);
#pragma unroll
            for (int ai = 0; ai < 2; ++ai)
#pragma unroll
                for (int bj = 0; bj < 2; ++bj)
#pragma unroll
                    for (int m = 0; m < 4; ++m)
#pragma unroll
                        for (int n = 0; n < 2; ++n) acc[ai][bj][m][n] = __builtin_amdgcn_mfma_f32_16x16x32_bf16(Bf[bj][n], Af[ai][m], acc[ai][bj][m][n], 0, 0, 0);
            __syncthreads();
        }
        E(acc, u, wr, wc, fr, fq);
    }
}
#define EPI_ROWS(r) for (int ai = 0; ai < 2; ++ai) for (int m = 0; m < 4; ++m) { const int r = 128 * ai + 64 * wr + 16 * m + fr;
#define EPI_COLS(c) for (int bj = 0; bj < 2; ++bj) for (int n = 0; n < 2; ++n) { const int c = 128 * bj + 32 * wc + 16 * n + 4 * fq; const f32x4 v = acc[ai][bj][m][n];
#define EPI_END }

struct DenseSched {
    const char* A; const char* Bt; unsigned lda, ldb; int K; int nM, nN; int pm_per_b; size_t zB; int G, c;
    __device__ __forceinline__ bool next(int i, GUnit& u) const {
        const long L = (long)i * G + c; if (L >= (long)nM * nN) return false;
        const int pm = (int)(L / nN), pn = (int)(L % nN);
        u.a = A + (size_t)pm * 256 * lda; u.b = Bt + (size_t)(pm / pm_per_b) * zB + (size_t)pn * 256 * ldb; u.row0 = pm * 256; u.col0 = pn * 256; u.e = 0; u.valid = 256; u.aux = 0; return true;
    }
    __device__ __forceinline__ unsigned a_off(const GUnit&, int r) const { return (unsigned)r * lda; }
};
struct SchedWqk {
    const char* kv; const char* wq; unsigned lda, ldb; int K; int G, c, pad;
    __device__ __forceinline__ bool next(int i, GUnit& u) const {
        const int L = i * G + c; if (L >= 32) return false; const int z = L >> 2, pn = L & 3, b = z >> 2, h = z & 3;
        u.a = kv + (size_t)b * 256 * 4096 + h * 512; u.b = wq + (size_t)pn * 256 * 2048 + h * 512; u.row0 = z * 256; u.col0 = pn * 256; u.e = 0; u.valid = 256; u.aux = 0; return true;
    }
    __device__ __forceinline__ unsigned a_off(const GUnit&, int r) const { return (unsigned)r * lda; }
};
struct SchedVo {
    const char* wmo; const char* kv; unsigned lda, ldb; int K; int G, c, pad;
    __device__ __forceinline__ bool next(int i, GUnit& u) const {
        const int L = i * G + c; if (L >= 32) return false; const int z = L >> 2, pm = L & 3, b = z >> 2, h = z & 3;
        u.a = wmo + (size_t)pm * 256 * 2048 + h * 512; u.b = kv + (size_t)b * 256 * 4096 + 2048 + h * 512; u.row0 = b * 1024 + pm * 256; u.col0 = h * 256; u.e = 0; u.valid = 256; u.aux = 0; return true;
    }
    __device__ __forceinline__ unsigned a_off(const GUnit&, int r) const { return (unsigned)r * lda; }
};
struct MoeSched {
    const char* A; const char* Bt; unsigned lda, ldb; int K; int nN; size_t zB;
    const int* cnt; const int* list; int gather; int G, c, pad;
    __device__ __forceinline__ bool next(int i, GUnit& u) const {
        const int L = i * G + c; const int T = L / nN, pn = L % nN;
        int tiles = 0, start = 0;
        for (int e = 0; e < NEXP; ++e) { const int ce = cnt[e]; const int te = (ce + 255) >> 8;
            if (T < tiles + te) { const int rt = T - tiles; u.e = e; u.valid = min(256, ce - rt * 256); u.row0 = start + rt * 256; u.col0 = pn * 256; u.aux = rt * 256;
                u.a = gather ? A : A + (size_t)u.row0 * lda; u.b = Bt + (size_t)e * zB + (size_t)pn * 256 * ldb; return true; }
            tiles += te; start += ce; }
        return false;
    }
    __device__ __forceinline__ unsigned a_off(const GUnit& u, int r) const {
        if (!gather) return (unsigned)r * lda;
        const int rr = r < u.valid ? r : 0; const int tok = list[u.e * NTOK + u.aux + rr]; return (unsigned)tok * lda;
    }
};

struct EpiBf16 { bf16_t* O; int ldc, pad;
    __device__ __forceinline__ void operator()(const f32x4 (&acc)[2][2][4][2], const GUnit& u, int wr, int wc, int fr, int fq) const {
        EPI_ROWS(r) EPI_COLS(c) u32x2 w; w.x = pk2(v[0], v[1]); w.y = pk2(v[2], v[3]); *(u32x2*)(O + (size_t)(u.row0 + r) * ldc + u.col0 + c) = w; EPI_END EPI_END } };
struct EpiF32 { float* O; int ldc, pad;
    __device__ __forceinline__ void operator()(const f32x4 (&acc)[2][2][4][2], const GUnit& u, int wr, int wc, int fr, int fq) const {
        EPI_ROWS(r) EPI_COLS(c) *(f32x4*)(O + (size_t)(u.row0 + r) * ldc + u.col0 + c) = v; EPI_END EPI_END } };
struct EpiResid { const float* base; float* out; int ldc, pad;
    __device__ __forceinline__ void operator()(const f32x4 (&acc)[2][2][4][2], const GUnit& u, int wr, int wc, int fr, int fq) const {
        EPI_ROWS(r) EPI_COLS(c) const size_t o = (size_t)(u.row0 + r) * ldc + u.col0 + c; *(f32x4*)(out + o) = *(const f32x4*)(base + o) + v; EPI_END EPI_END } };
struct EpiGU { const float* bgu; bf16_t* act;
    __device__ __forceinline__ void operator()(const f32x4 (&acc)[2][2][4][2], const GUnit& u, int wr, int wc, int fr, int fq) const {
        const int pn = u.col0 >> 8; const float* bg = bgu + (size_t)u.e * 2048;
        for (int ai = 0; ai < 2; ++ai) for (int m = 0; m < 4; ++m) { const int r = 128 * ai + 64 * wr + 16 * m + fr; if (r >= u.valid) continue;
            for (int n = 0; n < 2; ++n) { const int c = 32 * wc + 16 * n + 4 * fq; const int col = 128 * pn + c;
                const f32x4 g = acc[ai][0][m][n] + *(const f32x4*)(bg + col), l = acc[ai][1][m][n] + *(const f32x4*)(bg + 1024 + col); float o[4];
#pragma unroll
                for (int j = 0; j < 4; ++j) { const float gg = fminf(g[j], 7.0f), ll = fminf(fmaxf(l[j], -7.0f), 7.0f); o[j] = (ll + 1.0f) * (gg / (1.0f + __expf(-1.702f * gg))); }
                u32x2 w; w.x = pk2(o[0], o[1]); w.y = pk2(o[2], o[3]); *(u32x2*)(act + (size_t)(u.row0 + r) * 1024 + col) = w; } } } };
struct EpiDown { const float* bdn; bf16_t* ys;
    __device__ __forceinline__ void operator()(const f32x4 (&acc)[2][2][4][2], const GUnit& u, int wr, int wc, int fr, int fq) const {
        const float* bd = bdn + (size_t)u.e * 1024;
        for (int ai = 0; ai < 2; ++ai) for (int m = 0; m < 4; ++m) { const int r = 128 * ai + 64 * wr + 16 * m + fr; if (r >= u.valid) continue;
            EPI_COLS(c) const int col = u.col0 + c; const f32x4 y = v + *(const f32x4*)(bd + col); u32x2 w; w.x = pk2(y[0], y[1]); w.y = pk2(y[2], y[3]); *(u32x2*)(ys + (size_t)(u.row0 + r) * 1024 + col) = w; EPI_END } } };

template <class Sched, class Epi>
__global__ void __launch_bounds__(512) k_gemm(Sched S, Epi E) {
    __shared__ __attribute__((aligned(16))) unsigned char lds[32768];
    S.G = gridDim.x; S.c = blockIdx.x;
    sgemm_body(lds, S, E);
}

__global__ void __launch_bounds__(256) k_alpha(const bf16_t* __restrict__ proj, const float* __restrict__ wg, const float* __restrict__ bg, float* __restrict__ alpha) {
    const int idx = blockIdx.x * blockDim.x + threadIdx.x; if (idx >= NTOK * 256) return;
    const int t = idx >> 8, j = idx & 255; float u = bg[j];
    for (int i = 0; i < 16; ++i) u += bf2f(proj[(size_t)t * PROJ_LD + C_GLR + i]) * wg[i * 256 + j];
    const float ls = fminf(u, 0.f) - log1pf(__expf(-fabsf(u)));
    alpha[idx] = __expf(ls * (1.0f / 16.0f));
}
__global__ void __launch_bounds__(128) k_gla_naive(const bf16_t* __restrict__ proj, const float* __restrict__ alpha, float* __restrict__ oraw) {
    const int b = blockIdx.x >> 2, h = blockIdx.x & 3, dv = threadIdx.x;
    float S[64];
#pragma unroll
    for (int i = 0; i < 64; ++i) S[i] = 0.f;
    for (int c = 0; c < SEQ / 64; ++c) {
        for (int s = 0; s < 64; ++s) { const size_t t = (size_t)b * SEQ + c * 64 + s; const bf16_t* pr = proj + t * PROJ_LD;
            const float vv = bf2f(pr[C_VG + h * 128 + dv]); const float* al = alpha + t * 256 + h * 64;
#pragma unroll
            for (int i = 0; i < 64; ++i) S[i] = al[i] * S[i] + bf2f(pr[C_KG + h * 64 + i]) * vv; }
        for (int s = 0; s < 64; ++s) { const size_t t = (size_t)b * SEQ + c * 64 + s; const bf16_t* pr = proj + t * PROJ_LD; float o = 0.f;
#pragma unroll
            for (int i = 0; i < 64; ++i) o += bf2f(pr[C_QG + h * 64 + i]) * S[i];
            oraw[t * 512 + h * 128 + dv] = o; }
    }
}
__global__ void __launch_bounds__(256) k_gla_norm(const float* __restrict__ oraw, const bf16_t* __restrict__ proj, const float* __restrict__ ghead, bf16_t* __restrict__ mix) {
    const int idx = blockIdx.x * blockDim.x + threadIdx.x; if (idx >= NTOK * 4) return;
    const int t = idx >> 2, h = idx & 3; const float* o = oraw + (size_t)t * 512 + h * 128; float s = 0.f;
    for (int i = 0; i < 128; ++i) s += o[i] * o[i];
    const float rstd = 1.0f / sqrtf(s * (1.f / 128.f) + EPS);
    for (int i = 0; i < 128; ++i) { const float rg = bf2f(proj[(size_t)t * PROJ_LD + C_RG + h * 128 + i]); const float y = o[i] * rstd * ghead[i] * (rg / (1.0f + __expf(-rg)));
        mix[(size_t)t * 1024 + h * 128 + i] = (bf16_t)f2bf(y); }
}
__global__ void __launch_bounds__(256) k_sb_naive(const bf16_t* __restrict__ proj, bf16_t* __restrict__ mix) {
    const int idx = blockIdx.x * blockDim.x + threadIdx.x; if (idx >= NTOK * 8) return;
    const int tt = idx % SEQ, bh = idx / SEQ, b = bh >> 3, h = bh & 7; const size_t t = (size_t)b * SEQ + tt;
    float q[64], o[64];
#pragma unroll
    for (int d = 0; d < 64; ++d) { q[d] = bf2f(proj[t * PROJ_LD + C_QS + h * 64 + d]); o[d] = 0.f; }
    float D = 1.0f;
    for (int s = tt - 1; s >= 0; --s) { const bf16_t* pr = proj + ((size_t)b * SEQ + s) * PROJ_LD; float z = 0.f;
#pragma unroll
        for (int d = 0; d < 64; ++d) z += q[d] * bf2f(pr[C_KS + h * 64 + d]);
        const float e = exp2f(fminf(z, 126.0f)); D = D + D * e; const float A = e * (1.0f / D);
#pragma unroll
        for (int d = 0; d < 64; ++d) o[d] += A * bf2f(pr[C_VS + h * 64 + d]);
        if (!(D < 3.0e38f)) break; }
#pragma unroll
    for (int d = 0; d < 64; ++d) mix[t * 1024 + 512 + h * 64 + d] = (bf16_t)f2bf(o[d]);
}

typedef float f32x16 __attribute__((ext_vector_type(16)));
typedef short s16x4 __attribute__((ext_vector_type(4)));
#define LDSP __attribute__((address_space(3)))
#define LAUNDER(x) asm volatile("" : "+v"(x))
__device__ __forceinline__ int crow(int r, int hi) { return (r & 3) + 8 * (r >> 2) + 4 * hi; }
__device__ __forceinline__ s16x4 tr_read(const unsigned char* p) { return __builtin_bit_cast(s16x4, __builtin_amdgcn_ds_read_tr16_b64_v4i16((LDSP s16x4*)(unsigned)(uintptr_t)p)); }
__device__ __forceinline__ bf16x8 tr_frag(const unsigned char* img, int pitch, int k0, int f0, int lane) {
    const unsigned char* p = img + (k0 + 8 * (lane >> 5) + ((lane & 15) >> 2)) * pitch + (f0 + 16 * ((lane >> 4) & 1) + 4 * (lane & 3)) * 2;
    const s16x4 lo = tr_read(p), hi = tr_read(p + 4 * pitch);
    return (bf16x8){lo[0], lo[1], lo[2], lo[3], hi[0], hi[1], hi[2], hi[3]};
}
constexpr int GA_PK = 576, GA_PV = 1088;
constexpr int GA_V = 0, GA_PART = 0, GA_GLR = 69632, GA_TOT = 73728, GA_KD = 75776, GA_END = GA_KD + 64 * GA_PK;
__device__ __forceinline__ void gla_pass_a(unsigned char* lds, int task, const bf16_t* __restrict__ xn, const bf16_t* __restrict__ wglr  , const bf16_t* __restrict__ proj,
                                           const float* __restrict__ wg, const float* __restrict__ bg, float* __restrict__ UT, float* __restrict__ decay) {
    int tid = threadIdx.x; LAUNDER(tid); int wid = tid >> 6, lane = tid & 63, fr = lane & 15, fq = lane >> 4;
    const size_t t0 = (size_t)task * 64;
    { f32x4 acc[4];
#pragma unroll
      for (int m = 0; m < 4; ++m) acc[m] = (f32x4){0.f, 0.f, 0.f, 0.f};
#pragma unroll
      for (int ks = 0; ks < 4; ++ks) { const int k = 128 * wid + 32 * ks + 8 * fq; const bf16x8 bfr = *(const bf16x8*)(wglr + (size_t)fr * 1024 + k);
#pragma unroll
          for (int m = 0; m < 4; ++m) { const bf16x8 afr = *(const bf16x8*)(xn + (t0 + 16 * m + fr) * DM + k); acc[m] = __builtin_amdgcn_mfma_f32_16x16x32_bf16(afr, bfr, acc[m], 0, 0, 0); } }
      float* part = (float*)(lds + GA_PART) + wid * 1024;
#pragma unroll
      for (int m = 0; m < 4; ++m)
#pragma unroll
          for (int j = 0; j < 4; ++j) part[(16 * m + 4 * fq + j) * 16 + fr] = acc[m][j]; }
    __syncthreads();
    { float* glr = (float*)(lds + GA_GLR); const float* part = (const float*)(lds + GA_PART);
      for (int i = tid; i < 1024; i += 512) { float s = 0.f;
#pragma unroll
          for (int w = 0; w < 8; ++w) s += part[w * 1024 + i];
          glr[i] = s; } }
    __syncthreads();
    LAUNDER(tid);
    { const int cv = tid & 63, tk = tid >> 6;
#pragma unroll
      for (int i = 0; i < 8; ++i) { const int tok = tk + 8 * i; const u32x4 v = *(const u32x4*)(proj + (t0 + tok) * PROJ_LD + C_VG + cv * 8); *(u32x4*)(lds + GA_V + tok * GA_PV + cv * 16) = v; } }
    LAUNDER(tid);
    { const int j = tid & 255, half = tid >> 8; const float* glr = (const float*)(lds + GA_GLR); float* tot = (float*)(lds + GA_TOT);
      float w[16];
#pragma unroll
      for (int i = 0; i < 16; ++i) w[i] = wg[i * 256 + j];
      const float bj = bg[j]; float run = 0.f;
#pragma unroll 2
      for (int s = 0; s < 32; ++s) { const float* gl = glr + (32 * half + s) * 16; float u = bj;
#pragma unroll
          for (int i = 0; i < 16; ++i) u += gl[i] * w[i];
          const float ls = fminf(u, 0.f) - __logf(1.0f + __expf(-fabsf(u)));
          run += ls * (1.0f / 16.0f); }
      tot[half * 256 + j] = run;
      __syncthreads();
      const float t0v = tot[j], t1v = tot[256 + j]; const float gend = t0v + t1v;
      if (half == 0) decay[(size_t)task * 256 + j] = __expf(gend);
      run = half ? t0v : 0.f;
#pragma unroll 2
      for (int s = 0; s < 32; ++s) { const int tok = 32 * half + s; const float* gl = glr + tok * 16; float u = bj;
#pragma unroll
          for (int i = 0; i < 16; ++i) u += gl[i] * w[i];
          const float ls = fminf(u, 0.f) - __logf(1.0f + __expf(-fabsf(u)));
          run += ls * (1.0f / 16.0f);
          const float kk = bf2f(proj[(t0 + tok) * PROJ_LD + C_KG + j]);
          *(bf16_t*)(lds + GA_KD + tok * GA_PK + j * 2) = (bf16_t)f2bf(kk * __expf(gend - run)); } }
    __syncthreads();
    LAUNDER(tid); wid = __builtin_amdgcn_readfirstlane(tid >> 6); lane = tid & 63;
    { const int h = wid >> 1, nt = wid & 1, hi = lane >> 5, c32 = lane & 31; f32x16 acc[4];
#pragma unroll
      for (int m = 0; m < 4; ++m)
#pragma unroll
          for (int r = 0; r < 16; ++r) acc[m][r] = 0.f;
#pragma unroll
      for (int ks = 0; ks < 4; ++ks) { const bf16x8 bfr = tr_frag(lds + GA_KD, GA_PK, 16 * ks, h * 64 + 32 * nt, lane);
#pragma unroll
          for (int m = 0; m < 4; ++m) { const bf16x8 afr = tr_frag(lds + GA_V, GA_PV, 16 * ks, h * 128 + 32 * m, lane); acc[m] = __builtin_amdgcn_mfma_f32_32x32x16_bf16(afr, bfr, acc[m], 0, 0, 0); } }
      float* u = UT + ((size_t)task * 4 + h) * 8192;
#pragma unroll
      for (int m = 0; m < 4; ++m)
#pragma unroll
          for (int r = 0; r < 16; ++r) u[(32 * m + crow(r, hi)) * 64 + 32 * nt + c32] = acc[m][r]; }
    __syncthreads();
}
__device__ __forceinline__ void gla_pass_b(int e, const float* __restrict__ UT, const float* __restrict__ decay, bf16_t* __restrict__ ST) {
    const int dk = e & 63, dv = (e >> 6) & 127, h = (e >> 13) & 3, b = e >> 15; float s = 0.f;
    const size_t base = ((size_t)b * 128 * 4 + h) * 8192 + dv * 64 + dk; const size_t dbase = (size_t)b * 128 * 256 + h * 64 + dk;
#pragma unroll 8
    for (int c = 0; c < 128; ++c) { const float u = UT[base + (size_t)c * 4 * 8192], d = decay[dbase + (size_t)c * 256]; s = d * s + u; ST[base + (size_t)c * 4 * 8192] = (bf16_t)f2bf(s); }
}
constexpr int GC_PITCH = 520;
__device__ __forceinline__ void gla_pass_c(unsigned char* wlds  , int wtask, const bf16_t* __restrict__ ST, const bf16_t* __restrict__ proj, const float* __restrict__ ghead, bf16_t* __restrict__ mix, int lane) {
    const int nh = wtask & 1, h = (wtask >> 1) & 3, bc = wtask >> 3; const int c32 = lane & 31, hi = lane >> 5;
    const size_t t0 = (size_t)bc * 64 + 32 * nh; const bf16_t* st = ST + ((size_t)bc * 4 + h) * 8192;
    f32x16 acc[4];
#pragma unroll
    for (int m = 0; m < 4; ++m)
#pragma unroll
        for (int r = 0; r < 16; ++r) acc[m][r] = 0.f;
#pragma unroll
    for (int ks = 0; ks < 4; ++ks) { const bf16x8 bfr = *(const bf16x8*)(proj + (t0 + c32) * PROJ_LD + C_QG + h * 64 + 16 * ks + 8 * hi);
#pragma unroll
        for (int m = 0; m < 4; ++m) { const bf16x8 afr = *(const bf16x8*)(st + (32 * m + c32) * 64 + 16 * ks + 8 * hi); acc[m] = __builtin_amdgcn_mfma_f32_32x32x16_bf16(afr, bfr, acc[m], 0, 0, 0); } }
    float ss = 0.f;
#pragma unroll
    for (int m = 0; m < 4; ++m)
#pragma unroll
        for (int r = 0; r < 16; ++r) ss += acc[m][r] * acc[m][r];
    ss += __shfl_xor(ss, 32);
    const float rstd = 1.0f / sqrtf(ss * (1.0f / 128.0f) + EPS);
#pragma unroll
    for (int m = 0; m < 4; ++m)
#pragma unroll
        for (int r = 0; r < 16; ++r) *(float*)(wlds + c32 * GC_PITCH + (32 * m + crow(r, hi)) * 4) = acc[m][r] * rstd;
#pragma unroll
    for (int i = 0; i < 8; ++i) { const int q = lane + 64 * i, tok = q >> 4, dv0 = (q & 15) * 8; const float* src = (const float*)(wlds + tok * GC_PITCH + dv0 * 4);
        const u32x4 rgw = *(const u32x4*)(proj + (t0 + tok) * PROJ_LD + C_RG + h * 128 + dv0); const f32x4 g0 = *(const f32x4*)(ghead + dv0), g1 = *(const f32x4*)(ghead + dv0 + 4);
        const float rg[8] = {bflo(rgw.x), bfhi(rgw.x), bflo(rgw.y), bfhi(rgw.y), bflo(rgw.z), bfhi(rgw.z), bflo(rgw.w), bfhi(rgw.w)}; const float gg[8] = {g0.x, g0.y, g0.z, g0.w, g1.x, g1.y, g1.z, g1.w}; float y[8];
#pragma unroll
        for (int k = 0; k < 8; ++k) y[k] = src[k] * gg[k] * (rg[k] / (1.0f + __expf(-rg[k])));
        u32x4 o; o.x = pk2(y[0], y[1]); o.y = pk2(y[2], y[3]); o.z = pk2(y[4], y[5]); o.w = pk2(y[6], y[7]);
        *(u32x4*)(mix + (t0 + tok) * 1024 + h * 128 + dv0) = o; }
}
__device__ __forceinline__ void sb_task(unsigned char* vl  , int wtask, const bf16_t* __restrict__ proj, bf16_t* __restrict__ mix, int lane) {
    const int qt = wtask & 255, h = (wtask >> 8) & 7, b = wtask >> 11; const int c = lane & 31, hi = lane >> 5;
    const int t0 = qt * 32; const size_t rowb = (size_t)b * SEQ;
    bf16x8 qf[4];
#pragma unroll
    for (int d0 = 0; d0 < 4; ++d0) qf[d0] = *(const bf16x8*)(proj + (rowb + t0 + c) * PROJ_LD + C_QS + h * 64 + 16 * d0 + 8 * hi);
    const int kap = 16 * ((c >> 2) & 1) + (c & 3) + 4 * (c >> 3);
    f32x16 o0, o1;
#pragma unroll
    for (int r = 0; r < 16; ++r) { o0[r] = 0.f; o1[r] = 0.f; }
    float Dc = 1.0f;
    for (int j0 = t0; j0 >= 0; j0 -= 32) {
        const bf16_t* kp = proj + (rowb + j0 + kap) * PROJ_LD + C_KS + h * 64 + 8 * hi;
        bf16x8 kf[4];
#pragma unroll
        for (int d0 = 0; d0 < 4; ++d0) kf[d0] = *(const bf16x8*)(kp + 16 * d0);
#pragma unroll
        for (int i = 0; i < 4; ++i) { const int idx = lane + 64 * i, key = idx >> 3, ch = idx & 7; const u32x4 v = *(const u32x4*)(proj + (rowb + j0 + key) * PROJ_LD + C_VS + h * 64 + ch * 8);
            *(u32x4*)(vl + (ch >> 2) * 2048 + key * 64 + (ch & 3) * 16) = v; }
        f32x16 z;
#pragma unroll
        for (int r = 0; r < 16; ++r) z[r] = 0.f;
#pragma unroll
        for (int d0 = 0; d0 < 4; ++d0) z = __builtin_amdgcn_mfma_f32_32x32x16_bf16(kf[d0], qf[d0], z, 0, 0, 0);
        float e[16], Dl[16];
        const bool diag = (j0 == t0);
#pragma unroll
        for (int r = 0; r < 16; ++r) { float ev = __builtin_amdgcn_exp2f(fminf(z[r], 126.0f)); if (diag && (16 * hi + r >= c)) ev = 0.f; e[r] = ev; }
        float D = hi ? Dc : 1.0f;
#pragma unroll
        for (int r = 15; r >= 0; --r) { D = fmaf(D, e[r], D); Dl[r] = D; }
        const float other = __shfl_xor(D, 32);
        const float mult = hi ? 1.0f : other;
        Dc = D * other;
        unsigned pw[8];
#pragma unroll
        for (int r = 0; r < 16; r += 2) { const float a0 = e[r] * __builtin_amdgcn_rcpf(Dl[r] * mult), a1 = e[r + 1] * __builtin_amdgcn_rcpf(Dl[r + 1] * mult); pw[r >> 1] = pk2(a0, a1); }
#pragma unroll
        for (int ks = 0; ks < 2; ++ks) { const bf16x8 pa = __builtin_bit_cast(bf16x8, (u32x4){pw[4 * ks], pw[4 * ks + 1], pw[4 * ks + 2], pw[4 * ks + 3]});
            const unsigned char* vb = vl + (16 * hi + 8 * ks + ((lane & 15) >> 2)) * 64 + (16 * ((lane >> 4) & 1) + 4 * (lane & 3)) * 2;
            { const s16x4 lo = tr_read(vb), hh = tr_read(vb + 256); o0 = __builtin_amdgcn_mfma_f32_32x32x16_bf16(pa, (bf16x8){lo[0], lo[1], lo[2], lo[3], hh[0], hh[1], hh[2], hh[3]}, o0, 0, 0, 0); }
            { const s16x4 lo = tr_read(vb + 2048), hh = tr_read(vb + 2048 + 256); o1 = __builtin_amdgcn_mfma_f32_32x32x16_bf16(pa, (bf16x8){lo[0], lo[1], lo[2], lo[3], hh[0], hh[1], hh[2], hh[3]}, o1, 0, 0, 0); } }
        if (__all(!(Dc < 3.0e38f))) break;
    }
    bf16_t* ob = mix + (rowb + t0) * 1024 + 512 + h * 64 + c;
#pragma unroll
    for (int r = 0; r < 16; ++r) { const int q = crow(r, hi); ob[(size_t)q * 1024] = (bf16_t)f2bf(o0[r]); ob[(size_t)q * 1024 + 32] = (bf16_t)f2bf(o1[r]); }
}
__global__ void __launch_bounds__(512) k_gla_a(const bf16_t* xn, const bf16_t* wglr, const bf16_t* proj, const float* wg, const float* bg, float* UT, float* decay) {
    extern __shared__ __attribute__((aligned(16))) unsigned char dl[];
    for (int t = blockIdx.x; t < 256; t += gridDim.x) gla_pass_a(dl, t, xn, wglr, proj, wg, bg, UT, decay);
}
__global__ void __launch_bounds__(512) k_gla_b(const float* UT, const float* decay, bf16_t* ST) {
    const int e = blockIdx.x * 512 + threadIdx.x; if (e < 65536) gla_pass_b(e, UT, decay, ST);
}
__global__ void __launch_bounds__(512) k_gla_c(const bf16_t* ST, const bf16_t* proj, const float* ghead, bf16_t* mix) {
    extern __shared__ __attribute__((aligned(16))) unsigned char dl[];
    const int wid = threadIdx.x >> 6, lane = threadIdx.x & 63;
    for (int t = blockIdx.x * 8 + wid; t < 2048; t += gridDim.x * 8) gla_pass_c(dl + wid * 32 * GC_PITCH, t, ST, proj, ghead, mix, lane);
}
__global__ void __launch_bounds__(512) k_sb(const bf16_t* proj, bf16_t* mix) {
    extern __shared__ __attribute__((aligned(16))) unsigned char dl[];
    const int wid = threadIdx.x >> 6, lane = threadIdx.x & 63;
    for (int t = blockIdx.x * 8 + wid; t < 4096; t += gridDim.x * 8) sb_task(dl + wid * 4096, t, proj, mix, lane);
}
__global__ void __launch_bounds__(256) k_softmax(const float* __restrict__ S, bf16_t* __restrict__ P) {
    const int lane = threadIdx.x & 63; const int gw = (blockIdx.x * blockDim.x + threadIdx.x) >> 6;
    if (gw >= NTOK * 4) return;
    const f32x4 v = *((const f32x4*)(S + (size_t)gw * 256) + lane);
    float m = fmaxf(fmaxf(v.x, v.y), fmaxf(v.z, v.w));
#pragma unroll
    for (int o = 1; o < 64; o <<= 1) m = fmaxf(m, __shfl_xor(m, o));
    const float e0 = exp2f(v.x - m), e1 = exp2f(v.y - m), e2 = exp2f(v.z - m), e3 = exp2f(v.w - m);
    const float inv = 1.0f / wave_sum(e0 + e1 + e2 + e3);
    u32x2 w; w.x = pk2(e0 * inv, e1 * inv); w.y = pk2(e2 * inv, e3 * inv); *((u32x2*)(P + (size_t)gw * 256) + lane) = w;
}
__global__ void __launch_bounds__(256) k_router_logits(const bf16_t* __restrict__ xn, const bf16_t* __restrict__ wr, const float* __restrict__ br, float* __restrict__ lg) {
    const int idx = blockIdx.x * blockDim.x + threadIdx.x; if (idx >= NTOK * NEXP) return;
    const int t = idx >> 5, e = idx & 31; const u32x4* a = (const u32x4*)(xn + (size_t)t * DM); const u32x4* w = (const u32x4*)(wr + (size_t)e * DM); float s = 0.f;
    for (int i = 0; i < DM / 8; ++i) { const u32x4 x = a[i], y = w[i];
        s += bflo(x.x) * bflo(y.x) + bfhi(x.x) * bfhi(y.x) + bflo(x.y) * bflo(y.y) + bfhi(x.y) * bfhi(y.y) + bflo(x.z) * bflo(y.z) + bfhi(x.z) * bfhi(y.z) + bflo(x.w) * bflo(y.w) + bfhi(x.w) * bfhi(y.w); }
    lg[idx] = s + br[e];
}
__global__ void __launch_bounds__(256) k_router_topk(const float* __restrict__ lg, int* __restrict__ cnt, int* __restrict__ list, int* __restrict__ toke, int* __restrict__ tokr, float* __restrict__ tokw) {
    const int t = blockIdx.x * blockDim.x + threadIdx.x; if (t >= NTOK) return;
    float v[NEXP];
#pragma unroll
    for (int e = 0; e < NEXP; ++e) v[e] = lg[(size_t)t * NEXP + e];
    float tv[4]; int ti[4];
#pragma unroll
    for (int k = 0; k < 4; ++k) { float best = -INFINITY; int bi = 0;
#pragma unroll
        for (int e = 0; e < NEXP; ++e) { if (v[e] > best) { best = v[e]; bi = e; } }
        tv[k] = best; ti[k] = bi;
#pragma unroll
        for (int e = 0; e < NEXP; ++e) if (e == bi) v[e] = -INFINITY; }
    const float e1 = __expf(tv[1] - tv[0]), e2 = __expf(tv[2] - tv[0]), e3 = __expf(tv[3] - tv[0]); const float inv = 1.0f / (1.0f + e1 + e2 + e3);
    const float g[4] = {inv, e1 * inv, e2 * inv, e3 * inv};
#pragma unroll
    for (int k = 0; k < 4; ++k) { const int r = atomicAdd(&cnt[ti[k]], 1); list[ti[k] * NTOK + r] = t; toke[t * 4 + k] = ti[k]; tokr[t * 4 + k] = r; tokw[t * 4 + k] = g[k]; }
}
__global__ void __launch_bounds__(256) k_combine(float* __restrict__ xio, const bf16_t* __restrict__ ys, const int* __restrict__ cnt, const int* __restrict__ toke, const int* __restrict__ tokr,
                                                 const float* __restrict__ tokw, const float* __restrict__ gfin) {
    const int lane = threadIdx.x & 63; const int t = (blockIdx.x * blockDim.x + threadIdx.x) >> 6; if (t >= NTOK) return;
    f32x4* xr = (f32x4*)(xio + (size_t)t * DM) + lane; f32x4 v[4];
#pragma unroll
    for (int j = 0; j < 4; ++j) v[j] = xr[64 * j];
    for (int k = 0; k < 4; ++k) { const int e = toke[t * 4 + k], r = tokr[t * 4 + k]; const float w = tokw[t * 4 + k]; int start = 0; for (int i = 0; i < e; ++i) start += cnt[i];
        const u32x2* yr = (const u32x2*)(ys + (size_t)(start + r) * DM) + lane;
#pragma unroll
        for (int j = 0; j < 4; ++j) { const u32x2 y = yr[64 * j]; v[j].x += w * bflo(y.x); v[j].y += w * bfhi(y.x); v[j].z += w * bflo(y.y); v[j].w += w * bfhi(y.y); } }
    float s = 0.f;
#pragma unroll
    for (int j = 0; j < 4; ++j) s += v[j].x * v[j].x + v[j].y * v[j].y + v[j].z * v[j].z + v[j].w * v[j].w;
    const float rstd = 1.0f / sqrtf(wave_sum(s) * (1.f / DM) + EPS);
#pragma unroll
    for (int j = 0; j < 4; ++j) { const f32x4 g = *((const f32x4*)gfin + lane + 64 * j); xr[64 * j] = v[j] * rstd * g; }
}

extern "C" void kernel_launch(void* const* d_in, const int* in_sizes, int n_in, void* d_out, int out_size, void* d_ws, size_t ws_size, hipStream_t stream) {
    if (n_in != 22 || in_sizes[0] != NTOK * DM || out_size != NTOK * DM || ws_size < WS_END) { fprintf(stderr, "kernel_launch: unexpected shapes (n_in %d, ws %zu)\n", n_in, ws_size); return; }
    const float* x = (const float*)d_in[0]; const float* mem = (const float*)d_in[1]; const float* g_mix = (const float*)d_in[2]; const float* w_in = (const float*)d_in[3];
    const float* w_gla_gate = (const float*)d_in[4]; const float* b_gla_gate = (const float*)d_in[5]; const float* g_gla_head = (const float*)d_in[6]; const float* w_out = (const float*)d_in[7];
    const float* g_mem_q = (const float*)d_in[8]; const float* g_mem_kv = (const float*)d_in[9]; const float* w_mq = (const float*)d_in[10]; const float* w_mk = (const float*)d_in[11];
    const float* w_mv = (const float*)d_in[12]; const float* w_mo = (const float*)d_in[13]; const float* g_ffn = (const float*)d_in[14]; const float* w_router = (const float*)d_in[15];
    const float* b_router = (const float*)d_in[16]; const float* w_gu = (const float*)d_in[17]; const float* b_gu = (const float*)d_in[18]; const float* w_down = (const float*)d_in[19];
    const float* b_down = (const float*)d_in[20]; const float* g_final = (const float*)d_in[21];
    unsigned char* ws = (unsigned char*)d_ws; float* out = (float*)d_out;
    bf16_t* Wt_in = (bf16_t*)(ws + WS_WIN); bf16_t* Wt_out = (bf16_t*)(ws + WS_WOUT); bf16_t* Wq = (bf16_t*)(ws + WS_WQ); bf16_t* Wt_kv = (bf16_t*)(ws + WS_WKV);
    bf16_t* Wt_mo = (bf16_t*)(ws + WS_WMO); bf16_t* Wt_r = (bf16_t*)(ws + WS_WR); bf16_t* Wt_gu = (bf16_t*)(ws + WS_WGU); bf16_t* Wt_dn = (bf16_t*)(ws + WS_WDN);
    bf16_t* xn = (bf16_t*)(ws + WS_XN); bf16_t* memn = (bf16_t*)(ws + WS_MEMN); bf16_t* kv = (bf16_t*)(ws + WS_KV); bf16_t* Bs = (bf16_t*)(ws + WS_BS); bf16_t* Bo = (bf16_t*)(ws + WS_BO);
    bf16_t* proj = (bf16_t*)(ws + WS_PROJ); float* alpha = (float*)(ws + WS_LA); float* oraw = (float*)(ws + WS_ORAW); bf16_t* mix = (bf16_t*)(ws + WS_MIX);
    float* Sc = (float*)(ws + WS_S); bf16_t* P = (bf16_t*)(ws + WS_P); float* lg = (float*)(ws + WS_LG); int* toke = (int*)(ws + WS_TOKE); int* tokr = (int*)(ws + WS_TOKR);
    float* tokw = (float*)(ws + WS_TOKW); int* list = (int*)(ws + WS_LIST); bf16_t* act = (bf16_t*)(ws + WS_ACT); bf16_t* ys = (bf16_t*)(ws + WS_YS);
    int* cnt = (int*)(ws + WS_CTL) + CW_CNT;

    (void)hipMemsetAsync(ws + WS_CTL, 0, 1 * MiB, stream);
    k_conv_t<1><<<2048, 256, 0, stream>>>(w_in, Wt_in, g_mix, 3088, 1024, 3328, 1, 0, 0);
    k_conv_t<0><<<1024, 256, 0, stream>>>(w_out, Wt_out, nullptr, 1024, 1024, 1024, 1, 0, 0);
    k_conv_n<<<1024, 256, 0, stream>>>(w_mq, Wq, g_mem_q, 1024, 1024, LOG2E / 16.0f);
    k_conv_t<0><<<1024, 256, 0, stream>>>(w_mk, Wt_kv, g_mem_kv, 1024, 1024, 1024, 1, 0, 0);
    k_conv_t<0><<<1024, 256, 0, stream>>>(w_mv, Wt_kv + (size_t)1024 * 1024, g_mem_kv, 1024, 1024, 1024, 1, 0, 0);
    k_conv_t<0><<<1024, 256, 0, stream>>>(w_mo, Wt_mo, nullptr, 1024, 1024, 1024, 1, 0, 0);
    k_conv_t<0><<<64, 256, 0, stream>>>(w_router, Wt_r, g_ffn, 32, 1024, 32, 1, 0, 0);
    k_conv_t<2><<<8192, 256, 0, stream>>>(w_gu, Wt_gu, g_ffn, 2048, 1024, 2048, 32, (size_t)1024 * 2048, (size_t)2048 * 1024);
    k_conv_t<0><<<8192, 256, 0, stream>>>(w_down, Wt_dn, nullptr, 1024, 1024, 1024, 32, (size_t)1024 * 1024, (size_t)1024 * 1024);
    k_rms<<<2048, 256, 0, stream>>>(x, xn, NTOK);
    k_rms<<<128, 256, 0, stream>>>(mem, memn, NB * MEML);
    { DenseSched S{(const char*)xn, (const char*)Wt_in, 2048u, 2048u, 1024, 64, 13, 1 << 30, 0, 0, 0}; EpiBf16 E{proj, PROJ_LD, 0}; k_gemm<<<832, 512, 0, stream>>>(S, E); }
    { DenseSched S{(const char*)memn, (const char*)Wt_kv, 2048u, 2048u, 1024, 2, 8, 1 << 30, 0, 0, 0}; EpiBf16 E{kv, 2048, 0}; k_gemm<<<16, 512, 0, stream>>>(S, E); }
    { SchedWqk S{(const char*)kv, (const char*)Wq, 4096u, 2048u, 256, 0, 0, 0}; EpiBf16 E{Bs, 1024, 0}; k_gemm<<<32, 512, 0, stream>>>(S, E); }
    { SchedVo S{(const char*)Wt_mo, (const char*)kv, 2048u, 4096u, 256, 0, 0, 0}; EpiBf16 E{Bo, 1024, 0}; k_gemm<<<32, 512, 0, stream>>>(S, E); }
#if USE_NAIVE_GLA
    k_alpha<<<NTOK, 256, 0, stream>>>(proj, w_gla_gate, b_gla_gate, alpha);
    k_gla_naive<<<8, 128, 0, stream>>>(proj, alpha, oraw);
    k_gla_norm<<<NTOK * 4 / 256, 256, 0, stream>>>(oraw, proj, g_gla_head, mix);
#else
    { float* UT = (float*)(ws + WS_S); float* decay = (float*)(ws + WS_LA); bf16_t* ST = (bf16_t*)(ws + WS_ORAW);
      static bool attr = false; if (!attr) { (void)hipFuncSetAttribute((const void*)k_gla_a, hipFuncAttributeMaxDynamicSharedMemorySize, GA_END); (void)hipFuncSetAttribute((const void*)k_gla_c, hipFuncAttributeMaxDynamicSharedMemorySize, 8 * 32 * GC_PITCH); attr = true; }
      k_gla_a<<<256, 512, GA_END, stream>>>(xn, Wt_in + (size_t)3072 * 1024, proj, w_gla_gate, b_gla_gate, UT, decay);
      k_gla_b<<<128, 512, 0, stream>>>(UT, decay, ST);
      k_gla_c<<<256, 512, 8 * 32 * GC_PITCH, stream>>>(ST, proj, g_gla_head, mix); }
#endif
#if USE_NAIVE_SB
    k_sb_naive<<<NTOK * 8 / 256, 256, 0, stream>>>(proj, mix);
#else
    k_sb<<<512, 512, 8 * 4096, stream>>>(proj, mix);
#endif
    { DenseSched S{(const char*)mix, (const char*)Wt_out, 2048u, 2048u, 1024, 64, 4, 1 << 30, 0, 0, 0}; EpiResid E{x, out, 1024, 0}; k_gemm<<<256, 512, 0, stream>>>(S, E); }
    k_rms<<<2048, 256, 0, stream>>>(out, xn, NTOK);
    { DenseSched S{(const char*)xn, (const char*)Bs, 2048u, 2048u, 1024, 64, 4, 32, (size_t)1024 * 2048, 0, 0}; EpiF32 E{Sc, 1024, 0}; k_gemm<<<256, 512, 0, stream>>>(S, E); }
    k_softmax<<<NTOK * 4 / 4, 256, 0, stream>>>(Sc, P);
    { DenseSched S{(const char*)P, (const char*)Bo, 2048u, 2048u, 1024, 64, 4, 32, (size_t)1024 * 2048, 0, 0}; EpiResid E{out, out, 1024, 0}; k_gemm<<<256, 512, 0, stream>>>(S, E); }
    k_rms<<<2048, 256, 0, stream>>>(out, xn, NTOK);
    k_router_logits<<<NTOK * NEXP / 256, 256, 0, stream>>>(xn, Wt_r, b_router, lg);
    k_router_topk<<<NTOK / 256, 256, 0, stream>>>(lg, cnt, list, toke, tokr, tokw);
    { MoeSched S{(const char*)xn, (const char*)Wt_gu, 2048u, 2048u, 1024, 8, (size_t)2048 * 2048, cnt, list, 1, 0, 0, 0}; EpiGU E{b_gu, act}; k_gemm<<<288 * 8, 512, 0, stream>>>(S, E); }
    { MoeSched S{(const char*)act, (const char*)Wt_dn, 2048u, 2048u, 1024, 4, (size_t)1024 * 2048, cnt, list, 0, 0, 0, 0}; EpiDown E{b_down, ys}; k_gemm<<<288 * 4, 512, 0, stream>>>(S, E); }
    k_combine<<<NTOK / 4, 256, 0, stream>>>(out, ys, cnt, toke, tokr, tokw, g_final);
}
```

```cpp
#include <hip/hip_runtime.h>
#include <cstdio>
#include <cstdint>

typedef unsigned short bf16_t;
typedef short bf16x8 __attribute__((ext_vector_type(8)));
typedef float f32x4 __attribute__((ext_vector_type(4)));
typedef unsigned u32x4 __attribute__((ext_vector_type(4)));
typedef unsigned u32x2 __attribute__((ext_vector_type(2)));

constexpr int NB = 2, SEQ = 8192, NTOK = NB * SEQ, DM = 1024, MEML = 256;
constexpr int NEXP = 32, TOPK = 4, NASSIGN = NTOK * TOPK;
constexpr int PROJ_LD = 3072;
constexpr int C_QG = 0, C_KG = 256, C_VG = 512, C_RG = 1024, C_QS = 1536, C_KS = 2048, C_VS = 2560, C_GLR = 3072;
constexpr float LOG2E = 1.4426950408889634f;
constexpr float EPS = 1e-5f;

__device__ __forceinline__ unsigned f2bf(float f) { unsigned u = __float_as_uint(f); return (u + 0x7fffu + ((u >> 16) & 1u)) >> 16; }
__device__ __forceinline__ unsigned pk2(float lo, float hi) { return f2bf(lo) | (f2bf(hi) << 16); }
__device__ __forceinline__ float bf2f(bf16_t h) { return __uint_as_float(((unsigned)h) << 16); }
__device__ __forceinline__ float bflo(unsigned w) { return __uint_as_float(w << 16); }
__device__ __forceinline__ float bfhi(unsigned w) { return __uint_as_float(w & 0xffff0000u); }

constexpr size_t MiB = 1u << 20;
constexpr size_t WS_CTL = 0;
constexpr size_t WS_WIN = 1 * MiB;
constexpr size_t WS_WOUT = 8 * MiB;
constexpr size_t WS_WQ = 10 * MiB;
constexpr size_t WS_WKV = 12 * MiB;
constexpr size_t WS_WMO = 16 * MiB;
constexpr size_t WS_WR = 18 * MiB;
constexpr size_t WS_WGU = 20 * MiB;
constexpr size_t WS_WDN = 148 * MiB;
constexpr size_t WS_XN = 212 * MiB;
constexpr size_t WS_MEMN = 244 * MiB;
constexpr size_t WS_KV = 245 * MiB;
constexpr size_t WS_BS = 247 * MiB;
constexpr size_t WS_BO = 251 * MiB;
constexpr size_t WS_PROJ = 256 * MiB;
constexpr size_t WS_LA = 360 * MiB;
constexpr size_t WS_ORAW = 376 * MiB;
constexpr size_t WS_MIX = 408 * MiB;
constexpr size_t WS_S = 440 * MiB;
constexpr size_t WS_P = 504 * MiB;
constexpr size_t WS_LG = 536 * MiB;
constexpr size_t WS_TOKE = 538 * MiB;
constexpr size_t WS_TOKR = 539 * MiB;
constexpr size_t WS_TOKW = 540 * MiB;
constexpr size_t WS_LIST = 541 * MiB;
constexpr size_t WS_ACT = 544 * MiB;
constexpr size_t WS_YS = 674 * MiB;
constexpr size_t WS_END = 804 * MiB;
constexpr int CW_CNT = 1024;

template <int MAP> __device__ __forceinline__ int srccol(int n, float& sc) {
    sc = 1.f;
    if (MAP == 0) return n;
    if (MAP == 1) {
        if (n < 256) { sc = 0.125f; return n; }
        if (n < 1024) return n;
        if (n < 3072) { if (n >= C_QS && n < C_KS) sc = 0.125f * LOG2E; return n + 16; }
        if (n < 3088) return 1024 + (n - 3072);
        return -1;
    }
    { const int ct = n >> 8, w = n & 255; return (w < 128) ? (128 * ct + w) : (1024 + 128 * ct + (w - 128)); }
}
template <int MAP>
__device__ __forceinline__ void conv_t_body(size_t gtid, size_t gsz, const float* __restrict__ src, bf16_t* __restrict__ dst, const float* __restrict__ gain,
                                               int ldsrc, int K, int nrows, int nmat, size_t sms, size_t dms) {
    const int kc8 = K / 8;
    const size_t total = (size_t)nmat * nrows * kc8;
    for (size_t idx = gtid; idx < total; idx += gsz) {
        const int n = (int)(idx % nrows); const size_t t = idx / nrows; const int kc = (int)(t % kc8); const int mat = (int)(t / kc8);
        float sc; const int c = srccol<MAP>(n, sc);
        u32x4 o = {0u, 0u, 0u, 0u};
        if (c >= 0) {
            const float* s = src + (size_t)mat * sms + (size_t)(kc * 8) * ldsrc + c;
            float v[8];
#pragma unroll
            for (int j = 0; j < 8; ++j) v[j] = s[(size_t)j * ldsrc] * (gain ? gain[kc * 8 + j] : 1.f) * sc;
            o.x = pk2(v[0], v[1]); o.y = pk2(v[2], v[3]); o.z = pk2(v[4], v[5]); o.w = pk2(v[6], v[7]);
        }
        *(u32x4*)(dst + (size_t)mat * dms + (size_t)n * K + kc * 8) = o;
    }
}
__device__ __forceinline__ void conv_n_body(size_t gtid, size_t gsz, const float* __restrict__ src, bf16_t* __restrict__ dst, const float* __restrict__ gain, int K, int nrows, float sc) {
    const int kc8 = K / 8; const size_t total = (size_t)nrows * kc8;
    for (size_t idx = gtid; idx < total; idx += gsz) {
        const int kc = (int)(idx % kc8), n = (int)(idx / kc8);
        const float g = gain[n] * sc; const f32x4 a = *(const f32x4*)(src + (size_t)n * K + kc * 8), b = *(const f32x4*)(src + (size_t)n * K + kc * 8 + 4);
        u32x4 o; o.x = pk2(a.x * g, a.y * g); o.y = pk2(a.z * g, a.w * g); o.z = pk2(b.x * g, b.y * g); o.w = pk2(b.z * g, b.w * g);
        *(u32x4*)(dst + (size_t)n * K + kc * 8) = o;
    }
}

__device__ __forceinline__ float wave_sum(float v) {
#pragma unroll
    for (int o = 1; o < 64; o <<= 1) v += __shfl_xor(v, o);
    return v;
}
__device__ __forceinline__ void rms_body(int gw, int ngw, int lane, const float* __restrict__ x, bf16_t* __restrict__ out, int nrows) {
    for (int row = gw; row < nrows; row += ngw) {
        const f32x4* xr = (const f32x4*)(x + (size_t)row * DM) + lane; f32x4 v[4]; float s = 0.f;
#pragma unroll
        for (int j = 0; j < 4; ++j) { v[j] = xr[64 * j]; s += v[j].x * v[j].x + v[j].y * v[j].y + v[j].z * v[j].z + v[j].w * v[j].w; }
        const float rstd = 1.0f / sqrtf(wave_sum(s) * (1.f / DM) + EPS);
        u32x2* o = (u32x2*)(out + (size_t)row * DM) + lane;
#pragma unroll
        for (int j = 0; j < 4; ++j) { u32x2 w; w.x = pk2(v[j].x * rstd, v[j].y * rstd); w.y = pk2(v[j].z * rstd, v[j].w * rstd); o[64 * j] = w; }
    }
}

struct GUnit { const char* a; const char* b; int row0, col0, e, valid, aux; };

template <class Sched, class Epi>
__device__ __forceinline__ void sgemm_body(unsigned char* lds, const Sched& S, const Epi& E) {
    const int tid = threadIdx.x, wid = tid >> 6, lane = tid & 63, wr = wid >> 2, wc = wid & 3, fr = lane & 15, fq = lane >> 4;
    unsigned char* SA = lds; unsigned char* SB = lds + 16384;
    GUnit u;
    for (int i = 0; S.next(i, u); ++i) {
        f32x4 acc[2][2][4][2];
#pragma unroll
        for (int a = 0; a < 2; ++a)
#pragma unroll
            for (int b = 0; b < 2; ++b)
#pragma unroll
                for (int m = 0; m < 4; ++m)
#pragma unroll
                    for (int n = 0; n < 2; ++n) acc[a][b][m][n] = (f32x4){0.f, 0.f, 0.f, 0.f};
        unsigned aoff[2], boff[2];
#pragma unroll
        for (int p = 0; p < 2; ++p) { const int b = tid * 16 + p * 8192, r = b >> 6, c = (b & 63) >> 1; aoff[p] = S.a_off(u, r) + c * 2; boff[p] = r * S.ldb + c * 2; }
        const int nk = S.K / 32;
        for (int kt = 0; kt < nk; ++kt) {
            u32x4 ra[2], rb[2];
#pragma unroll
            for (int p = 0; p < 2; ++p) { ra[p] = *(const u32x4*)(u.a + aoff[p] + kt * 64); rb[p] = *(const u32x4*)(u.b + boff[p] + kt * 64); }
#pragma unroll
            for (int p = 0; p < 2; ++p) { *(u32x4*)(SA + tid * 16 + p * 8192) = ra[p]; *(u32x4*)(SB + tid * 16 + p * 8192) = rb[p]; }
            __syncthreads();
            bf16x8 Af[2][4], Bf[2][2];
#pragma unroll
            for (int ai = 0; ai < 2; ++ai)
#pragma unroll
                for (int m = 0; m < 4; ++m) Af[ai][m] = *(const bf16x8*)(SA + (128 * ai + 64 * wr + 16 * m + fr) * 64 + fq * 16);
#pragma unroll
            for (int bj = 0; bj < 2; ++bj)
#pragma unroll
                for (int n = 0; n < 2; ++n) Bf[bj][n] = *(const bf16x8*)(SB + (128 * bj + 32 * wc + 16 * n + fr) * 64 + fq * 16);
#pragma unroll
            for (int ai = 0; ai < 2; ++ai)
#pragma unroll
                for (int bj = 0; bj < 2; ++bj)
#pragma unroll
                    for (int m = 0; m < 4; ++m)
#pragma unroll
                        for (int n = 0; n < 2; ++n) acc[ai][bj][m][n] = __builtin_amdgcn_mfma_f32_16x16x32_bf16(Bf[bj][n], Af[ai][m], acc[ai][bj][m][n], 0, 0, 0);
            __syncthreads();
        }
        E(acc, u, wr, wc, fr, fq);
    }
}
#define EPI_ROWS(r) for (int ai = 0; ai < 2; ++ai) for (int m = 0; m < 4; ++m) { const int r = 128 * ai + 64 * wr + 16 * m + fr;
#define EPI_COLS(c) for (int bj = 0; bj < 2; ++bj) for (int n = 0; n < 2; ++n) { const int c = 128 * bj + 32 * wc + 16 * n + 4 * fq; const f32x4 v = acc[ai][bj][m][n];
#define EPI_END }

struct DenseSched {
    const char* A; const char* Bt; unsigned lda, ldb; int K; int nM, nN; int pm_per_b; size_t zB; int G, c;
    __device__ __forceinline__ bool next(int i, GUnit& u) const {
        const long L = (long)i * G + c; if (c < 0 || L >= (long)nM * nN) return false;
        const int pm = (int)(L / nN), pn = (int)(L % nN);
        u.a = A + (size_t)pm * 256 * lda; u.b = Bt + (size_t)(pm / pm_per_b) * zB + (size_t)pn * 256 * ldb; u.row0 = pm * 256; u.col0 = pn * 256; u.e = 0; u.valid = 256; u.aux = 0; return true;
    }
    __device__ __forceinline__ unsigned a_off(const GUnit&, int r) const { return (unsigned)r * lda; }
};
struct SchedWqk {
    const char* kv; const char* wq; unsigned lda, ldb; int K; int G, c, pad;
    __device__ __forceinline__ bool next(int i, GUnit& u) const {
        const int L = i * G + c; if (c < 0 || L >= 32) return false; const int z = L >> 2, pn = L & 3, b = z >> 2, h = z & 3;
        u.a = kv + (size_t)b * 256 * 4096 + h * 512; u.b = wq + (size_t)pn * 256 * 2048 + h * 512; u.row0 = z * 256; u.col0 = pn * 256; u.e = 0; u.valid = 256; u.aux = 0; return true;
    }
    __device__ __forceinline__ unsigned a_off(const GUnit&, int r) const { return (unsigned)r * lda; }
};
struct SchedVo {
    const char* wmo; const char* kv; unsigned lda, ldb; int K; int G, c, pad;
    __device__ __forceinline__ bool next(int i, GUnit& u) const {
        const int L = i * G + c; if (c < 0 || L >= 32) return false; const int z = L >> 2, pm = L & 3, b = z >> 2, h = z & 3;
        u.a = wmo + (size_t)pm * 256 * 2048 + h * 512; u.b = kv + (size_t)b * 256 * 4096 + 2048 + h * 512; u.row0 = b * 1024 + pm * 256; u.col0 = h * 256; u.e = 0; u.valid = 256; u.aux = 0; return true;
    }
    __device__ __forceinline__ unsigned a_off(const GUnit&, int r) const { return (unsigned)r * lda; }
};
struct MoeSched {
    const char* A; const char* Bt; unsigned lda, ldb; int K; int nN; size_t zB;
    const int* cnt; const int* list; int gather; int G, c, pad;
    __device__ __forceinline__ bool next(int i, GUnit& u) const {
        const int L = i * G + c; const int T = L / nN, pn = L % nN;
        int tiles = 0, start = 0;
        for (int e = 0; e < NEXP; ++e) { const int ce = cnt[e]; const int te = (ce + 255) >> 8;
            if (T < tiles + te) { const int rt = T - tiles; u.e = e; u.valid = min(256, ce - rt * 256); u.row0 = start + rt * 256; u.col0 = pn * 256; u.aux = rt * 256;
                u.a = gather ? A : A + (size_t)u.row0 * lda; u.b = Bt + (size_t)e * zB + (size_t)pn * 256 * ldb; return true; }
            tiles += te; start += ce; }
        return false;
    }
    __device__ __forceinline__ unsigned a_off(const GUnit& u, int r) const {
        if (!gather) return (unsigned)r * lda;
        const int rr = r < u.valid ? r : 0; const int tok = list[u.e * NTOK + u.aux + rr]; return (unsigned)tok * lda;
    }
};

struct EpiBf16 { bf16_t* O; int ldc, pad;
    __device__ __forceinline__ void operator()(const f32x4 (&acc)[2][2][4][2], const GUnit& u, int wr, int wc, int fr, int fq) const {
        EPI_ROWS(r) EPI_COLS(c) u32x2 w; w.x = pk2(v[0], v[1]); w.y = pk2(v[2], v[3]); *(u32x2*)(O + (size_t)(u.row0 + r) * ldc + u.col0 + c) = w; EPI_END EPI_END } };
struct EpiF32 { float* O; int ldc, pad;
    __device__ __forceinline__ void operator()(const f32x4 (&acc)[2][2][4][2], const GUnit& u, int wr, int wc, int fr, int fq) const {
        EPI_ROWS(r) EPI_COLS(c) *(f32x4*)(O + (size_t)(u.row0 + r) * ldc + u.col0 + c) = v; EPI_END EPI_END } };
struct EpiResid { const float* base; float* out; int ldc, pad;
    __device__ __forceinline__ void operator()(const f32x4 (&acc)[2][2][4][2], const GUnit& u, int wr, int wc, int fr, int fq) const {
        EPI_ROWS(r) EPI_COLS(c) const size_t o = (size_t)(u.row0 + r) * ldc + u.col0 + c; *(f32x4*)(out + o) = *(const f32x4*)(base + o) + v; EPI_END EPI_END } };
struct EpiGU { const float* bgu; bf16_t* act;
    __device__ __forceinline__ void operator()(const f32x4 (&acc)[2][2][4][2], const GUnit& u, int wr, int wc, int fr, int fq) const {
        const int pn = u.col0 >> 8; const float* bg = bgu + (size_t)u.e * 2048;
        for (int ai = 0; ai < 2; ++ai) for (int m = 0; m < 4; ++m) { const int r = 128 * ai + 64 * wr + 16 * m + fr; if (r >= u.valid) continue;
            for (int n = 0; n < 2; ++n) { const int c = 32 * wc + 16 * n + 4 * fq; const int col = 128 * pn + c;
                const f32x4 g = acc[ai][0][m][n] + *(const f32x4*)(bg + col), l = acc[ai][1][m][n] + *(const f32x4*)(bg + 1024 + col); float o[4];
#pragma unroll
                for (int j = 0; j < 4; ++j) { const float gg = fminf(g[j], 7.0f), ll = fminf(fmaxf(l[j], -7.0f), 7.0f); o[j] = (ll + 1.0f) * (gg / (1.0f + __expf(-1.702f * gg))); }
                u32x2 w; w.x = pk2(o[0], o[1]); w.y = pk2(o[2], o[3]); *(u32x2*)(act + (size_t)(u.row0 + r) * 1024 + col) = w; } } } };
struct EpiDown { const float* bdn; bf16_t* ys;
    __device__ __forceinline__ void operator()(const f32x4 (&acc)[2][2][4][2], const GUnit& u, int wr, int wc, int fr, int fq) const {
        const float* bd = bdn + (size_t)u.e * 1024;
        for (int ai = 0; ai < 2; ++ai) for (int m = 0; m < 4; ++m) { const int r = 128 * ai + 64 * wr + 16 * m + fr; if (r >= u.valid) continue;
            EPI_COLS(c) const int col = u.col0 + c; const f32x4 y = v + *(const f32x4*)(bd + col); u32x2 w; w.x = pk2(y[0], y[1]); w.y = pk2(y[2], y[3]); *(u32x2*)(ys + (size_t)(u.row0 + r) * 1024 + col) = w; EPI_END } } };


typedef float f32x16 __attribute__((ext_vector_type(16)));
typedef short s16x4 __attribute__((ext_vector_type(4)));
#define LDSP __attribute__((address_space(3)))
#define LAUNDER(x) asm volatile("" : "+v"(x))
__device__ __forceinline__ int crow(int r, int hi) { return (r & 3) + 8 * (r >> 2) + 4 * hi; }
__device__ __forceinline__ s16x4 tr_read(const unsigned char* p) { return __builtin_bit_cast(s16x4, __builtin_amdgcn_ds_read_tr16_b64_v4i16((LDSP s16x4*)(unsigned)(uintptr_t)p)); }
__device__ __forceinline__ bf16x8 tr_frag(const unsigned char* img, int pitch, int k0, int f0, int lane) {
    const unsigned char* p = img + (k0 + 8 * (lane >> 5) + ((lane & 15) >> 2)) * pitch + (f0 + 16 * ((lane >> 4) & 1) + 4 * (lane & 3)) * 2;
    const s16x4 lo = tr_read(p), hi = tr_read(p + 4 * pitch);
    return (bf16x8){lo[0], lo[1], lo[2], lo[3], hi[0], hi[1], hi[2], hi[3]};
}
constexpr int GA_PK = 576, GA_PV = 1088;
constexpr int GA_V = 0, GA_PART = 0, GA_GLR = 69632, GA_TOT = 73728, GA_KD = 75776, GA_END = GA_KD + 64 * GA_PK;
__device__ __forceinline__ void gla_pass_a(unsigned char* lds, int task, const bf16_t* __restrict__ xn, const bf16_t* __restrict__ wglr  , const bf16_t* __restrict__ proj,
                                           const float* __restrict__ wg, const float* __restrict__ bg, float* __restrict__ UT, float* __restrict__ decay) {
    int tid = threadIdx.x; LAUNDER(tid); int wid = tid >> 6, lane = tid & 63, fr = lane & 15, fq = lane >> 4;
    const size_t t0 = (size_t)task * 64;
    { f32x4 acc[4];
#pragma unroll
      for (int m = 0; m < 4; ++m) acc[m] = (f32x4){0.f, 0.f, 0.f, 0.f};
#pragma unroll
      for (int ks = 0; ks < 4; ++ks) { const int k = 128 * wid + 32 * ks + 8 * fq; const bf16x8 bfr = *(const bf16x8*)(wglr + (size_t)fr * 1024 + k);
#pragma unroll
          for (int m = 0; m < 4; ++m) { const bf16x8 afr = *(const bf16x8*)(xn + (t0 + 16 * m + fr) * DM + k); acc[m] = __builtin_amdgcn_mfma_f32_16x16x32_bf16(afr, bfr, acc[m], 0, 0, 0); } }
      float* part = (float*)(lds + GA_PART) + wid * 1024;
#pragma unroll
      for (int m = 0; m < 4; ++m)
#pragma unroll
          for (int j = 0; j < 4; ++j) part[(16 * m + 4 * fq + j) * 16 + fr] = acc[m][j]; }
    __syncthreads();
    { float* glr = (float*)(lds + GA_GLR); const float* part = (const float*)(lds + GA_PART);
      for (int i = tid; i < 1024; i += 512) { float s = 0.f;
#pragma unroll
          for (int w = 0; w < 8; ++w) s += part[w * 1024 + i];
          glr[i] = s; } }
    __syncthreads();
    LAUNDER(tid);
    { const int cv = tid & 63, tk = tid >> 6;
#pragma unroll
      for (int i = 0; i < 8; ++i) { const int tok = tk + 8 * i; const u32x4 v = *(const u32x4*)(proj + (t0 + tok) * PROJ_LD + C_VG + cv * 8); *(u32x4*)(lds + GA_V + tok * GA_PV + cv * 16) = v; } }
    LAUNDER(tid);
    { const int j = tid & 255, half = tid >> 8; const float* glr = (const float*)(lds + GA_GLR); float* tot = (float*)(lds + GA_TOT);
      float w[16];
#pragma unroll
      for (int i = 0; i < 16; ++i) w[i] = wg[i * 256 + j];
      const float bj = bg[j]; float run = 0.f;
#pragma unroll 2
      for (int s = 0; s < 32; ++s) { const float* gl = glr + (32 * half + s) * 16; float u = bj;
#pragma unroll
          for (int i = 0; i < 16; ++i) u += gl[i] * w[i];
          const float ls = fminf(u, 0.f) - __logf(1.0f + __expf(-fabsf(u)));
          run += ls * (1.0f / 16.0f); }
      tot[half * 256 + j] = run;
      __syncthreads();
      const float t0v = tot[j], t1v = tot[256 + j]; const float gend = t0v + t1v;
      if (half == 0) decay[(size_t)task * 256 + j] = __expf(gend);
      run = half ? t0v : 0.f;
#pragma unroll 2
      for (int s = 0; s < 32; ++s) { const int tok = 32 * half + s; const float* gl = glr + tok * 16; float u = bj;
#pragma unroll
          for (int i = 0; i < 16; ++i) u += gl[i] * w[i];
          const float ls = fminf(u, 0.f) - __logf(1.0f + __expf(-fabsf(u)));
          run += ls * (1.0f / 16.0f);
          const float kk = bf2f(proj[(t0 + tok) * PROJ_LD + C_KG + j]);
          *(bf16_t*)(lds + GA_KD + tok * GA_PK + j * 2) = (bf16_t)f2bf(kk * __expf(gend - run)); } }
    __syncthreads();
    LAUNDER(tid); wid = __builtin_amdgcn_readfirstlane(tid >> 6); lane = tid & 63;
    { const int h = wid >> 1, nt = wid & 1, hi = lane >> 5, c32 = lane & 31; f32x16 acc[4];
#pragma unroll
      for (int m = 0; m < 4; ++m)
#pragma unroll
          for (int r = 0; r < 16; ++r) acc[m][r] = 0.f;
#pragma unroll
      for (int ks = 0; ks < 4; ++ks) { const bf16x8 bfr = tr_frag(lds + GA_KD, GA_PK, 16 * ks, h * 64 + 32 * nt, lane);
#pragma unroll
          for (int m = 0; m < 4; ++m) { const bf16x8 afr = tr_frag(lds + GA_V, GA_PV, 16 * ks, h * 128 + 32 * m, lane); acc[m] = __builtin_amdgcn_mfma_f32_32x32x16_bf16(afr, bfr, acc[m], 0, 0, 0); } }
      float* u = UT + ((size_t)task * 4 + h) * 8192;
#pragma unroll
      for (int m = 0; m < 4; ++m)
#pragma unroll
          for (int r = 0; r < 16; ++r) u[(32 * m + crow(r, hi)) * 64 + 32 * nt + c32] = acc[m][r]; }
    __syncthreads();
}
__device__ __forceinline__ void gla_pass_b(int e, const float* __restrict__ UT, const float* __restrict__ decay, bf16_t* __restrict__ ST) {
    const int dk = e & 63, dv = (e >> 6) & 127, h = (e >> 13) & 3, b = e >> 15; float s = 0.f;
    const size_t base = ((size_t)b * 128 * 4 + h) * 8192 + dv * 64 + dk; const size_t dbase = (size_t)b * 128 * 256 + h * 64 + dk;
#pragma unroll 8
    for (int c = 0; c < 128; ++c) { const float u = UT[base + (size_t)c * 4 * 8192], d = decay[dbase + (size_t)c * 256]; s = d * s + u; ST[base + (size_t)c * 4 * 8192] = (bf16_t)f2bf(s); }
}
constexpr int GC_PITCH = 520;
__device__ __forceinline__ void gla_pass_c(unsigned char* wlds  , int wtask, const bf16_t* __restrict__ ST, const bf16_t* __restrict__ proj, const float* __restrict__ ghead, bf16_t* __restrict__ mix, int lane) {
    const int nh = wtask & 1, h = (wtask >> 1) & 3, bc = wtask >> 3; const int c32 = lane & 31, hi = lane >> 5;
    const size_t t0 = (size_t)bc * 64 + 32 * nh; const bf16_t* st = ST + ((size_t)bc * 4 + h) * 8192;
    f32x16 acc[4];
#pragma unroll
    for (int m = 0; m < 4; ++m)
#pragma unroll
        for (int r = 0; r < 16; ++r) acc[m][r] = 0.f;
#pragma unroll
    for (int ks = 0; ks < 4; ++ks) { const bf16x8 bfr = *(const bf16x8*)(proj + (t0 + c32) * PROJ_LD + C_QG + h * 64 + 16 * ks + 8 * hi);
#pragma unroll
        for (int m = 0; m < 4; ++m) { const bf16x8 afr = *(const bf16x8*)(st + (32 * m + c32) * 64 + 16 * ks + 8 * hi); acc[m] = __builtin_amdgcn_mfma_f32_32x32x16_bf16(afr, bfr, acc[m], 0, 0, 0); } }
    float ss = 0.f;
#pragma unroll
    for (int m = 0; m < 4; ++m)
#pragma unroll
        for (int r = 0; r < 16; ++r) ss += acc[m][r] * acc[m][r];
    ss += __shfl_xor(ss, 32);
    const float rstd = 1.0f / sqrtf(ss * (1.0f / 128.0f) + EPS);
#pragma unroll
    for (int m = 0; m < 4; ++m)
#pragma unroll
        for (int r = 0; r < 16; ++r) *(float*)(wlds + c32 * GC_PITCH + (32 * m + crow(r, hi)) * 4) = acc[m][r] * rstd;
#pragma unroll
    for (int i = 0; i < 8; ++i) { const int q = lane + 64 * i, tok = q >> 4, dv0 = (q & 15) * 8; const float* src = (const float*)(wlds + tok * GC_PITCH + dv0 * 4);
        const u32x4 rgw = *(const u32x4*)(proj + (t0 + tok) * PROJ_LD + C_RG + h * 128 + dv0); const f32x4 g0 = *(const f32x4*)(ghead + dv0), g1 = *(const f32x4*)(ghead + dv0 + 4);
        const float rg[8] = {bflo(rgw.x), bfhi(rgw.x), bflo(rgw.y), bfhi(rgw.y), bflo(rgw.z), bfhi(rgw.z), bflo(rgw.w), bfhi(rgw.w)}; const float gg[8] = {g0.x, g0.y, g0.z, g0.w, g1.x, g1.y, g1.z, g1.w}; float y[8];
#pragma unroll
        for (int k = 0; k < 8; ++k) y[k] = src[k] * gg[k] * (rg[k] / (1.0f + __expf(-rg[k])));
        u32x4 o; o.x = pk2(y[0], y[1]); o.y = pk2(y[2], y[3]); o.z = pk2(y[4], y[5]); o.w = pk2(y[6], y[7]);
        *(u32x4*)(mix + (t0 + tok) * 1024 + h * 128 + dv0) = o; }
}
__device__ __forceinline__ void sb_task(unsigned char* vl  , int wtask, const bf16_t* __restrict__ proj, bf16_t* __restrict__ mix, int lane) {
    const int qt = wtask & 255, h = (wtask >> 8) & 7, b = wtask >> 11; const int c = lane & 31, hi = lane >> 5;
    const int t0 = qt * 32; const size_t rowb = (size_t)b * SEQ;
    bf16x8 qf[4];
#pragma unroll
    for (int d0 = 0; d0 < 4; ++d0) qf[d0] = *(const bf16x8*)(proj + (rowb + t0 + c) * PROJ_LD + C_QS + h * 64 + 16 * d0 + 8 * hi);
    const int kap = 16 * ((c >> 2) & 1) + (c & 3) + 4 * (c >> 3);
    f32x16 o0, o1;
#pragma unroll
    for (int r = 0; r < 16; ++r) { o0[r] = 0.f; o1[r] = 0.f; }
    float Dc = 1.0f;
    for (int j0 = t0; j0 >= 0; j0 -= 32) {
        const bf16_t* kp = proj + (rowb + j0 + kap) * PROJ_LD + C_KS + h * 64 + 8 * hi;
        bf16x8 kf[4];
#pragma unroll
        for (int d0 = 0; d0 < 4; ++d0) kf[d0] = *(const bf16x8*)(kp + 16 * d0);
#pragma unroll
        for (int i = 0; i < 4; ++i) { const int idx = lane + 64 * i, key = idx >> 3, ch = idx & 7; const u32x4 v = *(const u32x4*)(proj + (rowb + j0 + key) * PROJ_LD + C_VS + h * 64 + ch * 8);
            *(u32x4*)(vl + (ch >> 2) * 2048 + key * 64 + (ch & 3) * 16) = v; }
        f32x16 z;
#pragma unroll
        for (int r = 0; r < 16; ++r) z[r] = 0.f;
#pragma unroll
        for (int d0 = 0; d0 < 4; ++d0) z = __builtin_amdgcn_mfma_f32_32x32x16_bf16(kf[d0], qf[d0], z, 0, 0, 0);
        float e[16], Dl[16];
        const bool diag = (j0 == t0);
#pragma unroll
        for (int r = 0; r < 16; ++r) { float ev = __builtin_amdgcn_exp2f(fminf(z[r], 126.0f)); if (diag && (16 * hi + r >= c)) ev = 0.f; e[r] = ev; }
        float D = hi ? Dc : 1.0f;
#pragma unroll
        for (int r = 15; r >= 0; --r) { D = fmaf(D, e[r], D); Dl[r] = D; }
        const float other = __shfl_xor(D, 32);
        const float mult = hi ? 1.0f : other;
        Dc = D * other;
        unsigned pw[8];
#pragma unroll
        for (int r = 0; r < 16; r += 2) { const float a0 = e[r] * __builtin_amdgcn_rcpf(Dl[r] * mult), a1 = e[r + 1] * __builtin_amdgcn_rcpf(Dl[r + 1] * mult); pw[r >> 1] = pk2(a0, a1); }
#pragma unroll
        for (int ks = 0; ks < 2; ++ks) { const bf16x8 pa = __builtin_bit_cast(bf16x8, (u32x4){pw[4 * ks], pw[4 * ks + 1], pw[4 * ks + 2], pw[4 * ks + 3]});
            const unsigned char* vb = vl + (16 * hi + 8 * ks + ((lane & 15) >> 2)) * 64 + (16 * ((lane >> 4) & 1) + 4 * (lane & 3)) * 2;
            { const s16x4 lo = tr_read(vb), hh = tr_read(vb + 256); o0 = __builtin_amdgcn_mfma_f32_32x32x16_bf16(pa, (bf16x8){lo[0], lo[1], lo[2], lo[3], hh[0], hh[1], hh[2], hh[3]}, o0, 0, 0, 0); }
            { const s16x4 lo = tr_read(vb + 2048), hh = tr_read(vb + 2048 + 256); o1 = __builtin_amdgcn_mfma_f32_32x32x16_bf16(pa, (bf16x8){lo[0], lo[1], lo[2], lo[3], hh[0], hh[1], hh[2], hh[3]}, o1, 0, 0, 0); } }
        if (__all(!(Dc < 3.0e38f))) break;
    }
    bf16_t* ob = mix + (rowb + t0) * 1024 + 512 + h * 64 + c;
#pragma unroll
    for (int r = 0; r < 16; ++r) { const int q = crow(r, hi); ob[(size_t)q * 1024] = (bf16_t)f2bf(o0[r]); ob[(size_t)q * 1024 + 32] = (bf16_t)f2bf(o1[r]); }
}
__device__ __forceinline__ void softmax_task(int gw, int lane, const float* __restrict__ S, bf16_t* __restrict__ P) {
    const f32x4 v = *((const f32x4*)(S + (size_t)gw * 256) + lane);
    float m = fmaxf(fmaxf(v.x, v.y), fmaxf(v.z, v.w));
#pragma unroll
    for (int o = 1; o < 64; o <<= 1) m = fmaxf(m, __shfl_xor(m, o));
    const float e0 = exp2f(v.x - m), e1 = exp2f(v.y - m), e2 = exp2f(v.z - m), e3 = exp2f(v.w - m);
    const float inv = 1.0f / wave_sum(e0 + e1 + e2 + e3);
    u32x2 w; w.x = pk2(e0 * inv, e1 * inv); w.y = pk2(e2 * inv, e3 * inv); *((u32x2*)(P + (size_t)gw * 256) + lane) = w;
}
__device__ __forceinline__ void router_logit(int idx, const bf16_t* __restrict__ xn, const bf16_t* __restrict__ wr, const float* __restrict__ br, float* __restrict__ lg) {
    const int t = idx >> 5, e = idx & 31; const u32x4* a = (const u32x4*)(xn + (size_t)t * DM); const u32x4* w = (const u32x4*)(wr + (size_t)e * DM); float s = 0.f;
    for (int i = 0; i < DM / 8; ++i) { const u32x4 x = a[i], y = w[i];
        s += bflo(x.x) * bflo(y.x) + bfhi(x.x) * bfhi(y.x) + bflo(x.y) * bflo(y.y) + bfhi(x.y) * bfhi(y.y) + bflo(x.z) * bflo(y.z) + bfhi(x.z) * bfhi(y.z) + bflo(x.w) * bflo(y.w) + bfhi(x.w) * bfhi(y.w); }
    lg[idx] = s + br[e];
}
__device__ __forceinline__ void router_topk(int t, const float* __restrict__ lg, int* __restrict__ cnt, int* __restrict__ list, int* __restrict__ toke, int* __restrict__ tokr, float* __restrict__ tokw) {
    float v[NEXP];
#pragma unroll
    for (int e = 0; e < NEXP; ++e) v[e] = lg[(size_t)t * NEXP + e];
    float tv[4]; int ti[4];
#pragma unroll
    for (int k = 0; k < 4; ++k) { float best = -INFINITY; int bi = 0;
#pragma unroll
        for (int e = 0; e < NEXP; ++e) { if (v[e] > best) { best = v[e]; bi = e; } }
        tv[k] = best; ti[k] = bi;
#pragma unroll
        for (int e = 0; e < NEXP; ++e) if (e == bi) v[e] = -INFINITY; }
    const float e1 = __expf(tv[1] - tv[0]), e2 = __expf(tv[2] - tv[0]), e3 = __expf(tv[3] - tv[0]); const float inv = 1.0f / (1.0f + e1 + e2 + e3);
    const float g[4] = {inv, e1 * inv, e2 * inv, e3 * inv};
#pragma unroll
    for (int k = 0; k < 4; ++k) { const int r = atomicAdd(&cnt[ti[k]], 1); list[ti[k] * NTOK + r] = t; toke[t * 4 + k] = ti[k]; tokr[t * 4 + k] = r; tokw[t * 4 + k] = g[k]; }
}
__device__ __forceinline__ void combine_task(int t, int lane, float* __restrict__ xio, const bf16_t* __restrict__ ys, const int* __restrict__ cnt, const int* __restrict__ toke, const int* __restrict__ tokr,
                                                 const float* __restrict__ tokw, const float* __restrict__ gfin) {
    f32x4* xr = (f32x4*)(xio + (size_t)t * DM) + lane; f32x4 v[4];
#pragma unroll
    for (int j = 0; j < 4; ++j) v[j] = xr[64 * j];
    for (int k = 0; k < 4; ++k) { const int e = toke[t * 4 + k], r = tokr[t * 4 + k]; const float w = tokw[t * 4 + k]; int start = 0; for (int i = 0; i < e; ++i) start += cnt[i];
        const u32x2* yr = (const u32x2*)(ys + (size_t)(start + r) * DM) + lane;
#pragma unroll
        for (int j = 0; j < 4; ++j) { const u32x2 y = yr[64 * j]; v[j].x += w * bflo(y.x); v[j].y += w * bfhi(y.x); v[j].z += w * bflo(y.y); v[j].w += w * bfhi(y.y); } }
    float s = 0.f;
#pragma unroll
    for (int j = 0; j < 4; ++j) s += v[j].x * v[j].x + v[j].y * v[j].y + v[j].z * v[j].z + v[j].w * v[j].w;
    const float rstd = 1.0f / sqrtf(wave_sum(s) * (1.f / DM) + EPS);
#pragma unroll
    for (int j = 0; j < 4; ++j) { const f32x4 g = *((const f32x4*)gfin + lane + 64 * j); xr[64 * j] = v[j] * rstd * g; }
}

#define GAS __attribute__((address_space(1)))
#define RLX_AGENT __ATOMIC_RELAXED, __HIP_MEMORY_SCOPE_AGENT
#define XB_TMO      128
#define XB_XCNT(j)  (256  + 64 * (j))
#define XB_XSUB(j)  (1280 + 64 * (j))
#define XB_XGEN(j)  (2304 + 64 * (j))
#define XB_TOP      3328
#define XB_TOPGEN   3392
#define XCD_BAR_WORDS 3456
#define XB_SPIN_CAP (1u << 18)
__device__ __forceinline__ unsigned xb_ld(unsigned* p)              { return __hip_atomic_load(p, __ATOMIC_RELAXED, __HIP_MEMORY_SCOPE_AGENT); }
__device__ __forceinline__ unsigned xb_add(unsigned* p, unsigned v) { return __hip_atomic_fetch_add(p, v, __ATOMIC_RELAXED, __HIP_MEMORY_SCOPE_AGENT); }
__device__ __forceinline__ unsigned xb_xcc_id() { return (unsigned)__builtin_amdgcn_s_getreg((3 << 11) | 20) & 0xFu; }
#define XB_SPIN(cond, bar) do { unsigned _sp = 0; while (cond) { __builtin_amdgcn_s_sleep(1); \
    if ((++_sp & 255u) == 0u) { if (xb_ld(&(bar)[XB_TMO])) break; if (_sp > XB_SPIN_CAP) { atomicAdd(&(bar)[XB_TMO], 1u); break; } } } } while (0)
struct XcdBarrier { unsigned* bar; unsigned x; volatile LDSP unsigned* st; };
__device__ __forceinline__ XcdBarrier xcd_barrier_post(unsigned* bar, volatile LDSP unsigned* st) {
    XcdBarrier b; b.bar = bar; b.x = xb_xcc_id(); b.st = st;
    if (threadIdx.x == 0) (void)xb_add(&bar[XB_XCNT(b.x)], 1u);
    return b;
}
__device__ __forceinline__ void xcd_barrier_complete(unsigned* bar, unsigned x, unsigned& nloc, unsigned& nx) {
    const unsigned G = gridDim.x * gridDim.y * gridDim.z;
    unsigned sum, cnt, mine, sp = 0u;
    for (;;) {
        sum = 0u; cnt = 0u; mine = 0u;
#pragma unroll
        for (unsigned j = 0; j < 16; ++j) { const unsigned c = xb_ld(&bar[XB_XCNT(j)]); sum += c; cnt += (c > 0u) ? 1u : 0u; mine = (j == x) ? c : mine; }
        if (sum == G) break;
        __builtin_amdgcn_s_sleep(1);
        if ((++sp & 255u) == 0u) { if (xb_ld(&bar[XB_TMO])) break; if (sp > XB_SPIN_CAP) { atomicAdd(&bar[XB_TMO], 1u); break; } }
    }
    nloc = mine > 0u ? mine : 1u; nx = cnt > 0u ? cnt : 1u;
}
__device__ __forceinline__ void xcd_barrier(const XcdBarrier& b) {
    asm volatile("s_waitcnt vmcnt(0)" ::: "memory");
    __syncthreads();
    if (threadIdx.x == 0) {
        unsigned* bar = b.bar;
        __builtin_amdgcn_s_waitcnt(0);
        unsigned nloc = b.st[0], nx = b.st[1];
        if (nloc == 0u) { xcd_barrier_complete(bar, b.x, nloc, nx); b.st[0] = nloc; b.st[1] = nx; }
        const unsigned old = xb_add(&bar[XB_XSUB(b.x)], 1u);
        const unsigned gen = old / nloc;
        if (old + 1u == (gen + 1u) * nloc) {
            __builtin_amdgcn_fence(__ATOMIC_RELEASE, "agent");
            asm volatile("s_waitcnt vmcnt(0)" ::: "memory");
            const unsigned og = xb_add(&bar[XB_TOP], 1u);
            const unsigned tg = og / nx;
            if (og + 1u == (tg + 1u) * nx) xb_add(&bar[XB_TOPGEN], 1u);
            else XB_SPIN(xb_ld(&bar[XB_TOPGEN]) == tg, bar);
            __builtin_amdgcn_fence(__ATOMIC_ACQUIRE, "agent");
            xb_add(&bar[XB_XGEN(b.x)], 1u);
            asm volatile("s_waitcnt vmcnt(0)" ::: "memory");
        } else {
            XB_SPIN(xb_ld(&bar[XB_XGEN(b.x)]) == gen, bar);
            __builtin_amdgcn_fence(__ATOMIC_ACQUIRE, "agent");
            asm volatile("s_waitcnt vmcnt(0)" ::: "memory");
        }
    }
    __syncthreads();
}

constexpr int LDS_BYTES = 147456;
constexpr int MISC_OFF = LDS_BYTES - 512;
constexpr int CW_BAR = 4096;
constexpr size_t CTL_ZERO_BYTES = 65536;
constexpr int NPHASE = 16;
struct Args { const float* in[22]; float* out; unsigned char* ws; int ph_lo, ph_hi; };

__global__ void __launch_bounds__(512, 2) mega(Args a) {
    extern __shared__ __attribute__((aligned(16))) unsigned char lds[];
    unsigned char* ws = a.ws; float* out = a.out;
    const float* x = a.in[0]; const float* mem = a.in[1]; const float* g_mix = a.in[2]; const float* w_in = a.in[3];
    const float* w_gla_gate = a.in[4]; const float* b_gla_gate = a.in[5]; const float* g_gla_head = a.in[6]; const float* w_out = a.in[7];
    const float* g_mem_q = a.in[8]; const float* g_mem_kv = a.in[9]; const float* w_mq = a.in[10]; const float* w_mk = a.in[11];
    const float* w_mv = a.in[12]; const float* w_mo = a.in[13]; const float* g_ffn = a.in[14]; const float* w_router = a.in[15];
    const float* b_router = a.in[16]; const float* w_gu = a.in[17]; const float* b_gu = a.in[18]; const float* w_down = a.in[19];
    const float* b_down = a.in[20]; const float* g_final = a.in[21];
    bf16_t* Wt_in = (bf16_t*)(ws + WS_WIN); bf16_t* Wt_out = (bf16_t*)(ws + WS_WOUT); bf16_t* Wq = (bf16_t*)(ws + WS_WQ); bf16_t* Wt_kv = (bf16_t*)(ws + WS_WKV);
    bf16_t* Wt_mo = (bf16_t*)(ws + WS_WMO); bf16_t* Wt_r = (bf16_t*)(ws + WS_WR); bf16_t* Wt_gu = (bf16_t*)(ws + WS_WGU); bf16_t* Wt_dn = (bf16_t*)(ws + WS_WDN);
    bf16_t* xn = (bf16_t*)(ws + WS_XN); bf16_t* memn = (bf16_t*)(ws + WS_MEMN); bf16_t* kv = (bf16_t*)(ws + WS_KV); bf16_t* Bs = (bf16_t*)(ws + WS_BS); bf16_t* Bo = (bf16_t*)(ws + WS_BO);
    bf16_t* proj = (bf16_t*)(ws + WS_PROJ); bf16_t* mix = (bf16_t*)(ws + WS_MIX);
    float* Sc = (float*)(ws + WS_S); bf16_t* P = (bf16_t*)(ws + WS_P); float* lg = (float*)(ws + WS_LG); int* toke = (int*)(ws + WS_TOKE); int* tokr = (int*)(ws + WS_TOKR);
    float* tokw = (float*)(ws + WS_TOKW); int* list = (int*)(ws + WS_LIST); bf16_t* act = (bf16_t*)(ws + WS_ACT); bf16_t* ys = (bf16_t*)(ws + WS_YS);
    float* UT = (float*)(ws + WS_S); float* decay = (float*)(ws + WS_LA); bf16_t* ST = (bf16_t*)(ws + WS_ORAW);
    unsigned* ctl = (unsigned*)(ws + WS_CTL); int* cnt = (int*)ctl + CW_CNT;

    const int G = gridDim.x, vb = blockIdx.x;
    volatile LDSP unsigned* MISC = (volatile LDSP unsigned*)(unsigned)(uintptr_t)(lds + MISC_OFF);
    if (threadIdx.x < 128) MISC[threadIdx.x] = 0u;
    __syncthreads();
    XcdBarrier bar = xcd_barrier_post(ctl + CW_BAR, MISC + 8);
    const int lo = a.ph_lo, hi = a.ph_hi;
#define IN(k) (lo <= (k) && (k) < hi)
#define SEAM(k) do { if (IN(k) && IN((k) + 1)) xcd_barrier(bar); } while (0)
#define TIDS() int tid = threadIdx.x; LAUNDER(tid); const int lane = tid & 63; const int wid = __builtin_amdgcn_readfirstlane(tid >> 6); (void)lane; (void)wid

    if (IN(0)) { TIDS(); const size_t gt = (size_t)vb * 512 + tid, gs = (size_t)G * 512;
        conv_t_body<1>(gt, gs, w_in, Wt_in, g_mix, 3088, 1024, 3088, 1, 0, 0);
        conv_t_body<0>(gt, gs, w_out, Wt_out, nullptr, 1024, 1024, 1024, 1, 0, 0);
        conv_n_body(gt, gs, w_mq, Wq, g_mem_q, 1024, 1024, LOG2E / 16.0f);
        conv_t_body<0>(gt, gs, w_mk, Wt_kv, g_mem_kv, 1024, 1024, 1024, 1, 0, 0);
        conv_t_body<0>(gt, gs, w_mv, Wt_kv + (size_t)1024 * 1024, g_mem_kv, 1024, 1024, 1024, 1, 0, 0);
        conv_t_body<0>(gt, gs, w_mo, Wt_mo, nullptr, 1024, 1024, 1024, 1, 0, 0);
        conv_t_body<0>(gt, gs, w_router, Wt_r, g_ffn, 32, 1024, 32, 1, 0, 0);
        conv_t_body<2>(gt, gs, w_gu, Wt_gu, g_ffn, 2048, 1024, 2048, 32, (size_t)1024 * 2048, (size_t)2048 * 1024);
        conv_t_body<0>(gt, gs, w_down, Wt_dn, nullptr, 1024, 1024, 1024, 32, (size_t)1024 * 1024, (size_t)1024 * 1024);
        rms_body(vb * 8 + wid, G * 8, lane, x, xn, NTOK);
        rms_body(vb * 8 + wid, G * 8, lane, mem, memn, NB * MEML); }
    SEAM(0);
    if (IN(1)) { DenseSched S{(const char*)xn, (const char*)Wt_in, 2048u, 2048u, 1024, 64, 12, 1 << 30, 0, G, vb}; EpiBf16 E{proj, PROJ_LD, 0}; sgemm_body(lds, S, E); }
    SEAM(1);
    if (IN(2)) {
        for (int t = vb; t < 256; t += G) gla_pass_a(lds, t, xn, Wt_in + (size_t)3072 * 1024, proj, w_gla_gate, b_gla_gate, UT, decay);
        { TIDS(); for (int t = vb * 8 + wid; t < 4096; t += G * 8) sb_task(lds + wid * 4096, t, proj, mix, lane); }
        __syncthreads();
        { DenseSched S{(const char*)memn, (const char*)Wt_kv, 2048u, 2048u, 1024, 2, 8, 1 << 30, 0, G, vb}; EpiBf16 E{kv, 2048, 0}; sgemm_body(lds, S, E); } }
    SEAM(2);
    if (IN(3)) {
        { TIDS(); for (int e = vb * 512 + tid; e < 65536; e += G * 512) gla_pass_b(e, UT, decay, ST); }
        { SchedWqk S{(const char*)kv, (const char*)Wq, 4096u, 2048u, 256, G / 2, vb - G / 2, 0}; EpiBf16 E{Bs, 1024, 0}; sgemm_body(lds, S, E); }
        { SchedVo S{(const char*)Wt_mo, (const char*)kv, 2048u, 4096u, 256, G / 2, vb - G / 2 - 32, 0}; EpiBf16 E{Bo, 1024, 0}; sgemm_body(lds, S, E); } }
    SEAM(3);
    if (IN(4)) { TIDS(); for (int t = vb * 8 + wid; t < 2048; t += G * 8) gla_pass_c(lds + wid * 32 * GC_PITCH, t, ST, proj, g_gla_head, mix, lane); }
    SEAM(4);
    if (IN(5)) { DenseSched S{(const char*)mix, (const char*)Wt_out, 2048u, 2048u, 1024, 64, 4, 1 << 30, 0, G, vb}; EpiResid E{x, out, 1024, 0}; sgemm_body(lds, S, E); }
    SEAM(5);
    if (IN(6)) { TIDS(); rms_body(vb * 8 + wid, G * 8, lane, out, xn, NTOK); }
    SEAM(6);
    if (IN(7)) { DenseSched S{(const char*)xn, (const char*)Bs, 2048u, 2048u, 1024, 64, 4, 32, (size_t)1024 * 2048, G, vb}; EpiF32 E{Sc, 1024, 0}; sgemm_body(lds, S, E); }
    SEAM(7);
    if (IN(8)) { TIDS(); for (int t = vb * 8 + wid; t < NTOK * 4; t += G * 8) softmax_task(t, lane, Sc, P); }
    SEAM(8);
    if (IN(9)) { DenseSched S{(const char*)P, (const char*)Bo, 2048u, 2048u, 1024, 64, 4, 32, (size_t)1024 * 2048, G, vb}; EpiResid E{out, out, 1024, 0}; sgemm_body(lds, S, E); }
    SEAM(9);
    if (IN(10)) { TIDS(); rms_body(vb * 8 + wid, G * 8, lane, out, xn, NTOK); }
    SEAM(10);
    if (IN(11)) { TIDS(); for (int i = vb * 512 + tid; i < NTOK * NEXP; i += G * 512) router_logit(i, xn, Wt_r, b_router, lg); }
    SEAM(11);
    if (IN(12)) { TIDS(); for (int t = vb * 512 + tid; t < NTOK; t += G * 512) router_topk(t, lg, cnt, list, toke, tokr, tokw); }
    SEAM(12);
    if (IN(13)) { MoeSched S{(const char*)xn, (const char*)Wt_gu, 2048u, 2048u, 1024, 8, (size_t)2048 * 2048, cnt, list, 1, G, vb, 0}; EpiGU E{b_gu, act}; sgemm_body(lds, S, E); }
    SEAM(13);
    if (IN(14)) { MoeSched S{(const char*)act, (const char*)Wt_dn, 2048u, 2048u, 1024, 4, (size_t)1024 * 2048, cnt, list, 0, G, vb, 0}; EpiDown E{b_down, ys}; sgemm_body(lds, S, E); }
    SEAM(14);
    if (IN(15)) { TIDS(); for (int t = vb * 8 + wid; t < NTOK; t += G * 8) combine_task(t, lane, out, ys, cnt, toke, tokr, tokw, g_final); }
#undef IN
#undef SEAM
#undef TIDS
}

#ifndef MK_PER_PHASE
#define MK_PER_PHASE 0
#endif
extern "C" void kernel_launch(void* const* d_in, const int* in_sizes, int n_in, void* d_out, int out_size, void* d_ws, size_t ws_size, hipStream_t stream) {
    static int grid = 0;
    if (grid == 0) {
        if (n_in != 22 || in_sizes[0] != NTOK * DM || out_size != NTOK * DM || ws_size < WS_END) { fprintf(stderr, "kernel_launch: unexpected shapes (n_in %d, ws %zu)\n", n_in, ws_size); grid = -1; return; }
        int dev = 0, cus = 0, per_cu = 0;
        if (hipGetDevice(&dev) != hipSuccess || hipDeviceGetAttribute(&cus, hipDeviceAttributeMultiprocessorCount, dev) != hipSuccess) { grid = -1; return; }
        if (hipFuncSetAttribute((const void*)mega, hipFuncAttributeMaxDynamicSharedMemorySize, LDS_BYTES) != hipSuccess) { fprintf(stderr, "kernel_launch: hipFuncSetAttribute failed\n"); grid = -1; return; }
        if (hipOccupancyMaxActiveBlocksPerMultiprocessor(&per_cu, (const void*)mega, 512, LDS_BYTES) != hipSuccess || per_cu < 1) fprintf(stderr, "kernel_launch: occupancy query says %d blocks/CU\n", per_cu);
        (void)hipGetLastError();
        grid = cus;
    }
    if (grid < 0) return;
    (void)hipMemsetAsync((char*)d_ws + WS_CTL, 0, CTL_ZERO_BYTES, stream);
    Args a{};
    for (int i = 0; i < 22; ++i) a.in[i] = (const float*)d_in[i];
    a.out = (float*)d_out; a.ws = (unsigned char*)d_ws;
#if MK_PER_PHASE
    for (int p = 0; p < NPHASE; ++p) { a.ph_lo = p; a.ph_hi = p + 1; hipLaunchKernelGGL(mega, dim3(grid), dim3(512), LDS_BYTES, stream, a); }
#else
    a.ph_lo = 0; a.ph_hi = NPHASE; hipLaunchKernelGGL(mega, dim3(grid), dim3(512), LDS_BYTES, stream, a);
#endif
}
```

```cpp
#include <hip/hip_runtime.h>
#include <cstdio>
#include <cstdint>

typedef unsigned short bf16_t;
typedef short bf16x8 __attribute__((ext_vector_type(8)));
typedef float f32x4 __attribute__((ext_vector_type(4)));
typedef unsigned u32x4 __attribute__((ext_vector_type(4)));
typedef unsigned u32x2 __attribute__((ext_vector_type(2)));
#define LDSP __attribute__((address_space(3)))
#define LAUNDER(x) asm volatile("" : "+v"(x))

constexpr int NB = 2, SEQ = 8192, NTOK = NB * SEQ, DM = 1024, MEML = 256;
constexpr int NEXP = 32, TOPK = 4, NASSIGN = NTOK * TOPK;
constexpr int PROJ_LD = 3072;
constexpr int C_QG = 0, C_KG = 256, C_VG = 512, C_RG = 1024, C_QS = 1536, C_KS = 2048, C_VS = 2560, C_GLR = 3072;
constexpr float LOG2E = 1.4426950408889634f;
constexpr float EPS = 1e-5f;

__device__ __forceinline__ unsigned f2bf(float f) { unsigned u = __float_as_uint(f); return (u + 0x7fffu + ((u >> 16) & 1u)) >> 16; }
__device__ __forceinline__ unsigned pk2(float lo, float hi) { return f2bf(lo) | (f2bf(hi) << 16); }
__device__ __forceinline__ float bf2f(bf16_t h) { return __uint_as_float(((unsigned)h) << 16); }
__device__ __forceinline__ float bflo(unsigned w) { return __uint_as_float(w << 16); }
__device__ __forceinline__ float bfhi(unsigned w) { return __uint_as_float(w & 0xffff0000u); }

constexpr size_t MiB = 1u << 20;
constexpr size_t WS_CTL = 0;
constexpr size_t WS_WIN = 1 * MiB;
constexpr size_t WS_WOUT = 8 * MiB;
constexpr size_t WS_WQ = 10 * MiB;
constexpr size_t WS_WKV = 12 * MiB;
constexpr size_t WS_WMO = 16 * MiB;
constexpr size_t WS_WR = 18 * MiB;
constexpr size_t WS_WGU = 20 * MiB;
constexpr size_t WS_WDN = 148 * MiB;
constexpr size_t WS_XN = 212 * MiB;
constexpr size_t WS_MEMN = 244 * MiB;
constexpr size_t WS_KV = 245 * MiB;
constexpr size_t WS_BS = 247 * MiB;
constexpr size_t WS_BO = 251 * MiB;
constexpr size_t WS_PROJ = 256 * MiB;
constexpr size_t WS_LA = 360 * MiB;
constexpr size_t WS_ORAW = 376 * MiB;
constexpr size_t WS_MIX = 408 * MiB;
constexpr size_t WS_S = 440 * MiB;
constexpr size_t WS_P = 504 * MiB;
constexpr size_t WS_LG = 536 * MiB;
constexpr size_t WS_TOKE = 538 * MiB;
constexpr size_t WS_TOKR = 539 * MiB;
constexpr size_t WS_TOKW = 540 * MiB;
constexpr size_t WS_LIST = 541 * MiB;
constexpr size_t WS_ACT = 544 * MiB;
constexpr size_t WS_YS = 674 * MiB;
constexpr size_t WS_END = 804 * MiB;
constexpr int CW_CNT = 1024;

template <int MAP> __device__ __forceinline__ int srccol(int n, float& sc) {
    sc = 1.f;
    if (MAP == 0) return n;
    if (MAP == 1) {
        if (n < 256) { sc = 0.125f; return n; }
        if (n < 1024) return n;
        if (n < 3072) { if (n >= C_QS && n < C_KS) sc = 0.125f * LOG2E; return n + 16; }
        if (n < 3088) return 1024 + (n - 3072);
        return -1;
    }
    { const int ct = n >> 8, w = n & 255; return (w < 128) ? (128 * ct + w) : (1024 + 128 * ct + (w - 128)); }
}
template <int MAP>
__device__ __forceinline__ void conv_t_body(size_t gtid, size_t gsz, const float* __restrict__ src, bf16_t* __restrict__ dst, const float* __restrict__ gain,
                                               int ldsrc, int K, int nrows, int nmat, size_t sms, size_t dms) {
    const int kc8 = K / 8;
    const size_t total = (size_t)nmat * nrows * kc8;
    for (size_t idx = gtid; idx < total; idx += gsz) {
        const int n = (int)(idx % nrows); const size_t t = idx / nrows; const int kc = (int)(t % kc8); const int mat = (int)(t / kc8);
        float sc; const int c = srccol<MAP>(n, sc);
        u32x4 o = {0u, 0u, 0u, 0u};
        if (c >= 0) {
            const float* s = src + (size_t)mat * sms + (size_t)(kc * 8) * ldsrc + c;
            float v[8];
#pragma unroll
            for (int j = 0; j < 8; ++j) v[j] = s[(size_t)j * ldsrc] * (gain ? gain[kc * 8 + j] : 1.f) * sc;
            o.x = pk2(v[0], v[1]); o.y = pk2(v[2], v[3]); o.z = pk2(v[4], v[5]); o.w = pk2(v[6], v[7]);
        }
        *(u32x4*)(dst + (size_t)mat * dms + (size_t)n * K + kc * 8) = o;
    }
}
__device__ __forceinline__ void conv_n_body(size_t gtid, size_t gsz, const float* __restrict__ src, bf16_t* __restrict__ dst, const float* __restrict__ gain, int K, int nrows, float sc) {
    const int kc8 = K / 8; const size_t total = (size_t)nrows * kc8;
    for (size_t idx = gtid; idx < total; idx += gsz) {
        const int kc = (int)(idx % kc8), n = (int)(idx / kc8);
        const float g = gain[n] * sc; const f32x4 a = *(const f32x4*)(src + (size_t)n * K + kc * 8), b = *(const f32x4*)(src + (size_t)n * K + kc * 8 + 4);
        u32x4 o; o.x = pk2(a.x * g, a.y * g); o.y = pk2(a.z * g, a.w * g); o.z = pk2(b.x * g, b.y * g); o.w = pk2(b.z * g, b.w * g);
        *(u32x4*)(dst + (size_t)n * K + kc * 8) = o;
    }
}

__device__ __forceinline__ float wave_sum(float v) {
#pragma unroll
    for (int o = 1; o < 64; o <<= 1) v += __shfl_xor(v, o);
    return v;
}
__device__ __forceinline__ void rms_body(int gw, int ngw, int lane, const float* __restrict__ x, bf16_t* __restrict__ out, int nrows) {
    for (int row = gw; row < nrows; row += ngw) {
        const f32x4* xr = (const f32x4*)(x + (size_t)row * DM) + lane; f32x4 v[4]; float s = 0.f;
#pragma unroll
        for (int j = 0; j < 4; ++j) { v[j] = xr[64 * j]; s += v[j].x * v[j].x + v[j].y * v[j].y + v[j].z * v[j].z + v[j].w * v[j].w; }
        const float rstd = 1.0f / sqrtf(wave_sum(s) * (1.f / DM) + EPS);
        u32x2* o = (u32x2*)(out + (size_t)row * DM) + lane;
#pragma unroll
        for (int j = 0; j < 4; ++j) { u32x2 w; w.x = pk2(v[j].x * rstd, v[j].y * rstd); w.y = pk2(v[j].z * rstd, v[j].w * rstd); o[64 * j] = w; }
    }
}

struct GUnit { const char* a; const char* b; int row0, col0, e, valid, aux; };

template <class Sched, class Epi>
__device__ __forceinline__ void sgemm_body(unsigned char* lds, const Sched& S, const Epi& E) {
    const int tid = threadIdx.x, wid = tid >> 6, lane = tid & 63, wr = wid >> 2, wc = wid & 3, fr = lane & 15, fq = lane >> 4;
    unsigned char* SA = lds; unsigned char* SB = lds + 16384;
    GUnit u;
    for (int i = 0; S.next(i, u); ++i) {
        f32x4 acc[2][2][4][2];
#pragma unroll
        for (int a = 0; a < 2; ++a)
#pragma unroll
            for (int b = 0; b < 2; ++b)
#pragma unroll
                for (int m = 0; m < 4; ++m)
#pragma unroll
                    for (int n = 0; n < 2; ++n) acc[a][b][m][n] = (f32x4){0.f, 0.f, 0.f, 0.f};
        unsigned aoff[2], boff[2];
#pragma unroll
        for (int p = 0; p < 2; ++p) { const int b = tid * 16 + p * 8192, r = b >> 6, c = (b & 63) >> 1; aoff[p] = S.a_off(u, r) + c * 2; boff[p] = r * S.ldb + c * 2; }
        const int nk = S.K / 32;
        for (int kt = 0; kt < nk; ++kt) {
            u32x4 ra[2], rb[2];
#pragma unroll
            for (int p = 0; p < 2; ++p) { ra[p] = *(const u32x4*)(u.a + aoff[p] + kt * 64); rb[p] = *(const u32x4*)(u.b + boff[p] + kt * 64); }
#pragma unroll
            for (int p = 0; p < 2; ++p) { *(u32x4*)(SA + tid * 16 + p * 8192) = ra[p]; *(u32x4*)(SB + tid * 16 + p * 8192) = rb[p]; }
            __syncthreads();
            bf16x8 Af[2][4], Bf[2][2];
#pragma unroll
            for (int ai = 0; ai < 2; ++ai)
#pragma unroll
                for (int m = 0; m < 4; ++m) Af[ai][m] = *(const bf16x8*)(SA + (128 * ai + 64 * wr + 16 * m + fr) * 64 + fq * 16);
#pragma unroll
            for (int bj = 0; bj < 2; ++bj)
#pragma unroll
                for (int n = 0; n < 2; ++n) Bf[bj][n] = *(const bf16x8*)(SB + (128 * bj + 32 * wc + 16 * n + fr) * 64 + fq * 16);
#pragma unroll
            for (int ai = 0; ai < 2; ++ai)
#pragma unroll
                for (int bj = 0; bj < 2; ++bj)
#pragma unroll
                    for (int m = 0; m < 4; ++m)
#pragma unroll
                        for (int n = 0; n < 2; ++n) acc[ai][bj][m][n] = __builtin_amdgcn_mfma_f32_16x16x32_bf16(Bf[bj][n], Af[ai][m], acc[ai][bj][m][n], 0, 0, 0);
            __syncthreads();
        }
        E(acc, u, wr, wc, fr, fq);
    }
}
__host__ __device__ __forceinline__ int lds_byte(int r, int c) { const int st = (r >> 4) * 2 + (c >> 5), rr = r & 15, cc = c & 31, ob = rr * 64 + cc * 2; return st * 1024 + (ob ^ (((ob >> 9) & 1) << 5)); }
__host__ __device__ __forceinline__ void stage_rc(int b, int& R, int& C) { const int st = b / 1024, sb = b % 1024, swz = sb ^ (((sb >> 9) & 1) << 5); R = (st >> 1) * 16 + swz / 64; C = (st & 1) * 32 + (swz % 64) / 2; }
constexpr int HTB = 128 * 64 * 2;
template <class Sched, class Epi, bool ALIGN_EPI>
__device__ __forceinline__ void gemm_phase(unsigned char* lds_flat, const Sched& S, const Epi& E) {
    LDSP unsigned char* lds = (LDSP unsigned char*)(unsigned)(uintptr_t)lds_flat;
    int tid = threadIdx.x; LAUNDER(tid);
    const int wid = __builtin_amdgcn_readfirstlane(tid >> 6), lane = tid & 63, wr = wid >> 2, wc = wid & 3, fr = lane & 15, fq = lane >> 4;
    const int nt = S.K / 64;
    int Rr[2], Cc[2];
#pragma unroll
    for (int i = 0; i < 2; ++i) stage_rc(tid * 16 + i * 8192, Rr[i], Cc[i]);
    unsigned voffB[2][2];
#pragma unroll
    for (int h = 0; h < 2; ++h)
#pragma unroll
        for (int i = 0; i < 2; ++i) voffB[h][i] = (unsigned)(128 * h + Rr[i]) * S.ldb + (unsigned)Cc[i] * 2u;
    const unsigned ldsw = (unsigned)wid * 1024u;
    const int aoff = lds_byte(wr * 64 + fr, fq * 8), boff = lds_byte(wc * 32 + fr, fq * 8);
#define PG8_SA(b, h) (((b) * 2 + (h)) * HTB)
#define PG8_SB(b, h) ((4 + (b) * 2 + (h)) * HTB)
#define PG8_STAGE(bufoff, gbase, voff, kb) do { _Pragma("unroll") for (int _i = 0; _i < 2; ++_i) \
        __builtin_amdgcn_global_load_lds((const unsigned*)((gbase) + (size_t)(voff)[_i] + (size_t)(kb)), (LDSP unsigned*)(lds + (bufoff) + ldsw + _i * 8192), 16, 0, 0); } while (0)
#define PG8_LDA(dst, b, h) do { _Pragma("unroll") for (int m = 0; m < 4; ++m) _Pragma("unroll") for (int k = 0; k < 2; ++k) dst[m][k] = *(const LDSP bf16x8*)(lds + PG8_SA(b, h) + aoff + m * 2048 + k * 1024); } while (0)
#define PG8_LDB(dst, b, h) do { _Pragma("unroll") for (int n = 0; n < 2; ++n) _Pragma("unroll") for (int k = 0; k < 2; ++k) dst[n][k] = *(const LDSP bf16x8*)(lds + PG8_SB(b, h) + boff + n * 2048 + k * 1024); } while (0)
#define PG8_MMA(ai, bj, At, Bt) do { __builtin_amdgcn_s_setprio(1); _Pragma("unroll") for (int m = 0; m < 4; ++m) _Pragma("unroll") for (int n = 0; n < 2; ++n) _Pragma("unroll") for (int k = 0; k < 2; ++k) \
        acc[ai][bj][m][n] = __builtin_amdgcn_mfma_f32_16x16x32_bf16(Bt[n][k], At[m][k], acc[ai][bj][m][n], 0, 0, 0); __builtin_amdgcn_s_setprio(0); } while (0)
#define PG8_WAIT_V(n) asm volatile("s_waitcnt vmcnt(" #n ")" ::: "memory")
#define PG8_WAIT_L(n) asm volatile("s_waitcnt lgkmcnt(" #n ")" ::: "memory")
#define PG8_BAR __builtin_amdgcn_s_barrier()
#define PG8_SCHED __builtin_amdgcn_sched_barrier(0)
    GUnit cur, nxt; int ui = 0;
    if (!S.next(0, cur)) return;
    unsigned oc[2][2], on[2][2];
#pragma unroll
    for (int h = 0; h < 2; ++h)
#pragma unroll
        for (int i = 0; i < 2; ++i) oc[h][i] = S.a_off(cur, 128 * h + Rr[i]) + (unsigned)Cc[i] * 2u;
    f32x4 acc[2][2][4][2];
#pragma unroll
    for (int a = 0; a < 2; ++a)
#pragma unroll
        for (int b = 0; b < 2; ++b)
#pragma unroll
            for (int m = 0; m < 4; ++m)
#pragma unroll
                for (int n = 0; n < 2; ++n) acc[a][b][m][n] = (f32x4){0.f, 0.f, 0.f, 0.f};
    bf16x8 At[4][2], B0[2][2], B1[2][2];
    const size_t kstep = 128;
    PG8_STAGE(PG8_SB(0, 0), cur.b, voffB[0], 0); PG8_STAGE(PG8_SB(0, 1), cur.b, voffB[1], 0); PG8_STAGE(PG8_SA(0, 0), cur.a, oc[0], 0); PG8_STAGE(PG8_SA(0, 1), cur.a, oc[1], 0);
    if (wr == 1) PG8_BAR;
    PG8_WAIT_V(2); PG8_BAR;
    PG8_STAGE(PG8_SB(1, 0), cur.b, voffB[0], kstep); PG8_STAGE(PG8_SA(1, 0), cur.a, oc[0], kstep); PG8_STAGE(PG8_SB(1, 1), cur.b, voffB[1], kstep);
    PG8_WAIT_V(6); PG8_BAR;
    for (;;) {
        const bool has_next = S.next(ui + 1, nxt);
        const char* nA = has_next ? nxt.a : cur.a; const char* nB = has_next ? nxt.b : cur.b;
#pragma unroll
        for (int h = 0; h < 2; ++h)
#pragma unroll
            for (int i = 0; i < 2; ++i) on[h][i] = has_next ? (S.a_off(nxt, 128 * h + Rr[i]) + (unsigned)Cc[i] * 2u) : oc[h][i];
        for (int t = 0; t < nt; t += 2) {
            const bool last = (t == nt - 2);
            const size_t k1 = (size_t)(t + 1) * kstep;
            const char* pA2 = last ? nA : cur.a; const char* pB2 = last ? nB : cur.b; const size_t k2 = last ? 0 : (size_t)(t + 2) * kstep, k3 = k2 + kstep;
            unsigned o2[2][2];
#pragma unroll
            for (int h = 0; h < 2; ++h)
#pragma unroll
                for (int i = 0; i < 2; ++i) o2[h][i] = last ? on[h][i] : oc[h][i];
            PG8_LDB(B0, 0, 0); PG8_LDB(B1, 0, 1); PG8_SCHED; PG8_LDA(At, 0, 0); PG8_STAGE(PG8_SA(1, 1), cur.a, oc[1], k1);
            PG8_WAIT_V(8); PG8_WAIT_L(0); PG8_BAR; PG8_MMA(0, 0, At, B0); PG8_MMA(0, 1, At, B1); PG8_BAR; PG8_SCHED;
            PG8_LDA(At, 0, 1); PG8_STAGE(PG8_SB(0, 0), pB2, voffB[0], k2); PG8_STAGE(PG8_SB(0, 1), pB2, voffB[1], k2); PG8_STAGE(PG8_SA(0, 0), pA2, o2[0], k2);
            PG8_WAIT_V(8); PG8_WAIT_L(0); PG8_BAR; PG8_MMA(1, 0, At, B0); PG8_MMA(1, 1, At, B1); PG8_BAR; PG8_SCHED;
            PG8_LDB(B0, 1, 0); PG8_LDB(B1, 1, 1); PG8_SCHED; PG8_LDA(At, 1, 0); PG8_STAGE(PG8_SA(0, 1), pA2, o2[1], k2);
            PG8_WAIT_V(8); PG8_WAIT_L(0); PG8_BAR; PG8_MMA(0, 0, At, B0); PG8_MMA(0, 1, At, B1); PG8_BAR; PG8_SCHED;
            PG8_LDA(At, 1, 1); PG8_STAGE(PG8_SB(1, 0), pB2, voffB[0], k3); PG8_STAGE(PG8_SB(1, 1), pB2, voffB[1], k3); PG8_STAGE(PG8_SA(1, 0), pA2, o2[0], k3);
            PG8_WAIT_V(8); PG8_WAIT_L(0); PG8_BAR; PG8_MMA(1, 0, At, B0); PG8_MMA(1, 1, At, B1); PG8_BAR; PG8_SCHED;
        }
        if constexpr (ALIGN_EPI) { if (wr == 0) PG8_BAR; }
        if constexpr (!Epi::AFTER_DRAIN) E(acc, cur, wr, wc, fr, fq);
        if (!has_next) break;
#pragma unroll
        for (int a = 0; a < 2; ++a)
#pragma unroll
            for (int b = 0; b < 2; ++b)
#pragma unroll
                for (int m = 0; m < 4; ++m)
#pragma unroll
                    for (int n = 0; n < 2; ++n) acc[a][b][m][n] = (f32x4){0.f, 0.f, 0.f, 0.f};
        cur = nxt; ++ui;
#pragma unroll
        for (int h = 0; h < 2; ++h)
#pragma unroll
            for (int i = 0; i < 2; ++i) oc[h][i] = on[h][i];
        if constexpr (ALIGN_EPI) { if (wr == 1) PG8_BAR; }
    }
    PG8_WAIT_V(0);
    if constexpr (!ALIGN_EPI) { if (wr == 0) PG8_BAR; }
    PG8_BAR;
    if constexpr (Epi::AFTER_DRAIN) E.fused(acc, cur, wr, wc, fr, fq, lds_flat, wid, lane);
#undef PG8_SA
#undef PG8_SB
#undef PG8_STAGE
#undef PG8_LDA
#undef PG8_LDB
#undef PG8_MMA
#undef PG8_WAIT_V
#undef PG8_WAIT_L
#undef PG8_BAR
#undef PG8_SCHED
}
#ifndef USE_SIMPLE_GEMM
#define USE_SIMPLE_GEMM 0
#endif
template <bool ALIGN, class Sched, class Epi> __device__ __forceinline__ void gemm_run(unsigned char* lds, const Sched& S, const Epi& E) {
#if USE_SIMPLE_GEMM
    sgemm_body(lds, S, E);
#else
    gemm_phase<Sched, Epi, ALIGN>(lds, S, E);
#endif
}
#define EPI_ROWS(r) for (int ai = 0; ai < 2; ++ai) for (int m = 0; m < 4; ++m) { const int r = 128 * ai + 64 * wr + 16 * m + fr;
#define EPI_COLS(c) for (int bj = 0; bj < 2; ++bj) for (int n = 0; n < 2; ++n) { const int c = 128 * bj + 32 * wc + 16 * n + 4 * fq; const f32x4 v = acc[ai][bj][m][n];
#define EPI_END }

struct DenseSched {
    const char* A; const char* Bt; unsigned lda, ldb; int K; int nM, nN; int pm_per_b; size_t zB; int G, c;
    __device__ __forceinline__ bool next(int i, GUnit& u) const {
        const long L = (long)i * G + c; if (c < 0 || L >= (long)nM * nN) return false;
        const int pm = (int)(L / nN), pn = (int)(L % nN);
        u.a = A + (size_t)pm * 256 * lda; u.b = Bt + (size_t)(pm / pm_per_b) * zB + (size_t)pn * 256 * ldb; u.row0 = pm * 256; u.col0 = pn * 256; u.e = 0; u.valid = 256; u.aux = 0; return true;
    }
    __device__ __forceinline__ unsigned a_off(const GUnit&, int r) const { return (unsigned)r * lda; }
};
struct SchedWqk {
    const char* kv; const char* wq; unsigned lda, ldb; int K; int G, c, pad;
    __device__ __forceinline__ bool next(int i, GUnit& u) const {
        const int L = i * G + c; if (c < 0 || L >= 32) return false; const int z = L >> 2, pn = L & 3, b = z >> 2, h = z & 3;
        u.a = kv + (size_t)b * 256 * 4096 + h * 512; u.b = wq + (size_t)pn * 256 * 2048 + h * 512; u.row0 = z * 256; u.col0 = pn * 256; u.e = 0; u.valid = 256; u.aux = 0; return true;
    }
    __device__ __forceinline__ unsigned a_off(const GUnit&, int r) const { return (unsigned)r * lda; }
};
struct SchedVo {
    const char* wmo; const char* kv; unsigned lda, ldb; int K; int G, c, pad;
    __device__ __forceinline__ bool next(int i, GUnit& u) const {
        const int L = i * G + c; if (c < 0 || L >= 32) return false; const int z = L >> 2, pm = L & 3, b = z >> 2, h = z & 3;
        u.a = wmo + (size_t)pm * 256 * 2048 + h * 512; u.b = kv + (size_t)b * 256 * 4096 + 2048 + h * 512; u.row0 = b * 1024 + pm * 256; u.col0 = h * 256; u.e = 0; u.valid = 256; u.aux = 0; return true;
    }
    __device__ __forceinline__ unsigned a_off(const GUnit&, int r) const { return (unsigned)r * lda; }
};
struct MoeSched {
    const char* A; const char* Bt; unsigned lda, ldb; int K; int nN; size_t zB;
    const int* cnt; const int* list; int gather; int G, c, pad;
    __device__ __forceinline__ bool next(int i, GUnit& u) const {
        const int L = i * G + c; const int T = L / nN, pn = L % nN;
        int tiles = 0, start = 0;
        for (int e = 0; e < NEXP; ++e) { const int ce = cnt[e]; const int te = (ce + 255) >> 8;
            if (T < tiles + te) { const int rt = T - tiles; u.e = e; u.valid = min(256, ce - rt * 256); u.row0 = start + rt * 256; u.col0 = pn * 256; u.aux = rt * 256;
                u.a = gather ? A : A + (size_t)u.row0 * lda; u.b = Bt + (size_t)e * zB + (size_t)pn * 256 * ldb; return true; }
            tiles += te; start += ce; }
        return false;
    }
    __device__ __forceinline__ unsigned a_off(const GUnit& u, int r) const {
        if (!gather) return (unsigned)r * lda;
        const int rr = r < u.valid ? r : 0; const int tok = list[u.e * NTOK + u.aux + rr]; return (unsigned)tok * lda;
    }
};

struct EpiBf16 { static constexpr bool AFTER_DRAIN = false; bf16_t* O; int ldc, pad;
    __device__ __forceinline__ void operator()(const f32x4 (&acc)[2][2][4][2], const GUnit& u, int wr, int wc, int fr, int fq) const {
        EPI_ROWS(r) EPI_COLS(c) u32x2 w; w.x = pk2(v[0], v[1]); w.y = pk2(v[2], v[3]); *(u32x2*)(O + (size_t)(u.row0 + r) * ldc + u.col0 + c) = w; EPI_END EPI_END } };
struct EpiF32 { static constexpr bool AFTER_DRAIN = false; float* O; int ldc, pad;
    __device__ __forceinline__ void operator()(const f32x4 (&acc)[2][2][4][2], const GUnit& u, int wr, int wc, int fr, int fq) const {
        EPI_ROWS(r) EPI_COLS(c) *(f32x4*)(O + (size_t)(u.row0 + r) * ldc + u.col0 + c) = v; EPI_END EPI_END } };
struct EpiResid { static constexpr bool AFTER_DRAIN = false; const float* base; float* out; int ldc, pad;
    __device__ __forceinline__ void operator()(const f32x4 (&acc)[2][2][4][2], const GUnit& u, int wr, int wc, int fr, int fq) const {
        EPI_ROWS(r) EPI_COLS(c) const size_t o = (size_t)(u.row0 + r) * ldc + u.col0 + c; *(f32x4*)(out + o) = *(const f32x4*)(base + o) + v; EPI_END EPI_END } };
struct EpiGU { static constexpr bool AFTER_DRAIN = false; const float* bgu; bf16_t* act;
    __device__ __forceinline__ void operator()(const f32x4 (&acc)[2][2][4][2], const GUnit& u, int wr, int wc, int fr, int fq) const {
        const int pn = u.col0 >> 8; const float* bg = bgu + (size_t)u.e * 2048;
        for (int ai = 0; ai < 2; ++ai) for (int m = 0; m < 4; ++m) { const int r = 128 * ai + 64 * wr + 16 * m + fr; if (r >= u.valid) continue;
            for (int n = 0; n < 2; ++n) { const int c = 32 * wc + 16 * n + 4 * fq; const int col = 128 * pn + c;
                const f32x4 g = acc[ai][0][m][n] + *(const f32x4*)(bg + col), l = acc[ai][1][m][n] + *(const f32x4*)(bg + 1024 + col); float o[4];
#pragma unroll
                for (int j = 0; j < 4; ++j) { const float gg = fminf(g[j], 7.0f), ll = fminf(fmaxf(l[j], -7.0f), 7.0f); o[j] = (ll + 1.0f) * (gg / (1.0f + __expf(-1.702f * gg))); }
                u32x2 w; w.x = pk2(o[0], o[1]); w.y = pk2(o[2], o[3]); *(u32x2*)(act + (size_t)(u.row0 + r) * 1024 + col) = w; } } } };
struct EpiDown { static constexpr bool AFTER_DRAIN = false; const float* bdn; bf16_t* ys;
    __device__ __forceinline__ void operator()(const f32x4 (&acc)[2][2][4][2], const GUnit& u, int wr, int wc, int fr, int fq) const {
        const float* bd = bdn + (size_t)u.e * 1024;
        for (int ai = 0; ai < 2; ++ai) for (int m = 0; m < 4; ++m) { const int r = 128 * ai + 64 * wr + 16 * m + fr; if (r >= u.valid) continue;
            EPI_COLS(c) const int col = u.col0 + c; const f32x4 y = v + *(const f32x4*)(bd + col); u32x2 w; w.x = pk2(y[0], y[1]); w.y = pk2(y[2], y[3]); *(u32x2*)(ys + (size_t)(u.row0 + r) * 1024 + col) = w; EPI_END } } };


typedef float f32x16 __attribute__((ext_vector_type(16)));
typedef short s16x4 __attribute__((ext_vector_type(4)));
__device__ __forceinline__ int crow(int r, int hi) { return (r & 3) + 8 * (r >> 2) + 4 * hi; }
__device__ __forceinline__ s16x4 tr_read(const unsigned char* p) { return __builtin_bit_cast(s16x4, __builtin_amdgcn_ds_read_tr16_b64_v4i16((LDSP s16x4*)(unsigned)(uintptr_t)p)); }
__device__ __forceinline__ bf16x8 tr_frag(const unsigned char* img, int pitch, int k0, int f0, int lane) {
    const unsigned char* p = img + (k0 + 8 * (lane >> 5) + ((lane & 15) >> 2)) * pitch + (f0 + 16 * ((lane >> 4) & 1) + 4 * (lane & 3)) * 2;
    const s16x4 lo = tr_read(p), hi = tr_read(p + 4 * pitch);
    return (bf16x8){lo[0], lo[1], lo[2], lo[3], hi[0], hi[1], hi[2], hi[3]};
}
constexpr int GA_PK = 576, GA_PV = 1088;
constexpr int GA_V = 0, GA_PART = 0, GA_GLR = 69632, GA_TOT = 73728, GA_KD = 75776, GA_END = GA_KD + 64 * GA_PK;
__device__ __forceinline__ void gla_pass_a(unsigned char* lds, int task, const bf16_t* __restrict__ xn, const bf16_t* __restrict__ wglr  , const bf16_t* __restrict__ proj,
                                           const float* __restrict__ wg, const float* __restrict__ bg, float* __restrict__ UT, float* __restrict__ decay) {
    int tid = threadIdx.x; LAUNDER(tid); int wid = tid >> 6, lane = tid & 63, fr = lane & 15, fq = lane >> 4;
    const size_t t0 = (size_t)task * 64;
    { f32x4 acc[4];
#pragma unroll
      for (int m = 0; m < 4; ++m) acc[m] = (f32x4){0.f, 0.f, 0.f, 0.f};
#pragma unroll
      for (int ks = 0; ks < 4; ++ks) { const int k = 128 * wid + 32 * ks + 8 * fq; const bf16x8 bfr = *(const bf16x8*)(wglr + (size_t)fr * 1024 + k);
#pragma unroll
          for (int m = 0; m < 4; ++m) { const bf16x8 afr = *(const bf16x8*)(xn + (t0 + 16 * m + fr) * DM + k); acc[m] = __builtin_amdgcn_mfma_f32_16x16x32_bf16(afr, bfr, acc[m], 0, 0, 0); } }
      float* part = (float*)(lds + GA_PART) + wid * 1024;
#pragma unroll
      for (int m = 0; m < 4; ++m)
#pragma unroll
          for (int j = 0; j < 4; ++j) part[(16 * m + 4 * fq + j) * 16 + fr] = acc[m][j]; }
    __syncthreads();
    { float* glr = (float*)(lds + GA_GLR); const float* part = (const float*)(lds + GA_PART);
      for (int i = tid; i < 1024; i += 512) { float s = 0.f;
#pragma unroll
          for (int w = 0; w < 8; ++w) s += part[w * 1024 + i];
          glr[i] = s; } }
    __syncthreads();
    LAUNDER(tid);
    { const int cv = tid & 63, tk = tid >> 6;
#pragma unroll
      for (int i = 0; i < 8; ++i) { const int tok = tk + 8 * i; const u32x4 v = *(const u32x4*)(proj + (t0 + tok) * PROJ_LD + C_VG + cv * 8); *(u32x4*)(lds + GA_V + tok * GA_PV + cv * 16) = v; } }
    LAUNDER(tid);
    { const int j = tid & 255, half = tid >> 8; const float* glr = (const float*)(lds + GA_GLR); float* tot = (float*)(lds + GA_TOT);
      float w[16];
#pragma unroll
      for (int i = 0; i < 16; ++i) w[i] = wg[i * 256 + j];
      const float bj = bg[j]; float run = 0.f;
#pragma unroll 2
      for (int s = 0; s < 32; ++s) { const float* gl = glr + (32 * half + s) * 16; float u = bj;
#pragma unroll
          for (int i = 0; i < 16; ++i) u += gl[i] * w[i];
          const float ls = fminf(u, 0.f) - __logf(1.0f + __expf(-fabsf(u)));
          run += ls * (1.0f / 16.0f); }
      tot[half * 256 + j] = run;
      __syncthreads();
      const float t0v = tot[j], t1v = tot[256 + j]; const float gend = t0v + t1v;
      if (half == 0) decay[(size_t)task * 256 + j] = __expf(gend);
      run = half ? t0v : 0.f;
#pragma unroll 2
      for (int s = 0; s < 32; ++s) { const int tok = 32 * half + s; const float* gl = glr + tok * 16; float u = bj;
#pragma unroll
          for (int i = 0; i < 16; ++i) u += gl[i] * w[i];
          const float ls = fminf(u, 0.f) - __logf(1.0f + __expf(-fabsf(u)));
          run += ls * (1.0f / 16.0f);
          const float kk = bf2f(proj[(t0 + tok) * PROJ_LD + C_KG + j]);
          *(bf16_t*)(lds + GA_KD + tok * GA_PK + j * 2) = (bf16_t)f2bf(kk * __expf(gend - run)); } }
    __syncthreads();
    LAUNDER(tid); wid = __builtin_amdgcn_readfirstlane(tid >> 6); lane = tid & 63;
    { const int h = wid >> 1, nt = wid & 1, hi = lane >> 5, c32 = lane & 31; f32x16 acc[4];
#pragma unroll
      for (int m = 0; m < 4; ++m)
#pragma unroll
          for (int r = 0; r < 16; ++r) acc[m][r] = 0.f;
#pragma unroll
      for (int ks = 0; ks < 4; ++ks) { const bf16x8 bfr = tr_frag(lds + GA_KD, GA_PK, 16 * ks, h * 64 + 32 * nt, lane);
#pragma unroll
          for (int m = 0; m < 4; ++m) { const bf16x8 afr = tr_frag(lds + GA_V, GA_PV, 16 * ks, h * 128 + 32 * m, lane); acc[m] = __builtin_amdgcn_mfma_f32_32x32x16_bf16(afr, bfr, acc[m], 0, 0, 0); } }
      float* u = UT + ((size_t)task * 4 + h) * 8192;
#pragma unroll
      for (int m = 0; m < 4; ++m)
#pragma unroll
          for (int r = 0; r < 16; ++r) u[(32 * m + crow(r, hi)) * 64 + 32 * nt + c32] = acc[m][r]; }
    __syncthreads();
}
__device__ __forceinline__ void gla_pass_b(int e, const float* __restrict__ UT, const float* __restrict__ decay, bf16_t* __restrict__ ST) {
    const int dk = e & 63, dv = (e >> 6) & 127, h = (e >> 13) & 3, b = e >> 15; float s = 0.f;
    const size_t base = ((size_t)b * 128 * 4 + h) * 8192 + dv * 64 + dk; const size_t dbase = (size_t)b * 128 * 256 + h * 64 + dk;
#pragma unroll 8
    for (int c = 0; c < 128; ++c) { const float u = UT[base + (size_t)c * 4 * 8192], d = decay[dbase + (size_t)c * 256]; s = d * s + u; ST[base + (size_t)c * 4 * 8192] = (bf16_t)f2bf(s); }
}
constexpr int GC_PITCH = 520;
__device__ __forceinline__ void gla_pass_c(unsigned char* wlds  , int wtask, const bf16_t* __restrict__ ST, const bf16_t* __restrict__ proj, const float* __restrict__ ghead, bf16_t* __restrict__ mix, int lane) {
    const int nh = wtask & 1, h = (wtask >> 1) & 3, bc = wtask >> 3; const int c32 = lane & 31, hi = lane >> 5;
    const size_t t0 = (size_t)bc * 64 + 32 * nh; const bf16_t* st = ST + ((size_t)bc * 4 + h) * 8192;
    f32x16 acc[4];
#pragma unroll
    for (int m = 0; m < 4; ++m)
#pragma unroll
        for (int r = 0; r < 16; ++r) acc[m][r] = 0.f;
#pragma unroll
    for (int ks = 0; ks < 4; ++ks) { const bf16x8 bfr = *(const bf16x8*)(proj + (t0 + c32) * PROJ_LD + C_QG + h * 64 + 16 * ks + 8 * hi);
#pragma unroll
        for (int m = 0; m < 4; ++m) { const bf16x8 afr = *(const bf16x8*)(st + (32 * m + c32) * 64 + 16 * ks + 8 * hi); acc[m] = __builtin_amdgcn_mfma_f32_32x32x16_bf16(afr, bfr, acc[m], 0, 0, 0); } }
    float ss = 0.f;
#pragma unroll
    for (int m = 0; m < 4; ++m)
#pragma unroll
        for (int r = 0; r < 16; ++r) ss += acc[m][r] * acc[m][r];
    ss += __shfl_xor(ss, 32);
    const float rstd = 1.0f / sqrtf(ss * (1.0f / 128.0f) + EPS);
#pragma unroll
    for (int m = 0; m < 4; ++m)
#pragma unroll
        for (int r = 0; r < 16; ++r) *(float*)(wlds + c32 * GC_PITCH + (32 * m + crow(r, hi)) * 4) = acc[m][r] * rstd;
#pragma unroll
    for (int i = 0; i < 8; ++i) { const int q = lane + 64 * i, tok = q >> 4, dv0 = (q & 15) * 8; const float* src = (const float*)(wlds + tok * GC_PITCH + dv0 * 4);
        const u32x4 rgw = *(const u32x4*)(proj + (t0 + tok) * PROJ_LD + C_RG + h * 128 + dv0); const f32x4 g0 = *(const f32x4*)(ghead + dv0), g1 = *(const f32x4*)(ghead + dv0 + 4);
        const float rg[8] = {bflo(rgw.x), bfhi(rgw.x), bflo(rgw.y), bfhi(rgw.y), bflo(rgw.z), bfhi(rgw.z), bflo(rgw.w), bfhi(rgw.w)}; const float gg[8] = {g0.x, g0.y, g0.z, g0.w, g1.x, g1.y, g1.z, g1.w}; float y[8];
#pragma unroll
        for (int k = 0; k < 8; ++k) y[k] = src[k] * gg[k] * (rg[k] / (1.0f + __expf(-rg[k])));
        u32x4 o; o.x = pk2(y[0], y[1]); o.y = pk2(y[2], y[3]); o.z = pk2(y[4], y[5]); o.w = pk2(y[6], y[7]);
        *(u32x4*)(mix + (t0 + tok) * 1024 + h * 128 + dv0) = o; }
}
__device__ __forceinline__ void sb_task(unsigned char* vl  , int wtask, const bf16_t* __restrict__ proj, bf16_t* __restrict__ mix, int lane) {
    const int qt = wtask & 255, h = (wtask >> 8) & 7, b = wtask >> 11; const int c = lane & 31, hi = lane >> 5;
    const int t0 = qt * 32; const size_t rowb = (size_t)b * SEQ;
    bf16x8 qf[4];
#pragma unroll
    for (int d0 = 0; d0 < 4; ++d0) qf[d0] = *(const bf16x8*)(proj + (rowb + t0 + c) * PROJ_LD + C_QS + h * 64 + 16 * d0 + 8 * hi);
    const int kap = 16 * ((c >> 2) & 1) + (c & 3) + 4 * (c >> 3);
    f32x16 o0, o1;
#pragma unroll
    for (int r = 0; r < 16; ++r) { o0[r] = 0.f; o1[r] = 0.f; }
    float Dc = 1.0f;
    for (int j0 = t0; j0 >= 0; j0 -= 32) {
        const bf16_t* kp = proj + (rowb + j0 + kap) * PROJ_LD + C_KS + h * 64 + 8 * hi;
        bf16x8 kf[4];
#pragma unroll
        for (int d0 = 0; d0 < 4; ++d0) kf[d0] = *(const bf16x8*)(kp + 16 * d0);
#pragma unroll
        for (int i = 0; i < 4; ++i) { const int idx = lane + 64 * i, key = idx >> 3, ch = idx & 7; const u32x4 v = *(const u32x4*)(proj + (rowb + j0 + key) * PROJ_LD + C_VS + h * 64 + ch * 8);
            *(u32x4*)(vl + (ch >> 2) * 2048 + key * 64 + (ch & 3) * 16) = v; }
        f32x16 z;
#pragma unroll
        for (int r = 0; r < 16; ++r) z[r] = 0.f;
#pragma unroll
        for (int d0 = 0; d0 < 4; ++d0) z = __builtin_amdgcn_mfma_f32_32x32x16_bf16(kf[d0], qf[d0], z, 0, 0, 0);
        float e[16], Dl[16];
        const bool diag = (j0 == t0);
#pragma unroll
        for (int r = 0; r < 16; ++r) { float ev = __builtin_amdgcn_exp2f(fminf(z[r], 126.0f)); if (diag && (16 * hi + r >= c)) ev = 0.f; e[r] = ev; }
        float D = hi ? Dc : 1.0f;
#pragma unroll
        for (int r = 15; r >= 0; --r) { D = fmaf(D, e[r], D); Dl[r] = D; }
        const float other = __shfl_xor(D, 32);
        const float mult = hi ? 1.0f : other;
        Dc = D * other;
        unsigned pw[8];
#pragma unroll
        for (int r = 0; r < 16; r += 2) { const float a0 = e[r] * __builtin_amdgcn_rcpf(Dl[r] * mult), a1 = e[r + 1] * __builtin_amdgcn_rcpf(Dl[r + 1] * mult); pw[r >> 1] = pk2(a0, a1); }
#pragma unroll
        for (int ks = 0; ks < 2; ++ks) { const bf16x8 pa = __builtin_bit_cast(bf16x8, (u32x4){pw[4 * ks], pw[4 * ks + 1], pw[4 * ks + 2], pw[4 * ks + 3]});
            const unsigned char* vb = vl + (16 * hi + 8 * ks + ((lane & 15) >> 2)) * 64 + (16 * ((lane >> 4) & 1) + 4 * (lane & 3)) * 2;
            { const s16x4 lo = tr_read(vb), hh = tr_read(vb + 256); o0 = __builtin_amdgcn_mfma_f32_32x32x16_bf16(pa, (bf16x8){lo[0], lo[1], lo[2], lo[3], hh[0], hh[1], hh[2], hh[3]}, o0, 0, 0, 0); }
            { const s16x4 lo = tr_read(vb + 2048), hh = tr_read(vb + 2048 + 256); o1 = __builtin_amdgcn_mfma_f32_32x32x16_bf16(pa, (bf16x8){lo[0], lo[1], lo[2], lo[3], hh[0], hh[1], hh[2], hh[3]}, o1, 0, 0, 0); } }
        if (__all(!(Dc < 3.0e38f))) break;
    }
    bf16_t* ob = mix + (rowb + t0) * 1024 + 512 + h * 64 + c;
#pragma unroll
    for (int r = 0; r < 16; ++r) { const int q = crow(r, hi); ob[(size_t)q * 1024] = (bf16_t)f2bf(o0[r]); ob[(size_t)q * 1024 + 32] = (bf16_t)f2bf(o1[r]); }
}
__device__ __forceinline__ void softmax_task(int gw, int lane, const float* __restrict__ S, bf16_t* __restrict__ P) {
    const f32x4 v = *((const f32x4*)(S + (size_t)gw * 256) + lane);
    float m = fmaxf(fmaxf(v.x, v.y), fmaxf(v.z, v.w));
#pragma unroll
    for (int o = 1; o < 64; o <<= 1) m = fmaxf(m, __shfl_xor(m, o));
    const float e0 = exp2f(v.x - m), e1 = exp2f(v.y - m), e2 = exp2f(v.z - m), e3 = exp2f(v.w - m);
    const float inv = 1.0f / wave_sum(e0 + e1 + e2 + e3);
    u32x2 w; w.x = pk2(e0 * inv, e1 * inv); w.y = pk2(e2 * inv, e3 * inv); *((u32x2*)(P + (size_t)gw * 256) + lane) = w;
}
__device__ __forceinline__ void router_logit(int idx, const bf16_t* __restrict__ xn, const bf16_t* __restrict__ wr, const float* __restrict__ br, float* __restrict__ lg) {
    const int t = idx >> 5, e = idx & 31; const u32x4* a = (const u32x4*)(xn + (size_t)t * DM); const u32x4* w = (const u32x4*)(wr + (size_t)e * DM); float s = 0.f;
    for (int i = 0; i < DM / 8; ++i) { const u32x4 x = a[i], y = w[i];
        s += bflo(x.x) * bflo(y.x) + bfhi(x.x) * bfhi(y.x) + bflo(x.y) * bflo(y.y) + bfhi(x.y) * bfhi(y.y) + bflo(x.z) * bflo(y.z) + bfhi(x.z) * bfhi(y.z) + bflo(x.w) * bflo(y.w) + bfhi(x.w) * bfhi(y.w); }
    lg[idx] = s + br[e];
}
__device__ __forceinline__ void router_topk(int t, const float* __restrict__ lg, int* __restrict__ cnt, int* __restrict__ list, int* __restrict__ toke, int* __restrict__ tokr, float* __restrict__ tokw) {
    float v[NEXP];
#pragma unroll
    for (int e = 0; e < NEXP; ++e) v[e] = lg[(size_t)t * NEXP + e];
    float tv[4]; int ti[4];
#pragma unroll
    for (int k = 0; k < 4; ++k) { float best = -INFINITY; int bi = 0;
#pragma unroll
        for (int e = 0; e < NEXP; ++e) { if (v[e] > best) { best = v[e]; bi = e; } }
        tv[k] = best; ti[k] = bi;
#pragma unroll
        for (int e = 0; e < NEXP; ++e) if (e == bi) v[e] = -INFINITY; }
    const float e1 = __expf(tv[1] - tv[0]), e2 = __expf(tv[2] - tv[0]), e3 = __expf(tv[3] - tv[0]); const float inv = 1.0f / (1.0f + e1 + e2 + e3);
    const float g[4] = {inv, e1 * inv, e2 * inv, e3 * inv};
#pragma unroll
    for (int k = 0; k < 4; ++k) { const int r = atomicAdd(&cnt[ti[k]], 1); list[ti[k] * NTOK + r] = t; toke[t * 4 + k] = ti[k]; tokr[t * 4 + k] = r; tokw[t * 4 + k] = g[k]; }
}
__device__ __forceinline__ void combine_task(int t, int lane, float* __restrict__ xio, const bf16_t* __restrict__ ys, const int* __restrict__ cnt, const int* __restrict__ toke, const int* __restrict__ tokr,
                                                 const float* __restrict__ tokw, const float* __restrict__ gfin) {
    f32x4* xr = (f32x4*)(xio + (size_t)t * DM) + lane; f32x4 v[4];
#pragma unroll
    for (int j = 0; j < 4; ++j) v[j] = xr[64 * j];
    for (int k = 0; k < 4; ++k) { const int e = toke[t * 4 + k], r = tokr[t * 4 + k]; const float w = tokw[t * 4 + k]; int start = 0; for (int i = 0; i < e; ++i) start += cnt[i];
        const u32x2* yr = (const u32x2*)(ys + (size_t)(start + r) * DM) + lane;
#pragma unroll
        for (int j = 0; j < 4; ++j) { const u32x2 y = yr[64 * j]; v[j].x += w * bflo(y.x); v[j].y += w * bfhi(y.x); v[j].z += w * bflo(y.y); v[j].w += w * bfhi(y.y); } }
    float s = 0.f;
#pragma unroll
    for (int j = 0; j < 4; ++j) s += v[j].x * v[j].x + v[j].y * v[j].y + v[j].z * v[j].z + v[j].w * v[j].w;
    const float rstd = 1.0f / sqrtf(wave_sum(s) * (1.f / DM) + EPS);
#pragma unroll
    for (int j = 0; j < 4; ++j) { const f32x4 g = *((const f32x4*)gfin + lane + 64 * j); xr[64 * j] = v[j] * rstd * g; }
}

#define GAS __attribute__((address_space(1)))
#define RLX_AGENT __ATOMIC_RELAXED, __HIP_MEMORY_SCOPE_AGENT
#define XB_TMO      128
#define XB_XCNT(j)  (256  + 64 * (j))
#define XB_XSUB(j)  (1280 + 64 * (j))
#define XB_XGEN(j)  (2304 + 64 * (j))
#define XB_TOP      3328
#define XB_TOPGEN   3392
#define XCD_BAR_WORDS 3456
#define XB_SPIN_CAP (1u << 18)
__device__ __forceinline__ unsigned xb_ld(unsigned* p)              { return __hip_atomic_load(p, __ATOMIC_RELAXED, __HIP_MEMORY_SCOPE_AGENT); }
__device__ __forceinline__ unsigned xb_add(unsigned* p, unsigned v) { return __hip_atomic_fetch_add(p, v, __ATOMIC_RELAXED, __HIP_MEMORY_SCOPE_AGENT); }
__device__ __forceinline__ unsigned xb_xcc_id() { return (unsigned)__builtin_amdgcn_s_getreg((3 << 11) | 20) & 0xFu; }
#define XB_SPIN(cond, bar) do { unsigned _sp = 0; while (cond) { __builtin_amdgcn_s_sleep(1); \
    if ((++_sp & 255u) == 0u) { if (xb_ld(&(bar)[XB_TMO])) break; if (_sp > XB_SPIN_CAP) { atomicAdd(&(bar)[XB_TMO], 1u); break; } } } } while (0)
struct XcdBarrier { unsigned* bar; unsigned x; volatile LDSP unsigned* st; };
__device__ __forceinline__ XcdBarrier xcd_barrier_post(unsigned* bar, volatile LDSP unsigned* st) {
    XcdBarrier b; b.bar = bar; b.x = xb_xcc_id(); b.st = st;
    if (threadIdx.x == 0) (void)xb_add(&bar[XB_XCNT(b.x)], 1u);
    return b;
}
__device__ __forceinline__ void xcd_barrier_complete(unsigned* bar, unsigned x, unsigned& nloc, unsigned& nx) {
    const unsigned G = gridDim.x * gridDim.y * gridDim.z;
    unsigned sum, cnt, mine, sp = 0u;
    for (;;) {
        sum = 0u; cnt = 0u; mine = 0u;
#pragma unroll
        for (unsigned j = 0; j < 16; ++j) { const unsigned c = xb_ld(&bar[XB_XCNT(j)]); sum += c; cnt += (c > 0u) ? 1u : 0u; mine = (j == x) ? c : mine; }
        if (sum == G) break;
        __builtin_amdgcn_s_sleep(1);
        if ((++sp & 255u) == 0u) { if (xb_ld(&bar[XB_TMO])) break; if (sp > XB_SPIN_CAP) { atomicAdd(&bar[XB_TMO], 1u); break; } }
    }
    nloc = mine > 0u ? mine : 1u; nx = cnt > 0u ? cnt : 1u;
}
__device__ __forceinline__ void xcd_barrier(const XcdBarrier& b) {
    asm volatile("s_waitcnt vmcnt(0)" ::: "memory");
    __syncthreads();
    if (threadIdx.x == 0) {
        unsigned* bar = b.bar;
        __builtin_amdgcn_s_waitcnt(0);
        unsigned nloc = b.st[0], nx = b.st[1];
        if (nloc == 0u) { xcd_barrier_complete(bar, b.x, nloc, nx); b.st[0] = nloc; b.st[1] = nx; }
        const unsigned old = xb_add(&bar[XB_XSUB(b.x)], 1u);
        const unsigned gen = old / nloc;
        if (old + 1u == (gen + 1u) * nloc) {
            __builtin_amdgcn_fence(__ATOMIC_RELEASE, "agent");
            asm volatile("s_waitcnt vmcnt(0)" ::: "memory");
            const unsigned og = xb_add(&bar[XB_TOP], 1u);
            const unsigned tg = og / nx;
            if (og + 1u == (tg + 1u) * nx) xb_add(&bar[XB_TOPGEN], 1u);
            else XB_SPIN(xb_ld(&bar[XB_TOPGEN]) == tg, bar);
            __builtin_amdgcn_fence(__ATOMIC_ACQUIRE, "agent");
            xb_add(&bar[XB_XGEN(b.x)], 1u);
            asm volatile("s_waitcnt vmcnt(0)" ::: "memory");
        } else {
            XB_SPIN(xb_ld(&bar[XB_XGEN(b.x)]) == gen, bar);
            __builtin_amdgcn_fence(__ATOMIC_ACQUIRE, "agent");
            asm volatile("s_waitcnt vmcnt(0)" ::: "memory");
        }
    }
    __syncthreads();
}

constexpr int LDS_BYTES = 147456;
constexpr int MISC_OFF = LDS_BYTES - 512;
constexpr int CW_BAR = 4096;
constexpr size_t CTL_ZERO_BYTES = 65536;
constexpr int NPHASE = 16;
struct Args { const float* in[22]; float* out; unsigned char* ws; int ph_lo, ph_hi; };

__global__ void __launch_bounds__(512, 2) mega(Args a) {
    extern __shared__ __attribute__((aligned(16))) unsigned char lds[];
    unsigned char* ws = a.ws; float* out = a.out;
    const float* x = a.in[0]; const float* mem = a.in[1]; const float* g_mix = a.in[2]; const float* w_in = a.in[3];
    const float* w_gla_gate = a.in[4]; const float* b_gla_gate = a.in[5]; const float* g_gla_head = a.in[6]; const float* w_out = a.in[7];
    const float* g_mem_q = a.in[8]; const float* g_mem_kv = a.in[9]; const float* w_mq = a.in[10]; const float* w_mk = a.in[11];
    const float* w_mv = a.in[12]; const float* w_mo = a.in[13]; const float* g_ffn = a.in[14]; const float* w_router = a.in[15];
    const float* b_router = a.in[16]; const float* w_gu = a.in[17]; const float* b_gu = a.in[18]; const float* w_down = a.in[19];
    const float* b_down = a.in[20]; const float* g_final = a.in[21];
    bf16_t* Wt_in = (bf16_t*)(ws + WS_WIN); bf16_t* Wt_out = (bf16_t*)(ws + WS_WOUT); bf16_t* Wq = (bf16_t*)(ws + WS_WQ); bf16_t* Wt_kv = (bf16_t*)(ws + WS_WKV);
    bf16_t* Wt_mo = (bf16_t*)(ws + WS_WMO); bf16_t* Wt_r = (bf16_t*)(ws + WS_WR); bf16_t* Wt_gu = (bf16_t*)(ws + WS_WGU); bf16_t* Wt_dn = (bf16_t*)(ws + WS_WDN);
    bf16_t* xn = (bf16_t*)(ws + WS_XN); bf16_t* memn = (bf16_t*)(ws + WS_MEMN); bf16_t* kv = (bf16_t*)(ws + WS_KV); bf16_t* Bs = (bf16_t*)(ws + WS_BS); bf16_t* Bo = (bf16_t*)(ws + WS_BO);
    bf16_t* proj = (bf16_t*)(ws + WS_PROJ); bf16_t* mix = (bf16_t*)(ws + WS_MIX);
    float* Sc = (float*)(ws + WS_S); bf16_t* P = (bf16_t*)(ws + WS_P); float* lg = (float*)(ws + WS_LG); int* toke = (int*)(ws + WS_TOKE); int* tokr = (int*)(ws + WS_TOKR);
    float* tokw = (float*)(ws + WS_TOKW); int* list = (int*)(ws + WS_LIST); bf16_t* act = (bf16_t*)(ws + WS_ACT); bf16_t* ys = (bf16_t*)(ws + WS_YS);
    float* UT = (float*)(ws + WS_S); float* decay = (float*)(ws + WS_LA); bf16_t* ST = (bf16_t*)(ws + WS_ORAW);
    unsigned* ctl = (unsigned*)(ws + WS_CTL); int* cnt = (int*)ctl + CW_CNT;

    const int G = gridDim.x, vb = blockIdx.x;
    volatile LDSP unsigned* MISC = (volatile LDSP unsigned*)(unsigned)(uintptr_t)(lds + MISC_OFF);
    if (threadIdx.x < 128) MISC[threadIdx.x] = 0u;
    __syncthreads();
    XcdBarrier bar = xcd_barrier_post(ctl + CW_BAR, MISC + 8);
    const int lo = a.ph_lo, hi = a.ph_hi;
#define IN(k) (lo <= (k) && (k) < hi)
#define SEAM(k) do { if (IN(k) && IN((k) + 1)) xcd_barrier(bar); } while (0)
#define TIDS() int tid = threadIdx.x; LAUNDER(tid); const int lane = tid & 63; const int wid = __builtin_amdgcn_readfirstlane(tid >> 6); (void)lane; (void)wid

    if (IN(0)) { TIDS(); const size_t gt = (size_t)vb * 512 + tid, gs = (size_t)G * 512;
        conv_t_body<1>(gt, gs, w_in, Wt_in, g_mix, 3088, 1024, 3088, 1, 0, 0);
        conv_t_body<0>(gt, gs, w_out, Wt_out, nullptr, 1024, 1024, 1024, 1, 0, 0);
        conv_n_body(gt, gs, w_mq, Wq, g_mem_q, 1024, 1024, LOG2E / 16.0f);
        conv_t_body<0>(gt, gs, w_mk, Wt_kv, g_mem_kv, 1024, 1024, 1024, 1, 0, 0);
        conv_t_body<0>(gt, gs, w_mv, Wt_kv + (size_t)1024 * 1024, g_mem_kv, 1024, 1024, 1024, 1, 0, 0);
        conv_t_body<0>(gt, gs, w_mo, Wt_mo, nullptr, 1024, 1024, 1024, 1, 0, 0);
        conv_t_body<0>(gt, gs, w_router, Wt_r, g_ffn, 32, 1024, 32, 1, 0, 0);
        conv_t_body<2>(gt, gs, w_gu, Wt_gu, g_ffn, 2048, 1024, 2048, 32, (size_t)1024 * 2048, (size_t)2048 * 1024);
        conv_t_body<0>(gt, gs, w_down, Wt_dn, nullptr, 1024, 1024, 1024, 32, (size_t)1024 * 1024, (size_t)1024 * 1024);
        rms_body(vb * 8 + wid, G * 8, lane, x, xn, NTOK);
        rms_body(vb * 8 + wid, G * 8, lane, mem, memn, NB * MEML); }
    SEAM(0);
    if (IN(1)) { DenseSched S{(const char*)xn, (const char*)Wt_in, 2048u, 2048u, 1024, 64, 12, 1 << 30, 0, G, vb}; EpiBf16 E{proj, PROJ_LD, 0}; gemm_run<true>(lds, S, E); }
    SEAM(1);
    if (IN(2)) {
        for (int t = vb; t < 256; t += G) gla_pass_a(lds, t, xn, Wt_in + (size_t)3072 * 1024, proj, w_gla_gate, b_gla_gate, UT, decay);
        { TIDS(); for (int t = vb * 8 + wid; t < 4096; t += G * 8) sb_task(lds + wid * 4096, t, proj, mix, lane); }
        __syncthreads();
        { DenseSched S{(const char*)memn, (const char*)Wt_kv, 2048u, 2048u, 1024, 2, 8, 1 << 30, 0, G, vb}; EpiBf16 E{kv, 2048, 0}; gemm_run<false>(lds, S, E); } }
    SEAM(2);
    if (IN(3)) {
        { TIDS(); for (int e = vb * 512 + tid; e < 65536; e += G * 512) gla_pass_b(e, UT, decay, ST); }
        { SchedWqk S{(const char*)kv, (const char*)Wq, 4096u, 2048u, 256, G / 2, vb - G / 2, 0}; EpiBf16 E{Bs, 1024, 0}; gemm_run<false>(lds, S, E); }
        { SchedVo S{(const char*)Wt_mo, (const char*)kv, 2048u, 4096u, 256, G / 2, vb - G / 2 - 32, 0}; EpiBf16 E{Bo, 1024, 0}; gemm_run<false>(lds, S, E); } }
    SEAM(3);
    if (IN(4)) { TIDS(); for (int t = vb * 8 + wid; t < 2048; t += G * 8) gla_pass_c(lds + wid * 32 * GC_PITCH, t, ST, proj, g_gla_head, mix, lane); }
    SEAM(4);
    if (IN(5)) { DenseSched S{(const char*)mix, (const char*)Wt_out, 2048u, 2048u, 1024, 64, 4, 1 << 30, 0, G, vb}; EpiResid E{x, out, 1024, 0}; gemm_run<false>(lds, S, E); }
    SEAM(5);
    if (IN(6)) { TIDS(); rms_body(vb * 8 + wid, G * 8, lane, out, xn, NTOK); }
    SEAM(6);
    if (IN(7)) { DenseSched S{(const char*)xn, (const char*)Bs, 2048u, 2048u, 1024, 64, 4, 32, (size_t)1024 * 2048, G, vb}; EpiF32 E{Sc, 1024, 0}; gemm_run<false>(lds, S, E); }
    SEAM(7);
    if (IN(8)) { TIDS(); for (int t = vb * 8 + wid; t < NTOK * 4; t += G * 8) softmax_task(t, lane, Sc, P); }
    SEAM(8);
    if (IN(9)) { DenseSched S{(const char*)P, (const char*)Bo, 2048u, 2048u, 1024, 64, 4, 32, (size_t)1024 * 2048, G, vb}; EpiResid E{out, out, 1024, 0}; gemm_run<false>(lds, S, E); }
    SEAM(9);
    if (IN(10)) { TIDS(); rms_body(vb * 8 + wid, G * 8, lane, out, xn, NTOK); }
    SEAM(10);
    if (IN(11)) { TIDS(); for (int i = vb * 512 + tid; i < NTOK * NEXP; i += G * 512) router_logit(i, xn, Wt_r, b_router, lg); }
    SEAM(11);
    if (IN(12)) { TIDS(); for (int t = vb * 512 + tid; t < NTOK; t += G * 512) router_topk(t, lg, cnt, list, toke, tokr, tokw); }
    SEAM(12);
    if (IN(13)) { MoeSched S{(const char*)xn, (const char*)Wt_gu, 2048u, 2048u, 1024, 8, (size_t)2048 * 2048, cnt, list, 1, G, vb, 0}; EpiGU E{b_gu, act}; gemm_run<true>(lds, S, E); }
    SEAM(13);
    if (IN(14)) { MoeSched S{(const char*)act, (const char*)Wt_dn, 2048u, 2048u, 1024, 4, (size_t)1024 * 2048, cnt, list, 0, G, vb, 0}; EpiDown E{b_down, ys}; gemm_run<true>(lds, S, E); }
    SEAM(14);
    if (IN(15)) { TIDS(); for (int t = vb * 8 + wid; t < NTOK; t += G * 8) combine_task(t, lane, out, ys, cnt, toke, tokr, tokw, g_final); }
#undef IN
#undef SEAM
#undef TIDS
}

#ifndef MK_PER_PHASE
#define MK_PER_PHASE 0
#endif
extern "C" void kernel_launch(void* const* d_in, const int* in_sizes, int n_in, void* d_out, int out_size, void* d_ws, size_t ws_size, hipStream_t stream) {
    static int grid = 0;
    if (grid == 0) {
        if (n_in != 22 || in_sizes[0] != NTOK * DM || out_size != NTOK * DM || ws_size < WS_END) { fprintf(stderr, "kernel_launch: unexpected shapes (n_in %d, ws %zu)\n", n_in, ws_size); grid = -1; return; }
        int dev = 0, cus = 0, per_cu = 0;
        if (hipGetDevice(&dev) != hipSuccess || hipDeviceGetAttribute(&cus, hipDeviceAttributeMultiprocessorCount, dev) != hipSuccess) { grid = -1; return; }
        if (hipFuncSetAttribute((const void*)mega, hipFuncAttributeMaxDynamicSharedMemorySize, LDS_BYTES) != hipSuccess) { fprintf(stderr, "kernel_launch: hipFuncSetAttribute failed\n"); grid = -1; return; }
        if (hipOccupancyMaxActiveBlocksPerMultiprocessor(&per_cu, (const void*)mega, 512, LDS_BYTES) != hipSuccess || per_cu < 1) fprintf(stderr, "kernel_launch: occupancy query says %d blocks/CU\n", per_cu);
        (void)hipGetLastError();
        grid = cus;
    }
    if (grid < 0) return;
    (void)hipMemsetAsync((char*)d_ws + WS_CTL, 0, CTL_ZERO_BYTES, stream);
    Args a{};
    for (int i = 0; i < 22; ++i) a.in[i] = (const float*)d_in[i];
    a.out = (float*)d_out; a.ws = (unsigned char*)d_ws;
#if MK_PER_PHASE
    for (int p = 0; p < NPHASE; ++p) { a.ph_lo = p; a.ph_hi = p + 1; hipLaunchKernelGGL(mega, dim3(grid), dim3(512), LDS_BYTES, stream, a); }
#else
    a.ph_lo = 0; a.ph_hi = NPHASE; hipLaunchKernelGGL(mega, dim3(grid), dim3(512), LDS_BYTES, stream, a);
#endif
}
```

```cpp
#include <hip/hip_runtime.h>
#include <cstdio>
#include <cstdint>
#ifndef PROBE_BARRIERS
#define PROBE_BARRIERS 0
#endif

typedef unsigned short bf16_t;
typedef short bf16x8 __attribute__((ext_vector_type(8)));
typedef float f32x4 __attribute__((ext_vector_type(4)));
typedef unsigned u32x4 __attribute__((ext_vector_type(4)));
typedef unsigned u32x2 __attribute__((ext_vector_type(2)));
#define LDSP __attribute__((address_space(3)))
#define LAUNDER(x) asm volatile("" : "+v"(x))

constexpr int NB = 2, SEQ = 8192, NTOK = NB * SEQ, DM = 1024, MEML = 256;
constexpr int NEXP = 32, TOPK = 4, NASSIGN = NTOK * TOPK;
constexpr int PROJ_LD = 3072;
constexpr int C_QG = 0, C_KG = 256, C_VG = 512, C_RG = 1024, C_QS = 1536, C_KS = 2048, C_VS = 2560, C_GLR = 3072;
constexpr float LOG2E = 1.4426950408889634f;
constexpr float EPS = 1e-5f;

__device__ __forceinline__ unsigned f2bf(float f) { unsigned u = __float_as_uint(f); return (u + 0x7fffu + ((u >> 16) & 1u)) >> 16; }
__device__ __forceinline__ unsigned pk2(float lo, float hi) { return f2bf(lo) | (f2bf(hi) << 16); }
__device__ __forceinline__ float bf2f(bf16_t h) { return __uint_as_float(((unsigned)h) << 16); }
__device__ __forceinline__ float bflo(unsigned w) { return __uint_as_float(w << 16); }
__device__ __forceinline__ float bfhi(unsigned w) { return __uint_as_float(w & 0xffff0000u); }

constexpr size_t MiB = 1u << 20;
constexpr size_t WS_CTL = 0;
constexpr size_t WS_WIN = 1 * MiB;
constexpr size_t WS_WOUT = 8 * MiB;
constexpr size_t WS_WQ = 10 * MiB;
constexpr size_t WS_WKV = 12 * MiB;
constexpr size_t WS_WMO = 16 * MiB;
constexpr size_t WS_WR = 18 * MiB;
constexpr size_t WS_WGU = 20 * MiB;
constexpr size_t WS_WDN = 148 * MiB;
constexpr size_t WS_XN = 212 * MiB;
constexpr size_t WS_MEMN = 244 * MiB;
constexpr size_t WS_KV = 245 * MiB;
constexpr size_t WS_BS = 247 * MiB;
constexpr size_t WS_BO = 251 * MiB;
constexpr size_t WS_PROJ = 256 * MiB;
constexpr size_t WS_LA = 360 * MiB;
constexpr size_t WS_ORAW = 376 * MiB;
constexpr size_t WS_MIX = 408 * MiB;
constexpr size_t WS_S = 440 * MiB;
constexpr size_t WS_P = 504 * MiB;
constexpr size_t WS_LG = 536 * MiB;
constexpr size_t WS_TOKE = 538 * MiB;
constexpr size_t WS_TOKR = 539 * MiB;
constexpr size_t WS_TOKW = 540 * MiB;
constexpr size_t WS_LIST = 541 * MiB;
constexpr size_t WS_ACT = 544 * MiB;
constexpr size_t WS_YS = 674 * MiB;
constexpr size_t WS_DUMMY = 804 * MiB;
constexpr size_t WS_END = 872 * MiB;
constexpr int CW_CNT = 1024;

template <int MAP> __device__ __forceinline__ int srccol(int n, float& sc) {
    sc = 1.f;
    if (MAP == 0) return n;
    if (MAP == 1) {
        if (n < 256) { sc = 0.125f; return n; }
        if (n < 1024) return n;
        if (n < 3072) { if (n >= C_QS && n < C_KS) sc = 0.125f * LOG2E; return n + 16; }
        if (n < 3088) return 1024 + (n - 3072);
        return -1;
    }
    { const int ct = n >> 8, w = n & 255; return (w < 128) ? (128 * ct + w) : (1024 + 128 * ct + (w - 128)); }
}
template <int MAP>
__device__ __forceinline__ void conv_t_body(size_t gtid, size_t gsz, const float* __restrict__ src, bf16_t* __restrict__ dst, const float* __restrict__ gain,
                                               int ldsrc, int K, int nrows, int nmat, size_t sms, size_t dms) {
    const int kc8 = K / 8;
    const size_t total = (size_t)nmat * nrows * kc8;
    for (size_t idx = gtid; idx < total; idx += gsz) {
        const int n = (int)(idx % nrows); const size_t t = idx / nrows; const int kc = (int)(t % kc8); const int mat = (int)(t / kc8);
        float sc; const int c = srccol<MAP>(n, sc);
        u32x4 o = {0u, 0u, 0u, 0u};
        if (c >= 0) {
            const float* s = src + (size_t)mat * sms + (size_t)(kc * 8) * ldsrc + c;
            float v[8];
#pragma unroll
            for (int j = 0; j < 8; ++j) v[j] = s[(size_t)j * ldsrc] * (gain ? gain[kc * 8 + j] : 1.f) * sc;
            o.x = pk2(v[0], v[1]); o.y = pk2(v[2], v[3]); o.z = pk2(v[4], v[5]); o.w = pk2(v[6], v[7]);
        }
        *(u32x4*)(dst + (size_t)mat * dms + (size_t)n * K + kc * 8) = o;
    }
}
template <int MAP>
__device__ __forceinline__ void conv_item(float* scr, const float* __restrict__ src, bf16_t* __restrict__ dst, const float* __restrict__ gain, int ldsrc, int K, int nrows, int kb, int nb, int lane) {
    const int k0 = kb * 64, n0 = nb * 32; float sc; const int c0 = srccol<MAP>(n0, sc);
    const int half = lane >> 5, l31 = lane & 31;
    const float* s0 = src + (size_t)(k0 + half) * ldsrc + c0 + l31;
    float v[32];
#pragma unroll
    for (int i = 0; i < 32; ++i) v[i] = s0[(size_t)(2 * i) * ldsrc];
#pragma unroll
    for (int i = 0; i < 32; ++i) { const int kk = 2 * i + half; const float g = (gain ? gain[k0 + kk] : 1.f) * sc; scr[kk * 33 + l31] = v[i] * g; }
    asm volatile("s_waitcnt lgkmcnt(0)" ::: "memory");
    const int c = lane & 7;
#pragma unroll
    for (int j = 0; j < 4; ++j) { const int n = (lane >> 3) + 8 * j; const float* s = scr + (8 * c) * 33 + n;
        u32x4 o; o.x = pk2(s[0 * 33], s[1 * 33]); o.y = pk2(s[2 * 33], s[3 * 33]); o.z = pk2(s[4 * 33], s[5 * 33]); o.w = pk2(s[6 * 33], s[7 * 33]);
        if (n0 + n < nrows) *(u32x4*)(dst + (size_t)(n0 + n) * K + k0 + 8 * c) = o; }
    asm volatile("s_waitcnt lgkmcnt(0)" ::: "memory");
}
__device__ __forceinline__ unsigned pk4_fp8(float a, float b, float c, float d) { int w = __builtin_amdgcn_cvt_pk_fp8_f32(a, b, 0, false); w = __builtin_amdgcn_cvt_pk_fp8_f32(c, d, w, true); return (unsigned)w; }
template <int MAP>
__device__ __forceinline__ void conv_item8(float* scr, const float* __restrict__ src, unsigned char* __restrict__ dst, const float* __restrict__ gain, int ldsrc, int K, int nrows, int kb, int nb, int lane, float mul) {
    const int k0 = kb * 64, n0 = nb * 32; float sc; const int c0 = srccol<MAP>(n0, sc); sc *= mul;
    const int half = lane >> 5, l31 = lane & 31;
    const float* s0 = src + (size_t)(k0 + half) * ldsrc + c0 + l31;
    float v[32];
#pragma unroll
    for (int i = 0; i < 32; ++i) v[i] = s0[(size_t)(2 * i) * ldsrc];
#pragma unroll
    for (int i = 0; i < 32; ++i) { const int kk = 2 * i + half; const float g = (gain ? gain[k0 + kk] : 1.f) * sc; scr[kk * 33 + l31] = v[i] * g; }
    asm volatile("s_waitcnt lgkmcnt(0)" ::: "memory");
    const int c = lane & 3;
#pragma unroll
    for (int j = 0; j < 2; ++j) { const int n = (lane >> 2) + 16 * j; const float* s = scr + (16 * c) * 33 + n;
        u32x4 o; o.x = pk4_fp8(s[0 * 33], s[1 * 33], s[2 * 33], s[3 * 33]); o.y = pk4_fp8(s[4 * 33], s[5 * 33], s[6 * 33], s[7 * 33]);
        o.z = pk4_fp8(s[8 * 33], s[9 * 33], s[10 * 33], s[11 * 33]); o.w = pk4_fp8(s[12 * 33], s[13 * 33], s[14 * 33], s[15 * 33]);
        if (n0 + n < nrows) *(u32x4*)(dst + (size_t)(n0 + n) * K + k0 + 16 * c) = o; }
    asm volatile("s_waitcnt lgkmcnt(0)" ::: "memory");
}
__device__ __forceinline__ void conv_n_body(size_t gtid, size_t gsz, const float* __restrict__ src, bf16_t* __restrict__ dst, const float* __restrict__ gain, int K, int nrows, float sc) {
    const int kc8 = K / 8; const size_t total = (size_t)nrows * kc8;
    for (size_t idx = gtid; idx < total; idx += gsz) {
        const int kc = (int)(idx % kc8), n = (int)(idx / kc8);
        const float g = gain[n] * sc; const f32x4 a = *(const f32x4*)(src + (size_t)n * K + kc * 8), b = *(const f32x4*)(src + (size_t)n * K + kc * 8 + 4);
        u32x4 o; o.x = pk2(a.x * g, a.y * g); o.y = pk2(a.z * g, a.w * g); o.z = pk2(b.x * g, b.y * g); o.w = pk2(b.z * g, b.w * g);
        *(u32x4*)(dst + (size_t)n * K + kc * 8) = o;
    }
}

__device__ __forceinline__ float wave_sum(float v) {
#pragma unroll
    for (int o = 1; o < 64; o <<= 1) v += __shfl_xor(v, o);
    return v;
}
__device__ __forceinline__ void rms_body(int gw, int ngw, int lane, const float* __restrict__ x, bf16_t* __restrict__ out, int nrows) {
    for (int row = gw; row < nrows; row += ngw) {
        const f32x4* xr = (const f32x4*)(x + (size_t)row * DM) + lane; f32x4 v[4]; float s = 0.f;
#pragma unroll
        for (int j = 0; j < 4; ++j) { v[j] = xr[64 * j]; s += v[j].x * v[j].x + v[j].y * v[j].y + v[j].z * v[j].z + v[j].w * v[j].w; }
        const float rstd = 1.0f / sqrtf(wave_sum(s) * (1.f / DM) + EPS);
        u32x2* o = (u32x2*)(out + (size_t)row * DM) + lane;
#pragma unroll
        for (int j = 0; j < 4; ++j) { u32x2 w; w.x = pk2(v[j].x * rstd, v[j].y * rstd); w.y = pk2(v[j].z * rstd, v[j].w * rstd); o[64 * j] = w; }
    }
}

struct GUnit { unsigned ao, bo; int row0, col0, e, valid, aux; };

__host__ __device__ __forceinline__ int lds_byte(int r, int c) { const int st = (r >> 4) * 2 + (c >> 5), rr = r & 15, cc = c & 31, ob = rr * 64 + cc * 2; return st * 1024 + (ob ^ (((ob >> 9) & 1) << 5)); }
__host__ __device__ __forceinline__ void stage_rc(int b, int& R, int& C) { const int st = b / 1024, sb = b % 1024, swz = sb ^ (((sb >> 9) & 1) << 5); R = (st >> 1) * 16 + swz / 64; C = (st & 1) * 32 + (swz % 64) / 2; }
__host__ __device__ __forceinline__ int perm32(int rho) { const int n = rho >> 4, i = rho & 15; return 8 * (i >> 2) + 4 * n + (i & 3); }
constexpr int HTB = 128 * 64 * 2;
typedef int v8i __attribute__((ext_vector_type(8)));
typedef int v4i __attribute__((ext_vector_type(4)));
struct Frag2 { bf16x8 h[2]; };
template <bool F> struct FragT { typedef Frag2 T; };
template <> struct FragT<true> { typedef v8i T; };
template <class Sched, class Epi, bool ALIGN_EPI, bool FP8 = false, int SCALE_B = 0x7f>
__device__ __forceinline__ void gemm_phase(unsigned char* lds_flat, const Sched& S, const Epi& E) {
    LDSP unsigned char* lds = (LDSP unsigned char*)(unsigned)(uintptr_t)lds_flat;
    int tid = threadIdx.x; LAUNDER(tid);
    const int wid = __builtin_amdgcn_readfirstlane(tid >> 6), lane = tid & 63, wr = wid >> 2, wc = wid & 3, fr = lane & 15, fq = lane >> 4;
    const int nt = S.K / 64;
    int Rr[2], Cc[2];
#pragma unroll
    for (int i = 0; i < 2; ++i) stage_rc(tid * 16 + i * 8192, Rr[i], Cc[i]);
    unsigned voffB[2][2];
#pragma unroll
    for (int h = 0; h < 2; ++h)
#pragma unroll
        for (int i = 0; i < 2; ++i) voffB[h][i] = (unsigned)(128 * h + (Rr[i] & ~31) + perm32(Rr[i] & 31)) * S.ldb + (unsigned)Cc[i] * 2u;
    const unsigned ldsw = (unsigned)wid * 1024u;
    const int aoff = lds_byte(wr * 64 + fr, FP8 ? fq * 16 : fq * 8), boff = lds_byte(wc * 32 + fr, FP8 ? fq * 16 : fq * 8);
    constexpr int KSUB = FP8 ? 16 : 1024;
#define PG8_SA(b, h) (((b) * 2 + (h)) * HTB)
#define PG8_SB(b, h) ((4 + (b) * 2 + (h)) * HTB)
#define PG8_STAGE(bufoff, rsrc, voff, soff) do { _Pragma("unroll") for (int _i = 0; _i < 2; ++_i) \
        __builtin_amdgcn_raw_ptr_buffer_load_lds(rsrc, (LDSP unsigned*)(lds + (bufoff) + ldsw + _i * 8192), 16, (int)(voff)[_i], (int)(soff), 0, 0); } while (0)
#define PG8_LDF(dst, addr) do { const bf16x8 lo_ = *(const LDSP bf16x8*)(addr); const bf16x8 hi_ = *(const LDSP bf16x8*)((addr) + KSUB); \
        if constexpr (FP8) dst = __builtin_shufflevector(__builtin_bit_cast(v4i, lo_), __builtin_bit_cast(v4i, hi_), 0, 1, 2, 3, 4, 5, 6, 7); else { dst.h[0] = lo_; dst.h[1] = hi_; } } while (0)
#define PG8_LDA(dst, b, h) do { _Pragma("unroll") for (int m = 0; m < 4; ++m) PG8_LDF(dst[m], lds + PG8_SA(b, h) + aoff + m * 2048); } while (0)
#define PG8_LDB(dst, b, h) do { _Pragma("unroll") for (int n = 0; n < 2; ++n) PG8_LDF(dst[n], lds + PG8_SB(b, h) + boff + n * 2048); } while (0)
#define PG8_MMA(ai, bj, At, Bt) do { __builtin_amdgcn_s_setprio(1); _Pragma("unroll") for (int m = 0; m < 4; ++m) _Pragma("unroll") for (int n = 0; n < 2; ++n) { \
        if constexpr (FP8) asm volatile("v_mfma_scale_f32_16x16x128_f8f6f4 %0, %1, %2, %0, %3, %4 op_sel_hi:[0,0,0]" : "+v"(acc[ai][bj][m][n]) : "v"(Bt[n]), "v"(At[m]), "v"(sclB), "v"(sclA)); \
        else { _Pragma("unroll") for (int k = 0; k < 2; ++k) acc[ai][bj][m][n] = __builtin_amdgcn_mfma_f32_16x16x32_bf16(Bt[n].h[k], At[m].h[k], acc[ai][bj][m][n], 0, 0, 0); } } \
        __builtin_amdgcn_s_setprio(0); } while (0)
#define PG8_WAIT_V(n) asm volatile("s_waitcnt vmcnt(" #n ")" ::: "memory")
#define PG8_WAIT_L(n) asm volatile("s_waitcnt lgkmcnt(" #n ")" ::: "memory")
#define PG8_BAR __builtin_amdgcn_s_barrier()
#define PG8_SCHED __builtin_amdgcn_sched_barrier(0)
    GUnit cur, nxt; int ui = 0;
    if (!S.next(0, cur)) return;
    const __amdgpu_buffer_rsrc_t rA = __builtin_amdgcn_make_buffer_rsrc((void*)S.A, 0, 0x7fffffff, 0x00020000);
    const __amdgpu_buffer_rsrc_t rB = __builtin_amdgcn_make_buffer_rsrc((void*)S.Bt, 0, 0x7fffffff, 0x00020000);
    unsigned oc[2][2], on[2][2];
#pragma unroll
    for (int h = 0; h < 2; ++h)
#pragma unroll
        for (int i = 0; i < 2; ++i) oc[h][i] = S.a_off(cur, 128 * h + Rr[i]) + (unsigned)Cc[i] * 2u;
    f32x4 acc[2][2][4][2];
#pragma unroll
    for (int a = 0; a < 2; ++a)
#pragma unroll
        for (int b = 0; b < 2; ++b)
#pragma unroll
            for (int m = 0; m < 4; ++m)
#pragma unroll
                for (int n = 0; n < 2; ++n) acc[a][b][m][n] = (f32x4){0.f, 0.f, 0.f, 0.f};
    typedef typename FragT<FP8>::T frag_t;
    frag_t At[4], B0[2], B1[2];
    const unsigned kstep = 128;
    const int sclB = SCALE_B * 0x01010101, sclA = 0x7f7f7f7f; (void)sclA; (void)sclB;
    PG8_STAGE(PG8_SB(0, 0), rB, voffB[0], cur.bo); PG8_STAGE(PG8_SB(0, 1), rB, voffB[1], cur.bo); PG8_STAGE(PG8_SA(0, 0), rA, oc[0], cur.ao); PG8_STAGE(PG8_SA(0, 1), rA, oc[1], cur.ao);
    if (wr == 1) PG8_BAR;
    PG8_WAIT_V(2); PG8_BAR;
    PG8_STAGE(PG8_SB(1, 0), rB, voffB[0], cur.bo + kstep); PG8_STAGE(PG8_SA(1, 0), rA, oc[0], cur.ao + kstep); PG8_STAGE(PG8_SB(1, 1), rB, voffB[1], cur.bo + kstep);
    PG8_WAIT_V(6); PG8_BAR;
    for (;;) {
        const bool has_next = S.next(ui + 1, nxt);
        if (!has_next) nxt = cur;
        const unsigned nA = nxt.ao, nB = nxt.bo;
        { int t2 = threadIdx.x; LAUNDER(t2);
#pragma unroll
          for (int i = 0; i < 2; ++i) { int R_, C_; stage_rc(t2 * 16 + i * 8192, R_, C_);
#pragma unroll
              for (int h = 0; h < 2; ++h) on[h][i] = S.a_off(nxt, 128 * h + R_) + (unsigned)C_ * 2u; } }
        for (int t = 0; t < nt; t += 2) {
            const bool last = (t == nt - 2);
            const unsigned k1 = cur.ao + (unsigned)(t + 1) * kstep;
            const unsigned a2 = last ? nA : cur.ao + (unsigned)(t + 2) * kstep, b2 = last ? nB : cur.bo + (unsigned)(t + 2) * kstep, a3 = a2 + kstep, b3 = b2 + kstep;
            unsigned o2[2][2];
#pragma unroll
            for (int h = 0; h < 2; ++h)
#pragma unroll
                for (int i = 0; i < 2; ++i) o2[h][i] = last ? on[h][i] : oc[h][i];
            PG8_LDB(B0, 0, 0); PG8_LDB(B1, 0, 1); PG8_SCHED; PG8_LDA(At, 0, 0); PG8_STAGE(PG8_SA(1, 1), rA, oc[1], k1);
            PG8_WAIT_V(8); PG8_WAIT_L(0); PG8_BAR; PG8_MMA(0, 0, At, B0); PG8_MMA(0, 1, At, B1); PG8_BAR; PG8_SCHED;
            PG8_LDA(At, 0, 1); PG8_STAGE(PG8_SB(0, 0), rB, voffB[0], b2); PG8_STAGE(PG8_SB(0, 1), rB, voffB[1], b2); PG8_STAGE(PG8_SA(0, 0), rA, o2[0], a2);
            PG8_WAIT_V(8); PG8_WAIT_L(0); PG8_BAR; PG8_MMA(1, 0, At, B0); PG8_MMA(1, 1, At, B1); PG8_BAR; PG8_SCHED;
            PG8_LDB(B0, 1, 0); PG8_LDB(B1, 1, 1); PG8_SCHED; PG8_LDA(At, 1, 0); PG8_STAGE(PG8_SA(0, 1), rA, o2[1], a2);
            PG8_WAIT_V(8); PG8_WAIT_L(0); PG8_BAR; PG8_MMA(0, 0, At, B0); PG8_MMA(0, 1, At, B1); PG8_BAR; PG8_SCHED;
            PG8_LDA(At, 1, 1); PG8_STAGE(PG8_SB(1, 0), rB, voffB[0], b3); PG8_STAGE(PG8_SB(1, 1), rB, voffB[1], b3); PG8_STAGE(PG8_SA(1, 0), rA, o2[0], a3);
            PG8_WAIT_V(8); PG8_WAIT_L(0); PG8_BAR; PG8_MMA(1, 0, At, B0); PG8_MMA(1, 1, At, B1); PG8_BAR; PG8_SCHED;
        }
        if constexpr (FP8) asm volatile("s_nop 15\n\ts_nop 15" ::: "memory");
        if constexpr (ALIGN_EPI) { if (wr == 0) PG8_BAR; }
        if constexpr (!Epi::AFTER_DRAIN) E(acc, cur, wr, wc, fr, fq);
        if (!has_next) break;
#pragma unroll
        for (int a = 0; a < 2; ++a)
#pragma unroll
            for (int b = 0; b < 2; ++b)
#pragma unroll
                for (int m = 0; m < 4; ++m)
#pragma unroll
                    for (int n = 0; n < 2; ++n) acc[a][b][m][n] = (f32x4){0.f, 0.f, 0.f, 0.f};
        cur = nxt; ++ui;
#pragma unroll
        for (int h = 0; h < 2; ++h)
#pragma unroll
            for (int i = 0; i < 2; ++i) oc[h][i] = on[h][i];
        if constexpr (ALIGN_EPI) { if (wr == 1) PG8_BAR; }
    }
    PG8_WAIT_V(0);
    if constexpr (!ALIGN_EPI) { if (wr == 0) PG8_BAR; }
    PG8_BAR;
    if constexpr (Epi::AFTER_DRAIN) E.fused(acc, cur, wr, wc, fr, fq, lds_flat, wid, lane);
#undef PG8_SA
#undef PG8_SB
#undef PG8_STAGE
#undef PG8_LDA
#undef PG8_LDF
#undef PG8_LDB
#undef PG8_MMA
#undef PG8_WAIT_V
#undef PG8_WAIT_L
#undef PG8_BAR
#undef PG8_SCHED
}
template <bool ALIGN, class Sched, class Epi> __device__ __forceinline__ void gemm_run(unsigned char* lds, const Sched& S, const Epi& E) {
    gemm_phase<Sched, Epi, ALIGN>(lds, S, E);
}
constexpr int WSCALE_LOG2 = 6;
template <bool ALIGN, class Sched, class Epi> __device__ __forceinline__ void gemm_run_fp8(unsigned char* lds, const Sched& S, const Epi& E) {
    gemm_phase<Sched, Epi, ALIGN, true, 127 - WSCALE_LOG2>(lds, S, E);
}
#define EPI_ROWS(r) for (int ai = 0; ai < 2; ++ai) for (int m = 0; m < 4; ++m) { const int r = 128 * ai + 64 * wr + 16 * m + fr;
#define EPI_COLS(c) for (int bj = 0; bj < 2; ++bj) for (int n = 0; n < 2; ++n) { const int c = 128 * bj + 32 * wc + 16 * n + 4 * fq; const f32x4 v = acc[ai][bj][m][n];
#define EPI_END }

struct DenseSched {
    const char* A; const char* Bt; unsigned lda, ldb; int K; int nM, nN; int pm_per_b; size_t zB; int G, c; int i0, imax;
    __device__ __forceinline__ bool next(int i, GUnit& u) const {
        if (i >= imax) return false; i += i0;
        int pm, pn;
        if (G == 256 && (nN & 3) == 0 && nM * nN >= 256) {
            const int j = c & 7, q = c >> 3, s = i * 8 + j, ncg = nN >> 2; pm = (s / ncg) * 8 + (q >> 2); pn = (s % ncg) * 4 + (q & 3); if (c < 0 || pm >= nM) return false; }
        else { const long L = (long)i * G + c; if (c < 0 || L >= (long)nM * nN) return false; pm = (int)(L / nN); pn = (int)(L % nN); }
        u.ao = (unsigned)pm * 256u * lda; u.bo = (unsigned)((size_t)(pm / pm_per_b) * zB) + (unsigned)pn * 256u * ldb; u.row0 = pm * 256; u.col0 = pn * 256; u.e = 0; u.valid = 256; u.aux = 0; return true;
    }
    __device__ __forceinline__ unsigned a_off(const GUnit&, int r) const { return (unsigned)r * lda; }
};
struct SchedWqk {
    const char* A; const char* Bt; unsigned lda, ldb; int K; int G, c, pad;
    __device__ __forceinline__ bool next(int i, GUnit& u) const {
        const int L = i * G + c; if (c < 0 || L >= 32) return false; const int z = L >> 2, pn = L & 3, b = z >> 2, h = z & 3;
        u.ao = (unsigned)b * 256u * 4096u + h * 512u; u.bo = (unsigned)pn * 256u * 2048u + h * 512u; u.row0 = z * 256; u.col0 = pn * 256; u.e = 0; u.valid = 256; u.aux = 0; return true;
    }
    __device__ __forceinline__ unsigned a_off(const GUnit&, int r) const { return (unsigned)r * lda; }
};
struct SchedVo {
    const char* A; const char* Bt; unsigned lda, ldb; int K; int G, c, pad;
    __device__ __forceinline__ bool next(int i, GUnit& u) const {
        const int L = i * G + c; if (c < 0 || L >= 32) return false; const int z = L >> 2, pm = L & 3, b = z >> 2, h = z & 3;
        u.ao = (unsigned)pm * 256u * 2048u + h * 512u; u.bo = (unsigned)b * 256u * 4096u + 2048u + h * 512u; u.row0 = b * 1024 + pm * 256; u.col0 = h * 256; u.e = 0; u.valid = 256; u.aux = 0; return true;
    }
    __device__ __forceinline__ unsigned a_off(const GUnit&, int r) const { return (unsigned)r * lda; }
};
template <bool GATHER> struct MoeSched {
    const char* A; const char* Bt; unsigned lda, ldb; int K; int nN; size_t zB;
    const int* tab; const int* list; int gather; int G, c, pad;
    __device__ __forceinline__ bool next(int i, GUnit& u) const {
        int T, pn;
        if (G == 256) { const int j = c & 7, q = c >> 3, s = i * 8 + j;
            if (nN == 8) { T = 4 * s + (q >> 3); pn = q & 7; } else { T = 8 * s + (q >> 2); pn = q & 3; } }
        else { const int L = i * G + c; T = L / nN; pn = L % nN; }
        if (T >= tab[64]) return false;
        const int w = tab[128 + T]; const int e = w & 255, rt = w >> 8; const int ce = tab[e], start = tab[32 + e];
        u.e = e; u.valid = min(256, ce - rt * 256); u.row0 = start + rt * 256; u.col0 = pn * 256; u.aux = rt * 256;
        u.ao = GATHER ? 0u : (unsigned)u.row0 * lda; u.bo = (unsigned)((size_t)e * zB) + (unsigned)pn * 256u * ldb; return true;
    }
    __device__ __forceinline__ unsigned a_off(const GUnit& u, int r) const {
        if (!GATHER) return (unsigned)r * lda;
        const int rr = r < u.valid ? r : 0; const int tok = list[u.e * NTOK + u.aux + rr]; return (unsigned)tok * lda;
    }
};
__device__ __forceinline__ void moe_build_table(int* tab, const int* __restrict__ cnt, int tid) {
    if (tid < 32) tab[tid] = cnt[tid * 32];
    __syncthreads();
    if (tid < 32) { int s = 0; for (int e = 0; e < tid; ++e) s += tab[e]; tab[32 + tid] = s; }
    if (tid < 320) { int tiles = 0, found = -1;
        for (int e = 0; e < NEXP; ++e) { const int te = (tab[e] + 255) >> 8; if (found < 0 && tid < tiles + te) found = e | ((tid - tiles) << 8); tiles += te; }
        if (found >= 0) tab[128 + tid] = found; if (tid == 0) tab[64] = tiles; }
    __syncthreads();
}

__device__ __forceinline__ u32x4 pack8(const f32x4& a, const f32x4& b) { u32x4 w; w.x = pk2(a[0], a[1]); w.y = pk2(a[2], a[3]); w.z = pk2(b[0], b[1]); w.w = pk2(b[2], b[3]); return w; }
struct EpiBf16 { static constexpr bool AFTER_DRAIN = false; bf16_t* O; int ldc, pad;
    __device__ __forceinline__ void operator()(const f32x4 (&acc)[2][2][4][2], const GUnit& u, int wr, int wc, int fr, int fq) const {
        LAUNDER(fr); LAUNDER(fq);
#pragma unroll
        for (int ai = 0; ai < 2; ++ai)
#pragma unroll
            for (int m = 0; m < 4; ++m) { const int r = 128 * ai + 64 * wr + 16 * m + fr;
#pragma unroll
                for (int bj = 0; bj < 2; ++bj) *(u32x4*)(O + (size_t)(u.row0 + r) * ldc + u.col0 + 128 * bj + 32 * wc + 8 * fq) = pack8(acc[ai][bj][m][0], acc[ai][bj][m][1]); } } };
template <bool BASE_BF16> struct EpiResidSS { static constexpr bool AFTER_DRAIN = false; const void* base; bf16_t* xb; float* ss; unsigned char* xq;
    __device__ __forceinline__ void operator()(const f32x4 (&acc)[2][2][4][2], const GUnit& u, int wr, int wc, int fr, int fq) const {
        LAUNDER(fr); LAUNDER(fq);
#pragma unroll
        for (int ai = 0; ai < 2; ++ai) {
            f32x4 b[4][2][2];
#pragma unroll
            for (int m = 0; m < 4; ++m)
#pragma unroll
                for (int bj = 0; bj < 2; ++bj) { const size_t o = (size_t)(u.row0 + 128 * ai + 64 * wr + 16 * m + fr) * 1024 + u.col0 + 128 * bj + 32 * wc + 8 * fq;
                    if (BASE_BF16) { const u32x4 w = *(const u32x4*)((const bf16_t*)base + o); b[m][bj][0] = (f32x4){bflo(w.x), bfhi(w.x), bflo(w.y), bfhi(w.y)}; b[m][bj][1] = (f32x4){bflo(w.z), bfhi(w.z), bflo(w.w), bfhi(w.w)}; }
                    else { b[m][bj][0] = *(const f32x4*)((const float*)base + o); b[m][bj][1] = *(const f32x4*)((const float*)base + o + 4); } }
#pragma unroll
            for (int m = 0; m < 4; ++m) { const int r = 128 * ai + 64 * wr + 16 * m + fr; float part = 0.f;
#pragma unroll
                for (int bj = 0; bj < 2; ++bj) { const size_t o = (size_t)(u.row0 + r) * 1024 + u.col0 + 128 * bj + 32 * wc + 8 * fq;
                    const f32x4 y0 = b[m][bj][0] + acc[ai][bj][m][0], y1 = b[m][bj][1] + acc[ai][bj][m][1]; *(u32x4*)(xb + o) = pack8(y0, y1);
                    if (xq) { u32x2 q; q.x = pk4_fp8(y0[0], y0[1], y0[2], y0[3]); q.y = pk4_fp8(y1[0], y1[1], y1[2], y1[3]); *(u32x2*)(xq + o) = q; }
                    part += (y0[0] * y0[0] + y0[1] * y0[1] + y0[2] * y0[2] + y0[3] * y0[3]) + (y1[0] * y1[0] + y1[1] * y1[1] + y1[2] * y1[2] + y1[3] * y1[3]); }
                part += __shfl_xor(part, 16); part += __shfl_xor(part, 32);
                if (fq == 0) atomicAdd(ss + u.row0 + r, part); } } } };
struct EpiSoftmax { static constexpr bool AFTER_DRAIN = true; const float* ss; bf16_t* P;
    __device__ __forceinline__ void operator()(const f32x4 (&)[2][2][4][2], const GUnit&, int, int, int, int) const {}
    __device__ __forceinline__ void fused(f32x4 (&acc)[2][2][4][2], const GUnit& u, int wr, int wc, int fr, int fq, unsigned char* lds, int wid, int lane) const {
        float* Pm = (float*)lds; float* Ps = (float*)(lds + 4096);
        LAUNDER(fr); LAUNDER(fq);
#pragma unroll
        for (int ai = 0; ai < 2; ++ai)
#pragma unroll
            for (int m = 0; m < 4; ++m) { const int r = 128 * ai + 64 * wr + 16 * m + fr; const float rstd = 1.0f / sqrtf(ss[u.row0 + r] * (1.0f / 1024.0f) + EPS); float mv = -INFINITY;
#pragma unroll
                for (int bj = 0; bj < 2; ++bj)
#pragma unroll
                    for (int n = 0; n < 2; ++n) { f32x4 s = acc[ai][bj][m][n] * rstd; acc[ai][bj][m][n] = s; mv = fmaxf(mv, fmaxf(fmaxf(s[0], s[1]), fmaxf(s[2], s[3]))); }
                mv = fmaxf(mv, __shfl_xor(mv, 16)); mv = fmaxf(mv, __shfl_xor(mv, 32));
                if (fq == 0) Pm[r * 4 + wc] = mv; }
        __syncthreads();
#pragma unroll
        for (int ai = 0; ai < 2; ++ai)
#pragma unroll
            for (int m = 0; m < 4; ++m) { const int r = 128 * ai + 64 * wr + 16 * m + fr; const f32x4 pm = *(const f32x4*)(Pm + r * 4); const float mv = fmaxf(fmaxf(pm[0], pm[1]), fmaxf(pm[2], pm[3])); float sum = 0.f;
#pragma unroll
                for (int bj = 0; bj < 2; ++bj)
#pragma unroll
                    for (int n = 0; n < 2; ++n) { f32x4 s = acc[ai][bj][m][n]; s[0] = __builtin_amdgcn_exp2f(s[0] - mv); s[1] = __builtin_amdgcn_exp2f(s[1] - mv); s[2] = __builtin_amdgcn_exp2f(s[2] - mv); s[3] = __builtin_amdgcn_exp2f(s[3] - mv);
                        acc[ai][bj][m][n] = s; sum += (s[0] + s[1]) + (s[2] + s[3]); }
                sum += __shfl_xor(sum, 16); sum += __shfl_xor(sum, 32);
                if (fq == 0) Ps[r * 4 + wc] = sum; }
        __syncthreads();
#pragma unroll
        for (int ai = 0; ai < 2; ++ai)
#pragma unroll
            for (int m = 0; m < 4; ++m) { const int r = 128 * ai + 64 * wr + 16 * m + fr; const f32x4 ps = *(const f32x4*)(Ps + r * 4); const float inv = 1.0f / ((ps[0] + ps[1]) + (ps[2] + ps[3]));
#pragma unroll
                for (int bj = 0; bj < 2; ++bj) *(u32x4*)(P + (size_t)(u.row0 + r) * 1024 + u.col0 + 128 * bj + 32 * wc + 8 * fq) = pack8(acc[ai][bj][m][0] * inv, acc[ai][bj][m][1] * inv); }
        (void)wid; (void)lane;
        __syncthreads();
    } };
struct EpiGU { static constexpr bool AFTER_DRAIN = false; const float* bgu; unsigned char* act  ; const float* lrs  ;
    __device__ __forceinline__ void operator()(const f32x4 (&acc)[2][2][4][2], const GUnit& u, int wr, int wc, int fr, int fq) const {
        const int pn = u.col0 >> 8; const float* bg = bgu + (size_t)u.e * 2048; LAUNDER(fr); LAUNDER(fq);
        float rs[8];
#pragma unroll
        for (int i = 0; i < 8; ++i) { const int r = 128 * (i >> 2) + 64 * wr + 16 * (i & 3) + fr; rs[i] = lrs[(size_t)u.e * NTOK + u.aux + (r < u.valid ? r : 0)]; }
        const int col = 128 * pn + 32 * wc + 8 * fq;
        f32x4 bgv[2], blv[2];
#pragma unroll
        for (int n = 0; n < 2; ++n) { bgv[n] = *(const f32x4*)(bg + col + 4 * n); blv[n] = *(const f32x4*)(bg + 1024 + col + 4 * n); }
#pragma unroll
        for (int ai = 0; ai < 2; ++ai)
#pragma unroll
            for (int m = 0; m < 4; ++m) { const int r = 128 * ai + 64 * wr + 16 * m + fr; const float rstd = rs[ai * 4 + m]; u32x2 q;
#pragma unroll
                for (int n = 0; n < 2; ++n) { const f32x4 g = acc[ai][0][m][n] * rstd + bgv[n], l = acc[ai][1][m][n] * rstd + blv[n]; float o[4];
#pragma unroll
                    for (int j = 0; j < 4; ++j) { const float gg = fminf(g[j], 7.0f), ll = fminf(fmaxf(l[j], -7.0f), 7.0f); o[j] = (ll + 1.0f) * (gg * __builtin_amdgcn_rcpf(1.0f + __builtin_amdgcn_exp2f(-1.702f * LOG2E * gg))); }
                    const unsigned w = pk4_fp8(o[0], o[1], o[2], o[3]); if (n == 0) q.x = w; else q.y = w; }
                if (r < u.valid) *(u32x2*)(act + (size_t)(u.row0 + r) * 1024 + col) = q; } } };
struct EpiDown { static constexpr bool AFTER_DRAIN = false; const float* bdn; bf16_t* ys;
    __device__ __forceinline__ void operator()(const f32x4 (&acc)[2][2][4][2], const GUnit& u, int wr, int wc, int fr, int fq) const {
        const float* bd = bdn + (size_t)u.e * 1024; LAUNDER(fr); LAUNDER(fq);
        f32x4 bv[2][2];
#pragma unroll
        for (int bj = 0; bj < 2; ++bj)
#pragma unroll
            for (int n = 0; n < 2; ++n) bv[bj][n] = *(const f32x4*)(bd + u.col0 + 128 * bj + 32 * wc + 8 * fq + 4 * n);
#pragma unroll
        for (int ai = 0; ai < 2; ++ai)
#pragma unroll
            for (int m = 0; m < 4; ++m) { const int r = 128 * ai + 64 * wr + 16 * m + fr; if (r < u.valid) {
#pragma unroll
                for (int bj = 0; bj < 2; ++bj) *(u32x4*)(ys + (size_t)(u.row0 + r) * 1024 + u.col0 + 128 * bj + 32 * wc + 8 * fq) = pack8(acc[ai][bj][m][0] + bv[bj][0], acc[ai][bj][m][1] + bv[bj][1]); } } } };


typedef float f32x16 __attribute__((ext_vector_type(16)));
typedef short s16x4 __attribute__((ext_vector_type(4)));
__device__ __forceinline__ int crow(int r, int hi) { return (r & 3) + 8 * (r >> 2) + 4 * hi; }
__device__ __forceinline__ s16x4 tr_read(const unsigned char* p) { return __builtin_bit_cast(s16x4, __builtin_amdgcn_ds_read_tr16_b64_v4i16((LDSP s16x4*)(unsigned)(uintptr_t)p)); }
__device__ __forceinline__ bf16x8 tr_frag(const unsigned char* img, int pitch, int k0, int f0, int lane) {
    const unsigned char* p = img + (k0 + 8 * (lane >> 5) + ((lane & 15) >> 2)) * pitch + (f0 + 16 * ((lane >> 4) & 1) + 4 * (lane & 3)) * 2;
    const s16x4 lo = tr_read(p), hi = tr_read(p + 4 * pitch);
    return (bf16x8){lo[0], lo[1], lo[2], lo[3], hi[0], hi[1], hi[2], hi[3]};
}
constexpr int GA_PK = 576, GA_PV = 1088;
constexpr int GA_V = 0, GA_PART = 0, GA_GLR = 69632, GA_TOT = 73728, GA_KD = 75776, GA_END = GA_KD + 64 * GA_PK;
__device__ __forceinline__ void gla_pass_a(unsigned char* lds, int task, const bf16_t* __restrict__ xn, const bf16_t* __restrict__ wglr  , const bf16_t* __restrict__ proj,
                                           const float* __restrict__ wg, const float* __restrict__ bg, float* __restrict__ UT, float* __restrict__ decay) {
    int tid = threadIdx.x; LAUNDER(tid); int wid = tid >> 6, lane = tid & 63, fr = lane & 15, fq = lane >> 4;
    const size_t t0 = (size_t)task * 64;
    { f32x4 acc[4];
#pragma unroll
      for (int m = 0; m < 4; ++m) acc[m] = (f32x4){0.f, 0.f, 0.f, 0.f};
#pragma unroll
      for (int ks = 0; ks < 4; ++ks) { const int k = 128 * wid + 32 * ks + 8 * fq; const bf16x8 bfr = *(const bf16x8*)(wglr + (size_t)fr * 1024 + k);
#pragma unroll
          for (int m = 0; m < 4; ++m) { const bf16x8 afr = *(const bf16x8*)(xn + (t0 + 16 * m + fr) * DM + k); acc[m] = __builtin_amdgcn_mfma_f32_16x16x32_bf16(afr, bfr, acc[m], 0, 0, 0); } }
      float* part = (float*)(lds + GA_PART) + wid * 1024;
#pragma unroll
      for (int m = 0; m < 4; ++m)
#pragma unroll
          for (int j = 0; j < 4; ++j) part[(16 * m + 4 * fq + j) * 16 + fr] = acc[m][j]; }
    __syncthreads();
    { float* glr = (float*)(lds + GA_GLR); const float* part = (const float*)(lds + GA_PART);
      for (int i = tid; i < 1024; i += 512) { float s = 0.f;
#pragma unroll
          for (int w = 0; w < 8; ++w) s += part[w * 1024 + i];
          glr[i] = s; } }
    __syncthreads();
    LAUNDER(tid);
    { const int cv = tid & 63, tk = tid >> 6;
#pragma unroll
      for (int i = 0; i < 8; ++i) { const int tok = tk + 8 * i; const u32x4 v = *(const u32x4*)(proj + (t0 + tok) * PROJ_LD + C_VG + cv * 8); *(u32x4*)(lds + GA_V + tok * GA_PV + cv * 16) = v; } }
    LAUNDER(tid);
    { const int j = tid & 255, half = tid >> 8; const float* glr = (const float*)(lds + GA_GLR); float* tot = (float*)(lds + GA_TOT);
      float w[16];
#pragma unroll
      for (int i = 0; i < 16; ++i) w[i] = wg[i * 256 + j];
      const float bj = bg[j]; float run = 0.f;
      bf16_t kk16[32];
#pragma unroll
      for (int s = 0; s < 32; ++s) kk16[s] = proj[(t0 + 32 * half + s) * PROJ_LD + C_KG + j];
#pragma unroll 2
      for (int s = 0; s < 32; ++s) { const float* gl = glr + (32 * half + s) * 16; float u = bj;
#pragma unroll
          for (int i = 0; i < 16; ++i) u += gl[i] * w[i];
          const float ls = fminf(u, 0.f) - __logf(1.0f + __expf(-fabsf(u)));
          run += ls * (1.0f / 16.0f); }
      tot[half * 256 + j] = run;
      __syncthreads();
      const float t0v = tot[j], t1v = tot[256 + j]; const float gend = t0v + t1v;
      if (half == 0) decay[(size_t)task * 256 + j] = __expf(gend);
      run = half ? t0v : 0.f;
#pragma unroll
      for (int s = 0; s < 32; ++s) { const int tok = 32 * half + s; const float* gl = glr + tok * 16; float u = bj;
#pragma unroll
          for (int i = 0; i < 16; ++i) u += gl[i] * w[i];
          const float ls = fminf(u, 0.f) - __logf(1.0f + __expf(-fabsf(u)));
          run += ls * (1.0f / 16.0f);
          const float kk = bf2f(kk16[s]);
          *(bf16_t*)(lds + GA_KD + tok * GA_PK + j * 2) = (bf16_t)f2bf(kk * __expf(gend - run)); } }
    __syncthreads();
    LAUNDER(tid); wid = __builtin_amdgcn_readfirstlane(tid >> 6); lane = tid & 63;
    { const int h = wid >> 1, nt = wid & 1, hi = lane >> 5, c32 = lane & 31; f32x16 acc[4];
#pragma unroll
      for (int m = 0; m < 4; ++m)
#pragma unroll
          for (int r = 0; r < 16; ++r) acc[m][r] = 0.f;
#pragma unroll
      for (int ks = 0; ks < 4; ++ks) { const bf16x8 bfr = tr_frag(lds + GA_KD, GA_PK, 16 * ks, h * 64 + 32 * nt, lane);
#pragma unroll
          for (int m = 0; m < 4; ++m) { const bf16x8 afr = tr_frag(lds + GA_V, GA_PV, 16 * ks, h * 128 + 32 * m, lane); acc[m] = __builtin_amdgcn_mfma_f32_32x32x16_bf16(afr, bfr, acc[m], 0, 0, 0); } }
      float* u = UT + ((size_t)task * 4 + h) * 8192;
#pragma unroll
      for (int m = 0; m < 4; ++m)
#pragma unroll
          for (int r = 0; r < 16; ++r) u[(32 * m + crow(r, hi)) * 64 + 32 * nt + c32] = acc[m][r]; }
    __syncthreads();
}
__device__ __forceinline__ void gla_pass_b(int e, const float* __restrict__ UT, const float* __restrict__ decay, bf16_t* __restrict__ ST) {
    const int dk = e & 63, dv = (e >> 6) & 127, h = (e >> 13) & 3, b = e >> 15; float s = 0.f;
    const size_t base = ((size_t)b * 128 * 4 + h) * 8192 + dv * 64 + dk; const size_t dbase = (size_t)b * 128 * 256 + h * 64 + dk;
    for (int c0 = 0; c0 < 128; c0 += 32) { float u[32], d[32];
#pragma unroll
        for (int i = 0; i < 32; ++i) { u[i] = UT[base + (size_t)(c0 + i) * 4 * 8192]; d[i] = decay[dbase + (size_t)(c0 + i) * 256]; }
#pragma unroll
        for (int i = 0; i < 32; ++i) { s = d[i] * s + u[i]; ST[base + (size_t)(c0 + i) * 4 * 8192] = (bf16_t)f2bf(s); } }
}
constexpr int GC_PITCH = 520;
__device__ __forceinline__ void gla_pass_c(unsigned char* wlds  , int wtask, const bf16_t* __restrict__ ST, const bf16_t* __restrict__ proj, const float* __restrict__ ghead, bf16_t* __restrict__ mix, int lane) {
    const int nh = wtask & 1, h = (wtask >> 1) & 3, bc = wtask >> 3; const int c32 = lane & 31, hi = lane >> 5;
    const size_t t0 = (size_t)bc * 64 + 32 * nh; const bf16_t* st = ST + ((size_t)bc * 4 + h) * 8192;
    f32x16 acc[4];
#pragma unroll
    for (int m = 0; m < 4; ++m)
#pragma unroll
        for (int r = 0; r < 16; ++r) acc[m][r] = 0.f;
#pragma unroll
    for (int ks = 0; ks < 4; ++ks) { const bf16x8 bfr = *(const bf16x8*)(proj + (t0 + c32) * PROJ_LD + C_QG + h * 64 + 16 * ks + 8 * hi);
#pragma unroll
        for (int m = 0; m < 4; ++m) { const bf16x8 afr = *(const bf16x8*)(st + (32 * m + c32) * 64 + 16 * ks + 8 * hi); acc[m] = __builtin_amdgcn_mfma_f32_32x32x16_bf16(afr, bfr, acc[m], 0, 0, 0); } }
    float ss = 0.f;
#pragma unroll
    for (int m = 0; m < 4; ++m)
#pragma unroll
        for (int r = 0; r < 16; ++r) ss += acc[m][r] * acc[m][r];
    ss += __shfl_xor(ss, 32);
    const float rstd = 1.0f / sqrtf(ss * (1.0f / 128.0f) + EPS);
#pragma unroll
    for (int m = 0; m < 4; ++m)
#pragma unroll
        for (int r = 0; r < 16; ++r) *(float*)(wlds + c32 * GC_PITCH + (32 * m + crow(r, hi)) * 4) = acc[m][r] * rstd;
#pragma unroll
    for (int i = 0; i < 8; ++i) { const int q = lane + 64 * i, tok = q >> 4, dv0 = (q & 15) * 8; const float* src = (const float*)(wlds + tok * GC_PITCH + dv0 * 4);
        const u32x4 rgw = *(const u32x4*)(proj + (t0 + tok) * PROJ_LD + C_RG + h * 128 + dv0); const f32x4 g0 = *(const f32x4*)(ghead + dv0), g1 = *(const f32x4*)(ghead + dv0 + 4);
        const float rg[8] = {bflo(rgw.x), bfhi(rgw.x), bflo(rgw.y), bfhi(rgw.y), bflo(rgw.z), bfhi(rgw.z), bflo(rgw.w), bfhi(rgw.w)}; const float gg[8] = {g0.x, g0.y, g0.z, g0.w, g1.x, g1.y, g1.z, g1.w}; float y[8];
#pragma unroll
        for (int k = 0; k < 8; ++k) y[k] = src[k] * gg[k] * (rg[k] / (1.0f + __expf(-rg[k])));
        u32x4 o; o.x = pk2(y[0], y[1]); o.y = pk2(y[2], y[3]); o.z = pk2(y[4], y[5]); o.w = pk2(y[6], y[7]);
        *(u32x4*)(mix + (t0 + tok) * 1024 + h * 128 + dv0) = o; }
}
__device__ __forceinline__ void sb_task(unsigned char* vl  , int wtask, const bf16_t* __restrict__ proj, bf16_t* __restrict__ mix, int lane) {
    const int qt = wtask & 255, h = (wtask >> 8) & 7, b = wtask >> 11; const int c = lane & 31, hi = lane >> 5;
    const int t0 = qt * 32; const size_t rowb = (size_t)b * SEQ;
    bf16x8 qf[4];
#pragma unroll
    for (int d0 = 0; d0 < 4; ++d0) qf[d0] = *(const bf16x8*)(proj + (rowb + t0 + c) * PROJ_LD + C_QS + h * 64 + 16 * d0 + 8 * hi);
    const int kap = 16 * ((c >> 2) & 1) + (c & 3) + 4 * (c >> 3);
    f32x16 o0, o1;
#pragma unroll
    for (int r = 0; r < 16; ++r) { o0[r] = 0.f; o1[r] = 0.f; }
    float Dc = 1.0f;
    const bf16_t* kbase = proj + rowb * PROJ_LD + C_KS + h * 64 + 8 * hi + (size_t)kap * PROJ_LD;
    const bf16_t* vbase = proj + rowb * PROJ_LD + C_VS + h * 64 + (lane & 7) * 8 + (size_t)(lane >> 3) * PROJ_LD;
    bf16x8 kf[4]; u32x4 vr[4];
#pragma unroll
    for (int d0 = 0; d0 < 4; ++d0) kf[d0] = *(const bf16x8*)(kbase + (size_t)t0 * PROJ_LD + 16 * d0);
#pragma unroll
    for (int i = 0; i < 4; ++i) vr[i] = *(const u32x4*)(vbase + (size_t)(t0 + 8 * i) * PROJ_LD);
    for (int j0 = t0; j0 >= 0; j0 -= 32) {
#pragma unroll
        for (int i = 0; i < 4; ++i) { const int key = (lane >> 3) + 8 * i, ch = lane & 7; *(u32x4*)(vl + (ch >> 2) * 2048 + key * 64 + (ch & 3) * 16) = vr[i]; }
        bf16x8 kc[4];
#pragma unroll
        for (int d0 = 0; d0 < 4; ++d0) kc[d0] = kf[d0];
        { const int jn = (j0 >= 32) ? j0 - 32 : j0;
#pragma unroll
          for (int d0 = 0; d0 < 4; ++d0) kf[d0] = *(const bf16x8*)(kbase + (size_t)jn * PROJ_LD + 16 * d0);
#pragma unroll
          for (int i = 0; i < 4; ++i) vr[i] = *(const u32x4*)(vbase + (size_t)(jn + 8 * i) * PROJ_LD); }
        f32x16 z;
#pragma unroll
        for (int r = 0; r < 16; ++r) z[r] = 0.f;
#pragma unroll
        for (int d0 = 0; d0 < 4; ++d0) z = __builtin_amdgcn_mfma_f32_32x32x16_bf16(kc[d0], qf[d0], z, 0, 0, 0);
        float e[16], Dl[16];
        const bool diag = (j0 == t0);
#pragma unroll
        for (int r = 0; r < 16; ++r) { float ev = __builtin_amdgcn_exp2f(fminf(z[r], 126.0f)); if (diag && (16 * hi + r >= c)) ev = 0.f; e[r] = ev; }
        float D = hi ? Dc : 1.0f;
#pragma unroll
        for (int r = 15; r >= 0; --r) { D = fmaf(D, e[r], D); Dl[r] = D; }
        const float other = __shfl_xor(D, 32);
        const float mult = hi ? 1.0f : other;
        Dc = D * other;
        unsigned pw[8];
#pragma unroll
        for (int r = 0; r < 16; r += 2) { const float a0 = e[r] * __builtin_amdgcn_rcpf(Dl[r] * mult), a1 = e[r + 1] * __builtin_amdgcn_rcpf(Dl[r + 1] * mult); pw[r >> 1] = pk2(a0, a1); }
#pragma unroll
        for (int ks = 0; ks < 2; ++ks) { const bf16x8 pa = __builtin_bit_cast(bf16x8, (u32x4){pw[4 * ks], pw[4 * ks + 1], pw[4 * ks + 2], pw[4 * ks + 3]});
            const unsigned char* vb = vl + (16 * hi + 8 * ks + ((lane & 15) >> 2)) * 64 + (16 * ((lane >> 4) & 1) + 4 * (lane & 3)) * 2;
            { const s16x4 lo = tr_read(vb), hh = tr_read(vb + 256); o0 = __builtin_amdgcn_mfma_f32_32x32x16_bf16(pa, (bf16x8){lo[0], lo[1], lo[2], lo[3], hh[0], hh[1], hh[2], hh[3]}, o0, 0, 0, 0); }
            { const s16x4 lo = tr_read(vb + 2048), hh = tr_read(vb + 2048 + 256); o1 = __builtin_amdgcn_mfma_f32_32x32x16_bf16(pa, (bf16x8){lo[0], lo[1], lo[2], lo[3], hh[0], hh[1], hh[2], hh[3]}, o1, 0, 0, 0); } }
        if (__all(!(Dc < 3.0e38f))) break;
    }
    bf16_t* ob = mix + (rowb + t0) * 1024 + 512 + h * 64 + c;
#pragma unroll
    for (int r = 0; r < 16; ++r) { const int q = crow(r, hi); ob[(size_t)q * 1024] = (bf16_t)f2bf(o0[r]); ob[(size_t)q * 1024 + 32] = (bf16_t)f2bf(o1[r]); }
}
__device__ __forceinline__ void softmax_task(int gw, int lane, const float* __restrict__ S, bf16_t* __restrict__ P) {
    const f32x4 v = *((const f32x4*)(S + (size_t)gw * 256) + lane);
    float m = fmaxf(fmaxf(v.x, v.y), fmaxf(v.z, v.w));
#pragma unroll
    for (int o = 1; o < 64; o <<= 1) m = fmaxf(m, __shfl_xor(m, o));
    const float e0 = exp2f(v.x - m), e1 = exp2f(v.y - m), e2 = exp2f(v.z - m), e3 = exp2f(v.w - m);
    const float inv = 1.0f / wave_sum(e0 + e1 + e2 + e3);
    u32x2 w; w.x = pk2(e0 * inv, e1 * inv); w.y = pk2(e2 * inv, e3 * inv); *((u32x2*)(P + (size_t)gw * 256) + lane) = w;
}
__device__ __forceinline__ void router_logit(int idx, const bf16_t* __restrict__ xn, const bf16_t* __restrict__ wr, const float* __restrict__ br, float* __restrict__ lg) {
    const int t = idx >> 5, e = idx & 31; const u32x4* a = (const u32x4*)(xn + (size_t)t * DM); const u32x4* w = (const u32x4*)(wr + (size_t)e * DM); float s = 0.f;
    for (int i = 0; i < DM / 8; ++i) { const u32x4 x = a[i], y = w[i];
        s += bflo(x.x) * bflo(y.x) + bfhi(x.x) * bfhi(y.x) + bflo(x.y) * bflo(y.y) + bfhi(x.y) * bfhi(y.y) + bflo(x.z) * bflo(y.z) + bfhi(x.z) * bfhi(y.z) + bflo(x.w) * bflo(y.w) + bfhi(x.w) * bfhi(y.w); }
    lg[idx] = s + br[e];
}
__device__ __forceinline__ void router_topk(int t, const float* __restrict__ lg, int* __restrict__ cnt, int* __restrict__ list, int* __restrict__ toke, int* __restrict__ tokr, float* __restrict__ tokw) {
    float v[NEXP];
#pragma unroll
    for (int e = 0; e < NEXP; ++e) v[e] = lg[(size_t)t * NEXP + e];
    float tv[4]; int ti[4];
#pragma unroll
    for (int k = 0; k < 4; ++k) { float best = -INFINITY; int bi = 0;
#pragma unroll
        for (int e = 0; e < NEXP; ++e) { if (v[e] > best) { best = v[e]; bi = e; } }
        tv[k] = best; ti[k] = bi;
#pragma unroll
        for (int e = 0; e < NEXP; ++e) if (e == bi) v[e] = -INFINITY; }
    const float e1 = __expf(tv[1] - tv[0]), e2 = __expf(tv[2] - tv[0]), e3 = __expf(tv[3] - tv[0]); const float inv = 1.0f / (1.0f + e1 + e2 + e3);
    const float g[4] = {inv, e1 * inv, e2 * inv, e3 * inv};
#pragma unroll
    for (int k = 0; k < 4; ++k) { const int r = atomicAdd(&cnt[ti[k]], 1); list[ti[k] * NTOK + r] = t; toke[t * 4 + k] = ti[k]; tokr[t * 4 + k] = r; tokw[t * 4 + k] = g[k]; }
}
__device__ __forceinline__ void memkv_task(int wtask, int lane, const bf16_t* __restrict__ memn, const bf16_t* __restrict__ wkv, bf16_t* __restrict__ kv) {
    const int tm = wtask >> 6, tn = wtask & 63; const int c = lane & 31, hi = lane >> 5;
    const bf16_t* ap = memn + (size_t)(tm * 32 + c) * DM + 8 * hi; const bf16_t* bp = wkv + (size_t)(tn * 32 + c) * DM + 8 * hi;
    f32x16 acc;
#pragma unroll
    for (int r = 0; r < 16; ++r) acc[r] = 0.f;
#pragma unroll 16
    for (int ks = 0; ks < 64; ++ks) { const bf16x8 a = *(const bf16x8*)(ap + 16 * ks), b = *(const bf16x8*)(bp + 16 * ks); acc = __builtin_amdgcn_mfma_f32_32x32x16_bf16(a, b, acc, 0, 0, 0); }
    bf16_t* o = kv + (size_t)(tm * 32) * 2048 + tn * 32 + c;
#pragma unroll
    for (int r = 0; r < 16; ++r) o[(size_t)crow(r, hi) * 2048] = (bf16_t)f2bf(acc[r]);
}
__device__ __forceinline__ void router_task(int wtask, int lane, const bf16_t* __restrict__ xn, const float* __restrict__ ss, const bf16_t* __restrict__ wr, const float* __restrict__ br,
                                            int (&oe)[4], float (&ow)[4]) {
    const int c = lane & 31, hi = lane >> 5; const int t = wtask * 32 + c;
    const bf16_t* ap = wr + (size_t)c * DM + 8 * hi; const bf16_t* bp = xn + (size_t)t * DM + 8 * hi;
    f32x16 acc;
#pragma unroll
    for (int r = 0; r < 16; ++r) acc[r] = 0.f;
#pragma unroll 16
    for (int ks = 0; ks < 64; ++ks) { const bf16x8 a = *(const bf16x8*)(ap + 16 * ks), b = *(const bf16x8*)(bp + 16 * ks); acc = __builtin_amdgcn_mfma_f32_32x32x16_bf16(a, b, acc, 0, 0, 0); }
    float v[16]; const float rstd = 1.0f / sqrtf(ss[t] * (1.0f / 1024.0f) + EPS);
#pragma unroll
    for (int r = 0; r < 16; ++r) v[r] = acc[r] * rstd + br[crow(r, hi)];
    float tv[4]; int ti[4];
#pragma unroll
    for (int k = 0; k < 4; ++k) { float best = -INFINITY; int bi = 64;
#pragma unroll
        for (int r = 0; r < 16; ++r) { if (v[r] > best) { best = v[r]; bi = crow(r, hi); } }
        tv[k] = best; ti[k] = bi;
#pragma unroll
        for (int r = 0; r < 16; ++r) if (crow(r, hi) == bi) v[r] = -INFINITY; }
    float cv[8]; int ci[8];
#pragma unroll
    for (int k = 0; k < 4; ++k) { cv[k] = tv[k]; ci[k] = ti[k]; cv[4 + k] = __shfl_xor(tv[k], 32); ci[4 + k] = __shfl_xor(ti[k], 32); }
#pragma unroll
    for (int k = 0; k < 4; ++k) { float best = -INFINITY; int bi = 64;
#pragma unroll
        for (int q = 0; q < 8; ++q) { if (cv[q] > best || (cv[q] == best && ci[q] < bi)) { best = cv[q]; bi = ci[q]; } }
        tv[k] = best; ti[k] = bi;
#pragma unroll
        for (int q = 0; q < 8; ++q) if (ci[q] == bi) cv[q] = -INFINITY; }
    const float e1 = __expf(tv[1] - tv[0]), e2 = __expf(tv[2] - tv[0]), e3 = __expf(tv[3] - tv[0]); const float inv = 1.0f / (1.0f + e1 + e2 + e3);
    const float g[4] = {inv, e1 * inv, e2 * inv, e3 * inv};
#pragma unroll
    for (int k = 0; k < 4; ++k) { oe[k] = ti[k]; ow[k] = g[k]; }
}
__device__ __forceinline__ void combine_task(int t, int lane, const bf16_t* xin, float* xout, const bf16_t* __restrict__ ys, const int* tab, const int* __restrict__ toke, const int* __restrict__ tokr,
                                                 const float* __restrict__ tokw, const float* __restrict__ gfin) {
    const u32x2* xr = (const u32x2*)(xin + (size_t)t * DM) + lane; f32x4* xo = (f32x4*)(xout + (size_t)t * DM) + lane; f32x4 v[4];
#pragma unroll
    for (int j = 0; j < 4; ++j) { const u32x2 w = xr[64 * j]; v[j] = (f32x4){bflo(w.x), bfhi(w.x), bflo(w.y), bfhi(w.y)}; }
    for (int k = 0; k < 4; ++k) { const int e = toke[t * 4 + k], r = tokr[t * 4 + k]; const float w = tokw[t * 4 + k]; const int start = tab[32 + e];
        const u32x2* yr = (const u32x2*)(ys + (size_t)(start + r) * DM) + lane;
#pragma unroll
        for (int j = 0; j < 4; ++j) { const u32x2 y = yr[64 * j]; v[j].x += w * bflo(y.x); v[j].y += w * bfhi(y.x); v[j].z += w * bflo(y.y); v[j].w += w * bfhi(y.y); } }
    float s = 0.f;
#pragma unroll
    for (int j = 0; j < 4; ++j) s += v[j].x * v[j].x + v[j].y * v[j].y + v[j].z * v[j].z + v[j].w * v[j].w;
    const float rstd = 1.0f / sqrtf(wave_sum(s) * (1.f / DM) + EPS);
#pragma unroll
    for (int j = 0; j < 4; ++j) { const f32x4 g = *((const f32x4*)gfin + lane + 64 * j); xo[64 * j] = v[j] * rstd * g; }
}

#define GAS __attribute__((address_space(1)))
#define RLX_AGENT __ATOMIC_RELAXED, __HIP_MEMORY_SCOPE_AGENT
#define XB_TMO      128
#define XB_XCNT(j)  (256  + 64 * (j))
#define XB_XSUB(j)  (1280 + 64 * (j))
#define XB_XGEN(j)  (2304 + 64 * (j))
#define XB_TOP      3328
#define XB_TOPGEN   3392
#define XCD_BAR_WORDS 3456
#define XB_SPIN_CAP (1u << 18)
__device__ __forceinline__ unsigned xb_ld(unsigned* p)              { return __hip_atomic_load(p, __ATOMIC_RELAXED, __HIP_MEMORY_SCOPE_AGENT); }
__device__ __forceinline__ unsigned xb_add(unsigned* p, unsigned v) { return __hip_atomic_fetch_add(p, v, __ATOMIC_RELAXED, __HIP_MEMORY_SCOPE_AGENT); }
__device__ __forceinline__ unsigned xb_xcc_id() { return (unsigned)__builtin_amdgcn_s_getreg((3 << 11) | 20) & 0xFu; }
#define XB_SPIN(cond, bar) do { unsigned _sp = 0; while (cond) { __builtin_amdgcn_s_sleep(1); \
    if ((++_sp & 255u) == 0u) { if (xb_ld(&(bar)[XB_TMO])) break; if (_sp > XB_SPIN_CAP) { atomicAdd(&(bar)[XB_TMO], 1u); break; } } } } while (0)
struct XcdBarrier { unsigned* bar; unsigned x; volatile LDSP unsigned* st; };
__device__ __forceinline__ XcdBarrier xcd_barrier_post(unsigned* bar, volatile LDSP unsigned* st) {
    XcdBarrier b; b.bar = bar; b.x = xb_xcc_id(); b.st = st;
    if (threadIdx.x == 0) (void)xb_add(&bar[XB_XCNT(b.x)], 1u);
    return b;
}
__device__ __forceinline__ void xcd_barrier_complete(unsigned* bar, unsigned x, unsigned& nloc, unsigned& nx) {
    const unsigned G = gridDim.x * gridDim.y * gridDim.z;
    unsigned sum, cnt, mine, sp = 0u;
    for (;;) {
        sum = 0u; cnt = 0u; mine = 0u;
#pragma unroll
        for (unsigned j = 0; j < 16; ++j) { const unsigned c = xb_ld(&bar[XB_XCNT(j)]); sum += c; cnt += (c > 0u) ? 1u : 0u; mine = (j == x) ? c : mine; }
        if (sum == G) break;
        __builtin_amdgcn_s_sleep(1);
        if ((++sp & 255u) == 0u) { if (xb_ld(&bar[XB_TMO])) break; if (sp > XB_SPIN_CAP) { atomicAdd(&bar[XB_TMO], 1u); break; } }
    }
    nloc = mine > 0u ? mine : 1u; nx = cnt > 0u ? cnt : 1u;
}
__device__ __forceinline__ void xcd_barrier(const XcdBarrier& b) {
    asm volatile("s_waitcnt vmcnt(0)" ::: "memory");
    __syncthreads();
    if (threadIdx.x == 0) {
        unsigned* bar = b.bar;
        __builtin_amdgcn_s_waitcnt(0);
        unsigned nloc = b.st[0], nx = b.st[1];
        if (nloc == 0u) { xcd_barrier_complete(bar, b.x, nloc, nx); b.st[0] = nloc; b.st[1] = nx; }
        const unsigned old = xb_add(&bar[XB_XSUB(b.x)], 1u);
        const unsigned gen = old / nloc;
        if (old + 1u == (gen + 1u) * nloc) {
            __builtin_amdgcn_fence(__ATOMIC_RELEASE, "agent");
            asm volatile("s_waitcnt vmcnt(0)" ::: "memory");
            const unsigned og = xb_add(&bar[XB_TOP], 1u);
            const unsigned tg = og / nx;
            if (og + 1u == (tg + 1u) * nx) xb_add(&bar[XB_TOPGEN], 1u);
            else XB_SPIN(xb_ld(&bar[XB_TOPGEN]) == tg, bar);
            __builtin_amdgcn_fence(__ATOMIC_ACQUIRE, "agent");
            xb_add(&bar[XB_XGEN(b.x)], 1u);
            asm volatile("s_waitcnt vmcnt(0)" ::: "memory");
        } else {
            XB_SPIN(xb_ld(&bar[XB_XGEN(b.x)]) == gen, bar);
            __builtin_amdgcn_fence(__ATOMIC_ACQUIRE, "agent");
            asm volatile("s_waitcnt vmcnt(0)" ::: "memory");
        }
    }
    __syncthreads();
}

constexpr int LDS_BYTES = 147456;
constexpr int MISC_OFF = LDS_BYTES - 512;
constexpr int CW_BAR = 4096;
constexpr size_t CTL_ZERO_BYTES = 196608;
constexpr int NPHASE = 12;
struct Args { const float* in[22]; float* out; unsigned char* ws; int ph_lo, ph_hi; };

__global__ void __launch_bounds__(512, 2) mega(Args a) {
    extern __shared__ __attribute__((aligned(16))) unsigned char lds[];
    unsigned char* ws = a.ws; float* out = a.out;
    const float* x = a.in[0]; const float* mem = a.in[1]; const float* g_mix = a.in[2]; const float* w_in = a.in[3];
    const float* w_gla_gate = a.in[4]; const float* b_gla_gate = a.in[5]; const float* g_gla_head = a.in[6]; const float* w_out = a.in[7];
    const float* g_mem_q = a.in[8]; const float* g_mem_kv = a.in[9]; const float* w_mq = a.in[10]; const float* w_mk = a.in[11];
    const float* w_mv = a.in[12]; const float* w_mo = a.in[13]; const float* g_ffn = a.in[14]; const float* w_router = a.in[15];
    const float* b_router = a.in[16]; const float* w_gu = a.in[17]; const float* b_gu = a.in[18]; const float* w_down = a.in[19];
    const float* b_down = a.in[20]; const float* g_final = a.in[21];
    bf16_t* Wt_in = (bf16_t*)(ws + WS_WIN); bf16_t* Wt_out = (bf16_t*)(ws + WS_WOUT); bf16_t* Wq = (bf16_t*)(ws + WS_WQ); bf16_t* Wt_kv = (bf16_t*)(ws + WS_WKV);
    bf16_t* Wt_mo = (bf16_t*)(ws + WS_WMO); bf16_t* Wt_r = (bf16_t*)(ws + WS_WR); bf16_t* Wt_gu = (bf16_t*)(ws + WS_WGU); bf16_t* Wt_dn = (bf16_t*)(ws + WS_WDN);
    bf16_t* xn = (bf16_t*)(ws + WS_XN); bf16_t* memn = (bf16_t*)(ws + WS_MEMN); bf16_t* kv = (bf16_t*)(ws + WS_KV); bf16_t* Bs = (bf16_t*)(ws + WS_BS); bf16_t* Bo = (bf16_t*)(ws + WS_BO);
    bf16_t* proj = (bf16_t*)(ws + WS_PROJ); bf16_t* mix = (bf16_t*)(ws + WS_MIX);
    float* Sc = (float*)(ws + WS_S); bf16_t* P = (bf16_t*)(ws + WS_P); float* lg = (float*)(ws + WS_LG); int* toke = (int*)(ws + WS_TOKE); int* tokr = (int*)(ws + WS_TOKR);
    float* tokw = (float*)(ws + WS_TOKW); int* list = (int*)(ws + WS_LIST); bf16_t* act = (bf16_t*)(ws + WS_ACT); bf16_t* ys = (bf16_t*)(ws + WS_YS);
    unsigned char* Wq_gu = ws + WS_WGU; unsigned char* Wq_dn = ws + WS_WDN; unsigned char* x2q = ws + WS_S; unsigned char* act8 = ws + WS_ACT;
    float* lrs = (float*)(ws + WS_LG);
    float* UT = (float*)(ws + WS_S); float* decay = (float*)(ws + WS_LA); bf16_t* ST = (bf16_t*)(ws + WS_ORAW);
    unsigned* ctl = (unsigned*)(ws + WS_CTL); int* cnt = (int*)ctl + CW_CNT; float* ss1 = (float*)(ws + WS_CTL + 65536); float* ss2 = (float*)(ws + WS_CTL + 131072);

    const int G = gridDim.x, vb = blockIdx.x;
    volatile LDSP unsigned* MISC = (volatile LDSP unsigned*)(unsigned)(uintptr_t)(lds + MISC_OFF);
    if (threadIdx.x < 128) MISC[threadIdx.x] = 0u;
    __syncthreads();
    XcdBarrier bar = xcd_barrier_post(ctl + CW_BAR, MISC + 8);
    const int lo = a.ph_lo, hi = a.ph_hi;
    float* dmy = (float*)(ws + WS_DUMMY); (void)dmy;
#ifndef REPEAT_MASK
#define REPEAT_MASK 0
#endif
#define IN(k) (lo <= (k) && (k) < hi)
#define REP(k) for (int rep_ = 0; rep_ < 1 + ((REPEAT_MASK >> (k)) & 1); ++rep_)
#define SEAM(k) do { if (IN(k) && IN((k) + 1)) xcd_barrier(bar); } while (0)
#define TIDS() int tid = threadIdx.x; LAUNDER(tid); const int lane = tid & 63; const int wid = __builtin_amdgcn_readfirstlane(tid >> 6); (void)lane; (void)wid

    constexpr int I_GU = 32 * 16 * 64, I_DN = 32 * 16 * 32, NSLICE = 6, SLICE_ITEMS = (I_GU + I_DN) / NSLICE;
    static_assert((I_GU + I_DN) % NSLICE == 0 && SLICE_ITEMS % (256 * 8) == 0, "slices");
#define CONV_SLICE(s) do { TIDS(); float* scr_ = (float*)(lds + wid * 8448); const int per_w_ = SLICE_ITEMS / (G * 8); \
        for (int j_ = 0; j_ < per_w_; ++j_) { int r = (s) * SLICE_ITEMS + (vb * 8 + wid) * per_w_ + j_; \
            if (r < I_GU) { const int e = r >> 10, q = r & 1023; conv_item8<2>(scr_, w_gu + (size_t)e * 1024 * 2048, Wq_gu + (size_t)e * 2048 * 1024, g_ffn, 2048, 1024, 2048, q >> 6, q & 63, lane, (float)(1 << WSCALE_LOG2)); } \
            else { r -= I_GU; const int e = r >> 9, q = r & 511; conv_item8<0>(scr_, w_down + (size_t)e * 1024 * 1024, Wq_dn + (size_t)e * 1024 * 1024, nullptr, 1024, 1024, 1024, q >> 5, q & 31, lane, (float)(1 << WSCALE_LOG2)); } } \
        __syncthreads(); } while (0)
    if (IN(0)) REP(0) { TIDS(); const size_t gt = (size_t)vb * 512 + tid, gs = (size_t)G * 512;
        float* scr = (float*)(lds + wid * 8448);
        const int gw = vb * 8 + wid, ngw = G * 8;
        rms_body(gw, ngw, lane, x, xn, NTOK);
        rms_body(gw, ngw, lane, mem, memn, NB * MEML);
        conv_n_body(gt, gs, w_mq, Wq, g_mem_q, 1024, 1024, LOG2E / 16.0f);
        constexpr int I_IN = 16 * 97, I_SQ = 16 * 32, I_R = 16;
        constexpr int NITEMS = I_IN + 4 * I_SQ + I_R;
        for (int it = gw; it < NITEMS; it += ngw) { int r = it;
            if (r < I_IN) { conv_item<1>(scr, w_in, Wt_in, g_mix, 3088, 1024, 3088, r / 97, r % 97, lane); continue; } r -= I_IN;
            if (r < I_SQ) { conv_item<0>(scr, w_out, Wt_out, nullptr, 1024, 1024, 1024, r >> 5, r & 31, lane); continue; } r -= I_SQ;
            if (r < I_SQ) { conv_item<0>(scr, w_mk, Wt_kv, g_mem_kv, 1024, 1024, 1024, r >> 5, r & 31, lane); continue; } r -= I_SQ;
            if (r < I_SQ) { conv_item<0>(scr, w_mv, Wt_kv + (size_t)1024 * 1024, g_mem_kv, 1024, 1024, 1024, r >> 5, r & 31, lane); continue; } r -= I_SQ;
            if (r < I_SQ) { conv_item<0>(scr, w_mo, Wt_mo, nullptr, 1024, 1024, 1024, r >> 5, r & 31, lane); continue; } r -= I_SQ;
            conv_item<0>(scr, w_router, Wt_r, g_ffn, 32, 1024, 32, r, 0, lane); }
        __syncthreads(); }
    SEAM(0);
    if (IN(1)) REP(1) { EpiBf16 E{proj, PROJ_LD, 0};
        for (int k3 = 0; k3 < 3; ++k3) { DenseSched S{(const char*)xn, (const char*)Wt_in, 2048u, 2048u, 1024, 64, 12, 1 << 30, 0, G, vb, k3, 1};
            if (vb & 1) { CONV_SLICE(k3); gemm_run<false>(lds, S, E); } else { gemm_run<false>(lds, S, E); CONV_SLICE(k3); } } }
    SEAM(1);
    if (IN(2)) REP(2) {
        REP(12) { for (int t = vb; t < 256; t += G) gla_pass_a(lds, t, xn, Wt_in + (size_t)3072 * 1024, proj, w_gla_gate, b_gla_gate, UT, decay); }
        REP(13) { TIDS(); for (int t = vb * 8 + wid; t < 4096; t += G * 8) sb_task(lds + wid * 4096, t, proj, mix, lane); }
        REP(14) { TIDS(); for (int t = vb + G * wid; t < 1024; t += G * 8) memkv_task(t, lane, memn, Wt_kv, kv); } }
    SEAM(2);
    if (IN(3)) REP(3) {
        { TIDS(); for (int e = vb * 512 + tid; e < 65536; e += G * 512) gla_pass_b(e, UT, decay, ST); }
        { SchedWqk S{(const char*)kv, (const char*)Wq, 4096u, 2048u, 256, G / 2, vb - G / 2, 0}; EpiBf16 E{Bs, 1024, 0}; gemm_run<false>(lds, S, E); }
        { SchedVo S{(const char*)Wt_mo, (const char*)kv, 2048u, 4096u, 256, G / 2, vb - G / 2 - 32, 0}; EpiBf16 E{Bo, 1024, 0}; gemm_run<false>(lds, S, E); } }
    SEAM(3);
    if (IN(4)) REP(4) { TIDS(); for (int t = vb * 8 + wid; t < 2048; t += G * 8) gla_pass_c(lds + wid * 32 * GC_PITCH, t, ST, proj, g_gla_head, mix, lane); }
    SEAM(4);
#if PROBE_BARRIERS
    for (int pb_ = 0; pb_ < 8; ++pb_) xcd_barrier(bar);
#endif
    if (IN(5)) REP(5) { DenseSched S{(const char*)mix, (const char*)Wt_out, 2048u, 2048u, 1024, 64, 4, 1 << 30, 0, G, vb, 0, 1 << 20}; EpiResidSS<false> E{x, rep_ ? (bf16_t*)dmy : xn, rep_ ? dmy + 16 * 1024 * 1024 : ss1, nullptr};
        if (vb & 1) { CONV_SLICE(3); gemm_run<false>(lds, S, E); } else { gemm_run<false>(lds, S, E); CONV_SLICE(3); } }
    SEAM(5);
    if (IN(6)) REP(6) { DenseSched S{(const char*)xn, (const char*)Bs, 2048u, 2048u, 1024, 64, 4, 32, (size_t)1024 * 2048, G, vb, 0, 1 << 20}; EpiSoftmax E{ss1, P};
        if (vb & 1) { CONV_SLICE(4); gemm_run<false>(lds, S, E); } else { gemm_run<false>(lds, S, E); CONV_SLICE(4); } }
    SEAM(6);
    if (IN(7)) REP(7) { DenseSched S{(const char*)P, (const char*)Bo, 2048u, 2048u, 1024, 64, 4, 32, (size_t)1024 * 2048, G, vb, 0, 1 << 20}; EpiResidSS<true> E{xn, rep_ ? (bf16_t*)dmy : xn, rep_ ? dmy + 16 * 1024 * 1024 : ss2, rep_ ? (unsigned char*)dmy + 40 * 1024 * 1024 : x2q};
        if (vb & 1) { CONV_SLICE(5); gemm_run<false>(lds, S, E); } else { gemm_run<false>(lds, S, E); CONV_SLICE(5); } }
    SEAM(7);
    if (IN(8)) REP(8) { TIDS(); int* cntp = rep_ ? (int*)ctl + 2048 : cnt; int* listp = rep_ ? (int*)dmy + 1024 : list; float* lrsp = rep_ ? dmy + 4096 * 1024 : lrs; int* tokep = rep_ ? (int*)dmy + 1024 * 1024 : toke; int* tokrp = rep_ ? (int*)dmy + 2048 * 1024 : tokr; float* tokwp = rep_ ? dmy + 3072 * 1024 : tokw;
        int* lcnt = (int*)lds; int* gbase = (int*)lds + 32;
        for (int tb = vb; tb < NTOK / 64; tb += G) {
            if (tid < 32) lcnt[tid] = 0;
            __syncthreads();
            int oe[4] = {0, 0, 0, 0}; float ow[4] = {0.f, 0.f, 0.f, 0.f}; int lr[4] = {0, 0, 0, 0};
            if (wid < 2) { router_task(tb * 2 + wid, lane, xn, ss2, Wt_r, b_router, oe, ow);
                if (lane < 32) {
#pragma unroll
                    for (int k = 0; k < 4; ++k) lr[k] = atomicAdd(&lcnt[oe[k]], 1); } }
            __syncthreads();
            if (tid < 32) gbase[tid] = atomicAdd(&cntp[tid * 32], lcnt[tid]);
            __syncthreads();
            if (wid < 2 && lane < 32) { const int t = (tb * 2 + wid) * 32 + lane;
                const float rstd_t = 1.0f / sqrtf(ss2[t] * (1.0f / 1024.0f) + EPS);
#pragma unroll
                for (int k = 0; k < 4; ++k) { const int r = gbase[oe[k]] + lr[k]; listp[oe[k] * NTOK + r] = t; lrsp[oe[k] * NTOK + r] = rstd_t; tokep[t * 4 + k] = oe[k]; tokrp[t * 4 + k] = r; tokwp[t * 4 + k] = ow[k]; } }
            __syncthreads(); } }
    SEAM(8);
    if (IN(9)) REP(9) { int* tab = (int*)(lds + 131072); { TIDS(); moe_build_table(tab, cnt, tid); }
        MoeSched<true> S{(const char*)x2q, (const char*)Wq_gu, 1024u, 1024u, 512, 8, (size_t)2048 * 1024, tab, list, 1, G, vb, 0}; EpiGU E{b_gu, act8, lrs}; gemm_run_fp8<true>(lds, S, E); }
    SEAM(9);
    if (IN(10)) REP(10) { int* tab = (int*)(lds + 131072); { TIDS(); moe_build_table(tab, cnt, tid); }
        MoeSched<false> S{(const char*)act8, (const char*)Wq_dn, 1024u, 1024u, 512, 4, (size_t)1024 * 1024, tab, list, 0, G, vb, 0}; EpiDown E{b_down, ys}; gemm_run_fp8<true>(lds, S, E); }
    SEAM(10);
    if (IN(11)) REP(11) { TIDS(); int* tab = (int*)(lds + 131072); moe_build_table(tab, cnt, tid);
        for (int t = vb * 8 + wid; t < NTOK; t += G * 8) combine_task(t, lane, xn, rep_ ? dmy : out, ys, tab, toke, tokr, tokw, g_final); }
#undef CONV_SLICE
#undef IN
#undef SEAM
#undef TIDS
}

#ifndef MK_PER_PHASE
#define MK_PER_PHASE 0
#endif
extern "C" void kernel_launch(void* const* d_in, const int* in_sizes, int n_in, void* d_out, int out_size, void* d_ws, size_t ws_size, hipStream_t stream) {
    static int grid = 0;
    if (grid == 0) {
        if (n_in != 22 || in_sizes[0] != NTOK * DM || out_size != NTOK * DM || ws_size < WS_END) { fprintf(stderr, "kernel_launch: unexpected shapes (n_in %d, ws %zu)\n", n_in, ws_size); grid = -1; return; }
        int dev = 0, cus = 0, per_cu = 0;
        if (hipGetDevice(&dev) != hipSuccess || hipDeviceGetAttribute(&cus, hipDeviceAttributeMultiprocessorCount, dev) != hipSuccess) { grid = -1; return; }
        if (hipFuncSetAttribute((const void*)mega, hipFuncAttributeMaxDynamicSharedMemorySize, LDS_BYTES) != hipSuccess) { fprintf(stderr, "kernel_launch: hipFuncSetAttribute failed\n"); grid = -1; return; }
        if (hipOccupancyMaxActiveBlocksPerMultiprocessor(&per_cu, (const void*)mega, 512, LDS_BYTES) != hipSuccess || per_cu < 1) fprintf(stderr, "kernel_launch: occupancy query says %d blocks/CU\n", per_cu);
        (void)hipGetLastError();
        grid = cus;
    }
    if (grid < 0) return;
    (void)hipMemsetAsync((char*)d_ws + WS_CTL, 0, CTL_ZERO_BYTES, stream);
    Args a{};
    for (int i = 0; i < 22; ++i) a.in[i] = (const float*)d_in[i];
    a.out = (float*)d_out; a.ws = (unsigned char*)d_ws;
#if MK_PER_PHASE
    for (int p = 0; p < NPHASE; ++p) { a.ph_lo = p; a.ph_hi = p + 1; hipLaunchKernelGGL(mega, dim3(grid), dim3(512), LDS_BYTES, stream, a); }
#else
    a.ph_lo = 0; a.ph_hi = NPHASE; hipLaunchKernelGGL(mega, dim3(grid), dim3(512), LDS_BYTES, stream, a);
#endif
}
```

```cpp
#include <hip/hip_runtime.h>
#include <cstdio>
#include <cstdint>
#ifndef PROBE_BARRIERS
#define PROBE_BARRIERS 0
#endif

typedef unsigned short bf16_t;
typedef short bf16x8 __attribute__((ext_vector_type(8)));
typedef float f32x4 __attribute__((ext_vector_type(4)));
typedef unsigned u32x4 __attribute__((ext_vector_type(4)));
typedef unsigned u32x2 __attribute__((ext_vector_type(2)));
#define LDSP __attribute__((address_space(3)))
#define LAUNDER(x) asm volatile("" : "+v"(x))

constexpr int NB = 2, SEQ = 8192, NTOK = NB * SEQ, DM = 1024, MEML = 256;
constexpr int NEXP = 32, TOPK = 4, NASSIGN = NTOK * TOPK;
constexpr int PROJ_LD = 3072;
constexpr int C_QG = 0, C_KG = 256, C_VG = 512, C_RG = 1024, C_QS = 1536, C_KS = 2048, C_VS = 2560, C_GLR = 3072;
constexpr float LOG2E = 1.4426950408889634f;
constexpr float EPS = 1e-5f;

__device__ __forceinline__ unsigned f2bf(float f) { unsigned u = __float_as_uint(f); return (u + 0x7fffu + ((u >> 16) & 1u)) >> 16; }
__device__ __forceinline__ unsigned pk2(float lo, float hi) { return f2bf(lo) | (f2bf(hi) << 16); }
__device__ __forceinline__ float bf2f(bf16_t h) { return __uint_as_float(((unsigned)h) << 16); }
__device__ __forceinline__ float bflo(unsigned w) { return __uint_as_float(w << 16); }
__device__ __forceinline__ float bfhi(unsigned w) { return __uint_as_float(w & 0xffff0000u); }

constexpr size_t MiB = 1u << 20;
constexpr size_t WS_CTL = 0;
constexpr size_t WS_WIN = 1 * MiB;
constexpr size_t WS_WOUT = 8 * MiB;
constexpr size_t WS_WQ = 10 * MiB;
constexpr size_t WS_WKV = 12 * MiB;
constexpr size_t WS_WMO = 16 * MiB;
constexpr size_t WS_WR = 18 * MiB;
constexpr size_t WS_WGU = 20 * MiB;
constexpr size_t WS_WDN = 148 * MiB;
constexpr size_t WS_XN = 212 * MiB;
constexpr size_t WS_MEMN = 244 * MiB;
constexpr size_t WS_KV = 245 * MiB;
constexpr size_t WS_BS = 247 * MiB;
constexpr size_t WS_BO = 251 * MiB;
constexpr size_t WS_PROJ = 256 * MiB;
constexpr size_t WS_LA = 360 * MiB;
constexpr size_t WS_ORAW = 376 * MiB;
constexpr size_t WS_MIX = 408 * MiB;
constexpr size_t WS_S = 440 * MiB;
constexpr size_t WS_P = 504 * MiB;
constexpr size_t WS_LG = 536 * MiB;
constexpr size_t WS_TOKE = 538 * MiB;
constexpr size_t WS_TOKR = 539 * MiB;
constexpr size_t WS_TOKW = 540 * MiB;
constexpr size_t WS_LIST = 541 * MiB;
constexpr size_t WS_ACT = 544 * MiB;
constexpr size_t WS_YS = 674 * MiB;
constexpr size_t WS_DUMMY = 804 * MiB;
constexpr size_t WS_END = 872 * MiB;
constexpr int CW_CNT = 1024;

template <int MAP> __device__ __forceinline__ int srccol(int n, float& sc) {
    sc = 1.f;
    if (MAP == 0) return n;
    if (MAP == 1) {
        if (n < 256) { sc = 0.125f; return n; }
        if (n < 1024) return n;
        if (n < 3072) { if (n >= C_QS && n < C_KS) sc = 0.125f * LOG2E; return n + 16; }
        if (n < 3088) return 1024 + (n - 3072);
        return -1;
    }
    { const int ct = n >> 8, w = n & 255; return (w < 128) ? (128 * ct + w) : (1024 + 128 * ct + (w - 128)); }
}
template <int MAP>
__device__ __forceinline__ void conv_t_body(size_t gtid, size_t gsz, const float* __restrict__ src, bf16_t* __restrict__ dst, const float* __restrict__ gain,
                                               int ldsrc, int K, int nrows, int nmat, size_t sms, size_t dms) {
    const int kc8 = K / 8;
    const size_t total = (size_t)nmat * nrows * kc8;
    for (size_t idx = gtid; idx < total; idx += gsz) {
        const int n = (int)(idx % nrows); const size_t t = idx / nrows; const int kc = (int)(t % kc8); const int mat = (int)(t / kc8);
        float sc; const int c = srccol<MAP>(n, sc);
        u32x4 o = {0u, 0u, 0u, 0u};
        if (c >= 0) {
            const float* s = src + (size_t)mat * sms + (size_t)(kc * 8) * ldsrc + c;
            float v[8];
#pragma unroll
            for (int j = 0; j < 8; ++j) v[j] = s[(size_t)j * ldsrc] * (gain ? gain[kc * 8 + j] : 1.f) * sc;
            o.x = pk2(v[0], v[1]); o.y = pk2(v[2], v[3]); o.z = pk2(v[4], v[5]); o.w = pk2(v[6], v[7]);
        }
        *(u32x4*)(dst + (size_t)mat * dms + (size_t)n * K + kc * 8) = o;
    }
}
template <int MAP>
__device__ __forceinline__ void conv_item(float* scr, const float* __restrict__ src, bf16_t* __restrict__ dst, const float* __restrict__ gain, int ldsrc, int K, int nrows, int kb, int nb, int lane) {
    const int k0 = kb * 64, n0 = nb * 32; float sc; const int c0 = srccol<MAP>(n0, sc);
    const int half = lane >> 5, l31 = lane & 31;
    const float* s0 = src + (size_t)(k0 + half) * ldsrc + c0 + l31;
    float v[32];
#pragma unroll
    for (int i = 0; i < 32; ++i) v[i] = s0[(size_t)(2 * i) * ldsrc];
#pragma unroll
    for (int i = 0; i < 32; ++i) { const int kk = 2 * i + half; const float g = (gain ? gain[k0 + kk] : 1.f) * sc; scr[kk * 33 + l31] = v[i] * g; }
    asm volatile("s_waitcnt lgkmcnt(0)" ::: "memory");
    const int c = lane & 7;
#pragma unroll
    for (int j = 0; j < 4; ++j) { const int n = (lane >> 3) + 8 * j; const float* s = scr + (8 * c) * 33 + n;
        u32x4 o; o.x = pk2(s[0 * 33], s[1 * 33]); o.y = pk2(s[2 * 33], s[3 * 33]); o.z = pk2(s[4 * 33], s[5 * 33]); o.w = pk2(s[6 * 33], s[7 * 33]);
        if (n0 + n < nrows) *(u32x4*)(dst + (size_t)(n0 + n) * K + k0 + 8 * c) = o; }
    asm volatile("s_waitcnt lgkmcnt(0)" ::: "memory");
}
__device__ __forceinline__ unsigned pk4_fp8(float a, float b, float c, float d) { int w = __builtin_amdgcn_cvt_pk_fp8_f32(a, b, 0, false); w = __builtin_amdgcn_cvt_pk_fp8_f32(c, d, w, true); return (unsigned)w; }
template <int MAP>
__device__ __forceinline__ void conv_item8(float* scr, const float* __restrict__ src, unsigned char* __restrict__ dst, const float* __restrict__ gain, int ldsrc, int K, int nrows, int kb, int nb, int lane, float mul) {
    const int k0 = kb * 64, n0 = nb * 32; float sc; const int c0 = srccol<MAP>(n0, sc); sc *= mul;
    const int half = lane >> 5, l31 = lane & 31;
    const float* s0 = src + (size_t)(k0 + half) * ldsrc + c0 + l31;
    float v[32];
#pragma unroll
    for (int i = 0; i < 32; ++i) v[i] = s0[(size_t)(2 * i) * ldsrc];
#pragma unroll
    for (int i = 0; i < 32; ++i) { const int kk = 2 * i + half; const float g = (gain ? gain[k0 + kk] : 1.f) * sc; scr[kk * 33 + l31] = v[i] * g; }
    asm volatile("s_waitcnt lgkmcnt(0)" ::: "memory");
    const int c = lane & 3;
#pragma unroll
    for (int j = 0; j < 2; ++j) { const int n = (lane >> 2) + 16 * j; const float* s = scr + (16 * c) * 33 + n;
        u32x4 o; o.x = pk4_fp8(s[0 * 33], s[1 * 33], s[2 * 33], s[3 * 33]); o.y = pk4_fp8(s[4 * 33], s[5 * 33], s[6 * 33], s[7 * 33]);
        o.z = pk4_fp8(s[8 * 33], s[9 * 33], s[10 * 33], s[11 * 33]); o.w = pk4_fp8(s[12 * 33], s[13 * 33], s[14 * 33], s[15 * 33]);
        if (n0 + n < nrows) *(u32x4*)(dst + (size_t)(n0 + n) * K + k0 + 16 * c) = o; }
    asm volatile("s_waitcnt lgkmcnt(0)" ::: "memory");
}
__device__ __forceinline__ void conv_n_body(size_t gtid, size_t gsz, const float* __restrict__ src, bf16_t* __restrict__ dst, const float* __restrict__ gain, int K, int nrows, float sc) {
    const int kc8 = K / 8; const size_t total = (size_t)nrows * kc8;
    for (size_t idx = gtid; idx < total; idx += gsz) {
        const int kc = (int)(idx % kc8), n = (int)(idx / kc8);
        const float g = gain[n] * sc; const f32x4 a = *(const f32x4*)(src + (size_t)n * K + kc * 8), b = *(const f32x4*)(src + (size_t)n * K + kc * 8 + 4);
        u32x4 o; o.x = pk2(a.x * g, a.y * g); o.y = pk2(a.z * g, a.w * g); o.z = pk2(b.x * g, b.y * g); o.w = pk2(b.z * g, b.w * g);
        *(u32x4*)(dst + (size_t)n * K + kc * 8) = o;
    }
}

__device__ __forceinline__ float wave_sum(float v) {
#pragma unroll
    for (int o = 1; o < 64; o <<= 1) v += __shfl_xor(v, o);
    return v;
}
__device__ __forceinline__ void rms_body(int gw, int ngw, int lane, const float* __restrict__ x, bf16_t* __restrict__ out, int nrows) {
    for (int row = gw; row < nrows; row += ngw) {
        const f32x4* xr = (const f32x4*)(x + (size_t)row * DM) + lane; f32x4 v[4]; float s = 0.f;
#pragma unroll
        for (int j = 0; j < 4; ++j) { v[j] = xr[64 * j]; s += v[j].x * v[j].x + v[j].y * v[j].y + v[j].z * v[j].z + v[j].w * v[j].w; }
        const float rstd = 1.0f / sqrtf(wave_sum(s) * (1.f / DM) + EPS);
        u32x2* o = (u32x2*)(out + (size_t)row * DM) + lane;
#pragma unroll
        for (int j = 0; j < 4; ++j) { u32x2 w; w.x = pk2(v[j].x * rstd, v[j].y * rstd); w.y = pk2(v[j].z * rstd, v[j].w * rstd); o[64 * j] = w; }
    }
}

struct GUnit { unsigned ao, bo; int row0, col0, e, valid, aux; };

__host__ __device__ __forceinline__ int lds_byte(int r, int c) { const int st = (r >> 4) * 2 + (c >> 5), rr = r & 15, cc = c & 31, ob = rr * 64 + cc * 2; return st * 1024 + (ob ^ (((ob >> 9) & 1) << 5)); }
__host__ __device__ __forceinline__ void stage_rc(int b, int& R, int& C) { const int st = b / 1024, sb = b % 1024, swz = sb ^ (((sb >> 9) & 1) << 5); R = (st >> 1) * 16 + swz / 64; C = (st & 1) * 32 + (swz % 64) / 2; }
__host__ __device__ __forceinline__ int perm32(int rho) { const int n = rho >> 4, i = rho & 15; return 8 * (i >> 2) + 4 * n + (i & 3); }
constexpr int HTB = 128 * 64 * 2;
typedef int v8i __attribute__((ext_vector_type(8)));
typedef int v4i __attribute__((ext_vector_type(4)));
struct Frag2 { bf16x8 h[2]; };
template <bool F> struct FragT { typedef Frag2 T; };
template <> struct FragT<true> { typedef v8i T; };
template <class Sched, class Epi, bool ALIGN_EPI, bool FP8 = false, int SCALE_B = 0x7f>
__device__ __forceinline__ void gemm_phase(unsigned char* lds_flat, const Sched& S, const Epi& E) {
    LDSP unsigned char* lds = (LDSP unsigned char*)(unsigned)(uintptr_t)lds_flat;
    int tid = threadIdx.x; LAUNDER(tid);
    const int wid = __builtin_amdgcn_readfirstlane(tid >> 6), lane = tid & 63, wr = wid >> 2, wc = wid & 3, fr = lane & 15, fq = lane >> 4;
    const int nt = S.K / 64;
    int Rr[2], Cc[2];
#pragma unroll
    for (int i = 0; i < 2; ++i) stage_rc(tid * 16 + i * 8192, Rr[i], Cc[i]);
    unsigned voffB[2][2];
#pragma unroll
    for (int h = 0; h < 2; ++h)
#pragma unroll
        for (int i = 0; i < 2; ++i) voffB[h][i] = (unsigned)(128 * h + (Rr[i] & ~31) + perm32(Rr[i] & 31)) * S.ldb + (unsigned)Cc[i] * 2u;
    const unsigned ldsw = (unsigned)wid * 1024u;
    const int aoff = lds_byte(wr * 64 + fr, FP8 ? fq * 16 : fq * 8), boff = lds_byte(wc * 32 + fr, FP8 ? fq * 16 : fq * 8);
    constexpr int KSUB = FP8 ? 16 : 1024;
#define PG8_SA(b, h) (((b) * 2 + (h)) * HTB)
#define PG8_SB(b, h) ((4 + (b) * 2 + (h)) * HTB)
#define PG8_STAGE(bufoff, rsrc, voff, soff) do { _Pragma("unroll") for (int _i = 0; _i < 2; ++_i) \
        __builtin_amdgcn_raw_ptr_buffer_load_lds(rsrc, (LDSP unsigned*)(lds + (bufoff) + ldsw + _i * 8192), 16, (int)(voff)[_i], (int)(soff), 0, 0); } while (0)
#define PG8_LDF(dst, addr) do { const bf16x8 lo_ = *(const LDSP bf16x8*)(addr); const bf16x8 hi_ = *(const LDSP bf16x8*)((addr) + KSUB); \
        if constexpr (FP8) dst = __builtin_shufflevector(__builtin_bit_cast(v4i, lo_), __builtin_bit_cast(v4i, hi_), 0, 1, 2, 3, 4, 5, 6, 7); else { dst.h[0] = lo_; dst.h[1] = hi_; } } while (0)
#define PG8_LDA(dst, b, h) do { _Pragma("unroll") for (int m = 0; m < 4; ++m) PG8_LDF(dst[m], lds + PG8_SA(b, h) + aoff + m * 2048); } while (0)
#define PG8_LDB(dst, b, h) do { _Pragma("unroll") for (int n = 0; n < 2; ++n) PG8_LDF(dst[n], lds + PG8_SB(b, h) + boff + n * 2048); } while (0)
#define PG8_MMA(ai, bj, At, Bt) do { __builtin_amdgcn_s_setprio(1); _Pragma("unroll") for (int m = 0; m < 4; ++m) _Pragma("unroll") for (int n = 0; n < 2; ++n) { \
        if constexpr (FP8) asm volatile("v_mfma_scale_f32_16x16x128_f8f6f4 %0, %1, %2, %0, %3, %4 op_sel_hi:[0,0,0]" : "+v"(acc[ai][bj][m][n]) : "v"(Bt[n]), "v"(At[m]), "v"(sclB), "v"(sclA)); \
        else { _Pragma("unroll") for (int k = 0; k < 2; ++k) acc[ai][bj][m][n] = __builtin_amdgcn_mfma_f32_16x16x32_bf16(Bt[n].h[k], At[m].h[k], acc[ai][bj][m][n], 0, 0, 0); } } \
        __builtin_amdgcn_s_setprio(0); } while (0)
#define PG8_WAIT_V(n) asm volatile("s_waitcnt vmcnt(" #n ")" ::: "memory")
#define PG8_WAIT_L(n) asm volatile("s_waitcnt lgkmcnt(" #n ")" ::: "memory")
#define PG8_BAR __builtin_amdgcn_s_barrier()
#define PG8_SCHED __builtin_amdgcn_sched_barrier(0)
    GUnit cur, nxt; int ui = 0;
    if (!S.next(0, cur)) return;
    const __amdgpu_buffer_rsrc_t rA = __builtin_amdgcn_make_buffer_rsrc((void*)S.A, 0, 0x7fffffff, 0x00020000);
    const __amdgpu_buffer_rsrc_t rB = __builtin_amdgcn_make_buffer_rsrc((void*)S.Bt, 0, 0x7fffffff, 0x00020000);
    unsigned oc[2][2], on[2][2];
#pragma unroll
    for (int h = 0; h < 2; ++h)
#pragma unroll
        for (int i = 0; i < 2; ++i) oc[h][i] = S.a_off(cur, 128 * h + Rr[i]) + (unsigned)Cc[i] * 2u;
    f32x4 acc[2][2][4][2];
#pragma unroll
    for (int a = 0; a < 2; ++a)
#pragma unroll
        for (int b = 0; b < 2; ++b)
#pragma unroll
            for (int m = 0; m < 4; ++m)
#pragma unroll
                for (int n = 0; n < 2; ++n) acc[a][b][m][n] = (f32x4){0.f, 0.f, 0.f, 0.f};
    typedef typename FragT<FP8>::T frag_t;
    frag_t At[4], B0[2], B1[2];
    const unsigned kstep = 128;
    const int sclB = SCALE_B * 0x01010101, sclA = 0x7f7f7f7f; (void)sclA; (void)sclB;
    PG8_STAGE(PG8_SB(0, 0), rB, voffB[0], cur.bo); PG8_STAGE(PG8_SB(0, 1), rB, voffB[1], cur.bo); PG8_STAGE(PG8_SA(0, 0), rA, oc[0], cur.ao); PG8_STAGE(PG8_SA(0, 1), rA, oc[1], cur.ao);
    if (wr == 1) PG8_BAR;
    PG8_WAIT_V(2); PG8_BAR;
    PG8_STAGE(PG8_SB(1, 0), rB, voffB[0], cur.bo + kstep); PG8_STAGE(PG8_SA(1, 0), rA, oc[0], cur.ao + kstep); PG8_STAGE(PG8_SB(1, 1), rB, voffB[1], cur.bo + kstep);
    PG8_WAIT_V(6); PG8_BAR;
    for (;;) {
        const bool has_next = S.next(ui + 1, nxt);
        if (!has_next) nxt = cur;
        const unsigned nA = nxt.ao, nB = nxt.bo;
        { int t2 = threadIdx.x; LAUNDER(t2);
#pragma unroll
          for (int i = 0; i < 2; ++i) { int R_, C_; stage_rc(t2 * 16 + i * 8192, R_, C_);
#pragma unroll
              for (int h = 0; h < 2; ++h) on[h][i] = S.a_off(nxt, 128 * h + R_) + (unsigned)C_ * 2u; } }
        for (int t = 0; t < nt; t += 2) {
            const bool last = (t == nt - 2);
            const unsigned k1 = cur.ao + (unsigned)(t + 1) * kstep;
            const unsigned a2 = last ? nA : cur.ao + (unsigned)(t + 2) * kstep, b2 = last ? nB : cur.bo + (unsigned)(t + 2) * kstep, a3 = a2 + kstep, b3 = b2 + kstep;
            unsigned o2[2][2];
#pragma unroll
            for (int h = 0; h < 2; ++h)
#pragma unroll
                for (int i = 0; i < 2; ++i) o2[h][i] = last ? on[h][i] : oc[h][i];
            PG8_LDB(B0, 0, 0); PG8_LDB(B1, 0, 1); PG8_SCHED; PG8_LDA(At, 0, 0); PG8_STAGE(PG8_SA(1, 1), rA, oc[1], k1);
            PG8_WAIT_V(8); PG8_WAIT_L(0); PG8_BAR; PG8_MMA(0, 0, At, B0); PG8_MMA(0, 1, At, B1); PG8_BAR; PG8_SCHED;
            PG8_LDA(At, 0, 1); PG8_STAGE(PG8_SB(0, 0), rB, voffB[0], b2); PG8_STAGE(PG8_SB(0, 1), rB, voffB[1], b2); PG8_STAGE(PG8_SA(0, 0), rA, o2[0], a2);
            PG8_WAIT_V(8); PG8_WAIT_L(0); PG8_BAR; PG8_MMA(1, 0, At, B0); PG8_MMA(1, 1, At, B1); PG8_BAR; PG8_SCHED;
            PG8_LDB(B0, 1, 0); PG8_LDB(B1, 1, 1); PG8_SCHED; PG8_LDA(At, 1, 0); PG8_STAGE(PG8_SA(0, 1), rA, o2[1], a2);
            PG8_WAIT_V(8); PG8_WAIT_L(0); PG8_BAR; PG8_MMA(0, 0, At, B0); PG8_MMA(0, 1, At, B1); PG8_BAR; PG8_SCHED;
            PG8_LDA(At, 1, 1); PG8_STAGE(PG8_SB(1, 0), rB, voffB[0], b3); PG8_STAGE(PG8_SB(1, 1), rB, voffB[1], b3); PG8_STAGE(PG8_SA(1, 0), rA, o2[0], a3);
            PG8_WAIT_V(8); PG8_WAIT_L(0); PG8_BAR; PG8_MMA(1, 0, At, B0); PG8_MMA(1, 1, At, B1); PG8_BAR; PG8_SCHED;
        }
        if constexpr (FP8) asm volatile("s_nop 15\n\ts_nop 15" ::: "memory");
        if constexpr (ALIGN_EPI) { if (wr == 0) PG8_BAR; }
        if constexpr (!Epi::AFTER_DRAIN) E(acc, cur, wr, wc, fr, fq);
        if (!has_next) break;
#pragma unroll
        for (int a = 0; a < 2; ++a)
#pragma unroll
            for (int b = 0; b < 2; ++b)
#pragma unroll
                for (int m = 0; m < 4; ++m)
#pragma unroll
                    for (int n = 0; n < 2; ++n) acc[a][b][m][n] = (f32x4){0.f, 0.f, 0.f, 0.f};
        cur = nxt; ++ui;
#pragma unroll
        for (int h = 0; h < 2; ++h)
#pragma unroll
            for (int i = 0; i < 2; ++i) oc[h][i] = on[h][i];
        if constexpr (ALIGN_EPI) { if (wr == 1) PG8_BAR; }
    }
    PG8_WAIT_V(0);
    if constexpr (!ALIGN_EPI) { if (wr == 0) PG8_BAR; }
    PG8_BAR;
    if constexpr (Epi::AFTER_DRAIN) E.fused(acc, cur, wr, wc, fr, fq, lds_flat, wid, lane);
#undef PG8_SA
#undef PG8_SB
#undef PG8_STAGE
#undef PG8_LDA
#undef PG8_LDF
#undef PG8_LDB
#undef PG8_MMA
#undef PG8_WAIT_V
#undef PG8_WAIT_L
#undef PG8_BAR
#undef PG8_SCHED
}
template <bool ALIGN, class Sched, class Epi> __device__ __forceinline__ void gemm_run(unsigned char* lds, const Sched& S, const Epi& E) {
    gemm_phase<Sched, Epi, ALIGN>(lds, S, E);
}
constexpr int WSCALE_LOG2 = 6;
template <bool ALIGN, class Sched, class Epi> __device__ __forceinline__ void gemm_run_fp8(unsigned char* lds, const Sched& S, const Epi& E) {
    gemm_phase<Sched, Epi, ALIGN, true, 127 - WSCALE_LOG2>(lds, S, E);
}
#define EPI_ROWS(r) for (int ai = 0; ai < 2; ++ai) for (int m = 0; m < 4; ++m) { const int r = 128 * ai + 64 * wr + 16 * m + fr;
#define EPI_COLS(c) for (int bj = 0; bj < 2; ++bj) for (int n = 0; n < 2; ++n) { const int c = 128 * bj + 32 * wc + 16 * n + 4 * fq; const f32x4 v = acc[ai][bj][m][n];
#define EPI_END }

struct DenseSched {
    const char* A; const char* Bt; unsigned lda, ldb; int K; int nM, nN; int pm_per_b; size_t zB; int G, c;
    __device__ __forceinline__ bool next(int i, GUnit& u) const {
        int pm, pn;
        if (G == 256 && (nN & 3) == 0 && nM * nN >= 256) {
            const int j = c & 7, q = c >> 3, s = i * 8 + j, ncg = nN >> 2; pm = (s / ncg) * 8 + (q >> 2); pn = (s % ncg) * 4 + (q & 3); if (c < 0 || pm >= nM) return false; }
        else { const long L = (long)i * G + c; if (c < 0 || L >= (long)nM * nN) return false; pm = (int)(L / nN); pn = (int)(L % nN); }
        u.ao = (unsigned)pm * 256u * lda; u.bo = (unsigned)((size_t)(pm / pm_per_b) * zB) + (unsigned)pn * 256u * ldb; u.row0 = pm * 256; u.col0 = pn * 256; u.e = 0; u.valid = 256; u.aux = 0; return true;
    }
    __device__ __forceinline__ unsigned a_off(const GUnit&, int r) const { return (unsigned)r * lda; }
};
struct SchedWqk {
    const char* A; const char* Bt; unsigned lda, ldb; int K; int G, c, pad;
    __device__ __forceinline__ bool next(int i, GUnit& u) const {
        const int L = i * G + c; if (c < 0 || L >= 32) return false; const int z = L >> 2, pn = L & 3, b = z >> 2, h = z & 3;
        u.ao = (unsigned)b * 256u * 4096u + h * 512u; u.bo = (unsigned)pn * 256u * 2048u + h * 512u; u.row0 = z * 256; u.col0 = pn * 256; u.e = 0; u.valid = 256; u.aux = 0; return true;
    }
    __device__ __forceinline__ unsigned a_off(const GUnit&, int r) const { return (unsigned)r * lda; }
};
struct SchedVo {
    const char* A; const char* Bt; unsigned lda, ldb; int K; int G, c, pad;
    __device__ __forceinline__ bool next(int i, GUnit& u) const {
        const int L = i * G + c; if (c < 0 || L >= 32) return false; const int z = L >> 2, pm = L & 3, b = z >> 2, h = z & 3;
        u.ao = (unsigned)pm * 256u * 2048u + h * 512u; u.bo = (unsigned)b * 256u * 4096u + 2048u + h * 512u; u.row0 = b * 1024 + pm * 256; u.col0 = h * 256; u.e = 0; u.valid = 256; u.aux = 0; return true;
    }
    __device__ __forceinline__ unsigned a_off(const GUnit&, int r) const { return (unsigned)r * lda; }
};
template <bool GATHER> struct MoeSched {
    const char* A; const char* Bt; unsigned lda, ldb; int K; int nN; size_t zB;
    const int* tab; const int* list; int gather; int G, c, pad;
    __device__ __forceinline__ bool next(int i, GUnit& u) const {
        int T, pn;
        if (G == 256) { const int j = c & 7, q = c >> 3, s = i * 8 + j;
            if (nN == 8) { T = 4 * s + (q >> 3); pn = q & 7; } else { T = 8 * s + (q >> 2); pn = q & 3; } }
        else { const int L = i * G + c; T = L / nN; pn = L % nN; }
        if (T >= tab[64]) return false;
        const int w = tab[128 + T]; const int e = w & 255, rt = w >> 8; const int ce = tab[e], start = tab[32 + e];
        u.e = e; u.valid = min(256, ce - rt * 256); u.row0 = start + rt * 256; u.col0 = pn * 256; u.aux = rt * 256;
        u.ao = GATHER ? 0u : (unsigned)u.row0 * lda; u.bo = (unsigned)((size_t)e * zB) + (unsigned)pn * 256u * ldb; return true;
    }
    __device__ __forceinline__ unsigned a_off(const GUnit& u, int r) const {
        if (!GATHER) return (unsigned)r * lda;
        const int rr = r < u.valid ? r : 0; const int tok = list[u.e * NTOK + u.aux + rr]; return (unsigned)tok * lda;
    }
};
__device__ __forceinline__ void moe_build_table(int* tab, const int* __restrict__ cnt, int tid) {
    if (tid < 32) tab[tid] = cnt[tid * 32];
    __syncthreads();
    if (tid < 32) { int s = 0; for (int e = 0; e < tid; ++e) s += tab[e]; tab[32 + tid] = s; }
    if (tid < 320) { int tiles = 0, found = -1;
        for (int e = 0; e < NEXP; ++e) { const int te = (tab[e] + 255) >> 8; if (found < 0 && tid < tiles + te) found = e | ((tid - tiles) << 8); tiles += te; }
        if (found >= 0) tab[128 + tid] = found; if (tid == 0) tab[64] = tiles; }
    __syncthreads();
}

__device__ __forceinline__ u32x4 pack8(const f32x4& a, const f32x4& b) { u32x4 w; w.x = pk2(a[0], a[1]); w.y = pk2(a[2], a[3]); w.z = pk2(b[0], b[1]); w.w = pk2(b[2], b[3]); return w; }
struct EpiBf16 { static constexpr bool AFTER_DRAIN = false; bf16_t* O; int ldc, pad;
    __device__ __forceinline__ void operator()(const f32x4 (&acc)[2][2][4][2], const GUnit& u, int wr, int wc, int fr, int fq) const {
        LAUNDER(fr); LAUNDER(fq);
#pragma unroll
        for (int ai = 0; ai < 2; ++ai)
#pragma unroll
            for (int m = 0; m < 4; ++m) { const int r = 128 * ai + 64 * wr + 16 * m + fr;
#pragma unroll
                for (int bj = 0; bj < 2; ++bj) *(u32x4*)(O + (size_t)(u.row0 + r) * ldc + u.col0 + 128 * bj + 32 * wc + 8 * fq) = pack8(acc[ai][bj][m][0], acc[ai][bj][m][1]); } } };
template <bool BASE_BF16> struct EpiResidSS { static constexpr bool AFTER_DRAIN = false; const void* base; bf16_t* xb; float* ss; unsigned char* xq;
    __device__ __forceinline__ void operator()(const f32x4 (&acc)[2][2][4][2], const GUnit& u, int wr, int wc, int fr, int fq) const {
        LAUNDER(fr); LAUNDER(fq);
#pragma unroll
        for (int ai = 0; ai < 2; ++ai) {
            f32x4 b[4][2][2];
#pragma unroll
            for (int m = 0; m < 4; ++m)
#pragma unroll
                for (int bj = 0; bj < 2; ++bj) { const size_t o = (size_t)(u.row0 + 128 * ai + 64 * wr + 16 * m + fr) * 1024 + u.col0 + 128 * bj + 32 * wc + 8 * fq;
                    if (BASE_BF16) { const u32x4 w = *(const u32x4*)((const bf16_t*)base + o); b[m][bj][0] = (f32x4){bflo(w.x), bfhi(w.x), bflo(w.y), bfhi(w.y)}; b[m][bj][1] = (f32x4){bflo(w.z), bfhi(w.z), bflo(w.w), bfhi(w.w)}; }
                    else { b[m][bj][0] = *(const f32x4*)((const float*)base + o); b[m][bj][1] = *(const f32x4*)((const float*)base + o + 4); } }
#pragma unroll
            for (int m = 0; m < 4; ++m) { const int r = 128 * ai + 64 * wr + 16 * m + fr; float part = 0.f;
#pragma unroll
                for (int bj = 0; bj < 2; ++bj) { const size_t o = (size_t)(u.row0 + r) * 1024 + u.col0 + 128 * bj + 32 * wc + 8 * fq;
                    const f32x4 y0 = b[m][bj][0] + acc[ai][bj][m][0], y1 = b[m][bj][1] + acc[ai][bj][m][1]; *(u32x4*)(xb + o) = pack8(y0, y1);
                    if (xq) { u32x2 q; q.x = pk4_fp8(y0[0], y0[1], y0[2], y0[3]); q.y = pk4_fp8(y1[0], y1[1], y1[2], y1[3]); *(u32x2*)(xq + o) = q; }
                    part += (y0[0] * y0[0] + y0[1] * y0[1] + y0[2] * y0[2] + y0[3] * y0[3]) + (y1[0] * y1[0] + y1[1] * y1[1] + y1[2] * y1[2] + y1[3] * y1[3]); }
                part += __shfl_xor(part, 16); part += __shfl_xor(part, 32);
                if (fq == 0) atomicAdd(ss + u.row0 + r, part); } } } };
struct EpiSoftmax { static constexpr bool AFTER_DRAIN = true; const float* ss; bf16_t* P;
    __device__ __forceinline__ void operator()(const f32x4 (&)[2][2][4][2], const GUnit&, int, int, int, int) const {}
    __device__ __forceinline__ void fused(f32x4 (&acc)[2][2][4][2], const GUnit& u, int wr, int wc, int fr, int fq, unsigned char* lds, int wid, int lane) const {
        float* Pm = (float*)lds; float* Ps = (float*)(lds + 4096);
        LAUNDER(fr); LAUNDER(fq);
#pragma unroll
        for (int ai = 0; ai < 2; ++ai)
#pragma unroll
            for (int m = 0; m < 4; ++m) { const int r = 128 * ai + 64 * wr + 16 * m + fr; const float rstd = 1.0f / sqrtf(ss[u.row0 + r] * (1.0f / 1024.0f) + EPS); float mv = -INFINITY;
#pragma unroll
                for (int bj = 0; bj < 2; ++bj)
#pragma unroll
                    for (int n = 0; n < 2; ++n) { f32x4 s = acc[ai][bj][m][n] * rstd; acc[ai][bj][m][n] = s; mv = fmaxf(mv, fmaxf(fmaxf(s[0], s[1]), fmaxf(s[2], s[3]))); }
                mv = fmaxf(mv, __shfl_xor(mv, 16)); mv = fmaxf(mv, __shfl_xor(mv, 32));
                if (fq == 0) Pm[r * 4 + wc] = mv; }
        __syncthreads();
#pragma unroll
        for (int ai = 0; ai < 2; ++ai)
#pragma unroll
            for (int m = 0; m < 4; ++m) { const int r = 128 * ai + 64 * wr + 16 * m + fr; const f32x4 pm = *(const f32x4*)(Pm + r * 4); const float mv = fmaxf(fmaxf(pm[0], pm[1]), fmaxf(pm[2], pm[3])); float sum = 0.f;
#pragma unroll
                for (int bj = 0; bj < 2; ++bj)
#pragma unroll
                    for (int n = 0; n < 2; ++n) { f32x4 s = acc[ai][bj][m][n]; s[0] = __builtin_amdgcn_exp2f(s[0] - mv); s[1] = __builtin_amdgcn_exp2f(s[1] - mv); s[2] = __builtin_amdgcn_exp2f(s[2] - mv); s[3] = __builtin_amdgcn_exp2f(s[3] - mv);
                        acc[ai][bj][m][n] = s; sum += (s[0] + s[1]) + (s[2] + s[3]); }
                sum += __shfl_xor(sum, 16); sum += __shfl_xor(sum, 32);
                if (fq == 0) Ps[r * 4 + wc] = sum; }
        __syncthreads();
#pragma unroll
        for (int ai = 0; ai < 2; ++ai)
#pragma unroll
            for (int m = 0; m < 4; ++m) { const int r = 128 * ai + 64 * wr + 16 * m + fr; const f32x4 ps = *(const f32x4*)(Ps + r * 4); const float inv = 1.0f / ((ps[0] + ps[1]) + (ps[2] + ps[3]));
#pragma unroll
                for (int bj = 0; bj < 2; ++bj) *(u32x4*)(P + (size_t)(u.row0 + r) * 1024 + u.col0 + 128 * bj + 32 * wc + 8 * fq) = pack8(acc[ai][bj][m][0] * inv, acc[ai][bj][m][1] * inv); }
        (void)wid; (void)lane;
        __syncthreads();
    } };
struct EpiGU { static constexpr bool AFTER_DRAIN = false; const float* bgu; unsigned char* act  ; const float* lrs  ;
    __device__ __forceinline__ void operator()(const f32x4 (&acc)[2][2][4][2], const GUnit& u, int wr, int wc, int fr, int fq) const {
        const int pn = u.col0 >> 8; const float* bg = bgu + (size_t)u.e * 2048; LAUNDER(fr); LAUNDER(fq);
        float rs[8];
#pragma unroll
        for (int i = 0; i < 8; ++i) { const int r = 128 * (i >> 2) + 64 * wr + 16 * (i & 3) + fr; rs[i] = lrs[(size_t)u.e * NTOK + u.aux + (r < u.valid ? r : 0)]; }
        const int col = 128 * pn + 32 * wc + 8 * fq;
        f32x4 bgv[2], blv[2];
#pragma unroll
        for (int n = 0; n < 2; ++n) { bgv[n] = *(const f32x4*)(bg + col + 4 * n); blv[n] = *(const f32x4*)(bg + 1024 + col + 4 * n); }
#pragma unroll
        for (int ai = 0; ai < 2; ++ai)
#pragma unroll
            for (int m = 0; m < 4; ++m) { const int r = 128 * ai + 64 * wr + 16 * m + fr; const float rstd = rs[ai * 4 + m]; u32x2 q;
#pragma unroll
                for (int n = 0; n < 2; ++n) { const f32x4 g = acc[ai][0][m][n] * rstd + bgv[n], l = acc[ai][1][m][n] * rstd + blv[n]; float o[4];
#pragma unroll
                    for (int j = 0; j < 4; ++j) { const float gg = fminf(g[j], 7.0f), ll = fminf(fmaxf(l[j], -7.0f), 7.0f); o[j] = (ll + 1.0f) * (gg * __builtin_amdgcn_rcpf(1.0f + __builtin_amdgcn_exp2f(-1.702f * LOG2E * gg))); }
                    const unsigned w = pk4_fp8(o[0], o[1], o[2], o[3]); if (n == 0) q.x = w; else q.y = w; }
                if (r < u.valid) *(u32x2*)(act + (size_t)(u.row0 + r) * 1024 + col) = q; } } };
struct EpiDown { static constexpr bool AFTER_DRAIN = false; const float* bdn; bf16_t* ys;
    __device__ __forceinline__ void operator()(const f32x4 (&acc)[2][2][4][2], const GUnit& u, int wr, int wc, int fr, int fq) const {
        const float* bd = bdn + (size_t)u.e * 1024; LAUNDER(fr); LAUNDER(fq);
        f32x4 bv[2][2];
#pragma unroll
        for (int bj = 0; bj < 2; ++bj)
#pragma unroll
            for (int n = 0; n < 2; ++n) bv[bj][n] = *(const f32x4*)(bd + u.col0 + 128 * bj + 32 * wc + 8 * fq + 4 * n);
#pragma unroll
        for (int ai = 0; ai < 2; ++ai)
#pragma unroll
            for (int m = 0; m < 4; ++m) { const int r = 128 * ai + 64 * wr + 16 * m + fr; if (r < u.valid) {
#pragma unroll
                for (int bj = 0; bj < 2; ++bj) *(u32x4*)(ys + (size_t)(u.row0 + r) * 1024 + u.col0 + 128 * bj + 32 * wc + 8 * fq) = pack8(acc[ai][bj][m][0] + bv[bj][0], acc[ai][bj][m][1] + bv[bj][1]); } } } };


typedef float f32x16 __attribute__((ext_vector_type(16)));
typedef short s16x4 __attribute__((ext_vector_type(4)));
__device__ __forceinline__ int crow(int r, int hi) { return (r & 3) + 8 * (r >> 2) + 4 * hi; }
__device__ __forceinline__ s16x4 tr_read(const unsigned char* p) { return __builtin_bit_cast(s16x4, __builtin_amdgcn_ds_read_tr16_b64_v4i16((LDSP s16x4*)(unsigned)(uintptr_t)p)); }
__device__ __forceinline__ bf16x8 tr_frag(const unsigned char* img, int pitch, int k0, int f0, int lane) {
    const unsigned char* p = img + (k0 + 8 * (lane >> 5) + ((lane & 15) >> 2)) * pitch + (f0 + 16 * ((lane >> 4) & 1) + 4 * (lane & 3)) * 2;
    const s16x4 lo = tr_read(p), hi = tr_read(p + 4 * pitch);
    return (bf16x8){lo[0], lo[1], lo[2], lo[3], hi[0], hi[1], hi[2], hi[3]};
}
constexpr int GA_PK = 576, GA_PV = 1088;
constexpr int GA_V = 0, GA_PART = 0, GA_GLR = 69632, GA_TOT = 73728, GA_KD = 75776, GA_END = GA_KD + 64 * GA_PK;
__device__ __forceinline__ void gla_pass_a(unsigned char* lds, int task, const bf16_t* __restrict__ xn, const bf16_t* __restrict__ wglr  , const bf16_t* __restrict__ proj,
                                           const float* __restrict__ wg, const float* __restrict__ bg, float* __restrict__ UT, float* __restrict__ decay) {
    int tid = threadIdx.x; LAUNDER(tid); int wid = tid >> 6, lane = tid & 63, fr = lane & 15, fq = lane >> 4;
    const size_t t0 = (size_t)task * 64;
    { f32x4 acc[4];
#pragma unroll
      for (int m = 0; m < 4; ++m) acc[m] = (f32x4){0.f, 0.f, 0.f, 0.f};
#pragma unroll
      for (int ks = 0; ks < 4; ++ks) { const int k = 128 * wid + 32 * ks + 8 * fq; const bf16x8 bfr = *(const bf16x8*)(wglr + (size_t)fr * 1024 + k);
#pragma unroll
          for (int m = 0; m < 4; ++m) { const bf16x8 afr = *(const bf16x8*)(xn + (t0 + 16 * m + fr) * DM + k); acc[m] = __builtin_amdgcn_mfma_f32_16x16x32_bf16(afr, bfr, acc[m], 0, 0, 0); } }
      float* part = (float*)(lds + GA_PART) + wid * 1024;
#pragma unroll
      for (int m = 0; m < 4; ++m)
#pragma unroll
          for (int j = 0; j < 4; ++j) part[(16 * m + 4 * fq + j) * 16 + fr] = acc[m][j]; }
    __syncthreads();
    { float* glr = (float*)(lds + GA_GLR); const float* part = (const float*)(lds + GA_PART);
      for (int i = tid; i < 1024; i += 512) { float s = 0.f;
#pragma unroll
          for (int w = 0; w < 8; ++w) s += part[w * 1024 + i];
          glr[i] = s; } }
    __syncthreads();
    LAUNDER(tid);
    { const int cv = tid & 63, tk = tid >> 6;
#pragma unroll
      for (int i = 0; i < 8; ++i) { const int tok = tk + 8 * i; const u32x4 v = *(const u32x4*)(proj + (t0 + tok) * PROJ_LD + C_VG + cv * 8); *(u32x4*)(lds + GA_V + tok * GA_PV + cv * 16) = v; } }
    LAUNDER(tid);
    { const int j = tid & 255, half = tid >> 8; const float* glr = (const float*)(lds + GA_GLR); float* tot = (float*)(lds + GA_TOT);
      float w[16];
#pragma unroll
      for (int i = 0; i < 16; ++i) w[i] = wg[i * 256 + j];
      const float bj = bg[j]; float run = 0.f;
      bf16_t kk16[32];
#pragma unroll
      for (int s = 0; s < 32; ++s) kk16[s] = proj[(t0 + 32 * half + s) * PROJ_LD + C_KG + j];
#pragma unroll 2
      for (int s = 0; s < 32; ++s) { const float* gl = glr + (32 * half + s) * 16; float u = bj;
#pragma unroll
          for (int i = 0; i < 16; ++i) u += gl[i] * w[i];
          const float ls = fminf(u, 0.f) - __logf(1.0f + __expf(-fabsf(u)));
          run += ls * (1.0f / 16.0f); }
      tot[half * 256 + j] = run;
      __syncthreads();
      const float t0v = tot[j], t1v = tot[256 + j]; const float gend = t0v + t1v;
      if (half == 0) decay[(size_t)task * 256 + j] = __expf(gend);
      run = half ? t0v : 0.f;
#pragma unroll
      for (int s = 0; s < 32; ++s) { const int tok = 32 * half + s; const float* gl = glr + tok * 16; float u = bj;
#pragma unroll
          for (int i = 0; i < 16; ++i) u += gl[i] * w[i];
          const float ls = fminf(u, 0.f) - __logf(1.0f + __expf(-fabsf(u)));
          run += ls * (1.0f / 16.0f);
          const float kk = bf2f(kk16[s]);
          *(bf16_t*)(lds + GA_KD + tok * GA_PK + j * 2) = (bf16_t)f2bf(kk * __expf(gend - run)); } }
    __syncthreads();
    LAUNDER(tid); wid = __builtin_amdgcn_readfirstlane(tid >> 6); lane = tid & 63;
    { const int h = wid >> 1, nt = wid & 1, hi = lane >> 5, c32 = lane & 31; f32x16 acc[4];
#pragma unroll
      for (int m = 0; m < 4; ++m)
#pragma unroll
          for (int r = 0; r < 16; ++r) acc[m][r] = 0.f;
#pragma unroll
      for (int ks = 0; ks < 4; ++ks) { const bf16x8 bfr = tr_frag(lds + GA_KD, GA_PK, 16 * ks, h * 64 + 32 * nt, lane);
#pragma unroll
          for (int m = 0; m < 4; ++m) { const bf16x8 afr = tr_frag(lds + GA_V, GA_PV, 16 * ks, h * 128 + 32 * m, lane); acc[m] = __builtin_amdgcn_mfma_f32_32x32x16_bf16(afr, bfr, acc[m], 0, 0, 0); } }
      float* u = UT + ((size_t)task * 4 + h) * 8192;
#pragma unroll
      for (int m = 0; m < 4; ++m)
#pragma unroll
          for (int r = 0; r < 16; ++r) u[(32 * m + crow(r, hi)) * 64 + 32 * nt + c32] = acc[m][r]; }
    __syncthreads();
}
__device__ __forceinline__ void gla_pass_b(int e, const float* __restrict__ UT, const float* __restrict__ decay, bf16_t* __restrict__ ST) {
    const int dk = e & 63, dv = (e >> 6) & 127, h = (e >> 13) & 3, b = e >> 15; float s = 0.f;
    const size_t base = ((size_t)b * 128 * 4 + h) * 8192 + dv * 64 + dk; const size_t dbase = (size_t)b * 128 * 256 + h * 64 + dk;
    for (int c0 = 0; c0 < 128; c0 += 32) { float u[32], d[32];
#pragma unroll
        for (int i = 0; i < 32; ++i) { u[i] = UT[base + (size_t)(c0 + i) * 4 * 8192]; d[i] = decay[dbase + (size_t)(c0 + i) * 256]; }
#pragma unroll
        for (int i = 0; i < 32; ++i) { s = d[i] * s + u[i]; ST[base + (size_t)(c0 + i) * 4 * 8192] = (bf16_t)f2bf(s); } }
}
constexpr int GC_PITCH = 520;
__device__ __forceinline__ void gla_pass_c(unsigned char* wlds  , int wtask, const bf16_t* __restrict__ ST, const bf16_t* __restrict__ proj, const float* __restrict__ ghead, bf16_t* __restrict__ mix, int lane) {
    const int nh = wtask & 1, h = (wtask >> 1) & 3, bc = wtask >> 3; const int c32 = lane & 31, hi = lane >> 5;
    const size_t t0 = (size_t)bc * 64 + 32 * nh; const bf16_t* st = ST + ((size_t)bc * 4 + h) * 8192;
    f32x16 acc[4];
#pragma unroll
    for (int m = 0; m < 4; ++m)
#pragma unroll
        for (int r = 0; r < 16; ++r) acc[m][r] = 0.f;
#pragma unroll
    for (int ks = 0; ks < 4; ++ks) { const bf16x8 bfr = *(const bf16x8*)(proj + (t0 + c32) * PROJ_LD + C_QG + h * 64 + 16 * ks + 8 * hi);
#pragma unroll
        for (int m = 0; m < 4; ++m) { const bf16x8 afr = *(const bf16x8*)(st + (32 * m + c32) * 64 + 16 * ks + 8 * hi); acc[m] = __builtin_amdgcn_mfma_f32_32x32x16_bf16(afr, bfr, acc[m], 0, 0, 0); } }
    float ss = 0.f;
#pragma unroll
    for (int m = 0; m < 4; ++m)
#pragma unroll
        for (int r = 0; r < 16; ++r) ss += acc[m][r] * acc[m][r];
    ss += __shfl_xor(ss, 32);
    const float rstd = 1.0f / sqrtf(ss * (1.0f / 128.0f) + EPS);
#pragma unroll
    for (int m = 0; m < 4; ++m)
#pragma unroll
        for (int r = 0; r < 16; ++r) *(float*)(wlds + c32 * GC_PITCH + (32 * m + crow(r, hi)) * 4) = acc[m][r] * rstd;
#pragma unroll
    for (int i = 0; i < 8; ++i) { const int q = lane + 64 * i, tok = q >> 4, dv0 = (q & 15) * 8; const float* src = (const float*)(wlds + tok * GC_PITCH + dv0 * 4);
        const u32x4 rgw = *(const u32x4*)(proj + (t0 + tok) * PROJ_LD + C_RG + h * 128 + dv0); const f32x4 g0 = *(const f32x4*)(ghead + dv0), g1 = *(const f32x4*)(ghead + dv0 + 4);
        const float rg[8] = {bflo(rgw.x), bfhi(rgw.x), bflo(rgw.y), bfhi(rgw.y), bflo(rgw.z), bfhi(rgw.z), bflo(rgw.w), bfhi(rgw.w)}; const float gg[8] = {g0.x, g0.y, g0.z, g0.w, g1.x, g1.y, g1.z, g1.w}; float y[8];
#pragma unroll
        for (int k = 0; k < 8; ++k) y[k] = src[k] * gg[k] * (rg[k] / (1.0f + __expf(-rg[k])));
        u32x4 o; o.x = pk2(y[0], y[1]); o.y = pk2(y[2], y[3]); o.z = pk2(y[4], y[5]); o.w = pk2(y[6], y[7]);
        *(u32x4*)(mix + (t0 + tok) * 1024 + h * 128 + dv0) = o; }
}
__device__ __forceinline__ void sb_task(unsigned char* vl  , int wtask, const bf16_t* __restrict__ proj, bf16_t* __restrict__ mix, int lane) {
    const int qt = wtask & 255, h = (wtask >> 8) & 7, b = wtask >> 11; const int c = lane & 31, hi = lane >> 5;
    const int t0 = qt * 32; const size_t rowb = (size_t)b * SEQ;
    bf16x8 qf[4];
#pragma unroll
    for (int d0 = 0; d0 < 4; ++d0) qf[d0] = *(const bf16x8*)(proj + (rowb + t0 + c) * PROJ_LD + C_QS + h * 64 + 16 * d0 + 8 * hi);
    const int kap = 16 * ((c >> 2) & 1) + (c & 3) + 4 * (c >> 3);
    f32x16 o0, o1;
#pragma unroll
    for (int r = 0; r < 16; ++r) { o0[r] = 0.f; o1[r] = 0.f; }
    float Dc = 1.0f;
    const bf16_t* kbase = proj + rowb * PROJ_LD + C_KS + h * 64 + 8 * hi + (size_t)kap * PROJ_LD;
    const bf16_t* vbase = proj + rowb * PROJ_LD + C_VS + h * 64 + (lane & 7) * 8 + (size_t)(lane >> 3) * PROJ_LD;
    bf16x8 kf[4]; u32x4 vr[4];
#pragma unroll
    for (int d0 = 0; d0 < 4; ++d0) kf[d0] = *(const bf16x8*)(kbase + (size_t)t0 * PROJ_LD + 16 * d0);
#pragma unroll
    for (int i = 0; i < 4; ++i) vr[i] = *(const u32x4*)(vbase + (size_t)(t0 + 8 * i) * PROJ_LD);
    for (int j0 = t0; j0 >= 0; j0 -= 32) {
#pragma unroll
        for (int i = 0; i < 4; ++i) { const int key = (lane >> 3) + 8 * i, ch = lane & 7; *(u32x4*)(vl + (ch >> 2) * 2048 + key * 64 + (ch & 3) * 16) = vr[i]; }
        bf16x8 kc[4];
#pragma unroll
        for (int d0 = 0; d0 < 4; ++d0) kc[d0] = kf[d0];
        { const int jn = (j0 >= 32) ? j0 - 32 : j0;
#pragma unroll
          for (int d0 = 0; d0 < 4; ++d0) kf[d0] = *(const bf16x8*)(kbase + (size_t)jn * PROJ_LD + 16 * d0);
#pragma unroll
          for (int i = 0; i < 4; ++i) vr[i] = *(const u32x4*)(vbase + (size_t)(jn + 8 * i) * PROJ_LD); }
        f32x16 z;
#pragma unroll
        for (int r = 0; r < 16; ++r) z[r] = 0.f;
#pragma unroll
        for (int d0 = 0; d0 < 4; ++d0) z = __builtin_amdgcn_mfma_f32_32x32x16_bf16(kc[d0], qf[d0], z, 0, 0, 0);
        float e[16], Dl[16];
        const bool diag = (j0 == t0);
#pragma unroll
        for (int r = 0; r < 16; ++r) { float ev = __builtin_amdgcn_exp2f(fminf(z[r], 126.0f)); if (diag && (16 * hi + r >= c)) ev = 0.f; e[r] = ev; }
        float D = hi ? Dc : 1.0f;
#pragma unroll
        for (int r = 15; r >= 0; --r) { D = fmaf(D, e[r], D); Dl[r] = D; }
        const float other = __shfl_xor(D, 32);
        const float mult = hi ? 1.0f : other;
        Dc = D * other;
        unsigned pw[8];
#pragma unroll
        for (int r = 0; r < 16; r += 2) { const float a0 = e[r] * __builtin_amdgcn_rcpf(Dl[r] * mult), a1 = e[r + 1] * __builtin_amdgcn_rcpf(Dl[r + 1] * mult); pw[r >> 1] = pk2(a0, a1); }
#pragma unroll
        for (int ks = 0; ks < 2; ++ks) { const bf16x8 pa = __builtin_bit_cast(bf16x8, (u32x4){pw[4 * ks], pw[4 * ks + 1], pw[4 * ks + 2], pw[4 * ks + 3]});
            const unsigned char* vb = vl + (16 * hi + 8 * ks + ((lane & 15) >> 2)) * 64 + (16 * ((lane >> 4) & 1) + 4 * (lane & 3)) * 2;
            { const s16x4 lo = tr_read(vb), hh = tr_read(vb + 256); o0 = __builtin_amdgcn_mfma_f32_32x32x16_bf16(pa, (bf16x8){lo[0], lo[1], lo[2], lo[3], hh[0], hh[1], hh[2], hh[3]}, o0, 0, 0, 0); }
            { const s16x4 lo = tr_read(vb + 2048), hh = tr_read(vb + 2048 + 256); o1 = __builtin_amdgcn_mfma_f32_32x32x16_bf16(pa, (bf16x8){lo[0], lo[1], lo[2], lo[3], hh[0], hh[1], hh[2], hh[3]}, o1, 0, 0, 0); } }
        if (__all(!(Dc < 3.0e38f))) break;
    }
    bf16_t* ob = mix + (rowb + t0) * 1024 + 512 + h * 64 + c;
#pragma unroll
    for (int r = 0; r < 16; ++r) { const int q = crow(r, hi); ob[(size_t)q * 1024] = (bf16_t)f2bf(o0[r]); ob[(size_t)q * 1024 + 32] = (bf16_t)f2bf(o1[r]); }
}
__device__ __forceinline__ void softmax_task(int gw, int lane, const float* __restrict__ S, bf16_t* __restrict__ P) {
    const f32x4 v = *((const f32x4*)(S + (size_t)gw * 256) + lane);
    float m = fmaxf(fmaxf(v.x, v.y), fmaxf(v.z, v.w));
#pragma unroll
    for (int o = 1; o < 64; o <<= 1) m = fmaxf(m, __shfl_xor(m, o));
    const float e0 = exp2f(v.x - m), e1 = exp2f(v.y - m), e2 = exp2f(v.z - m), e3 = exp2f(v.w - m);
    const float inv = 1.0f / wave_sum(e0 + e1 + e2 + e3);
    u32x2 w; w.x = pk2(e0 * inv, e1 * inv); w.y = pk2(e2 * inv, e3 * inv); *((u32x2*)(P + (size_t)gw * 256) + lane) = w;
}
__device__ __forceinline__ void router_logit(int idx, const bf16_t* __restrict__ xn, const bf16_t* __restrict__ wr, const float* __restrict__ br, float* __restrict__ lg) {
    const int t = idx >> 5, e = idx & 31; const u32x4* a = (const u32x4*)(xn + (size_t)t * DM); const u32x4* w = (const u32x4*)(wr + (size_t)e * DM); float s = 0.f;
    for (int i = 0; i < DM / 8; ++i) { const u32x4 x = a[i], y = w[i];
        s += bflo(x.x) * bflo(y.x) + bfhi(x.x) * bfhi(y.x) + bflo(x.y) * bflo(y.y) + bfhi(x.y) * bfhi(y.y) + bflo(x.z) * bflo(y.z) + bfhi(x.z) * bfhi(y.z) + bflo(x.w) * bflo(y.w) + bfhi(x.w) * bfhi(y.w); }
    lg[idx] = s + br[e];
}
__device__ __forceinline__ void router_topk(int t, const float* __restrict__ lg, int* __restrict__ cnt, int* __restrict__ list, int* __restrict__ toke, int* __restrict__ tokr, float* __restrict__ tokw) {
    float v[NEXP];
#pragma unroll
    for (int e = 0; e < NEXP; ++e) v[e] = lg[(size_t)t * NEXP + e];
    float tv[4]; int ti[4];
#pragma unroll
    for (int k = 0; k < 4; ++k) { float best = -INFINITY; int bi = 0;
#pragma unroll
        for (int e = 0; e < NEXP; ++e) { if (v[e] > best) { best = v[e]; bi = e; } }
        tv[k] = best; ti[k] = bi;
#pragma unroll
        for (int e = 0; e < NEXP; ++e) if (e == bi) v[e] = -INFINITY; }
    const float e1 = __expf(tv[1] - tv[0]), e2 = __expf(tv[2] - tv[0]), e3 = __expf(tv[3] - tv[0]); const float inv = 1.0f / (1.0f + e1 + e2 + e3);
    const float g[4] = {inv, e1 * inv, e2 * inv, e3 * inv};
#pragma unroll
    for (int k = 0; k < 4; ++k) { const int r = atomicAdd(&cnt[ti[k]], 1); list[ti[k] * NTOK + r] = t; toke[t * 4 + k] = ti[k]; tokr[t * 4 + k] = r; tokw[t * 4 + k] = g[k]; }
}
__device__ __forceinline__ void memkv_task(int wtask, int lane, const bf16_t* __restrict__ memn, const bf16_t* __restrict__ wkv, bf16_t* __restrict__ kv) {
    const int tm = wtask >> 6, tn = wtask & 63; const int c = lane & 31, hi = lane >> 5;
    const bf16_t* ap = memn + (size_t)(tm * 32 + c) * DM + 8 * hi; const bf16_t* bp = wkv + (size_t)(tn * 32 + c) * DM + 8 * hi;
    f32x16 acc;
#pragma unroll
    for (int r = 0; r < 16; ++r) acc[r] = 0.f;
#pragma unroll 16
    for (int ks = 0; ks < 64; ++ks) { const bf16x8 a = *(const bf16x8*)(ap + 16 * ks), b = *(const bf16x8*)(bp + 16 * ks); acc = __builtin_amdgcn_mfma_f32_32x32x16_bf16(a, b, acc, 0, 0, 0); }
    bf16_t* o = kv + (size_t)(tm * 32) * 2048 + tn * 32 + c;
#pragma unroll
    for (int r = 0; r < 16; ++r) o[(size_t)crow(r, hi) * 2048] = (bf16_t)f2bf(acc[r]);
}
__device__ __forceinline__ void router_task(int wtask, int lane, const bf16_t* __restrict__ xn, const float* __restrict__ ss, const bf16_t* __restrict__ wr, const float* __restrict__ br,
                                            int (&oe)[4], float (&ow)[4]) {
    const int c = lane & 31, hi = lane >> 5; const int t = wtask * 32 + c;
    const bf16_t* ap = wr + (size_t)c * DM + 8 * hi; const bf16_t* bp = xn + (size_t)t * DM + 8 * hi;
    f32x16 acc;
#pragma unroll
    for (int r = 0; r < 16; ++r) acc[r] = 0.f;
#pragma unroll 16
    for (int ks = 0; ks < 64; ++ks) { const bf16x8 a = *(const bf16x8*)(ap + 16 * ks), b = *(const bf16x8*)(bp + 16 * ks); acc = __builtin_amdgcn_mfma_f32_32x32x16_bf16(a, b, acc, 0, 0, 0); }
    float v[16]; const float rstd = 1.0f / sqrtf(ss[t] * (1.0f / 1024.0f) + EPS);
#pragma unroll
    for (int r = 0; r < 16; ++r) v[r] = acc[r] * rstd + br[crow(r, hi)];
    float tv[4]; int ti[4];
#pragma unroll
    for (int k = 0; k < 4; ++k) { float best = -INFINITY; int bi = 64;
#pragma unroll
        for (int r = 0; r < 16; ++r) { if (v[r] > best) { best = v[r]; bi = crow(r, hi); } }
        tv[k] = best; ti[k] = bi;
#pragma unroll
        for (int r = 0; r < 16; ++r) if (crow(r, hi) == bi) v[r] = -INFINITY; }
    float cv[8]; int ci[8];
#pragma unroll
    for (int k = 0; k < 4; ++k) { cv[k] = tv[k]; ci[k] = ti[k]; cv[4 + k] = __shfl_xor(tv[k], 32); ci[4 + k] = __shfl_xor(ti[k], 32); }
#pragma unroll
    for (int k = 0; k < 4; ++k) { float best = -INFINITY; int bi = 64;
#pragma unroll
        for (int q = 0; q < 8; ++q) { if (cv[q] > best || (cv[q] == best && ci[q] < bi)) { best = cv[q]; bi = ci[q]; } }
        tv[k] = best; ti[k] = bi;
#pragma unroll
        for (int q = 0; q < 8; ++q) if (ci[q] == bi) cv[q] = -INFINITY; }
    const float e1 = __expf(tv[1] - tv[0]), e2 = __expf(tv[2] - tv[0]), e3 = __expf(tv[3] - tv[0]); const float inv = 1.0f / (1.0f + e1 + e2 + e3);
    const float g[4] = {inv, e1 * inv, e2 * inv, e3 * inv};
#pragma unroll
    for (int k = 0; k < 4; ++k) { oe[k] = ti[k]; ow[k] = g[k]; }
}
__device__ __forceinline__ void combine_task(int t, int lane, const bf16_t* xin, float* xout, const bf16_t* __restrict__ ys, const int* tab, const int* __restrict__ toke, const int* __restrict__ tokr,
                                                 const float* __restrict__ tokw, const float* __restrict__ gfin) {
    const u32x2* xr = (const u32x2*)(xin + (size_t)t * DM) + lane; f32x4* xo = (f32x4*)(xout + (size_t)t * DM) + lane; f32x4 v[4];
#pragma unroll
    for (int j = 0; j < 4; ++j) { const u32x2 w = xr[64 * j]; v[j] = (f32x4){bflo(w.x), bfhi(w.x), bflo(w.y), bfhi(w.y)}; }
    for (int k = 0; k < 4; ++k) { const int e = toke[t * 4 + k], r = tokr[t * 4 + k]; const float w = tokw[t * 4 + k]; const int start = tab[32 + e];
        const u32x2* yr = (const u32x2*)(ys + (size_t)(start + r) * DM) + lane;
#pragma unroll
        for (int j = 0; j < 4; ++j) { const u32x2 y = yr[64 * j]; v[j].x += w * bflo(y.x); v[j].y += w * bfhi(y.x); v[j].z += w * bflo(y.y); v[j].w += w * bfhi(y.y); } }
    float s = 0.f;
#pragma unroll
    for (int j = 0; j < 4; ++j) s += v[j].x * v[j].x + v[j].y * v[j].y + v[j].z * v[j].z + v[j].w * v[j].w;
    const float rstd = 1.0f / sqrtf(wave_sum(s) * (1.f / DM) + EPS);
#pragma unroll
    for (int j = 0; j < 4; ++j) { const f32x4 g = *((const f32x4*)gfin + lane + 64 * j); xo[64 * j] = v[j] * rstd * g; }
}

#define GAS __attribute__((address_space(1)))
#define RLX_AGENT __ATOMIC_RELAXED, __HIP_MEMORY_SCOPE_AGENT
#define XB_TMO      128
#define XB_XCNT(j)  (256  + 64 * (j))
#define XB_XSUB(j)  (1280 + 64 * (j))
#define XB_XGEN(j)  (2304 + 64 * (j))
#define XB_TOP      3328
#define XB_TOPGEN   3392
#define XCD_BAR_WORDS 3456
#define XB_SPIN_CAP (1u << 18)
__device__ __forceinline__ unsigned xb_ld(unsigned* p)              { return __hip_atomic_load(p, __ATOMIC_RELAXED, __HIP_MEMORY_SCOPE_AGENT); }
__device__ __forceinline__ unsigned xb_add(unsigned* p, unsigned v) { return __hip_atomic_fetch_add(p, v, __ATOMIC_RELAXED, __HIP_MEMORY_SCOPE_AGENT); }
__device__ __forceinline__ unsigned xb_xcc_id() { return (unsigned)__builtin_amdgcn_s_getreg((3 << 11) | 20) & 0xFu; }
#define XB_SPIN(cond, bar) do { unsigned _sp = 0; while (cond) { __builtin_amdgcn_s_sleep(1); \
    if ((++_sp & 255u) == 0u) { if (xb_ld(&(bar)[XB_TMO])) break; if (_sp > XB_SPIN_CAP) { atomicAdd(&(bar)[XB_TMO], 1u); break; } } } } while (0)
struct XcdBarrier { unsigned* bar; unsigned x; volatile LDSP unsigned* st; };
__device__ __forceinline__ XcdBarrier xcd_barrier_post(unsigned* bar, volatile LDSP unsigned* st) {
    XcdBarrier b; b.bar = bar; b.x = xb_xcc_id(); b.st = st;
    if (threadIdx.x == 0) st[2] = xb_add(&bar[XB_XCNT(b.x)], 1u);
    return b;
}
__device__ __forceinline__ void xcd_barrier_complete(unsigned* bar, unsigned x, unsigned& nloc, unsigned& nx) {
    const unsigned G = gridDim.x * gridDim.y * gridDim.z;
    unsigned sum, cnt, mine, sp = 0u;
    for (;;) {
        sum = 0u; cnt = 0u; mine = 0u;
#pragma unroll
        for (unsigned j = 0; j < 16; ++j) { const unsigned c = xb_ld(&bar[XB_XCNT(j)]); sum += c; cnt += (c > 0u) ? 1u : 0u; mine = (j == x) ? c : mine; }
        if (sum == G) break;
        __builtin_amdgcn_s_sleep(1);
        if ((++sp & 255u) == 0u) { if (xb_ld(&bar[XB_TMO])) break; if (sp > XB_SPIN_CAP) { atomicAdd(&bar[XB_TMO], 1u); break; } }
    }
    nloc = mine > 0u ? mine : 1u; nx = cnt > 0u ? cnt : 1u;
}
__device__ __forceinline__ void xcd_barrier(const XcdBarrier& b) {
    asm volatile("s_waitcnt vmcnt(0)" ::: "memory");
    __syncthreads();
    if (threadIdx.x == 0) {
        unsigned* bar = b.bar;
        __builtin_amdgcn_s_waitcnt(0);
        unsigned nloc = b.st[0], nx = b.st[1];
        if (nloc == 0u) { xcd_barrier_complete(bar, b.x, nloc, nx); b.st[0] = nloc; b.st[1] = nx; }
        const unsigned old = xb_add(&bar[XB_XSUB(b.x)], 1u);
        const unsigned gen = old / nloc;
        if (old + 1u == (gen + 1u) * nloc) {
            __builtin_amdgcn_fence(__ATOMIC_RELEASE, "agent");
            asm volatile("s_waitcnt vmcnt(0)" ::: "memory");
            const unsigned og = xb_add(&bar[XB_TOP], 1u);
            const unsigned tg = og / nx;
            if (og + 1u == (tg + 1u) * nx) xb_add(&bar[XB_TOPGEN], 1u);
            else XB_SPIN(xb_ld(&bar[XB_TOPGEN]) == tg, bar);
            __builtin_amdgcn_fence(__ATOMIC_ACQUIRE, "agent");
            xb_add(&bar[XB_XGEN(b.x)], 1u);
            asm volatile("s_waitcnt vmcnt(0)" ::: "memory");
        } else {
            XB_SPIN(xb_ld(&bar[XB_XGEN(b.x)]) == gen, bar);
            __builtin_amdgcn_fence(__ATOMIC_ACQUIRE, "agent");
            asm volatile("s_waitcnt vmcnt(0)" ::: "memory");
        }
    }
    __syncthreads();
}

constexpr int LDS_BYTES = 147456;
constexpr int MISC_OFF = LDS_BYTES - 512;
constexpr int CW_BAR = 4096;
constexpr size_t CTL_ZERO_BYTES = 196608;
constexpr int NPHASE = 12;
struct Args { const float* in[22]; float* out; unsigned char* ws; int ph_lo, ph_hi; };

__global__ void __launch_bounds__(512, 2) mega(Args a) {
    extern __shared__ __attribute__((aligned(16))) unsigned char lds[];
    unsigned char* ws = a.ws; float* out = a.out;
    const float* x = a.in[0]; const float* mem = a.in[1]; const float* g_mix = a.in[2]; const float* w_in = a.in[3];
    const float* w_gla_gate = a.in[4]; const float* b_gla_gate = a.in[5]; const float* g_gla_head = a.in[6]; const float* w_out = a.in[7];
    const float* g_mem_q = a.in[8]; const float* g_mem_kv = a.in[9]; const float* w_mq = a.in[10]; const float* w_mk = a.in[11];
    const float* w_mv = a.in[12]; const float* w_mo = a.in[13]; const float* g_ffn = a.in[14]; const float* w_router = a.in[15];
    const float* b_router = a.in[16]; const float* w_gu = a.in[17]; const float* b_gu = a.in[18]; const float* w_down = a.in[19];
    const float* b_down = a.in[20]; const float* g_final = a.in[21];
    bf16_t* Wt_in = (bf16_t*)(ws + WS_WIN); bf16_t* Wt_out = (bf16_t*)(ws + WS_WOUT); bf16_t* Wq = (bf16_t*)(ws + WS_WQ); bf16_t* Wt_kv = (bf16_t*)(ws + WS_WKV);
    bf16_t* Wt_mo = (bf16_t*)(ws + WS_WMO); bf16_t* Wt_r = (bf16_t*)(ws + WS_WR); bf16_t* Wt_gu = (bf16_t*)(ws + WS_WGU); bf16_t* Wt_dn = (bf16_t*)(ws + WS_WDN);
    bf16_t* xn = (bf16_t*)(ws + WS_XN); bf16_t* memn = (bf16_t*)(ws + WS_MEMN); bf16_t* kv = (bf16_t*)(ws + WS_KV); bf16_t* Bs = (bf16_t*)(ws + WS_BS); bf16_t* Bo = (bf16_t*)(ws + WS_BO);
    bf16_t* proj = (bf16_t*)(ws + WS_PROJ); bf16_t* mix = (bf16_t*)(ws + WS_MIX);
    float* Sc = (float*)(ws + WS_S); bf16_t* P = (bf16_t*)(ws + WS_P); float* lg = (float*)(ws + WS_LG); int* toke = (int*)(ws + WS_TOKE); int* tokr = (int*)(ws + WS_TOKR);
    float* tokw = (float*)(ws + WS_TOKW); int* list = (int*)(ws + WS_LIST); bf16_t* act = (bf16_t*)(ws + WS_ACT); bf16_t* ys = (bf16_t*)(ws + WS_YS);
    unsigned char* Wq_gu = ws + WS_WGU; unsigned char* Wq_dn = ws + WS_WDN; unsigned char* x2q = ws + WS_S; unsigned char* act8 = ws + WS_ACT;
    float* lrs = (float*)(ws + WS_LG);
    float* UT = (float*)(ws + WS_S); float* decay = (float*)(ws + WS_LA); bf16_t* ST = (bf16_t*)(ws + WS_ORAW);
    unsigned* ctl = (unsigned*)(ws + WS_CTL); int* cnt = (int*)ctl + CW_CNT; float* ss1 = (float*)(ws + WS_CTL + 65536); float* ss2 = (float*)(ws + WS_CTL + 131072);

    const int G = gridDim.x; int vb = blockIdx.x;
    volatile LDSP unsigned* MISC = (volatile LDSP unsigned*)(unsigned)(uintptr_t)(lds + MISC_OFF);
    if (threadIdx.x < 128) MISC[threadIdx.x] = 0u;
    __syncthreads();
    XcdBarrier bar = xcd_barrier_post(ctl + CW_BAR, MISC + 8);
    const int lo = a.ph_lo, hi = a.ph_hi;
    float* dmy = (float*)(ws + WS_DUMMY); (void)dmy;
#ifndef REPEAT_MASK
#define REPEAT_MASK 0
#endif
#define IN(k) (lo <= (k) && (k) < hi)
#define REP(k) for (int rep_ = 0; rep_ < 1 + ((REPEAT_MASK >> (k)) & 1); ++rep_)
#define SEAM(k) do { if (IN(k) && IN((k) + 1)) xcd_barrier(bar); } while (0)
#define TIDS() int tid = threadIdx.x; LAUNDER(tid); const int lane = tid & 63; const int wid = __builtin_amdgcn_readfirstlane(tid >> 6); (void)lane; (void)wid

    if (IN(0)) REP(0) { TIDS(); const size_t gt = (size_t)vb * 512 + tid, gs = (size_t)G * 512;
        float* scr = (float*)(lds + wid * 8448);
        const int gw = vb * 8 + wid, ngw = G * 8;
        rms_body(gw, ngw, lane, x, xn, NTOK);
        rms_body(gw, ngw, lane, mem, memn, NB * MEML);
        conv_n_body(gt, gs, w_mq, Wq, g_mem_q, 1024, 1024, LOG2E / 16.0f);
        constexpr int I_IN = 16 * 97, I_SQ = 16 * 32, I_R = 16, I_GU = 32 * 16 * 64, I_DN = 32 * 16 * 32;
        constexpr int NITEMS = I_IN + 4 * I_SQ + I_R + I_GU + I_DN;
        for (int it = gw; it < NITEMS; it += ngw) { int r = it;
            if (r < I_IN) { conv_item<1>(scr, w_in, Wt_in, g_mix, 3088, 1024, 3088, r / 97, r % 97, lane); continue; } r -= I_IN;
            if (r < I_SQ) { conv_item<0>(scr, w_out, Wt_out, nullptr, 1024, 1024, 1024, r >> 5, r & 31, lane); continue; } r -= I_SQ;
            if (r < I_SQ) { conv_item<0>(scr, w_mk, Wt_kv, g_mem_kv, 1024, 1024, 1024, r >> 5, r & 31, lane); continue; } r -= I_SQ;
            if (r < I_SQ) { conv_item<0>(scr, w_mv, Wt_kv + (size_t)1024 * 1024, g_mem_kv, 1024, 1024, 1024, r >> 5, r & 31, lane); continue; } r -= I_SQ;
            if (r < I_SQ) { conv_item<0>(scr, w_mo, Wt_mo, nullptr, 1024, 1024, 1024, r >> 5, r & 31, lane); continue; } r -= I_SQ;
            if (r < I_R) { conv_item<0>(scr, w_router, Wt_r, g_ffn, 32, 1024, 32, r, 0, lane); continue; } r -= I_R;
            if (r < I_GU) { const int e = r >> 10, q = r & 1023; conv_item8<2>(scr, w_gu + (size_t)e * 1024 * 2048, Wq_gu + (size_t)e * 2048 * 1024, g_ffn, 2048, 1024, 2048, q >> 6, q & 63, lane, (float)(1 << WSCALE_LOG2)); continue; } r -= I_GU;
            { const int e = r >> 9, q = r & 511; conv_item8<0>(scr, w_down + (size_t)e * 1024 * 1024, Wq_dn + (size_t)e * 1024 * 1024, nullptr, 1024, 1024, 1024, q >> 5, q & 31, lane, (float)(1 << WSCALE_LOG2)); } }
        __syncthreads(); }
    SEAM(0);
    if (IN(0) && IN(1) && G == 256) { unsigned ok = 1u;
#pragma unroll
        for (unsigned j = 0; j < 16; ++j) { const unsigned cj = xb_ld(&bar.bar[XB_XCNT(j)]); ok &= (j < 8u) ? (cj == 32u) : (cj == 0u); }
        __syncthreads();
        if (ok) { const unsigned q = MISC[10]; if (q < 32u && bar.x < 8u) vb = (int)(bar.x + 8u * q); } }
    if (IN(1)) REP(1) { DenseSched S{(const char*)xn, (const char*)Wt_in, 2048u, 2048u, 1024, 64, 12, 1 << 30, 0, G, vb}; EpiBf16 E{proj, PROJ_LD, 0}; gemm_run<true>(lds, S, E); }
    SEAM(1);
    if (IN(2)) REP(2) {
        for (int t = vb; t < 256; t += G) gla_pass_a(lds, t, xn, Wt_in + (size_t)3072 * 1024, proj, w_gla_gate, b_gla_gate, UT, decay);
        { TIDS(); for (int t = vb * 8 + wid; t < 4096; t += G * 8) sb_task(lds + wid * 4096, t, proj, mix, lane); }
        { TIDS(); for (int t = vb + G * wid; t < 1024; t += G * 8) memkv_task(t, lane, memn, Wt_kv, kv); } }
    SEAM(2);
    if (IN(3)) REP(3) {
        { TIDS(); for (int e = vb * 512 + tid; e < 65536; e += G * 512) gla_pass_b(e, UT, decay, ST); }
        { SchedWqk S{(const char*)kv, (const char*)Wq, 4096u, 2048u, 256, G / 2, vb - G / 2, 0}; EpiBf16 E{Bs, 1024, 0}; gemm_run<false>(lds, S, E); }
        { SchedVo S{(const char*)Wt_mo, (const char*)kv, 2048u, 4096u, 256, G / 2, vb - G / 2 - 32, 0}; EpiBf16 E{Bo, 1024, 0}; gemm_run<false>(lds, S, E); } }
    SEAM(3);
    if (IN(4)) REP(4) { TIDS(); for (int t = vb * 8 + wid; t < 2048; t += G * 8) gla_pass_c(lds + wid * 32 * GC_PITCH, t, ST, proj, g_gla_head, mix, lane); }
    SEAM(4);
#if PROBE_BARRIERS
    for (int pb_ = 0; pb_ < 8; ++pb_) xcd_barrier(bar);
#endif
    if (IN(5)) REP(5) { DenseSched S{(const char*)mix, (const char*)Wt_out, 2048u, 2048u, 1024, 64, 4, 1 << 30, 0, G, vb}; EpiResidSS<false> E{x, rep_ ? (bf16_t*)dmy : xn, rep_ ? dmy + 16 * 1024 * 1024 : ss1, nullptr}; gemm_run<false>(lds, S, E); }
    SEAM(5);
    if (IN(6)) REP(6) { DenseSched S{(const char*)xn, (const char*)Bs, 2048u, 2048u, 1024, 64, 4, 32, (size_t)1024 * 2048, G, vb}; EpiSoftmax E{ss1, P}; gemm_run<false>(lds, S, E); }
    SEAM(6);
    if (IN(7)) REP(7) { DenseSched S{(const char*)P, (const char*)Bo, 2048u, 2048u, 1024, 64, 4, 32, (size_t)1024 * 2048, G, vb}; EpiResidSS<true> E{xn, rep_ ? (bf16_t*)dmy : xn, rep_ ? dmy + 16 * 1024 * 1024 : ss2, rep_ ? (unsigned char*)dmy + 40 * 1024 * 1024 : x2q}; gemm_run<false>(lds, S, E); }
    SEAM(7);
    if (IN(8)) REP(8) { TIDS(); int* cntp = rep_ ? (int*)ctl + 2048 : cnt; int* listp = rep_ ? (int*)dmy + 1024 : list; float* lrsp = rep_ ? dmy + 4096 * 1024 : lrs; int* tokep = rep_ ? (int*)dmy + 1024 * 1024 : toke; int* tokrp = rep_ ? (int*)dmy + 2048 * 1024 : tokr; float* tokwp = rep_ ? dmy + 3072 * 1024 : tokw;
        int* lcnt = (int*)lds; int* gbase = (int*)lds + 32;
        for (int tb = vb; tb < NTOK / 64; tb += G) {
            if (tid < 32) lcnt[tid] = 0;
            __syncthreads();
            int oe[4] = {0, 0, 0, 0}; float ow[4] = {0.f, 0.f, 0.f, 0.f}; int lr[4] = {0, 0, 0, 0};
            if (wid < 2) { router_task(tb * 2 + wid, lane, xn, ss2, Wt_r, b_router, oe, ow);
                if (lane < 32) {
#pragma unroll
                    for (int k = 0; k < 4; ++k) lr[k] = atomicAdd(&lcnt[oe[k]], 1); } }
            __syncthreads();
            if (tid < 32) gbase[tid] = atomicAdd(&cntp[tid * 32], lcnt[tid]);
            __syncthreads();
            if (wid < 2 && lane < 32) { const int t = (tb * 2 + wid) * 32 + lane;
                const float rstd_t = 1.0f / sqrtf(ss2[t] * (1.0f / 1024.0f) + EPS);
#pragma unroll
                for (int k = 0; k < 4; ++k) { const int r = gbase[oe[k]] + lr[k]; listp[oe[k] * NTOK + r] = t; lrsp[oe[k] * NTOK + r] = rstd_t; tokep[t * 4 + k] = oe[k]; tokrp[t * 4 + k] = r; tokwp[t * 4 + k] = ow[k]; } }
            __syncthreads(); } }
    SEAM(8);
    if (IN(9)) REP(9) { int* tab = (int*)(lds + 131072); { TIDS(); moe_build_table(tab, cnt, tid); }
        MoeSched<true> S{(const char*)x2q, (const char*)Wq_gu, 1024u, 1024u, 512, 8, (size_t)2048 * 1024, tab, list, 1, G, vb, 0}; EpiGU E{b_gu, act8, lrs}; gemm_run_fp8<true>(lds, S, E); }
    SEAM(9);
    if (IN(10)) REP(10) { int* tab = (int*)(lds + 131072); { TIDS(); moe_build_table(tab, cnt, tid); }
        MoeSched<false> S{(const char*)act8, (const char*)Wq_dn, 1024u, 1024u, 512, 4, (size_t)1024 * 1024, tab, list, 0, G, vb, 0}; EpiDown E{b_down, ys}; gemm_run_fp8<true>(lds, S, E); }
    SEAM(10);
    if (IN(11)) REP(11) { TIDS(); int* tab = (int*)(lds + 131072); moe_build_table(tab, cnt, tid);
        for (int t = vb * 8 + wid; t < NTOK; t += G * 8) combine_task(t, lane, xn, rep_ ? dmy : out, ys, tab, toke, tokr, tokw, g_final); }
#undef IN
#undef SEAM
#undef TIDS
}

#ifndef MK_PER_PHASE
#define MK_PER_PHASE 0
#endif
extern "C" void kernel_launch(void* const* d_in, const int* in_sizes, int n_in, void* d_out, int out_size, void* d_ws, size_t ws_size, hipStream_t stream) {
    static int grid = 0;
    if (grid == 0) {
        if (n_in != 22 || in_sizes[0] != NTOK * DM || out_size != NTOK * DM || ws_size < WS_END) { fprintf(stderr, "kernel_launch: unexpected shapes (n_in %d, ws %zu)\n", n_in, ws_size); grid = -1; return; }
        int dev = 0, cus = 0, per_cu = 0;
        if (hipGetDevice(&dev) != hipSuccess || hipDeviceGetAttribute(&cus, hipDeviceAttributeMultiprocessorCount, dev) != hipSuccess) { grid = -1; return; }
        if (hipFuncSetAttribute((const void*)mega, hipFuncAttributeMaxDynamicSharedMemorySize, LDS_BYTES) != hipSuccess) { fprintf(stderr, "kernel_launch: hipFuncSetAttribute failed\n"); grid = -1; return; }
        if (hipOccupancyMaxActiveBlocksPerMultiprocessor(&per_cu, (const void*)mega, 512, LDS_BYTES) != hipSuccess || per_cu < 1) fprintf(stderr, "kernel_launch: occupancy query says %d blocks/CU\n", per_cu);
        (void)hipGetLastError();
        grid = cus;
    }
    if (grid < 0) return;
    (void)hipMemsetAsync((char*)d_ws + WS_CTL, 0, CTL_ZERO_BYTES, stream);
    Args a{};
    for (int i = 0; i < 22; ++i) a.in[i] = (const float*)d_in[i];
    a.out = (float*)d_out; a.ws = (unsigned char*)d_ws;
#if MK_PER_PHASE
    for (int p = 0; p < NPHASE; ++p) { a.ph_lo = p; a.ph_hi = p + 1; hipLaunchKernelGGL(mega, dim3(grid), dim3(512), LDS_BYTES, stream, a); }
#else
    a.ph_lo = 0; a.ph_hi = NPHASE; hipLaunchKernelGGL(mega, dim3(grid), dim3(512), LDS_BYTES, stream, a);
#endif
}
```

```cpp
#include <hip/hip_runtime.h>
#include <cstdio>
#include <cstdint>
#ifndef PROBE_BARRIERS
#define PROBE_BARRIERS 0
#endif

typedef unsigned short bf16_t;
typedef short bf16x8 __attribute__((ext_vector_type(8)));
typedef float f32x4 __attribute__((ext_vector_type(4)));
typedef unsigned u32x4 __attribute__((ext_vector_type(4)));
typedef unsigned u32x2 __attribute__((ext_vector_type(2)));
typedef float f32x2 __attribute__((ext_vector_type(2)));
#define LDSP __attribute__((address_space(3)))
#define LAUNDER(x) asm volatile("" : "+v"(x))

constexpr int NB = 2, SEQ = 8192, NTOK = NB * SEQ, DM = 1024, MEML = 256;
constexpr int NEXP = 32, TOPK = 4, NASSIGN = NTOK * TOPK;
constexpr int PROJ_LD = 3072;
constexpr int C_QG = 0, C_KG = 256, C_VG = 512, C_RG = 1024, C_QS = 1536, C_KS = 2048, C_VS = 2560, C_GLR = 3072;
constexpr float LOG2E = 1.4426950408889634f;
constexpr float EPS = 1e-5f;

__device__ __forceinline__ unsigned f2bf(float f) { unsigned u = __float_as_uint(f); return (u + 0x7fffu + ((u >> 16) & 1u)) >> 16; }
__device__ __forceinline__ unsigned pk2(float lo, float hi) { return f2bf(lo) | (f2bf(hi) << 16); }
__device__ __forceinline__ float bf2f(bf16_t h) { return __uint_as_float(((unsigned)h) << 16); }
__device__ __forceinline__ float bflo(unsigned w) { return __uint_as_float(w << 16); }
__device__ __forceinline__ float bfhi(unsigned w) { return __uint_as_float(w & 0xffff0000u); }

constexpr size_t MiB = 1u << 20;
constexpr size_t WS_CTL = 0;
constexpr size_t WS_WIN = 1 * MiB;
constexpr size_t WS_WOUT = 8 * MiB;
constexpr size_t WS_WQ = 10 * MiB;
constexpr size_t WS_WKV = 12 * MiB;
constexpr size_t WS_WMO = 16 * MiB;
constexpr size_t WS_WR = 18 * MiB;
constexpr size_t WS_WGU = 20 * MiB;
constexpr size_t WS_WDN = 148 * MiB;
constexpr size_t WS_XN = 212 * MiB;
constexpr size_t WS_MEMN = 244 * MiB;
constexpr size_t WS_KV = 245 * MiB;
constexpr size_t WS_BS = 247 * MiB;
constexpr size_t WS_BO = 251 * MiB;
constexpr size_t WS_PROJ = 256 * MiB;
constexpr size_t WS_LA = 360 * MiB;
constexpr size_t WS_ORAW = 376 * MiB;
constexpr size_t WS_MIX = 408 * MiB;
constexpr size_t WS_S = 440 * MiB;
constexpr size_t WS_P = 504 * MiB;
constexpr size_t WS_LG = 536 * MiB;
constexpr size_t WS_TOKE = 538 * MiB;
constexpr size_t WS_TOKR = 539 * MiB;
constexpr size_t WS_TOKW = 540 * MiB;
constexpr size_t WS_LIST = 541 * MiB;
constexpr size_t WS_ACT = 544 * MiB;
constexpr size_t WS_YS = 674 * MiB;
constexpr size_t WS_DUMMY = 804 * MiB;
constexpr size_t WS_END = 872 * MiB;
constexpr int CW_CNT = 1024;

template <int MAP> __device__ __forceinline__ int srccol(int n, float& sc) {
    sc = 1.f;
    if (MAP == 0) return n;
    if (MAP == 1) {
        if (n < 256) { sc = 0.125f; return n; }
        if (n < 1024) return n;
        if (n < 3072) { if (n >= C_QS && n < C_KS) sc = 0.125f * LOG2E; return n + 16; }
        if (n < 3088) return 1024 + (n - 3072);
        return -1;
    }
    { const int ct = n >> 8, w = n & 255; return (w < 128) ? (128 * ct + w) : (1024 + 128 * ct + (w - 128)); }
}
template <int MAP>
__device__ __forceinline__ void conv_t_body(size_t gtid, size_t gsz, const float* __restrict__ src, bf16_t* __restrict__ dst, const float* __restrict__ gain,
                                               int ldsrc, int K, int nrows, int nmat, size_t sms, size_t dms) {
    const int kc8 = K / 8;
    const size_t total = (size_t)nmat * nrows * kc8;
    for (size_t idx = gtid; idx < total; idx += gsz) {
        const int n = (int)(idx % nrows); const size_t t = idx / nrows; const int kc = (int)(t % kc8); const int mat = (int)(t / kc8);
        float sc; const int c = srccol<MAP>(n, sc);
        u32x4 o = {0u, 0u, 0u, 0u};
        if (c >= 0) {
            const float* s = src + (size_t)mat * sms + (size_t)(kc * 8) * ldsrc + c;
            float v[8];
#pragma unroll
            for (int j = 0; j < 8; ++j) v[j] = s[(size_t)j * ldsrc] * (gain ? gain[kc * 8 + j] : 1.f) * sc;
            o.x = pk2(v[0], v[1]); o.y = pk2(v[2], v[3]); o.z = pk2(v[4], v[5]); o.w = pk2(v[6], v[7]);
        }
        *(u32x4*)(dst + (size_t)mat * dms + (size_t)n * K + kc * 8) = o;
    }
}
template <int MAP>
__device__ __forceinline__ void conv_item(float* scr, const float* __restrict__ src, bf16_t* __restrict__ dst, const float* __restrict__ gain, int ldsrc, int K, int nrows, int kb, int nb, int lane) {
    const int k0 = kb * 64, n0 = nb * 32; float sc; const int c0 = srccol<MAP>(n0, sc);
    const int half = lane >> 5, l31 = lane & 31;
    const float* s0 = src + (size_t)(k0 + half) * ldsrc + c0 + l31;
    float v[32];
#pragma unroll
    for (int i = 0; i < 32; ++i) v[i] = s0[(size_t)(2 * i) * ldsrc];
#pragma unroll
    for (int i = 0; i < 32; ++i) { const int kk = 2 * i + half; const float g = (gain ? gain[k0 + kk] : 1.f) * sc; scr[kk * 33 + l31] = v[i] * g; }
    asm volatile("s_waitcnt lgkmcnt(0)" ::: "memory");
    const int c = lane & 7;
#pragma unroll
    for (int j = 0; j < 4; ++j) { const int n = (lane >> 3) + 8 * j; const float* s = scr + (8 * c) * 33 + n;
        u32x4 o; o.x = pk2(s[0 * 33], s[1 * 33]); o.y = pk2(s[2 * 33], s[3 * 33]); o.z = pk2(s[4 * 33], s[5 * 33]); o.w = pk2(s[6 * 33], s[7 * 33]);
        if (n0 + n < nrows) *(u32x4*)(dst + (size_t)(n0 + n) * K + k0 + 8 * c) = o; }
    asm volatile("s_waitcnt lgkmcnt(0)" ::: "memory");
}
__device__ __forceinline__ unsigned pk4_fp8(float a, float b, float c, float d) { int w = __builtin_amdgcn_cvt_pk_fp8_f32(a, b, 0, false); w = __builtin_amdgcn_cvt_pk_fp8_f32(c, d, w, true); return (unsigned)w; }
template <int MAP>
__device__ __forceinline__ void conv_item8(float* scr, const float* __restrict__ src, unsigned char* __restrict__ dst, const float* __restrict__ gain, int ldsrc, int K, int nrows, int kb, int nb, int lane, float mul) {
    const int k0 = kb * 64, n0 = nb * 32; float sc; const int c0 = srccol<MAP>(n0, sc); sc *= mul;
    const int half = lane >> 5, l31 = lane & 31;
    const float* s0 = src + (size_t)(k0 + half) * ldsrc + c0 + l31;
    float v[32];
#pragma unroll
    for (int i = 0; i < 32; ++i) v[i] = s0[(size_t)(2 * i) * ldsrc];
#pragma unroll
    for (int i = 0; i < 32; ++i) { const int kk = 2 * i + half; const float g = (gain ? gain[k0 + kk] : 1.f) * sc; scr[kk * 33 + l31] = v[i] * g; }
    asm volatile("s_waitcnt lgkmcnt(0)" ::: "memory");
    const int c = lane & 3;
#pragma unroll
    for (int j = 0; j < 2; ++j) { const int n = (lane >> 2) + 16 * j; const float* s = scr + (16 * c) * 33 + n;
        u32x4 o; o.x = pk4_fp8(s[0 * 33], s[1 * 33], s[2 * 33], s[3 * 33]); o.y = pk4_fp8(s[4 * 33], s[5 * 33], s[6 * 33], s[7 * 33]);
        o.z = pk4_fp8(s[8 * 33], s[9 * 33], s[10 * 33], s[11 * 33]); o.w = pk4_fp8(s[12 * 33], s[13 * 33], s[14 * 33], s[15 * 33]);
        if (n0 + n < nrows) *(u32x4*)(dst + (size_t)(n0 + n) * K + k0 + 16 * c) = o; }
    asm volatile("s_waitcnt lgkmcnt(0)" ::: "memory");
}
__device__ __forceinline__ void conv_n_body(size_t gtid, size_t gsz, const float* __restrict__ src, bf16_t* __restrict__ dst, const float* __restrict__ gain, int K, int nrows, float sc) {
    const int kc8 = K / 8; const size_t total = (size_t)nrows * kc8;
    for (size_t idx = gtid; idx < total; idx += gsz) {
        const int kc = (int)(idx % kc8), n = (int)(idx / kc8);
        const float g = gain[n] * sc; const f32x4 a = *(const f32x4*)(src + (size_t)n * K + kc * 8), b = *(const f32x4*)(src + (size_t)n * K + kc * 8 + 4);
        u32x4 o; o.x = pk2(a.x * g, a.y * g); o.y = pk2(a.z * g, a.w * g); o.z = pk2(b.x * g, b.y * g); o.w = pk2(b.z * g, b.w * g);
        *(u32x4*)(dst + (size_t)n * K + kc * 8) = o;
    }
}

__device__ __forceinline__ float wave_sum(float v) {
#pragma unroll
    for (int o = 1; o < 64; o <<= 1) v += __shfl_xor(v, o);
    return v;
}
__device__ __forceinline__ void rms_body(int gw, int ngw, int lane, const float* __restrict__ x, bf16_t* __restrict__ out, int nrows) {
    for (int row = gw; row < nrows; row += ngw) {
        const f32x4* xr = (const f32x4*)(x + (size_t)row * DM) + lane; f32x4 v[4]; float s = 0.f;
#pragma unroll
        for (int j = 0; j < 4; ++j) { v[j] = xr[64 * j]; s += v[j].x * v[j].x + v[j].y * v[j].y + v[j].z * v[j].z + v[j].w * v[j].w; }
        const float rstd = 1.0f / sqrtf(wave_sum(s) * (1.f / DM) + EPS);
        u32x2* o = (u32x2*)(out + (size_t)row * DM) + lane;
#pragma unroll
        for (int j = 0; j < 4; ++j) { u32x2 w; w.x = pk2(v[j].x * rstd, v[j].y * rstd); w.y = pk2(v[j].z * rstd, v[j].w * rstd); o[64 * j] = w; }
    }
}

struct GUnit { unsigned ao, bo; int row0, col0, e, valid, aux; };

__host__ __device__ __forceinline__ int lds_byte(int r, int c) { const int st = (r >> 4) * 2 + (c >> 5), rr = r & 15, cc = c & 31, ob = rr * 64 + cc * 2; return st * 1024 + (ob ^ (((ob >> 9) & 1) << 5)); }
__host__ __device__ __forceinline__ void stage_rc(int b, int& R, int& C) { const int st = b / 1024, sb = b % 1024, swz = sb ^ (((sb >> 9) & 1) << 5); R = (st >> 1) * 16 + swz / 64; C = (st & 1) * 32 + (swz % 64) / 2; }
__host__ __device__ __forceinline__ int perm32(int rho) { const int n = rho >> 4, i = rho & 15; return 8 * (i >> 2) + 4 * n + (i & 3); }
constexpr int HTB = 128 * 64 * 2;
typedef int v8i __attribute__((ext_vector_type(8)));
typedef int v4i __attribute__((ext_vector_type(4)));
struct Frag2 { bf16x8 h[2]; };
template <bool F> struct FragT { typedef Frag2 T; };
template <> struct FragT<true> { typedef v8i T; };
template <class Sched, class Epi, bool ALIGN_EPI, bool FP8 = false, int SCALE_B = 0x7f>
__device__ __forceinline__ void gemm_phase(unsigned char* lds_flat, const Sched& S, const Epi& E) {
    LDSP unsigned char* lds = (LDSP unsigned char*)(unsigned)(uintptr_t)lds_flat;
    int tid = threadIdx.x; LAUNDER(tid);
    const int wid = __builtin_amdgcn_readfirstlane(tid >> 6), lane = tid & 63, wr = wid >> 2, wc = wid & 3, fr = lane & 15, fq = lane >> 4;
    const int nt = S.K / 64;
    int Rr[2], Cc[2];
#pragma unroll
    for (int i = 0; i < 2; ++i) stage_rc(tid * 16 + i * 8192, Rr[i], Cc[i]);
    unsigned voffB[2][2];
#pragma unroll
    for (int h = 0; h < 2; ++h)
#pragma unroll
        for (int i = 0; i < 2; ++i) voffB[h][i] = (unsigned)(128 * h + (Rr[i] & ~31) + perm32(Rr[i] & 31)) * S.ldb + (unsigned)Cc[i] * 2u;
    const unsigned ldsw = (unsigned)wid * 1024u;
    const int aoff = lds_byte(wr * 64 + fr, FP8 ? fq * 16 : fq * 8), boff = lds_byte(wc * 32 + fr, FP8 ? fq * 16 : fq * 8);
    constexpr int KSUB = FP8 ? 16 : 1024;
#define PG8_SA(b, h) (((b) * 2 + (h)) * HTB)
#define PG8_SB(b, h) ((4 + (b) * 2 + (h)) * HTB)
#define PG8_STAGE(bufoff, rsrc, voff, soff) do { _Pragma("unroll") for (int _i = 0; _i < 2; ++_i) \
        __builtin_amdgcn_raw_ptr_buffer_load_lds(rsrc, (LDSP unsigned*)(lds + (bufoff) + ldsw + _i * 8192), 16, (int)(voff)[_i], (int)(soff), 0, 0); } while (0)
#define PG8_LDF(dst, addr) do { const bf16x8 lo_ = *(const LDSP bf16x8*)(addr); const bf16x8 hi_ = *(const LDSP bf16x8*)((addr) + KSUB); \
        if constexpr (FP8) dst = __builtin_shufflevector(__builtin_bit_cast(v4i, lo_), __builtin_bit_cast(v4i, hi_), 0, 1, 2, 3, 4, 5, 6, 7); else { dst.h[0] = lo_; dst.h[1] = hi_; } } while (0)
#define PG8_LDA(dst, b, h) do { _Pragma("unroll") for (int m = 0; m < 4; ++m) PG8_LDF(dst[m], lds + PG8_SA(b, h) + aoff + m * 2048); } while (0)
#define PG8_LDB(dst, b, h) do { _Pragma("unroll") for (int n = 0; n < 2; ++n) PG8_LDF(dst[n], lds + PG8_SB(b, h) + boff + n * 2048); } while (0)
#define PG8_MMA(ai, bj, At, Bt) do { __builtin_amdgcn_s_setprio(1); _Pragma("unroll") for (int m = 0; m < 4; ++m) _Pragma("unroll") for (int n = 0; n < 2; ++n) { \
        if constexpr (FP8) asm volatile("v_mfma_scale_f32_16x16x128_f8f6f4 %0, %1, %2, %0, %3, %4 op_sel_hi:[0,0,0]" : "+v"(acc[ai][bj][m][n]) : "v"(Bt[n]), "v"(At[m]), "v"(sclB), "v"(sclA)); \
        else { _Pragma("unroll") for (int k = 0; k < 2; ++k) acc[ai][bj][m][n] = __builtin_amdgcn_mfma_f32_16x16x32_bf16(Bt[n].h[k], At[m].h[k], acc[ai][bj][m][n], 0, 0, 0); } } \
        __builtin_amdgcn_s_setprio(0); } while (0)
#define PG8_WAIT_V(n) asm volatile("s_waitcnt vmcnt(" #n ")" ::: "memory")
#define PG8_WAIT_L(n) asm volatile("s_waitcnt lgkmcnt(" #n ")" ::: "memory")
#define PG8_BAR __builtin_amdgcn_s_barrier()
#define PG8_SCHED __builtin_amdgcn_sched_barrier(0)
    GUnit cur, nxt; int ui = 0;
    if (!S.next(0, cur)) return;
    const __amdgpu_buffer_rsrc_t rA = __builtin_amdgcn_make_buffer_rsrc((void*)S.A, 0, 0x7fffffff, 0x00020000);
    const __amdgpu_buffer_rsrc_t rB = __builtin_amdgcn_make_buffer_rsrc((void*)S.Bt, 0, 0x7fffffff, 0x00020000);
    unsigned oc[2][2], on[2][2];
#pragma unroll
    for (int h = 0; h < 2; ++h)
#pragma unroll
        for (int i = 0; i < 2; ++i) oc[h][i] = S.a_off(cur, 128 * h + Rr[i]) + (unsigned)Cc[i] * 2u;
    f32x4 acc[2][2][4][2];
#pragma unroll
    for (int a = 0; a < 2; ++a)
#pragma unroll
        for (int b = 0; b < 2; ++b)
#pragma unroll
            for (int m = 0; m < 4; ++m)
#pragma unroll
                for (int n = 0; n < 2; ++n) acc[a][b][m][n] = (f32x4){0.f, 0.f, 0.f, 0.f};
    typedef typename FragT<FP8>::T frag_t;
    frag_t At[4], B0[2], B1[2];
    const unsigned kstep = 128;
    const int sclB = SCALE_B * 0x01010101, sclA = 0x7f7f7f7f; (void)sclA; (void)sclB;
    PG8_STAGE(PG8_SB(0, 0), rB, voffB[0], cur.bo); PG8_STAGE(PG8_SB(0, 1), rB, voffB[1], cur.bo); PG8_STAGE(PG8_SA(0, 0), rA, oc[0], cur.ao); PG8_STAGE(PG8_SA(0, 1), rA, oc[1], cur.ao);
    if (wr == 1) PG8_BAR;
    PG8_WAIT_V(2); PG8_BAR;
    PG8_STAGE(PG8_SB(1, 0), rB, voffB[0], cur.bo + kstep); PG8_STAGE(PG8_SA(1, 0), rA, oc[0], cur.ao + kstep); PG8_STAGE(PG8_SB(1, 1), rB, voffB[1], cur.bo + kstep);
    PG8_WAIT_V(6); PG8_BAR;
    for (;;) {
        const bool has_next = S.next(ui + 1, nxt);
        if (!has_next) nxt = cur;
        const unsigned nA = nxt.ao, nB = nxt.bo;
        { int t2 = threadIdx.x; LAUNDER(t2);
#pragma unroll
          for (int i = 0; i < 2; ++i) { int R_, C_; stage_rc(t2 * 16 + i * 8192, R_, C_);
#pragma unroll
              for (int h = 0; h < 2; ++h) on[h][i] = S.a_off(nxt, 128 * h + R_) + (unsigned)C_ * 2u; } }
        for (int t = 0; t < nt; t += 2) {
            const bool last = (t == nt - 2);
            const unsigned k1 = cur.ao + (unsigned)(t + 1) * kstep;
            const unsigned a2 = last ? nA : cur.ao + (unsigned)(t + 2) * kstep, b2 = last ? nB : cur.bo + (unsigned)(t + 2) * kstep, a3 = a2 + kstep, b3 = b2 + kstep;
            unsigned o2[2][2];
#pragma unroll
            for (int h = 0; h < 2; ++h)
#pragma unroll
                for (int i = 0; i < 2; ++i) o2[h][i] = last ? on[h][i] : oc[h][i];
            PG8_LDB(B0, 0, 0); PG8_LDB(B1, 0, 1); PG8_SCHED; PG8_LDA(At, 0, 0); PG8_STAGE(PG8_SA(1, 1), rA, oc[1], k1);
            PG8_WAIT_V(8); PG8_WAIT_L(0); PG8_BAR; PG8_MMA(0, 0, At, B0); PG8_MMA(0, 1, At, B1); PG8_BAR; PG8_SCHED;
            PG8_LDA(At, 0, 1); PG8_STAGE(PG8_SB(0, 0), rB, voffB[0], b2); PG8_STAGE(PG8_SB(0, 1), rB, voffB[1], b2); PG8_STAGE(PG8_SA(0, 0), rA, o2[0], a2);
            PG8_WAIT_V(8); PG8_WAIT_L(0); PG8_BAR; PG8_MMA(1, 0, At, B0); PG8_MMA(1, 1, At, B1); PG8_BAR; PG8_SCHED;
            PG8_LDB(B0, 1, 0); PG8_LDB(B1, 1, 1); PG8_SCHED; PG8_LDA(At, 1, 0); PG8_STAGE(PG8_SA(0, 1), rA, o2[1], a2);
            PG8_WAIT_V(8); PG8_WAIT_L(0); PG8_BAR; PG8_MMA(0, 0, At, B0); PG8_MMA(0, 1, At, B1); PG8_BAR; PG8_SCHED;
            PG8_LDA(At, 1, 1); PG8_STAGE(PG8_SB(1, 0), rB, voffB[0], b3); PG8_STAGE(PG8_SB(1, 1), rB, voffB[1], b3); PG8_STAGE(PG8_SA(1, 0), rA, o2[0], a3);
            PG8_WAIT_V(8); PG8_WAIT_L(0); PG8_BAR; PG8_MMA(1, 0, At, B0); PG8_MMA(1, 1, At, B1); PG8_BAR; PG8_SCHED;
        }
        if constexpr (FP8) asm volatile("s_nop 15\n\ts_nop 15" ::: "memory");
        if constexpr (ALIGN_EPI) { if (wr == 0) PG8_BAR; }
        if constexpr (!Epi::AFTER_DRAIN) E(acc, cur, wr, wc, fr, fq);
        if (!has_next) break;
#pragma unroll
        for (int a = 0; a < 2; ++a)
#pragma unroll
            for (int b = 0; b < 2; ++b)
#pragma unroll
                for (int m = 0; m < 4; ++m)
#pragma unroll
                    for (int n = 0; n < 2; ++n) acc[a][b][m][n] = (f32x4){0.f, 0.f, 0.f, 0.f};
        cur = nxt; ++ui;
#pragma unroll
        for (int h = 0; h < 2; ++h)
#pragma unroll
            for (int i = 0; i < 2; ++i) oc[h][i] = on[h][i];
        if constexpr (ALIGN_EPI) { if (wr == 1) PG8_BAR; }
    }
    PG8_WAIT_V(0);
    if constexpr (!ALIGN_EPI) { if (wr == 0) PG8_BAR; }
    PG8_BAR;
    if constexpr (Epi::AFTER_DRAIN) E.fused(acc, cur, wr, wc, fr, fq, lds_flat, wid, lane);
#undef PG8_SA
#undef PG8_SB
#undef PG8_STAGE
#undef PG8_LDA
#undef PG8_LDF
#undef PG8_LDB
#undef PG8_MMA
#undef PG8_WAIT_V
#undef PG8_WAIT_L
#undef PG8_BAR
#undef PG8_SCHED
}
template <bool ALIGN, class Sched, class Epi> __device__ __forceinline__ void gemm_run(unsigned char* lds, const Sched& S, const Epi& E) {
    gemm_phase<Sched, Epi, ALIGN>(lds, S, E);
}
constexpr int WSCALE_LOG2 = 6;
template <bool ALIGN, class Sched, class Epi> __device__ __forceinline__ void gemm_run_fp8(unsigned char* lds, const Sched& S, const Epi& E) {
    gemm_phase<Sched, Epi, ALIGN, true, 127 - WSCALE_LOG2>(lds, S, E);
}
#define EPI_ROWS(r) for (int ai = 0; ai < 2; ++ai) for (int m = 0; m < 4; ++m) { const int r = 128 * ai + 64 * wr + 16 * m + fr;
#define EPI_COLS(c) for (int bj = 0; bj < 2; ++bj) for (int n = 0; n < 2; ++n) { const int c = 128 * bj + 32 * wc + 16 * n + 4 * fq; const f32x4 v = acc[ai][bj][m][n];
#define EPI_END }

struct DenseSched {
    const char* A; const char* Bt; unsigned lda, ldb; int K; int nM, nN; int pm_per_b; size_t zB; int G, c;
    __device__ __forceinline__ bool next(int i, GUnit& u) const {
        int pm, pn;
        if (G == 256 && (nN & 3) == 0 && nM * nN >= 256) {
            const int j = c & 7, q = c >> 3, s = i * 8 + j, ncg = nN >> 2; pm = (s / ncg) * 8 + (q >> 2); pn = (s % ncg) * 4 + (q & 3); if (c < 0 || pm >= nM) return false; }
        else { const long L = (long)i * G + c; if (c < 0 || L >= (long)nM * nN) return false; pm = (int)(L / nN); pn = (int)(L % nN); }
        u.ao = (unsigned)pm * 256u * lda; u.bo = (unsigned)((size_t)(pm / pm_per_b) * zB) + (unsigned)pn * 256u * ldb; u.row0 = pm * 256; u.col0 = pn * 256; u.e = 0; u.valid = 256; u.aux = 0; return true;
    }
    __device__ __forceinline__ unsigned a_off(const GUnit&, int r) const { return (unsigned)r * lda; }
};
struct SchedWqk {
    const char* A; const char* Bt; unsigned lda, ldb; int K; int G, c, pad;
    __device__ __forceinline__ bool next(int i, GUnit& u) const {
        const int L = i * G + c; if (c < 0 || L >= 32) return false; const int z = L >> 2, pn = L & 3, b = z >> 2, h = z & 3;
        u.ao = (unsigned)b * 256u * 4096u + h * 512u; u.bo = (unsigned)pn * 256u * 2048u + h * 512u; u.row0 = z * 256; u.col0 = pn * 256; u.e = 0; u.valid = 256; u.aux = 0; return true;
    }
    __device__ __forceinline__ unsigned a_off(const GUnit&, int r) const { return (unsigned)r * lda; }
};
struct SchedVo {
    const char* A; const char* Bt; unsigned lda, ldb; int K; int G, c, pad;
    __device__ __forceinline__ bool next(int i, GUnit& u) const {
        const int L = i * G + c; if (c < 0 || L >= 32) return false; const int z = L >> 2, pm = L & 3, b = z >> 2, h = z & 3;
        u.ao = (unsigned)pm * 256u * 2048u + h * 512u; u.bo = (unsigned)b * 256u * 4096u + 2048u + h * 512u; u.row0 = b * 1024 + pm * 256; u.col0 = h * 256; u.e = 0; u.valid = 256; u.aux = 0; return true;
    }
    __device__ __forceinline__ unsigned a_off(const GUnit&, int r) const { return (unsigned)r * lda; }
};
template <bool GATHER> struct MoeSched {
    const char* A; const char* Bt; unsigned lda, ldb; int K; int nN; size_t zB;
    const int* tab; const int* list; int gather; int G, c, pad;
    __device__ __forceinline__ bool next(int i, GUnit& u) const {
        int T, pn;
        if (G == 256) { const int j = c & 7, q = c >> 3, s = i * 8 + j;
            if (nN == 8) { T = 4 * s + (q >> 3); pn = q & 7; } else { T = 8 * s + (q >> 2); pn = q & 3; } }
        else { const int L = i * G + c; T = L / nN; pn = L % nN; }
        if (T >= tab[64]) return false;
        const int w = tab[128 + T]; const int e = w & 255, rt = w >> 8; const int ce = tab[e], start = tab[32 + e];
        u.e = e; u.valid = min(256, ce - rt * 256); u.row0 = start + rt * 256; u.col0 = pn * 256; u.aux = rt * 256;
        u.ao = GATHER ? 0u : (unsigned)u.row0 * lda; u.bo = (unsigned)((size_t)e * zB) + (unsigned)pn * 256u * ldb; return true;
    }
    __device__ __forceinline__ unsigned a_off(const GUnit& u, int r) const {
        if (!GATHER) return (unsigned)r * lda;
        const int rr = r < u.valid ? r : 0; const int tok = list[u.e * NTOK + u.aux + rr]; return (unsigned)tok * lda;
    }
};
__device__ __forceinline__ void moe_build_table(int* tab, const int* __restrict__ cnt, int tid) {
    if (tid < 32) tab[tid] = cnt[tid * 32];
    __syncthreads();
    if (tid < 32) { int s = 0; for (int e = 0; e < tid; ++e) s += tab[e]; tab[32 + tid] = s; }
    if (tid < 320) { int tiles = 0, found = -1;
        for (int e = 0; e < NEXP; ++e) { const int te = (tab[e] + 255) >> 8; if (found < 0 && tid < tiles + te) found = e | ((tid - tiles) << 8); tiles += te; }
        if (found >= 0) tab[128 + tid] = found; if (tid == 0) tab[64] = tiles; }
    __syncthreads();
}

__device__ __forceinline__ u32x4 pack8(const f32x4& a, const f32x4& b) { u32x4 w; w.x = pk2(a[0], a[1]); w.y = pk2(a[2], a[3]); w.z = pk2(b[0], b[1]); w.w = pk2(b[2], b[3]); return w; }
struct EpiBf16 { static constexpr bool AFTER_DRAIN = false; bf16_t* O; int ldc, pad;
    __device__ __forceinline__ void operator()(const f32x4 (&acc)[2][2][4][2], const GUnit& u, int wr, int wc, int fr, int fq) const {
        LAUNDER(fr); LAUNDER(fq);
#pragma unroll
        for (int ai = 0; ai < 2; ++ai)
#pragma unroll
            for (int m = 0; m < 4; ++m) { const int r = 128 * ai + 64 * wr + 16 * m + fr;
#pragma unroll
                for (int bj = 0; bj < 2; ++bj) *(u32x4*)(O + (size_t)(u.row0 + r) * ldc + u.col0 + 128 * bj + 32 * wc + 8 * fq) = pack8(acc[ai][bj][m][0], acc[ai][bj][m][1]); } } };
template <bool BASE_BF16> struct EpiResidSS { static constexpr bool AFTER_DRAIN = false; const void* base; bf16_t* xb; float* ss; unsigned char* xq;
    __device__ __forceinline__ void operator()(const f32x4 (&acc)[2][2][4][2], const GUnit& u, int wr, int wc, int fr, int fq) const {
        LAUNDER(fr); LAUNDER(fq);
#pragma unroll
        for (int ai = 0; ai < 2; ++ai) {
            f32x4 b[4][2][2];
#pragma unroll
            for (int m = 0; m < 4; ++m)
#pragma unroll
                for (int bj = 0; bj < 2; ++bj) { const size_t o = (size_t)(u.row0 + 128 * ai + 64 * wr + 16 * m + fr) * 1024 + u.col0 + 128 * bj + 32 * wc + 8 * fq;
                    if (BASE_BF16) { const u32x4 w = *(const u32x4*)((const bf16_t*)base + o); b[m][bj][0] = (f32x4){bflo(w.x), bfhi(w.x), bflo(w.y), bfhi(w.y)}; b[m][bj][1] = (f32x4){bflo(w.z), bfhi(w.z), bflo(w.w), bfhi(w.w)}; }
                    else { b[m][bj][0] = *(const f32x4*)((const float*)base + o); b[m][bj][1] = *(const f32x4*)((const float*)base + o + 4); } }
#pragma unroll
            for (int m = 0; m < 4; ++m) { const int r = 128 * ai + 64 * wr + 16 * m + fr; float part = 0.f;
#pragma unroll
                for (int bj = 0; bj < 2; ++bj) { const size_t o = (size_t)(u.row0 + r) * 1024 + u.col0 + 128 * bj + 32 * wc + 8 * fq;
                    const f32x4 y0 = b[m][bj][0] + acc[ai][bj][m][0], y1 = b[m][bj][1] + acc[ai][bj][m][1]; *(u32x4*)(xb + o) = pack8(y0, y1);
                    if (xq) { u32x2 q; q.x = pk4_fp8(y0[0], y0[1], y0[2], y0[3]); q.y = pk4_fp8(y1[0], y1[1], y1[2], y1[3]); *(u32x2*)(xq + o) = q; }
                    part += (y0[0] * y0[0] + y0[1] * y0[1] + y0[2] * y0[2] + y0[3] * y0[3]) + (y1[0] * y1[0] + y1[1] * y1[1] + y1[2] * y1[2] + y1[3] * y1[3]); }
                part += __shfl_xor(part, 16); part += __shfl_xor(part, 32);
                if (fq == 0) atomicAdd(ss + u.row0 + r, part); } } } };
struct EpiSoftmax { static constexpr bool AFTER_DRAIN = true; const float* ss; bf16_t* P;
    __device__ __forceinline__ void operator()(const f32x4 (&)[2][2][4][2], const GUnit&, int, int, int, int) const {}
    __device__ __forceinline__ void fused(f32x4 (&acc)[2][2][4][2], const GUnit& u, int wr, int wc, int fr, int fq, unsigned char* lds, int wid, int lane) const {
        float* Pm = (float*)lds; float* Ps = (float*)(lds + 4096);
        LAUNDER(fr); LAUNDER(fq);
#pragma unroll
        for (int ai = 0; ai < 2; ++ai)
#pragma unroll
            for (int m = 0; m < 4; ++m) { const int r = 128 * ai + 64 * wr + 16 * m + fr; const float rstd = 1.0f / sqrtf(ss[u.row0 + r] * (1.0f / 1024.0f) + EPS); float mv = -INFINITY;
#pragma unroll
                for (int bj = 0; bj < 2; ++bj)
#pragma unroll
                    for (int n = 0; n < 2; ++n) { f32x4 s = acc[ai][bj][m][n] * rstd; acc[ai][bj][m][n] = s; mv = fmaxf(mv, fmaxf(fmaxf(s[0], s[1]), fmaxf(s[2], s[3]))); }
                mv = fmaxf(mv, __shfl_xor(mv, 16)); mv = fmaxf(mv, __shfl_xor(mv, 32));
                if (fq == 0) Pm[r * 4 + wc] = mv; }
        __syncthreads();
#pragma unroll
        for (int ai = 0; ai < 2; ++ai)
#pragma unroll
            for (int m = 0; m < 4; ++m) { const int r = 128 * ai + 64 * wr + 16 * m + fr; const f32x4 pm = *(const f32x4*)(Pm + r * 4); const float mv = fmaxf(fmaxf(pm[0], pm[1]), fmaxf(pm[2], pm[3])); float sum = 0.f;
#pragma unroll
                for (int bj = 0; bj < 2; ++bj)
#pragma unroll
                    for (int n = 0; n < 2; ++n) { f32x4 s = acc[ai][bj][m][n]; s[0] = __builtin_amdgcn_exp2f(s[0] - mv); s[1] = __builtin_amdgcn_exp2f(s[1] - mv); s[2] = __builtin_amdgcn_exp2f(s[2] - mv); s[3] = __builtin_amdgcn_exp2f(s[3] - mv);
                        acc[ai][bj][m][n] = s; sum += (s[0] + s[1]) + (s[2] + s[3]); }
                sum += __shfl_xor(sum, 16); sum += __shfl_xor(sum, 32);
                if (fq == 0) Ps[r * 4 + wc] = sum; }
        __syncthreads();
#pragma unroll
        for (int ai = 0; ai < 2; ++ai)
#pragma unroll
            for (int m = 0; m < 4; ++m) { const int r = 128 * ai + 64 * wr + 16 * m + fr; const f32x4 ps = *(const f32x4*)(Ps + r * 4); const float inv = 1.0f / ((ps[0] + ps[1]) + (ps[2] + ps[3]));
#pragma unroll
                for (int bj = 0; bj < 2; ++bj) *(u32x4*)(P + (size_t)(u.row0 + r) * 1024 + u.col0 + 128 * bj + 32 * wc + 8 * fq) = pack8(acc[ai][bj][m][0] * inv, acc[ai][bj][m][1] * inv); }
        (void)wid; (void)lane;
        __syncthreads();
    } };
struct EpiGU { static constexpr bool AFTER_DRAIN = false; const float* bgu; unsigned char* act  ; const float* lrs  ;
    __device__ __forceinline__ void operator()(const f32x4 (&acc)[2][2][4][2], const GUnit& u, int wr, int wc, int fr, int fq) const {
        const int pn = u.col0 >> 8; const float* bg = bgu + (size_t)u.e * 2048; LAUNDER(fr); LAUNDER(fq);
        float rs[8];
#pragma unroll
        for (int i = 0; i < 8; ++i) { const int r = 128 * (i >> 2) + 64 * wr + 16 * (i & 3) + fr; rs[i] = lrs[(size_t)u.e * NTOK + u.aux + (r < u.valid ? r : 0)]; }
        const int col = 128 * pn + 32 * wc + 8 * fq;
        f32x4 bgv[2], blv[2];
#pragma unroll
        for (int n = 0; n < 2; ++n) { bgv[n] = *(const f32x4*)(bg + col + 4 * n); blv[n] = *(const f32x4*)(bg + 1024 + col + 4 * n); }
#pragma unroll
        for (int ai = 0; ai < 2; ++ai)
#pragma unroll
            for (int m = 0; m < 4; ++m) { const int r = 128 * ai + 64 * wr + 16 * m + fr; const float rstd = rs[ai * 4 + m]; u32x2 q;
#pragma unroll
                for (int n = 0; n < 2; ++n) { const f32x4 g = acc[ai][0][m][n] * rstd + bgv[n], l = acc[ai][1][m][n] * rstd + blv[n]; float o[4];
#pragma unroll
                    for (int j = 0; j < 4; ++j) { const float gg = fminf(g[j], 7.0f), ll = fminf(fmaxf(l[j], -7.0f), 7.0f); o[j] = (ll + 1.0f) * (gg * __builtin_amdgcn_rcpf(1.0f + __builtin_amdgcn_exp2f(-1.702f * LOG2E * gg))); }
                    const unsigned w = pk4_fp8(o[0], o[1], o[2], o[3]); if (n == 0) q.x = w; else q.y = w; }
                if (r < u.valid) *(u32x2*)(act + (size_t)(u.row0 + r) * 1024 + col) = q; } } };
struct EpiDown { static constexpr bool AFTER_DRAIN = false; const float* bdn; unsigned char* ys  ;
    __device__ __forceinline__ void operator()(const f32x4 (&acc)[2][2][4][2], const GUnit& u, int wr, int wc, int fr, int fq) const {
        const float* bd = bdn + (size_t)u.e * 1024; LAUNDER(fr); LAUNDER(fq);
        f32x4 bv[2][2];
#pragma unroll
        for (int bj = 0; bj < 2; ++bj)
#pragma unroll
            for (int n = 0; n < 2; ++n) bv[bj][n] = *(const f32x4*)(bd + u.col0 + 128 * bj + 32 * wc + 8 * fq + 4 * n);
#pragma unroll
        for (int ai = 0; ai < 2; ++ai)
#pragma unroll
            for (int m = 0; m < 4; ++m) { const int r = 128 * ai + 64 * wr + 16 * m + fr; if (r < u.valid) {
#pragma unroll
                for (int bj = 0; bj < 2; ++bj) { const f32x4 y0 = acc[ai][bj][m][0] + bv[bj][0], y1 = acc[ai][bj][m][1] + bv[bj][1]; u32x2 q; q.x = pk4_fp8(y0[0], y0[1], y0[2], y0[3]); q.y = pk4_fp8(y1[0], y1[1], y1[2], y1[3]);
                    *(u32x2*)(ys + (size_t)(u.row0 + r) * 1024 + u.col0 + 128 * bj + 32 * wc + 8 * fq) = q; } } } } };


typedef float f32x16 __attribute__((ext_vector_type(16)));
typedef short s16x4 __attribute__((ext_vector_type(4)));
__device__ __forceinline__ int crow(int r, int hi) { return (r & 3) + 8 * (r >> 2) + 4 * hi; }
__device__ __forceinline__ s16x4 tr_read(const unsigned char* p) { return __builtin_bit_cast(s16x4, __builtin_amdgcn_ds_read_tr16_b64_v4i16((LDSP s16x4*)(unsigned)(uintptr_t)p)); }
__device__ __forceinline__ bf16x8 tr_frag(const unsigned char* img, int pitch, int k0, int f0, int lane) {
    const unsigned char* p = img + (k0 + 8 * (lane >> 5) + ((lane & 15) >> 2)) * pitch + (f0 + 16 * ((lane >> 4) & 1) + 4 * (lane & 3)) * 2;
    const s16x4 lo = tr_read(p), hi = tr_read(p + 4 * pitch);
    return (bf16x8){lo[0], lo[1], lo[2], lo[3], hi[0], hi[1], hi[2], hi[3]};
}
constexpr int GA_PK = 576, GA_PV = 1088;
constexpr int GA_V = 0, GA_PART = 0, GA_GLR = 69632, GA_TOT = 73728, GA_KD = 75776, GA_END = GA_KD + 64 * GA_PK;
__device__ __forceinline__ void gla_pass_a(unsigned char* lds, int task, const bf16_t* __restrict__ xn, const bf16_t* __restrict__ wglr  , const bf16_t* __restrict__ proj,
                                           const float* __restrict__ wg, const float* __restrict__ bg, float* __restrict__ UT, float* __restrict__ decay) {
    int tid = threadIdx.x; LAUNDER(tid); int wid = tid >> 6, lane = tid & 63, fr = lane & 15, fq = lane >> 4;
    const size_t t0 = (size_t)task * 64;
    { f32x4 acc[4];
#pragma unroll
      for (int m = 0; m < 4; ++m) acc[m] = (f32x4){0.f, 0.f, 0.f, 0.f};
#pragma unroll
      for (int ks = 0; ks < 4; ++ks) { const int k = 128 * wid + 32 * ks + 8 * fq; const bf16x8 bfr = *(const bf16x8*)(wglr + (size_t)fr * 1024 + k);
#pragma unroll
          for (int m = 0; m < 4; ++m) { const bf16x8 afr = *(const bf16x8*)(xn + (t0 + 16 * m + fr) * DM + k); acc[m] = __builtin_amdgcn_mfma_f32_16x16x32_bf16(afr, bfr, acc[m], 0, 0, 0); } }
      float* part = (float*)(lds + GA_PART) + wid * 1024;
#pragma unroll
      for (int m = 0; m < 4; ++m)
#pragma unroll
          for (int j = 0; j < 4; ++j) part[(16 * m + 4 * fq + j) * 16 + fr] = acc[m][j]; }
    __syncthreads();
    { float* glr = (float*)(lds + GA_GLR); const float* part = (const float*)(lds + GA_PART);
      for (int i = tid; i < 1024; i += 512) { float s = 0.f;
#pragma unroll
          for (int w = 0; w < 8; ++w) s += part[w * 1024 + i];
          glr[i] = s; } }
    __syncthreads();
    LAUNDER(tid);
    { const int cv = tid & 63, tk = tid >> 6;
#pragma unroll
      for (int i = 0; i < 8; ++i) { const int tok = tk + 8 * i; const u32x4 v = *(const u32x4*)(proj + (t0 + tok) * PROJ_LD + C_VG + cv * 8); *(u32x4*)(lds + GA_V + tok * GA_PV + cv * 16) = v; } }
    LAUNDER(tid);
    { const int j = tid & 255, half = tid >> 8; const float* glr = (const float*)(lds + GA_GLR); float* tot = (float*)(lds + GA_TOT);
      float w[16];
#pragma unroll
      for (int i = 0; i < 16; ++i) w[i] = wg[i * 256 + j];
      const float bj = bg[j]; float run = 0.f;
      bf16_t kk16[32];
#pragma unroll
      for (int s = 0; s < 32; ++s) kk16[s] = proj[(t0 + 32 * half + s) * PROJ_LD + C_KG + j];
#pragma unroll 2
      for (int s = 0; s < 32; ++s) { const float* gl = glr + (32 * half + s) * 16; float u = bj;
#pragma unroll
          for (int i = 0; i < 16; ++i) u += gl[i] * w[i];
          const float ls = fminf(u, 0.f) - __logf(1.0f + __expf(-fabsf(u)));
          run += ls * (1.0f / 16.0f); }
      tot[half * 256 + j] = run;
      __syncthreads();
      const float t0v = tot[j], t1v = tot[256 + j]; const float gend = t0v + t1v;
      if (half == 0) decay[(size_t)task * 256 + j] = __expf(gend);
      run = half ? t0v : 0.f;
#pragma unroll
      for (int s = 0; s < 32; ++s) { const int tok = 32 * half + s; const float* gl = glr + tok * 16; float u = bj;
#pragma unroll
          for (int i = 0; i < 16; ++i) u += gl[i] * w[i];
          const float ls = fminf(u, 0.f) - __logf(1.0f + __expf(-fabsf(u)));
          run += ls * (1.0f / 16.0f);
          const float kk = bf2f(kk16[s]);
          *(bf16_t*)(lds + GA_KD + tok * GA_PK + j * 2) = (bf16_t)f2bf(kk * __expf(gend - run)); } }
    __syncthreads();
    LAUNDER(tid); wid = __builtin_amdgcn_readfirstlane(tid >> 6); lane = tid & 63;
    { const int h = wid >> 1, nt = wid & 1, hi = lane >> 5, c32 = lane & 31; f32x16 acc[4];
#pragma unroll
      for (int m = 0; m < 4; ++m)
#pragma unroll
          for (int r = 0; r < 16; ++r) acc[m][r] = 0.f;
#pragma unroll
      for (int ks = 0; ks < 4; ++ks) { const bf16x8 bfr = tr_frag(lds + GA_KD, GA_PK, 16 * ks, h * 64 + 32 * nt, lane);
#pragma unroll
          for (int m = 0; m < 4; ++m) { const bf16x8 afr = tr_frag(lds + GA_V, GA_PV, 16 * ks, h * 128 + 32 * m, lane); acc[m] = __builtin_amdgcn_mfma_f32_32x32x16_bf16(afr, bfr, acc[m], 0, 0, 0); } }
      float* u = UT + ((size_t)task * 4 + h) * 8192;
#pragma unroll
      for (int m = 0; m < 4; ++m)
#pragma unroll
          for (int r = 0; r < 16; ++r) u[(32 * m + crow(r, hi)) * 64 + 32 * nt + c32] = acc[m][r]; }
    __syncthreads();
}
__device__ __forceinline__ void gla_pass_b(int e, const float* __restrict__ UT, const float* __restrict__ decay, bf16_t* __restrict__ ST) {
    const int dk = e & 63, dv = (e >> 6) & 127, h = (e >> 13) & 3, b = e >> 15; float s = 0.f;
    const size_t base = ((size_t)b * 128 * 4 + h) * 8192 + dv * 64 + dk; const size_t dbase = (size_t)b * 128 * 256 + h * 64 + dk;
    for (int c0 = 0; c0 < 128; c0 += 32) { float u[32], d[32];
#pragma unroll
        for (int i = 0; i < 32; ++i) { u[i] = UT[base + (size_t)(c0 + i) * 4 * 8192]; d[i] = decay[dbase + (size_t)(c0 + i) * 256]; }
#pragma unroll
        for (int i = 0; i < 32; ++i) { s = d[i] * s + u[i]; ST[base + (size_t)(c0 + i) * 4 * 8192] = (bf16_t)f2bf(s); } }
}
constexpr int GC_PITCH = 520;
__device__ __forceinline__ void gla_pass_c(unsigned char* wlds  , int wtask, const bf16_t* __restrict__ ST, const bf16_t* __restrict__ proj, const float* __restrict__ ghead, bf16_t* __restrict__ mix, int lane) {
    const int nh = wtask & 1, h = (wtask >> 1) & 3, bc = wtask >> 3; const int c32 = lane & 31, hi = lane >> 5;
    const size_t t0 = (size_t)bc * 64 + 32 * nh; const bf16_t* st = ST + ((size_t)bc * 4 + h) * 8192;
    f32x16 acc[4];
#pragma unroll
    for (int m = 0; m < 4; ++m)
#pragma unroll
        for (int r = 0; r < 16; ++r) acc[m][r] = 0.f;
#pragma unroll
    for (int ks = 0; ks < 4; ++ks) { const bf16x8 bfr = *(const bf16x8*)(proj + (t0 + c32) * PROJ_LD + C_QG + h * 64 + 16 * ks + 8 * hi);
#pragma unroll
        for (int m = 0; m < 4; ++m) { const bf16x8 afr = *(const bf16x8*)(st + (32 * m + c32) * 64 + 16 * ks + 8 * hi); acc[m] = __builtin_amdgcn_mfma_f32_32x32x16_bf16(afr, bfr, acc[m], 0, 0, 0); } }
    float ss = 0.f;
#pragma unroll
    for (int m = 0; m < 4; ++m)
#pragma unroll
        for (int r = 0; r < 16; ++r) ss += acc[m][r] * acc[m][r];
    ss += __shfl_xor(ss, 32);
    const float rstd = 1.0f / sqrtf(ss * (1.0f / 128.0f) + EPS);
#pragma unroll
    for (int m = 0; m < 4; ++m)
#pragma unroll
        for (int r = 0; r < 16; ++r) *(float*)(wlds + c32 * GC_PITCH + (32 * m + crow(r, hi)) * 4) = acc[m][r] * rstd;
#pragma unroll
    for (int i = 0; i < 8; ++i) { const int q = lane + 64 * i, tok = q >> 4, dv0 = (q & 15) * 8; const float* src = (const float*)(wlds + tok * GC_PITCH + dv0 * 4);
        const u32x4 rgw = *(const u32x4*)(proj + (t0 + tok) * PROJ_LD + C_RG + h * 128 + dv0); const f32x4 g0 = *(const f32x4*)(ghead + dv0), g1 = *(const f32x4*)(ghead + dv0 + 4);
        const float rg[8] = {bflo(rgw.x), bfhi(rgw.x), bflo(rgw.y), bfhi(rgw.y), bflo(rgw.z), bfhi(rgw.z), bflo(rgw.w), bfhi(rgw.w)}; const float gg[8] = {g0.x, g0.y, g0.z, g0.w, g1.x, g1.y, g1.z, g1.w}; float y[8];
#pragma unroll
        for (int k = 0; k < 8; ++k) y[k] = src[k] * gg[k] * (rg[k] / (1.0f + __expf(-rg[k])));
        u32x4 o; o.x = pk2(y[0], y[1]); o.y = pk2(y[2], y[3]); o.z = pk2(y[4], y[5]); o.w = pk2(y[6], y[7]);
        *(u32x4*)(mix + (t0 + tok) * 1024 + h * 128 + dv0) = o; }
}
__device__ __forceinline__ void sb_task(unsigned char* vl  , int wtask, const bf16_t* __restrict__ proj, bf16_t* __restrict__ mix, int lane) {
    const int qt = wtask & 255, h = (wtask >> 8) & 7, b = wtask >> 11; const int c = lane & 31, hi = lane >> 5;
    const int t0 = qt * 32; const size_t rowb = (size_t)b * SEQ;
    bf16x8 qf[4];
#pragma unroll
    for (int d0 = 0; d0 < 4; ++d0) qf[d0] = *(const bf16x8*)(proj + (rowb + t0 + c) * PROJ_LD + C_QS + h * 64 + 16 * d0 + 8 * hi);
    const int kap = 16 * ((c >> 2) & 1) + (c & 3) + 4 * (c >> 3);
    f32x16 o0, o1;
#pragma unroll
    for (int r = 0; r < 16; ++r) { o0[r] = 0.f; o1[r] = 0.f; }
    float Dc = 1.0f;
    const bf16_t* kbase = proj + rowb * PROJ_LD + C_KS + h * 64 + 8 * hi + (size_t)kap * PROJ_LD;
    const bf16_t* vbase = proj + rowb * PROJ_LD + C_VS + h * 64 + (lane & 7) * 8 + (size_t)(lane >> 3) * PROJ_LD;
    bf16x8 kf[4]; u32x4 vr[4];
#pragma unroll
    for (int d0 = 0; d0 < 4; ++d0) kf[d0] = *(const bf16x8*)(kbase + (size_t)t0 * PROJ_LD + 16 * d0);
#pragma unroll
    for (int i = 0; i < 4; ++i) vr[i] = *(const u32x4*)(vbase + (size_t)(t0 + 8 * i) * PROJ_LD);
    for (int j0 = t0; j0 >= 0; j0 -= 32) {
#pragma unroll
        for (int i = 0; i < 4; ++i) { const int key = (lane >> 3) + 8 * i, ch = lane & 7; *(u32x4*)(vl + (ch >> 2) * 2048 + key * 64 + (ch & 3) * 16) = vr[i]; }
        f32x16 z;
#pragma unroll
        for (int r = 0; r < 16; ++r) z[r] = 0.f;
#pragma unroll
        for (int d0 = 0; d0 < 4; ++d0) z = __builtin_amdgcn_mfma_f32_32x32x16_bf16(kf[d0], qf[d0], z, 0, 0, 0);
        asm volatile("" ::: "memory");
        { const int jn = (j0 >= 32) ? j0 - 32 : j0;
#pragma unroll
          for (int d0 = 0; d0 < 4; ++d0) kf[d0] = *(const bf16x8*)(kbase + (size_t)jn * PROJ_LD + 16 * d0);
#pragma unroll
          for (int i = 0; i < 4; ++i) vr[i] = *(const u32x4*)(vbase + (size_t)(jn + 8 * i) * PROJ_LD); }
        asm volatile("" ::: "memory");
        float e[16], Dl[16];
        const bool diag = (j0 == t0);
#pragma unroll
        for (int r = 0; r < 16; ++r) { float ev = __builtin_amdgcn_exp2f(fminf(z[r], 126.0f)); if (diag && (16 * hi + r >= c)) ev = 0.f; e[r] = ev; }
        float D = hi ? Dc : 1.0f;
#pragma unroll
        for (int r = 15; r >= 0; --r) { D = fmaf(D, e[r], D); Dl[r] = D; }
        const float other = __shfl_xor(D, 32);
        const float mult = hi ? 1.0f : other;
        Dc = D * other;
        unsigned pw[8];
#pragma unroll
        for (int r = 0; r < 16; r += 2) { const float a0 = e[r] * __builtin_amdgcn_rcpf(Dl[r] * mult), a1 = e[r + 1] * __builtin_amdgcn_rcpf(Dl[r + 1] * mult); pw[r >> 1] = pk2(a0, a1); }
#pragma unroll
        for (int ks = 0; ks < 2; ++ks) { const bf16x8 pa = __builtin_bit_cast(bf16x8, (u32x4){pw[4 * ks], pw[4 * ks + 1], pw[4 * ks + 2], pw[4 * ks + 3]});
            const unsigned char* vb = vl + (16 * hi + 8 * ks + ((lane & 15) >> 2)) * 64 + (16 * ((lane >> 4) & 1) + 4 * (lane & 3)) * 2;
            { const s16x4 lo = tr_read(vb), hh = tr_read(vb + 256); o0 = __builtin_amdgcn_mfma_f32_32x32x16_bf16(pa, (bf16x8){lo[0], lo[1], lo[2], lo[3], hh[0], hh[1], hh[2], hh[3]}, o0, 0, 0, 0); }
            { const s16x4 lo = tr_read(vb + 2048), hh = tr_read(vb + 2048 + 256); o1 = __builtin_amdgcn_mfma_f32_32x32x16_bf16(pa, (bf16x8){lo[0], lo[1], lo[2], lo[3], hh[0], hh[1], hh[2], hh[3]}, o1, 0, 0, 0); } }
        if (__all(!(Dc < 3.0e38f))) break;
    }
    bf16_t* ob = mix + (rowb + t0) * 1024 + 512 + h * 64 + c;
#pragma unroll
    for (int r = 0; r < 16; ++r) { const int q = crow(r, hi); ob[(size_t)q * 1024] = (bf16_t)f2bf(o0[r]); ob[(size_t)q * 1024 + 32] = (bf16_t)f2bf(o1[r]); }
}
__device__ __forceinline__ void softmax_task(int gw, int lane, const float* __restrict__ S, bf16_t* __restrict__ P) {
    const f32x4 v = *((const f32x4*)(S + (size_t)gw * 256) + lane);
    float m = fmaxf(fmaxf(v.x, v.y), fmaxf(v.z, v.w));
#pragma unroll
    for (int o = 1; o < 64; o <<= 1) m = fmaxf(m, __shfl_xor(m, o));
    const float e0 = exp2f(v.x - m), e1 = exp2f(v.y - m), e2 = exp2f(v.z - m), e3 = exp2f(v.w - m);
    const float inv = 1.0f / wave_sum(e0 + e1 + e2 + e3);
    u32x2 w; w.x = pk2(e0 * inv, e1 * inv); w.y = pk2(e2 * inv, e3 * inv); *((u32x2*)(P + (size_t)gw * 256) + lane) = w;
}
__device__ __forceinline__ void router_logit(int idx, const bf16_t* __restrict__ xn, const bf16_t* __restrict__ wr, const float* __restrict__ br, float* __restrict__ lg) {
    const int t = idx >> 5, e = idx & 31; const u32x4* a = (const u32x4*)(xn + (size_t)t * DM); const u32x4* w = (const u32x4*)(wr + (size_t)e * DM); float s = 0.f;
    for (int i = 0; i < DM / 8; ++i) { const u32x4 x = a[i], y = w[i];
        s += bflo(x.x) * bflo(y.x) + bfhi(x.x) * bfhi(y.x) + bflo(x.y) * bflo(y.y) + bfhi(x.y) * bfhi(y.y) + bflo(x.z) * bflo(y.z) + bfhi(x.z) * bfhi(y.z) + bflo(x.w) * bflo(y.w) + bfhi(x.w) * bfhi(y.w); }
    lg[idx] = s + br[e];
}
__device__ __forceinline__ void router_topk(int t, const float* __restrict__ lg, int* __restrict__ cnt, int* __restrict__ list, int* __restrict__ toke, int* __restrict__ tokr, float* __restrict__ tokw) {
    float v[NEXP];
#pragma unroll
    for (int e = 0; e < NEXP; ++e) v[e] = lg[(size_t)t * NEXP + e];
    float tv[4]; int ti[4];
#pragma unroll
    for (int k = 0; k < 4; ++k) { float best = -INFINITY; int bi = 0;
#pragma unroll
        for (int e = 0; e < NEXP; ++e) { if (v[e] > best) { best = v[e]; bi = e; } }
        tv[k] = best; ti[k] = bi;
#pragma unroll
        for (int e = 0; e < NEXP; ++e) if (e == bi) v[e] = -INFINITY; }
    const float e1 = __expf(tv[1] - tv[0]), e2 = __expf(tv[2] - tv[0]), e3 = __expf(tv[3] - tv[0]); const float inv = 1.0f / (1.0f + e1 + e2 + e3);
    const float g[4] = {inv, e1 * inv, e2 * inv, e3 * inv};
#pragma unroll
    for (int k = 0; k < 4; ++k) { const int r = atomicAdd(&cnt[ti[k]], 1); list[ti[k] * NTOK + r] = t; toke[t * 4 + k] = ti[k]; tokr[t * 4 + k] = r; tokw[t * 4 + k] = g[k]; }
}
__device__ __forceinline__ void memkv_task(int wtask, int lane, const bf16_t* __restrict__ memn, const bf16_t* __restrict__ wkv, bf16_t* __restrict__ kv) {
    const int tm = wtask >> 6, tn = wtask & 63; const int c = lane & 31, hi = lane >> 5;
    const bf16_t* ap = memn + (size_t)(tm * 32 + c) * DM + 8 * hi; const bf16_t* bp = wkv + (size_t)(tn * 32 + c) * DM + 8 * hi;
    f32x16 acc;
#pragma unroll
    for (int r = 0; r < 16; ++r) acc[r] = 0.f;
#pragma unroll 16
    for (int ks = 0; ks < 64; ++ks) { const bf16x8 a = *(const bf16x8*)(ap + 16 * ks), b = *(const bf16x8*)(bp + 16 * ks); acc = __builtin_amdgcn_mfma_f32_32x32x16_bf16(a, b, acc, 0, 0, 0); }
    bf16_t* o = kv + (size_t)(tm * 32) * 2048 + tn * 32 + c;
#pragma unroll
    for (int r = 0; r < 16; ++r) o[(size_t)crow(r, hi) * 2048] = (bf16_t)f2bf(acc[r]);
}
__device__ __forceinline__ void router_task(int wtask, int lane, const bf16_t* __restrict__ xn, const float* __restrict__ ss, const bf16_t* __restrict__ wr, const float* __restrict__ br,
                                            int (&oe)[4], float (&ow)[4]) {
    const int c = lane & 31, hi = lane >> 5; const int t = wtask * 32 + c;
    const bf16_t* ap = wr + (size_t)c * DM + 8 * hi; const bf16_t* bp = xn + (size_t)t * DM + 8 * hi;
    f32x16 acc;
#pragma unroll
    for (int r = 0; r < 16; ++r) acc[r] = 0.f;
#pragma unroll 16
    for (int ks = 0; ks < 64; ++ks) { const bf16x8 a = *(const bf16x8*)(ap + 16 * ks), b = *(const bf16x8*)(bp + 16 * ks); acc = __builtin_amdgcn_mfma_f32_32x32x16_bf16(a, b, acc, 0, 0, 0); }
    float v[16]; const float rstd = 1.0f / sqrtf(ss[t] * (1.0f / 1024.0f) + EPS);
#pragma unroll
    for (int r = 0; r < 16; ++r) v[r] = acc[r] * rstd + br[crow(r, hi)];
    float tv[4]; int ti[4];
#pragma unroll
    for (int k = 0; k < 4; ++k) { float best = -INFINITY; int bi = 64;
#pragma unroll
        for (int r = 0; r < 16; ++r) { if (v[r] > best) { best = v[r]; bi = crow(r, hi); } }
        tv[k] = best; ti[k] = bi;
#pragma unroll
        for (int r = 0; r < 16; ++r) if (crow(r, hi) == bi) v[r] = -INFINITY; }
    float cv[8]; int ci[8];
#pragma unroll
    for (int k = 0; k < 4; ++k) { cv[k] = tv[k]; ci[k] = ti[k]; cv[4 + k] = __shfl_xor(tv[k], 32); ci[4 + k] = __shfl_xor(ti[k], 32); }
#pragma unroll
    for (int k = 0; k < 4; ++k) { float best = -INFINITY; int bi = 64;
#pragma unroll
        for (int q = 0; q < 8; ++q) { if (cv[q] > best || (cv[q] == best && ci[q] < bi)) { best = cv[q]; bi = ci[q]; } }
        tv[k] = best; ti[k] = bi;
#pragma unroll
        for (int q = 0; q < 8; ++q) if (ci[q] == bi) cv[q] = -INFINITY; }
    const float e1 = __expf(tv[1] - tv[0]), e2 = __expf(tv[2] - tv[0]), e3 = __expf(tv[3] - tv[0]); const float inv = 1.0f / (1.0f + e1 + e2 + e3);
    const float g[4] = {inv, e1 * inv, e2 * inv, e3 * inv};
#pragma unroll
    for (int k = 0; k < 4; ++k) { oe[k] = ti[k]; ow[k] = g[k]; }
}
__device__ __forceinline__ void combine_task(int t, int lane, const bf16_t* xin, float* xout, const unsigned char* __restrict__ ys, const int* tab, const int* __restrict__ toke, const int* __restrict__ tokr,
                                                 const float* __restrict__ tokw, const float* __restrict__ gfin) {
    const u32x2* xr = (const u32x2*)(xin + (size_t)t * DM) + lane; f32x4* xo = (f32x4*)(xout + (size_t)t * DM) + lane; f32x4 v[4];
#pragma unroll
    for (int j = 0; j < 4; ++j) { const u32x2 w = xr[64 * j]; v[j] = (f32x4){bflo(w.x), bfhi(w.x), bflo(w.y), bfhi(w.y)}; }
    for (int k = 0; k < 4; ++k) { const int e = toke[t * 4 + k], r = tokr[t * 4 + k]; const float w = tokw[t * 4 + k]; const int start = tab[32 + e];
        const unsigned* yr = (const unsigned*)(ys + (size_t)(start + r) * DM) + lane;
#pragma unroll
        for (int j = 0; j < 4; ++j) { const int y = (int)yr[64 * j]; const f32x2 lo = __builtin_amdgcn_cvt_pk_f32_fp8(y, false), hi = __builtin_amdgcn_cvt_pk_f32_fp8(y, true);
            v[j].x += w * lo.x; v[j].y += w * lo.y; v[j].z += w * hi.x; v[j].w += w * hi.y; } }
    float s = 0.f;
#pragma unroll
    for (int j = 0; j < 4; ++j) s += v[j].x * v[j].x + v[j].y * v[j].y + v[j].z * v[j].z + v[j].w * v[j].w;
    const float rstd = 1.0f / sqrtf(wave_sum(s) * (1.f / DM) + EPS);
#pragma unroll
    for (int j = 0; j < 4; ++j) { const f32x4 g = *((const f32x4*)gfin + lane + 64 * j); xo[64 * j] = v[j] * rstd * g; }
}

#define GAS __attribute__((address_space(1)))
#define RLX_AGENT __ATOMIC_RELAXED, __HIP_MEMORY_SCOPE_AGENT
#define XB_TMO      128
#define XB_XCNT(j)  (256  + 64 * (j))
#define XB_XSUB(j)  (1280 + 64 * (j))
#define XB_XGEN(j)  (2304 + 64 * (j))
#define XB_TOP      3328
#define XB_TOPGEN   3392
#define XCD_BAR_WORDS 3456
#define XB_SPIN_CAP (1u << 18)
__device__ __forceinline__ unsigned xb_ld(unsigned* p)              { return __hip_atomic_load(p, __ATOMIC_RELAXED, __HIP_MEMORY_SCOPE_AGENT); }
__device__ __forceinline__ unsigned xb_add(unsigned* p, unsigned v) { return __hip_atomic_fetch_add(p, v, __ATOMIC_RELAXED, __HIP_MEMORY_SCOPE_AGENT); }
__device__ __forceinline__ unsigned xb_xcc_id() { return (unsigned)__builtin_amdgcn_s_getreg((3 << 11) | 20) & 0xFu; }
#define XB_SPIN(cond, bar) do { unsigned _sp = 0; while (cond) { __builtin_amdgcn_s_sleep(1); \
    if ((++_sp & 255u) == 0u) { if (xb_ld(&(bar)[XB_TMO])) break; if (_sp > XB_SPIN_CAP) { atomicAdd(&(bar)[XB_TMO], 1u); break; } } } } while (0)
struct XcdBarrier { unsigned* bar; unsigned x; volatile LDSP unsigned* st; };
__device__ __forceinline__ XcdBarrier xcd_barrier_post(unsigned* bar, volatile LDSP unsigned* st) {
    XcdBarrier b; b.bar = bar; b.x = xb_xcc_id(); b.st = st;
    if (threadIdx.x == 0) (void)xb_add(&bar[XB_XCNT(b.x)], 1u);
    return b;
}
__device__ __forceinline__ void xcd_barrier_complete(unsigned* bar, unsigned x, unsigned& nloc, unsigned& nx) {
    const unsigned G = gridDim.x * gridDim.y * gridDim.z;
    unsigned sum, cnt, mine, sp = 0u;
    for (;;) {
        sum = 0u; cnt = 0u; mine = 0u;
#pragma unroll
        for (unsigned j = 0; j < 16; ++j) { const unsigned c = xb_ld(&bar[XB_XCNT(j)]); sum += c; cnt += (c > 0u) ? 1u : 0u; mine = (j == x) ? c : mine; }
        if (sum == G) break;
        __builtin_amdgcn_s_sleep(1);
        if ((++sp & 255u) == 0u) { if (xb_ld(&bar[XB_TMO])) break; if (sp > XB_SPIN_CAP) { atomicAdd(&bar[XB_TMO], 1u); break; } }
    }
    nloc = mine > 0u ? mine : 1u; nx = cnt > 0u ? cnt : 1u;
}
__device__ __forceinline__ void xcd_barrier(const XcdBarrier& b) {
    asm volatile("s_waitcnt vmcnt(0)" ::: "memory");
    __syncthreads();
    if (threadIdx.x == 0) {
        unsigned* bar = b.bar;
        __builtin_amdgcn_s_waitcnt(0);
        unsigned nloc = b.st[0], nx = b.st[1];
        if (nloc == 0u) { xcd_barrier_complete(bar, b.x, nloc, nx); b.st[0] = nloc; b.st[1] = nx; }
        const unsigned old = xb_add(&bar[XB_XSUB(b.x)], 1u);
        const unsigned gen = old / nloc;
        if (old + 1u == (gen + 1u) * nloc) {
            __builtin_amdgcn_fence(__ATOMIC_RELEASE, "agent");
            asm volatile("s_waitcnt vmcnt(0)" ::: "memory");
            const unsigned og = xb_add(&bar[XB_TOP], 1u);
            const unsigned tg = og / nx;
            if (og + 1u == (tg + 1u) * nx) xb_add(&bar[XB_TOPGEN], 1u);
            else XB_SPIN(xb_ld(&bar[XB_TOPGEN]) == tg, bar);
            __builtin_amdgcn_fence(__ATOMIC_ACQUIRE, "agent");
            xb_add(&bar[XB_XGEN(b.x)], 1u);
            asm volatile("s_waitcnt vmcnt(0)" ::: "memory");
        } else {
            XB_SPIN(xb_ld(&bar[XB_XGEN(b.x)]) == gen, bar);
            __builtin_amdgcn_fence(__ATOMIC_ACQUIRE, "agent");
            asm volatile("s_waitcnt vmcnt(0)" ::: "memory");
        }
    }
    __syncthreads();
}

constexpr int LDS_BYTES = 147456;
constexpr int MISC_OFF = LDS_BYTES - 512;
constexpr int CW_BAR = 4096;
constexpr size_t CTL_ZERO_BYTES = 196608;
constexpr int NPHASE = 12;
struct Args { const float* in[22]; float* out; unsigned char* ws; int ph_lo, ph_hi; };

__global__ void __launch_bounds__(512, 2) mega(Args a) {
    extern __shared__ __attribute__((aligned(16))) unsigned char lds[];
    unsigned char* ws = a.ws; float* out = a.out;
    const float* x = a.in[0]; const float* mem = a.in[1]; const float* g_mix = a.in[2]; const float* w_in = a.in[3];
    const float* w_gla_gate = a.in[4]; const float* b_gla_gate = a.in[5]; const float* g_gla_head = a.in[6]; const float* w_out = a.in[7];
    const float* g_mem_q = a.in[8]; const float* g_mem_kv = a.in[9]; const float* w_mq = a.in[10]; const float* w_mk = a.in[11];
    const float* w_mv = a.in[12]; const float* w_mo = a.in[13]; const float* g_ffn = a.in[14]; const float* w_router = a.in[15];
    const float* b_router = a.in[16]; const float* w_gu = a.in[17]; const float* b_gu = a.in[18]; const float* w_down = a.in[19];
    const float* b_down = a.in[20]; const float* g_final = a.in[21];
    bf16_t* Wt_in = (bf16_t*)(ws + WS_WIN); bf16_t* Wt_out = (bf16_t*)(ws + WS_WOUT); bf16_t* Wq = (bf16_t*)(ws + WS_WQ); bf16_t* Wt_kv = (bf16_t*)(ws + WS_WKV);
    bf16_t* Wt_mo = (bf16_t*)(ws + WS_WMO); bf16_t* Wt_r = (bf16_t*)(ws + WS_WR); bf16_t* Wt_gu = (bf16_t*)(ws + WS_WGU); bf16_t* Wt_dn = (bf16_t*)(ws + WS_WDN);
    bf16_t* xn = (bf16_t*)(ws + WS_XN); bf16_t* memn = (bf16_t*)(ws + WS_MEMN); bf16_t* kv = (bf16_t*)(ws + WS_KV); bf16_t* Bs = (bf16_t*)(ws + WS_BS); bf16_t* Bo = (bf16_t*)(ws + WS_BO);
    bf16_t* proj = (bf16_t*)(ws + WS_PROJ); bf16_t* mix = (bf16_t*)(ws + WS_MIX);
    float* Sc = (float*)(ws + WS_S); bf16_t* P = (bf16_t*)(ws + WS_P); float* lg = (float*)(ws + WS_LG); int* toke = (int*)(ws + WS_TOKE); int* tokr = (int*)(ws + WS_TOKR);
    float* tokw = (float*)(ws + WS_TOKW); int* list = (int*)(ws + WS_LIST); unsigned char* ys = ws + WS_YS;
    unsigned char* Wq_gu = ws + WS_WGU; unsigned char* Wq_dn = ws + WS_WDN; unsigned char* x2q = ws + WS_S; unsigned char* act8 = ws + WS_ACT;
    float* lrs = (float*)(ws + WS_LG);
    float* UT = (float*)(ws + WS_S); float* decay = (float*)(ws + WS_LA); bf16_t* ST = (bf16_t*)(ws + WS_ORAW);
    unsigned* ctl = (unsigned*)(ws + WS_CTL); int* cnt = (int*)ctl + CW_CNT; float* ss1 = (float*)(ws + WS_CTL + 65536); float* ss2 = (float*)(ws + WS_CTL + 131072);

    const int G = gridDim.x, vb = blockIdx.x;
    volatile LDSP unsigned* MISC = (volatile LDSP unsigned*)(unsigned)(uintptr_t)(lds + MISC_OFF);
    if (threadIdx.x < 128) MISC[threadIdx.x] = 0u;
    __syncthreads();
    XcdBarrier bar = xcd_barrier_post(ctl + CW_BAR, MISC + 8);
    const int lo = a.ph_lo, hi = a.ph_hi;
    float* dmy = (float*)(ws + WS_DUMMY); (void)dmy;
#ifndef REPEAT_MASK
#define REPEAT_MASK 0
#endif
#define IN(k) (lo <= (k) && (k) < hi)
#define REP(k) for (int rep_ = 0; rep_ < 1 + ((REPEAT_MASK >> (k)) & 1); ++rep_)
#define SEAM(k) do { if (IN(k) && IN((k) + 1)) xcd_barrier(bar); } while (0)
#define TIDS() int tid = threadIdx.x; LAUNDER(tid); const int lane = tid & 63; const int wid = __builtin_amdgcn_readfirstlane(tid >> 6); (void)lane; (void)wid

    if (IN(0)) REP(0) { TIDS(); const size_t gt = (size_t)vb * 512 + tid, gs = (size_t)G * 512;
        float* scr = (float*)(lds + wid * 8448);
        const int gw = vb * 8 + wid, ngw = G * 8;
        rms_body(gw, ngw, lane, x, xn, NTOK);
        rms_body(gw, ngw, lane, mem, memn, NB * MEML);
        conv_n_body(gt, gs, w_mq, Wq, g_mem_q, 1024, 1024, LOG2E / 16.0f);
        constexpr int I_IN = 16 * 97, I_SQ = 16 * 32, I_R = 16, I_GU = 32 * 16 * 64, I_DN = 32 * 16 * 32;
        constexpr int NITEMS = I_IN + 4 * I_SQ + I_R + I_GU + I_DN;
        for (int it = gw; it < NITEMS; it += ngw) { int r = it;
            if (r < I_IN) { conv_item<1>(scr, w_in, Wt_in, g_mix, 3088, 1024, 3088, r / 97, r % 97, lane); continue; } r -= I_IN;
            if (r < I_SQ) { conv_item<0>(scr, w_out, Wt_out, nullptr, 1024, 1024, 1024, r >> 5, r & 31, lane); continue; } r -= I_SQ;
            if (r < I_SQ) { conv_item<0>(scr, w_mk, Wt_kv, g_mem_kv, 1024, 1024, 1024, r >> 5, r & 31, lane); continue; } r -= I_SQ;
            if (r < I_SQ) { conv_item<0>(scr, w_mv, Wt_kv + (size_t)1024 * 1024, g_mem_kv, 1024, 1024, 1024, r >> 5, r & 31, lane); continue; } r -= I_SQ;
            if (r < I_SQ) { conv_item<0>(scr, w_mo, Wt_mo, nullptr, 1024, 1024, 1024, r >> 5, r & 31, lane); continue; } r -= I_SQ;
            if (r < I_R) { conv_item<0>(scr, w_router, Wt_r, g_ffn, 32, 1024, 32, r, 0, lane); continue; } r -= I_R;
            if (r < I_GU) { const int e = r >> 10, q = r & 1023; conv_item8<2>(scr, w_gu + (size_t)e * 1024 * 2048, Wq_gu + (size_t)e * 2048 * 1024, g_ffn, 2048, 1024, 2048, q >> 6, q & 63, lane, (float)(1 << WSCALE_LOG2)); continue; } r -= I_GU;
            { const int e = r >> 9, q = r & 511; conv_item8<0>(scr, w_down + (size_t)e * 1024 * 1024, Wq_dn + (size_t)e * 1024 * 1024, nullptr, 1024, 1024, 1024, q >> 5, q & 31, lane, (float)(1 << WSCALE_LOG2)); } }
        __syncthreads(); }
    SEAM(0);
    if (IN(1)) REP(1) { DenseSched S{(const char*)xn, (const char*)Wt_in, 2048u, 2048u, 1024, 64, 12, 1 << 30, 0, G, vb}; EpiBf16 E{proj, PROJ_LD, 0}; gemm_run<true>(lds, S, E); }
    SEAM(1);
    if (IN(2)) REP(2) {
        for (int t = vb; t < 256; t += G) gla_pass_a(lds, t, xn, Wt_in + (size_t)3072 * 1024, proj, w_gla_gate, b_gla_gate, UT, decay);
        { TIDS(); for (int t = vb * 8 + wid; t < 4096; t += G * 8) sb_task(lds + wid * 4096, t, proj, mix, lane); }
        { TIDS(); for (int t = vb + G * wid; t < 1024; t += G * 8) memkv_task(t, lane, memn, Wt_kv, kv); } }
    SEAM(2);
    if (IN(3)) REP(3) {
        { TIDS(); for (int e = vb * 512 + tid; e < 65536; e += G * 512) gla_pass_b(e, UT, decay, ST); }
        { SchedWqk S{(const char*)kv, (const char*)Wq, 4096u, 2048u, 256, G / 2, vb - G / 2, 0}; EpiBf16 E{Bs, 1024, 0}; gemm_run<false>(lds, S, E); }
        { SchedVo S{(const char*)Wt_mo, (const char*)kv, 2048u, 4096u, 256, G / 2, vb - G / 2 - 32, 0}; EpiBf16 E{Bo, 1024, 0}; gemm_run<false>(lds, S, E); } }
    SEAM(3);
    if (IN(4)) REP(4) { TIDS(); for (int t = vb * 8 + wid; t < 2048; t += G * 8) gla_pass_c(lds + wid * 32 * GC_PITCH, t, ST, proj, g_gla_head, mix, lane); }
    SEAM(4);
#if PROBE_BARRIERS
    for (int pb_ = 0; pb_ < 8; ++pb_) xcd_barrier(bar);
#endif
    if (IN(5)) REP(5) { DenseSched S{(const char*)mix, (const char*)Wt_out, 2048u, 2048u, 1024, 64, 4, 1 << 30, 0, G, vb}; EpiResidSS<false> E{x, rep_ ? (bf16_t*)dmy : xn, rep_ ? dmy + 16 * 1024 * 1024 : ss1, nullptr}; gemm_run<false>(lds, S, E); }
    SEAM(5);
    if (IN(6)) REP(6) { DenseSched S{(const char*)xn, (const char*)Bs, 2048u, 2048u, 1024, 64, 4, 32, (size_t)1024 * 2048, G, vb}; EpiSoftmax E{ss1, P}; gemm_run<false>(lds, S, E); }
    SEAM(6);
    if (IN(7)) REP(7) { DenseSched S{(const char*)P, (const char*)Bo, 2048u, 2048u, 1024, 64, 4, 32, (size_t)1024 * 2048, G, vb}; EpiResidSS<true> E{xn, rep_ ? (bf16_t*)dmy : xn, rep_ ? dmy + 16 * 1024 * 1024 : ss2, rep_ ? (unsigned char*)dmy + 40 * 1024 * 1024 : x2q}; gemm_run<false>(lds, S, E); }
    SEAM(7);
    if (IN(8)) REP(8) { TIDS(); int* cntp = rep_ ? (int*)ctl + 2048 : cnt; int* listp = rep_ ? (int*)dmy + 1024 : list; float* lrsp = rep_ ? dmy + 4096 * 1024 : lrs; int* tokep = rep_ ? (int*)dmy + 1024 * 1024 : toke; int* tokrp = rep_ ? (int*)dmy + 2048 * 1024 : tokr; float* tokwp = rep_ ? dmy + 3072 * 1024 : tokw;
        int* lcnt = (int*)lds; int* gbase = (int*)lds + 32;
        for (int tb = vb; tb < NTOK / 64; tb += G) {
            if (tid < 32) lcnt[tid] = 0;
            __syncthreads();
            int oe[4] = {0, 0, 0, 0}; float ow[4] = {0.f, 0.f, 0.f, 0.f}; int lr[4] = {0, 0, 0, 0};
            if (wid < 2) { router_task(tb * 2 + wid, lane, xn, ss2, Wt_r, b_router, oe, ow);
                if (lane < 32) {
#pragma unroll
                    for (int k = 0; k < 4; ++k) lr[k] = atomicAdd(&lcnt[oe[k]], 1); } }
            __syncthreads();
            if (tid < 32) gbase[tid] = atomicAdd(&cntp[tid * 32], lcnt[tid]);
            __syncthreads();
            if (wid < 2 && lane < 32) { const int t = (tb * 2 + wid) * 32 + lane;
                const float rstd_t = 1.0f / sqrtf(ss2[t] * (1.0f / 1024.0f) + EPS);
#pragma unroll
                for (int k = 0; k < 4; ++k) { const int r = gbase[oe[k]] + lr[k]; listp[oe[k] * NTOK + r] = t; lrsp[oe[k] * NTOK + r] = rstd_t; tokep[t * 4 + k] = oe[k]; tokrp[t * 4 + k] = r; tokwp[t * 4 + k] = ow[k]; } }
            __syncthreads(); } }
    SEAM(8);
    if (IN(9)) REP(9) { int* tab = (int*)(lds + 131072); { TIDS(); moe_build_table(tab, cnt, tid); }
        MoeSched<true> S{(const char*)x2q, (const char*)Wq_gu, 1024u, 1024u, 512, 8, (size_t)2048 * 1024, tab, list, 1, G, vb, 0}; EpiGU E{b_gu, act8, lrs}; gemm_run_fp8<true>(lds, S, E); }
    SEAM(9);
    if (IN(10)) REP(10) { int* tab = (int*)(lds + 131072); { TIDS(); moe_build_table(tab, cnt, tid); }
        MoeSched<false> S{(const char*)act8, (const char*)Wq_dn, 1024u, 1024u, 512, 4, (size_t)1024 * 1024, tab, list, 0, G, vb, 0}; EpiDown E{b_down, ys}; gemm_run_fp8<true>(lds, S, E); }
    SEAM(10);
    if (IN(11)) REP(11) { TIDS(); int* tab = (int*)(lds + 131072); moe_build_table(tab, cnt, tid);
        for (int t = vb * 8 + wid; t < NTOK; t += G * 8) combine_task(t, lane, xn, rep_ ? dmy : out, ys, tab, toke, tokr, tokw, g_final); }
#undef IN
#undef SEAM
#undef TIDS
}

#ifndef MK_PER_PHASE
#define MK_PER_PHASE 0
#endif
extern "C" void kernel_launch(void* const* d_in, const int* in_sizes, int n_in, void* d_out, int out_size, void* d_ws, size_t ws_size, hipStream_t stream) {
    static int grid = 0;
    if (grid == 0) {
        if (n_in != 22 || in_sizes[0] != NTOK * DM || out_size != NTOK * DM || ws_size < WS_END) { fprintf(stderr, "kernel_launch: unexpected shapes (n_in %d, ws %zu)\n", n_in, ws_size); grid = -1; return; }
        int dev = 0, cus = 0, per_cu = 0;
        if (hipGetDevice(&dev) != hipSuccess || hipDeviceGetAttribute(&cus, hipDeviceAttributeMultiprocessorCount, dev) != hipSuccess) { grid = -1; return; }
        if (hipFuncSetAttribute((const void*)mega, hipFuncAttributeMaxDynamicSharedMemorySize, LDS_BYTES) != hipSuccess) { fprintf(stderr, "kernel_launch: hipFuncSetAttribute failed\n"); grid = -1; return; }
        if (hipOccupancyMaxActiveBlocksPerMultiprocessor(&per_cu, (const void*)mega, 512, LDS_BYTES) != hipSuccess || per_cu < 1) fprintf(stderr, "kernel_launch: occupancy query says %d blocks/CU\n", per_cu);
        (void)hipGetLastError();
        grid = cus;
    }
    if (grid < 0) return;
    (void)hipMemsetAsync((char*)d_ws + WS_CTL, 0, CTL_ZERO_BYTES, stream);
    Args a{};
    for (int i = 0; i < 22; ++i) a.in[i] = (const float*)d_in[i];
    a.out = (float*)d_out; a.ws = (unsigned char*)d_ws;
#if MK_PER_PHASE
    for (int p = 0; p < NPHASE; ++p) { a.ph_lo = p; a.ph_hi = p + 1; hipLaunchKernelGGL(mega, dim3(grid), dim3(512), LDS_BYTES, stream, a); }
#else
    a.ph_lo = 0; a.ph_hi = NPHASE; hipLaunchKernelGGL(mega, dim3(grid), dim3(512), LDS_BYTES, stream, a);
#endif
}
```

```cpp
#include <hip/hip_runtime.h>
#include <cstdio>
#include <cstdint>
#ifndef PROBE_BARRIERS
#define PROBE_BARRIERS 0
#endif

typedef unsigned short bf16_t;
typedef short bf16x8 __attribute__((ext_vector_type(8)));
typedef float f32x4 __attribute__((ext_vector_type(4)));
typedef unsigned u32x4 __attribute__((ext_vector_type(4)));
typedef unsigned u32x2 __attribute__((ext_vector_type(2)));
typedef float f32x2 __attribute__((ext_vector_type(2)));
#define LDSP __attribute__((address_space(3)))
#define LAUNDER(x) asm volatile("" : "+v"(x))

constexpr int NB = 2, SEQ = 8192, NTOK = NB * SEQ, DM = 1024, MEML = 256;
constexpr int NEXP = 32, TOPK = 4, NASSIGN = NTOK * TOPK;
constexpr int PROJ_LD = 3072;
constexpr int C_QG = 0, C_KG = 256, C_VG = 512, C_RG = 1024, C_QS = 1536, C_KS = 2048, C_VS = 2560, C_GLR = 3072;
constexpr float LOG2E = 1.4426950408889634f;
constexpr float EPS = 1e-5f;

__device__ __forceinline__ unsigned f2bf(float f) { unsigned u = __float_as_uint(f); return (u + 0x7fffu + ((u >> 16) & 1u)) >> 16; }
__device__ __forceinline__ unsigned pk2(float lo, float hi) { return f2bf(lo) | (f2bf(hi) << 16); }
__device__ __forceinline__ float bf2f(bf16_t h) { return __uint_as_float(((unsigned)h) << 16); }
__device__ __forceinline__ float bflo(unsigned w) { return __uint_as_float(w << 16); }
__device__ __forceinline__ float bfhi(unsigned w) { return __uint_as_float(w & 0xffff0000u); }

constexpr size_t MiB = 1u << 20;
constexpr size_t WS_CTL = 0;
constexpr size_t WS_WIN = 1 * MiB;
constexpr size_t WS_WOUT = 8 * MiB;
constexpr size_t WS_WQ = 10 * MiB;
constexpr size_t WS_WKV = 12 * MiB;
constexpr size_t WS_WMO = 16 * MiB;
constexpr size_t WS_WR = 18 * MiB;
constexpr size_t WS_WGU = 20 * MiB;
constexpr size_t WS_WDN = 148 * MiB;
constexpr size_t WS_XN = 212 * MiB;
constexpr size_t WS_MEMN = 244 * MiB;
constexpr size_t WS_KV = 245 * MiB;
constexpr size_t WS_BS = 247 * MiB;
constexpr size_t WS_BO = 251 * MiB;
constexpr size_t WS_PROJ = 256 * MiB;
constexpr size_t WS_LA = 360 * MiB;
constexpr size_t WS_ORAW = 376 * MiB;
constexpr size_t WS_MIX = 408 * MiB;
constexpr size_t WS_S = 440 * MiB;
constexpr size_t WS_P = 504 * MiB;
constexpr size_t WS_LG = 536 * MiB;
constexpr size_t WS_TOKE = 538 * MiB;
constexpr size_t WS_TOKR = 539 * MiB;
constexpr size_t WS_TOKW = 540 * MiB;
constexpr size_t WS_LIST = 541 * MiB;
constexpr size_t WS_ACT = 544 * MiB;
constexpr size_t WS_YS = 674 * MiB;
constexpr size_t WS_DUMMY = 804 * MiB;
constexpr size_t WS_END = 872 * MiB;
constexpr int CW_CNT = 1024;

template <int MAP> __device__ __forceinline__ int srccol(int n, float& sc) {
    sc = 1.f;
    if (MAP == 0) return n;
    if (MAP == 1) {
        if (n < 256) { sc = 0.125f; return n; }
        if (n < 1024) return n;
        if (n < 3072) { if (n >= C_QS && n < C_KS) sc = 0.125f * LOG2E; return n + 16; }
        if (n < 3088) return 1024 + (n - 3072);
        return -1;
    }
    { const int ct = n >> 8, w = n & 255; return (w < 128) ? (128 * ct + w) : (1024 + 128 * ct + (w - 128)); }
}
template <int MAP>
__device__ __forceinline__ void conv_t_body(size_t gtid, size_t gsz, const float* __restrict__ src, bf16_t* __restrict__ dst, const float* __restrict__ gain,
                                               int ldsrc, int K, int nrows, int nmat, size_t sms, size_t dms) {
    const int kc8 = K / 8;
    const size_t total = (size_t)nmat * nrows * kc8;
    for (size_t idx = gtid; idx < total; idx += gsz) {
        const int n = (int)(idx % nrows); const size_t t = idx / nrows; const int kc = (int)(t % kc8); const int mat = (int)(t / kc8);
        float sc; const int c = srccol<MAP>(n, sc);
        u32x4 o = {0u, 0u, 0u, 0u};
        if (c >= 0) {
            const float* s = src + (size_t)mat * sms + (size_t)(kc * 8) * ldsrc + c;
            float v[8];
#pragma unroll
            for (int j = 0; j < 8; ++j) v[j] = s[(size_t)j * ldsrc] * (gain ? gain[kc * 8 + j] : 1.f) * sc;
            o.x = pk2(v[0], v[1]); o.y = pk2(v[2], v[3]); o.z = pk2(v[4], v[5]); o.w = pk2(v[6], v[7]);
        }
        *(u32x4*)(dst + (size_t)mat * dms + (size_t)n * K + kc * 8) = o;
    }
}
template <int MAP>
__device__ __forceinline__ void conv_item(float* scr, const float* __restrict__ src, bf16_t* __restrict__ dst, const float* __restrict__ gain, int ldsrc, int K, int nrows, int kb, int nb, int lane) {
    const int k0 = kb * 64, n0 = nb * 32; float sc; const int c0 = srccol<MAP>(n0, sc);
    const int half = lane >> 5, l31 = lane & 31;
    const float* s0 = src + (size_t)(k0 + half) * ldsrc + c0 + l31;
    float v[32];
#pragma unroll
    for (int i = 0; i < 32; ++i) v[i] = s0[(size_t)(2 * i) * ldsrc];
#pragma unroll
    for (int i = 0; i < 32; ++i) { const int kk = 2 * i + half; const float g = (gain ? gain[k0 + kk] : 1.f) * sc; scr[kk * 33 + l31] = v[i] * g; }
    asm volatile("s_waitcnt lgkmcnt(0)" ::: "memory");
    const int c = lane & 7;
#pragma unroll
    for (int j = 0; j < 4; ++j) { const int n = (lane >> 3) + 8 * j; const float* s = scr + (8 * c) * 33 + n;
        u32x4 o; o.x = pk2(s[0 * 33], s[1 * 33]); o.y = pk2(s[2 * 33], s[3 * 33]); o.z = pk2(s[4 * 33], s[5 * 33]); o.w = pk2(s[6 * 33], s[7 * 33]);
        if (n0 + n < nrows) *(u32x4*)(dst + (size_t)(n0 + n) * K + k0 + 8 * c) = o; }
    asm volatile("s_waitcnt lgkmcnt(0)" ::: "memory");
}
__device__ __forceinline__ unsigned pk4_fp8(float a, float b, float c, float d) { int w = __builtin_amdgcn_cvt_pk_fp8_f32(a, b, 0, false); w = __builtin_amdgcn_cvt_pk_fp8_f32(c, d, w, true); return (unsigned)w; }
template <int MAP>
__device__ __forceinline__ void conv_item8(float* scr, const float* __restrict__ src, unsigned char* __restrict__ dst, const float* __restrict__ gain, int ldsrc, int K, int nrows, int kb, int nb, int lane, float mul) {
    const int k0 = kb * 64, n0 = nb * 32; float sc; const int c0 = srccol<MAP>(n0, sc); sc *= mul;
    const int half = lane >> 5, l31 = lane & 31;
    const float* s0 = src + (size_t)(k0 + half) * ldsrc + c0 + l31;
    float v[32];
#pragma unroll
    for (int i = 0; i < 32; ++i) v[i] = s0[(size_t)(2 * i) * ldsrc];
#pragma unroll
    for (int i = 0; i < 32; ++i) { const int kk = 2 * i + half; const float g = (gain ? gain[k0 + kk] : 1.f) * sc; scr[kk * 33 + l31] = v[i] * g; }
    asm volatile("s_waitcnt lgkmcnt(0)" ::: "memory");
    const int c = lane & 3;
#pragma unroll
    for (int j = 0; j < 2; ++j) { const int n = (lane >> 2) + 16 * j; const float* s = scr + (16 * c) * 33 + n;
        u32x4 o; o.x = pk4_fp8(s[0 * 33], s[1 * 33], s[2 * 33], s[3 * 33]); o.y = pk4_fp8(s[4 * 33], s[5 * 33], s[6 * 33], s[7 * 33]);
        o.z = pk4_fp8(s[8 * 33], s[9 * 33], s[10 * 33], s[11 * 33]); o.w = pk4_fp8(s[12 * 33], s[13 * 33], s[14 * 33], s[15 * 33]);
        if (n0 + n < nrows) *(u32x4*)(dst + (size_t)(n0 + n) * K + k0 + 16 * c) = o; }
    asm volatile("s_waitcnt lgkmcnt(0)" ::: "memory");
}
__device__ __forceinline__ void conv_n_body(size_t gtid, size_t gsz, const float* __restrict__ src, bf16_t* __restrict__ dst, const float* __restrict__ gain, int K, int nrows, float sc) {
    const int kc8 = K / 8; const size_t total = (size_t)nrows * kc8;
    for (size_t idx = gtid; idx < total; idx += gsz) {
        const int kc = (int)(idx % kc8), n = (int)(idx / kc8);
        const float g = gain[n] * sc; const f32x4 a = *(const f32x4*)(src + (size_t)n * K + kc * 8), b = *(const f32x4*)(src + (size_t)n * K + kc * 8 + 4);
        u32x4 o; o.x = pk2(a.x * g, a.y * g); o.y = pk2(a.z * g, a.w * g); o.z = pk2(b.x * g, b.y * g); o.w = pk2(b.z * g, b.w * g);
        *(u32x4*)(dst + (size_t)n * K + kc * 8) = o;
    }
}

__device__ __forceinline__ float wave_sum(float v) {
#pragma unroll
    for (int o = 1; o < 64; o <<= 1) v += __shfl_xor(v, o);
    return v;
}
__device__ __forceinline__ void rms_body(int gw, int ngw, int lane, const float* __restrict__ x, bf16_t* __restrict__ out, int nrows) {
    for (int row = gw; row < nrows; row += ngw) {
        const f32x4* xr = (const f32x4*)(x + (size_t)row * DM) + lane; f32x4 v[4]; float s = 0.f;
#pragma unroll
        for (int j = 0; j < 4; ++j) { v[j] = xr[64 * j]; s += v[j].x * v[j].x + v[j].y * v[j].y + v[j].z * v[j].z + v[j].w * v[j].w; }
        const float rstd = 1.0f / sqrtf(wave_sum(s) * (1.f / DM) + EPS);
        u32x2* o = (u32x2*)(out + (size_t)row * DM) + lane;
#pragma unroll
        for (int j = 0; j < 4; ++j) { u32x2 w; w.x = pk2(v[j].x * rstd, v[j].y * rstd); w.y = pk2(v[j].z * rstd, v[j].w * rstd); o[64 * j] = w; }
    }
}

struct GUnit { unsigned ao, bo; int row0, col0, e, valid, aux; };

__host__ __device__ __forceinline__ int lds_byte(int r, int c) { const int st = (r >> 4) * 2 + (c >> 5), rr = r & 15, cc = c & 31, ob = rr * 64 + cc * 2; return st * 1024 + (ob ^ (((ob >> 9) & 1) << 5)); }
__host__ __device__ __forceinline__ void stage_rc(int b, int& R, int& C) { const int st = b / 1024, sb = b % 1024, swz = sb ^ (((sb >> 9) & 1) << 5); R = (st >> 1) * 16 + swz / 64; C = (st & 1) * 32 + (swz % 64) / 2; }
__host__ __device__ __forceinline__ int perm32(int rho) { const int n = rho >> 4, i = rho & 15; return 8 * (i >> 2) + 4 * n + (i & 3); }
constexpr int HTB = 128 * 64 * 2;
typedef int v8i __attribute__((ext_vector_type(8)));
typedef int v4i __attribute__((ext_vector_type(4)));
struct Frag2 { bf16x8 h[2]; };
template <bool F> struct FragT { typedef Frag2 T; };
template <> struct FragT<true> { typedef v8i T; };
template <class Sched, class Epi, bool ALIGN_EPI, bool FP8 = false, int SCALE_B = 0x7f>
__device__ __forceinline__ void gemm_phase(unsigned char* lds_flat, const Sched& S, const Epi& E) {
    LDSP unsigned char* lds = (LDSP unsigned char*)(unsigned)(uintptr_t)lds_flat;
    int tid = threadIdx.x; LAUNDER(tid);
    const int wid = __builtin_amdgcn_readfirstlane(tid >> 6), lane = tid & 63, wr = wid >> 2, wc = wid & 3, fr = lane & 15, fq = lane >> 4;
    const int nt = S.K / 64;
    int Rr[2], Cc[2];
#pragma unroll
    for (int i = 0; i < 2; ++i) stage_rc(tid * 16 + i * 8192, Rr[i], Cc[i]);
    unsigned voffB[2][2];
#pragma unroll
    for (int h = 0; h < 2; ++h)
#pragma unroll
        for (int i = 0; i < 2; ++i) voffB[h][i] = (unsigned)(128 * h + (Rr[i] & ~31) + perm32(Rr[i] & 31)) * S.ldb + (unsigned)Cc[i] * 2u;
    const unsigned ldsw = (unsigned)wid * 1024u;
    const int aoff = lds_byte(wr * 64 + fr, FP8 ? fq * 16 : fq * 8), boff = lds_byte(wc * 32 + fr, FP8 ? fq * 16 : fq * 8);
    constexpr int KSUB = FP8 ? 16 : 1024;
#define PG8_SA(b, h) (((b) * 2 + (h)) * HTB)
#define PG8_SB(b, h) ((4 + (b) * 2 + (h)) * HTB)
#define PG8_STAGE(bufoff, rsrc, voff, soff) do { _Pragma("unroll") for (int _i = 0; _i < 2; ++_i) \
        __builtin_amdgcn_raw_ptr_buffer_load_lds(rsrc, (LDSP unsigned*)(lds + (bufoff) + ldsw + _i * 8192), 16, (int)(voff)[_i], (int)(soff), 0, 0); } while (0)
#define PG8_LDF(dst, addr) do { const bf16x8 lo_ = *(const LDSP bf16x8*)(addr); const bf16x8 hi_ = *(const LDSP bf16x8*)((addr) + KSUB); \
        if constexpr (FP8) dst = __builtin_shufflevector(__builtin_bit_cast(v4i, lo_), __builtin_bit_cast(v4i, hi_), 0, 1, 2, 3, 4, 5, 6, 7); else { dst.h[0] = lo_; dst.h[1] = hi_; } } while (0)
#define PG8_LDA(dst, b, h) do { _Pragma("unroll") for (int m = 0; m < 4; ++m) PG8_LDF(dst[m], lds + PG8_SA(b, h) + aoff + m * 2048); } while (0)
#define PG8_LDB(dst, b, h) do { _Pragma("unroll") for (int n = 0; n < 2; ++n) PG8_LDF(dst[n], lds + PG8_SB(b, h) + boff + n * 2048); } while (0)
#define PG8_MMA(ai, bj, At, Bt) do { __builtin_amdgcn_s_setprio(1); _Pragma("unroll") for (int m = 0; m < 4; ++m) _Pragma("unroll") for (int n = 0; n < 2; ++n) { \
        if constexpr (FP8) asm volatile("v_mfma_scale_f32_16x16x128_f8f6f4 %0, %1, %2, %0, %3, %4 op_sel_hi:[0,0,0]" : "+v"(acc[ai][bj][m][n]) : "v"(Bt[n]), "v"(At[m]), "v"(sclB), "v"(sclA)); \
        else { _Pragma("unroll") for (int k = 0; k < 2; ++k) acc[ai][bj][m][n] = __builtin_amdgcn_mfma_f32_16x16x32_bf16(Bt[n].h[k], At[m].h[k], acc[ai][bj][m][n], 0, 0, 0); } } \
        __builtin_amdgcn_s_setprio(0); } while (0)
#define PG8_WAIT_V(n) asm volatile("s_waitcnt vmcnt(" #n ")" ::: "memory")
#define PG8_WAIT_L(n) asm volatile("s_waitcnt lgkmcnt(" #n ")" ::: "memory")
#define PG8_BAR __builtin_amdgcn_s_barrier()
#define PG8_SCHED __builtin_amdgcn_sched_barrier(0)
    GUnit cur, nxt; int ui = 0;
    if (!S.next(0, cur)) return;
    const __amdgpu_buffer_rsrc_t rA = __builtin_amdgcn_make_buffer_rsrc((void*)S.A, 0, 0x7fffffff, 0x00020000);
    const __amdgpu_buffer_rsrc_t rB = __builtin_amdgcn_make_buffer_rsrc((void*)S.Bt, 0, 0x7fffffff, 0x00020000);
    unsigned oc[2][2], on[2][2];
#pragma unroll
    for (int h = 0; h < 2; ++h)
#pragma unroll
        for (int i = 0; i < 2; ++i) oc[h][i] = S.a_off(cur, 128 * h + Rr[i]) + (unsigned)Cc[i] * 2u;
    f32x4 acc[2][2][4][2];
#pragma unroll
    for (int a = 0; a < 2; ++a)
#pragma unroll
        for (int b = 0; b < 2; ++b)
#pragma unroll
            for (int m = 0; m < 4; ++m)
#pragma unroll
                for (int n = 0; n < 2; ++n) acc[a][b][m][n] = (f32x4){0.f, 0.f, 0.f, 0.f};
    typedef typename FragT<FP8>::T frag_t;
    frag_t At[4], B0[2], B1[2];
    const unsigned kstep = 128;
    const int sclB = SCALE_B * 0x01010101, sclA = 0x7f7f7f7f; (void)sclA; (void)sclB;
    PG8_STAGE(PG8_SB(0, 0), rB, voffB[0], cur.bo); PG8_STAGE(PG8_SB(0, 1), rB, voffB[1], cur.bo); PG8_STAGE(PG8_SA(0, 0), rA, oc[0], cur.ao); PG8_STAGE(PG8_SA(0, 1), rA, oc[1], cur.ao);
    if (wr == 1) PG8_BAR;
    PG8_WAIT_V(2); PG8_BAR;
    PG8_STAGE(PG8_SB(1, 0), rB, voffB[0], cur.bo + kstep); PG8_STAGE(PG8_SA(1, 0), rA, oc[0], cur.ao + kstep); PG8_STAGE(PG8_SB(1, 1), rB, voffB[1], cur.bo + kstep);
    PG8_WAIT_V(6); PG8_BAR;
    for (;;) {
        const bool has_next = S.next(ui + 1, nxt);
        if (!has_next) nxt = cur;
        const unsigned nA = nxt.ao, nB = nxt.bo;
        { int t2 = threadIdx.x; LAUNDER(t2);
#pragma unroll
          for (int i = 0; i < 2; ++i) { int R_, C_; stage_rc(t2 * 16 + i * 8192, R_, C_);
#pragma unroll
              for (int h = 0; h < 2; ++h) on[h][i] = S.a_off(nxt, 128 * h + R_) + (unsigned)C_ * 2u; } }
        for (int t = 0; t < nt; t += 2) {
            const bool last = (t == nt - 2);
            const unsigned k1 = cur.ao + (unsigned)(t + 1) * kstep;
            const unsigned a2 = last ? nA : cur.ao + (unsigned)(t + 2) * kstep, b2 = last ? nB : cur.bo + (unsigned)(t + 2) * kstep, a3 = a2 + kstep, b3 = b2 + kstep;
            unsigned o2[2][2];
#pragma unroll
            for (int h = 0; h < 2; ++h)
#pragma unroll
                for (int i = 0; i < 2; ++i) o2[h][i] = last ? on[h][i] : oc[h][i];
            PG8_LDB(B0, 0, 0); PG8_LDB(B1, 0, 1); PG8_SCHED; PG8_LDA(At, 0, 0); PG8_STAGE(PG8_SA(1, 1), rA, oc[1], k1);
            PG8_WAIT_V(8); PG8_WAIT_L(0); PG8_BAR; PG8_MMA(0, 0, At, B0); PG8_MMA(0, 1, At, B1); PG8_BAR; PG8_SCHED;
            PG8_LDA(At, 0, 1); PG8_STAGE(PG8_SB(0, 0), rB, voffB[0], b2); PG8_STAGE(PG8_SB(0, 1), rB, voffB[1], b2); PG8_STAGE(PG8_SA(0, 0), rA, o2[0], a2);
            PG8_WAIT_V(8); PG8_WAIT_L(0); PG8_BAR; PG8_MMA(1, 0, At, B0); PG8_MMA(1, 1, At, B1); PG8_BAR; PG8_SCHED;
            PG8_LDB(B0, 1, 0); PG8_LDB(B1, 1, 1); PG8_SCHED; PG8_LDA(At, 1, 0); PG8_STAGE(PG8_SA(0, 1), rA, o2[1], a2);
            PG8_WAIT_V(8); PG8_WAIT_L(0); PG8_BAR; PG8_MMA(0, 0, At, B0); PG8_MMA(0, 1, At, B1); PG8_BAR; PG8_SCHED;
            PG8_LDA(At, 1, 1); PG8_STAGE(PG8_SB(1, 0), rB, voffB[0], b3); PG8_STAGE(PG8_SB(1, 1), rB, voffB[1], b3); PG8_STAGE(PG8_SA(1, 0), rA, o2[0], a3);
            PG8_WAIT_V(8); PG8_WAIT_L(0); PG8_BAR; PG8_MMA(1, 0, At, B0); PG8_MMA(1, 1, At, B1); PG8_BAR; PG8_SCHED;
        }
        if constexpr (FP8) asm volatile("s_nop 15\n\ts_nop 15" ::: "memory");
        if constexpr (ALIGN_EPI) { if (wr == 0) PG8_BAR; }
        if constexpr (!Epi::AFTER_DRAIN) E(acc, cur, wr, wc, fr, fq);
        if (!has_next) break;
#pragma unroll
        for (int a = 0; a < 2; ++a)
#pragma unroll
            for (int b = 0; b < 2; ++b)
#pragma unroll
                for (int m = 0; m < 4; ++m)
#pragma unroll
                    for (int n = 0; n < 2; ++n) acc[a][b][m][n] = (f32x4){0.f, 0.f, 0.f, 0.f};
        cur = nxt; ++ui;
#pragma unroll
        for (int h = 0; h < 2; ++h)
#pragma unroll
            for (int i = 0; i < 2; ++i) oc[h][i] = on[h][i];
        if constexpr (ALIGN_EPI) { if (wr == 1) PG8_BAR; }
    }
    PG8_WAIT_V(0);
    if constexpr (!ALIGN_EPI) { if (wr == 0) PG8_BAR; }
    PG8_BAR;
    if constexpr (Epi::AFTER_DRAIN) E.fused(acc, cur, wr, wc, fr, fq, lds_flat, wid, lane);
#undef PG8_SA
#undef PG8_SB
#undef PG8_STAGE
#undef PG8_LDA
#undef PG8_LDF
#undef PG8_LDB
#undef PG8_MMA
#undef PG8_WAIT_V
#undef PG8_WAIT_L
#undef PG8_BAR
#undef PG8_SCHED
}
template <bool ALIGN, class Sched, class Epi> __device__ __forceinline__ void gemm_run(unsigned char* lds, const Sched& S, const Epi& E) {
    gemm_phase<Sched, Epi, ALIGN>(lds, S, E);
}
constexpr int WSCALE_LOG2 = 6;
template <bool ALIGN, class Sched, class Epi> __device__ __forceinline__ void gemm_run_fp8(unsigned char* lds, const Sched& S, const Epi& E) {
    gemm_phase<Sched, Epi, ALIGN, true, 127 - WSCALE_LOG2>(lds, S, E);
}
#define EPI_ROWS(r) for (int ai = 0; ai < 2; ++ai) for (int m = 0; m < 4; ++m) { const int r = 128 * ai + 64 * wr + 16 * m + fr;
#define EPI_COLS(c) for (int bj = 0; bj < 2; ++bj) for (int n = 0; n < 2; ++n) { const int c = 128 * bj + 32 * wc + 16 * n + 4 * fq; const f32x4 v = acc[ai][bj][m][n];
#define EPI_END }

struct DenseSched {
    const char* A; const char* Bt; unsigned lda, ldb; int K; int nM, nN; int pm_per_b; size_t zB; int G, c;
    __device__ __forceinline__ bool next(int i, GUnit& u) const {
        int pm, pn;
        if (G == 256 && (nN & 3) == 0 && nM * nN >= 256) {
            const int j = c & 7, q = c >> 3, s = i * 8 + j, ncg = nN >> 2; pm = (s / ncg) * 8 + (q >> 2); pn = (s % ncg) * 4 + (q & 3); if (c < 0 || pm >= nM) return false; }
        else { const long L = (long)i * G + c; if (c < 0 || L >= (long)nM * nN) return false; pm = (int)(L / nN); pn = (int)(L % nN); }
        u.ao = (unsigned)pm * 256u * lda; u.bo = (unsigned)((size_t)(pm / pm_per_b) * zB) + (unsigned)pn * 256u * ldb; u.row0 = pm * 256; u.col0 = pn * 256; u.e = 0; u.valid = 256; u.aux = 0; return true;
    }
    __device__ __forceinline__ unsigned a_off(const GUnit&, int r) const { return (unsigned)r * lda; }
};
struct SchedWqk {
    const char* A; const char* Bt; unsigned lda, ldb; int K; int G, c, pad;
    __device__ __forceinline__ bool next(int i, GUnit& u) const {
        const int L = i * G + c; if (c < 0 || L >= 32) return false; const int z = L >> 2, pn = L & 3, b = z >> 2, h = z & 3;
        u.ao = (unsigned)b * 256u * 4096u + h * 512u; u.bo = (unsigned)pn * 256u * 2048u + h * 512u; u.row0 = z * 256; u.col0 = pn * 256; u.e = 0; u.valid = 256; u.aux = 0; return true;
    }
    __device__ __forceinline__ unsigned a_off(const GUnit&, int r) const { return (unsigned)r * lda; }
};
struct SchedVo {
    const char* A; const char* Bt; unsigned lda, ldb; int K; int G, c, pad;
    __device__ __forceinline__ bool next(int i, GUnit& u) const {
        const int L = i * G + c; if (c < 0 || L >= 32) return false; const int z = L >> 2, pm = L & 3, b = z >> 2, h = z & 3;
        u.ao = (unsigned)pm * 256u * 2048u + h * 512u; u.bo = (unsigned)b * 256u * 4096u + 2048u + h * 512u; u.row0 = b * 1024 + pm * 256; u.col0 = h * 256; u.e = 0; u.valid = 256; u.aux = 0; return true;
    }
    __device__ __forceinline__ unsigned a_off(const GUnit&, int r) const { return (unsigned)r * lda; }
};
template <bool GATHER> struct MoeSched {
    const char* A; const char* Bt; unsigned lda, ldb; int K; int nN; size_t zB;
    const int* tab; const int* list; int gather; int G, c, pad;
    __device__ __forceinline__ bool next(int i, GUnit& u) const {
        int T, pn;
        if (G == 256) { const int j = c & 7, q = c >> 3, s = i * 8 + j;
            if (nN == 8) { T = 4 * s + (q >> 3); pn = q & 7; } else { T = 8 * s + (q >> 2); pn = q & 3; } }
        else { const int L = i * G + c; T = L / nN; pn = L % nN; }
        if (T >= tab[64]) return false;
        const int w = tab[128 + T]; const int e = w & 255, rt = w >> 8; const int ce = tab[e], start = tab[32 + e];
        u.e = e; u.valid = min(256, ce - rt * 256); u.row0 = start + rt * 256; u.col0 = pn * 256; u.aux = rt * 256;
        u.ao = GATHER ? 0u : (unsigned)u.row0 * lda; u.bo = (unsigned)((size_t)e * zB) + (unsigned)pn * 256u * ldb; return true;
    }
    __device__ __forceinline__ unsigned a_off(const GUnit& u, int r) const {
        if (!GATHER) return (unsigned)r * lda;
        const int rr = r < u.valid ? r : 0; const int tok = list[u.e * NTOK + u.aux + rr]; return (unsigned)tok * lda;
    }
};
__device__ __forceinline__ void moe_build_table(int* tab, const int* __restrict__ cnt, int tid) {
    if (tid < 32) tab[tid] = cnt[tid * 32];
    __syncthreads();
    if (tid < 32) { int s = 0; for (int e = 0; e < tid; ++e) s += tab[e]; tab[32 + tid] = s; }
    if (tid < 320) { int tiles = 0, found = -1;
        for (int e = 0; e < NEXP; ++e) { const int te = (tab[e] + 255) >> 8; if (found < 0 && tid < tiles + te) found = e | ((tid - tiles) << 8); tiles += te; }
        if (found >= 0) tab[128 + tid] = found; if (tid == 0) tab[64] = tiles; }
    __syncthreads();
}

__device__ __forceinline__ u32x4 pack8(const f32x4& a, const f32x4& b) { u32x4 w; w.x = pk2(a[0], a[1]); w.y = pk2(a[2], a[3]); w.z = pk2(b[0], b[1]); w.w = pk2(b[2], b[3]); return w; }
struct EpiBf16 { static constexpr bool AFTER_DRAIN = false; bf16_t* O; int ldc, pad;
    __device__ __forceinline__ void operator()(const f32x4 (&acc)[2][2][4][2], const GUnit& u, int wr, int wc, int fr, int fq) const {
        LAUNDER(fr); LAUNDER(fq);
#pragma unroll
        for (int ai = 0; ai < 2; ++ai)
#pragma unroll
            for (int m = 0; m < 4; ++m) { const int r = 128 * ai + 64 * wr + 16 * m + fr;
#pragma unroll
                for (int bj = 0; bj < 2; ++bj) *(u32x4*)(O + (size_t)(u.row0 + r) * ldc + u.col0 + 128 * bj + 32 * wc + 8 * fq) = pack8(acc[ai][bj][m][0], acc[ai][bj][m][1]); } } };
__device__ __forceinline__ float row_rstd(const float* __restrict__ ssp, int row) { const f32x4* p = (const f32x4*)(ssp + (size_t)row * 16); const f32x4 a = p[0], b = p[1], c = p[2], d = p[3];
    const float s = (((a[0] + a[1]) + (a[2] + a[3])) + ((b[0] + b[1]) + (b[2] + b[3]))) + (((c[0] + c[1]) + (c[2] + c[3])) + ((d[0] + d[1]) + (d[2] + d[3]))); return 1.0f / sqrtf(s * (1.0f / 1024.0f) + EPS); }
template <bool BASE_BF16> struct EpiResidSS { static constexpr bool AFTER_DRAIN = false; const void* base; bf16_t* xb; float* ss; unsigned char* xq;
    __device__ __forceinline__ void operator()(const f32x4 (&acc)[2][2][4][2], const GUnit& u, int wr, int wc, int fr, int fq) const {
        LAUNDER(fr); LAUNDER(fq);
#pragma unroll
        for (int ai = 0; ai < 2; ++ai) {
            f32x4 b[4][2][2];
#pragma unroll
            for (int m = 0; m < 4; ++m)
#pragma unroll
                for (int bj = 0; bj < 2; ++bj) { const size_t o = (size_t)(u.row0 + 128 * ai + 64 * wr + 16 * m + fr) * 1024 + u.col0 + 128 * bj + 32 * wc + 8 * fq;
                    if (BASE_BF16) { const u32x4 w = *(const u32x4*)((const bf16_t*)base + o); b[m][bj][0] = (f32x4){bflo(w.x), bfhi(w.x), bflo(w.y), bfhi(w.y)}; b[m][bj][1] = (f32x4){bflo(w.z), bfhi(w.z), bflo(w.w), bfhi(w.w)}; }
                    else { b[m][bj][0] = *(const f32x4*)((const float*)base + o); b[m][bj][1] = *(const f32x4*)((const float*)base + o + 4); } }
#pragma unroll
            for (int m = 0; m < 4; ++m) { const int r = 128 * ai + 64 * wr + 16 * m + fr; float part = 0.f;
#pragma unroll
                for (int bj = 0; bj < 2; ++bj) { const size_t o = (size_t)(u.row0 + r) * 1024 + u.col0 + 128 * bj + 32 * wc + 8 * fq;
                    const f32x4 y0 = b[m][bj][0] + acc[ai][bj][m][0], y1 = b[m][bj][1] + acc[ai][bj][m][1]; *(u32x4*)(xb + o) = pack8(y0, y1);
                    if (xq) { u32x2 q; q.x = pk4_fp8(y0[0], y0[1], y0[2], y0[3]); q.y = pk4_fp8(y1[0], y1[1], y1[2], y1[3]); *(u32x2*)(xq + o) = q; }
                    part += (y0[0] * y0[0] + y0[1] * y0[1] + y0[2] * y0[2] + y0[3] * y0[3]) + (y1[0] * y1[0] + y1[1] * y1[1] + y1[2] * y1[2] + y1[3] * y1[3]); }
                part += __shfl_xor(part, 16); part += __shfl_xor(part, 32);
                if (fq == 0) ss[(size_t)(u.row0 + r) * 16 + (u.col0 >> 8) * 4 + wc] = part; } } } };
struct EpiSoftmax { static constexpr bool AFTER_DRAIN = true; const float* ss; bf16_t* P;
    __device__ __forceinline__ void operator()(const f32x4 (&)[2][2][4][2], const GUnit&, int, int, int, int) const {}
    __device__ __forceinline__ void fused(f32x4 (&acc)[2][2][4][2], const GUnit& u, int wr, int wc, int fr, int fq, unsigned char* lds, int wid, int lane) const {
        float* Pm = (float*)lds; float* Ps = (float*)(lds + 4096);
        LAUNDER(fr); LAUNDER(fq);
#pragma unroll
        for (int ai = 0; ai < 2; ++ai)
#pragma unroll
            for (int m = 0; m < 4; ++m) { const int r = 128 * ai + 64 * wr + 16 * m + fr; const float rstd = row_rstd(ss, u.row0 + r); float mv = -INFINITY;
#pragma unroll
                for (int bj = 0; bj < 2; ++bj)
#pragma unroll
                    for (int n = 0; n < 2; ++n) { f32x4 s = acc[ai][bj][m][n] * rstd; acc[ai][bj][m][n] = s; mv = fmaxf(mv, fmaxf(fmaxf(s[0], s[1]), fmaxf(s[2], s[3]))); }
                mv = fmaxf(mv, __shfl_xor(mv, 16)); mv = fmaxf(mv, __shfl_xor(mv, 32));
                if (fq == 0) Pm[r * 4 + wc] = mv; }
        __syncthreads();
#pragma unroll
        for (int ai = 0; ai < 2; ++ai)
#pragma unroll
            for (int m = 0; m < 4; ++m) { const int r = 128 * ai + 64 * wr + 16 * m + fr; const f32x4 pm = *(const f32x4*)(Pm + r * 4); const float mv = fmaxf(fmaxf(pm[0], pm[1]), fmaxf(pm[2], pm[3])); float sum = 0.f;
#pragma unroll
                for (int bj = 0; bj < 2; ++bj)
#pragma unroll
                    for (int n = 0; n < 2; ++n) { f32x4 s = acc[ai][bj][m][n]; s[0] = __builtin_amdgcn_exp2f(s[0] - mv); s[1] = __builtin_amdgcn_exp2f(s[1] - mv); s[2] = __builtin_amdgcn_exp2f(s[2] - mv); s[3] = __builtin_amdgcn_exp2f(s[3] - mv);
                        acc[ai][bj][m][n] = s; sum += (s[0] + s[1]) + (s[2] + s[3]); }
                sum += __shfl_xor(sum, 16); sum += __shfl_xor(sum, 32);
                if (fq == 0) Ps[r * 4 + wc] = sum; }
        __syncthreads();
#pragma unroll
        for (int ai = 0; ai < 2; ++ai)
#pragma unroll
            for (int m = 0; m < 4; ++m) { const int r = 128 * ai + 64 * wr + 16 * m + fr; const f32x4 ps = *(const f32x4*)(Ps + r * 4); const float inv = 1.0f / ((ps[0] + ps[1]) + (ps[2] + ps[3]));
#pragma unroll
                for (int bj = 0; bj < 2; ++bj) *(u32x4*)(P + (size_t)(u.row0 + r) * 1024 + u.col0 + 128 * bj + 32 * wc + 8 * fq) = pack8(acc[ai][bj][m][0] * inv, acc[ai][bj][m][1] * inv); }
        (void)wid; (void)lane;
        __syncthreads();
    } };
struct EpiGU { static constexpr bool AFTER_DRAIN = false; const float* bgu; unsigned char* act  ; const float* lrs  ;
    __device__ __forceinline__ void operator()(const f32x4 (&acc)[2][2][4][2], const GUnit& u, int wr, int wc, int fr, int fq) const {
        const int pn = u.col0 >> 8; const float* bg = bgu + (size_t)u.e * 2048; LAUNDER(fr); LAUNDER(fq);
        float rs[8];
#pragma unroll
        for (int i = 0; i < 8; ++i) { const int r = 128 * (i >> 2) + 64 * wr + 16 * (i & 3) + fr; rs[i] = lrs[(size_t)u.e * NTOK + u.aux + (r < u.valid ? r : 0)]; }
        const int col = 128 * pn + 32 * wc + 8 * fq;
        f32x4 bgv[2], blv[2];
#pragma unroll
        for (int n = 0; n < 2; ++n) { bgv[n] = *(const f32x4*)(bg + col + 4 * n); blv[n] = *(const f32x4*)(bg + 1024 + col + 4 * n); }
#pragma unroll
        for (int ai = 0; ai < 2; ++ai)
#pragma unroll
            for (int m = 0; m < 4; ++m) { const int r = 128 * ai + 64 * wr + 16 * m + fr; const float rstd = rs[ai * 4 + m]; u32x2 q;
#pragma unroll
                for (int n = 0; n < 2; ++n) { const f32x4 g = acc[ai][0][m][n] * rstd + bgv[n], l = acc[ai][1][m][n] * rstd + blv[n]; float o[4];
#pragma unroll
                    for (int j = 0; j < 4; ++j) { const float gg = fminf(g[j], 7.0f), ll = fminf(fmaxf(l[j], -7.0f), 7.0f); o[j] = (ll + 1.0f) * (gg * __builtin_amdgcn_rcpf(1.0f + __builtin_amdgcn_exp2f(-1.702f * LOG2E * gg))); }
                    const unsigned w = pk4_fp8(o[0], o[1], o[2], o[3]); if (n == 0) q.x = w; else q.y = w; }
                if (r < u.valid) *(u32x2*)(act + (size_t)(u.row0 + r) * 1024 + col) = q; } } };
struct EpiDown { static constexpr bool AFTER_DRAIN = false; const float* bdn; unsigned char* ys  ;
    __device__ __forceinline__ void operator()(const f32x4 (&acc)[2][2][4][2], const GUnit& u, int wr, int wc, int fr, int fq) const {
        const float* bd = bdn + (size_t)u.e * 1024; LAUNDER(fr); LAUNDER(fq);
        f32x4 bv[2][2];
#pragma unroll
        for (int bj = 0; bj < 2; ++bj)
#pragma unroll
            for (int n = 0; n < 2; ++n) bv[bj][n] = *(const f32x4*)(bd + u.col0 + 128 * bj + 32 * wc + 8 * fq + 4 * n);
#pragma unroll
        for (int ai = 0; ai < 2; ++ai)
#pragma unroll
            for (int m = 0; m < 4; ++m) { const int r = 128 * ai + 64 * wr + 16 * m + fr; if (r < u.valid) {
#pragma unroll
                for (int bj = 0; bj < 2; ++bj) { const f32x4 y0 = acc[ai][bj][m][0] + bv[bj][0], y1 = acc[ai][bj][m][1] + bv[bj][1]; u32x2 q; q.x = pk4_fp8(y0[0], y0[1], y0[2], y0[3]); q.y = pk4_fp8(y1[0], y1[1], y1[2], y1[3]);
                    *(u32x2*)(ys + (size_t)(u.row0 + r) * 1024 + u.col0 + 128 * bj + 32 * wc + 8 * fq) = q; } } } } };


typedef float f32x16 __attribute__((ext_vector_type(16)));
typedef short s16x4 __attribute__((ext_vector_type(4)));
__device__ __forceinline__ int crow(int r, int hi) { return (r & 3) + 8 * (r >> 2) + 4 * hi; }
__device__ __forceinline__ s16x4 tr_read(const unsigned char* p) { return __builtin_bit_cast(s16x4, __builtin_amdgcn_ds_read_tr16_b64_v4i16((LDSP s16x4*)(unsigned)(uintptr_t)p)); }
__device__ __forceinline__ bf16x8 tr_frag(const unsigned char* img, int pitch, int k0, int f0, int lane) {
    const unsigned char* p = img + (k0 + 8 * (lane >> 5) + ((lane & 15) >> 2)) * pitch + (f0 + 16 * ((lane >> 4) & 1) + 4 * (lane & 3)) * 2;
    const s16x4 lo = tr_read(p), hi = tr_read(p + 4 * pitch);
    return (bf16x8){lo[0], lo[1], lo[2], lo[3], hi[0], hi[1], hi[2], hi[3]};
}
constexpr int GA_PK = 576, GA_PV = 1088;
constexpr int GA_V = 0, GA_PART = 0, GA_GLR = 69632, GA_TOT = 73728, GA_KD = 75776, GA_END = GA_KD + 64 * GA_PK;
__device__ __forceinline__ void gla_pass_a(unsigned char* lds, int task, const bf16_t* __restrict__ xn, const bf16_t* __restrict__ wglr  , const bf16_t* __restrict__ proj,
                                           const float* __restrict__ wg, const float* __restrict__ bg, float* __restrict__ UT, float* __restrict__ decay) {
    int tid = threadIdx.x; LAUNDER(tid); int wid = tid >> 6, lane = tid & 63, fr = lane & 15, fq = lane >> 4;
    const size_t t0 = (size_t)task * 64;
    { f32x4 acc[4];
#pragma unroll
      for (int m = 0; m < 4; ++m) acc[m] = (f32x4){0.f, 0.f, 0.f, 0.f};
#pragma unroll
      for (int ks = 0; ks < 4; ++ks) { const int k = 128 * wid + 32 * ks + 8 * fq; const bf16x8 bfr = *(const bf16x8*)(wglr + (size_t)fr * 1024 + k);
#pragma unroll
          for (int m = 0; m < 4; ++m) { const bf16x8 afr = *(const bf16x8*)(xn + (t0 + 16 * m + fr) * DM + k); acc[m] = __builtin_amdgcn_mfma_f32_16x16x32_bf16(afr, bfr, acc[m], 0, 0, 0); } }
      float* part = (float*)(lds + GA_PART) + wid * 1024;
#pragma unroll
      for (int m = 0; m < 4; ++m)
#pragma unroll
          for (int j = 0; j < 4; ++j) part[(16 * m + 4 * fq + j) * 16 + fr] = acc[m][j]; }
    __syncthreads();
    { float* glr = (float*)(lds + GA_GLR); const float* part = (const float*)(lds + GA_PART);
      for (int i = tid; i < 1024; i += 512) { float s = 0.f;
#pragma unroll
          for (int w = 0; w < 8; ++w) s += part[w * 1024 + i];
          glr[i] = s; } }
    __syncthreads();
    LAUNDER(tid);
    { const int cv = tid & 63, tk = tid >> 6;
#pragma unroll
      for (int i = 0; i < 8; ++i) { const int tok = tk + 8 * i; const u32x4 v = *(const u32x4*)(proj + (t0 + tok) * PROJ_LD + C_VG + cv * 8); *(u32x4*)(lds + GA_V + tok * GA_PV + cv * 16) = v; } }
    LAUNDER(tid);
    { const int j = tid & 255, half = tid >> 8; const float* glr = (const float*)(lds + GA_GLR); float* tot = (float*)(lds + GA_TOT);
      float w[16];
#pragma unroll
      for (int i = 0; i < 16; ++i) w[i] = wg[i * 256 + j];
      const float bj = bg[j]; float run = 0.f;
      bf16_t kk16[32];
#pragma unroll
      for (int s = 0; s < 32; ++s) kk16[s] = proj[(t0 + 32 * half + s) * PROJ_LD + C_KG + j];
#pragma unroll 2
      for (int s = 0; s < 32; ++s) { const float* gl = glr + (32 * half + s) * 16; float u = bj;
#pragma unroll
          for (int i = 0; i < 16; ++i) u += gl[i] * w[i];
          const float ls = fminf(u, 0.f) - __logf(1.0f + __expf(-fabsf(u)));
          run += ls * (1.0f / 16.0f); }
      tot[half * 256 + j] = run;
      __syncthreads();
      const float t0v = tot[j], t1v = tot[256 + j]; const float gend = t0v + t1v;
      if (half == 0) decay[(size_t)task * 256 + j] = __expf(gend);
      run = half ? t0v : 0.f;
#pragma unroll
      for (int s = 0; s < 32; ++s) { const int tok = 32 * half + s; const float* gl = glr + tok * 16; float u = bj;
#pragma unroll
          for (int i = 0; i < 16; ++i) u += gl[i] * w[i];
          const float ls = fminf(u, 0.f) - __logf(1.0f + __expf(-fabsf(u)));
          run += ls * (1.0f / 16.0f);
          const float kk = bf2f(kk16[s]);
          *(bf16_t*)(lds + GA_KD + tok * GA_PK + j * 2) = (bf16_t)f2bf(kk * __expf(gend - run)); } }
    __syncthreads();
    LAUNDER(tid); wid = __builtin_amdgcn_readfirstlane(tid >> 6); lane = tid & 63;
    { const int h = wid >> 1, nt = wid & 1, hi = lane >> 5, c32 = lane & 31; f32x16 acc[4];
#pragma unroll
      for (int m = 0; m < 4; ++m)
#pragma unroll
          for (int r = 0; r < 16; ++r) acc[m][r] = 0.f;
#pragma unroll
      for (int ks = 0; ks < 4; ++ks) { const bf16x8 bfr = tr_frag(lds + GA_KD, GA_PK, 16 * ks, h * 64 + 32 * nt, lane);
#pragma unroll
          for (int m = 0; m < 4; ++m) { const bf16x8 afr = tr_frag(lds + GA_V, GA_PV, 16 * ks, h * 128 + 32 * m, lane); acc[m] = __builtin_amdgcn_mfma_f32_32x32x16_bf16(afr, bfr, acc[m], 0, 0, 0); } }
      float* u = UT + ((size_t)task * 4 + h) * 8192;
#pragma unroll
      for (int m = 0; m < 4; ++m)
#pragma unroll
          for (int r = 0; r < 16; ++r) u[(32 * m + crow(r, hi)) * 64 + 32 * nt + c32] = acc[m][r]; }
    __syncthreads();
}
__device__ __forceinline__ void gla_pass_b(int e, const float* __restrict__ UT, const float* __restrict__ decay, bf16_t* __restrict__ ST) {
    const int dk = e & 63, dv = (e >> 6) & 127, h = (e >> 13) & 3, b = e >> 15; float s = 0.f;
    const size_t base = ((size_t)b * 128 * 4 + h) * 8192 + dv * 64 + dk; const size_t dbase = (size_t)b * 128 * 256 + h * 64 + dk;
    for (int c0 = 0; c0 < 128; c0 += 32) { float u[32], d[32];
#pragma unroll
        for (int i = 0; i < 32; ++i) { u[i] = UT[base + (size_t)(c0 + i) * 4 * 8192]; d[i] = decay[dbase + (size_t)(c0 + i) * 256]; }
#pragma unroll
        for (int i = 0; i < 32; ++i) { s = d[i] * s + u[i]; ST[base + (size_t)(c0 + i) * 4 * 8192] = (bf16_t)f2bf(s); } }
}
constexpr int GC_PITCH = 520;
__device__ __forceinline__ void gla_pass_c(unsigned char* wlds  , int wtask, const bf16_t* __restrict__ ST, const bf16_t* __restrict__ proj, const float* __restrict__ ghead, bf16_t* __restrict__ mix, int lane) {
    const int nh = wtask & 1, h = (wtask >> 1) & 3, bc = wtask >> 3; const int c32 = lane & 31, hi = lane >> 5;
    const size_t t0 = (size_t)bc * 64 + 32 * nh; const bf16_t* st = ST + ((size_t)bc * 4 + h) * 8192;
    f32x16 acc[4];
#pragma unroll
    for (int m = 0; m < 4; ++m)
#pragma unroll
        for (int r = 0; r < 16; ++r) acc[m][r] = 0.f;
#pragma unroll
    for (int ks = 0; ks < 4; ++ks) { const bf16x8 bfr = *(const bf16x8*)(proj + (t0 + c32) * PROJ_LD + C_QG + h * 64 + 16 * ks + 8 * hi);
#pragma unroll
        for (int m = 0; m < 4; ++m) { const bf16x8 afr = *(const bf16x8*)(st + (32 * m + c32) * 64 + 16 * ks + 8 * hi); acc[m] = __builtin_amdgcn_mfma_f32_32x32x16_bf16(afr, bfr, acc[m], 0, 0, 0); } }
    float ss = 0.f;
#pragma unroll
    for (int m = 0; m < 4; ++m)
#pragma unroll
        for (int r = 0; r < 16; ++r) ss += acc[m][r] * acc[m][r];
    ss += __shfl_xor(ss, 32);
    const float rstd = 1.0f / sqrtf(ss * (1.0f / 128.0f) + EPS);
#pragma unroll
    for (int m = 0; m < 4; ++m)
#pragma unroll
        for (int r = 0; r < 16; ++r) *(float*)(wlds + c32 * GC_PITCH + (32 * m + crow(r, hi)) * 4) = acc[m][r] * rstd;
#pragma unroll
    for (int i = 0; i < 8; ++i) { const int q = lane + 64 * i, tok = q >> 4, dv0 = (q & 15) * 8; const float* src = (const float*)(wlds + tok * GC_PITCH + dv0 * 4);
        const u32x4 rgw = *(const u32x4*)(proj + (t0 + tok) * PROJ_LD + C_RG + h * 128 + dv0); const f32x4 g0 = *(const f32x4*)(ghead + dv0), g1 = *(const f32x4*)(ghead + dv0 + 4);
        const float rg[8] = {bflo(rgw.x), bfhi(rgw.x), bflo(rgw.y), bfhi(rgw.y), bflo(rgw.z), bfhi(rgw.z), bflo(rgw.w), bfhi(rgw.w)}; const float gg[8] = {g0.x, g0.y, g0.z, g0.w, g1.x, g1.y, g1.z, g1.w}; float y[8];
#pragma unroll
        for (int k = 0; k < 8; ++k) y[k] = src[k] * gg[k] * (rg[k] / (1.0f + __expf(-rg[k])));
        u32x4 o; o.x = pk2(y[0], y[1]); o.y = pk2(y[2], y[3]); o.z = pk2(y[4], y[5]); o.w = pk2(y[6], y[7]);
        *(u32x4*)(mix + (t0 + tok) * 1024 + h * 128 + dv0) = o; }
}
__device__ __forceinline__ void sb_task(unsigned char* vl  , int wtask, const bf16_t* __restrict__ proj, bf16_t* __restrict__ mix, int lane) {
    const int qt = wtask & 255, h = (wtask >> 8) & 7, b = wtask >> 11; const int c = lane & 31, hi = lane >> 5;
    const int t0 = qt * 32; const size_t rowb = (size_t)b * SEQ;
    bf16x8 qf[4];
#pragma unroll
    for (int d0 = 0; d0 < 4; ++d0) qf[d0] = *(const bf16x8*)(proj + (rowb + t0 + c) * PROJ_LD + C_QS + h * 64 + 16 * d0 + 8 * hi);
    const int kap = 16 * ((c >> 2) & 1) + (c & 3) + 4 * (c >> 3);
    f32x16 o0, o1;
#pragma unroll
    for (int r = 0; r < 16; ++r) { o0[r] = 0.f; o1[r] = 0.f; }
    float Dc = 1.0f;
    const bf16_t* kbase = proj + rowb * PROJ_LD + C_KS + h * 64 + 8 * hi + (size_t)kap * PROJ_LD;
    const bf16_t* vbase = proj + rowb * PROJ_LD + C_VS + h * 64 + (lane & 7) * 8 + (size_t)(lane >> 3) * PROJ_LD;
    bf16x8 kf[4]; u32x4 vr[4];
#pragma unroll
    for (int d0 = 0; d0 < 4; ++d0) kf[d0] = *(const bf16x8*)(kbase + (size_t)t0 * PROJ_LD + 16 * d0);
#pragma unroll
    for (int i = 0; i < 4; ++i) vr[i] = *(const u32x4*)(vbase + (size_t)(t0 + 8 * i) * PROJ_LD);
    for (int j0 = t0; j0 >= 0; j0 -= 32) {
#pragma unroll
        for (int i = 0; i < 4; ++i) { const int key = (lane >> 3) + 8 * i, ch = lane & 7; *(u32x4*)(vl + (ch >> 2) * 2048 + key * 64 + (ch & 3) * 16) = vr[i]; }
        f32x16 z;
#pragma unroll
        for (int r = 0; r < 16; ++r) z[r] = 0.f;
#pragma unroll
        for (int d0 = 0; d0 < 4; ++d0) z = __builtin_amdgcn_mfma_f32_32x32x16_bf16(kf[d0], qf[d0], z, 0, 0, 0);
        asm volatile("" ::: "memory");
        { const int jn = (j0 >= 32) ? j0 - 32 : j0;
#pragma unroll
          for (int d0 = 0; d0 < 4; ++d0) kf[d0] = *(const bf16x8*)(kbase + (size_t)jn * PROJ_LD + 16 * d0);
#pragma unroll
          for (int i = 0; i < 4; ++i) vr[i] = *(const u32x4*)(vbase + (size_t)(jn + 8 * i) * PROJ_LD); }
        asm volatile("" ::: "memory");
        float e[16], Dl[16];
        const bool diag = (j0 == t0);
#pragma unroll
        for (int r = 0; r < 16; ++r) { float ev = __builtin_amdgcn_exp2f(fminf(z[r], 126.0f)); if (diag && (16 * hi + r >= c)) ev = 0.f; e[r] = ev; }
        float D = hi ? Dc : 1.0f;
#pragma unroll
        for (int r = 15; r >= 0; --r) { D = fmaf(D, e[r], D); Dl[r] = D; }
        const float other = __shfl_xor(D, 32);
        const float mult = hi ? 1.0f : other;
        Dc = D * other;
        unsigned pw[8];
#pragma unroll
        for (int r = 0; r < 16; r += 2) { const float a0 = e[r] * __builtin_amdgcn_rcpf(Dl[r] * mult), a1 = e[r + 1] * __builtin_amdgcn_rcpf(Dl[r + 1] * mult); pw[r >> 1] = pk2(a0, a1); }
#pragma unroll
        for (int ks = 0; ks < 2; ++ks) { const bf16x8 pa = __builtin_bit_cast(bf16x8, (u32x4){pw[4 * ks], pw[4 * ks + 1], pw[4 * ks + 2], pw[4 * ks + 3]});
            const unsigned char* vb = vl + (16 * hi + 8 * ks + ((lane & 15) >> 2)) * 64 + (16 * ((lane >> 4) & 1) + 4 * (lane & 3)) * 2;
            { const s16x4 lo = tr_read(vb), hh = tr_read(vb + 256); o0 = __builtin_amdgcn_mfma_f32_32x32x16_bf16(pa, (bf16x8){lo[0], lo[1], lo[2], lo[3], hh[0], hh[1], hh[2], hh[3]}, o0, 0, 0, 0); }
            { const s16x4 lo = tr_read(vb + 2048), hh = tr_read(vb + 2048 + 256); o1 = __builtin_amdgcn_mfma_f32_32x32x16_bf16(pa, (bf16x8){lo[0], lo[1], lo[2], lo[3], hh[0], hh[1], hh[2], hh[3]}, o1, 0, 0, 0); } }
        if (__all(!(Dc < 3.0e38f))) break;
    }
    bf16_t* ob = mix + (rowb + t0) * 1024 + 512 + h * 64 + c;
#pragma unroll
    for (int r = 0; r < 16; ++r) { const int q = crow(r, hi); ob[(size_t)q * 1024] = (bf16_t)f2bf(o0[r]); ob[(size_t)q * 1024 + 32] = (bf16_t)f2bf(o1[r]); }
}
__device__ __forceinline__ void softmax_task(int gw, int lane, const float* __restrict__ S, bf16_t* __restrict__ P) {
    const f32x4 v = *((const f32x4*)(S + (size_t)gw * 256) + lane);
    float m = fmaxf(fmaxf(v.x, v.y), fmaxf(v.z, v.w));
#pragma unroll
    for (int o = 1; o < 64; o <<= 1) m = fmaxf(m, __shfl_xor(m, o));
    const float e0 = exp2f(v.x - m), e1 = exp2f(v.y - m), e2 = exp2f(v.z - m), e3 = exp2f(v.w - m);
    const float inv = 1.0f / wave_sum(e0 + e1 + e2 + e3);
    u32x2 w; w.x = pk2(e0 * inv, e1 * inv); w.y = pk2(e2 * inv, e3 * inv); *((u32x2*)(P + (size_t)gw * 256) + lane) = w;
}
__device__ __forceinline__ void router_logit(int idx, const bf16_t* __restrict__ xn, const bf16_t* __restrict__ wr, const float* __restrict__ br, float* __restrict__ lg) {
    const int t = idx >> 5, e = idx & 31; const u32x4* a = (const u32x4*)(xn + (size_t)t * DM); const u32x4* w = (const u32x4*)(wr + (size_t)e * DM); float s = 0.f;
    for (int i = 0; i < DM / 8; ++i) { const u32x4 x = a[i], y = w[i];
        s += bflo(x.x) * bflo(y.x) + bfhi(x.x) * bfhi(y.x) + bflo(x.y) * bflo(y.y) + bfhi(x.y) * bfhi(y.y) + bflo(x.z) * bflo(y.z) + bfhi(x.z) * bfhi(y.z) + bflo(x.w) * bflo(y.w) + bfhi(x.w) * bfhi(y.w); }
    lg[idx] = s + br[e];
}
__device__ __forceinline__ void router_topk(int t, const float* __restrict__ lg, int* __restrict__ cnt, int* __restrict__ list, int* __restrict__ toke, int* __restrict__ tokr, float* __restrict__ tokw) {
    float v[NEXP];
#pragma unroll
    for (int e = 0; e < NEXP; ++e) v[e] = lg[(size_t)t * NEXP + e];
    float tv[4]; int ti[4];
#pragma unroll
    for (int k = 0; k < 4; ++k) { float best = -INFINITY; int bi = 0;
#pragma unroll
        for (int e = 0; e < NEXP; ++e) { if (v[e] > best) { best = v[e]; bi = e; } }
        tv[k] = best; ti[k] = bi;
#pragma unroll
        for (int e = 0; e < NEXP; ++e) if (e == bi) v[e] = -INFINITY; }
    const float e1 = __expf(tv[1] - tv[0]), e2 = __expf(tv[2] - tv[0]), e3 = __expf(tv[3] - tv[0]); const float inv = 1.0f / (1.0f + e1 + e2 + e3);
    const float g[4] = {inv, e1 * inv, e2 * inv, e3 * inv};
#pragma unroll
    for (int k = 0; k < 4; ++k) { const int r = atomicAdd(&cnt[ti[k]], 1); list[ti[k] * NTOK + r] = t; toke[t * 4 + k] = ti[k]; tokr[t * 4 + k] = r; tokw[t * 4 + k] = g[k]; }
}
__device__ __forceinline__ void memkv_task(int wtask, int lane, const bf16_t* __restrict__ memn, const bf16_t* __restrict__ wkv, bf16_t* __restrict__ kv) {
    const int tm = wtask >> 6, tn = wtask & 63; const int c = lane & 31, hi = lane >> 5;
    const bf16_t* ap = memn + (size_t)(tm * 32 + c) * DM + 8 * hi; const bf16_t* bp = wkv + (size_t)(tn * 32 + c) * DM + 8 * hi;
    f32x16 acc;
#pragma unroll
    for (int r = 0; r < 16; ++r) acc[r] = 0.f;
#pragma unroll 16
    for (int ks = 0; ks < 64; ++ks) { const bf16x8 a = *(const bf16x8*)(ap + 16 * ks), b = *(const bf16x8*)(bp + 16 * ks); acc = __builtin_amdgcn_mfma_f32_32x32x16_bf16(a, b, acc, 0, 0, 0); }
    bf16_t* o = kv + (size_t)(tm * 32) * 2048 + tn * 32 + c;
#pragma unroll
    for (int r = 0; r < 16; ++r) o[(size_t)crow(r, hi) * 2048] = (bf16_t)f2bf(acc[r]);
}
__device__ __forceinline__ void router_task(int wtask, int lane, const bf16_t* __restrict__ xn, const float* __restrict__ ss, const bf16_t* __restrict__ wr, const float* __restrict__ br,
                                            int (&oe)[4], float (&ow)[4]) {
    const int c = lane & 31, hi = lane >> 5; const int t = wtask * 32 + c;
    const bf16_t* ap = wr + (size_t)c * DM + 8 * hi; const bf16_t* bp = xn + (size_t)t * DM + 8 * hi;
    f32x16 acc;
#pragma unroll
    for (int r = 0; r < 16; ++r) acc[r] = 0.f;
#pragma unroll 16
    for (int ks = 0; ks < 64; ++ks) { const bf16x8 a = *(const bf16x8*)(ap + 16 * ks), b = *(const bf16x8*)(bp + 16 * ks); acc = __builtin_amdgcn_mfma_f32_32x32x16_bf16(a, b, acc, 0, 0, 0); }
    float v[16]; const float rstd = row_rstd(ss, t);
#pragma unroll
    for (int r = 0; r < 16; ++r) v[r] = acc[r] * rstd + br[crow(r, hi)];
    float tv[4]; int ti[4];
#pragma unroll
    for (int k = 0; k < 4; ++k) { float best = -INFINITY; int bi = 64;
#pragma unroll
        for (int r = 0; r < 16; ++r) { if (v[r] > best) { best = v[r]; bi = crow(r, hi); } }
        tv[k] = best; ti[k] = bi;
#pragma unroll
        for (int r = 0; r < 16; ++r) if (crow(r, hi) == bi) v[r] = -INFINITY; }
    float cv[8]; int ci[8];
#pragma unroll
    for (int k = 0; k < 4; ++k) { cv[k] = tv[k]; ci[k] = ti[k]; cv[4 + k] = __shfl_xor(tv[k], 32); ci[4 + k] = __shfl_xor(ti[k], 32); }
#pragma unroll
    for (int k = 0; k < 4; ++k) { float best = -INFINITY; int bi = 64;
#pragma unroll
        for (int q = 0; q < 8; ++q) { if (cv[q] > best || (cv[q] == best && ci[q] < bi)) { best = cv[q]; bi = ci[q]; } }
        tv[k] = best; ti[k] = bi;
#pragma unroll
        for (int q = 0; q < 8; ++q) if (ci[q] == bi) cv[q] = -INFINITY; }
    const float e1 = __expf(tv[1] - tv[0]), e2 = __expf(tv[2] - tv[0]), e3 = __expf(tv[3] - tv[0]); const float inv = 1.0f / (1.0f + e1 + e2 + e3);
    const float g[4] = {inv, e1 * inv, e2 * inv, e3 * inv};
#pragma unroll
    for (int k = 0; k < 4; ++k) { oe[k] = ti[k]; ow[k] = g[k]; }
}
__device__ __forceinline__ void combine_task(int t, int lane, const bf16_t* xin, float* xout, const unsigned char* __restrict__ ys, const int* tab, const int* __restrict__ toke, const int* __restrict__ tokr,
                                                 const float* __restrict__ tokw, const float* __restrict__ gfin) {
    const u32x2* xr = (const u32x2*)(xin + (size_t)t * DM) + lane; f32x4* xo = (f32x4*)(xout + (size_t)t * DM) + lane; f32x4 v[4];
#pragma unroll
    for (int j = 0; j < 4; ++j) { const u32x2 w = xr[64 * j]; v[j] = (f32x4){bflo(w.x), bfhi(w.x), bflo(w.y), bfhi(w.y)}; }
    for (int k = 0; k < 4; ++k) { const int e = toke[t * 4 + k], r = tokr[t * 4 + k]; const float w = tokw[t * 4 + k]; const int start = tab[32 + e];
        const unsigned* yr = (const unsigned*)(ys + (size_t)(start + r) * DM) + lane;
#pragma unroll
        for (int j = 0; j < 4; ++j) { const int y = (int)yr[64 * j]; const f32x2 lo = __builtin_amdgcn_cvt_pk_f32_fp8(y, false), hi = __builtin_amdgcn_cvt_pk_f32_fp8(y, true);
            v[j].x += w * lo.x; v[j].y += w * lo.y; v[j].z += w * hi.x; v[j].w += w * hi.y; } }
    float s = 0.f;
#pragma unroll
    for (int j = 0; j < 4; ++j) s += v[j].x * v[j].x + v[j].y * v[j].y + v[j].z * v[j].z + v[j].w * v[j].w;
    const float rstd = 1.0f / sqrtf(wave_sum(s) * (1.f / DM) + EPS);
#pragma unroll
    for (int j = 0; j < 4; ++j) { const f32x4 g = *((const f32x4*)gfin + lane + 64 * j); xo[64 * j] = v[j] * rstd * g; }
}

#define GAS __attribute__((address_space(1)))
#define RLX_AGENT __ATOMIC_RELAXED, __HIP_MEMORY_SCOPE_AGENT
#define XB_TMO      128
#define XB_XCNT(j)  (256  + 64 * (j))
#define XB_XSUB(j)  (1280 + 64 * (j))
#define XB_XGEN(j)  (2304 + 64 * (j))
#define XB_TOP      3328
#define XB_TOPGEN   3392
#define XCD_BAR_WORDS 3456
#define XB_SPIN_CAP (1u << 18)
__device__ __forceinline__ unsigned xb_ld(unsigned* p)              { return __hip_atomic_load(p, __ATOMIC_RELAXED, __HIP_MEMORY_SCOPE_AGENT); }
__device__ __forceinline__ unsigned xb_add(unsigned* p, unsigned v) { return __hip_atomic_fetch_add(p, v, __ATOMIC_RELAXED, __HIP_MEMORY_SCOPE_AGENT); }
__device__ __forceinline__ unsigned xb_xcc_id() { return (unsigned)__builtin_amdgcn_s_getreg((3 << 11) | 20) & 0xFu; }
#define XB_SPIN(cond, bar) do { unsigned _sp = 0; while (cond) { __builtin_amdgcn_s_sleep(1); \
    if ((++_sp & 255u) == 0u) { if (xb_ld(&(bar)[XB_TMO])) break; if (_sp > XB_SPIN_CAP) { atomicAdd(&(bar)[XB_TMO], 1u); break; } } } } while (0)
struct XcdBarrier { unsigned* bar; unsigned x; volatile LDSP unsigned* st; };
__device__ __forceinline__ XcdBarrier xcd_barrier_post(unsigned* bar, volatile LDSP unsigned* st) {
    XcdBarrier b; b.bar = bar; b.x = xb_xcc_id(); b.st = st;
    if (threadIdx.x == 0) (void)xb_add(&bar[XB_XCNT(b.x)], 1u);
    return b;
}
__device__ __forceinline__ void xcd_barrier_complete(unsigned* bar, unsigned x, unsigned& nloc, unsigned& nx) {
    const unsigned G = gridDim.x * gridDim.y * gridDim.z;
    unsigned sum, cnt, mine, sp = 0u;
    for (;;) {
        sum = 0u; cnt = 0u; mine = 0u;
#pragma unroll
        for (unsigned j = 0; j < 16; ++j) { const unsigned c = xb_ld(&bar[XB_XCNT(j)]); sum += c; cnt += (c > 0u) ? 1u : 0u; mine = (j == x) ? c : mine; }
        if (sum == G) break;
        __builtin_amdgcn_s_sleep(1);
        if ((++sp & 255u) == 0u) { if (xb_ld(&bar[XB_TMO])) break; if (sp > XB_SPIN_CAP) { atomicAdd(&bar[XB_TMO], 1u); break; } }
    }
    nloc = mine > 0u ? mine : 1u; nx = cnt > 0u ? cnt : 1u;
}
__device__ __forceinline__ void xcd_barrier(const XcdBarrier& b) {
    asm volatile("s_waitcnt vmcnt(0)" ::: "memory");
    __syncthreads();
    if (threadIdx.x == 0) {
        unsigned* bar = b.bar;
        __builtin_amdgcn_s_waitcnt(0);
        unsigned nloc = b.st[0], nx = b.st[1];
        if (nloc == 0u) { xcd_barrier_complete(bar, b.x, nloc, nx); b.st[0] = nloc; b.st[1] = nx; }
        const unsigned old = xb_add(&bar[XB_XSUB(b.x)], 1u);
        const unsigned gen = old / nloc;
        if (old + 1u == (gen + 1u) * nloc) {
            __builtin_amdgcn_fence(__ATOMIC_RELEASE, "agent");
            asm volatile("s_waitcnt vmcnt(0)" ::: "memory");
            const unsigned og = xb_add(&bar[XB_TOP], 1u);
            const unsigned tg = og / nx;
            if (og + 1u == (tg + 1u) * nx) xb_add(&bar[XB_TOPGEN], 1u);
            else XB_SPIN(xb_ld(&bar[XB_TOPGEN]) == tg, bar);
            __builtin_amdgcn_fence(__ATOMIC_ACQUIRE, "agent");
            xb_add(&bar[XB_XGEN(b.x)], 1u);
            asm volatile("s_waitcnt vmcnt(0)" ::: "memory");
        } else {
            XB_SPIN(xb_ld(&bar[XB_XGEN(b.x)]) == gen, bar);
            __builtin_amdgcn_fence(__ATOMIC_ACQUIRE, "agent");
            asm volatile("s_waitcnt vmcnt(0)" ::: "memory");
        }
    }
    __syncthreads();
}

constexpr int LDS_BYTES = 147456;
constexpr int MISC_OFF = LDS_BYTES - 512;
constexpr int CW_BAR = 4096;
constexpr size_t CTL_ZERO_BYTES = 65536;
constexpr int NPHASE = 12;
struct Args { const float* in[22]; float* out; unsigned char* ws; int ph_lo, ph_hi; };

__global__ void __launch_bounds__(512, 2) mega(Args a) {
    extern __shared__ __attribute__((aligned(16))) unsigned char lds[];
    unsigned char* ws = a.ws; float* out = a.out;
    const float* x = a.in[0]; const float* mem = a.in[1]; const float* g_mix = a.in[2]; const float* w_in = a.in[3];
    const float* w_gla_gate = a.in[4]; const float* b_gla_gate = a.in[5]; const float* g_gla_head = a.in[6]; const float* w_out = a.in[7];
    const float* g_mem_q = a.in[8]; const float* g_mem_kv = a.in[9]; const float* w_mq = a.in[10]; const float* w_mk = a.in[11];
    const float* w_mv = a.in[12]; const float* w_mo = a.in[13]; const float* g_ffn = a.in[14]; const float* w_router = a.in[15];
    const float* b_router = a.in[16]; const float* w_gu = a.in[17]; const float* b_gu = a.in[18]; const float* w_down = a.in[19];
    const float* b_down = a.in[20]; const float* g_final = a.in[21];
    bf16_t* Wt_in = (bf16_t*)(ws + WS_WIN); bf16_t* Wt_out = (bf16_t*)(ws + WS_WOUT); bf16_t* Wq = (bf16_t*)(ws + WS_WQ); bf16_t* Wt_kv = (bf16_t*)(ws + WS_WKV);
    bf16_t* Wt_mo = (bf16_t*)(ws + WS_WMO); bf16_t* Wt_r = (bf16_t*)(ws + WS_WR); bf16_t* Wt_gu = (bf16_t*)(ws + WS_WGU); bf16_t* Wt_dn = (bf16_t*)(ws + WS_WDN);
    bf16_t* xn = (bf16_t*)(ws + WS_XN); bf16_t* memn = (bf16_t*)(ws + WS_MEMN); bf16_t* kv = (bf16_t*)(ws + WS_KV); bf16_t* Bs = (bf16_t*)(ws + WS_BS); bf16_t* Bo = (bf16_t*)(ws + WS_BO);
    bf16_t* proj = (bf16_t*)(ws + WS_PROJ); bf16_t* mix = (bf16_t*)(ws + WS_MIX);
    float* Sc = (float*)(ws + WS_S); bf16_t* P = (bf16_t*)(ws + WS_P); float* lg = (float*)(ws + WS_LG); int* toke = (int*)(ws + WS_TOKE); int* tokr = (int*)(ws + WS_TOKR);
    float* tokw = (float*)(ws + WS_TOKW); int* list = (int*)(ws + WS_LIST); unsigned char* ys = ws + WS_YS;
    unsigned char* Wq_gu = ws + WS_WGU; unsigned char* Wq_dn = ws + WS_WDN; unsigned char* x2q = ws + WS_S; unsigned char* act8 = ws + WS_ACT;
    float* lrs = (float*)(ws + WS_LG);
    float* UT = (float*)(ws + WS_S); float* decay = (float*)(ws + WS_LA); bf16_t* ST = (bf16_t*)(ws + WS_ORAW);
    unsigned* ctl = (unsigned*)(ws + WS_CTL); int* cnt = (int*)ctl + CW_CNT; float* ss1 = (float*)(ws + WS_LA + 8 * MiB); float* ss2 = (float*)(ws + WS_LA + 9 * MiB);

    const int G = gridDim.x, vb = blockIdx.x;
    volatile LDSP unsigned* MISC = (volatile LDSP unsigned*)(unsigned)(uintptr_t)(lds + MISC_OFF);
    if (threadIdx.x < 128) MISC[threadIdx.x] = 0u;
    __syncthreads();
    XcdBarrier bar = xcd_barrier_post(ctl + CW_BAR, MISC + 8);
    const int lo = a.ph_lo, hi = a.ph_hi;
    float* dmy = (float*)(ws + WS_DUMMY); (void)dmy;
#ifndef REPEAT_MASK
#define REPEAT_MASK 0
#endif
#define IN(k) (lo <= (k) && (k) < hi)
#define REP(k) for (int rep_ = 0; rep_ < 1 + ((REPEAT_MASK >> (k)) & 1); ++rep_)
#define SEAM(k) do { if (IN(k) && IN((k) + 1)) xcd_barrier(bar); } while (0)
#define TIDS() int tid = threadIdx.x; LAUNDER(tid); const int lane = tid & 63; const int wid = __builtin_amdgcn_readfirstlane(tid >> 6); (void)lane; (void)wid

    if (IN(0)) REP(0) { TIDS(); const size_t gt = (size_t)vb * 512 + tid, gs = (size_t)G * 512;
        float* scr = (float*)(lds + wid * 8448);
        const int gw = vb * 8 + wid, ngw = G * 8;
        rms_body(gw, ngw, lane, x, xn, NTOK);
        rms_body(gw, ngw, lane, mem, memn, NB * MEML);
        conv_n_body(gt, gs, w_mq, Wq, g_mem_q, 1024, 1024, LOG2E / 16.0f);
        constexpr int I_IN = 16 * 97, I_SQ = 16 * 32, I_R = 16, I_GU = 32 * 16 * 64, I_DN = 32 * 16 * 32;
        constexpr int NITEMS = I_IN + 4 * I_SQ + I_R + I_GU + I_DN;
        for (int it = gw; it < NITEMS; it += ngw) { int r = it;
            if (r < I_IN) { conv_item<1>(scr, w_in, Wt_in, g_mix, 3088, 1024, 3088, r / 97, r % 97, lane); continue; } r -= I_IN;
            if (r < I_SQ) { conv_item<0>(scr, w_out, Wt_out, nullptr, 1024, 1024, 1024, r >> 5, r & 31, lane); continue; } r -= I_SQ;
            if (r < I_SQ) { conv_item<0>(scr, w_mk, Wt_kv, g_mem_kv, 1024, 1024, 1024, r >> 5, r & 31, lane); continue; } r -= I_SQ;
            if (r < I_SQ) { conv_item<0>(scr, w_mv, Wt_kv + (size_t)1024 * 1024, g_mem_kv, 1024, 1024, 1024, r >> 5, r & 31, lane); continue; } r -= I_SQ;
            if (r < I_SQ) { conv_item<0>(scr, w_mo, Wt_mo, nullptr, 1024, 1024, 1024, r >> 5, r & 31, lane); continue; } r -= I_SQ;
            if (r < I_R) { conv_item<0>(scr, w_router, Wt_r, g_ffn, 32, 1024, 32, r, 0, lane); continue; } r -= I_R;
            if (r < I_GU) { const int e = r >> 10, q = r & 1023; conv_item8<2>(scr, w_gu + (size_t)e * 1024 * 2048, Wq_gu + (size_t)e * 2048 * 1024, g_ffn, 2048, 1024, 2048, q >> 6, q & 63, lane, (float)(1 << WSCALE_LOG2)); continue; } r -= I_GU;
            { const int e = r >> 9, q = r & 511; conv_item8<0>(scr, w_down + (size_t)e * 1024 * 1024, Wq_dn + (size_t)e * 1024 * 1024, nullptr, 1024, 1024, 1024, q >> 5, q & 31, lane, (float)(1 << WSCALE_LOG2)); } }
        __syncthreads(); }
    SEAM(0);
    if (IN(1)) REP(1) { DenseSched S{(const char*)xn, (const char*)Wt_in, 2048u, 2048u, 1024, 64, 12, 1 << 30, 0, G, vb}; EpiBf16 E{proj, PROJ_LD, 0}; gemm_run<true>(lds, S, E); }
    SEAM(1);
    if (IN(2)) REP(2) {
        for (int t = vb; t < 256; t += G) gla_pass_a(lds, t, xn, Wt_in + (size_t)3072 * 1024, proj, w_gla_gate, b_gla_gate, UT, decay);
        { TIDS(); for (int t = vb * 8 + wid; t < 4096; t += G * 8) sb_task(lds + wid * 4096, t, proj, mix, lane); }
        { TIDS(); for (int t = vb + G * wid; t < 1024; t += G * 8) memkv_task(t, lane, memn, Wt_kv, kv); } }
    SEAM(2);
    if (IN(3)) REP(3) {
        { TIDS(); for (int e = vb * 512 + tid; e < 65536; e += G * 512) gla_pass_b(e, UT, decay, ST); }
        { SchedWqk S{(const char*)kv, (const char*)Wq, 4096u, 2048u, 256, G / 2, vb - G / 2, 0}; EpiBf16 E{Bs, 1024, 0}; gemm_run<false>(lds, S, E); }
        { SchedVo S{(const char*)Wt_mo, (const char*)kv, 2048u, 4096u, 256, G / 2, vb - G / 2 - 32, 0}; EpiBf16 E{Bo, 1024, 0}; gemm_run<false>(lds, S, E); } }
    SEAM(3);
    if (IN(4)) REP(4) { TIDS(); for (int t = vb * 8 + wid; t < 2048; t += G * 8) gla_pass_c(lds + wid * 32 * GC_PITCH, t, ST, proj, g_gla_head, mix, lane); }
    SEAM(4);
#if PROBE_BARRIERS
    for (int pb_ = 0; pb_ < 8; ++pb_) xcd_barrier(bar);
#endif
    if (IN(5)) REP(5) { DenseSched S{(const char*)mix, (const char*)Wt_out, 2048u, 2048u, 1024, 64, 4, 1 << 30, 0, G, vb}; EpiResidSS<false> E{x, rep_ ? (bf16_t*)dmy : xn, rep_ ? dmy + 16 * 1024 * 1024 : ss1, nullptr}; gemm_run<false>(lds, S, E); }
    SEAM(5);
    if (IN(6)) REP(6) { DenseSched S{(const char*)xn, (const char*)Bs, 2048u, 2048u, 1024, 64, 4, 32, (size_t)1024 * 2048, G, vb}; EpiSoftmax E{ss1, P}; gemm_run<false>(lds, S, E); }
    SEAM(6);
    if (IN(7)) REP(7) { DenseSched S{(const char*)P, (const char*)Bo, 2048u, 2048u, 1024, 64, 4, 32, (size_t)1024 * 2048, G, vb}; EpiResidSS<true> E{xn, rep_ ? (bf16_t*)dmy : xn, rep_ ? dmy + 16 * 1024 * 1024 : ss2, rep_ ? (unsigned char*)dmy + 40 * 1024 * 1024 : x2q}; gemm_run<false>(lds, S, E); }
    SEAM(7);
    if (IN(8)) REP(8) { TIDS(); int* cntp = rep_ ? (int*)ctl + 2048 : cnt; int* listp = rep_ ? (int*)dmy + 1024 : list; float* lrsp = rep_ ? dmy + 4096 * 1024 : lrs; int* tokep = rep_ ? (int*)dmy + 1024 * 1024 : toke; int* tokrp = rep_ ? (int*)dmy + 2048 * 1024 : tokr; float* tokwp = rep_ ? dmy + 3072 * 1024 : tokw;
        int* lcnt = (int*)lds; int* gbase = (int*)lds + 32;
        for (int tb = vb; tb < NTOK / 64; tb += G) {
            if (tid < 32) lcnt[tid] = 0;
            __syncthreads();
            int oe[4] = {0, 0, 0, 0}; float ow[4] = {0.f, 0.f, 0.f, 0.f}; int lr[4] = {0, 0, 0, 0};
            if (wid < 2) { router_task(tb * 2 + wid, lane, xn, ss2, Wt_r, b_router, oe, ow);
                if (lane < 32) {
#pragma unroll
                    for (int k = 0; k < 4; ++k) lr[k] = atomicAdd(&lcnt[oe[k]], 1); } }
            __syncthreads();
            if (tid < 32) gbase[tid] = atomicAdd(&cntp[tid * 32], lcnt[tid]);
            __syncthreads();
            if (wid < 2 && lane < 32) { const int t = (tb * 2 + wid) * 32 + lane;
                const float rstd_t = row_rstd(ss2, t);
#pragma unroll
                for (int k = 0; k < 4; ++k) { const int r = gbase[oe[k]] + lr[k]; listp[oe[k] * NTOK + r] = t; lrsp[oe[k] * NTOK + r] = rstd_t; tokep[t * 4 + k] = oe[k]; tokrp[t * 4 + k] = r; tokwp[t * 4 + k] = ow[k]; } }
            __syncthreads(); } }
    SEAM(8);
    if (IN(9)) REP(9) { int* tab = (int*)(lds + 131072); { TIDS(); moe_build_table(tab, cnt, tid); }
        MoeSched<true> S{(const char*)x2q, (const char*)Wq_gu, 1024u, 1024u, 512, 8, (size_t)2048 * 1024, tab, list, 1, G, vb, 0}; EpiGU E{b_gu, act8, lrs}; gemm_run_fp8<true>(lds, S, E); }
    SEAM(9);
    if (IN(10)) REP(10) { int* tab = (int*)(lds + 131072); { TIDS(); moe_build_table(tab, cnt, tid); }
        MoeSched<false> S{(const char*)act8, (const char*)Wq_dn, 1024u, 1024u, 512, 4, (size_t)1024 * 1024, tab, list, 0, G, vb, 0}; EpiDown E{b_down, ys}; gemm_run_fp8<true>(lds, S, E); }
    SEAM(10);
    if (IN(11)) REP(11) { TIDS(); int* tab = (int*)(lds + 131072); moe_build_table(tab, cnt, tid);
        for (int t = vb * 8 + wid; t < NTOK; t += G * 8) combine_task(t, lane, xn, rep_ ? dmy : out, ys, tab, toke, tokr, tokw, g_final); }
#undef IN
#undef SEAM
#undef TIDS
}

#ifndef MK_PER_PHASE
#define MK_PER_PHASE 0
#endif
extern "C" void kernel_launch(void* const* d_in, const int* in_sizes, int n_in, void* d_out, int out_size, void* d_ws, size_t ws_size, hipStream_t stream) {
    static int grid = 0;
    if (grid == 0) {
        if (n_in != 22 || in_sizes[0] != NTOK * DM || out_size != NTOK * DM || ws_size < WS_END) { fprintf(stderr, "kernel_launch: unexpected shapes (n_in %d, ws %zu)\n", n_in, ws_size); grid = -1; return; }
        int dev = 0, cus = 0, per_cu = 0;
        if (hipGetDevice(&dev) != hipSuccess || hipDeviceGetAttribute(&cus, hipDeviceAttributeMultiprocessorCount, dev) != hipSuccess) { grid = -1; return; }
        if (hipFuncSetAttribute((const void*)mega, hipFuncAttributeMaxDynamicSharedMemorySize, LDS_BYTES) != hipSuccess) { fprintf(stderr, "kernel_launch: hipFuncSetAttribute failed\n"); grid = -1; return; }
        if (hipOccupancyMaxActiveBlocksPerMultiprocessor(&per_cu, (const void*)mega, 512, LDS_BYTES) != hipSuccess || per_cu < 1) fprintf(stderr, "kernel_launch: occupancy query says %d blocks/CU\n", per_cu);
        (void)hipGetLastError();
        grid = cus;
    }
    if (grid < 0) return;
    (void)hipMemsetAsync((char*)d_ws + WS_CTL, 0, CTL_ZERO_BYTES, stream);
    Args a{};
    for (int i = 0; i < 22; ++i) a.in[i] = (const float*)d_in[i];
    a.out = (float*)d_out; a.ws = (unsigned char*)d_ws;
#if MK_PER_PHASE
    for (int p = 0; p < NPHASE; ++p) { a.ph_lo = p; a.ph_hi = p + 1; hipLaunchKernelGGL(mega, dim3(grid), dim3(512), LDS_BYTES, stream, a); }
#else
    a.ph_lo = 0; a.ph_hi = NPHASE; hipLaunchKernelGGL(mega, dim3(grid), dim3(512), LDS_BYTES, stream, a);
#endif
}
```

```cpp
#include <hip/hip_runtime.h>
#include <cstdio>
#include <cstdint>
#ifndef PROBE_BARRIERS
#define PROBE_BARRIERS 0
#endif

typedef unsigned short bf16_t;
typedef short bf16x8 __attribute__((ext_vector_type(8)));
typedef float f32x4 __attribute__((ext_vector_type(4)));
typedef unsigned u32x4 __attribute__((ext_vector_type(4)));
typedef unsigned u32x2 __attribute__((ext_vector_type(2)));
typedef float f32x2 __attribute__((ext_vector_type(2)));
#define LDSP __attribute__((address_space(3)))
#define LAUNDER(x) asm volatile("" : "+v"(x))

constexpr int NB = 2, SEQ = 8192, NTOK = NB * SEQ, DM = 1024, MEML = 256;
constexpr int NEXP = 32, TOPK = 4, NASSIGN = NTOK * TOPK;
constexpr int PROJ_LD = 3072;
constexpr int C_QG = 0, C_KG = 256, C_VG = 512, C_RG = 1024, C_QS = 1536, C_KS = 2048, C_VS = 2560, C_GLR = 3072;
constexpr float LOG2E = 1.4426950408889634f;
constexpr float EPS = 1e-5f;

__device__ __forceinline__ unsigned f2bf(float f) { unsigned u = __float_as_uint(f); return (u + 0x7fffu + ((u >> 16) & 1u)) >> 16; }
__device__ __forceinline__ unsigned pk2(float lo, float hi) { return f2bf(lo) | (f2bf(hi) << 16); }
__device__ __forceinline__ float bf2f(bf16_t h) { return __uint_as_float(((unsigned)h) << 16); }
__device__ __forceinline__ float bflo(unsigned w) { return __uint_as_float(w << 16); }
__device__ __forceinline__ float bfhi(unsigned w) { return __uint_as_float(w & 0xffff0000u); }

constexpr size_t MiB = 1u << 20;
constexpr size_t WS_CTL = 0;
constexpr size_t WS_WIN = 1 * MiB;
constexpr size_t WS_WOUT = 8 * MiB;
constexpr size_t WS_WQ = 10 * MiB;
constexpr size_t WS_WKV = 12 * MiB;
constexpr size_t WS_WMO = 16 * MiB;
constexpr size_t WS_WR = 18 * MiB;
constexpr size_t WS_WGU = 20 * MiB;
constexpr size_t WS_WDN = 148 * MiB;
constexpr size_t WS_XN = 212 * MiB;
constexpr size_t WS_MEMN = 244 * MiB;
constexpr size_t WS_KV = 245 * MiB;
constexpr size_t WS_BS = 247 * MiB;
constexpr size_t WS_BO = 251 * MiB;
constexpr size_t WS_PROJ = 256 * MiB;
constexpr size_t WS_LA = 360 * MiB;
constexpr size_t WS_ORAW = 376 * MiB;
constexpr size_t WS_MIX = 408 * MiB;
constexpr size_t WS_S = 440 * MiB;
constexpr size_t WS_P = 504 * MiB;
constexpr size_t WS_LG = 536 * MiB;
constexpr size_t WS_TOKE = 538 * MiB;
constexpr size_t WS_TOKR = 539 * MiB;
constexpr size_t WS_TOKW = 540 * MiB;
constexpr size_t WS_LIST = 541 * MiB;
constexpr size_t WS_ACT = 544 * MiB;
constexpr size_t WS_YS = 674 * MiB;
constexpr size_t WS_DUMMY = 804 * MiB;
constexpr size_t WS_END = 872 * MiB;
constexpr int CW_CNT = 1024;

template <int MAP> __device__ __forceinline__ int srccol(int n, float& sc) {
    sc = 1.f;
    if (MAP == 0) return n;
    if (MAP == 1) {
        if (n < 256) { sc = 0.125f; return n; }
        if (n < 1024) return n;
        if (n < 3072) { if (n >= C_QS && n < C_KS) sc = 0.125f * LOG2E; return n + 16; }
        if (n < 3088) return 1024 + (n - 3072);
        return -1;
    }
    { const int ct = n >> 8, w = n & 255; return (w < 128) ? (128 * ct + w) : (1024 + 128 * ct + (w - 128)); }
}
template <int MAP>
__device__ __forceinline__ void conv_item(float* scr, const float* __restrict__ src, bf16_t* __restrict__ dst, const float* __restrict__ gain, int ldsrc, int K, int nrows, int kb, int nb, int lane) {
    const int k0 = kb * 64, n0 = nb * 32; float sc; const int c0 = srccol<MAP>(n0, sc);
    const int half = lane >> 5, l31 = lane & 31;
    const float* s0 = src + (size_t)(k0 + half) * ldsrc + c0 + l31;
    float v[32];
#pragma unroll
    for (int i = 0; i < 32; ++i) v[i] = s0[(size_t)(2 * i) * ldsrc];
#pragma unroll
    for (int i = 0; i < 32; ++i) { const int kk = 2 * i + half; const float g = (gain ? gain[k0 + kk] : 1.f) * sc; scr[kk * 33 + l31] = v[i] * g; }
    asm volatile("s_waitcnt lgkmcnt(0)" ::: "memory");
    const int c = lane & 7;
#pragma unroll
    for (int j = 0; j < 4; ++j) { const int n = (lane >> 3) + 8 * j; const float* s = scr + (8 * c) * 33 + n;
        u32x4 o; o.x = pk2(s[0 * 33], s[1 * 33]); o.y = pk2(s[2 * 33], s[3 * 33]); o.z = pk2(s[4 * 33], s[5 * 33]); o.w = pk2(s[6 * 33], s[7 * 33]);
        if (n0 + n < nrows) *(u32x4*)(dst + (size_t)(n0 + n) * K + k0 + 8 * c) = o; }
    asm volatile("s_waitcnt lgkmcnt(0)" ::: "memory");
}
__device__ __forceinline__ unsigned pk4_fp8(float a, float b, float c, float d) { int w = __builtin_amdgcn_cvt_pk_fp8_f32(a, b, 0, false); w = __builtin_amdgcn_cvt_pk_fp8_f32(c, d, w, true); return (unsigned)w; }
template <int MAP>
__device__ __forceinline__ void conv_item8(float* scr, const float* __restrict__ src, unsigned char* __restrict__ dst, const float* __restrict__ gain, int ldsrc, int K, int nrows, int kb, int nb, int lane, float mul) {
    const int k0 = kb * 64, n0 = nb * 32; float sc; const int c0 = srccol<MAP>(n0, sc); sc *= mul;
    const int half = lane >> 5, l31 = lane & 31;
    const float* s0 = src + (size_t)(k0 + half) * ldsrc + c0 + l31;
    float v[32];
#pragma unroll
    for (int i = 0; i < 32; ++i) v[i] = s0[(size_t)(2 * i) * ldsrc];
#pragma unroll
    for (int i = 0; i < 32; ++i) { const int kk = 2 * i + half; const float g = (gain ? gain[k0 + kk] : 1.f) * sc; scr[kk * 33 + l31] = v[i] * g; }
    asm volatile("s_waitcnt lgkmcnt(0)" ::: "memory");
    const int c = lane & 3;
#pragma unroll
    for (int j = 0; j < 2; ++j) { const int n = (lane >> 2) + 16 * j; const float* s = scr + (16 * c) * 33 + n;
        u32x4 o; o.x = pk4_fp8(s[0 * 33], s[1 * 33], s[2 * 33], s[3 * 33]); o.y = pk4_fp8(s[4 * 33], s[5 * 33], s[6 * 33], s[7 * 33]);
        o.z = pk4_fp8(s[8 * 33], s[9 * 33], s[10 * 33], s[11 * 33]); o.w = pk4_fp8(s[12 * 33], s[13 * 33], s[14 * 33], s[15 * 33]);
        if (n0 + n < nrows) *(u32x4*)(dst + (size_t)(n0 + n) * K + k0 + 16 * c) = o; }
    asm volatile("s_waitcnt lgkmcnt(0)" ::: "memory");
}
__device__ __forceinline__ void conv_n_body(size_t gtid, size_t gsz, const float* __restrict__ src, bf16_t* __restrict__ dst, const float* __restrict__ gain, int K, int nrows, float sc) {
    const int kc8 = K / 8; const size_t total = (size_t)nrows * kc8;
    for (size_t idx = gtid; idx < total; idx += gsz) {
        const int kc = (int)(idx % kc8), n = (int)(idx / kc8);
        const float g = gain[n] * sc; const f32x4 a = *(const f32x4*)(src + (size_t)n * K + kc * 8), b = *(const f32x4*)(src + (size_t)n * K + kc * 8 + 4);
        u32x4 o; o.x = pk2(a.x * g, a.y * g); o.y = pk2(a.z * g, a.w * g); o.z = pk2(b.x * g, b.y * g); o.w = pk2(b.z * g, b.w * g);
        *(u32x4*)(dst + (size_t)n * K + kc * 8) = o;
    }
}

__device__ __forceinline__ float wave_sum(float v) {
#pragma unroll
    for (int o = 1; o < 64; o <<= 1) v += __shfl_xor(v, o);
    return v;
}
__device__ __forceinline__ void rms_body(int gw, int ngw, int lane, const float* __restrict__ x, bf16_t* __restrict__ out, int nrows) {
    for (int row = gw; row < nrows; row += ngw) {
        const f32x4* xr = (const f32x4*)(x + (size_t)row * DM) + lane; f32x4 v[4]; float s = 0.f;
#pragma unroll
        for (int j = 0; j < 4; ++j) { v[j] = xr[64 * j]; s += v[j].x * v[j].x + v[j].y * v[j].y + v[j].z * v[j].z + v[j].w * v[j].w; }
        const float rstd = 1.0f / sqrtf(wave_sum(s) * (1.f / DM) + EPS);
        u32x2* o = (u32x2*)(out + (size_t)row * DM) + lane;
#pragma unroll
        for (int j = 0; j < 4; ++j) { u32x2 w; w.x = pk2(v[j].x * rstd, v[j].y * rstd); w.y = pk2(v[j].z * rstd, v[j].w * rstd); o[64 * j] = w; }
    }
}

struct GUnit { unsigned ao, bo; int row0, col0, e, valid, aux; };

__host__ __device__ __forceinline__ int lds_byte(int r, int c) { const int st = (r >> 4) * 2 + (c >> 5), rr = r & 15, cc = c & 31, ob = rr * 64 + cc * 2; return st * 1024 + (ob ^ (((ob >> 9) & 1) << 5)); }
__host__ __device__ __forceinline__ void stage_rc(int b, int& R, int& C) { const int st = b / 1024, sb = b % 1024, swz = sb ^ (((sb >> 9) & 1) << 5); R = (st >> 1) * 16 + swz / 64; C = (st & 1) * 32 + (swz % 64) / 2; }
__host__ __device__ __forceinline__ int perm32(int rho) { const int n = rho >> 4, i = rho & 15; return 8 * (i >> 2) + 4 * n + (i & 3); }
constexpr int HTB = 128 * 64 * 2;
typedef int v8i __attribute__((ext_vector_type(8)));
typedef int v4i __attribute__((ext_vector_type(4)));
struct Frag2 { bf16x8 h[2]; };
template <bool F> struct FragT { typedef Frag2 T; };
template <> struct FragT<true> { typedef v8i T; };
template <class Sched, class Epi, bool ALIGN_EPI, bool FP8 = false, int SCALE_B = 0x7f>
__device__ __forceinline__ void gemm_phase(unsigned char* lds_flat, const Sched& S, const Epi& E) {
    LDSP unsigned char* lds = (LDSP unsigned char*)(unsigned)(uintptr_t)lds_flat;
    int tid = threadIdx.x; LAUNDER(tid);
    const int wid = __builtin_amdgcn_readfirstlane(tid >> 6), lane = tid & 63, wr = wid >> 2, wc = wid & 3, fr = lane & 15, fq = lane >> 4;
    const int nt = S.K / 64;
    int Rr[2], Cc[2];
#pragma unroll
    for (int i = 0; i < 2; ++i) stage_rc(tid * 16 + i * 8192, Rr[i], Cc[i]);
    unsigned voffB[2][2];
#pragma unroll
    for (int h = 0; h < 2; ++h)
#pragma unroll
        for (int i = 0; i < 2; ++i) voffB[h][i] = (unsigned)(128 * h + (Rr[i] & ~31) + perm32(Rr[i] & 31)) * S.ldb + (unsigned)Cc[i] * 2u;
    const unsigned ldsw = (unsigned)wid * 1024u;
    const int aoff = lds_byte(wr * 64 + fr, FP8 ? fq * 16 : fq * 8), boff = lds_byte(wc * 32 + fr, FP8 ? fq * 16 : fq * 8);
    constexpr int KSUB = FP8 ? 16 : 1024;
#define PG8_SA(b, h) (((b) * 2 + (h)) * HTB)
#define PG8_SB(b, h) ((4 + (b) * 2 + (h)) * HTB)
#define PG8_STAGE(bufoff, rsrc, voff, soff) do { _Pragma("unroll") for (int _i = 0; _i < 2; ++_i) \
        __builtin_amdgcn_raw_ptr_buffer_load_lds(rsrc, (LDSP unsigned*)(lds + (bufoff) + ldsw + _i * 8192), 16, (int)(voff)[_i], (int)(soff), 0, 0); } while (0)
#define PG8_LDF(dst, addr) do { const bf16x8 lo_ = *(const LDSP bf16x8*)(addr); const bf16x8 hi_ = *(const LDSP bf16x8*)((addr) + KSUB); \
        if constexpr (FP8) dst = __builtin_shufflevector(__builtin_bit_cast(v4i, lo_), __builtin_bit_cast(v4i, hi_), 0, 1, 2, 3, 4, 5, 6, 7); else { dst.h[0] = lo_; dst.h[1] = hi_; } } while (0)
#define PG8_LDA(dst, b, h) do { _Pragma("unroll") for (int m = 0; m < 4; ++m) PG8_LDF(dst[m], lds + PG8_SA(b, h) + aoff + m * 2048); } while (0)
#define PG8_LDB(dst, b, h) do { _Pragma("unroll") for (int n = 0; n < 2; ++n) PG8_LDF(dst[n], lds + PG8_SB(b, h) + boff + n * 2048); } while (0)
#define PG8_MMA(ai, bj, At, Bt) do { __builtin_amdgcn_s_setprio(1); _Pragma("unroll") for (int m = 0; m < 4; ++m) _Pragma("unroll") for (int n = 0; n < 2; ++n) { \
        if constexpr (FP8) asm volatile("v_mfma_scale_f32_16x16x128_f8f6f4 %0, %1, %2, %0, %3, %4 op_sel_hi:[0,0,0]" : "+v"(acc[ai][bj][m][n]) : "v"(Bt[n]), "v"(At[m]), "v"(sclB), "v"(sclA)); \
        else { _Pragma("unroll") for (int k = 0; k < 2; ++k) acc[ai][bj][m][n] = __builtin_amdgcn_mfma_f32_16x16x32_bf16(Bt[n].h[k], At[m].h[k], acc[ai][bj][m][n], 0, 0, 0); } } \
        __builtin_amdgcn_s_setprio(0); } while (0)
#define PG8_WAIT_V(n) asm volatile("s_waitcnt vmcnt(" #n ")" ::: "memory")
#define PG8_WAIT_L(n) asm volatile("s_waitcnt lgkmcnt(" #n ")" ::: "memory")
#define PG8_BAR __builtin_amdgcn_s_barrier()
#define PG8_SCHED __builtin_amdgcn_sched_barrier(0)
    GUnit cur, nxt; int ui = 0;
    if (!S.next(0, cur)) return;
    const __amdgpu_buffer_rsrc_t rA = __builtin_amdgcn_make_buffer_rsrc((void*)S.A, 0, 0x7fffffff, 0x00020000);
    const __amdgpu_buffer_rsrc_t rB = __builtin_amdgcn_make_buffer_rsrc((void*)S.Bt, 0, 0x7fffffff, 0x00020000);
    unsigned oc[2][2], on[2][2];
#pragma unroll
    for (int h = 0; h < 2; ++h)
#pragma unroll
        for (int i = 0; i < 2; ++i) oc[h][i] = S.a_off(cur, 128 * h + Rr[i]) + (unsigned)Cc[i] * 2u;
    f32x4 acc[2][2][4][2];
#pragma unroll
    for (int a = 0; a < 2; ++a)
#pragma unroll
        for (int b = 0; b < 2; ++b)
#pragma unroll
            for (int m = 0; m < 4; ++m)
#pragma unroll
                for (int n = 0; n < 2; ++n) acc[a][b][m][n] = (f32x4){0.f, 0.f, 0.f, 0.f};
    typedef typename FragT<FP8>::T frag_t;
    frag_t At[4], B0[2], B1[2];
    const unsigned kstep = 128;
    const int sclB = SCALE_B * 0x01010101, sclA = 0x7f7f7f7f; (void)sclA; (void)sclB;
    PG8_STAGE(PG8_SB(0, 0), rB, voffB[0], cur.bo); PG8_STAGE(PG8_SB(0, 1), rB, voffB[1], cur.bo); PG8_STAGE(PG8_SA(0, 0), rA, oc[0], cur.ao); PG8_STAGE(PG8_SA(0, 1), rA, oc[1], cur.ao);
    if (wr == 1) PG8_BAR;
    PG8_WAIT_V(2); PG8_BAR;
    PG8_STAGE(PG8_SB(1, 0), rB, voffB[0], cur.bo + kstep); PG8_STAGE(PG8_SA(1, 0), rA, oc[0], cur.ao + kstep); PG8_STAGE(PG8_SB(1, 1), rB, voffB[1], cur.bo + kstep);
    PG8_WAIT_V(6); PG8_BAR;
    for (;;) {
        const bool has_next = S.next(ui + 1, nxt);
        if (!has_next) nxt = cur;
        const unsigned nA = nxt.ao, nB = nxt.bo;
        { int t2 = threadIdx.x; LAUNDER(t2);
#pragma unroll
          for (int i = 0; i < 2; ++i) { int R_, C_; stage_rc(t2 * 16 + i * 8192, R_, C_);
#pragma unroll
              for (int h = 0; h < 2; ++h) on[h][i] = S.a_off(nxt, 128 * h + R_) + (unsigned)C_ * 2u; } }
        for (int t = 0; t < nt; t += 2) {
            const bool last = (t == nt - 2);
            const unsigned k1 = cur.ao + (unsigned)(t + 1) * kstep;
            const unsigned a2 = last ? nA : cur.ao + (unsigned)(t + 2) * kstep, b2 = last ? nB : cur.bo + (unsigned)(t + 2) * kstep, a3 = a2 + kstep, b3 = b2 + kstep;
            unsigned o2[2][2];
#pragma unroll
            for (int h = 0; h < 2; ++h)
#pragma unroll
                for (int i = 0; i < 2; ++i) o2[h][i] = last ? on[h][i] : oc[h][i];
            PG8_LDB(B0, 0, 0); PG8_LDB(B1, 0, 1); PG8_SCHED; PG8_LDA(At, 0, 0); PG8_STAGE(PG8_SA(1, 1), rA, oc[1], k1);
            PG8_WAIT_V(8); PG8_WAIT_L(0); PG8_BAR; PG8_MMA(0, 0, At, B0); PG8_MMA(0, 1, At, B1); PG8_BAR; PG8_SCHED;
            PG8_LDA(At, 0, 1); PG8_STAGE(PG8_SB(0, 0), rB, voffB[0], b2); PG8_STAGE(PG8_SB(0, 1), rB, voffB[1], b2); PG8_STAGE(PG8_SA(0, 0), rA, o2[0], a2);
            PG8_WAIT_V(8); PG8_WAIT_L(0); PG8_BAR; PG8_MMA(1, 0, At, B0); PG8_MMA(1, 1, At, B1); PG8_BAR; PG8_SCHED;
            PG8_LDB(B0, 1, 0); PG8_LDB(B1, 1, 1); PG8_SCHED; PG8_LDA(At, 1, 0); PG8_STAGE(PG8_SA(0, 1), rA, o2[1], a2);
            PG8_WAIT_V(8); PG8_WAIT_L(0); PG8_BAR; PG8_MMA(0, 0, At, B0); PG8_MMA(0, 1, At, B1); PG8_BAR; PG8_SCHED;
            PG8_LDA(At, 1, 1); PG8_STAGE(PG8_SB(1, 0), rB, voffB[0], b3); PG8_STAGE(PG8_SB(1, 1), rB, voffB[1], b3); PG8_STAGE(PG8_SA(1, 0), rA, o2[0], a3);
            PG8_WAIT_V(8); PG8_WAIT_L(0); PG8_BAR; PG8_MMA(1, 0, At, B0); PG8_MMA(1, 1, At, B1); PG8_BAR; PG8_SCHED;
        }
        if constexpr (FP8) asm volatile("s_nop 15\n\ts_nop 15" ::: "memory");
        if constexpr (ALIGN_EPI) { if (wr == 0) PG8_BAR; }
        if constexpr (!Epi::AFTER_DRAIN) E(acc, cur, wr, wc, fr, fq);
        if (!has_next) break;
#pragma unroll
        for (int a = 0; a < 2; ++a)
#pragma unroll
            for (int b = 0; b < 2; ++b)
#pragma unroll
                for (int m = 0; m < 4; ++m)
#pragma unroll
                    for (int n = 0; n < 2; ++n) acc[a][b][m][n] = (f32x4){0.f, 0.f, 0.f, 0.f};
        cur = nxt; ++ui;
#pragma unroll
        for (int h = 0; h < 2; ++h)
#pragma unroll
            for (int i = 0; i < 2; ++i) oc[h][i] = on[h][i];
        if constexpr (ALIGN_EPI) { if (wr == 1) PG8_BAR; }
    }
    PG8_WAIT_V(0);
    if constexpr (!ALIGN_EPI) { if (wr == 0) PG8_BAR; }
    PG8_BAR;
    if constexpr (Epi::AFTER_DRAIN) E.fused(acc, cur, wr, wc, fr, fq, lds_flat, wid, lane);
#undef PG8_SA
#undef PG8_SB
#undef PG8_STAGE
#undef PG8_LDA
#undef PG8_LDF
#undef PG8_LDB
#undef PG8_MMA
#undef PG8_WAIT_V
#undef PG8_WAIT_L
#undef PG8_BAR
#undef PG8_SCHED
}
template <bool ALIGN, class Sched, class Epi> __device__ __forceinline__ void gemm_run(unsigned char* lds, const Sched& S, const Epi& E) {
    gemm_phase<Sched, Epi, ALIGN>(lds, S, E);
}
constexpr int WSCALE_LOG2 = 6;
template <bool ALIGN, class Sched, class Epi> __device__ __forceinline__ void gemm_run_fp8(unsigned char* lds, const Sched& S, const Epi& E) {
    gemm_phase<Sched, Epi, ALIGN, true, 127 - WSCALE_LOG2>(lds, S, E);
}

struct DenseSched {
    const char* A; const char* Bt; unsigned lda, ldb; int K; int nM, nN; int pm_per_b; size_t zB; int G, c;
    __device__ __forceinline__ bool next(int i, GUnit& u) const {
        int pm, pn;
        if (G == 256 && (nN & 3) == 0 && nM * nN >= 256) {
            const int j = c & 7, q = c >> 3, s = i * 8 + j, ncg = nN >> 2; pm = (s / ncg) * 8 + (q >> 2); pn = (s % ncg) * 4 + (q & 3); if (c < 0 || pm >= nM) return false; }
        else { const long L = (long)i * G + c; if (c < 0 || L >= (long)nM * nN) return false; pm = (int)(L / nN); pn = (int)(L % nN); }
        u.ao = (unsigned)pm * 256u * lda; u.bo = (unsigned)((size_t)(pm / pm_per_b) * zB) + (unsigned)pn * 256u * ldb; u.row0 = pm * 256; u.col0 = pn * 256; u.e = 0; u.valid = 256; u.aux = 0; return true;
    }
    __device__ __forceinline__ unsigned a_off(const GUnit&, int r) const { return (unsigned)r * lda; }
};
struct SchedWqk {
    const char* A; const char* Bt; unsigned lda, ldb; int K; int G, c, pad;
    __device__ __forceinline__ bool next(int i, GUnit& u) const {
        const int L = i * G + c; if (c < 0 || L >= 32) return false; const int z = L >> 2, pn = L & 3, b = z >> 2, h = z & 3;
        u.ao = (unsigned)b * 256u * 4096u + h * 512u; u.bo = (unsigned)pn * 256u * 2048u + h * 512u; u.row0 = z * 256; u.col0 = pn * 256; u.e = 0; u.valid = 256; u.aux = 0; return true;
    }
    __device__ __forceinline__ unsigned a_off(const GUnit&, int r) const { return (unsigned)r * lda; }
};
struct SchedVo {
    const char* A; const char* Bt; unsigned lda, ldb; int K; int G, c, pad;
    __device__ __forceinline__ bool next(int i, GUnit& u) const {
        const int L = i * G + c; if (c < 0 || L >= 32) return false; const int z = L >> 2, pm = L & 3, b = z >> 2, h = z & 3;
        u.ao = (unsigned)pm * 256u * 2048u + h * 512u; u.bo = (unsigned)b * 256u * 4096u + 2048u + h * 512u; u.row0 = b * 1024 + pm * 256; u.col0 = h * 256; u.e = 0; u.valid = 256; u.aux = 0; return true;
    }
    __device__ __forceinline__ unsigned a_off(const GUnit&, int r) const { return (unsigned)r * lda; }
};
template <bool GATHER> struct MoeSched {
    const char* A; const char* Bt; unsigned lda, ldb; int K; int nN; size_t zB;
    const int* tab; const int* list; int gather; int G, c, pad;
    __device__ __forceinline__ bool next(int i, GUnit& u) const {
        int T, pn;
        if (G == 256) { const int j = c & 7, q = c >> 3, s = i * 8 + j;
            if (nN == 8) { T = 4 * s + (q >> 3); pn = q & 7; } else { T = 8 * s + (q >> 2); pn = q & 3; } }
        else { const int L = i * G + c; T = L / nN; pn = L % nN; }
        if (T >= tab[64]) return false;
        const int w = tab[128 + T]; const int e = w & 255, rt = w >> 8; const int ce = tab[e], start = tab[32 + e];
        u.e = e; u.valid = min(256, ce - rt * 256); u.row0 = start + rt * 256; u.col0 = pn * 256; u.aux = rt * 256;
        u.ao = GATHER ? 0u : (unsigned)u.row0 * lda; u.bo = (unsigned)((size_t)e * zB) + (unsigned)pn * 256u * ldb; return true;
    }
    __device__ __forceinline__ unsigned a_off(const GUnit& u, int r) const {
        if (!GATHER) return (unsigned)r * lda;
        const int rr = r < u.valid ? r : 0; const int tok = list[u.e * NTOK + u.aux + rr]; return (unsigned)tok * lda;
    }
};
__device__ __forceinline__ void moe_build_table(int* tab, const int* __restrict__ cnt, int tid) {
    if (tid < 32) tab[tid] = cnt[tid * 32];
    __syncthreads();
    if (tid < 32) { int s = 0; for (int e = 0; e < tid; ++e) s += tab[e]; tab[32 + tid] = s; }
    if (tid < 320) { int tiles = 0, found = -1;
        for (int e = 0; e < NEXP; ++e) { const int te = (tab[e] + 255) >> 8; if (found < 0 && tid < tiles + te) found = e | ((tid - tiles) << 8); tiles += te; }
        if (found >= 0) tab[128 + tid] = found; if (tid == 0) tab[64] = tiles; }
    __syncthreads();
}

__device__ __forceinline__ u32x4 pack8(const f32x4& a, const f32x4& b) { u32x4 w; w.x = pk2(a[0], a[1]); w.y = pk2(a[2], a[3]); w.z = pk2(b[0], b[1]); w.w = pk2(b[2], b[3]); return w; }
struct EpiBf16 { static constexpr bool AFTER_DRAIN = false; bf16_t* O; int ldc, pad;
    __device__ __forceinline__ void operator()(const f32x4 (&acc)[2][2][4][2], const GUnit& u, int wr, int wc, int fr, int fq) const {
        LAUNDER(fr); LAUNDER(fq);
#pragma unroll
        for (int ai = 0; ai < 2; ++ai)
#pragma unroll
            for (int m = 0; m < 4; ++m) { const int r = 128 * ai + 64 * wr + 16 * m + fr;
#pragma unroll
                for (int bj = 0; bj < 2; ++bj) *(u32x4*)(O + (size_t)(u.row0 + r) * ldc + u.col0 + 128 * bj + 32 * wc + 8 * fq) = pack8(acc[ai][bj][m][0], acc[ai][bj][m][1]); } } };
__device__ __forceinline__ float row_rstd(const float* __restrict__ ssp, int row) { const f32x4* p = (const f32x4*)(ssp + (size_t)row * 16); const f32x4 a = p[0], b = p[1], c = p[2], d = p[3];
    const float s = (((a[0] + a[1]) + (a[2] + a[3])) + ((b[0] + b[1]) + (b[2] + b[3]))) + (((c[0] + c[1]) + (c[2] + c[3])) + ((d[0] + d[1]) + (d[2] + d[3]))); return 1.0f / sqrtf(s * (1.0f / 1024.0f) + EPS); }
template <bool BASE_BF16> struct EpiResidSS { static constexpr bool AFTER_DRAIN = false; const void* base; bf16_t* xb; float* ss; unsigned char* xq;
    __device__ __forceinline__ void operator()(const f32x4 (&acc)[2][2][4][2], const GUnit& u, int wr, int wc, int fr, int fq) const {
        LAUNDER(fr); LAUNDER(fq);
#pragma unroll
        for (int ai = 0; ai < 2; ++ai) {
            f32x4 b[4][2][2];
#pragma unroll
            for (int m = 0; m < 4; ++m)
#pragma unroll
                for (int bj = 0; bj < 2; ++bj) { const size_t o = (size_t)(u.row0 + 128 * ai + 64 * wr + 16 * m + fr) * 1024 + u.col0 + 128 * bj + 32 * wc + 8 * fq;
                    if (BASE_BF16) { const u32x4 w = *(const u32x4*)((const bf16_t*)base + o); b[m][bj][0] = (f32x4){bflo(w.x), bfhi(w.x), bflo(w.y), bfhi(w.y)}; b[m][bj][1] = (f32x4){bflo(w.z), bfhi(w.z), bflo(w.w), bfhi(w.w)}; }
                    else { b[m][bj][0] = *(const f32x4*)((const float*)base + o); b[m][bj][1] = *(const f32x4*)((const float*)base + o + 4); } }
#pragma unroll
            for (int m = 0; m < 4; ++m) { const int r = 128 * ai + 64 * wr + 16 * m + fr; float part = 0.f;
#pragma unroll
                for (int bj = 0; bj < 2; ++bj) { const size_t o = (size_t)(u.row0 + r) * 1024 + u.col0 + 128 * bj + 32 * wc + 8 * fq;
                    const f32x4 y0 = b[m][bj][0] + acc[ai][bj][m][0], y1 = b[m][bj][1] + acc[ai][bj][m][1]; *(u32x4*)(xb + o) = pack8(y0, y1);
                    if (xq) { u32x2 q; q.x = pk4_fp8(y0[0], y0[1], y0[2], y0[3]); q.y = pk4_fp8(y1[0], y1[1], y1[2], y1[3]); *(u32x2*)(xq + o) = q; }
                    part += (y0[0] * y0[0] + y0[1] * y0[1] + y0[2] * y0[2] + y0[3] * y0[3]) + (y1[0] * y1[0] + y1[1] * y1[1] + y1[2] * y1[2] + y1[3] * y1[3]); }
                part += __shfl_xor(part, 16); part += __shfl_xor(part, 32);
                if (fq == 0) ss[(size_t)(u.row0 + r) * 16 + (u.col0 >> 8) * 4 + wc] = part; } } } };
struct EpiSoftmax { static constexpr bool AFTER_DRAIN = true; const float* ss; bf16_t* P;
    __device__ __forceinline__ void operator()(const f32x4 (&)[2][2][4][2], const GUnit&, int, int, int, int) const {}
    __device__ __forceinline__ void fused(f32x4 (&acc)[2][2][4][2], const GUnit& u, int wr, int wc, int fr, int fq, unsigned char* lds, int wid, int lane) const {
        float* Pm = (float*)lds; float* Ps = (float*)(lds + 4096);
        LAUNDER(fr); LAUNDER(fq);
#pragma unroll
        for (int ai = 0; ai < 2; ++ai)
#pragma unroll
            for (int m = 0; m < 4; ++m) { const int r = 128 * ai + 64 * wr + 16 * m + fr; const float rstd = row_rstd(ss, u.row0 + r); float mv = -INFINITY;
#pragma unroll
                for (int bj = 0; bj < 2; ++bj)
#pragma unroll
                    for (int n = 0; n < 2; ++n) { f32x4 s = acc[ai][bj][m][n] * rstd; acc[ai][bj][m][n] = s; mv = fmaxf(mv, fmaxf(fmaxf(s[0], s[1]), fmaxf(s[2], s[3]))); }
                mv = fmaxf(mv, __shfl_xor(mv, 16)); mv = fmaxf(mv, __shfl_xor(mv, 32));
                if (fq == 0) Pm[r * 4 + wc] = mv; }
        __syncthreads();
#pragma unroll
        for (int ai = 0; ai < 2; ++ai)
#pragma unroll
            for (int m = 0; m < 4; ++m) { const int r = 128 * ai + 64 * wr + 16 * m + fr; const f32x4 pm = *(const f32x4*)(Pm + r * 4); const float mv = fmaxf(fmaxf(pm[0], pm[1]), fmaxf(pm[2], pm[3])); float sum = 0.f;
#pragma unroll
                for (int bj = 0; bj < 2; ++bj)
#pragma unroll
                    for (int n = 0; n < 2; ++n) { f32x4 s = acc[ai][bj][m][n]; s[0] = __builtin_amdgcn_exp2f(s[0] - mv); s[1] = __builtin_amdgcn_exp2f(s[1] - mv); s[2] = __builtin_amdgcn_exp2f(s[2] - mv); s[3] = __builtin_amdgcn_exp2f(s[3] - mv);
                        acc[ai][bj][m][n] = s; sum += (s[0] + s[1]) + (s[2] + s[3]); }
                sum += __shfl_xor(sum, 16); sum += __shfl_xor(sum, 32);
                if (fq == 0) Ps[r * 4 + wc] = sum; }
        __syncthreads();
#pragma unroll
        for (int ai = 0; ai < 2; ++ai)
#pragma unroll
            for (int m = 0; m < 4; ++m) { const int r = 128 * ai + 64 * wr + 16 * m + fr; const f32x4 ps = *(const f32x4*)(Ps + r * 4); const float inv = 1.0f / ((ps[0] + ps[1]) + (ps[2] + ps[3]));
#pragma unroll
                for (int bj = 0; bj < 2; ++bj) *(u32x4*)(P + (size_t)(u.row0 + r) * 1024 + u.col0 + 128 * bj + 32 * wc + 8 * fq) = pack8(acc[ai][bj][m][0] * inv, acc[ai][bj][m][1] * inv); }
        (void)wid; (void)lane;
        __syncthreads();
    } };
struct EpiGU { static constexpr bool AFTER_DRAIN = false; const float* bgu; unsigned char* act  ; const float* lrs  ;
    __device__ __forceinline__ void operator()(const f32x4 (&acc)[2][2][4][2], const GUnit& u, int wr, int wc, int fr, int fq) const {
        const int pn = u.col0 >> 8; const float* bg = bgu + (size_t)u.e * 2048; LAUNDER(fr); LAUNDER(fq);
        float rs[8];
#pragma unroll
        for (int i = 0; i < 8; ++i) { const int r = 128 * (i >> 2) + 64 * wr + 16 * (i & 3) + fr; rs[i] = lrs[(size_t)u.e * NTOK + u.aux + (r < u.valid ? r : 0)]; }
        const int col = 128 * pn + 32 * wc + 8 * fq;
        f32x4 bgv[2], blv[2];
#pragma unroll
        for (int n = 0; n < 2; ++n) { bgv[n] = *(const f32x4*)(bg + col + 4 * n); blv[n] = *(const f32x4*)(bg + 1024 + col + 4 * n); }
#pragma unroll
        for (int ai = 0; ai < 2; ++ai)
#pragma unroll
            for (int m = 0; m < 4; ++m) { const int r = 128 * ai + 64 * wr + 16 * m + fr; const float rstd = rs[ai * 4 + m]; u32x2 q;
#pragma unroll
                for (int n = 0; n < 2; ++n) { const f32x4 g = acc[ai][0][m][n] * rstd + bgv[n], l = acc[ai][1][m][n] * rstd + blv[n]; float o[4];
#pragma unroll
                    for (int j = 0; j < 4; ++j) { const float gg = fminf(g[j], 7.0f), ll = fminf(fmaxf(l[j], -7.0f), 7.0f); o[j] = (ll + 1.0f) * (gg * __builtin_amdgcn_rcpf(1.0f + __builtin_amdgcn_exp2f(-1.702f * LOG2E * gg))); }
                    const unsigned w = pk4_fp8(o[0], o[1], o[2], o[3]); if (n == 0) q.x = w; else q.y = w; }
                if (r < u.valid) *(u32x2*)(act + (size_t)(u.row0 + r) * 1024 + col) = q; } } };
struct EpiDown { static constexpr bool AFTER_DRAIN = false; const float* bdn; unsigned char* ys  ;
    __device__ __forceinline__ void operator()(const f32x4 (&acc)[2][2][4][2], const GUnit& u, int wr, int wc, int fr, int fq) const {
        const float* bd = bdn + (size_t)u.e * 1024; LAUNDER(fr); LAUNDER(fq);
        f32x4 bv[2][2];
#pragma unroll
        for (int bj = 0; bj < 2; ++bj)
#pragma unroll
            for (int n = 0; n < 2; ++n) bv[bj][n] = *(const f32x4*)(bd + u.col0 + 128 * bj + 32 * wc + 8 * fq + 4 * n);
#pragma unroll
        for (int ai = 0; ai < 2; ++ai)
#pragma unroll
            for (int m = 0; m < 4; ++m) { const int r = 128 * ai + 64 * wr + 16 * m + fr; if (r < u.valid) {
#pragma unroll
                for (int bj = 0; bj < 2; ++bj) { const f32x4 y0 = acc[ai][bj][m][0] + bv[bj][0], y1 = acc[ai][bj][m][1] + bv[bj][1]; u32x2 q; q.x = pk4_fp8(y0[0], y0[1], y0[2], y0[3]); q.y = pk4_fp8(y1[0], y1[1], y1[2], y1[3]);
                    *(u32x2*)(ys + (size_t)(u.row0 + r) * 1024 + u.col0 + 128 * bj + 32 * wc + 8 * fq) = q; } } } } };


typedef float f32x16 __attribute__((ext_vector_type(16)));
typedef short s16x4 __attribute__((ext_vector_type(4)));
__device__ __forceinline__ int crow(int r, int hi) { return (r & 3) + 8 * (r >> 2) + 4 * hi; }
__device__ __forceinline__ s16x4 tr_read(const unsigned char* p) { return __builtin_bit_cast(s16x4, __builtin_amdgcn_ds_read_tr16_b64_v4i16((LDSP s16x4*)(unsigned)(uintptr_t)p)); }
__device__ __forceinline__ bf16x8 tr_frag(const unsigned char* img, int pitch, int k0, int f0, int lane) {
    const unsigned char* p = img + (k0 + 8 * (lane >> 5) + ((lane & 15) >> 2)) * pitch + (f0 + 16 * ((lane >> 4) & 1) + 4 * (lane & 3)) * 2;
    const s16x4 lo = tr_read(p), hi = tr_read(p + 4 * pitch);
    return (bf16x8){lo[0], lo[1], lo[2], lo[3], hi[0], hi[1], hi[2], hi[3]};
}
constexpr int GA_PK = 576, GA_PV = 1088;
constexpr int GA_V = 0, GA_PART = 0, GA_GLR = 69632, GA_TOT = 73728, GA_KD = 75776, GA_END = GA_KD + 64 * GA_PK;
__device__ __forceinline__ void gla_pass_a(unsigned char* lds, int task, const bf16_t* __restrict__ xn, const bf16_t* __restrict__ wglr  , const bf16_t* __restrict__ proj,
                                           const float* __restrict__ wg, const float* __restrict__ bg, float* __restrict__ UT, float* __restrict__ decay) {
    int tid = threadIdx.x; LAUNDER(tid); int wid = tid >> 6, lane = tid & 63, fr = lane & 15, fq = lane >> 4;
    const size_t t0 = (size_t)task * 64;
    { f32x4 acc[4];
#pragma unroll
      for (int m = 0; m < 4; ++m) acc[m] = (f32x4){0.f, 0.f, 0.f, 0.f};
#pragma unroll
      for (int ks = 0; ks < 4; ++ks) { const int k = 128 * wid + 32 * ks + 8 * fq; const bf16x8 bfr = *(const bf16x8*)(wglr + (size_t)fr * 1024 + k);
#pragma unroll
          for (int m = 0; m < 4; ++m) { const bf16x8 afr = *(const bf16x8*)(xn + (t0 + 16 * m + fr) * DM + k); acc[m] = __builtin_amdgcn_mfma_f32_16x16x32_bf16(afr, bfr, acc[m], 0, 0, 0); } }
      float* part = (float*)(lds + GA_PART) + wid * 1024;
#pragma unroll
      for (int m = 0; m < 4; ++m)
#pragma unroll
          for (int j = 0; j < 4; ++j) part[(16 * m + 4 * fq + j) * 16 + fr] = acc[m][j]; }
    __syncthreads();
    { float* glr = (float*)(lds + GA_GLR); const float* part = (const float*)(lds + GA_PART);
      for (int i = tid; i < 1024; i += 512) { float s = 0.f;
#pragma unroll
          for (int w = 0; w < 8; ++w) s += part[w * 1024 + i];
          glr[i] = s; } }
    __syncthreads();
    LAUNDER(tid);
    { const int cv = tid & 63, tk = tid >> 6;
#pragma unroll
      for (int i = 0; i < 8; ++i) { const int tok = tk + 8 * i; const u32x4 v = *(const u32x4*)(proj + (t0 + tok) * PROJ_LD + C_VG + cv * 8); *(u32x4*)(lds + GA_V + tok * GA_PV + cv * 16) = v; } }
    LAUNDER(tid);
    { const int j = tid & 255, half = tid >> 8; const float* glr = (const float*)(lds + GA_GLR); float* tot = (float*)(lds + GA_TOT);
      float w[16];
#pragma unroll
      for (int i = 0; i < 16; ++i) w[i] = wg[i * 256 + j];
      const float bj = bg[j]; float run = 0.f;
      bf16_t kk16[32];
#pragma unroll
      for (int s = 0; s < 32; ++s) kk16[s] = proj[(t0 + 32 * half + s) * PROJ_LD + C_KG + j];
#pragma unroll 2
      for (int s = 0; s < 32; ++s) { const float* gl = glr + (32 * half + s) * 16; float u = bj;
#pragma unroll
          for (int i = 0; i < 16; ++i) u += gl[i] * w[i];
          const float ls = fminf(u, 0.f) - __logf(1.0f + __expf(-fabsf(u)));
          run += ls * (1.0f / 16.0f); }
      tot[half * 256 + j] = run;
      __syncthreads();
      const float t0v = tot[j], t1v = tot[256 + j]; const float gend = t0v + t1v;
      if (half == 0) decay[(size_t)task * 256 + j] = __expf(gend);
      run = half ? t0v : 0.f;
#pragma unroll
      for (int s = 0; s < 32; ++s) { const int tok = 32 * half + s; const float* gl = glr + tok * 16; float u = bj;
#pragma unroll
          for (int i = 0; i < 16; ++i) u += gl[i] * w[i];
          const float ls = fminf(u, 0.f) - __logf(1.0f + __expf(-fabsf(u)));
          run += ls * (1.0f / 16.0f);
          const float kk = bf2f(kk16[s]);
          *(bf16_t*)(lds + GA_KD + tok * GA_PK + j * 2) = (bf16_t)f2bf(kk * __expf(gend - run)); } }
    __syncthreads();
    LAUNDER(tid); wid = __builtin_amdgcn_readfirstlane(tid >> 6); lane = tid & 63;
    { const int h = wid >> 1, nt = wid & 1, hi = lane >> 5, c32 = lane & 31; f32x16 acc[4];
#pragma unroll
      for (int m = 0; m < 4; ++m)
#pragma unroll
          for (int r = 0; r < 16; ++r) acc[m][r] = 0.f;
#pragma unroll
      for (int ks = 0; ks < 4; ++ks) { const bf16x8 bfr = tr_frag(lds + GA_KD, GA_PK, 16 * ks, h * 64 + 32 * nt, lane);
#pragma unroll
          for (int m = 0; m < 4; ++m) { const bf16x8 afr = tr_frag(lds + GA_V, GA_PV, 16 * ks, h * 128 + 32 * m, lane); acc[m] = __builtin_amdgcn_mfma_f32_32x32x16_bf16(afr, bfr, acc[m], 0, 0, 0); } }
      float* u = UT + ((size_t)task * 4 + h) * 8192;
#pragma unroll
      for (int m = 0; m < 4; ++m)
#pragma unroll
          for (int r = 0; r < 16; ++r) u[(32 * m + crow(r, hi)) * 64 + 32 * nt + c32] = acc[m][r]; }
    __syncthreads();
}
__device__ __forceinline__ void gla_pass_b(int e, const float* __restrict__ UT, const float* __restrict__ decay, bf16_t* __restrict__ ST) {
    const int dk = e & 63, dv = (e >> 6) & 127, h = (e >> 13) & 3, b = e >> 15; float s = 0.f;
    const size_t base = ((size_t)b * 128 * 4 + h) * 8192 + dv * 64 + dk; const size_t dbase = (size_t)b * 128 * 256 + h * 64 + dk;
    for (int c0 = 0; c0 < 128; c0 += 32) { float u[32], d[32];
#pragma unroll
        for (int i = 0; i < 32; ++i) { u[i] = UT[base + (size_t)(c0 + i) * 4 * 8192]; d[i] = decay[dbase + (size_t)(c0 + i) * 256]; }
#pragma unroll
        for (int i = 0; i < 32; ++i) { s = d[i] * s + u[i]; ST[base + (size_t)(c0 + i) * 4 * 8192] = (bf16_t)f2bf(s); } }
}
constexpr int GC_PITCH = 520;
__device__ __forceinline__ void gla_pass_c(unsigned char* wlds  , int wtask, const bf16_t* __restrict__ ST, const bf16_t* __restrict__ proj, const float* __restrict__ ghead, bf16_t* __restrict__ mix, int lane) {
    const int nh = wtask & 1, h = (wtask >> 1) & 3, bc = wtask >> 3; const int c32 = lane & 31, hi = lane >> 5;
    const size_t t0 = (size_t)bc * 64 + 32 * nh; const bf16_t* st = ST + ((size_t)bc * 4 + h) * 8192;
    f32x16 acc[4];
#pragma unroll
    for (int m = 0; m < 4; ++m)
#pragma unroll
        for (int r = 0; r < 16; ++r) acc[m][r] = 0.f;
#pragma unroll
    for (int ks = 0; ks < 4; ++ks) { const bf16x8 bfr = *(const bf16x8*)(proj + (t0 + c32) * PROJ_LD + C_QG + h * 64 + 16 * ks + 8 * hi);
#pragma unroll
        for (int m = 0; m < 4; ++m) { const bf16x8 afr = *(const bf16x8*)(st + (32 * m + c32) * 64 + 16 * ks + 8 * hi); acc[m] = __builtin_amdgcn_mfma_f32_32x32x16_bf16(afr, bfr, acc[m], 0, 0, 0); } }
    float ss = 0.f;
#pragma unroll
    for (int m = 0; m < 4; ++m)
#pragma unroll
        for (int r = 0; r < 16; ++r) ss += acc[m][r] * acc[m][r];
    ss += __shfl_xor(ss, 32);
    const float rstd = 1.0f / sqrtf(ss * (1.0f / 128.0f) + EPS);
#pragma unroll
    for (int m = 0; m < 4; ++m)
#pragma unroll
        for (int r = 0; r < 16; ++r) *(float*)(wlds + c32 * GC_PITCH + (32 * m + crow(r, hi)) * 4) = acc[m][r] * rstd;
#pragma unroll
    for (int i = 0; i < 8; ++i) { const int q = lane + 64 * i, tok = q >> 4, dv0 = (q & 15) * 8; const float* src = (const float*)(wlds + tok * GC_PITCH + dv0 * 4);
        const u32x4 rgw = *(const u32x4*)(proj + (t0 + tok) * PROJ_LD + C_RG + h * 128 + dv0); const f32x4 g0 = *(const f32x4*)(ghead + dv0), g1 = *(const f32x4*)(ghead + dv0 + 4);
        const float rg[8] = {bflo(rgw.x), bfhi(rgw.x), bflo(rgw.y), bfhi(rgw.y), bflo(rgw.z), bfhi(rgw.z), bflo(rgw.w), bfhi(rgw.w)}; const float gg[8] = {g0.x, g0.y, g0.z, g0.w, g1.x, g1.y, g1.z, g1.w}; float y[8];
#pragma unroll
        for (int k = 0; k < 8; ++k) y[k] = src[k] * gg[k] * (rg[k] / (1.0f + __expf(-rg[k])));
        u32x4 o; o.x = pk2(y[0], y[1]); o.y = pk2(y[2], y[3]); o.z = pk2(y[4], y[5]); o.w = pk2(y[6], y[7]);
        *(u32x4*)(mix + (t0 + tok) * 1024 + h * 128 + dv0) = o; }
}
__device__ __forceinline__ void sb_task(unsigned char* vl  , int wtask, const bf16_t* __restrict__ proj, bf16_t* __restrict__ mix, int lane) {
    const int qt = wtask & 255, h = (wtask >> 8) & 7, b = wtask >> 11; const int c = lane & 31, hi = lane >> 5;
    const int t0 = qt * 32; const size_t rowb = (size_t)b * SEQ;
    bf16x8 qf[4];
#pragma unroll
    for (int d0 = 0; d0 < 4; ++d0) qf[d0] = *(const bf16x8*)(proj + (rowb + t0 + c) * PROJ_LD + C_QS + h * 64 + 16 * d0 + 8 * hi);
    const int kap = 16 * ((c >> 2) & 1) + (c & 3) + 4 * (c >> 3);
    f32x16 o0, o1;
#pragma unroll
    for (int r = 0; r < 16; ++r) { o0[r] = 0.f; o1[r] = 0.f; }
    float Dc = 1.0f;
    const bf16_t* kbase = proj + rowb * PROJ_LD + C_KS + h * 64 + 8 * hi + (size_t)kap * PROJ_LD;
    const bf16_t* vbase = proj + rowb * PROJ_LD + C_VS + h * 64 + (lane & 7) * 8 + (size_t)(lane >> 3) * PROJ_LD;
    bf16x8 kf[4]; u32x4 vr[4];
#pragma unroll
    for (int d0 = 0; d0 < 4; ++d0) kf[d0] = *(const bf16x8*)(kbase + (size_t)t0 * PROJ_LD + 16 * d0);
#pragma unroll
    for (int i = 0; i < 4; ++i) vr[i] = *(const u32x4*)(vbase + (size_t)(t0 + 8 * i) * PROJ_LD);
    for (int j0 = t0; j0 >= 0; j0 -= 32) {
#pragma unroll
        for (int i = 0; i < 4; ++i) { const int key = (lane >> 3) + 8 * i, ch = lane & 7; *(u32x4*)(vl + (ch >> 2) * 2048 + key * 64 + (ch & 3) * 16) = vr[i]; }
        f32x16 z;
#pragma unroll
        for (int r = 0; r < 16; ++r) z[r] = 0.f;
#pragma unroll
        for (int d0 = 0; d0 < 4; ++d0) z = __builtin_amdgcn_mfma_f32_32x32x16_bf16(kf[d0], qf[d0], z, 0, 0, 0);
        asm volatile("" ::: "memory");
        { const int jn = (j0 >= 32) ? j0 - 32 : j0;
#pragma unroll
          for (int d0 = 0; d0 < 4; ++d0) kf[d0] = *(const bf16x8*)(kbase + (size_t)jn * PROJ_LD + 16 * d0);
#pragma unroll
          for (int i = 0; i < 4; ++i) vr[i] = *(const u32x4*)(vbase + (size_t)(jn + 8 * i) * PROJ_LD); }
        asm volatile("" ::: "memory");
        float e[16], Dl[16];
        const bool diag = (j0 == t0);
#pragma unroll
        for (int r = 0; r < 16; ++r) { float ev = __builtin_amdgcn_exp2f(fminf(z[r], 126.0f)); if (diag && (16 * hi + r >= c)) ev = 0.f; e[r] = ev; }
        float D = hi ? Dc : 1.0f;
#pragma unroll
        for (int r = 15; r >= 0; --r) { D = fmaf(D, e[r], D); Dl[r] = D; }
        const float other = __shfl_xor(D, 32);
        const float mult = hi ? 1.0f : other;
        Dc = D * other;
        unsigned pw[8];
#pragma unroll
        for (int r = 0; r < 16; r += 2) { const float a0 = e[r] * __builtin_amdgcn_rcpf(Dl[r] * mult), a1 = e[r + 1] * __builtin_amdgcn_rcpf(Dl[r + 1] * mult); pw[r >> 1] = pk2(a0, a1); }
#pragma unroll
        for (int ks = 0; ks < 2; ++ks) { const bf16x8 pa = __builtin_bit_cast(bf16x8, (u32x4){pw[4 * ks], pw[4 * ks + 1], pw[4 * ks + 2], pw[4 * ks + 3]});
            const unsigned char* vb = vl + (16 * hi + 8 * ks + ((lane & 15) >> 2)) * 64 + (16 * ((lane >> 4) & 1) + 4 * (lane & 3)) * 2;
            { const s16x4 lo = tr_read(vb), hh = tr_read(vb + 256); o0 = __builtin_amdgcn_mfma_f32_32x32x16_bf16(pa, (bf16x8){lo[0], lo[1], lo[2], lo[3], hh[0], hh[1], hh[2], hh[3]}, o0, 0, 0, 0); }
            { const s16x4 lo = tr_read(vb + 2048), hh = tr_read(vb + 2048 + 256); o1 = __builtin_amdgcn_mfma_f32_32x32x16_bf16(pa, (bf16x8){lo[0], lo[1], lo[2], lo[3], hh[0], hh[1], hh[2], hh[3]}, o1, 0, 0, 0); } }
        if (__all(!(Dc < 3.0e38f))) break;
    }
    bf16_t* ob = mix + (rowb + t0) * 1024 + 512 + h * 64 + c;
#pragma unroll
    for (int r = 0; r < 16; ++r) { const int q = crow(r, hi); ob[(size_t)q * 1024] = (bf16_t)f2bf(o0[r]); ob[(size_t)q * 1024 + 32] = (bf16_t)f2bf(o1[r]); }
}
__device__ __forceinline__ void memkv_task(int wtask, int lane, const bf16_t* __restrict__ memn, const bf16_t* __restrict__ wkv, bf16_t* __restrict__ kv) {
    const int tm = wtask >> 6, tn = wtask & 63; const int c = lane & 31, hi = lane >> 5;
    const bf16_t* ap = memn + (size_t)(tm * 32 + c) * DM + 8 * hi; const bf16_t* bp = wkv + (size_t)(tn * 32 + c) * DM + 8 * hi;
    f32x16 acc;
#pragma unroll
    for (int r = 0; r < 16; ++r) acc[r] = 0.f;
#pragma unroll 16
    for (int ks = 0; ks < 64; ++ks) { const bf16x8 a = *(const bf16x8*)(ap + 16 * ks), b = *(const bf16x8*)(bp + 16 * ks); acc = __builtin_amdgcn_mfma_f32_32x32x16_bf16(a, b, acc, 0, 0, 0); }
    bf16_t* o = kv + (size_t)(tm * 32) * 2048 + tn * 32 + c;
#pragma unroll
    for (int r = 0; r < 16; ++r) o[(size_t)crow(r, hi) * 2048] = (bf16_t)f2bf(acc[r]);
}
__device__ __forceinline__ void router_task(int wtask, int lane, const bf16_t* __restrict__ xn, const float* __restrict__ ss, const bf16_t* __restrict__ wr, const float* __restrict__ br,
                                            int (&oe)[4], float (&ow)[4]) {
    const int c = lane & 31, hi = lane >> 5; const int t = wtask * 32 + c;
    const bf16_t* ap = wr + (size_t)c * DM + 8 * hi; const bf16_t* bp = xn + (size_t)t * DM + 8 * hi;
    f32x16 acc;
#pragma unroll
    for (int r = 0; r < 16; ++r) acc[r] = 0.f;
#pragma unroll 16
    for (int ks = 0; ks < 64; ++ks) { const bf16x8 a = *(const bf16x8*)(ap + 16 * ks), b = *(const bf16x8*)(bp + 16 * ks); acc = __builtin_amdgcn_mfma_f32_32x32x16_bf16(a, b, acc, 0, 0, 0); }
    float v[16]; const float rstd = row_rstd(ss, t);
#pragma unroll
    for (int r = 0; r < 16; ++r) v[r] = acc[r] * rstd + br[crow(r, hi)];
    float tv[4]; int ti[4];
#pragma unroll
    for (int k = 0; k < 4; ++k) { float best = -INFINITY; int bi = 64;
#pragma unroll
        for (int r = 0; r < 16; ++r) { if (v[r] > best) { best = v[r]; bi = crow(r, hi); } }
        tv[k] = best; ti[k] = bi;
#pragma unroll
        for (int r = 0; r < 16; ++r) if (crow(r, hi) == bi) v[r] = -INFINITY; }
    float cv[8]; int ci[8];
#pragma unroll
    for (int k = 0; k < 4; ++k) { cv[k] = tv[k]; ci[k] = ti[k]; cv[4 + k] = __shfl_xor(tv[k], 32); ci[4 + k] = __shfl_xor(ti[k], 32); }
#pragma unroll
    for (int k = 0; k < 4; ++k) { float best = -INFINITY; int bi = 64;
#pragma unroll
        for (int q = 0; q < 8; ++q) { if (cv[q] > best || (cv[q] == best && ci[q] < bi)) { best = cv[q]; bi = ci[q]; } }
        tv[k] = best; ti[k] = bi;
#pragma unroll
        for (int q = 0; q < 8; ++q) if (ci[q] == bi) cv[q] = -INFINITY; }
    const float e1 = __expf(tv[1] - tv[0]), e2 = __expf(tv[2] - tv[0]), e3 = __expf(tv[3] - tv[0]); const float inv = 1.0f / (1.0f + e1 + e2 + e3);
    const float g[4] = {inv, e1 * inv, e2 * inv, e3 * inv};
#pragma unroll
    for (int k = 0; k < 4; ++k) { oe[k] = ti[k]; ow[k] = g[k]; }
}
__device__ __forceinline__ void combine_task(int t, int lane, const bf16_t* xin, float* xout, const unsigned char* __restrict__ ys, const int* tab, const int* __restrict__ toke, const int* __restrict__ tokr,
                                                 const float* __restrict__ tokw, const float* __restrict__ gfin) {
    const u32x2* xr = (const u32x2*)(xin + (size_t)t * DM) + lane; f32x4* xo = (f32x4*)(xout + (size_t)t * DM) + lane; f32x4 v[4];
#pragma unroll
    for (int j = 0; j < 4; ++j) { const u32x2 w = xr[64 * j]; v[j] = (f32x4){bflo(w.x), bfhi(w.x), bflo(w.y), bfhi(w.y)}; }
    for (int k = 0; k < 4; ++k) { const int e = toke[t * 4 + k], r = tokr[t * 4 + k]; const float w = tokw[t * 4 + k]; const int start = tab[32 + e];
        const unsigned* yr = (const unsigned*)(ys + (size_t)(start + r) * DM) + lane;
#pragma unroll
        for (int j = 0; j < 4; ++j) { const int y = (int)yr[64 * j]; const f32x2 lo = __builtin_amdgcn_cvt_pk_f32_fp8(y, false), hi = __builtin_amdgcn_cvt_pk_f32_fp8(y, true);
            v[j].x += w * lo.x; v[j].y += w * lo.y; v[j].z += w * hi.x; v[j].w += w * hi.y; } }
    float s = 0.f;
#pragma unroll
    for (int j = 0; j < 4; ++j) s += v[j].x * v[j].x + v[j].y * v[j].y + v[j].z * v[j].z + v[j].w * v[j].w;
    const float rstd = 1.0f / sqrtf(wave_sum(s) * (1.f / DM) + EPS);
#pragma unroll
    for (int j = 0; j < 4; ++j) { const f32x4 g = *((const f32x4*)gfin + lane + 64 * j); xo[64 * j] = v[j] * rstd * g; }
}

#define GAS __attribute__((address_space(1)))
#define RLX_AGENT __ATOMIC_RELAXED, __HIP_MEMORY_SCOPE_AGENT
#define XB_TMO      128
#define XB_XCNT(j)  (256  + 64 * (j))
#define XB_XSUB(j)  (1280 + 64 * (j))
#define XB_XGEN(j)  (2304 + 64 * (j))
#define XB_TOP      3328
#define XB_TOPGEN   3392
#define XCD_BAR_WORDS 3456
#define XB_SPIN_CAP (1u << 18)
__device__ __forceinline__ unsigned xb_ld(unsigned* p)              { return __hip_atomic_load(p, __ATOMIC_RELAXED, __HIP_MEMORY_SCOPE_AGENT); }
__device__ __forceinline__ unsigned xb_add(unsigned* p, unsigned v) { return __hip_atomic_fetch_add(p, v, __ATOMIC_RELAXED, __HIP_MEMORY_SCOPE_AGENT); }
__device__ __forceinline__ unsigned xb_xcc_id() { return (unsigned)__builtin_amdgcn_s_getreg((3 << 11) | 20) & 0xFu; }
#define XB_SPIN(cond, bar) do { unsigned _sp = 0; while (cond) { __builtin_amdgcn_s_sleep(1); \
    if ((++_sp & 255u) == 0u) { if (xb_ld(&(bar)[XB_TMO])) break; if (_sp > XB_SPIN_CAP) { atomicAdd(&(bar)[XB_TMO], 1u); break; } } } } while (0)
struct XcdBarrier { unsigned* bar; unsigned x; volatile LDSP unsigned* st; };
__device__ __forceinline__ XcdBarrier xcd_barrier_post(unsigned* bar, volatile LDSP unsigned* st) {
    XcdBarrier b; b.bar = bar; b.x = xb_xcc_id(); b.st = st;
    if (threadIdx.x == 0) (void)xb_add(&bar[XB_XCNT(b.x)], 1u);
    return b;
}
__device__ __forceinline__ void xcd_barrier_complete(unsigned* bar, unsigned x, unsigned& nloc, unsigned& nx) {
    const unsigned G = gridDim.x * gridDim.y * gridDim.z;
    unsigned sum, cnt, mine, sp = 0u;
    for (;;) {
        sum = 0u; cnt = 0u; mine = 0u;
#pragma unroll
        for (unsigned j = 0; j < 16; ++j) { const unsigned c = xb_ld(&bar[XB_XCNT(j)]); sum += c; cnt += (c > 0u) ? 1u : 0u; mine = (j == x) ? c : mine; }
        if (sum == G) break;
        __builtin_amdgcn_s_sleep(1);
        if ((++sp & 255u) == 0u) { if (xb_ld(&bar[XB_TMO])) break; if (sp > XB_SPIN_CAP) { atomicAdd(&bar[XB_TMO], 1u); break; } }
    }
    nloc = mine > 0u ? mine : 1u; nx = cnt > 0u ? cnt : 1u;
}
__device__ __forceinline__ void xcd_barrier(const XcdBarrier& b) {
    asm volatile("s_waitcnt vmcnt(0)" ::: "memory");
    __syncthreads();
    if (threadIdx.x == 0) {
        unsigned* bar = b.bar;
        __builtin_amdgcn_s_waitcnt(0);
        unsigned nloc = b.st[0], nx = b.st[1];
        if (nloc == 0u) { xcd_barrier_complete(bar, b.x, nloc, nx); b.st[0] = nloc; b.st[1] = nx; }
        const unsigned old = xb_add(&bar[XB_XSUB(b.x)], 1u);
        const unsigned gen = old / nloc;
        if (old + 1u == (gen + 1u) * nloc) {
            __builtin_amdgcn_fence(__ATOMIC_RELEASE, "agent");
            asm volatile("s_waitcnt vmcnt(0)" ::: "memory");
            const unsigned og = xb_add(&bar[XB_TOP], 1u);
            const unsigned tg = og / nx;
            if (og + 1u == (tg + 1u) * nx) xb_add(&bar[XB_TOPGEN], 1u);
            else XB_SPIN(xb_ld(&bar[XB_TOPGEN]) == tg, bar);
            __builtin_amdgcn_fence(__ATOMIC_ACQUIRE, "agent");
            xb_add(&bar[XB_XGEN(b.x)], 1u);
            asm volatile("s_waitcnt vmcnt(0)" ::: "memory");
        } else {
            XB_SPIN(xb_ld(&bar[XB_XGEN(b.x)]) == gen, bar);
            __builtin_amdgcn_fence(__ATOMIC_ACQUIRE, "agent");
            asm volatile("s_waitcnt vmcnt(0)" ::: "memory");
        }
    }
    __syncthreads();
}

constexpr int LDS_BYTES = 147456;
constexpr int MISC_OFF = LDS_BYTES - 512;
constexpr int CW_BAR = 4096;
constexpr size_t CTL_ZERO_BYTES = 65536;
constexpr int NPHASE = 12;
struct Args { const float* in[22]; float* out; unsigned char* ws; int ph_lo, ph_hi; };

__global__ void __launch_bounds__(512, 2) mega(Args a) {
    extern __shared__ __attribute__((aligned(16))) unsigned char lds[];
    unsigned char* ws = a.ws; float* out = a.out;
    const float* x = a.in[0]; const float* mem = a.in[1]; const float* g_mix = a.in[2]; const float* w_in = a.in[3];
    const float* w_gla_gate = a.in[4]; const float* b_gla_gate = a.in[5]; const float* g_gla_head = a.in[6]; const float* w_out = a.in[7];
    const float* g_mem_q = a.in[8]; const float* g_mem_kv = a.in[9]; const float* w_mq = a.in[10]; const float* w_mk = a.in[11];
    const float* w_mv = a.in[12]; const float* w_mo = a.in[13]; const float* g_ffn = a.in[14]; const float* w_router = a.in[15];
    const float* b_router = a.in[16]; const float* w_gu = a.in[17]; const float* b_gu = a.in[18]; const float* w_down = a.in[19];
    const float* b_down = a.in[20]; const float* g_final = a.in[21];
    bf16_t* Wt_in = (bf16_t*)(ws + WS_WIN); bf16_t* Wt_out = (bf16_t*)(ws + WS_WOUT); bf16_t* Wq = (bf16_t*)(ws + WS_WQ); bf16_t* Wt_kv = (bf16_t*)(ws + WS_WKV);
    bf16_t* Wt_mo = (bf16_t*)(ws + WS_WMO); bf16_t* Wt_r = (bf16_t*)(ws + WS_WR); bf16_t* Wt_gu = (bf16_t*)(ws + WS_WGU); bf16_t* Wt_dn = (bf16_t*)(ws + WS_WDN);
    bf16_t* xn = (bf16_t*)(ws + WS_XN); bf16_t* memn = (bf16_t*)(ws + WS_MEMN); bf16_t* kv = (bf16_t*)(ws + WS_KV); bf16_t* Bs = (bf16_t*)(ws + WS_BS); bf16_t* Bo = (bf16_t*)(ws + WS_BO);
    bf16_t* proj = (bf16_t*)(ws + WS_PROJ); bf16_t* mix = (bf16_t*)(ws + WS_MIX);
    float* Sc = (float*)(ws + WS_S); bf16_t* P = (bf16_t*)(ws + WS_P); float* lg = (float*)(ws + WS_LG); int* toke = (int*)(ws + WS_TOKE); int* tokr = (int*)(ws + WS_TOKR);
    float* tokw = (float*)(ws + WS_TOKW); int* list = (int*)(ws + WS_LIST); unsigned char* ys = ws + WS_YS;
    unsigned char* Wq_gu = ws + WS_WGU; unsigned char* Wq_dn = ws + WS_WDN; unsigned char* x2q = ws + WS_S; unsigned char* act8 = ws + WS_ACT;
    float* lrs = (float*)(ws + WS_LG);
    float* UT = (float*)(ws + WS_S); float* decay = (float*)(ws + WS_LA); bf16_t* ST = (bf16_t*)(ws + WS_ORAW);
    unsigned* ctl = (unsigned*)(ws + WS_CTL); int* cnt = (int*)ctl + CW_CNT; float* ss1 = (float*)(ws + WS_LA + 8 * MiB); float* ss2 = (float*)(ws + WS_LA + 9 * MiB);

    const int G = gridDim.x, vb = blockIdx.x;
    volatile LDSP unsigned* MISC = (volatile LDSP unsigned*)(unsigned)(uintptr_t)(lds + MISC_OFF);
    if (threadIdx.x < 128) MISC[threadIdx.x] = 0u;
    __syncthreads();
    XcdBarrier bar = xcd_barrier_post(ctl + CW_BAR, MISC + 8);
    const int lo = a.ph_lo, hi = a.ph_hi;
    float* dmy = (float*)(ws + WS_DUMMY); (void)dmy;
#ifndef REPEAT_MASK
#define REPEAT_MASK 0
#endif
#define IN(k) (lo <= (k) && (k) < hi)
#define REP(k) for (int rep_ = 0; rep_ < 1 + ((REPEAT_MASK >> (k)) & 1); ++rep_)
#define SEAM(k) do { if (IN(k) && IN((k) + 1)) xcd_barrier(bar); } while (0)
#define TIDS() int tid = threadIdx.x; LAUNDER(tid); const int lane = tid & 63; const int wid = __builtin_amdgcn_readfirstlane(tid >> 6); (void)lane; (void)wid

    if (IN(0)) REP(0) { TIDS(); const size_t gt = (size_t)vb * 512 + tid, gs = (size_t)G * 512;
        float* scr = (float*)(lds + wid * 8448);
        const int gw = vb * 8 + wid, ngw = G * 8;
        rms_body(gw, ngw, lane, x, xn, NTOK);
        rms_body(gw, ngw, lane, mem, memn, NB * MEML);
        conv_n_body(gt, gs, w_mq, Wq, g_mem_q, 1024, 1024, LOG2E / 16.0f);
        constexpr int I_IN = 16 * 97, I_SQ = 16 * 32, I_R = 16, I_GU = 32 * 16 * 64, I_DN = 32 * 16 * 32;
        constexpr int NITEMS = I_IN + 4 * I_SQ + I_R + I_GU + I_DN;
        for (int it = gw; it < NITEMS; it += ngw) { int r = it;
            if (r < I_IN) { conv_item<1>(scr, w_in, Wt_in, g_mix, 3088, 1024, 3088, r / 97, r % 97, lane); continue; } r -= I_IN;
            if (r < I_SQ) { conv_item<0>(scr, w_out, Wt_out, nullptr, 1024, 1024, 1024, r >> 5, r & 31, lane); continue; } r -= I_SQ;
            if (r < I_SQ) { conv_item<0>(scr, w_mk, Wt_kv, g_mem_kv, 1024, 1024, 1024, r >> 5, r & 31, lane); continue; } r -= I_SQ;
            if (r < I_SQ) { conv_item<0>(scr, w_mv, Wt_kv + (size_t)1024 * 1024, g_mem_kv, 1024, 1024, 1024, r >> 5, r & 31, lane); continue; } r -= I_SQ;
            if (r < I_SQ) { conv_item<0>(scr, w_mo, Wt_mo, nullptr, 1024, 1024, 1024, r >> 5, r & 31, lane); continue; } r -= I_SQ;
            if (r < I_R) { conv_item<0>(scr, w_router, Wt_r, g_ffn, 32, 1024, 32, r, 0, lane); continue; } r -= I_R;
            if (r < I_GU) { const int e = r >> 10, q = r & 1023; conv_item8<2>(scr, w_gu + (size_t)e * 1024 * 2048, Wq_gu + (size_t)e * 2048 * 1024, g_ffn, 2048, 1024, 2048, q >> 6, q & 63, lane, (float)(1 << WSCALE_LOG2)); continue; } r -= I_GU;
            { const int e = r >> 9, q = r & 511; conv_item8<0>(scr, w_down + (size_t)e * 1024 * 1024, Wq_dn + (size_t)e * 1024 * 1024, nullptr, 1024, 1024, 1024, q >> 5, q & 31, lane, (float)(1 << WSCALE_LOG2)); } }
        __syncthreads(); }
    SEAM(0);
    if (IN(1)) REP(1) { DenseSched S{(const char*)xn, (const char*)Wt_in, 2048u, 2048u, 1024, 64, 12, 1 << 30, 0, G, vb}; EpiBf16 E{proj, PROJ_LD, 0}; gemm_run<true>(lds, S, E); }
    SEAM(1);
    if (IN(2)) REP(2) {
        for (int t = vb; t < 256; t += G) gla_pass_a(lds, t, xn, Wt_in + (size_t)3072 * 1024, proj, w_gla_gate, b_gla_gate, UT, decay);
        { TIDS(); for (int t = vb * 8 + wid; t < 4096; t += G * 8) sb_task(lds + wid * 4096, t, proj, mix, lane); }
        { TIDS(); for (int t = vb + G * wid; t < 1024; t += G * 8) memkv_task(t, lane, memn, Wt_kv, kv); } }
    SEAM(2);
    if (IN(3)) REP(3) {
        { TIDS(); for (int e = vb * 512 + tid; e < 65536; e += G * 512) gla_pass_b(e, UT, decay, ST); }
        { SchedWqk S{(const char*)kv, (const char*)Wq, 4096u, 2048u, 256, G / 2, vb - G / 2, 0}; EpiBf16 E{Bs, 1024, 0}; gemm_run<false>(lds, S, E); }
        { SchedVo S{(const char*)Wt_mo, (const char*)kv, 2048u, 4096u, 256, G / 2, vb - G / 2 - 32, 0}; EpiBf16 E{Bo, 1024, 0}; gemm_run<false>(lds, S, E); } }
    SEAM(3);
    if (IN(4)) REP(4) { TIDS(); for (int t = vb * 8 + wid; t < 2048; t += G * 8) gla_pass_c(lds + wid * 32 * GC_PITCH, t, ST, proj, g_gla_head, mix, lane); }
    SEAM(4);
#if PROBE_BARRIERS
    for (int pb_ = 0; pb_ < 8; ++pb_) xcd_barrier(bar);
#endif
    if (IN(5)) REP(5) { DenseSched S{(const char*)mix, (const char*)Wt_out, 2048u, 2048u, 1024, 64, 4, 1 << 30, 0, G, vb}; EpiResidSS<false> E{x, rep_ ? (bf16_t*)dmy : xn, rep_ ? dmy + 16 * 1024 * 1024 : ss1, nullptr}; gemm_run<false>(lds, S, E); }
    SEAM(5);
    if (IN(6)) REP(6) { DenseSched S{(const char*)xn, (const char*)Bs, 2048u, 2048u, 1024, 64, 4, 32, (size_t)1024 * 2048, G, vb}; EpiSoftmax E{ss1, P}; gemm_run<false>(lds, S, E); }
    SEAM(6);
    if (IN(7)) REP(7) { DenseSched S{(const char*)P, (const char*)Bo, 2048u, 2048u, 1024, 64, 4, 32, (size_t)1024 * 2048, G, vb}; EpiResidSS<true> E{xn, rep_ ? (bf16_t*)dmy : xn, rep_ ? dmy + 16 * 1024 * 1024 : ss2, rep_ ? (unsigned char*)dmy + 40 * 1024 * 1024 : x2q}; gemm_run<false>(lds, S, E); }
    SEAM(7);
    if (IN(8)) REP(8) { TIDS(); int* cntp = rep_ ? (int*)ctl + 2048 : cnt; int* listp = rep_ ? (int*)dmy + 1024 : list; float* lrsp = rep_ ? dmy + 4096 * 1024 : lrs; int* tokep = rep_ ? (int*)dmy + 1024 * 1024 : toke; int* tokrp = rep_ ? (int*)dmy + 2048 * 1024 : tokr; float* tokwp = rep_ ? dmy + 3072 * 1024 : tokw;
        int* lcnt = (int*)lds; int* gbase = (int*)lds + 32;
        for (int tb = vb; tb < NTOK / 64; tb += G) {
            if (tid < 32) lcnt[tid] = 0;
            __syncthreads();
            int oe[4] = {0, 0, 0, 0}; float ow[4] = {0.f, 0.f, 0.f, 0.f}; int lr[4] = {0, 0, 0, 0};
            if (wid < 2) { router_task(tb * 2 + wid, lane, xn, ss2, Wt_r, b_router, oe, ow);
                if (lane < 32) {
#pragma unroll
                    for (int k = 0; k < 4; ++k) lr[k] = atomicAdd(&lcnt[oe[k]], 1); } }
            __syncthreads();
            if (tid < 32) gbase[tid] = atomicAdd(&cntp[tid * 32], lcnt[tid]);
            __syncthreads();
            if (wid < 2 && lane < 32) { const int t = (tb * 2 + wid) * 32 + lane;
                const float rstd_t = row_rstd(ss2, t);
#pragma unroll
                for (int k = 0; k < 4; ++k) { const int r = gbase[oe[k]] + lr[k]; listp[oe[k] * NTOK + r] = t; lrsp[oe[k] * NTOK + r] = rstd_t; tokep[t * 4 + k] = oe[k]; tokrp[t * 4 + k] = r; tokwp[t * 4 + k] = ow[k]; } }
            __syncthreads(); } }
    SEAM(8);
    if (IN(9)) REP(9) { int* tab = (int*)(lds + 131072); { TIDS(); moe_build_table(tab, cnt, tid); }
        MoeSched<true> S{(const char*)x2q, (const char*)Wq_gu, 1024u, 1024u, 512, 8, (size_t)2048 * 1024, tab, list, 1, G, vb, 0}; EpiGU E{b_gu, act8, lrs}; gemm_run_fp8<true>(lds, S, E); }
    SEAM(9);
    if (IN(10)) REP(10) { int* tab = (int*)(lds + 131072); { TIDS(); moe_build_table(tab, cnt, tid); }
        MoeSched<false> S{(const char*)act8, (const char*)Wq_dn, 1024u, 1024u, 512, 4, (size_t)1024 * 1024, tab, list, 0, G, vb, 0}; EpiDown E{b_down, ys}; gemm_run_fp8<true>(lds, S, E); }
    SEAM(10);
    if (IN(11)) REP(11) { TIDS(); int* tab = (int*)(lds + 131072); moe_build_table(tab, cnt, tid);
        for (int t = vb * 8 + wid; t < NTOK; t += G * 8) combine_task(t, lane, xn, rep_ ? dmy : out, ys, tab, toke, tokr, tokw, g_final); }
#undef IN
#undef SEAM
#undef TIDS
}

#ifndef MK_PER_PHASE
#define MK_PER_PHASE 0
#endif
extern "C" void kernel_launch(void* const* d_in, const int* in_sizes, int n_in, void* d_out, int out_size, void* d_ws, size_t ws_size, hipStream_t stream) {
    static int grid = 0;
    if (grid == 0) {
        if (n_in != 22 || in_sizes[0] != NTOK * DM || out_size != NTOK * DM || ws_size < WS_END) { fprintf(stderr, "kernel_launch: unexpected shapes (n_in %d, ws %zu)\n", n_in, ws_size); grid = -1; return; }
        int dev = 0, cus = 0, per_cu = 0;
        if (hipGetDevice(&dev) != hipSuccess || hipDeviceGetAttribute(&cus, hipDeviceAttributeMultiprocessorCount, dev) != hipSuccess) { grid = -1; return; }
        if (hipFuncSetAttribute((const void*)mega, hipFuncAttributeMaxDynamicSharedMemorySize, LDS_BYTES) != hipSuccess) { fprintf(stderr, "kernel_launch: hipFuncSetAttribute failed\n"); grid = -1; return; }
        if (hipOccupancyMaxActiveBlocksPerMultiprocessor(&per_cu, (const void*)mega, 512, LDS_BYTES) != hipSuccess || per_cu < 1) fprintf(stderr, "kernel_launch: occupancy query says %d blocks/CU\n", per_cu);
        (void)hipGetLastError();
        grid = cus;
    }
    if (grid < 0) return;
    (void)hipMemsetAsync((char*)d_ws + WS_CTL, 0, CTL_ZERO_BYTES, stream);
    Args a{};
    for (int i = 0; i < 22; ++i) a.in[i] = (const float*)d_in[i];
    a.out = (float*)d_out; a.ws = (unsigned char*)d_ws;
#if MK_PER_PHASE
    for (int p = 0; p < NPHASE; ++p) { a.ph_lo = p; a.ph_hi = p + 1; hipLaunchKernelGGL(mega, dim3(grid), dim3(512), LDS_BYTES, stream, a); }
#else
    a.ph_lo = 0; a.ph_hi = NPHASE; hipLaunchKernelGGL(mega, dim3(grid), dim3(512), LDS_BYTES, stream, a);
#endif
}
```

```cpp
#include <hip/hip_runtime.h>
#include <cstdio>
#include <cstdint>
#ifndef PROBE_BARRIERS
#define PROBE_BARRIERS 0
#endif

typedef unsigned short bf16_t;
typedef short bf16x8 __attribute__((ext_vector_type(8)));
typedef float f32x4 __attribute__((ext_vector_type(4)));
typedef unsigned u32x4 __attribute__((ext_vector_type(4)));
typedef unsigned u32x2 __attribute__((ext_vector_type(2)));
typedef float f32x2 __attribute__((ext_vector_type(2)));
#define LDSP __attribute__((address_space(3)))
#define LAUNDER(x) asm volatile("" : "+v"(x))

constexpr int NB = 2, SEQ = 8192, NTOK = NB * SEQ, DM = 1024, MEML = 256;
constexpr int NEXP = 32, TOPK = 4, NASSIGN = NTOK * TOPK;
constexpr int PROJ_LD = 3072;
constexpr int C_QG = 0, C_KG = 256, C_VG = 512, C_RG = 1024, C_QS = 1536, C_KS = 2048, C_VS = 2560, C_GLR = 3072;
constexpr float LOG2E = 1.4426950408889634f;
constexpr float EPS = 1e-5f;

__device__ __forceinline__ unsigned f2bf(float f) { unsigned u = __float_as_uint(f); return (u + 0x7fffu + ((u >> 16) & 1u)) >> 16; }
__device__ __forceinline__ unsigned pk2(float lo, float hi) { return f2bf(lo) | (f2bf(hi) << 16); }
__device__ __forceinline__ float bf2f(bf16_t h) { return __uint_as_float(((unsigned)h) << 16); }
__device__ __forceinline__ float bflo(unsigned w) { return __uint_as_float(w << 16); }
__device__ __forceinline__ float bfhi(unsigned w) { return __uint_as_float(w & 0xffff0000u); }

constexpr size_t MiB = 1u << 20;
constexpr size_t WS_CTL = 0;
constexpr size_t WS_WIN = 1 * MiB;
constexpr size_t WS_WOUT = 8 * MiB;
constexpr size_t WS_WQ = 10 * MiB;
constexpr size_t WS_WKV = 12 * MiB;
constexpr size_t WS_WMO = 16 * MiB;
constexpr size_t WS_WR = 18 * MiB;
constexpr size_t WS_WGU = 20 * MiB;
constexpr size_t WS_WDN = 148 * MiB;
constexpr size_t WS_XN = 212 * MiB;
constexpr size_t WS_MEMN = 244 * MiB;
constexpr size_t WS_KV = 245 * MiB;
constexpr size_t WS_BS = 247 * MiB;
constexpr size_t WS_BO = 251 * MiB;
constexpr size_t WS_PROJ = 256 * MiB;
constexpr size_t WS_LA = 360 * MiB;
constexpr size_t WS_ORAW = 376 * MiB;
constexpr size_t WS_MIX = 408 * MiB;
constexpr size_t WS_S = 440 * MiB;
constexpr size_t WS_P = 504 * MiB;
constexpr size_t WS_LG = 536 * MiB;
constexpr size_t WS_TOKE = 538 * MiB;
constexpr size_t WS_TOKR = 539 * MiB;
constexpr size_t WS_TOKW = 540 * MiB;
constexpr size_t WS_LIST = 541 * MiB;
constexpr size_t WS_ACT = 544 * MiB;
constexpr size_t WS_YS = 674 * MiB;
constexpr size_t WS_DUMMY = 804 * MiB;
constexpr size_t WS_END = 872 * MiB;
constexpr int CW_CNT = 1024;

template <int MAP> __device__ __forceinline__ int srccol(int n, float& sc) {
    sc = 1.f;
    if (MAP == 0) return n;
    if (MAP == 1) {
        if (n < 256) { sc = 0.125f; return n; }
        if (n < 1024) return n;
        if (n < 3072) { if (n >= C_QS && n < C_KS) sc = 0.125f * LOG2E; return n + 16; }
        if (n < 3088) return 1024 + (n - 3072);
        return -1;
    }
    { const int ct = n >> 8, w = n & 255; return (w < 128) ? (128 * ct + w) : (1024 + 128 * ct + (w - 128)); }
}
template <int MAP>
__device__ __forceinline__ void conv_item(float* scr, const float* __restrict__ src, bf16_t* __restrict__ dst, const float* __restrict__ gain, int ldsrc, int K, int nrows, int kb, int nb, int lane) {
    const int k0 = kb * 64, n0 = nb * 32; float sc; const int c0 = srccol<MAP>(n0, sc);
    const int half = lane >> 5, l31 = lane & 31;
    const float* s0 = src + (size_t)(k0 + half) * ldsrc + c0 + l31;
    float v[32];
#pragma unroll
    for (int i = 0; i < 32; ++i) v[i] = s0[(size_t)(2 * i) * ldsrc];
#pragma unroll
    for (int i = 0; i < 32; ++i) { const int kk = 2 * i + half; const float g = (gain ? gain[k0 + kk] : 1.f) * sc; scr[kk * 33 + l31] = v[i] * g; }
    asm volatile("s_waitcnt lgkmcnt(0)" ::: "memory");
    const int c = lane & 7;
#pragma unroll
    for (int j = 0; j < 4; ++j) { const int n = (lane >> 3) + 8 * j; const float* s = scr + (8 * c) * 33 + n;
        u32x4 o; o.x = pk2(s[0 * 33], s[1 * 33]); o.y = pk2(s[2 * 33], s[3 * 33]); o.z = pk2(s[4 * 33], s[5 * 33]); o.w = pk2(s[6 * 33], s[7 * 33]);
        if (n0 + n < nrows) *(u32x4*)(dst + (size_t)(n0 + n) * K + k0 + 8 * c) = o; }
    asm volatile("s_waitcnt lgkmcnt(0)" ::: "memory");
}
__device__ __forceinline__ unsigned pk4_fp8(float a, float b, float c, float d) { int w = __builtin_amdgcn_cvt_pk_fp8_f32(a, b, 0, false); w = __builtin_amdgcn_cvt_pk_fp8_f32(c, d, w, true); return (unsigned)w; }
template <int MAP>
__device__ __forceinline__ void conv_item8(float* scr, const float* __restrict__ src, unsigned char* __restrict__ dst, const float* __restrict__ gain, int ldsrc, int K, int nrows, int kb, int nb, int lane, float mul) {
    const int k0 = kb * 64, n0 = nb * 32; float sc; const int c0 = srccol<MAP>(n0, sc); sc *= mul;
    const int half = lane >> 5, l31 = lane & 31;
    const float* s0 = src + (size_t)(k0 + half) * ldsrc + c0 + l31;
    float v[32];
#pragma unroll
    for (int i = 0; i < 32; ++i) v[i] = s0[(size_t)(2 * i) * ldsrc];
#pragma unroll
    for (int i = 0; i < 32; ++i) { const int kk = 2 * i + half; const float g = (gain ? gain[k0 + kk] : 1.f) * sc; scr[kk * 33 + l31] = v[i] * g; }
    asm volatile("s_waitcnt lgkmcnt(0)" ::: "memory");
    const int c = lane & 3;
#pragma unroll
    for (int j = 0; j < 2; ++j) { const int n = (lane >> 2) + 16 * j; const float* s = scr + (16 * c) * 33 + n;
        u32x4 o; o.x = pk4_fp8(s[0 * 33], s[1 * 33], s[2 * 33], s[3 * 33]); o.y = pk4_fp8(s[4 * 33], s[5 * 33], s[6 * 33], s[7 * 33]);
        o.z = pk4_fp8(s[8 * 33], s[9 * 33], s[10 * 33], s[11 * 33]); o.w = pk4_fp8(s[12 * 33], s[13 * 33], s[14 * 33], s[15 * 33]);
        if (n0 + n < nrows) *(u32x4*)(dst + (size_t)(n0 + n) * K + k0 + 16 * c) = o; }
    asm volatile("s_waitcnt lgkmcnt(0)" ::: "memory");
}
__device__ __forceinline__ void conv_n_body(size_t gtid, size_t gsz, const float* __restrict__ src, bf16_t* __restrict__ dst, const float* __restrict__ gain, int K, int nrows, float sc) {
    const int kc8 = K / 8; const size_t total = (size_t)nrows * kc8;
    for (size_t idx = gtid; idx < total; idx += gsz) {
        const int kc = (int)(idx % kc8), n = (int)(idx / kc8);
        const float g = gain[n] * sc; const f32x4 a = *(const f32x4*)(src + (size_t)n * K + kc * 8), b = *(const f32x4*)(src + (size_t)n * K + kc * 8 + 4);
        u32x4 o; o.x = pk2(a.x * g, a.y * g); o.y = pk2(a.z * g, a.w * g); o.z = pk2(b.x * g, b.y * g); o.w = pk2(b.z * g, b.w * g);
        *(u32x4*)(dst + (size_t)n * K + kc * 8) = o;
    }
}

__device__ __forceinline__ float wave_sum(float v) {
#pragma unroll
    for (int o = 1; o < 64; o <<= 1) v += __shfl_xor(v, o);
    return v;
}
__device__ __forceinline__ void rms_body(int gw, int ngw, int lane, const float* __restrict__ x, bf16_t* __restrict__ out, int nrows) {
    for (int row = gw; row < nrows; row += ngw) {
        const f32x4* xr = (const f32x4*)(x + (size_t)row * DM) + lane; f32x4 v[4]; float s = 0.f;
#pragma unroll
        for (int j = 0; j < 4; ++j) { v[j] = xr[64 * j]; s += v[j].x * v[j].x + v[j].y * v[j].y + v[j].z * v[j].z + v[j].w * v[j].w; }
        const float rstd = 1.0f / sqrtf(wave_sum(s) * (1.f / DM) + EPS);
        u32x2* o = (u32x2*)(out + (size_t)row * DM) + lane;
#pragma unroll
        for (int j = 0; j < 4; ++j) { u32x2 w; w.x = pk2(v[j].x * rstd, v[j].y * rstd); w.y = pk2(v[j].z * rstd, v[j].w * rstd); o[64 * j] = w; }
    }
}

struct GUnit { unsigned ao, bo; int row0, col0, e, valid, aux; };

__host__ __device__ __forceinline__ int lds_byte(int r, int c) { const int st = (r >> 4) * 2 + (c >> 5), rr = r & 15, cc = c & 31, ob = rr * 64 + cc * 2; return st * 1024 + (ob ^ (((ob >> 9) & 1) << 5)); }
__host__ __device__ __forceinline__ void stage_rc(int b, int& R, int& C) { const int st = b / 1024, sb = b % 1024, swz = sb ^ (((sb >> 9) & 1) << 5); R = (st >> 1) * 16 + swz / 64; C = (st & 1) * 32 + (swz % 64) / 2; }
__host__ __device__ __forceinline__ int perm32(int rho) { const int n = rho >> 4, i = rho & 15; return 8 * (i >> 2) + 4 * n + (i & 3); }
constexpr int HTB = 128 * 64 * 2;
typedef int v8i __attribute__((ext_vector_type(8)));
typedef int v4i __attribute__((ext_vector_type(4)));
struct Frag2 { bf16x8 h[2]; };
template <bool F> struct FragT { typedef Frag2 T; };
template <> struct FragT<true> { typedef v8i T; };
template <class Sched, class Epi, bool ALIGN_EPI, bool FP8 = false, int SCALE_B = 0x7f>
__device__ __forceinline__ void gemm_phase(unsigned char* lds_flat, const Sched& S, const Epi& E) {
    LDSP unsigned char* lds = (LDSP unsigned char*)(unsigned)(uintptr_t)lds_flat;
    int tid = threadIdx.x; LAUNDER(tid);
    const int wid = __builtin_amdgcn_readfirstlane(tid >> 6), lane = tid & 63, wr = wid >> 2, wc = wid & 3, fr = lane & 15, fq = lane >> 4;
    const int nt = S.K / 64;
    int Rr[2], Cc[2];
#pragma unroll
    for (int i = 0; i < 2; ++i) stage_rc(tid * 16 + i * 8192, Rr[i], Cc[i]);
    unsigned voffB[2][2];
#pragma unroll
    for (int h = 0; h < 2; ++h)
#pragma unroll
        for (int i = 0; i < 2; ++i) voffB[h][i] = (unsigned)(128 * h + (Rr[i] & ~31) + perm32(Rr[i] & 31)) * S.ldb + (unsigned)Cc[i] * 2u;
    const unsigned ldsw = (unsigned)wid * 1024u;
    const int aoff = lds_byte(wr * 64 + fr, fq * 8), boff = lds_byte(wc * 32 + fr, fq * 8);
    constexpr int KSUB = 1024;
#define PG8_SA(b, h) (((b) * 2 + (h)) * HTB)
#define PG8_SB(b, h) ((4 + (b) * 2 + (h)) * HTB)
#define PG8_STAGE(bufoff, rsrc, voff, soff) do { _Pragma("unroll") for (int _i = 0; _i < 2; ++_i) \
        __builtin_amdgcn_raw_ptr_buffer_load_lds(rsrc, (LDSP unsigned*)(lds + (bufoff) + ldsw + _i * 8192), 16, (int)(voff)[_i], (int)(soff), 0, 0); } while (0)
#define PG8_LDF(dst, addr) do { const bf16x8 lo_ = *(const LDSP bf16x8*)(addr); const bf16x8 hi_ = *(const LDSP bf16x8*)((addr) + KSUB); \
        if constexpr (FP8) dst = __builtin_shufflevector(__builtin_bit_cast(v4i, lo_), __builtin_bit_cast(v4i, hi_), 0, 1, 2, 3, 4, 5, 6, 7); else { dst.h[0] = lo_; dst.h[1] = hi_; } } while (0)
#define PG8_LDA(dst, b, h) do { _Pragma("unroll") for (int m = 0; m < 4; ++m) PG8_LDF(dst[m], lds + PG8_SA(b, h) + aoff + m * 2048); } while (0)
#define PG8_LDB(dst, b, h) do { _Pragma("unroll") for (int n = 0; n < 2; ++n) PG8_LDF(dst[n], lds + PG8_SB(b, h) + boff + n * 2048); } while (0)
#define PG8_MMA(ai, bj, At, Bt) do { __builtin_amdgcn_s_setprio(1); _Pragma("unroll") for (int m = 0; m < 4; ++m) _Pragma("unroll") for (int n = 0; n < 2; ++n) { \
        if constexpr (FP8) asm volatile("v_mfma_scale_f32_16x16x128_f8f6f4 %0, %1, %2, %0, %3, %4 op_sel_hi:[0,0,0]" : "+v"(acc[ai][bj][m][n]) : "v"(Bt[n]), "v"(At[m]), "v"(sclB), "v"(sclA)); \
        else { _Pragma("unroll") for (int k = 0; k < 2; ++k) acc[ai][bj][m][n] = __builtin_amdgcn_mfma_f32_16x16x32_bf16(Bt[n].h[k], At[m].h[k], acc[ai][bj][m][n], 0, 0, 0); } } \
        __builtin_amdgcn_s_setprio(0); } while (0)
#define PG8_WAIT_V(n) asm volatile("s_waitcnt vmcnt(" #n ")" ::: "memory")
#define PG8_WAIT_L(n) asm volatile("s_waitcnt lgkmcnt(" #n ")" ::: "memory")
#define PG8_BAR __builtin_amdgcn_s_barrier()
#define PG8_SCHED __builtin_amdgcn_sched_barrier(0)
    GUnit cur, nxt; int ui = 0;
    if (!S.next(0, cur)) return;
    const __amdgpu_buffer_rsrc_t rA = __builtin_amdgcn_make_buffer_rsrc((void*)S.A, 0, 0x7fffffff, 0x00020000);
    const __amdgpu_buffer_rsrc_t rB = __builtin_amdgcn_make_buffer_rsrc((void*)S.Bt, 0, 0x7fffffff, 0x00020000);
    unsigned oc[2][2], on[2][2];
#pragma unroll
    for (int h = 0; h < 2; ++h)
#pragma unroll
        for (int i = 0; i < 2; ++i) oc[h][i] = S.a_off(cur, 128 * h + Rr[i]) + (unsigned)Cc[i] * 2u;
    f32x4 acc[2][2][4][2];
#pragma unroll
    for (int a = 0; a < 2; ++a)
#pragma unroll
        for (int b = 0; b < 2; ++b)
#pragma unroll
            for (int m = 0; m < 4; ++m)
#pragma unroll
                for (int n = 0; n < 2; ++n) acc[a][b][m][n] = (f32x4){0.f, 0.f, 0.f, 0.f};
    typedef typename FragT<FP8>::T frag_t;
    frag_t At[4], B0[2], B1[2];
    const unsigned kstep = 128;
    const int sclB = SCALE_B * 0x01010101, sclA = 0x7f7f7f7f; (void)sclA; (void)sclB;
    PG8_STAGE(PG8_SB(0, 0), rB, voffB[0], cur.bo); PG8_STAGE(PG8_SB(0, 1), rB, voffB[1], cur.bo); PG8_STAGE(PG8_SA(0, 0), rA, oc[0], cur.ao); PG8_STAGE(PG8_SA(0, 1), rA, oc[1], cur.ao);
    if (wr == 1) PG8_BAR;
    PG8_WAIT_V(2); PG8_BAR;
    PG8_STAGE(PG8_SB(1, 0), rB, voffB[0], cur.bo + kstep); PG8_STAGE(PG8_SA(1, 0), rA, oc[0], cur.ao + kstep); PG8_STAGE(PG8_SB(1, 1), rB, voffB[1], cur.bo + kstep);
    PG8_WAIT_V(6); PG8_BAR;
    for (;;) {
        const bool has_next = S.next(ui + 1, nxt);
        if (!has_next) nxt = cur;
        const unsigned nA = nxt.ao, nB = nxt.bo;
        { int t2 = threadIdx.x; LAUNDER(t2);
#pragma unroll
          for (int i = 0; i < 2; ++i) { int R_, C_; stage_rc(t2 * 16 + i * 8192, R_, C_);
#pragma unroll
              for (int h = 0; h < 2; ++h) on[h][i] = S.a_off(nxt, 128 * h + R_) + (unsigned)C_ * 2u; } }
        for (int t = 0; t < nt; t += 2) {
            const bool last = (t == nt - 2);
            const unsigned k1 = cur.ao + (unsigned)(t + 1) * kstep;
            const unsigned a2 = last ? nA : cur.ao + (unsigned)(t + 2) * kstep, b2 = last ? nB : cur.bo + (unsigned)(t + 2) * kstep, a3 = a2 + kstep, b3 = b2 + kstep;
            unsigned o2[2][2];
#pragma unroll
            for (int h = 0; h < 2; ++h)
#pragma unroll
                for (int i = 0; i < 2; ++i) o2[h][i] = last ? on[h][i] : oc[h][i];
            PG8_LDB(B0, 0, 0); PG8_LDB(B1, 0, 1); PG8_SCHED; PG8_LDA(At, 0, 0); PG8_STAGE(PG8_SA(1, 1), rA, oc[1], k1);
            PG8_WAIT_V(8); PG8_WAIT_L(0); PG8_BAR; PG8_MMA(0, 0, At, B0); PG8_MMA(0, 1, At, B1); PG8_BAR; PG8_SCHED;
            PG8_LDA(At, 0, 1); PG8_STAGE(PG8_SB(0, 0), rB, voffB[0], b2); PG8_STAGE(PG8_SB(0, 1), rB, voffB[1], b2); PG8_STAGE(PG8_SA(0, 0), rA, o2[0], a2);
            PG8_WAIT_V(8); PG8_WAIT_L(0); PG8_BAR; PG8_MMA(1, 0, At, B0); PG8_MMA(1, 1, At, B1); PG8_BAR; PG8_SCHED;
            PG8_LDB(B0, 1, 0); PG8_LDB(B1, 1, 1); PG8_SCHED; PG8_LDA(At, 1, 0); PG8_STAGE(PG8_SA(0, 1), rA, o2[1], a2);
            PG8_WAIT_V(8); PG8_WAIT_L(0); PG8_BAR; PG8_MMA(0, 0, At, B0); PG8_MMA(0, 1, At, B1); PG8_BAR; PG8_SCHED;
            PG8_LDA(At, 1, 1); PG8_STAGE(PG8_SB(1, 0), rB, voffB[0], b3); PG8_STAGE(PG8_SB(1, 1), rB, voffB[1], b3); PG8_STAGE(PG8_SA(1, 0), rA, o2[0], a3);
            PG8_WAIT_V(8); PG8_WAIT_L(0); PG8_BAR; PG8_MMA(1, 0, At, B0); PG8_MMA(1, 1, At, B1); PG8_BAR; PG8_SCHED;
        }
        if constexpr (FP8) asm volatile("s_nop 15\n\ts_nop 15" ::: "memory");
        if constexpr (ALIGN_EPI) { if (wr == 0) PG8_BAR; }
        if constexpr (!Epi::AFTER_DRAIN) E(acc, cur, wr, wc, fr, fq);
        if (!has_next) break;
#pragma unroll
        for (int a = 0; a < 2; ++a)
#pragma unroll
            for (int b = 0; b < 2; ++b)
#pragma unroll
                for (int m = 0; m < 4; ++m)
#pragma unroll
                    for (int n = 0; n < 2; ++n) acc[a][b][m][n] = (f32x4){0.f, 0.f, 0.f, 0.f};
        cur = nxt; ++ui;
#pragma unroll
        for (int h = 0; h < 2; ++h)
#pragma unroll
            for (int i = 0; i < 2; ++i) oc[h][i] = on[h][i];
        if constexpr (ALIGN_EPI) { if (wr == 1) PG8_BAR; }
    }
    PG8_WAIT_V(0);
    if constexpr (!ALIGN_EPI) { if (wr == 0) PG8_BAR; }
    PG8_BAR;
    if constexpr (Epi::AFTER_DRAIN) E.fused(acc, cur, wr, wc, fr, fq, lds_flat, wid, lane);
#undef PG8_SA
#undef PG8_SB
#undef PG8_STAGE
#undef PG8_LDA
#undef PG8_LDF
#undef PG8_LDB
#undef PG8_MMA
#undef PG8_WAIT_V
#undef PG8_WAIT_L
#undef PG8_BAR
#undef PG8_SCHED
}
template <bool ALIGN, class Sched, class Epi> __device__ __forceinline__ void gemm_run(unsigned char* lds, const Sched& S, const Epi& E) {
    gemm_phase<Sched, Epi, ALIGN>(lds, S, E);
}
constexpr int WSCALE_LOG2 = 6;
template <bool ALIGN, class Sched, class Epi> __device__ __forceinline__ void gemm_run_fp8(unsigned char* lds, const Sched& S, const Epi& E) {
    gemm_phase<Sched, Epi, ALIGN, true, 127 - WSCALE_LOG2>(lds, S, E);
}

struct DenseSched {
    const char* A; const char* Bt; unsigned lda, ldb; int K; int nM, nN; int pm_per_b; size_t zB; int G, c;
    __device__ __forceinline__ bool next(int i, GUnit& u) const {
        int pm, pn;
        if (G == 256 && (nN & 3) == 0 && nM * nN >= 256) {
            const int j = c & 7, q = c >> 3, s = i * 8 + j, ncg = nN >> 2; pm = (s / ncg) * 8 + (q >> 2); pn = (s % ncg) * 4 + (q & 3); if (c < 0 || pm >= nM) return false; }
        else { const long L = (long)i * G + c; if (c < 0 || L >= (long)nM * nN) return false; pm = (int)(L / nN); pn = (int)(L % nN); }
        u.ao = (unsigned)pm * 256u * lda; u.bo = (unsigned)((size_t)(pm / pm_per_b) * zB) + (unsigned)pn * 256u * ldb; u.row0 = pm * 256; u.col0 = pn * 256; u.e = 0; u.valid = 256; u.aux = 0; return true;
    }
    __device__ __forceinline__ unsigned a_off(const GUnit&, int r) const { return (unsigned)r * lda; }
};
struct SchedWqk {
    const char* A; const char* Bt; unsigned lda, ldb; int K; int G, c, pad;
    __device__ __forceinline__ bool next(int i, GUnit& u) const {
        const int L = i * G + c; if (c < 0 || L >= 32) return false; const int z = L >> 2, pn = L & 3, b = z >> 2, h = z & 3;
        u.ao = (unsigned)b * 256u * 4096u + h * 512u; u.bo = (unsigned)pn * 256u * 2048u + h * 512u; u.row0 = z * 256; u.col0 = pn * 256; u.e = 0; u.valid = 256; u.aux = 0; return true;
    }
    __device__ __forceinline__ unsigned a_off(const GUnit&, int r) const { return (unsigned)r * lda; }
};
struct SchedVo {
    const char* A; const char* Bt; unsigned lda, ldb; int K; int G, c, pad;
    __device__ __forceinline__ bool next(int i, GUnit& u) const {
        const int L = i * G + c; if (c < 0 || L >= 32) return false; const int z = L >> 2, pm = L & 3, b = z >> 2, h = z & 3;
        u.ao = (unsigned)pm * 256u * 2048u + h * 512u; u.bo = (unsigned)b * 256u * 4096u + 2048u + h * 512u; u.row0 = b * 1024 + pm * 256; u.col0 = h * 256; u.e = 0; u.valid = 256; u.aux = 0; return true;
    }
    __device__ __forceinline__ unsigned a_off(const GUnit&, int r) const { return (unsigned)r * lda; }
};
template <bool GATHER> struct MoeSched {
    const char* A; const char* Bt; unsigned lda, ldb; int K; int nN; size_t zB;
    const int* tab; const int* list; int gather; int G, c, pad;
    __device__ __forceinline__ bool next(int i, GUnit& u) const {
        int T, pn;
        if (G == 256) { const int j = c & 7, q = c >> 3, s = i * 8 + j;
            if (nN == 8) { T = 4 * s + (q >> 3); pn = q & 7; } else { T = 8 * s + (q >> 2); pn = q & 3; } }
        else { const int L = i * G + c; T = L / nN; pn = L % nN; }
        if (T >= tab[64]) return false;
        const int w = tab[128 + T]; const int e = w & 255, rt = w >> 8; const int ce = tab[e], start = tab[32 + e];
        u.e = e; u.valid = min(256, ce - rt * 256); u.row0 = start + rt * 256; u.col0 = pn * 256; u.aux = rt * 256;
        u.ao = GATHER ? 0u : (unsigned)u.row0 * lda; u.bo = (unsigned)((size_t)e * zB) + (unsigned)pn * 256u * ldb; return true;
    }
    __device__ __forceinline__ unsigned a_off(const GUnit& u, int r) const {
        if (!GATHER) return (unsigned)r * lda;
        const int rr = r < u.valid ? r : 0; const int tok = list[u.e * NTOK + u.aux + rr]; return (unsigned)tok * lda;
    }
};
__device__ __forceinline__ void moe_build_table(int* tab, const int* __restrict__ cnt, int tid) {
    if (tid < 32) tab[tid] = cnt[tid * 32];
    __syncthreads();
    if (tid < 32) { int s = 0; for (int e = 0; e < tid; ++e) s += tab[e]; tab[32 + tid] = s; }
    if (tid < 320) { int tiles = 0, found = -1;
        for (int e = 0; e < NEXP; ++e) { const int te = (tab[e] + 255) >> 8; if (found < 0 && tid < tiles + te) found = e | ((tid - tiles) << 8); tiles += te; }
        if (found >= 0) tab[128 + tid] = found; if (tid == 0) tab[64] = tiles; }
    __syncthreads();
}

__device__ __forceinline__ u32x4 pack8(const f32x4& a, const f32x4& b) { u32x4 w; w.x = pk2(a[0], a[1]); w.y = pk2(a[2], a[3]); w.z = pk2(b[0], b[1]); w.w = pk2(b[2], b[3]); return w; }
struct EpiBf16 { static constexpr bool AFTER_DRAIN = false; bf16_t* O; int ldc, pad;
    __device__ __forceinline__ void operator()(const f32x4 (&acc)[2][2][4][2], const GUnit& u, int wr, int wc, int fr, int fq) const {
        LAUNDER(fr); LAUNDER(fq);
#pragma unroll
        for (int ai = 0; ai < 2; ++ai)
#pragma unroll
            for (int m = 0; m < 4; ++m) { const int r = 128 * ai + 64 * wr + 16 * m + fr;
#pragma unroll
                for (int bj = 0; bj < 2; ++bj) *(u32x4*)(O + (size_t)(u.row0 + r) * ldc + u.col0 + 128 * bj + 32 * wc + 8 * fq) = pack8(acc[ai][bj][m][0], acc[ai][bj][m][1]); } } };
__device__ __forceinline__ float row_rstd(const float* __restrict__ ssp, int row) { const f32x4* p = (const f32x4*)(ssp + (size_t)row * 16); const f32x4 a = p[0], b = p[1], c = p[2], d = p[3];
    const float s = (((a[0] + a[1]) + (a[2] + a[3])) + ((b[0] + b[1]) + (b[2] + b[3]))) + (((c[0] + c[1]) + (c[2] + c[3])) + ((d[0] + d[1]) + (d[2] + d[3]))); return 1.0f / sqrtf(s * (1.0f / 1024.0f) + EPS); }
template <bool BASE_BF16> struct EpiResidSS { static constexpr bool AFTER_DRAIN = false; const void* base; bf16_t* xb; float* ss; unsigned char* xq;
    __device__ __forceinline__ void operator()(const f32x4 (&acc)[2][2][4][2], const GUnit& u, int wr, int wc, int fr, int fq) const {
        LAUNDER(fr); LAUNDER(fq);
#pragma unroll
        for (int ai = 0; ai < 2; ++ai) {
            f32x4 b[4][2][2];
#pragma unroll
            for (int m = 0; m < 4; ++m)
#pragma unroll
                for (int bj = 0; bj < 2; ++bj) { const size_t o = (size_t)(u.row0 + 128 * ai + 64 * wr + 16 * m + fr) * 1024 + u.col0 + 128 * bj + 32 * wc + 8 * fq;
                    if (BASE_BF16) { const u32x4 w = *(const u32x4*)((const bf16_t*)base + o); b[m][bj][0] = (f32x4){bflo(w.x), bfhi(w.x), bflo(w.y), bfhi(w.y)}; b[m][bj][1] = (f32x4){bflo(w.z), bfhi(w.z), bflo(w.w), bfhi(w.w)}; }
                    else { b[m][bj][0] = *(const f32x4*)((const float*)base + o); b[m][bj][1] = *(const f32x4*)((const float*)base + o + 4); } }
#pragma unroll
            for (int m = 0; m < 4; ++m) { const int r = 128 * ai + 64 * wr + 16 * m + fr; float part = 0.f;
#pragma unroll
                for (int bj = 0; bj < 2; ++bj) { const size_t o = (size_t)(u.row0 + r) * 1024 + u.col0 + 128 * bj + 32 * wc + 8 * fq;
                    const f32x4 y0 = b[m][bj][0] + acc[ai][bj][m][0], y1 = b[m][bj][1] + acc[ai][bj][m][1]; *(u32x4*)(xb + o) = pack8(y0, y1);
                    if (xq) { u32x2 q; q.x = pk4_fp8(y0[0], y0[1], y0[2], y0[3]); q.y = pk4_fp8(y1[0], y1[1], y1[2], y1[3]); *(u32x2*)(xq + o) = q; }
                    part += (y0[0] * y0[0] + y0[1] * y0[1] + y0[2] * y0[2] + y0[3] * y0[3]) + (y1[0] * y1[0] + y1[1] * y1[1] + y1[2] * y1[2] + y1[3] * y1[3]); }
                part += __shfl_xor(part, 16); part += __shfl_xor(part, 32);
                if (fq == 0) ss[(size_t)(u.row0 + r) * 16 + (u.col0 >> 8) * 4 + wc] = part; } } } };
struct EpiSoftmax { static constexpr bool AFTER_DRAIN = true; const float* ss; bf16_t* P;
    __device__ __forceinline__ void operator()(const f32x4 (&)[2][2][4][2], const GUnit&, int, int, int, int) const {}
    __device__ __forceinline__ void fused(f32x4 (&acc)[2][2][4][2], const GUnit& u, int wr, int wc, int fr, int fq, unsigned char* lds, int wid, int lane) const {
        float* Pm = (float*)lds; float* Ps = (float*)(lds + 4096);
        LAUNDER(fr); LAUNDER(fq);
#pragma unroll
        for (int ai = 0; ai < 2; ++ai)
#pragma unroll
            for (int m = 0; m < 4; ++m) { const int r = 128 * ai + 64 * wr + 16 * m + fr; const float rstd = row_rstd(ss, u.row0 + r); float mv = -INFINITY;
#pragma unroll
                for (int bj = 0; bj < 2; ++bj)
#pragma unroll
                    for (int n = 0; n < 2; ++n) { f32x4 s = acc[ai][bj][m][n] * rstd; acc[ai][bj][m][n] = s; mv = fmaxf(mv, fmaxf(fmaxf(s[0], s[1]), fmaxf(s[2], s[3]))); }
                mv = fmaxf(mv, __shfl_xor(mv, 16)); mv = fmaxf(mv, __shfl_xor(mv, 32));
                if (fq == 0) Pm[r * 4 + wc] = mv; }
        __syncthreads();
#pragma unroll
        for (int ai = 0; ai < 2; ++ai)
#pragma unroll
            for (int m = 0; m < 4; ++m) { const int r = 128 * ai + 64 * wr + 16 * m + fr; const f32x4 pm = *(const f32x4*)(Pm + r * 4); const float mv = fmaxf(fmaxf(pm[0], pm[1]), fmaxf(pm[2], pm[3])); float sum = 0.f;
#pragma unroll
                for (int bj = 0; bj < 2; ++bj)
#pragma unroll
                    for (int n = 0; n < 2; ++n) { f32x4 s = acc[ai][bj][m][n]; s[0] = __builtin_amdgcn_exp2f(s[0] - mv); s[1] = __builtin_amdgcn_exp2f(s[1] - mv); s[2] = __builtin_amdgcn_exp2f(s[2] - mv); s[3] = __builtin_amdgcn_exp2f(s[3] - mv);
                        acc[ai][bj][m][n] = s; sum += (s[0] + s[1]) + (s[2] + s[3]); }
                sum += __shfl_xor(sum, 16); sum += __shfl_xor(sum, 32);
                if (fq == 0) Ps[r * 4 + wc] = sum; }
        __syncthreads();
#pragma unroll
        for (int ai = 0; ai < 2; ++ai)
#pragma unroll
            for (int m = 0; m < 4; ++m) { const int r = 128 * ai + 64 * wr + 16 * m + fr; const f32x4 ps = *(const f32x4*)(Ps + r * 4); const float inv = 1.0f / ((ps[0] + ps[1]) + (ps[2] + ps[3]));
#pragma unroll
                for (int bj = 0; bj < 2; ++bj) *(u32x4*)(P + (size_t)(u.row0 + r) * 1024 + u.col0 + 128 * bj + 32 * wc + 8 * fq) = pack8(acc[ai][bj][m][0] * inv, acc[ai][bj][m][1] * inv); }
        (void)wid; (void)lane;
        __syncthreads();
    } };
struct EpiGU { static constexpr bool AFTER_DRAIN = false; const float* bgu; unsigned char* act  ; const float* lrs  ;
    __device__ __forceinline__ void operator()(const f32x4 (&acc)[2][2][4][2], const GUnit& u, int wr, int wc, int fr, int fq) const {
        const int pn = u.col0 >> 8; const float* bg = bgu + (size_t)u.e * 2048; LAUNDER(fr); LAUNDER(fq);
        float rs[8];
#pragma unroll
        for (int i = 0; i < 8; ++i) { const int r = 128 * (i >> 2) + 64 * wr + 16 * (i & 3) + fr; rs[i] = lrs[(size_t)u.e * NTOK + u.aux + (r < u.valid ? r : 0)]; }
        const int col = 128 * pn + 32 * wc + 8 * fq;
        f32x4 bgv[2], blv[2];
#pragma unroll
        for (int n = 0; n < 2; ++n) { bgv[n] = *(const f32x4*)(bg + col + 4 * n); blv[n] = *(const f32x4*)(bg + 1024 + col + 4 * n); }
#pragma unroll
        for (int ai = 0; ai < 2; ++ai)
#pragma unroll
            for (int m = 0; m < 4; ++m) { const int r = 128 * ai + 64 * wr + 16 * m + fr; const float rstd = rs[ai * 4 + m]; u32x2 q;
#pragma unroll
                for (int n = 0; n < 2; ++n) { const f32x4 g = acc[ai][0][m][n] * rstd + bgv[n], l = acc[ai][1][m][n] * rstd + blv[n]; float o[4];
#pragma unroll
                    for (int j = 0; j < 4; ++j) { const float gg = fminf(g[j], 7.0f), ll = fminf(fmaxf(l[j], -7.0f), 7.0f); o[j] = (ll + 1.0f) * (gg * __builtin_amdgcn_rcpf(1.0f + __builtin_amdgcn_exp2f(-1.702f * LOG2E * gg))); }
                    const unsigned w = pk4_fp8(o[0], o[1], o[2], o[3]); if (n == 0) q.x = w; else q.y = w; }
                if (r < u.valid) *(u32x2*)(act + (size_t)(u.row0 + r) * 1024 + col) = q; } } };
struct EpiDown { static constexpr bool AFTER_DRAIN = false; const float* bdn; unsigned char* ys  ;
    __device__ __forceinline__ void operator()(const f32x4 (&acc)[2][2][4][2], const GUnit& u, int wr, int wc, int fr, int fq) const {
        const float* bd = bdn + (size_t)u.e * 1024; LAUNDER(fr); LAUNDER(fq);
        f32x4 bv[2][2];
#pragma unroll
        for (int bj = 0; bj < 2; ++bj)
#pragma unroll
            for (int n = 0; n < 2; ++n) bv[bj][n] = *(const f32x4*)(bd + u.col0 + 128 * bj + 32 * wc + 8 * fq + 4 * n);
#pragma unroll
        for (int ai = 0; ai < 2; ++ai)
#pragma unroll
            for (int m = 0; m < 4; ++m) { const int r = 128 * ai + 64 * wr + 16 * m + fr; if (r < u.valid) {
#pragma unroll
                for (int bj = 0; bj < 2; ++bj) { const f32x4 y0 = acc[ai][bj][m][0] + bv[bj][0], y1 = acc[ai][bj][m][1] + bv[bj][1]; u32x2 q; q.x = pk4_fp8(y0[0], y0[1], y0[2], y0[3]); q.y = pk4_fp8(y1[0], y1[1], y1[2], y1[3]);
                    *(u32x2*)(ys + (size_t)(u.row0 + r) * 1024 + u.col0 + 128 * bj + 32 * wc + 8 * fq) = q; } } } } };


typedef float f32x16 __attribute__((ext_vector_type(16)));
typedef short s16x4 __attribute__((ext_vector_type(4)));
__device__ __forceinline__ int crow(int r, int hi) { return (r & 3) + 8 * (r >> 2) + 4 * hi; }
__device__ __forceinline__ s16x4 tr_read(const unsigned char* p) { return __builtin_bit_cast(s16x4, __builtin_amdgcn_ds_read_tr16_b64_v4i16((LDSP s16x4*)(unsigned)(uintptr_t)p)); }
__device__ __forceinline__ bf16x8 tr_frag(const unsigned char* img, int pitch, int k0, int f0, int lane) {
    const unsigned char* p = img + (k0 + 8 * (lane >> 5) + ((lane & 15) >> 2)) * pitch + (f0 + 16 * ((lane >> 4) & 1) + 4 * (lane & 3)) * 2;
    const s16x4 lo = tr_read(p), hi = tr_read(p + 4 * pitch);
    return (bf16x8){lo[0], lo[1], lo[2], lo[3], hi[0], hi[1], hi[2], hi[3]};
}
constexpr int GA_PK = 576, GA_PV = 1088;
constexpr int GA_V = 0, GA_PART = 0, GA_GLR = 69632, GA_TOT = 73728, GA_KD = 75776, GA_END = GA_KD + 64 * GA_PK;
__device__ __forceinline__ void gla_pass_a(unsigned char* lds, int task, const bf16_t* __restrict__ xn, const bf16_t* __restrict__ wglr  , const bf16_t* __restrict__ proj,
                                           const float* __restrict__ wg, const float* __restrict__ bg, float* __restrict__ UT, float* __restrict__ decay) {
    int tid = threadIdx.x; LAUNDER(tid); int wid = tid >> 6, lane = tid & 63, fr = lane & 15, fq = lane >> 4;
    const size_t t0 = (size_t)task * 64;
    { f32x4 acc[4];
#pragma unroll
      for (int m = 0; m < 4; ++m) acc[m] = (f32x4){0.f, 0.f, 0.f, 0.f};
#pragma unroll
      for (int ks = 0; ks < 4; ++ks) { const int k = 128 * wid + 32 * ks + 8 * fq; const bf16x8 bfr = *(const bf16x8*)(wglr + (size_t)fr * 1024 + k);
#pragma unroll
          for (int m = 0; m < 4; ++m) { const bf16x8 afr = *(const bf16x8*)(xn + (t0 + 16 * m + fr) * DM + k); acc[m] = __builtin_amdgcn_mfma_f32_16x16x32_bf16(afr, bfr, acc[m], 0, 0, 0); } }
      float* part = (float*)(lds + GA_PART) + wid * 1024;
#pragma unroll
      for (int m = 0; m < 4; ++m)
#pragma unroll
          for (int j = 0; j < 4; ++j) part[(16 * m + 4 * fq + j) * 16 + fr] = acc[m][j]; }
    __syncthreads();
    { float* glr = (float*)(lds + GA_GLR); const float* part = (const float*)(lds + GA_PART);
      for (int i = tid; i < 1024; i += 512) { float s = 0.f;
#pragma unroll
          for (int w = 0; w < 8; ++w) s += part[w * 1024 + i];
          glr[i] = s; } }
    __syncthreads();
    LAUNDER(tid);
    { const int cv = tid & 63, tk = tid >> 6;
#pragma unroll
      for (int i = 0; i < 8; ++i) { const int tok = tk + 8 * i; const u32x4 v = *(const u32x4*)(proj + (t0 + tok) * PROJ_LD + C_VG + cv * 8); *(u32x4*)(lds + GA_V + tok * GA_PV + cv * 16) = v; } }
    LAUNDER(tid);
    { const int j = tid & 255, half = tid >> 8; const float* glr = (const float*)(lds + GA_GLR); float* tot = (float*)(lds + GA_TOT);
      float w[16];
#pragma unroll
      for (int i = 0; i < 16; ++i) w[i] = wg[i * 256 + j];
      const float bj = bg[j]; float run = 0.f;
      bf16_t kk16[32];
#pragma unroll
      for (int s = 0; s < 32; ++s) kk16[s] = proj[(t0 + 32 * half + s) * PROJ_LD + C_KG + j];
#pragma unroll 2
      for (int s = 0; s < 32; ++s) { const float* gl = glr + (32 * half + s) * 16; float u = bj;
#pragma unroll
          for (int i = 0; i < 16; ++i) u += gl[i] * w[i];
          const float ls = fminf(u, 0.f) - __logf(1.0f + __expf(-fabsf(u)));
          run += ls * (1.0f / 16.0f); }
      tot[half * 256 + j] = run;
      __syncthreads();
      const float t0v = tot[j], t1v = tot[256 + j]; const float gend = t0v + t1v;
      if (half == 0) decay[(size_t)task * 256 + j] = __expf(gend);
      run = half ? t0v : 0.f;
#pragma unroll
      for (int s = 0; s < 32; ++s) { const int tok = 32 * half + s; const float* gl = glr + tok * 16; float u = bj;
#pragma unroll
          for (int i = 0; i < 16; ++i) u += gl[i] * w[i];
          const float ls = fminf(u, 0.f) - __logf(1.0f + __expf(-fabsf(u)));
          run += ls * (1.0f / 16.0f);
          const float kk = bf2f(kk16[s]);
          *(bf16_t*)(lds + GA_KD + tok * GA_PK + j * 2) = (bf16_t)f2bf(kk * __expf(gend - run)); } }
    __syncthreads();
    LAUNDER(tid); wid = __builtin_amdgcn_readfirstlane(tid >> 6); lane = tid & 63;
    { const int h = wid >> 1, nt = wid & 1, hi = lane >> 5, c32 = lane & 31; f32x16 acc[4];
#pragma unroll
      for (int m = 0; m < 4; ++m)
#pragma unroll
          for (int r = 0; r < 16; ++r) acc[m][r] = 0.f;
#pragma unroll
      for (int ks = 0; ks < 4; ++ks) { const bf16x8 bfr = tr_frag(lds + GA_KD, GA_PK, 16 * ks, h * 64 + 32 * nt, lane);
#pragma unroll
          for (int m = 0; m < 4; ++m) { const bf16x8 afr = tr_frag(lds + GA_V, GA_PV, 16 * ks, h * 128 + 32 * m, lane); acc[m] = __builtin_amdgcn_mfma_f32_32x32x16_bf16(afr, bfr, acc[m], 0, 0, 0); } }
      float* u = UT + ((size_t)task * 4 + h) * 8192;
#pragma unroll
      for (int m = 0; m < 4; ++m)
#pragma unroll
          for (int r = 0; r < 16; ++r) u[(32 * m + crow(r, hi)) * 64 + 32 * nt + c32] = acc[m][r]; }
    __syncthreads();
}
__device__ __forceinline__ void gla_pass_b(int e, const float* __restrict__ UT, const float* __restrict__ decay, bf16_t* __restrict__ ST) {
    const int dk = e & 63, dv = (e >> 6) & 127, h = (e >> 13) & 3, b = e >> 15; float s = 0.f;
    const size_t base = ((size_t)b * 128 * 4 + h) * 8192 + dv * 64 + dk; const size_t dbase = (size_t)b * 128 * 256 + h * 64 + dk;
    for (int c0 = 0; c0 < 128; c0 += 32) { float u[32], d[32];
#pragma unroll
        for (int i = 0; i < 32; ++i) { u[i] = UT[base + (size_t)(c0 + i) * 4 * 8192]; d[i] = decay[dbase + (size_t)(c0 + i) * 256]; }
#pragma unroll
        for (int i = 0; i < 32; ++i) { s = d[i] * s + u[i]; ST[base + (size_t)(c0 + i) * 4 * 8192] = (bf16_t)f2bf(s); } }
}
constexpr int GC_PITCH = 520;
__device__ __forceinline__ void gla_pass_c(unsigned char* wlds  , int wtask, const bf16_t* __restrict__ ST, const bf16_t* __restrict__ proj, const float* __restrict__ ghead, bf16_t* __restrict__ mix, int lane) {
    const int nh = wtask & 1, h = (wtask >> 1) & 3, bc = wtask >> 3; const int c32 = lane & 31, hi = lane >> 5;
    const size_t t0 = (size_t)bc * 64 + 32 * nh; const bf16_t* st = ST + ((size_t)bc * 4 + h) * 8192;
    f32x16 acc[4];
#pragma unroll
    for (int m = 0; m < 4; ++m)
#pragma unroll
        for (int r = 0; r < 16; ++r) acc[m][r] = 0.f;
#pragma unroll
    for (int ks = 0; ks < 4; ++ks) { const bf16x8 bfr = *(const bf16x8*)(proj + (t0 + c32) * PROJ_LD + C_QG + h * 64 + 16 * ks + 8 * hi);
#pragma unroll
        for (int m = 0; m < 4; ++m) { const bf16x8 afr = *(const bf16x8*)(st + (32 * m + c32) * 64 + 16 * ks + 8 * hi); acc[m] = __builtin_amdgcn_mfma_f32_32x32x16_bf16(afr, bfr, acc[m], 0, 0, 0); } }
    float ss = 0.f;
#pragma unroll
    for (int m = 0; m < 4; ++m)
#pragma unroll
        for (int r = 0; r < 16; ++r) ss += acc[m][r] * acc[m][r];
    ss += __shfl_xor(ss, 32);
    const float rstd = 1.0f / sqrtf(ss * (1.0f / 128.0f) + EPS);
#pragma unroll
    for (int m = 0; m < 4; ++m)
#pragma unroll
        for (int r = 0; r < 16; ++r) *(float*)(wlds + c32 * GC_PITCH + (32 * m + crow(r, hi)) * 4) = acc[m][r] * rstd;
#pragma unroll
    for (int i = 0; i < 8; ++i) { const int q = lane + 64 * i, tok = q >> 4, dv0 = (q & 15) * 8; const float* src = (const float*)(wlds + tok * GC_PITCH + dv0 * 4);
        const u32x4 rgw = *(const u32x4*)(proj + (t0 + tok) * PROJ_LD + C_RG + h * 128 + dv0); const f32x4 g0 = *(const f32x4*)(ghead + dv0), g1 = *(const f32x4*)(ghead + dv0 + 4);
        const float rg[8] = {bflo(rgw.x), bfhi(rgw.x), bflo(rgw.y), bfhi(rgw.y), bflo(rgw.z), bfhi(rgw.z), bflo(rgw.w), bfhi(rgw.w)}; const float gg[8] = {g0.x, g0.y, g0.z, g0.w, g1.x, g1.y, g1.z, g1.w}; float y[8];
#pragma unroll
        for (int k = 0; k < 8; ++k) y[k] = src[k] * gg[k] * (rg[k] / (1.0f + __expf(-rg[k])));
        u32x4 o; o.x = pk2(y[0], y[1]); o.y = pk2(y[2], y[3]); o.z = pk2(y[4], y[5]); o.w = pk2(y[6], y[7]);
        *(u32x4*)(mix + (t0 + tok) * 1024 + h * 128 + dv0) = o; }
}
__device__ __forceinline__ void sb_task(unsigned char* vl  , int wtask, const bf16_t* __restrict__ proj, bf16_t* __restrict__ mix, int lane) {
    const int qt = wtask & 255, h = (wtask >> 8) & 7, b = wtask >> 11; const int c = lane & 31, hi = lane >> 5;
    const int t0 = qt * 32; const size_t rowb = (size_t)b * SEQ;
    bf16x8 qf[4];
#pragma unroll
    for (int d0 = 0; d0 < 4; ++d0) qf[d0] = *(const bf16x8*)(proj + (rowb + t0 + c) * PROJ_LD + C_QS + h * 64 + 16 * d0 + 8 * hi);
    const int kap = 16 * ((c >> 2) & 1) + (c & 3) + 4 * (c >> 3);
    f32x16 o0, o1;
#pragma unroll
    for (int r = 0; r < 16; ++r) { o0[r] = 0.f; o1[r] = 0.f; }
    float Dc = 1.0f;
    const bf16_t* kbase = proj + rowb * PROJ_LD + C_KS + h * 64 + 8 * hi + (size_t)kap * PROJ_LD;
    const bf16_t* vbase = proj + rowb * PROJ_LD + C_VS + h * 64 + (lane & 7) * 8 + (size_t)(lane >> 3) * PROJ_LD;
    bf16x8 kf[4]; u32x4 vr[4];
#pragma unroll
    for (int d0 = 0; d0 < 4; ++d0) kf[d0] = *(const bf16x8*)(kbase + (size_t)t0 * PROJ_LD + 16 * d0);
#pragma unroll
    for (int i = 0; i < 4; ++i) vr[i] = *(const u32x4*)(vbase + (size_t)(t0 + 8 * i) * PROJ_LD);
    for (int j0 = t0; j0 >= 0; j0 -= 32) {
#pragma unroll
        for (int i = 0; i < 4; ++i) { const int key = (lane >> 3) + 8 * i, ch = lane & 7; *(u32x4*)(vl + (ch >> 2) * 2048 + key * 64 + (ch & 3) * 16) = vr[i]; }
        f32x16 z;
#pragma unroll
        for (int r = 0; r < 16; ++r) z[r] = 0.f;
#pragma unroll
        for (int d0 = 0; d0 < 4; ++d0) z = __builtin_amdgcn_mfma_f32_32x32x16_bf16(kf[d0], qf[d0], z, 0, 0, 0);
        asm volatile("" ::: "memory");
        { const int jn = (j0 >= 32) ? j0 - 32 : j0;
#pragma unroll
          for (int d0 = 0; d0 < 4; ++d0) kf[d0] = *(const bf16x8*)(kbase + (size_t)jn * PROJ_LD + 16 * d0);
#pragma unroll
          for (int i = 0; i < 4; ++i) vr[i] = *(const u32x4*)(vbase + (size_t)(jn + 8 * i) * PROJ_LD); }
        asm volatile("" ::: "memory");
        float e[16], Dl[16];
        const bool diag = (j0 == t0);
#pragma unroll
        for (int r = 0; r < 16; ++r) { float ev = __builtin_amdgcn_exp2f(fminf(z[r], 126.0f)); if (diag && (16 * hi + r >= c)) ev = 0.f; e[r] = ev; }
        float D = hi ? Dc : 1.0f;
#pragma unroll
        for (int r = 15; r >= 0; --r) { D = fmaf(D, e[r], D); Dl[r] = D; }
        const float other = __shfl_xor(D, 32);
        const float mult = hi ? 1.0f : other;
        Dc = D * other;
        unsigned pw[8];
#pragma unroll
        for (int r = 0; r < 16; r += 2) { const float a0 = e[r] * __builtin_amdgcn_rcpf(Dl[r] * mult), a1 = e[r + 1] * __builtin_amdgcn_rcpf(Dl[r + 1] * mult); pw[r >> 1] = pk2(a0, a1); }
#pragma unroll
        for (int ks = 0; ks < 2; ++ks) { const bf16x8 pa = __builtin_bit_cast(bf16x8, (u32x4){pw[4 * ks], pw[4 * ks + 1], pw[4 * ks + 2], pw[4 * ks + 3]});
            const unsigned char* vb = vl + (16 * hi + 8 * ks + ((lane & 15) >> 2)) * 64 + (16 * ((lane >> 4) & 1) + 4 * (lane & 3)) * 2;
            { const s16x4 lo = tr_read(vb), hh = tr_read(vb + 256); o0 = __builtin_amdgcn_mfma_f32_32x32x16_bf16(pa, (bf16x8){lo[0], lo[1], lo[2], lo[3], hh[0], hh[1], hh[2], hh[3]}, o0, 0, 0, 0); }
            { const s16x4 lo = tr_read(vb + 2048), hh = tr_read(vb + 2048 + 256); o1 = __builtin_amdgcn_mfma_f32_32x32x16_bf16(pa, (bf16x8){lo[0], lo[1], lo[2], lo[3], hh[0], hh[1], hh[2], hh[3]}, o1, 0, 0, 0); } }
        if (__all(!(Dc < 3.0e38f))) break;
    }
    bf16_t* ob = mix + (rowb + t0) * 1024 + 512 + h * 64 + c;
#pragma unroll
    for (int r = 0; r < 16; ++r) { const int q = crow(r, hi); ob[(size_t)q * 1024] = (bf16_t)f2bf(o0[r]); ob[(size_t)q * 1024 + 32] = (bf16_t)f2bf(o1[r]); }
}
__device__ __forceinline__ void memkv_task(int wtask, int lane, const bf16_t* __restrict__ memn, const bf16_t* __restrict__ wkv, bf16_t* __restrict__ kv) {
    const int tm = wtask >> 6, tn = wtask & 63; const int c = lane & 31, hi = lane >> 5;
    const bf16_t* ap = memn + (size_t)(tm * 32 + c) * DM + 8 * hi; const bf16_t* bp = wkv + (size_t)(tn * 32 + c) * DM + 8 * hi;
    f32x16 acc;
#pragma unroll
    for (int r = 0; r < 16; ++r) acc[r] = 0.f;
#pragma unroll 16
    for (int ks = 0; ks < 64; ++ks) { const bf16x8 a = *(const bf16x8*)(ap + 16 * ks), b = *(const bf16x8*)(bp + 16 * ks); acc = __builtin_amdgcn_mfma_f32_32x32x16_bf16(a, b, acc, 0, 0, 0); }
    bf16_t* o = kv + (size_t)(tm * 32) * 2048 + tn * 32 + c;
#pragma unroll
    for (int r = 0; r < 16; ++r) o[(size_t)crow(r, hi) * 2048] = (bf16_t)f2bf(acc[r]);
}
__device__ __forceinline__ void router_task(int wtask, int lane, const bf16_t* __restrict__ xn, const float* __restrict__ ss, const bf16_t* __restrict__ wr, const float* __restrict__ br,
                                            int (&oe)[4], float (&ow)[4]) {
    const int c = lane & 31, hi = lane >> 5; const int t = wtask * 32 + c;
    const bf16_t* ap = wr + (size_t)c * DM + 8 * hi; const bf16_t* bp = xn + (size_t)t * DM + 8 * hi;
    f32x16 acc;
#pragma unroll
    for (int r = 0; r < 16; ++r) acc[r] = 0.f;
#pragma unroll 16
    for (int ks = 0; ks < 64; ++ks) { const bf16x8 a = *(const bf16x8*)(ap + 16 * ks), b = *(const bf16x8*)(bp + 16 * ks); acc = __builtin_amdgcn_mfma_f32_32x32x16_bf16(a, b, acc, 0, 0, 0); }
    float v[16]; const float rstd = row_rstd(ss, t);
#pragma unroll
    for (int r = 0; r < 16; ++r) v[r] = acc[r] * rstd + br[crow(r, hi)];
    float tv[4]; int ti[4];
#pragma unroll
    for (int k = 0; k < 4; ++k) { float best = -INFINITY; int bi = 64;
#pragma unroll
        for (int r = 0; r < 16; ++r) { if (v[r] > best) { best = v[r]; bi = crow(r, hi); } }
        tv[k] = best; ti[k] = bi;
#pragma unroll
        for (int r = 0; r < 16; ++r) if (crow(r, hi) == bi) v[r] = -INFINITY; }
    float cv[8]; int ci[8];
#pragma unroll
    for (int k = 0; k < 4; ++k) { cv[k] = tv[k]; ci[k] = ti[k]; cv[4 + k] = __shfl_xor(tv[k], 32); ci[4 + k] = __shfl_xor(ti[k], 32); }
#pragma unroll
    for (int k = 0; k < 4; ++k) { float best = -INFINITY; int bi = 64;
#pragma unroll
        for (int q = 0; q < 8; ++q) { if (cv[q] > best || (cv[q] == best && ci[q] < bi)) { best = cv[q]; bi = ci[q]; } }
        tv[k] = best; ti[k] = bi;
#pragma unroll
        for (int q = 0; q < 8; ++q) if (ci[q] == bi) cv[q] = -INFINITY; }
    const float e1 = __expf(tv[1] - tv[0]), e2 = __expf(tv[2] - tv[0]), e3 = __expf(tv[3] - tv[0]); const float inv = 1.0f / (1.0f + e1 + e2 + e3);
    const float g[4] = {inv, e1 * inv, e2 * inv, e3 * inv};
#pragma unroll
    for (int k = 0; k < 4; ++k) { oe[k] = ti[k]; ow[k] = g[k]; }
}
__device__ __forceinline__ void combine_task(int t, int lane, const bf16_t* xin, float* xout, const unsigned char* __restrict__ ys, const int* tab, const int* __restrict__ toke, const int* __restrict__ tokr,
                                                 const float* __restrict__ tokw, const float* __restrict__ gfin) {
    const u32x2* xr = (const u32x2*)(xin + (size_t)t * DM) + lane; f32x4* xo = (f32x4*)(xout + (size_t)t * DM) + lane; f32x4 v[4];
#pragma unroll
    for (int j = 0; j < 4; ++j) { const u32x2 w = xr[64 * j]; v[j] = (f32x4){bflo(w.x), bfhi(w.x), bflo(w.y), bfhi(w.y)}; }
    for (int k = 0; k < 4; ++k) { const int e = toke[t * 4 + k], r = tokr[t * 4 + k]; const float w = tokw[t * 4 + k]; const int start = tab[32 + e];
        const unsigned* yr = (const unsigned*)(ys + (size_t)(start + r) * DM) + lane;
#pragma unroll
        for (int j = 0; j < 4; ++j) { const int y = (int)yr[64 * j]; const f32x2 lo = __builtin_amdgcn_cvt_pk_f32_fp8(y, false), hi = __builtin_amdgcn_cvt_pk_f32_fp8(y, true);
            v[j].x += w * lo.x; v[j].y += w * lo.y; v[j].z += w * hi.x; v[j].w += w * hi.y; } }
    float s = 0.f;
#pragma unroll
    for (int j = 0; j < 4; ++j) s += v[j].x * v[j].x + v[j].y * v[j].y + v[j].z * v[j].z + v[j].w * v[j].w;
    const float rstd = 1.0f / sqrtf(wave_sum(s) * (1.f / DM) + EPS);
#pragma unroll
    for (int j = 0; j < 4; ++j) { const f32x4 g = *((const f32x4*)gfin + lane + 64 * j); xo[64 * j] = v[j] * rstd * g; }
}

#define GAS __attribute__((address_space(1)))
#define RLX_AGENT __ATOMIC_RELAXED, __HIP_MEMORY_SCOPE_AGENT
#define XB_TMO      128
#define XB_XCNT(j)  (256  + 64 * (j))
#define XB_XSUB(j)  (1280 + 64 * (j))
#define XB_XGEN(j)  (2304 + 64 * (j))
#define XB_TOP      3328
#define XB_TOPGEN   3392
#define XCD_BAR_WORDS 3456
#define XB_SPIN_CAP (1u << 18)
__device__ __forceinline__ unsigned xb_ld(unsigned* p)              { return __hip_atomic_load(p, __ATOMIC_RELAXED, __HIP_MEMORY_SCOPE_AGENT); }
__device__ __forceinline__ unsigned xb_add(unsigned* p, unsigned v) { return __hip_atomic_fetch_add(p, v, __ATOMIC_RELAXED, __HIP_MEMORY_SCOPE_AGENT); }
__device__ __forceinline__ unsigned xb_xcc_id() { return (unsigned)__builtin_amdgcn_s_getreg((3 << 11) | 20) & 0xFu; }
#define XB_SPIN(cond, bar) do { unsigned _sp = 0; while (cond) { __builtin_amdgcn_s_sleep(1); \
    if ((++_sp & 255u) == 0u) { if (xb_ld(&(bar)[XB_TMO])) break; if (_sp > XB_SPIN_CAP) { atomicAdd(&(bar)[XB_TMO], 1u); break; } } } } while (0)
struct XcdBarrier { unsigned* bar; unsigned x; volatile LDSP unsigned* st; };
__device__ __forceinline__ XcdBarrier xcd_barrier_post(unsigned* bar, volatile LDSP unsigned* st) {
    XcdBarrier b; b.bar = bar; b.x = xb_xcc_id(); b.st = st;
    if (threadIdx.x == 0) (void)xb_add(&bar[XB_XCNT(b.x)], 1u);
    return b;
}
__device__ __forceinline__ void xcd_barrier_complete(unsigned* bar, unsigned x, unsigned& nloc, unsigned& nx) {
    const unsigned G = gridDim.x * gridDim.y * gridDim.z;
    unsigned sum, cnt, mine, sp = 0u;
    for (;;) {
        sum = 0u; cnt = 0u; mine = 0u;
#pragma unroll
        for (unsigned j = 0; j < 16; ++j) { const unsigned c = xb_ld(&bar[XB_XCNT(j)]); sum += c; cnt += (c > 0u) ? 1u : 0u; mine = (j == x) ? c : mine; }
        if (sum == G) break;
        __builtin_amdgcn_s_sleep(1);
        if ((++sp & 255u) == 0u) { if (xb_ld(&bar[XB_TMO])) break; if (sp > XB_SPIN_CAP) { atomicAdd(&bar[XB_TMO], 1u); break; } }
    }
    nloc = mine > 0u ? mine : 1u; nx = cnt > 0u ? cnt : 1u;
}
__device__ __forceinline__ void xcd_barrier(const XcdBarrier& b) {
    asm volatile("s_waitcnt vmcnt(0)" ::: "memory");
    __syncthreads();
    if (threadIdx.x == 0) {
        unsigned* bar = b.bar;
        __builtin_amdgcn_s_waitcnt(0);
        unsigned nloc = b.st[0], nx = b.st[1];
        if (nloc == 0u) { xcd_barrier_complete(bar, b.x, nloc, nx); b.st[0] = nloc; b.st[1] = nx; }
        const unsigned old = xb_add(&bar[XB_XSUB(b.x)], 1u);
        const unsigned gen = old / nloc;
        if (old + 1u == (gen + 1u) * nloc) {
            __builtin_amdgcn_fence(__ATOMIC_RELEASE, "agent");
            asm volatile("s_waitcnt vmcnt(0)" ::: "memory");
            const unsigned og = xb_add(&bar[XB_TOP], 1u);
            const unsigned tg = og / nx;
            if (og + 1u == (tg + 1u) * nx) xb_add(&bar[XB_TOPGEN], 1u);
            else XB_SPIN(xb_ld(&bar[XB_TOPGEN]) == tg, bar);
            __builtin_amdgcn_fence(__ATOMIC_ACQUIRE, "agent");
            xb_add(&bar[XB_XGEN(b.x)], 1u);
            asm volatile("s_waitcnt vmcnt(0)" ::: "memory");
        } else {
            XB_SPIN(xb_ld(&bar[XB_XGEN(b.x)]) == gen, bar);
            __builtin_amdgcn_fence(__ATOMIC_ACQUIRE, "agent");
            asm volatile("s_waitcnt vmcnt(0)" ::: "memory");
        }
    }
    __syncthreads();
}

constexpr int LDS_BYTES = 147456;
constexpr int MISC_OFF = LDS_BYTES - 512;
constexpr int CW_BAR = 4096;
constexpr size_t CTL_ZERO_BYTES = 65536;
constexpr int NPHASE = 12;
struct Args { const float* in[22]; float* out; unsigned char* ws; int ph_lo, ph_hi; };

__global__ void __launch_bounds__(512, 2) mega(Args a) {
    extern __shared__ __attribute__((aligned(16))) unsigned char lds[];
    unsigned char* ws = a.ws; float* out = a.out;
    const float* x = a.in[0]; const float* mem = a.in[1]; const float* g_mix = a.in[2]; const float* w_in = a.in[3];
    const float* w_gla_gate = a.in[4]; const float* b_gla_gate = a.in[5]; const float* g_gla_head = a.in[6]; const float* w_out = a.in[7];
    const float* g_mem_q = a.in[8]; const float* g_mem_kv = a.in[9]; const float* w_mq = a.in[10]; const float* w_mk = a.in[11];
    const float* w_mv = a.in[12]; const float* w_mo = a.in[13]; const float* g_ffn = a.in[14]; const float* w_router = a.in[15];
    const float* b_router = a.in[16]; const float* w_gu = a.in[17]; const float* b_gu = a.in[18]; const float* w_down = a.in[19];
    const float* b_down = a.in[20]; const float* g_final = a.in[21];
    bf16_t* Wt_in = (bf16_t*)(ws + WS_WIN); bf16_t* Wt_out = (bf16_t*)(ws + WS_WOUT); bf16_t* Wq = (bf16_t*)(ws + WS_WQ); bf16_t* Wt_kv = (bf16_t*)(ws + WS_WKV);
    bf16_t* Wt_mo = (bf16_t*)(ws + WS_WMO); bf16_t* Wt_r = (bf16_t*)(ws + WS_WR); bf16_t* Wt_gu = (bf16_t*)(ws + WS_WGU); bf16_t* Wt_dn = (bf16_t*)(ws + WS_WDN);
    bf16_t* xn = (bf16_t*)(ws + WS_XN); bf16_t* memn = (bf16_t*)(ws + WS_MEMN); bf16_t* kv = (bf16_t*)(ws + WS_KV); bf16_t* Bs = (bf16_t*)(ws + WS_BS); bf16_t* Bo = (bf16_t*)(ws + WS_BO);
    bf16_t* proj = (bf16_t*)(ws + WS_PROJ); bf16_t* mix = (bf16_t*)(ws + WS_MIX);
    float* Sc = (float*)(ws + WS_S); bf16_t* P = (bf16_t*)(ws + WS_P); float* lg = (float*)(ws + WS_LG); int* toke = (int*)(ws + WS_TOKE); int* tokr = (int*)(ws + WS_TOKR);
    float* tokw = (float*)(ws + WS_TOKW); int* list = (int*)(ws + WS_LIST); unsigned char* ys = ws + WS_YS;
    unsigned char* Wq_gu = ws + WS_WGU; unsigned char* Wq_dn = ws + WS_WDN; unsigned char* x2q = ws + WS_S; unsigned char* act8 = ws + WS_ACT;
    float* lrs = (float*)(ws + WS_LG);
    float* UT = (float*)(ws + WS_S); float* decay = (float*)(ws + WS_LA); bf16_t* ST = (bf16_t*)(ws + WS_ORAW);
    unsigned* ctl = (unsigned*)(ws + WS_CTL); int* cnt = (int*)ctl + CW_CNT; float* ss1 = (float*)(ws + WS_LA + 8 * MiB); float* ss2 = (float*)(ws + WS_LA + 9 * MiB);

    const int G = gridDim.x, vb = blockIdx.x;
    volatile LDSP unsigned* MISC = (volatile LDSP unsigned*)(unsigned)(uintptr_t)(lds + MISC_OFF);
    if (threadIdx.x < 128) MISC[threadIdx.x] = 0u;
    __syncthreads();
    XcdBarrier bar = xcd_barrier_post(ctl + CW_BAR, MISC + 8);
    const int lo = a.ph_lo, hi = a.ph_hi;
    float* dmy = (float*)(ws + WS_DUMMY); (void)dmy;
#ifndef REPEAT_MASK
#define REPEAT_MASK 0
#endif
#define IN(k) (lo <= (k) && (k) < hi)
#define REP(k) for (int rep_ = 0; rep_ < 1 + ((REPEAT_MASK >> (k)) & 1); ++rep_)
#define SEAM(k) do { if (IN(k) && IN((k) + 1)) xcd_barrier(bar); } while (0)
#define TIDS() int tid = threadIdx.x; LAUNDER(tid); const int lane = tid & 63; const int wid = __builtin_amdgcn_readfirstlane(tid >> 6); (void)lane; (void)wid

    if (IN(0)) REP(0) { TIDS(); const size_t gt = (size_t)vb * 512 + tid, gs = (size_t)G * 512;
        float* scr = (float*)(lds + wid * 8448);
        const int gw = vb * 8 + wid, ngw = G * 8;
        rms_body(gw, ngw, lane, x, xn, NTOK);
        rms_body(gw, ngw, lane, mem, memn, NB * MEML);
        conv_n_body(gt, gs, w_mq, Wq, g_mem_q, 1024, 1024, LOG2E / 16.0f);
        constexpr int I_IN = 16 * 97, I_SQ = 16 * 32, I_R = 16, I_GU = 32 * 16 * 64, I_DN = 32 * 16 * 32;
        constexpr int NITEMS = I_IN + 4 * I_SQ + I_R + I_GU + I_DN;
        for (int it = gw; it < NITEMS; it += ngw) { int r = it;
            if (r < I_IN) { conv_item<1>(scr, w_in, Wt_in, g_mix, 3088, 1024, 3088, r / 97, r % 97, lane); continue; } r -= I_IN;
            if (r < I_SQ) { conv_item<0>(scr, w_out, Wt_out, nullptr, 1024, 1024, 1024, r >> 5, r & 31, lane); continue; } r -= I_SQ;
            if (r < I_SQ) { conv_item<0>(scr, w_mk, Wt_kv, g_mem_kv, 1024, 1024, 1024, r >> 5, r & 31, lane); continue; } r -= I_SQ;
            if (r < I_SQ) { conv_item<0>(scr, w_mv, Wt_kv + (size_t)1024 * 1024, g_mem_kv, 1024, 1024, 1024, r >> 5, r & 31, lane); continue; } r -= I_SQ;
            if (r < I_SQ) { conv_item<0>(scr, w_mo, Wt_mo, nullptr, 1024, 1024, 1024, r >> 5, r & 31, lane); continue; } r -= I_SQ;
            if (r < I_R) { conv_item<0>(scr, w_router, Wt_r, g_ffn, 32, 1024, 32, r, 0, lane); continue; } r -= I_R;
            if (r < I_GU) { const int e = r >> 10, q = r & 1023; conv_item8<2>(scr, w_gu + (size_t)e * 1024 * 2048, Wq_gu + (size_t)e * 2048 * 1024, g_ffn, 2048, 1024, 2048, q >> 6, q & 63, lane, (float)(1 << WSCALE_LOG2)); continue; } r -= I_GU;
            { const int e = r >> 9, q = r & 511; conv_item8<0>(scr, w_down + (size_t)e * 1024 * 1024, Wq_dn + (size_t)e * 1024 * 1024, nullptr, 1024, 1024, 1024, q >> 5, q & 31, lane, (float)(1 << WSCALE_LOG2)); } }
        __syncthreads(); }
    SEAM(0);
    if (IN(1)) REP(1) { DenseSched S{(const char*)xn, (const char*)Wt_in, 2048u, 2048u, 1024, 64, 12, 1 << 30, 0, G, vb}; EpiBf16 E{proj, PROJ_LD, 0}; gemm_run<true>(lds, S, E); }
    SEAM(1);
    if (IN(2)) REP(2) {
        for (int t = vb; t < 256; t += G) gla_pass_a(lds, t, xn, Wt_in + (size_t)3072 * 1024, proj, w_gla_gate, b_gla_gate, UT, decay);
        { TIDS(); for (int t = vb * 8 + wid; t < 4096; t += G * 8) sb_task(lds + wid * 4096, t, proj, mix, lane); }
        { TIDS(); for (int t = vb + G * wid; t < 1024; t += G * 8) memkv_task(t, lane, memn, Wt_kv, kv); } }
    SEAM(2);
    if (IN(3)) REP(3) {
        { TIDS(); for (int e = vb * 512 + tid; e < 65536; e += G * 512) gla_pass_b(e, UT, decay, ST); }
        { SchedWqk S{(const char*)kv, (const char*)Wq, 4096u, 2048u, 256, G / 2, vb - G / 2, 0}; EpiBf16 E{Bs, 1024, 0}; gemm_run<false>(lds, S, E); }
        { SchedVo S{(const char*)Wt_mo, (const char*)kv, 2048u, 4096u, 256, G / 2, vb - G / 2 - 32, 0}; EpiBf16 E{Bo, 1024, 0}; gemm_run<false>(lds, S, E); } }
    SEAM(3);
    if (IN(4)) REP(4) { TIDS(); for (int t = vb * 8 + wid; t < 2048; t += G * 8) gla_pass_c(lds + wid * 32 * GC_PITCH, t, ST, proj, g_gla_head, mix, lane); }
    SEAM(4);
#if PROBE_BARRIERS
    for (int pb_ = 0; pb_ < 8; ++pb_) xcd_barrier(bar);
#endif
    if (IN(5)) REP(5) { DenseSched S{(const char*)mix, (const char*)Wt_out, 2048u, 2048u, 1024, 64, 4, 1 << 30, 0, G, vb}; EpiResidSS<false> E{x, rep_ ? (bf16_t*)dmy : xn, rep_ ? dmy + 16 * 1024 * 1024 : ss1, nullptr}; gemm_run<false>(lds, S, E); }
    SEAM(5);
    if (IN(6)) REP(6) { DenseSched S{(const char*)xn, (const char*)Bs, 2048u, 2048u, 1024, 64, 4, 32, (size_t)1024 * 2048, G, vb}; EpiSoftmax E{ss1, P}; gemm_run<false>(lds, S, E); }
    SEAM(6);
    if (IN(7)) REP(7) { DenseSched S{(const char*)P, (const char*)Bo, 2048u, 2048u, 1024, 64, 4, 32, (size_t)1024 * 2048, G, vb}; EpiResidSS<true> E{xn, rep_ ? (bf16_t*)dmy : xn, rep_ ? dmy + 16 * 1024 * 1024 : ss2, rep_ ? (unsigned char*)dmy + 40 * 1024 * 1024 : x2q}; gemm_run<false>(lds, S, E); }
    SEAM(7);
    if (IN(8)) REP(8) { TIDS(); int* cntp = rep_ ? (int*)ctl + 2048 : cnt; int* listp = rep_ ? (int*)dmy + 1024 : list; float* lrsp = rep_ ? dmy + 4096 * 1024 : lrs; int* tokep = rep_ ? (int*)dmy + 1024 * 1024 : toke; int* tokrp = rep_ ? (int*)dmy + 2048 * 1024 : tokr; float* tokwp = rep_ ? dmy + 3072 * 1024 : tokw;
        int* lcnt = (int*)lds; int* gbase = (int*)lds + 32;
        for (int tb = vb; tb < NTOK / 64; tb += G) {
            if (tid < 32) lcnt[tid] = 0;
            __syncthreads();
            int oe[4] = {0, 0, 0, 0}; float ow[4] = {0.f, 0.f, 0.f, 0.f}; int lr[4] = {0, 0, 0, 0};
            if (wid < 2) { router_task(tb * 2 + wid, lane, xn, ss2, Wt_r, b_router, oe, ow);
                if (lane < 32) {
#pragma unroll
                    for (int k = 0; k < 4; ++k) lr[k] = atomicAdd(&lcnt[oe[k]], 1); } }
            __syncthreads();
            if (tid < 32) gbase[tid] = atomicAdd(&cntp[tid * 32], lcnt[tid]);
            __syncthreads();
            if (wid < 2 && lane < 32) { const int t = (tb * 2 + wid) * 32 + lane;
                const float rstd_t = row_rstd(ss2, t);
#pragma unroll
                for (int k = 0; k < 4; ++k) { const int r = gbase[oe[k]] + lr[k]; listp[oe[k] * NTOK + r] = t; lrsp[oe[k] * NTOK + r] = rstd_t; tokep[t * 4 + k] = oe[k]; tokrp[t * 4 + k] = r; tokwp[t * 4 + k] = ow[k]; } }
            __syncthreads(); } }
    SEAM(8);
    if (IN(9)) REP(9) { int* tab = (int*)(lds + 131072); { TIDS(); moe_build_table(tab, cnt, tid); }
        MoeSched<true> S{(const char*)x2q, (const char*)Wq_gu, 1024u, 1024u, 512, 8, (size_t)2048 * 1024, tab, list, 1, G, vb, 0}; EpiGU E{b_gu, act8, lrs}; gemm_run_fp8<true>(lds, S, E); }
    SEAM(9);
    if (IN(10)) REP(10) { int* tab = (int*)(lds + 131072); { TIDS(); moe_build_table(tab, cnt, tid); }
        MoeSched<false> S{(const char*)act8, (const char*)Wq_dn, 1024u, 1024u, 512, 4, (size_t)1024 * 1024, tab, list, 0, G, vb, 0}; EpiDown E{b_down, ys}; gemm_run_fp8<true>(lds, S, E); }
    SEAM(10);
    if (IN(11)) REP(11) { TIDS(); int* tab = (int*)(lds + 131072); moe_build_table(tab, cnt, tid);
        for (int t = vb * 8 + wid; t < NTOK; t += G * 8) combine_task(t, lane, xn, rep_ ? dmy : out, ys, tab, toke, tokr, tokw, g_final); }
#undef IN
#undef SEAM
#undef TIDS
}

#ifndef MK_PER_PHASE
#define MK_PER_PHASE 0
#endif
extern "C" void kernel_launch(void* const* d_in, const int* in_sizes, int n_in, void* d_out, int out_size, void* d_ws, size_t ws_size, hipStream_t stream) {
    static int grid = 0;
    if (grid == 0) {
        if (n_in != 22 || in_sizes[0] != NTOK * DM || out_size != NTOK * DM || ws_size < WS_END) { fprintf(stderr, "kernel_launch: unexpected shapes (n_in %d, ws %zu)\n", n_in, ws_size); grid = -1; return; }
        int dev = 0, cus = 0, per_cu = 0;
        if (hipGetDevice(&dev) != hipSuccess || hipDeviceGetAttribute(&cus, hipDeviceAttributeMultiprocessorCount, dev) != hipSuccess) { grid = -1; return; }
        if (hipFuncSetAttribute((const void*)mega, hipFuncAttributeMaxDynamicSharedMemorySize, LDS_BYTES) != hipSuccess) { fprintf(stderr, "kernel_launch: hipFuncSetAttribute failed\n"); grid = -1; return; }
        if (hipOccupancyMaxActiveBlocksPerMultiprocessor(&per_cu, (const void*)mega, 512, LDS_BYTES) != hipSuccess || per_cu < 1) fprintf(stderr, "kernel_launch: occupancy query says %d blocks/CU\n", per_cu);
        (void)hipGetLastError();
        grid = cus;
    }
    if (grid < 0) return;
    (void)hipMemsetAsync((char*)d_ws + WS_CTL, 0, CTL_ZERO_BYTES, stream);
    Args a{};
    for (int i = 0; i < 22; ++i) a.in[i] = (const float*)d_in[i];
    a.out = (float*)d_out; a.ws = (unsigned char*)d_ws;
#if MK_PER_PHASE
    for (int p = 0; p < NPHASE; ++p) { a.ph_lo = p; a.ph_hi = p + 1; hipLaunchKernelGGL(mega, dim3(grid), dim3(512), LDS_BYTES, stream, a); }
#else
    a.ph_lo = 0; a.ph_hi = NPHASE; hipLaunchKernelGGL(mega, dim3(grid), dim3(512), LDS_BYTES, stream, a);
#endif
}
```

```cpp
#include <hip/hip_runtime.h>
#include <cstdio>
#include <cstdint>
#ifndef PROBE_BARRIERS
#define PROBE_BARRIERS 0
#endif

typedef unsigned short bf16_t;
typedef short bf16x8 __attribute__((ext_vector_type(8)));
typedef float f32x4 __attribute__((ext_vector_type(4)));
typedef unsigned u32x4 __attribute__((ext_vector_type(4)));
typedef unsigned u32x2 __attribute__((ext_vector_type(2)));
typedef float f32x2 __attribute__((ext_vector_type(2)));
#define LDSP __attribute__((address_space(3)))
#define LAUNDER(x) asm volatile("" : "+v"(x))

constexpr int NB = 2, SEQ = 8192, NTOK = NB * SEQ, DM = 1024, MEML = 256;
constexpr int NEXP = 32, TOPK = 4, NASSIGN = NTOK * TOPK;
constexpr int PROJ_LD = 3072;
constexpr int C_QG = 0, C_KG = 256, C_VG = 512, C_RG = 1024, C_QS = 1536, C_KS = 2048, C_VS = 2560, C_GLR = 3072;
constexpr float LOG2E = 1.4426950408889634f;
constexpr float EPS = 1e-5f;

__device__ __forceinline__ unsigned f2bf(float f) { unsigned u = __float_as_uint(f); return (u + 0x7fffu + ((u >> 16) & 1u)) >> 16; }
__device__ __forceinline__ unsigned pk2(float lo, float hi) { return f2bf(lo) | (f2bf(hi) << 16); }
__device__ __forceinline__ float bf2f(bf16_t h) { return __uint_as_float(((unsigned)h) << 16); }
__device__ __forceinline__ float bflo(unsigned w) { return __uint_as_float(w << 16); }
__device__ __forceinline__ float bfhi(unsigned w) { return __uint_as_float(w & 0xffff0000u); }

constexpr size_t MiB = 1u << 20;
constexpr size_t WS_CTL = 0;
constexpr size_t WS_WIN = 1 * MiB;
constexpr size_t WS_WOUT = 8 * MiB;
constexpr size_t WS_WQ = 10 * MiB;
constexpr size_t WS_WKV = 12 * MiB;
constexpr size_t WS_WMO = 16 * MiB;
constexpr size_t WS_WR = 18 * MiB;
constexpr size_t WS_WGU = 20 * MiB;
constexpr size_t WS_WDN = 148 * MiB;
constexpr size_t WS_XN = 212 * MiB;
constexpr size_t WS_MEMN = 244 * MiB;
constexpr size_t WS_KV = 245 * MiB;
constexpr size_t WS_BS = 247 * MiB;
constexpr size_t WS_BO = 251 * MiB;
constexpr size_t WS_PROJ = 256 * MiB;
constexpr size_t WS_LA = 360 * MiB;
constexpr size_t WS_ORAW = 376 * MiB;
constexpr size_t WS_MIX = 408 * MiB;
constexpr size_t WS_S = 440 * MiB;
constexpr size_t WS_P = 504 * MiB;
constexpr size_t WS_LG = 536 * MiB;
constexpr size_t WS_TOKE = 538 * MiB;
constexpr size_t WS_TOKR = 539 * MiB;
constexpr size_t WS_TOKW = 540 * MiB;
constexpr size_t WS_LIST = 541 * MiB;
constexpr size_t WS_ACT = 544 * MiB;
constexpr size_t WS_YS = 674 * MiB;
constexpr size_t WS_DUMMY = 804 * MiB;
constexpr size_t WS_END = 872 * MiB;
constexpr int CW_CNT = 1024;

template <int MAP> __device__ __forceinline__ int srccol(int n, float& sc) {
    sc = 1.f;
    if (MAP == 0) return n;
    if (MAP == 1) {
        if (n < 256) { sc = 0.125f; return n; }
        if (n < 1024) return n;
        if (n < 3072) { if (n >= C_QS && n < C_KS) sc = 0.125f * LOG2E; return n + 16; }
        if (n < 3088) return 1024 + (n - 3072);
        return -1;
    }
    { const int ct = n >> 8, w = n & 255; return (w < 128) ? (128 * ct + w) : (1024 + 128 * ct + (w - 128)); }
}
template <int MAP>
__device__ __forceinline__ void conv_item(float* scr, const float* __restrict__ src, bf16_t* __restrict__ dst, const float* __restrict__ gain, int ldsrc, int K, int nrows, int kb, int nb, int lane) {
    const int k0 = kb * 64, n0 = nb * 32; float sc; const int c0 = srccol<MAP>(n0, sc);
    const int half = lane >> 5, l31 = lane & 31;
    const float* s0 = src + (size_t)(k0 + half) * ldsrc + c0 + l31;
    float v[32];
#pragma unroll
    for (int i = 0; i < 32; ++i) v[i] = s0[(size_t)(2 * i) * ldsrc];
#pragma unroll
    for (int i = 0; i < 32; ++i) { const int kk = 2 * i + half; const float g = (gain ? gain[k0 + kk] : 1.f) * sc; scr[kk * 33 + l31] = v[i] * g; }
    asm volatile("s_waitcnt lgkmcnt(0)" ::: "memory");
    const int c = lane & 7;
#pragma unroll
    for (int j = 0; j < 4; ++j) { const int n = (lane >> 3) + 8 * j; const float* s = scr + (8 * c) * 33 + n;
        u32x4 o; o.x = pk2(s[0 * 33], s[1 * 33]); o.y = pk2(s[2 * 33], s[3 * 33]); o.z = pk2(s[4 * 33], s[5 * 33]); o.w = pk2(s[6 * 33], s[7 * 33]);
        if (n0 + n < nrows) *(u32x4*)(dst + (size_t)(n0 + n) * K + k0 + 8 * c) = o; }
    asm volatile("s_waitcnt lgkmcnt(0)" ::: "memory");
}
__device__ __forceinline__ unsigned pk4_fp8(float a, float b, float c, float d) { int w = __builtin_amdgcn_cvt_pk_fp8_f32(a, b, 0, false); w = __builtin_amdgcn_cvt_pk_fp8_f32(c, d, w, true); return (unsigned)w; }
template <int MAP>
__device__ __forceinline__ void conv_item8(float* scr, const float* __restrict__ src, unsigned char* __restrict__ dst, const float* __restrict__ gain, int ldsrc, int K, int nrows, int kb, int nb, int lane, float mul) {
    const int k0 = kb * 64, n0 = nb * 32; float sc; const int c0 = srccol<MAP>(n0, sc); sc *= mul;
    const int half = lane >> 5, l31 = lane & 31;
    const float* s0 = src + (size_t)(k0 + half) * ldsrc + c0 + l31;
    float v[32];
#pragma unroll
    for (int i = 0; i < 32; ++i) v[i] = s0[(size_t)(2 * i) * ldsrc];
#pragma unroll
    for (int i = 0; i < 32; ++i) { const int kk = 2 * i + half; const float g = (gain ? gain[k0 + kk] : 1.f) * sc; scr[kk * 33 + l31] = v[i] * g; }
    asm volatile("s_waitcnt lgkmcnt(0)" ::: "memory");
    const int c = lane & 3;
#pragma unroll
    for (int j = 0; j < 2; ++j) { const int n = (lane >> 2) + 16 * j; const float* s = scr + (16 * c) * 33 + n;
        u32x4 o; o.x = pk4_fp8(s[0 * 33], s[1 * 33], s[2 * 33], s[3 * 33]); o.y = pk4_fp8(s[4 * 33], s[5 * 33], s[6 * 33], s[7 * 33]);
        o.z = pk4_fp8(s[8 * 33], s[9 * 33], s[10 * 33], s[11 * 33]); o.w = pk4_fp8(s[12 * 33], s[13 * 33], s[14 * 33], s[15 * 33]);
        if (n0 + n < nrows) *(u32x4*)(dst + (size_t)(n0 + n) * K + k0 + 16 * c) = o; }
    asm volatile("s_waitcnt lgkmcnt(0)" ::: "memory");
}
__device__ __forceinline__ void conv_n_body(size_t gtid, size_t gsz, const float* __restrict__ src, bf16_t* __restrict__ dst, const float* __restrict__ gain, int K, int nrows, float sc) {
    const int kc8 = K / 8; const size_t total = (size_t)nrows * kc8;
    for (size_t idx = gtid; idx < total; idx += gsz) {
        const int kc = (int)(idx % kc8), n = (int)(idx / kc8);
        const float g = gain[n] * sc; const f32x4 a = *(const f32x4*)(src + (size_t)n * K + kc * 8), b = *(const f32x4*)(src + (size_t)n * K + kc * 8 + 4);
        u32x4 o; o.x = pk2(a.x * g, a.y * g); o.y = pk2(a.z * g, a.w * g); o.z = pk2(b.x * g, b.y * g); o.w = pk2(b.z * g, b.w * g);
        *(u32x4*)(dst + (size_t)n * K + kc * 8) = o;
    }
}

__device__ __forceinline__ float wave_sum(float v) {
#pragma unroll
    for (int o = 1; o < 64; o <<= 1) v += __shfl_xor(v, o);
    return v;
}
__device__ __forceinline__ void rms_body(int gw, int ngw, int lane, const float* __restrict__ x, bf16_t* __restrict__ out, int nrows) {
    for (int row = gw; row < nrows; row += ngw) {
        const f32x4* xr = (const f32x4*)(x + (size_t)row * DM) + lane; f32x4 v[4]; float s = 0.f;
#pragma unroll
        for (int j = 0; j < 4; ++j) { v[j] = xr[64 * j]; s += v[j].x * v[j].x + v[j].y * v[j].y + v[j].z * v[j].z + v[j].w * v[j].w; }
        const float rstd = 1.0f / sqrtf(wave_sum(s) * (1.f / DM) + EPS);
        u32x2* o = (u32x2*)(out + (size_t)row * DM) + lane;
#pragma unroll
        for (int j = 0; j < 4; ++j) { u32x2 w; w.x = pk2(v[j].x * rstd, v[j].y * rstd); w.y = pk2(v[j].z * rstd, v[j].w * rstd); o[64 * j] = w; }
    }
}

struct GUnit { unsigned ao, bo; int row0, col0, e, valid, aux; };

__host__ __device__ __forceinline__ int lds_byte(int r, int c) { const int st = (r >> 4) * 2 + (c >> 5), rr = r & 15, cc = c & 31, ob = rr * 64 + cc * 2; return st * 1024 + (ob ^ (((ob >> 9) & 1) << 5)); }
__host__ __device__ __forceinline__ void stage_rc(int b, int& R, int& C) { const int st = b / 1024, sb = b % 1024, swz = sb ^ (((sb >> 9) & 1) << 5); R = (st >> 1) * 16 + swz / 64; C = (st & 1) * 32 + (swz % 64) / 2; }
__host__ __device__ __forceinline__ int perm32(int rho) { const int n = rho >> 4, i = rho & 15; return 8 * (i >> 2) + 4 * n + (i & 3); }
constexpr int HTB = 128 * 64 * 2;
typedef int v8i __attribute__((ext_vector_type(8)));
typedef int v4i __attribute__((ext_vector_type(4)));
struct Frag2 { bf16x8 h[2]; };
template <bool F> struct FragT { typedef Frag2 T; };
template <> struct FragT<true> { typedef v8i T; };
template <class Sched, class Epi, bool ALIGN_EPI, bool FP8 = false, int SCALE_B = 0x7f>
__device__ __forceinline__ void gemm_phase(unsigned char* lds_flat, const Sched& S, const Epi& E) {
    LDSP unsigned char* lds = (LDSP unsigned char*)(unsigned)(uintptr_t)lds_flat;
    int tid = threadIdx.x; LAUNDER(tid);
    const int wid = __builtin_amdgcn_readfirstlane(tid >> 6), lane = tid & 63, wr = wid >> 2, wc = wid & 3, fr = lane & 15, fq = lane >> 4;
    const int nt = S.K / 64;
    int Rr[2], Cc[2];
#pragma unroll
    for (int i = 0; i < 2; ++i) stage_rc(tid * 16 + i * 8192, Rr[i], Cc[i]);
    unsigned voffB[2][2];
#pragma unroll
    for (int h = 0; h < 2; ++h)
#pragma unroll
        for (int i = 0; i < 2; ++i) voffB[h][i] = (unsigned)(128 * h + (Rr[i] & ~31) + perm32(Rr[i] & 31)) * S.ldb + (unsigned)Cc[i] * 2u;
    const unsigned ldsw = (unsigned)wid * 1024u;
    const int aoff = lds_byte(wr * 64 + fr, fq * 8), boff = lds_byte(wc * 32 + fr, fq * 8);
    constexpr int KSUB = 1024;
#define PG8_SA(b, h) (((b) * 2 + (h)) * HTB)
#define PG8_SB(b, h) ((4 + (b) * 2 + (h)) * HTB)
#define PG8_STAGE(bufoff, rsrc, voff, soff) do { _Pragma("unroll") for (int _i = 0; _i < 2; ++_i) \
        __builtin_amdgcn_raw_ptr_buffer_load_lds(rsrc, (LDSP unsigned*)(lds + (bufoff) + ldsw + _i * 8192), 16, (int)(voff)[_i], (int)(soff), 0, 0); } while (0)
#define PG8_LDF(dst, addr) do { const bf16x8 lo_ = *(const LDSP bf16x8*)(addr); const bf16x8 hi_ = *(const LDSP bf16x8*)((addr) + KSUB); \
        if constexpr (FP8) dst = __builtin_shufflevector(__builtin_bit_cast(v4i, lo_), __builtin_bit_cast(v4i, hi_), 0, 1, 2, 3, 4, 5, 6, 7); else { dst.h[0] = lo_; dst.h[1] = hi_; } } while (0)
#define PG8_LDA(dst, b, h) do { _Pragma("unroll") for (int m = 0; m < 4; ++m) PG8_LDF(dst[m], lds + PG8_SA(b, h) + aoff + m * 2048); } while (0)
#define PG8_LDB(dst, b, h) do { _Pragma("unroll") for (int n = 0; n < 2; ++n) PG8_LDF(dst[n], lds + PG8_SB(b, h) + boff + n * 2048); } while (0)
#define PG8_MMA(ai, bj, At, Bt) do { __builtin_amdgcn_s_setprio(1); _Pragma("unroll") for (int m = 0; m < 4; ++m) _Pragma("unroll") for (int n = 0; n < 2; ++n) { \
        if constexpr (FP8) asm volatile("v_mfma_scale_f32_16x16x128_f8f6f4 %0, %1, %2, %0, %3, %4 op_sel_hi:[0,0,0]" : "+v"(acc[ai][bj][m][n]) : "v"(Bt[n]), "v"(At[m]), "v"(sclB), "v"(sclA)); \
        else { _Pragma("unroll") for (int k = 0; k < 2; ++k) acc[ai][bj][m][n] = __builtin_amdgcn_mfma_f32_16x16x32_bf16(Bt[n].h[k], At[m].h[k], acc[ai][bj][m][n], 0, 0, 0); } } \
        __builtin_amdgcn_s_setprio(0); } while (0)
#define PG8_WAIT_V(n) asm volatile("s_waitcnt vmcnt(" #n ")" ::: "memory")
#define PG8_WAIT_L(n) asm volatile("s_waitcnt lgkmcnt(" #n ")" ::: "memory")
#define PG8_BAR __builtin_amdgcn_s_barrier()
#define PG8_SCHED __builtin_amdgcn_sched_barrier(0)
    GUnit cur, nxt; int ui = 0;
    if (!S.next(0, cur)) return;
    const __amdgpu_buffer_rsrc_t rA = __builtin_amdgcn_make_buffer_rsrc((void*)S.A, 0, 0x7fffffff, 0x00020000);
    const __amdgpu_buffer_rsrc_t rB = __builtin_amdgcn_make_buffer_rsrc((void*)S.Bt, 0, 0x7fffffff, 0x00020000);
    unsigned oc[2][2], on[2][2];
#pragma unroll
    for (int h = 0; h < 2; ++h)
#pragma unroll
        for (int i = 0; i < 2; ++i) oc[h][i] = S.a_off(cur, 128 * h + Rr[i]) + (unsigned)Cc[i] * 2u;
    f32x4 acc[2][2][4][2];
#pragma unroll
    for (int a = 0; a < 2; ++a)
#pragma unroll
        for (int b = 0; b < 2; ++b)
#pragma unroll
            for (int m = 0; m < 4; ++m)
#pragma unroll
                for (int n = 0; n < 2; ++n) acc[a][b][m][n] = (f32x4){0.f, 0.f, 0.f, 0.f};
    typedef typename FragT<FP8>::T frag_t;
    frag_t At[4], B0[2], B1[2];
    const unsigned kstep = 128;
    const int sclB = SCALE_B * 0x01010101, sclA = 0x7f7f7f7f; (void)sclA; (void)sclB;
    PG8_STAGE(PG8_SB(0, 0), rB, voffB[0], cur.bo); PG8_STAGE(PG8_SB(0, 1), rB, voffB[1], cur.bo); PG8_STAGE(PG8_SA(0, 0), rA, oc[0], cur.ao); PG8_STAGE(PG8_SA(0, 1), rA, oc[1], cur.ao);
    if (wr == 1) PG8_BAR;
    PG8_WAIT_V(2); PG8_BAR;
    PG8_STAGE(PG8_SB(1, 0), rB, voffB[0], cur.bo + kstep); PG8_STAGE(PG8_SA(1, 0), rA, oc[0], cur.ao + kstep); PG8_STAGE(PG8_SB(1, 1), rB, voffB[1], cur.bo + kstep);
    PG8_WAIT_V(6); PG8_BAR;
    for (;;) {
        const bool has_next = S.next(ui + 1, nxt);
        if (!has_next) nxt = cur;
        const unsigned nA = nxt.ao, nB = nxt.bo;
        { int t2 = threadIdx.x; LAUNDER(t2);
#pragma unroll
          for (int i = 0; i < 2; ++i) { int R_, C_; stage_rc(t2 * 16 + i * 8192, R_, C_);
#pragma unroll
              for (int h = 0; h < 2; ++h) on[h][i] = S.a_off(nxt, 128 * h + R_) + (unsigned)C_ * 2u; } }
        for (int t = 0; t < nt; t += 2) {
            const bool last = (t == nt - 2);
            const unsigned k1 = cur.ao + (unsigned)(t + 1) * kstep;
            const unsigned a2 = last ? nA : cur.ao + (unsigned)(t + 2) * kstep, b2 = last ? nB : cur.bo + (unsigned)(t + 2) * kstep, a3 = a2 + kstep, b3 = b2 + kstep;
            unsigned o2[2][2];
#pragma unroll
            for (int h = 0; h < 2; ++h)
#pragma unroll
                for (int i = 0; i < 2; ++i) o2[h][i] = last ? on[h][i] : oc[h][i];
            PG8_LDB(B0, 0, 0); PG8_LDB(B1, 0, 1); PG8_SCHED; PG8_LDA(At, 0, 0); PG8_STAGE(PG8_SA(1, 1), rA, oc[1], k1);
            PG8_WAIT_V(8); PG8_WAIT_L(0); PG8_BAR; PG8_MMA(0, 0, At, B0); PG8_MMA(0, 1, At, B1); PG8_BAR; PG8_SCHED;
            PG8_LDA(At, 0, 1); PG8_STAGE(PG8_SB(0, 0), rB, voffB[0], b2); PG8_STAGE(PG8_SB(0, 1), rB, voffB[1], b2); PG8_STAGE(PG8_SA(0, 0), rA, o2[0], a2);
            PG8_WAIT_V(8); PG8_WAIT_L(0); PG8_BAR; PG8_MMA(1, 0, At, B0); PG8_MMA(1, 1, At, B1); PG8_BAR; PG8_SCHED;
            PG8_LDB(B0, 1, 0); PG8_LDB(B1, 1, 1); PG8_SCHED; PG8_LDA(At, 1, 0); PG8_STAGE(PG8_SA(0, 1), rA, o2[1], a2);
            PG8_WAIT_V(8); PG8_WAIT_L(0); PG8_BAR; PG8_MMA(0, 0, At, B0); PG8_MMA(0, 1, At, B1); PG8_BAR; PG8_SCHED;
            PG8_LDA(At, 1, 1); PG8_STAGE(PG8_SB(1, 0), rB, voffB[0], b3); PG8_STAGE(PG8_SB(1, 1), rB, voffB[1], b3); PG8_STAGE(PG8_SA(1, 0), rA, o2[0], a3);
            PG8_WAIT_V(8); PG8_WAIT_L(0); PG8_BAR; PG8_MMA(1, 0, At, B0); PG8_MMA(1, 1, At, B1); PG8_BAR; PG8_SCHED;
        }
        if constexpr (FP8) asm volatile("s_nop 15\n\ts_nop 15" ::: "memory");
        if constexpr (ALIGN_EPI) { if (wr == 0) PG8_BAR; }
        if constexpr (!Epi::AFTER_DRAIN) E(acc, cur, wr, wc, fr, fq);
        if (!has_next) break;
#pragma unroll
        for (int a = 0; a < 2; ++a)
#pragma unroll
            for (int b = 0; b < 2; ++b)
#pragma unroll
                for (int m = 0; m < 4; ++m)
#pragma unroll
                    for (int n = 0; n < 2; ++n) acc[a][b][m][n] = (f32x4){0.f, 0.f, 0.f, 0.f};
        cur = nxt; ++ui;
#pragma unroll
        for (int h = 0; h < 2; ++h)
#pragma unroll
            for (int i = 0; i < 2; ++i) oc[h][i] = on[h][i];
        if constexpr (ALIGN_EPI) { if (wr == 1) PG8_BAR; }
    }
    PG8_WAIT_V(0);
    if constexpr (!ALIGN_EPI) { if (wr == 0) PG8_BAR; }
    PG8_BAR;
    if constexpr (Epi::AFTER_DRAIN) E.fused(acc, cur, wr, wc, fr, fq, lds_flat, wid, lane);
#undef PG8_SA
#undef PG8_SB
#undef PG8_STAGE
#undef PG8_LDA
#undef PG8_LDF
#undef PG8_LDB
#undef PG8_MMA
#undef PG8_WAIT_V
#undef PG8_WAIT_L
#undef PG8_BAR
#undef PG8_SCHED
}
template <bool ALIGN, class Sched, class Epi> __device__ __forceinline__ void gemm_run(unsigned char* lds, const Sched& S, const Epi& E) {
    gemm_phase<Sched, Epi, ALIGN>(lds, S, E);
}
constexpr int WSCALE_LOG2 = 6;
template <bool ALIGN, class Sched, class Epi> __device__ __forceinline__ void gemm_run_fp8(unsigned char* lds, const Sched& S, const Epi& E) {
    gemm_phase<Sched, Epi, ALIGN, true, 127 - WSCALE_LOG2>(lds, S, E);
}

struct DenseSched {
    const char* A; const char* Bt; unsigned lda, ldb; int K; int nM, nN; int pm_per_b; size_t zB; int G, c;
    __device__ __forceinline__ bool next(int i, GUnit& u) const {
        int pm, pn;
        if (G == 256 && (nN & 3) == 0 && nM * nN >= 256) {
            const int j = c & 7, q = c >> 3, s = i * 8 + j, ncg = nN >> 2; pm = (s / ncg) * 8 + (q >> 2); pn = (s % ncg) * 4 + (q & 3); if (c < 0 || pm >= nM) return false; }
        else { const long L = (long)i * G + c; if (c < 0 || L >= (long)nM * nN) return false; pm = (int)(L / nN); pn = (int)(L % nN); }
        u.ao = (unsigned)pm * 256u * lda; u.bo = (unsigned)((size_t)(pm / pm_per_b) * zB) + (unsigned)pn * 256u * ldb; u.row0 = pm * 256; u.col0 = pn * 256; u.e = 0; u.valid = 256; u.aux = 0; return true;
    }
    __device__ __forceinline__ unsigned a_off(const GUnit&, int r) const { return (unsigned)r * lda; }
};
struct SchedWqk {
    const char* A; const char* Bt; unsigned lda, ldb; int K; int G, c, pad;
    __device__ __forceinline__ bool next(int i, GUnit& u) const {
        const int L = i * G + c; if (c < 0 || L >= 32) return false; const int z = L >> 2, pn = L & 3, b = z >> 2, h = z & 3;
        u.ao = (unsigned)b * 256u * 4096u + h * 512u; u.bo = (unsigned)pn * 256u * 2048u + h * 512u; u.row0 = z * 256; u.col0 = pn * 256; u.e = 0; u.valid = 256; u.aux = 0; return true;
    }
    __device__ __forceinline__ unsigned a_off(const GUnit&, int r) const { return (unsigned)r * lda; }
};
struct SchedVo {
    const char* A; const char* Bt; unsigned lda, ldb; int K; int G, c, pad;
    __device__ __forceinline__ bool next(int i, GUnit& u) const {
        const int L = i * G + c; if (c < 0 || L >= 32) return false; const int z = L >> 2, pm = L & 3, b = z >> 2, h = z & 3;
        u.ao = (unsigned)pm * 256u * 2048u + h * 512u; u.bo = (unsigned)b * 256u * 4096u + 2048u + h * 512u; u.row0 = b * 1024 + pm * 256; u.col0 = h * 256; u.e = 0; u.valid = 256; u.aux = 0; return true;
    }
    __device__ __forceinline__ unsigned a_off(const GUnit&, int r) const { return (unsigned)r * lda; }
};
template <bool GATHER> struct MoeSched {
    const char* A; const char* Bt; unsigned lda, ldb; int K; int nN; size_t zB;
    const int* tab; const int* list; int gather; int G, c, pad;
    __device__ __forceinline__ bool next(int i, GUnit& u) const {
        int T, pn;
        if (G == 256) { const int j = c & 7, q = c >> 3, s = i * 8 + j;
            if (nN == 8) { T = 4 * s + (q >> 3); pn = q & 7; } else { T = 8 * s + (q >> 2); pn = q & 3; } }
        else { const int L = i * G + c; T = L / nN; pn = L % nN; }
        if (T >= __builtin_amdgcn_readfirstlane(tab[64])) return false;
        const int w = __builtin_amdgcn_readfirstlane(tab[128 + T]); const int e = w & 255, rt = w >> 8; const int ce = __builtin_amdgcn_readfirstlane(tab[e]), start = __builtin_amdgcn_readfirstlane(tab[32 + e]);
        u.e = e; u.valid = min(256, ce - rt * 256); u.row0 = start + rt * 256; u.col0 = pn * 256; u.aux = rt * 256;
        u.ao = GATHER ? 0u : (unsigned)u.row0 * lda; u.bo = (unsigned)((size_t)e * zB) + (unsigned)pn * 256u * ldb; return true;
    }
    __device__ __forceinline__ unsigned a_off(const GUnit& u, int r) const {
        if (!GATHER) return (unsigned)r * lda;
        const int rr = r < u.valid ? r : 0; const int tok = list[u.e * NTOK + u.aux + rr]; return (unsigned)tok * lda;
    }
};
__device__ __forceinline__ void moe_build_table(int* tab, const int* __restrict__ cnt, int tid) {
    if (tid < 32) tab[tid] = cnt[tid * 32];
    __syncthreads();
    if (tid < 32) { int s = 0; for (int e = 0; e < tid; ++e) s += tab[e]; tab[32 + tid] = s; }
    if (tid < 320) { int tiles = 0, found = -1;
        for (int e = 0; e < NEXP; ++e) { const int te = (tab[e] + 255) >> 8; if (found < 0 && tid < tiles + te) found = e | ((tid - tiles) << 8); tiles += te; }
        if (found >= 0) tab[128 + tid] = found; if (tid == 0) tab[64] = tiles; }
    __syncthreads();
}

__device__ __forceinline__ u32x4 pack8(const f32x4& a, const f32x4& b) { u32x4 w; w.x = pk2(a[0], a[1]); w.y = pk2(a[2], a[3]); w.z = pk2(b[0], b[1]); w.w = pk2(b[2], b[3]); return w; }
struct EpiBf16 { static constexpr bool AFTER_DRAIN = false; bf16_t* O; int ldc, pad;
    __device__ __forceinline__ void operator()(const f32x4 (&acc)[2][2][4][2], const GUnit& u, int wr, int wc, int fr, int fq) const {
        LAUNDER(fr); LAUNDER(fq);
#pragma unroll
        for (int ai = 0; ai < 2; ++ai)
#pragma unroll
            for (int m = 0; m < 4; ++m) { const int r = 128 * ai + 64 * wr + 16 * m + fr;
#pragma unroll
                for (int bj = 0; bj < 2; ++bj) *(u32x4*)(O + (size_t)(u.row0 + r) * ldc + u.col0 + 128 * bj + 32 * wc + 8 * fq) = pack8(acc[ai][bj][m][0], acc[ai][bj][m][1]); } } };
__device__ __forceinline__ float row_rstd(const float* __restrict__ ssp, int row) { const f32x4* p = (const f32x4*)(ssp + (size_t)row * 16); const f32x4 a = p[0], b = p[1], c = p[2], d = p[3];
    const float s = (((a[0] + a[1]) + (a[2] + a[3])) + ((b[0] + b[1]) + (b[2] + b[3]))) + (((c[0] + c[1]) + (c[2] + c[3])) + ((d[0] + d[1]) + (d[2] + d[3]))); return 1.0f / sqrtf(s * (1.0f / 1024.0f) + EPS); }
template <bool BASE_BF16> struct EpiResidSS { static constexpr bool AFTER_DRAIN = false; const void* base; bf16_t* xb; float* ss; unsigned char* xq;
    __device__ __forceinline__ void operator()(const f32x4 (&acc)[2][2][4][2], const GUnit& u, int wr, int wc, int fr, int fq) const {
        LAUNDER(fr); LAUNDER(fq);
#pragma unroll
        for (int ai = 0; ai < 2; ++ai) {
            f32x4 b[4][2][2];
#pragma unroll
            for (int m = 0; m < 4; ++m)
#pragma unroll
                for (int bj = 0; bj < 2; ++bj) { const size_t o = (size_t)(u.row0 + 128 * ai + 64 * wr + 16 * m + fr) * 1024 + u.col0 + 128 * bj + 32 * wc + 8 * fq;
                    if (BASE_BF16) { const u32x4 w = *(const u32x4*)((const bf16_t*)base + o); b[m][bj][0] = (f32x4){bflo(w.x), bfhi(w.x), bflo(w.y), bfhi(w.y)}; b[m][bj][1] = (f32x4){bflo(w.z), bfhi(w.z), bflo(w.w), bfhi(w.w)}; }
                    else { b[m][bj][0] = *(const f32x4*)((const float*)base + o); b[m][bj][1] = *(const f32x4*)((const float*)base + o + 4); } }
#pragma unroll
            for (int m = 0; m < 4; ++m) { const int r = 128 * ai + 64 * wr + 16 * m + fr; float part = 0.f;
#pragma unroll
                for (int bj = 0; bj < 2; ++bj) { const size_t o = (size_t)(u.row0 + r) * 1024 + u.col0 + 128 * bj + 32 * wc + 8 * fq;
                    const f32x4 y0 = b[m][bj][0] + acc[ai][bj][m][0], y1 = b[m][bj][1] + acc[ai][bj][m][1]; *(u32x4*)(xb + o) = pack8(y0, y1);
                    if (xq) { u32x2 q; q.x = pk4_fp8(y0[0], y0[1], y0[2], y0[3]); q.y = pk4_fp8(y1[0], y1[1], y1[2], y1[3]); *(u32x2*)(xq + o) = q; }
                    part += (y0[0] * y0[0] + y0[1] * y0[1] + y0[2] * y0[2] + y0[3] * y0[3]) + (y1[0] * y1[0] + y1[1] * y1[1] + y1[2] * y1[2] + y1[3] * y1[3]); }
                part += __shfl_xor(part, 16); part += __shfl_xor(part, 32);
                if (fq == 0) ss[(size_t)(u.row0 + r) * 16 + (u.col0 >> 8) * 4 + wc] = part; } } } };
struct EpiSoftmax { static constexpr bool AFTER_DRAIN = true; const float* ss; bf16_t* P;
    __device__ __forceinline__ void operator()(const f32x4 (&)[2][2][4][2], const GUnit&, int, int, int, int) const {}
    __device__ __forceinline__ void fused(f32x4 (&acc)[2][2][4][2], const GUnit& u, int wr, int wc, int fr, int fq, unsigned char* lds, int wid, int lane) const {
        float* Pm = (float*)lds; float* Ps = (float*)(lds + 4096);
        LAUNDER(fr); LAUNDER(fq);
#pragma unroll
        for (int ai = 0; ai < 2; ++ai)
#pragma unroll
            for (int m = 0; m < 4; ++m) { const int r = 128 * ai + 64 * wr + 16 * m + fr; const float rstd = row_rstd(ss, u.row0 + r); float mv = -INFINITY;
#pragma unroll
                for (int bj = 0; bj < 2; ++bj)
#pragma unroll
                    for (int n = 0; n < 2; ++n) { f32x4 s = acc[ai][bj][m][n] * rstd; acc[ai][bj][m][n] = s; mv = fmaxf(mv, fmaxf(fmaxf(s[0], s[1]), fmaxf(s[2], s[3]))); }
                mv = fmaxf(mv, __shfl_xor(mv, 16)); mv = fmaxf(mv, __shfl_xor(mv, 32));
                if (fq == 0) Pm[r * 4 + wc] = mv; }
        __syncthreads();
#pragma unroll
        for (int ai = 0; ai < 2; ++ai)
#pragma unroll
            for (int m = 0; m < 4; ++m) { const int r = 128 * ai + 64 * wr + 16 * m + fr; const f32x4 pm = *(const f32x4*)(Pm + r * 4); const float mv = fmaxf(fmaxf(pm[0], pm[1]), fmaxf(pm[2], pm[3])); float sum = 0.f;
#pragma unroll
                for (int bj = 0; bj < 2; ++bj)
#pragma unroll
                    for (int n = 0; n < 2; ++n) { f32x4 s = acc[ai][bj][m][n]; s[0] = __builtin_amdgcn_exp2f(s[0] - mv); s[1] = __builtin_amdgcn_exp2f(s[1] - mv); s[2] = __builtin_amdgcn_exp2f(s[2] - mv); s[3] = __builtin_amdgcn_exp2f(s[3] - mv);
                        acc[ai][bj][m][n] = s; sum += (s[0] + s[1]) + (s[2] + s[3]); }
                sum += __shfl_xor(sum, 16); sum += __shfl_xor(sum, 32);
                if (fq == 0) Ps[r * 4 + wc] = sum; }
        __syncthreads();
#pragma unroll
        for (int ai = 0; ai < 2; ++ai)
#pragma unroll
            for (int m = 0; m < 4; ++m) { const int r = 128 * ai + 64 * wr + 16 * m + fr; const f32x4 ps = *(const f32x4*)(Ps + r * 4); const float inv = 1.0f / ((ps[0] + ps[1]) + (ps[2] + ps[3]));
#pragma unroll
                for (int bj = 0; bj < 2; ++bj) *(u32x4*)(P + (size_t)(u.row0 + r) * 1024 + u.col0 + 128 * bj + 32 * wc + 8 * fq) = pack8(acc[ai][bj][m][0] * inv, acc[ai][bj][m][1] * inv); }
        (void)wid; (void)lane;
        __syncthreads();
    } };
struct EpiGU { static constexpr bool AFTER_DRAIN = false; const float* bgu; unsigned char* act  ; const float* lrs  ;
    __device__ __forceinline__ void operator()(const f32x4 (&acc)[2][2][4][2], const GUnit& u, int wr, int wc, int fr, int fq) const {
        const int pn = u.col0 >> 8; const float* bg = bgu + (size_t)u.e * 2048; LAUNDER(fr); LAUNDER(fq);
        float rs[8];
#pragma unroll
        for (int i = 0; i < 8; ++i) { const int r = 128 * (i >> 2) + 64 * wr + 16 * (i & 3) + fr; rs[i] = lrs[(size_t)u.e * NTOK + u.aux + (r < u.valid ? r : 0)]; }
        const int col = 128 * pn + 32 * wc + 8 * fq;
        f32x4 bgv[2], blv[2];
#pragma unroll
        for (int n = 0; n < 2; ++n) { bgv[n] = *(const f32x4*)(bg + col + 4 * n); blv[n] = *(const f32x4*)(bg + 1024 + col + 4 * n); }
#pragma unroll
        for (int ai = 0; ai < 2; ++ai)
#pragma unroll
            for (int m = 0; m < 4; ++m) { const int r = 128 * ai + 64 * wr + 16 * m + fr; const float rstd = rs[ai * 4 + m]; u32x2 q;
#pragma unroll
                for (int n = 0; n < 2; ++n) { const f32x4 g = acc[ai][0][m][n] * rstd + bgv[n], l = acc[ai][1][m][n] * rstd + blv[n]; float o[4];
#pragma unroll
                    for (int j = 0; j < 4; ++j) { const float gg = fminf(g[j], 7.0f), ll = fminf(fmaxf(l[j], -7.0f), 7.0f); o[j] = (ll + 1.0f) * (gg * __builtin_amdgcn_rcpf(1.0f + __builtin_amdgcn_exp2f(-1.702f * LOG2E * gg))); }
                    const unsigned w = pk4_fp8(o[0], o[1], o[2], o[3]); if (n == 0) q.x = w; else q.y = w; }
                if (r < u.valid) *(u32x2*)(act + (size_t)(u.row0 + r) * 1024 + col) = q; } } };
struct EpiDown { static constexpr bool AFTER_DRAIN = false; const float* bdn; unsigned char* ys  ;
    __device__ __forceinline__ void operator()(const f32x4 (&acc)[2][2][4][2], const GUnit& u, int wr, int wc, int fr, int fq) const {
        const float* bd = bdn + (size_t)u.e * 1024; LAUNDER(fr); LAUNDER(fq);
        f32x4 bv[2][2];
#pragma unroll
        for (int bj = 0; bj < 2; ++bj)
#pragma unroll
            for (int n = 0; n < 2; ++n) bv[bj][n] = *(const f32x4*)(bd + u.col0 + 128 * bj + 32 * wc + 8 * fq + 4 * n);
#pragma unroll
        for (int ai = 0; ai < 2; ++ai)
#pragma unroll
            for (int m = 0; m < 4; ++m) { const int r = 128 * ai + 64 * wr + 16 * m + fr; if (r < u.valid) {
#pragma unroll
                for (int bj = 0; bj < 2; ++bj) { const f32x4 y0 = acc[ai][bj][m][0] + bv[bj][0], y1 = acc[ai][bj][m][1] + bv[bj][1]; u32x2 q; q.x = pk4_fp8(y0[0], y0[1], y0[2], y0[3]); q.y = pk4_fp8(y1[0], y1[1], y1[2], y1[3]);
                    *(u32x2*)(ys + (size_t)(u.row0 + r) * 1024 + u.col0 + 128 * bj + 32 * wc + 8 * fq) = q; } } } } };


typedef float f32x16 __attribute__((ext_vector_type(16)));
typedef short s16x4 __attribute__((ext_vector_type(4)));
__device__ __forceinline__ int crow(int r, int hi) { return (r & 3) + 8 * (r >> 2) + 4 * hi; }
__device__ __forceinline__ s16x4 tr_read(const unsigned char* p) { return __builtin_bit_cast(s16x4, __builtin_amdgcn_ds_read_tr16_b64_v4i16((LDSP s16x4*)(unsigned)(uintptr_t)p)); }
__device__ __forceinline__ bf16x8 tr_frag(const unsigned char* img, int pitch, int k0, int f0, int lane) {
    const unsigned char* p = img + (k0 + 8 * (lane >> 5) + ((lane & 15) >> 2)) * pitch + (f0 + 16 * ((lane >> 4) & 1) + 4 * (lane & 3)) * 2;
    const s16x4 lo = tr_read(p), hi = tr_read(p + 4 * pitch);
    return (bf16x8){lo[0], lo[1], lo[2], lo[3], hi[0], hi[1], hi[2], hi[3]};
}
constexpr int GA_PK = 576, GA_PV = 1088;
constexpr int GA_V = 0, GA_PART = 0, GA_GLR = 69632, GA_TOT = 73728, GA_KD = 75776, GA_END = GA_KD + 64 * GA_PK;
__device__ __forceinline__ void gla_pass_a(unsigned char* lds, int task, const bf16_t* __restrict__ xn, const bf16_t* __restrict__ wglr  , const bf16_t* __restrict__ proj,
                                           const float* __restrict__ wg, const float* __restrict__ bg, float* __restrict__ UT, float* __restrict__ decay) {
    int tid = threadIdx.x; LAUNDER(tid); int wid = tid >> 6, lane = tid & 63, fr = lane & 15, fq = lane >> 4;
    const size_t t0 = (size_t)task * 64;
    { f32x4 acc[4];
#pragma unroll
      for (int m = 0; m < 4; ++m) acc[m] = (f32x4){0.f, 0.f, 0.f, 0.f};
#pragma unroll
      for (int ks = 0; ks < 4; ++ks) { const int k = 128 * wid + 32 * ks + 8 * fq; const bf16x8 bfr = *(const bf16x8*)(wglr + (size_t)fr * 1024 + k);
#pragma unroll
          for (int m = 0; m < 4; ++m) { const bf16x8 afr = *(const bf16x8*)(xn + (t0 + 16 * m + fr) * DM + k); acc[m] = __builtin_amdgcn_mfma_f32_16x16x32_bf16(afr, bfr, acc[m], 0, 0, 0); } }
      float* part = (float*)(lds + GA_PART) + wid * 1024;
#pragma unroll
      for (int m = 0; m < 4; ++m)
#pragma unroll
          for (int j = 0; j < 4; ++j) part[(16 * m + 4 * fq + j) * 16 + fr] = acc[m][j]; }
    __syncthreads();
    { float* glr = (float*)(lds + GA_GLR); const float* part = (const float*)(lds + GA_PART);
      for (int i = tid; i < 1024; i += 512) { float s = 0.f;
#pragma unroll
          for (int w = 0; w < 8; ++w) s += part[w * 1024 + i];
          glr[i] = s; } }
    __syncthreads();
    LAUNDER(tid);
    { const int cv = tid & 63, tk = tid >> 6;
#pragma unroll
      for (int i = 0; i < 8; ++i) { const int tok = tk + 8 * i; const u32x4 v = *(const u32x4*)(proj + (t0 + tok) * PROJ_LD + C_VG + cv * 8); *(u32x4*)(lds + GA_V + tok * GA_PV + cv * 16) = v; } }
    LAUNDER(tid);
    { const int j = tid & 255, half = tid >> 8; const float* glr = (const float*)(lds + GA_GLR); float* tot = (float*)(lds + GA_TOT);
      float w[16];
#pragma unroll
      for (int i = 0; i < 16; ++i) w[i] = wg[i * 256 + j];
      const float bj = bg[j]; float run = 0.f;
      bf16_t kk16[32];
#pragma unroll
      for (int s = 0; s < 32; ++s) kk16[s] = proj[(t0 + 32 * half + s) * PROJ_LD + C_KG + j];
#pragma unroll 2
      for (int s = 0; s < 32; ++s) { const float* gl = glr + (32 * half + s) * 16; float u = bj;
#pragma unroll
          for (int i = 0; i < 16; ++i) u += gl[i] * w[i];
          const float ls = fminf(u, 0.f) - __logf(1.0f + __expf(-fabsf(u)));
          run += ls * (1.0f / 16.0f); }
      tot[half * 256 + j] = run;
      __syncthreads();
      const float t0v = tot[j], t1v = tot[256 + j]; const float gend = t0v + t1v;
      if (half == 0) decay[(size_t)task * 256 + j] = __expf(gend);
      run = half ? t0v : 0.f;
#pragma unroll
      for (int s = 0; s < 32; ++s) { const int tok = 32 * half + s; const float* gl = glr + tok * 16; float u = bj;
#pragma unroll
          for (int i = 0; i < 16; ++i) u += gl[i] * w[i];
          const float ls = fminf(u, 0.f) - __logf(1.0f + __expf(-fabsf(u)));
          run += ls * (1.0f / 16.0f);
          const float kk = bf2f(kk16[s]);
          *(bf16_t*)(lds + GA_KD + tok * GA_PK + j * 2) = (bf16_t)f2bf(kk * __expf(gend - run)); } }
    __syncthreads();
    LAUNDER(tid); wid = __builtin_amdgcn_readfirstlane(tid >> 6); lane = tid & 63;
    { const int h = wid >> 1, nt = wid & 1, hi = lane >> 5, c32 = lane & 31; f32x16 acc[4];
#pragma unroll
      for (int m = 0; m < 4; ++m)
#pragma unroll
          for (int r = 0; r < 16; ++r) acc[m][r] = 0.f;
#pragma unroll
      for (int ks = 0; ks < 4; ++ks) { const bf16x8 bfr = tr_frag(lds + GA_KD, GA_PK, 16 * ks, h * 64 + 32 * nt, lane);
#pragma unroll
          for (int m = 0; m < 4; ++m) { const bf16x8 afr = tr_frag(lds + GA_V, GA_PV, 16 * ks, h * 128 + 32 * m, lane); acc[m] = __builtin_amdgcn_mfma_f32_32x32x16_bf16(afr, bfr, acc[m], 0, 0, 0); } }
      float* u = UT + ((size_t)task * 4 + h) * 8192;
#pragma unroll
      for (int m = 0; m < 4; ++m)
#pragma unroll
          for (int r = 0; r < 16; ++r) u[(32 * m + crow(r, hi)) * 64 + 32 * nt + c32] = acc[m][r]; }
    __syncthreads();
}
__device__ __forceinline__ void gla_pass_b(int e, const float* __restrict__ UT, const float* __restrict__ decay, bf16_t* __restrict__ ST) {
    const int dk = e & 63, dv = (e >> 6) & 127, h = (e >> 13) & 3, b = e >> 15; float s = 0.f;
    const size_t base = ((size_t)b * 128 * 4 + h) * 8192 + dv * 64 + dk; const size_t dbase = (size_t)b * 128 * 256 + h * 64 + dk;
    for (int c0 = 0; c0 < 128; c0 += 32) { float u[32], d[32];
#pragma unroll
        for (int i = 0; i < 32; ++i) { u[i] = UT[base + (size_t)(c0 + i) * 4 * 8192]; d[i] = decay[dbase + (size_t)(c0 + i) * 256]; }
#pragma unroll
        for (int i = 0; i < 32; ++i) { s = d[i] * s + u[i]; ST[base + (size_t)(c0 + i) * 4 * 8192] = (bf16_t)f2bf(s); } }
}
constexpr int GC_PITCH = 520;
__device__ __forceinline__ void gla_pass_c(unsigned char* wlds  , int wtask, const bf16_t* __restrict__ ST, const bf16_t* __restrict__ proj, const float* __restrict__ ghead, bf16_t* __restrict__ mix, int lane) {
    const int nh = wtask & 1, h = (wtask >> 1) & 3, bc = wtask >> 3; const int c32 = lane & 31, hi = lane >> 5;
    const size_t t0 = (size_t)bc * 64 + 32 * nh; const bf16_t* st = ST + ((size_t)bc * 4 + h) * 8192;
    f32x16 acc[4];
#pragma unroll
    for (int m = 0; m < 4; ++m)
#pragma unroll
        for (int r = 0; r < 16; ++r) acc[m][r] = 0.f;
#pragma unroll
    for (int ks = 0; ks < 4; ++ks) { const bf16x8 bfr = *(const bf16x8*)(proj + (t0 + c32) * PROJ_LD + C_QG + h * 64 + 16 * ks + 8 * hi);
#pragma unroll
        for (int m = 0; m < 4; ++m) { const bf16x8 afr = *(const bf16x8*)(st + (32 * m + c32) * 64 + 16 * ks + 8 * hi); acc[m] = __builtin_amdgcn_mfma_f32_32x32x16_bf16(afr, bfr, acc[m], 0, 0, 0); } }
    float ss = 0.f;
#pragma unroll
    for (int m = 0; m < 4; ++m)
#pragma unroll
        for (int r = 0; r < 16; ++r) ss += acc[m][r] * acc[m][r];
    ss += __shfl_xor(ss, 32);
    const float rstd = 1.0f / sqrtf(ss * (1.0f / 128.0f) + EPS);
#pragma unroll
    for (int m = 0; m < 4; ++m)
#pragma unroll
        for (int r = 0; r < 16; ++r) *(float*)(wlds + c32 * GC_PITCH + (32 * m + crow(r, hi)) * 4) = acc[m][r] * rstd;
#pragma unroll
    for (int i = 0; i < 8; ++i) { const int q = lane + 64 * i, tok = q >> 4, dv0 = (q & 15) * 8; const float* src = (const float*)(wlds + tok * GC_PITCH + dv0 * 4);
        const u32x4 rgw = *(const u32x4*)(proj + (t0 + tok) * PROJ_LD + C_RG + h * 128 + dv0); const f32x4 g0 = *(const f32x4*)(ghead + dv0), g1 = *(const f32x4*)(ghead + dv0 + 4);
        const float rg[8] = {bflo(rgw.x), bfhi(rgw.x), bflo(rgw.y), bfhi(rgw.y), bflo(rgw.z), bfhi(rgw.z), bflo(rgw.w), bfhi(rgw.w)}; const float gg[8] = {g0.x, g0.y, g0.z, g0.w, g1.x, g1.y, g1.z, g1.w}; float y[8];
#pragma unroll
        for (int k = 0; k < 8; ++k) y[k] = src[k] * gg[k] * (rg[k] / (1.0f + __expf(-rg[k])));
        u32x4 o; o.x = pk2(y[0], y[1]); o.y = pk2(y[2], y[3]); o.z = pk2(y[4], y[5]); o.w = pk2(y[6], y[7]);
        *(u32x4*)(mix + (t0 + tok) * 1024 + h * 128 + dv0) = o; }
}
__device__ __forceinline__ void sb_task(unsigned char* vl  , int wtask, const bf16_t* __restrict__ proj, bf16_t* __restrict__ mix, int lane) {
    const int qt = wtask & 255, h = (wtask >> 8) & 7, b = wtask >> 11; const int c = lane & 31, hi = lane >> 5;
    const int t0 = qt * 32; const size_t rowb = (size_t)b * SEQ;
    bf16x8 qf[4];
#pragma unroll
    for (int d0 = 0; d0 < 4; ++d0) qf[d0] = *(const bf16x8*)(proj + (rowb + t0 + c) * PROJ_LD + C_QS + h * 64 + 16 * d0 + 8 * hi);
    const int kap = 16 * ((c >> 2) & 1) + (c & 3) + 4 * (c >> 3);
    f32x16 o0, o1;
#pragma unroll
    for (int r = 0; r < 16; ++r) { o0[r] = 0.f; o1[r] = 0.f; }
    float Dc = 1.0f;
    const bf16_t* kbase = proj + rowb * PROJ_LD + C_KS + h * 64 + 8 * hi + (size_t)kap * PROJ_LD;
    const bf16_t* vbase = proj + rowb * PROJ_LD + C_VS + h * 64 + (lane & 7) * 8 + (size_t)(lane >> 3) * PROJ_LD;
    bf16x8 kf[4]; u32x4 vr[4];
#pragma unroll
    for (int d0 = 0; d0 < 4; ++d0) kf[d0] = *(const bf16x8*)(kbase + (size_t)t0 * PROJ_LD + 16 * d0);
#pragma unroll
    for (int i = 0; i < 4; ++i) vr[i] = *(const u32x4*)(vbase + (size_t)(t0 + 8 * i) * PROJ_LD);
    for (int j0 = t0; j0 >= 0; j0 -= 32) {
#pragma unroll
        for (int i = 0; i < 4; ++i) { const int key = (lane >> 3) + 8 * i, ch = lane & 7; *(u32x4*)(vl + (ch >> 2) * 2048 + key * 64 + (ch & 3) * 16) = vr[i]; }
        f32x16 z;
#pragma unroll
        for (int r = 0; r < 16; ++r) z[r] = 0.f;
#pragma unroll
        for (int d0 = 0; d0 < 4; ++d0) z = __builtin_amdgcn_mfma_f32_32x32x16_bf16(kf[d0], qf[d0], z, 0, 0, 0);
        asm volatile("" ::: "memory");
        { const int jn = (j0 >= 32) ? j0 - 32 : j0;
#pragma unroll
          for (int d0 = 0; d0 < 4; ++d0) kf[d0] = *(const bf16x8*)(kbase + (size_t)jn * PROJ_LD + 16 * d0);
#pragma unroll
          for (int i = 0; i < 4; ++i) vr[i] = *(const u32x4*)(vbase + (size_t)(jn + 8 * i) * PROJ_LD); }
        asm volatile("" ::: "memory");
        float e[16], Dl[16];
        const bool diag = (j0 == t0);
#pragma unroll
        for (int r = 0; r < 16; ++r) { float ev = __builtin_amdgcn_exp2f(fminf(z[r], 126.0f)); if (diag && (16 * hi + r >= c)) ev = 0.f; e[r] = ev; }
        float D = hi ? Dc : 1.0f;
#pragma unroll
        for (int r = 15; r >= 0; --r) { D = fmaf(D, e[r], D); Dl[r] = D; }
        const float other = __shfl_xor(D, 32);
        const float mult = hi ? 1.0f : other;
        Dc = D * other;
        unsigned pw[8];
#pragma unroll
        for (int r = 0; r < 16; r += 2) { const float a0 = e[r] * __builtin_amdgcn_rcpf(Dl[r] * mult), a1 = e[r + 1] * __builtin_amdgcn_rcpf(Dl[r + 1] * mult); pw[r >> 1] = pk2(a0, a1); }
#pragma unroll
        for (int ks = 0; ks < 2; ++ks) { const bf16x8 pa = __builtin_bit_cast(bf16x8, (u32x4){pw[4 * ks], pw[4 * ks + 1], pw[4 * ks + 2], pw[4 * ks + 3]});
            const unsigned char* vb = vl + (16 * hi + 8 * ks + ((lane & 15) >> 2)) * 64 + (16 * ((lane >> 4) & 1) + 4 * (lane & 3)) * 2;
            { const s16x4 lo = tr_read(vb), hh = tr_read(vb + 256); o0 = __builtin_amdgcn_mfma_f32_32x32x16_bf16(pa, (bf16x8){lo[0], lo[1], lo[2], lo[3], hh[0], hh[1], hh[2], hh[3]}, o0, 0, 0, 0); }
            { const s16x4 lo = tr_read(vb + 2048), hh = tr_read(vb + 2048 + 256); o1 = __builtin_amdgcn_mfma_f32_32x32x16_bf16(pa, (bf16x8){lo[0], lo[1], lo[2], lo[3], hh[0], hh[1], hh[2], hh[3]}, o1, 0, 0, 0); } }
        if (__all(!(Dc < 3.0e38f))) break;
    }
    bf16_t* ob = mix + (rowb + t0) * 1024 + 512 + h * 64 + c;
#pragma unroll
    for (int r = 0; r < 16; ++r) { const int q = crow(r, hi); ob[(size_t)q * 1024] = (bf16_t)f2bf(o0[r]); ob[(size_t)q * 1024 + 32] = (bf16_t)f2bf(o1[r]); }
}
__device__ __forceinline__ void memkv_task(int wtask, int lane, const bf16_t* __restrict__ memn, const bf16_t* __restrict__ wkv, bf16_t* __restrict__ kv) {
    const int tm = wtask >> 6, tn = wtask & 63; const int c = lane & 31, hi = lane >> 5;
    const bf16_t* ap = memn + (size_t)(tm * 32 + c) * DM + 8 * hi; const bf16_t* bp = wkv + (size_t)(tn * 32 + c) * DM + 8 * hi;
    f32x16 acc;
#pragma unroll
    for (int r = 0; r < 16; ++r) acc[r] = 0.f;
#pragma unroll 16
    for (int ks = 0; ks < 64; ++ks) { const bf16x8 a = *(const bf16x8*)(ap + 16 * ks), b = *(const bf16x8*)(bp + 16 * ks); acc = __builtin_amdgcn_mfma_f32_32x32x16_bf16(a, b, acc, 0, 0, 0); }
    bf16_t* o = kv + (size_t)(tm * 32) * 2048 + tn * 32 + c;
#pragma unroll
    for (int r = 0; r < 16; ++r) o[(size_t)crow(r, hi) * 2048] = (bf16_t)f2bf(acc[r]);
}
__device__ __forceinline__ void router_task(int wtask, int lane, const bf16_t* __restrict__ xn, const float* __restrict__ ss, const bf16_t* __restrict__ wr, const float* __restrict__ br,
                                            int (&oe)[4], float (&ow)[4]) {
    const int c = lane & 31, hi = lane >> 5; const int t = wtask * 32 + c;
    const bf16_t* ap = wr + (size_t)c * DM + 8 * hi; const bf16_t* bp = xn + (size_t)t * DM + 8 * hi;
    f32x16 acc;
#pragma unroll
    for (int r = 0; r < 16; ++r) acc[r] = 0.f;
#pragma unroll 16
    for (int ks = 0; ks < 64; ++ks) { const bf16x8 a = *(const bf16x8*)(ap + 16 * ks), b = *(const bf16x8*)(bp + 16 * ks); acc = __builtin_amdgcn_mfma_f32_32x32x16_bf16(a, b, acc, 0, 0, 0); }
    float v[16]; const float rstd = row_rstd(ss, t);
#pragma unroll
    for (int r = 0; r < 16; ++r) v[r] = acc[r] * rstd + br[crow(r, hi)];
    float tv[4]; int ti[4];
#pragma unroll
    for (int k = 0; k < 4; ++k) { float best = -INFINITY; int bi = 64;
#pragma unroll
        for (int r = 0; r < 16; ++r) { if (v[r] > best) { best = v[r]; bi = crow(r, hi); } }
        tv[k] = best; ti[k] = bi;
#pragma unroll
        for (int r = 0; r < 16; ++r) if (crow(r, hi) == bi) v[r] = -INFINITY; }
    float cv[8]; int ci[8];
#pragma unroll
    for (int k = 0; k < 4; ++k) { cv[k] = tv[k]; ci[k] = ti[k]; cv[4 + k] = __shfl_xor(tv[k], 32); ci[4 + k] = __shfl_xor(ti[k], 32); }
#pragma unroll
    for (int k = 0; k < 4; ++k) { float best = -INFINITY; int bi = 64;
#pragma unroll
        for (int q = 0; q < 8; ++q) { if (cv[q] > best || (cv[q] == best && ci[q] < bi)) { best = cv[q]; bi = ci[q]; } }
        tv[k] = best; ti[k] = bi;
#pragma unroll
        for (int q = 0; q < 8; ++q) if (ci[q] == bi) cv[q] = -INFINITY; }
    const float e1 = __expf(tv[1] - tv[0]), e2 = __expf(tv[2] - tv[0]), e3 = __expf(tv[3] - tv[0]); const float inv = 1.0f / (1.0f + e1 + e2 + e3);
    const float g[4] = {inv, e1 * inv, e2 * inv, e3 * inv};
#pragma unroll
    for (int k = 0; k < 4; ++k) { oe[k] = ti[k]; ow[k] = g[k]; }
}
__device__ __forceinline__ void combine_task(int t, int lane, const bf16_t* xin, float* xout, const unsigned char* __restrict__ ys, const int* tab, const int* __restrict__ toke, const int* __restrict__ tokr,
                                                 const float* __restrict__ tokw, const float* __restrict__ gfin) {
    const u32x2* xr = (const u32x2*)(xin + (size_t)t * DM) + lane; f32x4* xo = (f32x4*)(xout + (size_t)t * DM) + lane; f32x4 v[4];
#pragma unroll
    for (int j = 0; j < 4; ++j) { const u32x2 w = xr[64 * j]; v[j] = (f32x4){bflo(w.x), bfhi(w.x), bflo(w.y), bfhi(w.y)}; }
    for (int k = 0; k < 4; ++k) { const int e = toke[t * 4 + k], r = tokr[t * 4 + k]; const float w = tokw[t * 4 + k]; const int start = tab[32 + e];
        const unsigned* yr = (const unsigned*)(ys + (size_t)(start + r) * DM) + lane;
#pragma unroll
        for (int j = 0; j < 4; ++j) { const int y = (int)yr[64 * j]; const f32x2 lo = __builtin_amdgcn_cvt_pk_f32_fp8(y, false), hi = __builtin_amdgcn_cvt_pk_f32_fp8(y, true);
            v[j].x += w * lo.x; v[j].y += w * lo.y; v[j].z += w * hi.x; v[j].w += w * hi.y; } }
    float s = 0.f;
#pragma unroll
    for (int j = 0; j < 4; ++j) s += v[j].x * v[j].x + v[j].y * v[j].y + v[j].z * v[j].z + v[j].w * v[j].w;
    const float rstd = 1.0f / sqrtf(wave_sum(s) * (1.f / DM) + EPS);
#pragma unroll
    for (int j = 0; j < 4; ++j) { const f32x4 g = *((const f32x4*)gfin + lane + 64 * j); xo[64 * j] = v[j] * rstd * g; }
}

#define GAS __attribute__((address_space(1)))
#define RLX_AGENT __ATOMIC_RELAXED, __HIP_MEMORY_SCOPE_AGENT
#define XB_TMO      128
#define XB_XCNT(j)  (256  + 64 * (j))
#define XB_XSUB(j)  (1280 + 64 * (j))
#define XB_XGEN(j)  (2304 + 64 * (j))
#define XB_TOP      3328
#define XB_TOPGEN   3392
#define XCD_BAR_WORDS 3456
#define XB_SPIN_CAP (1u << 18)
__device__ __forceinline__ unsigned xb_ld(unsigned* p)              { return __hip_atomic_load(p, __ATOMIC_RELAXED, __HIP_MEMORY_SCOPE_AGENT); }
__device__ __forceinline__ unsigned xb_add(unsigned* p, unsigned v) { return __hip_atomic_fetch_add(p, v, __ATOMIC_RELAXED, __HIP_MEMORY_SCOPE_AGENT); }
__device__ __forceinline__ unsigned xb_xcc_id() { return (unsigned)__builtin_amdgcn_s_getreg((3 << 11) | 20) & 0xFu; }
#define XB_SPIN(cond, bar) do { unsigned _sp = 0; while (cond) { __builtin_amdgcn_s_sleep(1); \
    if ((++_sp & 255u) == 0u) { if (xb_ld(&(bar)[XB_TMO])) break; if (_sp > XB_SPIN_CAP) { atomicAdd(&(bar)[XB_TMO], 1u); break; } } } } while (0)
struct XcdBarrier { unsigned* bar; unsigned x; volatile LDSP unsigned* st; };
__device__ __forceinline__ XcdBarrier xcd_barrier_post(unsigned* bar, volatile LDSP unsigned* st) {
    XcdBarrier b; b.bar = bar; b.x = xb_xcc_id(); b.st = st;
    if (threadIdx.x == 0) (void)xb_add(&bar[XB_XCNT(b.x)], 1u);
    return b;
}
__device__ __forceinline__ void xcd_barrier_complete(unsigned* bar, unsigned x, unsigned& nloc, unsigned& nx) {
    const unsigned G = gridDim.x * gridDim.y * gridDim.z;
    unsigned sum, cnt, mine, sp = 0u;
    for (;;) {
        sum = 0u; cnt = 0u; mine = 0u;
#pragma unroll
        for (unsigned j = 0; j < 16; ++j) { const unsigned c = xb_ld(&bar[XB_XCNT(j)]); sum += c; cnt += (c > 0u) ? 1u : 0u; mine = (j == x) ? c : mine; }
        if (sum == G) break;
        __builtin_amdgcn_s_sleep(1);
        if ((++sp & 255u) == 0u) { if (xb_ld(&bar[XB_TMO])) break; if (sp > XB_SPIN_CAP) { atomicAdd(&bar[XB_TMO], 1u); break; } }
    }
    nloc = mine > 0u ? mine : 1u; nx = cnt > 0u ? cnt : 1u;
}
__device__ __forceinline__ void xcd_barrier(const XcdBarrier& b) {
    asm volatile("s_waitcnt vmcnt(0)" ::: "memory");
    __syncthreads();
    if (threadIdx.x == 0) {
        unsigned* bar = b.bar;
        __builtin_amdgcn_s_waitcnt(0);
        unsigned nloc = b.st[0], nx = b.st[1];
        if (nloc == 0u) { xcd_barrier_complete(bar, b.x, nloc, nx); b.st[0] = nloc; b.st[1] = nx; }
        const unsigned old = xb_add(&bar[XB_XSUB(b.x)], 1u);
        const unsigned gen = old / nloc;
        if (old + 1u == (gen + 1u) * nloc) {
            __builtin_amdgcn_fence(__ATOMIC_RELEASE, "agent");
            asm volatile("s_waitcnt vmcnt(0)" ::: "memory");
            const unsigned og = xb_add(&bar[XB_TOP], 1u);
            const unsigned tg = og / nx;
            if (og + 1u == (tg + 1u) * nx) xb_add(&bar[XB_TOPGEN], 1u);
            else XB_SPIN(xb_ld(&bar[XB_TOPGEN]) == tg, bar);
            __builtin_amdgcn_fence(__ATOMIC_ACQUIRE, "agent");
            xb_add(&bar[XB_XGEN(b.x)], 1u);
            asm volatile("s_waitcnt vmcnt(0)" ::: "memory");
        } else {
            XB_SPIN(xb_ld(&bar[XB_XGEN(b.x)]) == gen, bar);
            __builtin_amdgcn_fence(__ATOMIC_ACQUIRE, "agent");
            asm volatile("s_waitcnt vmcnt(0)" ::: "memory");
        }
    }
    __syncthreads();
}

constexpr int LDS_BYTES = 147456;
constexpr int MISC_OFF = LDS_BYTES - 512;
constexpr int CW_BAR = 4096;
constexpr size_t CTL_ZERO_BYTES = 65536;
constexpr int NPHASE = 12;
struct Args { const float* in[22]; float* out; unsigned char* ws; int ph_lo, ph_hi; };

__global__ void __launch_bounds__(512, 2) mega(Args a) {
    extern __shared__ __attribute__((aligned(16))) unsigned char lds[];
    unsigned char* ws = a.ws; float* out = a.out;
    const float* x = a.in[0]; const float* mem = a.in[1]; const float* g_mix = a.in[2]; const float* w_in = a.in[3];
    const float* w_gla_gate = a.in[4]; const float* b_gla_gate = a.in[5]; const float* g_gla_head = a.in[6]; const float* w_out = a.in[7];
    const float* g_mem_q = a.in[8]; const float* g_mem_kv = a.in[9]; const float* w_mq = a.in[10]; const float* w_mk = a.in[11];
    const float* w_mv = a.in[12]; const float* w_mo = a.in[13]; const float* g_ffn = a.in[14]; const float* w_router = a.in[15];
    const float* b_router = a.in[16]; const float* w_gu = a.in[17]; const float* b_gu = a.in[18]; const float* w_down = a.in[19];
    const float* b_down = a.in[20]; const float* g_final = a.in[21];
    bf16_t* Wt_in = (bf16_t*)(ws + WS_WIN); bf16_t* Wt_out = (bf16_t*)(ws + WS_WOUT); bf16_t* Wq = (bf16_t*)(ws + WS_WQ); bf16_t* Wt_kv = (bf16_t*)(ws + WS_WKV);
    bf16_t* Wt_mo = (bf16_t*)(ws + WS_WMO); bf16_t* Wt_r = (bf16_t*)(ws + WS_WR); bf16_t* Wt_gu = (bf16_t*)(ws + WS_WGU); bf16_t* Wt_dn = (bf16_t*)(ws + WS_WDN);
    bf16_t* xn = (bf16_t*)(ws + WS_XN); bf16_t* memn = (bf16_t*)(ws + WS_MEMN); bf16_t* kv = (bf16_t*)(ws + WS_KV); bf16_t* Bs = (bf16_t*)(ws + WS_BS); bf16_t* Bo = (bf16_t*)(ws + WS_BO);
    bf16_t* proj = (bf16_t*)(ws + WS_PROJ); bf16_t* mix = (bf16_t*)(ws + WS_MIX);
    float* Sc = (float*)(ws + WS_S); bf16_t* P = (bf16_t*)(ws + WS_P); float* lg = (float*)(ws + WS_LG); int* toke = (int*)(ws + WS_TOKE); int* tokr = (int*)(ws + WS_TOKR);
    float* tokw = (float*)(ws + WS_TOKW); int* list = (int*)(ws + WS_LIST); unsigned char* ys = ws + WS_YS;
    unsigned char* Wq_gu = ws + WS_WGU; unsigned char* Wq_dn = ws + WS_WDN; unsigned char* x2q = ws + WS_S; unsigned char* act8 = ws + WS_ACT;
    float* lrs = (float*)(ws + WS_LG);
    float* UT = (float*)(ws + WS_S); float* decay = (float*)(ws + WS_LA); bf16_t* ST = (bf16_t*)(ws + WS_ORAW);
    unsigned* ctl = (unsigned*)(ws + WS_CTL); int* cnt = (int*)ctl + CW_CNT; float* ss1 = (float*)(ws + WS_LA + 8 * MiB); float* ss2 = (float*)(ws + WS_LA + 9 * MiB);

    const int G = gridDim.x, vb = blockIdx.x;
    volatile LDSP unsigned* MISC = (volatile LDSP unsigned*)(unsigned)(uintptr_t)(lds + MISC_OFF);
    if (threadIdx.x < 128) MISC[threadIdx.x] = 0u;
    __syncthreads();
    XcdBarrier bar = xcd_barrier_post(ctl + CW_BAR, MISC + 8);
    const int lo = a.ph_lo, hi = a.ph_hi;
    float* dmy = (float*)(ws + WS_DUMMY); (void)dmy;
#ifndef REPEAT_MASK
#define REPEAT_MASK 0
#endif
#define IN(k) (lo <= (k) && (k) < hi)
#define REP(k) for (int rep_ = 0; rep_ < 1 + ((REPEAT_MASK >> (k)) & 1); ++rep_)
#define SEAM(k) do { if (IN(k) && IN((k) + 1)) xcd_barrier(bar); } while (0)
#define TIDS() int tid = threadIdx.x; LAUNDER(tid); const int lane = tid & 63; const int wid = __builtin_amdgcn_readfirstlane(tid >> 6); (void)lane; (void)wid

    if (IN(0)) REP(0) { TIDS(); const size_t gt = (size_t)vb * 512 + tid, gs = (size_t)G * 512;
        float* scr = (float*)(lds + wid * 8448);
        const int gw = vb * 8 + wid, ngw = G * 8;
        rms_body(gw, ngw, lane, x, xn, NTOK);
        rms_body(gw, ngw, lane, mem, memn, NB * MEML);
        conv_n_body(gt, gs, w_mq, Wq, g_mem_q, 1024, 1024, LOG2E / 16.0f);
        constexpr int I_IN = 16 * 97, I_SQ = 16 * 32, I_R = 16, I_GU = 32 * 16 * 64, I_DN = 32 * 16 * 32;
        constexpr int NITEMS = I_IN + 4 * I_SQ + I_R + I_GU + I_DN;
        for (int it = gw; it < NITEMS; it += ngw) { int r = it;
            if (r < I_IN) { conv_item<1>(scr, w_in, Wt_in, g_mix, 3088, 1024, 3088, r / 97, r % 97, lane); continue; } r -= I_IN;
            if (r < I_SQ) { conv_item<0>(scr, w_out, Wt_out, nullptr, 1024, 1024, 1024, r >> 5, r & 31, lane); continue; } r -= I_SQ;
            if (r < I_SQ) { conv_item<0>(scr, w_mk, Wt_kv, g_mem_kv, 1024, 1024, 1024, r >> 5, r & 31, lane); continue; } r -= I_SQ;
            if (r < I_SQ) { conv_item<0>(scr, w_mv, Wt_kv + (size_t)1024 * 1024, g_mem_kv, 1024, 1024, 1024, r >> 5, r & 31, lane); continue; } r -= I_SQ;
            if (r < I_SQ) { conv_item<0>(scr, w_mo, Wt_mo, nullptr, 1024, 1024, 1024, r >> 5, r & 31, lane); continue; } r -= I_SQ;
            if (r < I_R) { conv_item<0>(scr, w_router, Wt_r, g_ffn, 32, 1024, 32, r, 0, lane); continue; } r -= I_R;
            if (r < I_GU) { const int e = r >> 10, q = r & 1023; conv_item8<2>(scr, w_gu + (size_t)e * 1024 * 2048, Wq_gu + (size_t)e * 2048 * 1024, g_ffn, 2048, 1024, 2048, q >> 6, q & 63, lane, (float)(1 << WSCALE_LOG2)); continue; } r -= I_GU;
            { const int e = r >> 9, q = r & 511; conv_item8<0>(scr, w_down + (size_t)e * 1024 * 1024, Wq_dn + (size_t)e * 1024 * 1024, nullptr, 1024, 1024, 1024, q >> 5, q & 31, lane, (float)(1 << WSCALE_LOG2)); } }
        __syncthreads(); }
    SEAM(0);
    if (IN(1)) REP(1) { DenseSched S{(const char*)xn, (const char*)Wt_in, 2048u, 2048u, 1024, 64, 12, 1 << 30, 0, G, vb}; EpiBf16 E{proj, PROJ_LD, 0}; gemm_run<true>(lds, S, E); }
    SEAM(1);
    if (IN(2)) REP(2) {
        for (int t = vb; t < 256; t += G) gla_pass_a(lds, t, xn, Wt_in + (size_t)3072 * 1024, proj, w_gla_gate, b_gla_gate, UT, decay);
        { TIDS(); for (int t = vb * 8 + wid; t < 4096; t += G * 8) sb_task(lds + wid * 4096, t, proj, mix, lane); }
        { TIDS(); for (int t = vb + G * wid; t < 1024; t += G * 8) memkv_task(t, lane, memn, Wt_kv, kv); } }
    SEAM(2);
    if (IN(3)) REP(3) {
        { TIDS(); for (int e = vb * 512 + tid; e < 65536; e += G * 512) gla_pass_b(e, UT, decay, ST); }
        { SchedWqk S{(const char*)kv, (const char*)Wq, 4096u, 2048u, 256, G / 2, vb - G / 2, 0}; EpiBf16 E{Bs, 1024, 0}; gemm_run<false>(lds, S, E); }
        { SchedVo S{(const char*)Wt_mo, (const char*)kv, 2048u, 4096u, 256, G / 2, vb - G / 2 - 32, 0}; EpiBf16 E{Bo, 1024, 0}; gemm_run<false>(lds, S, E); } }
    SEAM(3);
    if (IN(4)) REP(4) { TIDS(); for (int t = vb * 8 + wid; t < 2048; t += G * 8) gla_pass_c(lds + wid * 32 * GC_PITCH, t, ST, proj, g_gla_head, mix, lane); }
    SEAM(4);
#if PROBE_BARRIERS
    for (int pb_ = 0; pb_ < 8; ++pb_) xcd_barrier(bar);
#endif
    if (IN(5)) REP(5) { DenseSched S{(const char*)mix, (const char*)Wt_out, 2048u, 2048u, 1024, 64, 4, 1 << 30, 0, G, vb}; EpiResidSS<false> E{x, rep_ ? (bf16_t*)dmy : xn, rep_ ? dmy + 16 * 1024 * 1024 : ss1, nullptr}; gemm_run<false>(lds, S, E); }
    SEAM(5);
    if (IN(6)) REP(6) { DenseSched S{(const char*)xn, (const char*)Bs, 2048u, 2048u, 1024, 64, 4, 32, (size_t)1024 * 2048, G, vb}; EpiSoftmax E{ss1, P}; gemm_run<false>(lds, S, E); }
    SEAM(6);
    if (IN(7)) REP(7) { DenseSched S{(const char*)P, (const char*)Bo, 2048u, 2048u, 1024, 64, 4, 32, (size_t)1024 * 2048, G, vb}; EpiResidSS<true> E{xn, rep_ ? (bf16_t*)dmy : xn, rep_ ? dmy + 16 * 1024 * 1024 : ss2, rep_ ? (unsigned char*)dmy + 40 * 1024 * 1024 : x2q}; gemm_run<false>(lds, S, E); }
    SEAM(7);
    if (IN(8)) REP(8) { TIDS(); int* cntp = rep_ ? (int*)ctl + 2048 : cnt; int* listp = rep_ ? (int*)dmy + 1024 : list; float* lrsp = rep_ ? dmy + 4096 * 1024 : lrs; int* tokep = rep_ ? (int*)dmy + 1024 * 1024 : toke; int* tokrp = rep_ ? (int*)dmy + 2048 * 1024 : tokr; float* tokwp = rep_ ? dmy + 3072 * 1024 : tokw;
        int* lcnt = (int*)lds; int* gbase = (int*)lds + 32;
        for (int tb = vb; tb < NTOK / 64; tb += G) {
            if (tid < 32) lcnt[tid] = 0;
            __syncthreads();
            int oe[4] = {0, 0, 0, 0}; float ow[4] = {0.f, 0.f, 0.f, 0.f}; int lr[4] = {0, 0, 0, 0};
            if (wid < 2) { router_task(tb * 2 + wid, lane, xn, ss2, Wt_r, b_router, oe, ow);
                if (lane < 32) {
#pragma unroll
                    for (int k = 0; k < 4; ++k) lr[k] = atomicAdd(&lcnt[oe[k]], 1); } }
            __syncthreads();
            if (tid < 32) gbase[tid] = atomicAdd(&cntp[tid * 32], lcnt[tid]);
            __syncthreads();
            if (wid < 2 && lane < 32) { const int t = (tb * 2 + wid) * 32 + lane;
                const float rstd_t = row_rstd(ss2, t);
#pragma unroll
                for (int k = 0; k < 4; ++k) { const int r = gbase[oe[k]] + lr[k]; listp[oe[k] * NTOK + r] = t; lrsp[oe[k] * NTOK + r] = rstd_t; tokep[t * 4 + k] = oe[k]; tokrp[t * 4 + k] = r; tokwp[t * 4 + k] = ow[k]; } }
            __syncthreads(); } }
    SEAM(8);
    if (IN(9)) REP(9) { int* tab = (int*)(lds + 131072); { TIDS(); moe_build_table(tab, cnt, tid); }
        MoeSched<true> S{(const char*)x2q, (const char*)Wq_gu, 1024u, 1024u, 512, 8, (size_t)2048 * 1024, tab, list, 1, G, vb, 0}; EpiGU E{b_gu, act8, lrs}; gemm_run_fp8<true>(lds, S, E); }
    SEAM(9);
    if (IN(10)) REP(10) { int* tab = (int*)(lds + 131072); { TIDS(); moe_build_table(tab, cnt, tid); }
        MoeSched<false> S{(const char*)act8, (const char*)Wq_dn, 1024u, 1024u, 512, 4, (size_t)1024 * 1024, tab, list, 0, G, vb, 0}; EpiDown E{b_down, ys}; gemm_run_fp8<true>(lds, S, E); }
    SEAM(10);
    if (IN(11)) REP(11) { TIDS(); int* tab = (int*)(lds + 131072); moe_build_table(tab, cnt, tid);
        for (int t = vb * 8 + wid; t < NTOK; t += G * 8) combine_task(t, lane, xn, rep_ ? dmy : out, ys, tab, toke, tokr, tokw, g_final); }
#undef IN
#undef SEAM
#undef TIDS
}

#ifndef MK_PER_PHASE
#define MK_PER_PHASE 0
#endif
extern "C" void kernel_launch(void* const* d_in, const int* in_sizes, int n_in, void* d_out, int out_size, void* d_ws, size_t ws_size, hipStream_t stream) {
    static int grid = 0;
    if (grid == 0) {
        if (n_in != 22 || in_sizes[0] != NTOK * DM || out_size != NTOK * DM || ws_size < WS_END) { fprintf(stderr, "kernel_launch: unexpected shapes (n_in %d, ws %zu)\n", n_in, ws_size); grid = -1; return; }
        int dev = 0, cus = 0, per_cu = 0;
        if (hipGetDevice(&dev) != hipSuccess || hipDeviceGetAttribute(&cus, hipDeviceAttributeMultiprocessorCount, dev) != hipSuccess) { grid = -1; return; }
        if (hipFuncSetAttribute((const void*)mega, hipFuncAttributeMaxDynamicSharedMemorySize, LDS_BYTES) != hipSuccess) { fprintf(stderr, "kernel_launch: hipFuncSetAttribute failed\n"); grid = -1; return; }
        if (hipOccupancyMaxActiveBlocksPerMultiprocessor(&per_cu, (const void*)mega, 512, LDS_BYTES) != hipSuccess || per_cu < 1) fprintf(stderr, "kernel_launch: occupancy query says %d blocks/CU\n", per_cu);
        (void)hipGetLastError();
        grid = cus;
    }
    if (grid < 0) return;
    (void)hipMemsetAsync((char*)d_ws + WS_CTL, 0, CTL_ZERO_BYTES, stream);
    Args a{};
    for (int i = 0; i < 22; ++i) a.in[i] = (const float*)d_in[i];
    a.out = (float*)d_out; a.ws = (unsigned char*)d_ws;
#if MK_PER_PHASE
    for (int p = 0; p < NPHASE; ++p) { a.ph_lo = p; a.ph_hi = p + 1; hipLaunchKernelGGL(mega, dim3(grid), dim3(512), LDS_BYTES, stream, a); }
#else
    a.ph_lo = 0; a.ph_hi = NPHASE; hipLaunchKernelGGL(mega, dim3(grid), dim3(512), LDS_BYTES, stream, a);
#endif
}
```

```cpp
#include <hip/hip_runtime.h>
#include <cstdio>
#include <cstdint>
#ifndef PROBE_BARRIERS
#define PROBE_BARRIERS 0
#endif

typedef unsigned short bf16_t;
typedef short bf16x8 __attribute__((ext_vector_type(8)));
typedef float f32x4 __attribute__((ext_vector_type(4)));
typedef unsigned u32x4 __attribute__((ext_vector_type(4)));
typedef unsigned u32x2 __attribute__((ext_vector_type(2)));
typedef float f32x2 __attribute__((ext_vector_type(2)));
#define LDSP __attribute__((address_space(3)))
#define LAUNDER(x) asm volatile("" : "+v"(x))

constexpr int NB = 2, SEQ = 8192, NTOK = NB * SEQ, DM = 1024, MEML = 256;
constexpr int NEXP = 32, TOPK = 4, NASSIGN = NTOK * TOPK;
constexpr int PROJ_LD = 3072;
constexpr int C_QG = 0, C_KG = 256, C_VG = 512, C_RG = 1024, C_QS = 1536, C_KS = 2048, C_VS = 2560, C_GLR = 3072;
constexpr float LOG2E = 1.4426950408889634f;
constexpr float EPS = 1e-5f;

__device__ __forceinline__ unsigned f2bf(float f) { unsigned u = __float_as_uint(f); return (u + 0x7fffu + ((u >> 16) & 1u)) >> 16; }
__device__ __forceinline__ unsigned pk2(float lo, float hi) { return f2bf(lo) | (f2bf(hi) << 16); }
__device__ __forceinline__ float bf2f(bf16_t h) { return __uint_as_float(((unsigned)h) << 16); }
__device__ __forceinline__ float bflo(unsigned w) { return __uint_as_float(w << 16); }
__device__ __forceinline__ float bfhi(unsigned w) { return __uint_as_float(w & 0xffff0000u); }

constexpr size_t MiB = 1u << 20;
constexpr size_t WS_CTL = 0;
constexpr size_t WS_WIN = 1 * MiB;
constexpr size_t WS_WOUT = 8 * MiB;
constexpr size_t WS_WQ = 10 * MiB;
constexpr size_t WS_WKV = 12 * MiB;
constexpr size_t WS_WMO = 16 * MiB;
constexpr size_t WS_WR = 18 * MiB;
constexpr size_t WS_WGU = 20 * MiB;
constexpr size_t WS_WDN = 148 * MiB;
constexpr size_t WS_XN = 212 * MiB;
constexpr size_t WS_MEMN = 244 * MiB;
constexpr size_t WS_KV = 245 * MiB;
constexpr size_t WS_BS = 247 * MiB;
constexpr size_t WS_BO = 251 * MiB;
constexpr size_t WS_PROJ = 256 * MiB;
constexpr size_t WS_LA = 360 * MiB;
constexpr size_t WS_ORAW = 376 * MiB;
constexpr size_t WS_MIX = 408 * MiB;
constexpr size_t WS_S = 440 * MiB;
constexpr size_t WS_P = 504 * MiB;
constexpr size_t WS_LG = 536 * MiB;
constexpr size_t WS_TOKE = 538 * MiB;
constexpr size_t WS_TOKR = 539 * MiB;
constexpr size_t WS_TOKW = 540 * MiB;
constexpr size_t WS_LIST = 541 * MiB;
constexpr size_t WS_ACT = 544 * MiB;
constexpr size_t WS_YS = 674 * MiB;
constexpr size_t WS_DUMMY = 804 * MiB;
constexpr size_t WS_END = 872 * MiB;
constexpr int CW_CNT = 1024;

template <int MAP> __device__ __forceinline__ int srccol(int n, float& sc) {
    sc = 1.f;
    if (MAP == 0) return n;
    if (MAP == 1) {
        if (n < 256) { sc = 0.125f; return n; }
        if (n < 1024) return n;
        if (n < 3072) { if (n >= C_QS && n < C_KS) sc = 0.125f * LOG2E; return n + 16; }
        if (n < 3088) return 1024 + (n - 3072);
        return -1;
    }
    { const int ct = n >> 8, w = n & 255; return (w < 128) ? (128 * ct + w) : (1024 + 128 * ct + (w - 128)); }
}
template <int MAP>
__device__ __forceinline__ void conv_item(float* scr, const float* __restrict__ src, bf16_t* __restrict__ dst, const float* __restrict__ gain, int ldsrc, int K, int nrows, int kb, int nb, int lane) {
    const int k0 = kb * 64, n0 = nb * 32; float sc; const int c0 = srccol<MAP>(n0, sc);
    const int half = lane >> 5, l31 = lane & 31;
    const float* s0 = src + (size_t)(k0 + half) * ldsrc + c0 + l31;
    float v[32];
#pragma unroll
    for (int i = 0; i < 32; ++i) v[i] = __builtin_nontemporal_load(s0 + (size_t)(2 * i) * ldsrc);
#pragma unroll
    for (int i = 0; i < 32; ++i) { const int kk = 2 * i + half; const float g = (gain ? gain[k0 + kk] : 1.f) * sc; scr[kk * 33 + l31] = v[i] * g; }
    asm volatile("s_waitcnt lgkmcnt(0)" ::: "memory");
    const int c = lane & 7;
#pragma unroll
    for (int j = 0; j < 4; ++j) { const int n = (lane >> 3) + 8 * j; const float* s = scr + (8 * c) * 33 + n;
        u32x4 o; o.x = pk2(s[0 * 33], s[1 * 33]); o.y = pk2(s[2 * 33], s[3 * 33]); o.z = pk2(s[4 * 33], s[5 * 33]); o.w = pk2(s[6 * 33], s[7 * 33]);
        if (n0 + n < nrows) *(u32x4*)(dst + (size_t)(n0 + n) * K + k0 + 8 * c) = o; }
    asm volatile("s_waitcnt lgkmcnt(0)" ::: "memory");
}
__device__ __forceinline__ unsigned pk4_fp8(float a, float b, float c, float d) { int w = __builtin_amdgcn_cvt_pk_fp8_f32(a, b, 0, false); w = __builtin_amdgcn_cvt_pk_fp8_f32(c, d, w, true); return (unsigned)w; }
template <int MAP>
__device__ __forceinline__ void conv_item8(float* scr, const float* __restrict__ src, unsigned char* __restrict__ dst, const float* __restrict__ gain, int ldsrc, int K, int nrows, int kb, int nb, int lane, float mul) {
    const int k0 = kb * 64, n0 = nb * 32; float sc; const int c0 = srccol<MAP>(n0, sc); sc *= mul;
    const int half = lane >> 5, l31 = lane & 31;
    const float* s0 = src + (size_t)(k0 + half) * ldsrc + c0 + l31;
    float v[32];
#pragma unroll
    for (int i = 0; i < 32; ++i) v[i] = __builtin_nontemporal_load(s0 + (size_t)(2 * i) * ldsrc);
#pragma unroll
    for (int i = 0; i < 32; ++i) { const int kk = 2 * i + half; const float g = (gain ? gain[k0 + kk] : 1.f) * sc; scr[kk * 33 + l31] = v[i] * g; }
    asm volatile("s_waitcnt lgkmcnt(0)" ::: "memory");
    const int c = lane & 3;
#pragma unroll
    for (int j = 0; j < 2; ++j) { const int n = (lane >> 2) + 16 * j; const float* s = scr + (16 * c) * 33 + n;
        u32x4 o; o.x = pk4_fp8(s[0 * 33], s[1 * 33], s[2 * 33], s[3 * 33]); o.y = pk4_fp8(s[4 * 33], s[5 * 33], s[6 * 33], s[7 * 33]);
        o.z = pk4_fp8(s[8 * 33], s[9 * 33], s[10 * 33], s[11 * 33]); o.w = pk4_fp8(s[12 * 33], s[13 * 33], s[14 * 33], s[15 * 33]);
        if (n0 + n < nrows) *(u32x4*)(dst + (size_t)(n0 + n) * K + k0 + 16 * c) = o; }
    asm volatile("s_waitcnt lgkmcnt(0)" ::: "memory");
}
__device__ __forceinline__ void conv_n_body(size_t gtid, size_t gsz, const float* __restrict__ src, bf16_t* __restrict__ dst, const float* __restrict__ gain, int K, int nrows, float sc) {
    const int kc8 = K / 8; const size_t total = (size_t)nrows * kc8;
    for (size_t idx = gtid; idx < total; idx += gsz) {
        const int kc = (int)(idx % kc8), n = (int)(idx / kc8);
        const float g = gain[n] * sc; const f32x4 a = *(const f32x4*)(src + (size_t)n * K + kc * 8), b = *(const f32x4*)(src + (size_t)n * K + kc * 8 + 4);
        u32x4 o; o.x = pk2(a.x * g, a.y * g); o.y = pk2(a.z * g, a.w * g); o.z = pk2(b.x * g, b.y * g); o.w = pk2(b.z * g, b.w * g);
        *(u32x4*)(dst + (size_t)n * K + kc * 8) = o;
    }
}

__device__ __forceinline__ float wave_sum(float v) {
#pragma unroll
    for (int o = 1; o < 64; o <<= 1) v += __shfl_xor(v, o);
    return v;
}
__device__ __forceinline__ void rms_body(int gw, int ngw, int lane, const float* __restrict__ x, bf16_t* __restrict__ out, int nrows) {
    for (int row = gw; row < nrows; row += ngw) {
        const f32x4* xr = (const f32x4*)(x + (size_t)row * DM) + lane; f32x4 v[4]; float s = 0.f;
#pragma unroll
        for (int j = 0; j < 4; ++j) { v[j] = __builtin_nontemporal_load(xr + 64 * j); s += v[j].x * v[j].x + v[j].y * v[j].y + v[j].z * v[j].z + v[j].w * v[j].w; }
        const float rstd = 1.0f / sqrtf(wave_sum(s) * (1.f / DM) + EPS);
        u32x2* o = (u32x2*)(out + (size_t)row * DM) + lane;
#pragma unroll
        for (int j = 0; j < 4; ++j) { u32x2 w; w.x = pk2(v[j].x * rstd, v[j].y * rstd); w.y = pk2(v[j].z * rstd, v[j].w * rstd); o[64 * j] = w; }
    }
}

struct GUnit { unsigned ao, bo; int row0, col0, e, valid, aux; };

__host__ __device__ __forceinline__ int lds_byte(int r, int c) { const int st = (r >> 4) * 2 + (c >> 5), rr = r & 15, cc = c & 31, ob = rr * 64 + cc * 2; return st * 1024 + (ob ^ (((ob >> 9) & 1) << 5)); }
__host__ __device__ __forceinline__ void stage_rc(int b, int& R, int& C) { const int st = b / 1024, sb = b % 1024, swz = sb ^ (((sb >> 9) & 1) << 5); R = (st >> 1) * 16 + swz / 64; C = (st & 1) * 32 + (swz % 64) / 2; }
__host__ __device__ __forceinline__ int perm32(int rho) { const int n = rho >> 4, i = rho & 15; return 8 * (i >> 2) + 4 * n + (i & 3); }
constexpr int HTB = 128 * 64 * 2;
typedef int v8i __attribute__((ext_vector_type(8)));
typedef int v4i __attribute__((ext_vector_type(4)));
struct Frag2 { bf16x8 h[2]; };
template <bool F> struct FragT { typedef Frag2 T; };
template <> struct FragT<true> { typedef v8i T; };
template <class Sched, class Epi, bool ALIGN_EPI, bool FP8 = false, int SCALE_B = 0x7f>
__device__ __forceinline__ void gemm_phase(unsigned char* lds_flat, const Sched& S, const Epi& E) {
    LDSP unsigned char* lds = (LDSP unsigned char*)(unsigned)(uintptr_t)lds_flat;
    int tid = threadIdx.x; LAUNDER(tid);
    const int wid = __builtin_amdgcn_readfirstlane(tid >> 6), lane = tid & 63, wr = wid >> 2, wc = wid & 3, fr = lane & 15, fq = lane >> 4;
    const int nt = S.K / 64;
    int Rr[2], Cc[2];
#pragma unroll
    for (int i = 0; i < 2; ++i) stage_rc(tid * 16 + i * 8192, Rr[i], Cc[i]);
    unsigned voffB[2][2];
#pragma unroll
    for (int h = 0; h < 2; ++h)
#pragma unroll
        for (int i = 0; i < 2; ++i) voffB[h][i] = (unsigned)(128 * h + (Rr[i] & ~31) + perm32(Rr[i] & 31)) * S.ldb + (unsigned)Cc[i] * 2u;
    const unsigned ldsw = (unsigned)wid * 1024u;
    const int aoff = lds_byte(wr * 64 + fr, fq * 8), boff = lds_byte(wc * 32 + fr, fq * 8);
    constexpr int KSUB = 1024;
#define PG8_SA(b, h) (((b) * 2 + (h)) * HTB)
#define PG8_SB(b, h) ((4 + (b) * 2 + (h)) * HTB)
#define PG8_STAGE(bufoff, rsrc, voff, soff) do { _Pragma("unroll") for (int _i = 0; _i < 2; ++_i) \
        __builtin_amdgcn_raw_ptr_buffer_load_lds(rsrc, (LDSP unsigned*)(lds + (bufoff) + ldsw + _i * 8192), 16, (int)(voff)[_i], (int)(soff), 0, 0); } while (0)
#define PG8_LDF(dst, addr) do { const bf16x8 lo_ = *(const LDSP bf16x8*)(addr); const bf16x8 hi_ = *(const LDSP bf16x8*)((addr) + KSUB); \
        if constexpr (FP8) dst = __builtin_shufflevector(__builtin_bit_cast(v4i, lo_), __builtin_bit_cast(v4i, hi_), 0, 1, 2, 3, 4, 5, 6, 7); else { dst.h[0] = lo_; dst.h[1] = hi_; } } while (0)
#define PG8_LDA(dst, b, h) do { _Pragma("unroll") for (int m = 0; m < 4; ++m) PG8_LDF(dst[m], lds + PG8_SA(b, h) + aoff + m * 2048); } while (0)
#define PG8_LDB(dst, b, h) do { _Pragma("unroll") for (int n = 0; n < 2; ++n) PG8_LDF(dst[n], lds + PG8_SB(b, h) + boff + n * 2048); } while (0)
#define PG8_MMA(ai, bj, At, Bt) do { __builtin_amdgcn_s_setprio(1); _Pragma("unroll") for (int m = 0; m < 4; ++m) _Pragma("unroll") for (int n = 0; n < 2; ++n) { \
        if constexpr (FP8) asm volatile("v_mfma_scale_f32_16x16x128_f8f6f4 %0, %1, %2, %0, %3, %4 op_sel_hi:[0,0,0]" : "+v"(acc[ai][bj][m][n]) : "v"(Bt[n]), "v"(At[m]), "v"(sclB), "v"(sclA)); \
        else { _Pragma("unroll") for (int k = 0; k < 2; ++k) acc[ai][bj][m][n] = __builtin_amdgcn_mfma_f32_16x16x32_bf16(Bt[n].h[k], At[m].h[k], acc[ai][bj][m][n], 0, 0, 0); } } \
        __builtin_amdgcn_s_setprio(0); } while (0)
#define PG8_WAIT_V(n) asm volatile("s_waitcnt vmcnt(" #n ")" ::: "memory")
#define PG8_WAIT_L(n) asm volatile("s_waitcnt lgkmcnt(" #n ")" ::: "memory")
#define PG8_BAR __builtin_amdgcn_s_barrier()
#define PG8_SCHED __builtin_amdgcn_sched_barrier(0)
    GUnit cur, nxt; int ui = 0;
    if (!S.next(0, cur)) return;
    const __amdgpu_buffer_rsrc_t rA = __builtin_amdgcn_make_buffer_rsrc((void*)S.A, 0, 0x7fffffff, 0x00020000);
    const __amdgpu_buffer_rsrc_t rB = __builtin_amdgcn_make_buffer_rsrc((void*)S.Bt, 0, 0x7fffffff, 0x00020000);
    unsigned oc[2][2], on[2][2];
#pragma unroll
    for (int h = 0; h < 2; ++h)
#pragma unroll
        for (int i = 0; i < 2; ++i) oc[h][i] = S.a_off(cur, 128 * h + Rr[i]) + (unsigned)Cc[i] * 2u;
    f32x4 acc[2][2][4][2];
#pragma unroll
    for (int a = 0; a < 2; ++a)
#pragma unroll
        for (int b = 0; b < 2; ++b)
#pragma unroll
            for (int m = 0; m < 4; ++m)
#pragma unroll
                for (int n = 0; n < 2; ++n) acc[a][b][m][n] = (f32x4){0.f, 0.f, 0.f, 0.f};
    typedef typename FragT<FP8>::T frag_t;
    frag_t At[4], B0[2], B1[2];
    const unsigned kstep = 128;
    const int sclB = SCALE_B * 0x01010101, sclA = 0x7f7f7f7f; (void)sclA; (void)sclB;
    PG8_STAGE(PG8_SB(0, 0), rB, voffB[0], cur.bo); PG8_STAGE(PG8_SB(0, 1), rB, voffB[1], cur.bo); PG8_STAGE(PG8_SA(0, 0), rA, oc[0], cur.ao); PG8_STAGE(PG8_SA(0, 1), rA, oc[1], cur.ao);
    if (wr == 1) PG8_BAR;
    PG8_WAIT_V(2); PG8_BAR;
    PG8_STAGE(PG8_SB(1, 0), rB, voffB[0], cur.bo + kstep); PG8_STAGE(PG8_SA(1, 0), rA, oc[0], cur.ao + kstep); PG8_STAGE(PG8_SB(1, 1), rB, voffB[1], cur.bo + kstep);
    PG8_WAIT_V(6); PG8_BAR;
    for (;;) {
        const bool has_next = S.next(ui + 1, nxt);
        if (!has_next) nxt = cur;
        const unsigned nA = nxt.ao, nB = nxt.bo;
        { int t2 = threadIdx.x; LAUNDER(t2);
#pragma unroll
          for (int i = 0; i < 2; ++i) { int R_, C_; stage_rc(t2 * 16 + i * 8192, R_, C_);
#pragma unroll
              for (int h = 0; h < 2; ++h) on[h][i] = S.a_off(nxt, 128 * h + R_) + (unsigned)C_ * 2u; } }
        for (int t = 0; t < nt; t += 2) {
            const bool last = (t == nt - 2);
            const unsigned k1 = cur.ao + (unsigned)(t + 1) * kstep;
            const unsigned a2 = last ? nA : cur.ao + (unsigned)(t + 2) * kstep, b2 = last ? nB : cur.bo + (unsigned)(t + 2) * kstep, a3 = a2 + kstep, b3 = b2 + kstep;
            unsigned o2[2][2];
#pragma unroll
            for (int h = 0; h < 2; ++h)
#pragma unroll
                for (int i = 0; i < 2; ++i) o2[h][i] = last ? on[h][i] : oc[h][i];
            PG8_LDB(B0, 0, 0); PG8_LDB(B1, 0, 1); PG8_SCHED; PG8_LDA(At, 0, 0); PG8_STAGE(PG8_SA(1, 1), rA, oc[1], k1);
            PG8_WAIT_V(8); PG8_WAIT_L(0); PG8_BAR; PG8_MMA(0, 0, At, B0); PG8_MMA(0, 1, At, B1); PG8_BAR; PG8_SCHED;
            PG8_LDA(At, 0, 1); PG8_STAGE(PG8_SB(0, 0), rB, voffB[0], b2); PG8_STAGE(PG8_SB(0, 1), rB, voffB[1], b2); PG8_STAGE(PG8_SA(0, 0), rA, o2[0], a2);
            PG8_WAIT_V(8); PG8_WAIT_L(0); PG8_BAR; PG8_MMA(1, 0, At, B0); PG8_MMA(1, 1, At, B1); PG8_BAR; PG8_SCHED;
            PG8_LDB(B0, 1, 0); PG8_LDB(B1, 1, 1); PG8_SCHED; PG8_LDA(At, 1, 0); PG8_STAGE(PG8_SA(0, 1), rA, o2[1], a2);
            PG8_WAIT_V(8); PG8_WAIT_L(0); PG8_BAR; PG8_MMA(0, 0, At, B0); PG8_MMA(0, 1, At, B1); PG8_BAR; PG8_SCHED;
            PG8_LDA(At, 1, 1); PG8_STAGE(PG8_SB(1, 0), rB, voffB[0], b3); PG8_STAGE(PG8_SB(1, 1), rB, voffB[1], b3); PG8_STAGE(PG8_SA(1, 0), rA, o2[0], a3);
            PG8_WAIT_V(8); PG8_WAIT_L(0); PG8_BAR; PG8_MMA(1, 0, At, B0); PG8_MMA(1, 1, At, B1); PG8_BAR; PG8_SCHED;
        }
        if constexpr (FP8) asm volatile("s_nop 15\n\ts_nop 15" ::: "memory");
        if constexpr (ALIGN_EPI) { if (wr == 0) PG8_BAR; }
        if constexpr (!Epi::AFTER_DRAIN) E(acc, cur, wr, wc, fr, fq);
        if (!has_next) break;
#pragma unroll
        for (int a = 0; a < 2; ++a)
#pragma unroll
            for (int b = 0; b < 2; ++b)
#pragma unroll
                for (int m = 0; m < 4; ++m)
#pragma unroll
                    for (int n = 0; n < 2; ++n) acc[a][b][m][n] = (f32x4){0.f, 0.f, 0.f, 0.f};
        cur = nxt; ++ui;
#pragma unroll
        for (int h = 0; h < 2; ++h)
#pragma unroll
            for (int i = 0; i < 2; ++i) oc[h][i] = on[h][i];
        if constexpr (ALIGN_EPI) { if (wr == 1) PG8_BAR; }
    }
    PG8_WAIT_V(0);
    if constexpr (!ALIGN_EPI) { if (wr == 0) PG8_BAR; }
    PG8_BAR;
    if constexpr (Epi::AFTER_DRAIN) E.fused(acc, cur, wr, wc, fr, fq, lds_flat, wid, lane);
#undef PG8_SA
#undef PG8_SB
#undef PG8_STAGE
#undef PG8_LDA
#undef PG8_LDF
#undef PG8_LDB
#undef PG8_MMA
#undef PG8_WAIT_V
#undef PG8_WAIT_L
#undef PG8_BAR
#undef PG8_SCHED
}
template <bool ALIGN, class Sched, class Epi> __device__ __forceinline__ void gemm_run(unsigned char* lds, const Sched& S, const Epi& E) {
    gemm_phase<Sched, Epi, ALIGN>(lds, S, E);
}
constexpr int WSCALE_LOG2 = 6;
template <bool ALIGN, class Sched, class Epi> __device__ __forceinline__ void gemm_run_fp8(unsigned char* lds, const Sched& S, const Epi& E) {
    gemm_phase<Sched, Epi, ALIGN, true, 127 - WSCALE_LOG2>(lds, S, E);
}

struct DenseSched {
    const char* A; const char* Bt; unsigned lda, ldb; int K; int nM, nN; int pm_per_b; size_t zB; int G, c;
    __device__ __forceinline__ bool next(int i, GUnit& u) const {
        int pm, pn;
        if (G == 256 && (nN & 3) == 0 && nM * nN >= 256) {
            const int j = c & 7, q = c >> 3, s = i * 8 + j, ncg = nN >> 2; pm = (s / ncg) * 8 + (q >> 2); pn = (s % ncg) * 4 + (q & 3); if (c < 0 || pm >= nM) return false; }
        else { const long L = (long)i * G + c; if (c < 0 || L >= (long)nM * nN) return false; pm = (int)(L / nN); pn = (int)(L % nN); }
        u.ao = (unsigned)pm * 256u * lda; u.bo = (unsigned)((size_t)(pm / pm_per_b) * zB) + (unsigned)pn * 256u * ldb; u.row0 = pm * 256; u.col0 = pn * 256; u.e = 0; u.valid = 256; u.aux = 0; return true;
    }
    __device__ __forceinline__ unsigned a_off(const GUnit&, int r) const { return (unsigned)r * lda; }
};
struct SchedWqk {
    const char* A; const char* Bt; unsigned lda, ldb; int K; int G, c, pad;
    __device__ __forceinline__ bool next(int i, GUnit& u) const {
        const int L = i * G + c; if (c < 0 || L >= 32) return false; const int z = L >> 2, pn = L & 3, b = z >> 2, h = z & 3;
        u.ao = (unsigned)b * 256u * 4096u + h * 512u; u.bo = (unsigned)pn * 256u * 2048u + h * 512u; u.row0 = z * 256; u.col0 = pn * 256; u.e = 0; u.valid = 256; u.aux = 0; return true;
    }
    __device__ __forceinline__ unsigned a_off(const GUnit&, int r) const { return (unsigned)r * lda; }
};
struct SchedVo {
    const char* A; const char* Bt; unsigned lda, ldb; int K; int G, c, pad;
    __device__ __forceinline__ bool next(int i, GUnit& u) const {
        const int L = i * G + c; if (c < 0 || L >= 32) return false; const int z = L >> 2, pm = L & 3, b = z >> 2, h = z & 3;
        u.ao = (unsigned)pm * 256u * 2048u + h * 512u; u.bo = (unsigned)b * 256u * 4096u + 2048u + h * 512u; u.row0 = b * 1024 + pm * 256; u.col0 = h * 256; u.e = 0; u.valid = 256; u.aux = 0; return true;
    }
    __device__ __forceinline__ unsigned a_off(const GUnit&, int r) const { return (unsigned)r * lda; }
};
template <bool GATHER> struct MoeSched {
    const char* A; const char* Bt; unsigned lda, ldb; int K; int nN; size_t zB;
    const int* tab; const int* list; int gather; int G, c, pad;
    __device__ __forceinline__ bool next(int i, GUnit& u) const {
        int T, pn;
        if (G == 256) { const int j = c & 7, q = c >> 3, s = i * 8 + j;
            if (nN == 8) { T = 4 * s + (q >> 3); pn = q & 7; } else { T = 8 * s + (q >> 2); pn = q & 3; } }
        else { const int L = i * G + c; T = L / nN; pn = L % nN; }
        if (T >= __builtin_amdgcn_readfirstlane(tab[64])) return false;
        const int w = __builtin_amdgcn_readfirstlane(tab[128 + T]); const int e = w & 255, rt = w >> 8; const int ce = __builtin_amdgcn_readfirstlane(tab[e]), start = __builtin_amdgcn_readfirstlane(tab[32 + e]);
        u.e = e; u.valid = min(256, ce - rt * 256); u.row0 = start + rt * 256; u.col0 = pn * 256; u.aux = rt * 256;
        u.ao = GATHER ? 0u : (unsigned)u.row0 * lda; u.bo = (unsigned)((size_t)e * zB) + (unsigned)pn * 256u * ldb; return true;
    }
    __device__ __forceinline__ unsigned a_off(const GUnit& u, int r) const {
        if (!GATHER) return (unsigned)r * lda;
        const int rr = r < u.valid ? r : 0; const int tok = list[u.e * NTOK + u.aux + rr]; return (unsigned)tok * lda;
    }
};
__device__ __forceinline__ void moe_build_table(int* tab, const int* __restrict__ cnt, int tid) {
    if (tid < 32) tab[tid] = cnt[tid * 32];
    __syncthreads();
    if (tid < 32) { int s = 0; for (int e = 0; e < tid; ++e) s += tab[e]; tab[32 + tid] = s; }
    if (tid < 320) { int tiles = 0, found = -1;
        for (int e = 0; e < NEXP; ++e) { const int te = (tab[e] + 255) >> 8; if (found < 0 && tid < tiles + te) found = e | ((tid - tiles) << 8); tiles += te; }
        if (found >= 0) tab[128 + tid] = found; if (tid == 0) tab[64] = tiles; }
    __syncthreads();
}

__device__ __forceinline__ u32x4 pack8(const f32x4& a, const f32x4& b) { u32x4 w; w.x = pk2(a[0], a[1]); w.y = pk2(a[2], a[3]); w.z = pk2(b[0], b[1]); w.w = pk2(b[2], b[3]); return w; }
struct EpiBf16 { static constexpr bool AFTER_DRAIN = false; bf16_t* O; int ldc, pad;
    __device__ __forceinline__ void operator()(const f32x4 (&acc)[2][2][4][2], const GUnit& u, int wr, int wc, int fr, int fq) const {
        LAUNDER(fr); LAUNDER(fq);
#pragma unroll
        for (int ai = 0; ai < 2; ++ai)
#pragma unroll
            for (int m = 0; m < 4; ++m) { const int r = 128 * ai + 64 * wr + 16 * m + fr;
#pragma unroll
                for (int bj = 0; bj < 2; ++bj) *(u32x4*)(O + (size_t)(u.row0 + r) * ldc + u.col0 + 128 * bj + 32 * wc + 8 * fq) = pack8(acc[ai][bj][m][0], acc[ai][bj][m][1]); } } };
__device__ __forceinline__ float row_rstd(const float* __restrict__ ssp, int row) { const f32x4* p = (const f32x4*)(ssp + (size_t)row * 16); const f32x4 a = p[0], b = p[1], c = p[2], d = p[3];
    const float s = (((a[0] + a[1]) + (a[2] + a[3])) + ((b[0] + b[1]) + (b[2] + b[3]))) + (((c[0] + c[1]) + (c[2] + c[3])) + ((d[0] + d[1]) + (d[2] + d[3]))); return 1.0f / sqrtf(s * (1.0f / 1024.0f) + EPS); }
template <bool BASE_BF16> struct EpiResidSS { static constexpr bool AFTER_DRAIN = false; const void* base; bf16_t* xb; float* ss; unsigned char* xq;
    __device__ __forceinline__ void operator()(const f32x4 (&acc)[2][2][4][2], const GUnit& u, int wr, int wc, int fr, int fq) const {
        LAUNDER(fr); LAUNDER(fq);
#pragma unroll
        for (int ai = 0; ai < 2; ++ai) {
            f32x4 b[4][2][2];
#pragma unroll
            for (int m = 0; m < 4; ++m)
#pragma unroll
                for (int bj = 0; bj < 2; ++bj) { const size_t o = (size_t)(u.row0 + 128 * ai + 64 * wr + 16 * m + fr) * 1024 + u.col0 + 128 * bj + 32 * wc + 8 * fq;
                    if (BASE_BF16) { const u32x4 w = *(const u32x4*)((const bf16_t*)base + o); b[m][bj][0] = (f32x4){bflo(w.x), bfhi(w.x), bflo(w.y), bfhi(w.y)}; b[m][bj][1] = (f32x4){bflo(w.z), bfhi(w.z), bflo(w.w), bfhi(w.w)}; }
                    else { b[m][bj][0] = *(const f32x4*)((const float*)base + o); b[m][bj][1] = *(const f32x4*)((const float*)base + o + 4); } }
#pragma unroll
            for (int m = 0; m < 4; ++m) { const int r = 128 * ai + 64 * wr + 16 * m + fr; float part = 0.f;
#pragma unroll
                for (int bj = 0; bj < 2; ++bj) { const size_t o = (size_t)(u.row0 + r) * 1024 + u.col0 + 128 * bj + 32 * wc + 8 * fq;
                    const f32x4 y0 = b[m][bj][0] + acc[ai][bj][m][0], y1 = b[m][bj][1] + acc[ai][bj][m][1]; *(u32x4*)(xb + o) = pack8(y0, y1);
                    if (xq) { u32x2 q; q.x = pk4_fp8(y0[0], y0[1], y0[2], y0[3]); q.y = pk4_fp8(y1[0], y1[1], y1[2], y1[3]); *(u32x2*)(xq + o) = q; }
                    part += (y0[0] * y0[0] + y0[1] * y0[1] + y0[2] * y0[2] + y0[3] * y0[3]) + (y1[0] * y1[0] + y1[1] * y1[1] + y1[2] * y1[2] + y1[3] * y1[3]); }
                part += __shfl_xor(part, 16); part += __shfl_xor(part, 32);
                if (fq == 0) ss[(size_t)(u.row0 + r) * 16 + (u.col0 >> 8) * 4 + wc] = part; } } } };
struct EpiSoftmax { static constexpr bool AFTER_DRAIN = true; const float* ss; bf16_t* P;
    __device__ __forceinline__ void operator()(const f32x4 (&)[2][2][4][2], const GUnit&, int, int, int, int) const {}
    __device__ __forceinline__ void fused(f32x4 (&acc)[2][2][4][2], const GUnit& u, int wr, int wc, int fr, int fq, unsigned char* lds, int wid, int lane) const {
        float* Pm = (float*)lds; float* Ps = (float*)(lds + 4096);
        LAUNDER(fr); LAUNDER(fq);
#pragma unroll
        for (int ai = 0; ai < 2; ++ai)
#pragma unroll
            for (int m = 0; m < 4; ++m) { const int r = 128 * ai + 64 * wr + 16 * m + fr; const float rstd = row_rstd(ss, u.row0 + r); float mv = -INFINITY;
#pragma unroll
                for (int bj = 0; bj < 2; ++bj)
#pragma unroll
                    for (int n = 0; n < 2; ++n) { f32x4 s = acc[ai][bj][m][n] * rstd; acc[ai][bj][m][n] = s; mv = fmaxf(mv, fmaxf(fmaxf(s[0], s[1]), fmaxf(s[2], s[3]))); }
                mv = fmaxf(mv, __shfl_xor(mv, 16)); mv = fmaxf(mv, __shfl_xor(mv, 32));
                if (fq == 0) Pm[r * 4 + wc] = mv; }
        __syncthreads();
#pragma unroll
        for (int ai = 0; ai < 2; ++ai)
#pragma unroll
            for (int m = 0; m < 4; ++m) { const int r = 128 * ai + 64 * wr + 16 * m + fr; const f32x4 pm = *(const f32x4*)(Pm + r * 4); const float mv = fmaxf(fmaxf(pm[0], pm[1]), fmaxf(pm[2], pm[3])); float sum = 0.f;
#pragma unroll
                for (int bj = 0; bj < 2; ++bj)
#pragma unroll
                    for (int n = 0; n < 2; ++n) { f32x4 s = acc[ai][bj][m][n]; s[0] = __builtin_amdgcn_exp2f(s[0] - mv); s[1] = __builtin_amdgcn_exp2f(s[1] - mv); s[2] = __builtin_amdgcn_exp2f(s[2] - mv); s[3] = __builtin_amdgcn_exp2f(s[3] - mv);
                        acc[ai][bj][m][n] = s; sum += (s[0] + s[1]) + (s[2] + s[3]); }
                sum += __shfl_xor(sum, 16); sum += __shfl_xor(sum, 32);
                if (fq == 0) Ps[r * 4 + wc] = sum; }
        __syncthreads();
#pragma unroll
        for (int ai = 0; ai < 2; ++ai)
#pragma unroll
            for (int m = 0; m < 4; ++m) { const int r = 128 * ai + 64 * wr + 16 * m + fr; const f32x4 ps = *(const f32x4*)(Ps + r * 4); const float inv = 1.0f / ((ps[0] + ps[1]) + (ps[2] + ps[3]));
#pragma unroll
                for (int bj = 0; bj < 2; ++bj) *(u32x4*)(P + (size_t)(u.row0 + r) * 1024 + u.col0 + 128 * bj + 32 * wc + 8 * fq) = pack8(acc[ai][bj][m][0] * inv, acc[ai][bj][m][1] * inv); }
        (void)wid; (void)lane;
        __syncthreads();
    } };
struct EpiGU { static constexpr bool AFTER_DRAIN = false; const float* bgu; unsigned char* act  ; const float* lrs  ;
    __device__ __forceinline__ void operator()(const f32x4 (&acc)[2][2][4][2], const GUnit& u, int wr, int wc, int fr, int fq) const {
        const int pn = u.col0 >> 8; const float* bg = bgu + (size_t)u.e * 2048; LAUNDER(fr); LAUNDER(fq);
        float rs[8];
#pragma unroll
        for (int i = 0; i < 8; ++i) { const int r = 128 * (i >> 2) + 64 * wr + 16 * (i & 3) + fr; rs[i] = lrs[(size_t)u.e * NTOK + u.aux + (r < u.valid ? r : 0)]; }
        const int col = 128 * pn + 32 * wc + 8 * fq;
        f32x4 bgv[2], blv[2];
#pragma unroll
        for (int n = 0; n < 2; ++n) { bgv[n] = *(const f32x4*)(bg + col + 4 * n); blv[n] = *(const f32x4*)(bg + 1024 + col + 4 * n); }
#pragma unroll
        for (int ai = 0; ai < 2; ++ai)
#pragma unroll
            for (int m = 0; m < 4; ++m) { const int r = 128 * ai + 64 * wr + 16 * m + fr; const float rstd = rs[ai * 4 + m]; u32x2 q;
#pragma unroll
                for (int n = 0; n < 2; ++n) { const f32x4 g = acc[ai][0][m][n] * rstd + bgv[n], l = acc[ai][1][m][n] * rstd + blv[n]; float o[4];
#pragma unroll
                    for (int j = 0; j < 4; ++j) { const float gg = fminf(g[j], 7.0f), ll = fminf(fmaxf(l[j], -7.0f), 7.0f); o[j] = (ll + 1.0f) * (gg * __builtin_amdgcn_rcpf(1.0f + __builtin_amdgcn_exp2f(-1.702f * LOG2E * gg))); }
                    const unsigned w = pk4_fp8(o[0], o[1], o[2], o[3]); if (n == 0) q.x = w; else q.y = w; }
                if (r < u.valid) *(u32x2*)(act + (size_t)(u.row0 + r) * 1024 + col) = q; } } };
struct EpiDown { static constexpr bool AFTER_DRAIN = false; const float* bdn; unsigned char* ys  ;
    __device__ __forceinline__ void operator()(const f32x4 (&acc)[2][2][4][2], const GUnit& u, int wr, int wc, int fr, int fq) const {
        const float* bd = bdn + (size_t)u.e * 1024; LAUNDER(fr); LAUNDER(fq);
        f32x4 bv[2][2];
#pragma unroll
        for (int bj = 0; bj < 2; ++bj)
#pragma unroll
            for (int n = 0; n < 2; ++n) bv[bj][n] = *(const f32x4*)(bd + u.col0 + 128 * bj + 32 * wc + 8 * fq + 4 * n);
#pragma unroll
        for (int ai = 0; ai < 2; ++ai)
#pragma unroll
            for (int m = 0; m < 4; ++m) { const int r = 128 * ai + 64 * wr + 16 * m + fr; if (r < u.valid) {
#pragma unroll
                for (int bj = 0; bj < 2; ++bj) { const f32x4 y0 = acc[ai][bj][m][0] + bv[bj][0], y1 = acc[ai][bj][m][1] + bv[bj][1]; u32x2 q; q.x = pk4_fp8(y0[0], y0[1], y0[2], y0[3]); q.y = pk4_fp8(y1[0], y1[1], y1[2], y1[3]);
                    *(u32x2*)(ys + (size_t)(u.row0 + r) * 1024 + u.col0 + 128 * bj + 32 * wc + 8 * fq) = q; } } } } };


typedef float f32x16 __attribute__((ext_vector_type(16)));
typedef short s16x4 __attribute__((ext_vector_type(4)));
__device__ __forceinline__ int crow(int r, int hi) { return (r & 3) + 8 * (r >> 2) + 4 * hi; }
__device__ __forceinline__ s16x4 tr_read(const unsigned char* p) { return __builtin_bit_cast(s16x4, __builtin_amdgcn_ds_read_tr16_b64_v4i16((LDSP s16x4*)(unsigned)(uintptr_t)p)); }
__device__ __forceinline__ bf16x8 tr_frag(const unsigned char* img, int pitch, int k0, int f0, int lane) {
    const unsigned char* p = img + (k0 + 8 * (lane >> 5) + ((lane & 15) >> 2)) * pitch + (f0 + 16 * ((lane >> 4) & 1) + 4 * (lane & 3)) * 2;
    const s16x4 lo = tr_read(p), hi = tr_read(p + 4 * pitch);
    return (bf16x8){lo[0], lo[1], lo[2], lo[3], hi[0], hi[1], hi[2], hi[3]};
}
constexpr int GA_PK = 576, GA_PV = 1088;
constexpr int GA_V = 0, GA_PART = 0, GA_GLR = 69632, GA_TOT = 73728, GA_KD = 75776, GA_END = GA_KD + 64 * GA_PK;
__device__ __forceinline__ void gla_pass_a(unsigned char* lds, int task, const bf16_t* __restrict__ xn, const bf16_t* __restrict__ wglr  , const bf16_t* __restrict__ proj,
                                           const float* __restrict__ wg, const float* __restrict__ bg, float* __restrict__ UT, float* __restrict__ decay) {
    int tid = threadIdx.x; LAUNDER(tid); int wid = tid >> 6, lane = tid & 63, fr = lane & 15, fq = lane >> 4;
    const size_t t0 = (size_t)task * 64;
    { f32x4 acc[4];
#pragma unroll
      for (int m = 0; m < 4; ++m) acc[m] = (f32x4){0.f, 0.f, 0.f, 0.f};
#pragma unroll
      for (int ks = 0; ks < 4; ++ks) { const int k = 128 * wid + 32 * ks + 8 * fq; const bf16x8 bfr = *(const bf16x8*)(wglr + (size_t)fr * 1024 + k);
#pragma unroll
          for (int m = 0; m < 4; ++m) { const bf16x8 afr = *(const bf16x8*)(xn + (t0 + 16 * m + fr) * DM + k); acc[m] = __builtin_amdgcn_mfma_f32_16x16x32_bf16(afr, bfr, acc[m], 0, 0, 0); } }
      float* part = (float*)(lds + GA_PART) + wid * 1024;
#pragma unroll
      for (int m = 0; m < 4; ++m)
#pragma unroll
          for (int j = 0; j < 4; ++j) part[(16 * m + 4 * fq + j) * 16 + fr] = acc[m][j]; }
    __syncthreads();
    { float* glr = (float*)(lds + GA_GLR); const float* part = (const float*)(lds + GA_PART);
      for (int i = tid; i < 1024; i += 512) { float s = 0.f;
#pragma unroll
          for (int w = 0; w < 8; ++w) s += part[w * 1024 + i];
          glr[i] = s; } }
    __syncthreads();
    LAUNDER(tid);
    { const int cv = tid & 63, tk = tid >> 6;
#pragma unroll
      for (int i = 0; i < 8; ++i) { const int tok = tk + 8 * i; const u32x4 v = *(const u32x4*)(proj + (t0 + tok) * PROJ_LD + C_VG + cv * 8); *(u32x4*)(lds + GA_V + tok * GA_PV + cv * 16) = v; } }
    LAUNDER(tid);
    { const int j = tid & 255, half = tid >> 8; const float* glr = (const float*)(lds + GA_GLR); float* tot = (float*)(lds + GA_TOT);
      float w[16];
#pragma unroll
      for (int i = 0; i < 16; ++i) w[i] = wg[i * 256 + j];
      const float bj = bg[j]; float run = 0.f;
      bf16_t kk16[32];
#pragma unroll
      for (int s = 0; s < 32; ++s) kk16[s] = proj[(t0 + 32 * half + s) * PROJ_LD + C_KG + j];
#pragma unroll 2
      for (int s = 0; s < 32; ++s) { const float* gl = glr + (32 * half + s) * 16; float u = bj;
#pragma unroll
          for (int i = 0; i < 16; ++i) u += gl[i] * w[i];
          const float ls = fminf(u, 0.f) - __logf(1.0f + __expf(-fabsf(u)));
          run += ls * (1.0f / 16.0f); }
      tot[half * 256 + j] = run;
      __syncthreads();
      const float t0v = tot[j], t1v = tot[256 + j]; const float gend = t0v + t1v;
      if (half == 0) decay[(size_t)task * 256 + j] = __expf(gend);
      run = half ? t0v : 0.f;
#pragma unroll
      for (int s = 0; s < 32; ++s) { const int tok = 32 * half + s; const float* gl = glr + tok * 16; float u = bj;
#pragma unroll
          for (int i = 0; i < 16; ++i) u += gl[i] * w[i];
          const float ls = fminf(u, 0.f) - __logf(1.0f + __expf(-fabsf(u)));
          run += ls * (1.0f / 16.0f);
          const float kk = bf2f(kk16[s]);
          *(bf16_t*)(lds + GA_KD + tok * GA_PK + j * 2) = (bf16_t)f2bf(kk * __expf(gend - run)); } }
    __syncthreads();
    LAUNDER(tid); wid = __builtin_amdgcn_readfirstlane(tid >> 6); lane = tid & 63;
    { const int h = wid >> 1, nt = wid & 1, hi = lane >> 5, c32 = lane & 31; f32x16 acc[4];
#pragma unroll
      for (int m = 0; m < 4; ++m)
#pragma unroll
          for (int r = 0; r < 16; ++r) acc[m][r] = 0.f;
#pragma unroll
      for (int ks = 0; ks < 4; ++ks) { const bf16x8 bfr = tr_frag(lds + GA_KD, GA_PK, 16 * ks, h * 64 + 32 * nt, lane);
#pragma unroll
          for (int m = 0; m < 4; ++m) { const bf16x8 afr = tr_frag(lds + GA_V, GA_PV, 16 * ks, h * 128 + 32 * m, lane); acc[m] = __builtin_amdgcn_mfma_f32_32x32x16_bf16(afr, bfr, acc[m], 0, 0, 0); } }
      float* u = UT + ((size_t)task * 4 + h) * 8192;
#pragma unroll
      for (int m = 0; m < 4; ++m)
#pragma unroll
          for (int r = 0; r < 16; ++r) u[(32 * m + crow(r, hi)) * 64 + 32 * nt + c32] = acc[m][r]; }
    __syncthreads();
}
__device__ __forceinline__ void gla_pass_b(int e, const float* __restrict__ UT, const float* __restrict__ decay, bf16_t* __restrict__ ST) {
    const int dk = e & 63, dv = (e >> 6) & 127, h = (e >> 13) & 3, b = e >> 15; float s = 0.f;
    const size_t base = ((size_t)b * 128 * 4 + h) * 8192 + dv * 64 + dk; const size_t dbase = (size_t)b * 128 * 256 + h * 64 + dk;
    for (int c0 = 0; c0 < 128; c0 += 32) { float u[32], d[32];
#pragma unroll
        for (int i = 0; i < 32; ++i) { u[i] = UT[base + (size_t)(c0 + i) * 4 * 8192]; d[i] = decay[dbase + (size_t)(c0 + i) * 256]; }
#pragma unroll
        for (int i = 0; i < 32; ++i) { s = d[i] * s + u[i]; ST[base + (size_t)(c0 + i) * 4 * 8192] = (bf16_t)f2bf(s); } }
}
constexpr int GC_PITCH = 520;
__device__ __forceinline__ void gla_pass_c(unsigned char* wlds  , int wtask, const bf16_t* __restrict__ ST, const bf16_t* __restrict__ proj, const float* __restrict__ ghead, bf16_t* __restrict__ mix, int lane) {
    const int nh = wtask & 1, h = (wtask >> 1) & 3, bc = wtask >> 3; const int c32 = lane & 31, hi = lane >> 5;
    const size_t t0 = (size_t)bc * 64 + 32 * nh; const bf16_t* st = ST + ((size_t)bc * 4 + h) * 8192;
    f32x16 acc[4];
#pragma unroll
    for (int m = 0; m < 4; ++m)
#pragma unroll
        for (int r = 0; r < 16; ++r) acc[m][r] = 0.f;
#pragma unroll
    for (int ks = 0; ks < 4; ++ks) { const bf16x8 bfr = *(const bf16x8*)(proj + (t0 + c32) * PROJ_LD + C_QG + h * 64 + 16 * ks + 8 * hi);
#pragma unroll
        for (int m = 0; m < 4; ++m) { const bf16x8 afr = *(const bf16x8*)(st + (32 * m + c32) * 64 + 16 * ks + 8 * hi); acc[m] = __builtin_amdgcn_mfma_f32_32x32x16_bf16(afr, bfr, acc[m], 0, 0, 0); } }
    float ss = 0.f;
#pragma unroll
    for (int m = 0; m < 4; ++m)
#pragma unroll
        for (int r = 0; r < 16; ++r) ss += acc[m][r] * acc[m][r];
    ss += __shfl_xor(ss, 32);
    const float rstd = 1.0f / sqrtf(ss * (1.0f / 128.0f) + EPS);
#pragma unroll
    for (int m = 0; m < 4; ++m)
#pragma unroll
        for (int r = 0; r < 16; ++r) *(float*)(wlds + c32 * GC_PITCH + (32 * m + crow(r, hi)) * 4) = acc[m][r] * rstd;
#pragma unroll
    for (int i = 0; i < 8; ++i) { const int q = lane + 64 * i, tok = q >> 4, dv0 = (q & 15) * 8; const float* src = (const float*)(wlds + tok * GC_PITCH + dv0 * 4);
        const u32x4 rgw = *(const u32x4*)(proj + (t0 + tok) * PROJ_LD + C_RG + h * 128 + dv0); const f32x4 g0 = *(const f32x4*)(ghead + dv0), g1 = *(const f32x4*)(ghead + dv0 + 4);
        const float rg[8] = {bflo(rgw.x), bfhi(rgw.x), bflo(rgw.y), bfhi(rgw.y), bflo(rgw.z), bfhi(rgw.z), bflo(rgw.w), bfhi(rgw.w)}; const float gg[8] = {g0.x, g0.y, g0.z, g0.w, g1.x, g1.y, g1.z, g1.w}; float y[8];
#pragma unroll
        for (int k = 0; k < 8; ++k) y[k] = src[k] * gg[k] * (rg[k] / (1.0f + __expf(-rg[k])));
        u32x4 o; o.x = pk2(y[0], y[1]); o.y = pk2(y[2], y[3]); o.z = pk2(y[4], y[5]); o.w = pk2(y[6], y[7]);
        *(u32x4*)(mix + (t0 + tok) * 1024 + h * 128 + dv0) = o; }
}
__device__ __forceinline__ void sb_task(unsigned char* vl  , int wtask, const bf16_t* __restrict__ proj, bf16_t* __restrict__ mix, int lane) {
    const int qt = wtask & 255, h = (wtask >> 8) & 7, b = wtask >> 11; const int c = lane & 31, hi = lane >> 5;
    const int t0 = qt * 32; const size_t rowb = (size_t)b * SEQ;
    bf16x8 qf[4];
#pragma unroll
    for (int d0 = 0; d0 < 4; ++d0) qf[d0] = *(const bf16x8*)(proj + (rowb + t0 + c) * PROJ_LD + C_QS + h * 64 + 16 * d0 + 8 * hi);
    const int kap = 16 * ((c >> 2) & 1) + (c & 3) + 4 * (c >> 3);
    f32x16 o0, o1;
#pragma unroll
    for (int r = 0; r < 16; ++r) { o0[r] = 0.f; o1[r] = 0.f; }
    float Dc = 1.0f;
    const bf16_t* kbase = proj + rowb * PROJ_LD + C_KS + h * 64 + 8 * hi + (size_t)kap * PROJ_LD;
    const bf16_t* vbase = proj + rowb * PROJ_LD + C_VS + h * 64 + (lane & 7) * 8 + (size_t)(lane >> 3) * PROJ_LD;
    bf16x8 kf[4]; u32x4 vr[4];
#pragma unroll
    for (int d0 = 0; d0 < 4; ++d0) kf[d0] = *(const bf16x8*)(kbase + (size_t)t0 * PROJ_LD + 16 * d0);
#pragma unroll
    for (int i = 0; i < 4; ++i) vr[i] = *(const u32x4*)(vbase + (size_t)(t0 + 8 * i) * PROJ_LD);
    for (int j0 = t0; j0 >= 0; j0 -= 32) {
#pragma unroll
        for (int i = 0; i < 4; ++i) { const int key = (lane >> 3) + 8 * i, ch = lane & 7; *(u32x4*)(vl + (ch >> 2) * 2048 + key * 64 + (ch & 3) * 16) = vr[i]; }
        f32x16 z;
#pragma unroll
        for (int r = 0; r < 16; ++r) z[r] = 0.f;
#pragma unroll
        for (int d0 = 0; d0 < 4; ++d0) z = __builtin_amdgcn_mfma_f32_32x32x16_bf16(kf[d0], qf[d0], z, 0, 0, 0);
        asm volatile("" ::: "memory");
        { const int jn = (j0 >= 32) ? j0 - 32 : j0;
#pragma unroll
          for (int d0 = 0; d0 < 4; ++d0) kf[d0] = *(const bf16x8*)(kbase + (size_t)jn * PROJ_LD + 16 * d0);
#pragma unroll
          for (int i = 0; i < 4; ++i) vr[i] = *(const u32x4*)(vbase + (size_t)(jn + 8 * i) * PROJ_LD); }
        asm volatile("" ::: "memory");
        float e[16], Dl[16];
        const bool diag = (j0 == t0);
#pragma unroll
        for (int r = 0; r < 16; ++r) { float ev = __builtin_amdgcn_exp2f(fminf(z[r], 126.0f)); if (diag && (16 * hi + r >= c)) ev = 0.f; e[r] = ev; }
        float D = hi ? Dc : 1.0f;
#pragma unroll
        for (int r = 15; r >= 0; --r) { D = fmaf(D, e[r], D); Dl[r] = D; }
        const float other = __shfl_xor(D, 32);
        const float mult = hi ? 1.0f : other;
        Dc = D * other;
        unsigned pw[8];
#pragma unroll
        for (int r = 0; r < 16; r += 2) { const float a0 = e[r] * __builtin_amdgcn_rcpf(Dl[r] * mult), a1 = e[r + 1] * __builtin_amdgcn_rcpf(Dl[r + 1] * mult); pw[r >> 1] = pk2(a0, a1); }
#pragma unroll
        for (int ks = 0; ks < 2; ++ks) { const bf16x8 pa = __builtin_bit_cast(bf16x8, (u32x4){pw[4 * ks], pw[4 * ks + 1], pw[4 * ks + 2], pw[4 * ks + 3]});
            const unsigned char* vb = vl + (16 * hi + 8 * ks + ((lane & 15) >> 2)) * 64 + (16 * ((lane >> 4) & 1) + 4 * (lane & 3)) * 2;
            { const s16x4 lo = tr_read(vb), hh = tr_read(vb + 256); o0 = __builtin_amdgcn_mfma_f32_32x32x16_bf16(pa, (bf16x8){lo[0], lo[1], lo[2], lo[3], hh[0], hh[1], hh[2], hh[3]}, o0, 0, 0, 0); }
            { const s16x4 lo = tr_read(vb + 2048), hh = tr_read(vb + 2048 + 256); o1 = __builtin_amdgcn_mfma_f32_32x32x16_bf16(pa, (bf16x8){lo[0], lo[1], lo[2], lo[3], hh[0], hh[1], hh[2], hh[3]}, o1, 0, 0, 0); } }
        if (__all(!(Dc < 3.0e38f))) break;
    }
    bf16_t* ob = mix + (rowb + t0) * 1024 + 512 + h * 64 + c;
#pragma unroll
    for (int r = 0; r < 16; ++r) { const int q = crow(r, hi); ob[(size_t)q * 1024] = (bf16_t)f2bf(o0[r]); ob[(size_t)q * 1024 + 32] = (bf16_t)f2bf(o1[r]); }
}
__device__ __forceinline__ void memkv_task(int wtask, int lane, const bf16_t* __restrict__ memn, const bf16_t* __restrict__ wkv, bf16_t* __restrict__ kv) {
    const int tm = wtask >> 6, tn = wtask & 63; const int c = lane & 31, hi = lane >> 5;
    const bf16_t* ap = memn + (size_t)(tm * 32 + c) * DM + 8 * hi; const bf16_t* bp = wkv + (size_t)(tn * 32 + c) * DM + 8 * hi;
    f32x16 acc;
#pragma unroll
    for (int r = 0; r < 16; ++r) acc[r] = 0.f;
#pragma unroll 16
    for (int ks = 0; ks < 64; ++ks) { const bf16x8 a = *(const bf16x8*)(ap + 16 * ks), b = *(const bf16x8*)(bp + 16 * ks); acc = __builtin_amdgcn_mfma_f32_32x32x16_bf16(a, b, acc, 0, 0, 0); }
    bf16_t* o = kv + (size_t)(tm * 32) * 2048 + tn * 32 + c;
#pragma unroll
    for (int r = 0; r < 16; ++r) o[(size_t)crow(r, hi) * 2048] = (bf16_t)f2bf(acc[r]);
}
__device__ __forceinline__ void router_task(int wtask, int lane, const bf16_t* __restrict__ xn, const float* __restrict__ ss, const bf16_t* __restrict__ wr, const float* __restrict__ br,
                                            int (&oe)[4], float (&ow)[4]) {
    const int c = lane & 31, hi = lane >> 5; const int t = wtask * 32 + c;
    const bf16_t* ap = wr + (size_t)c * DM + 8 * hi; const bf16_t* bp = xn + (size_t)t * DM + 8 * hi;
    f32x16 acc;
#pragma unroll
    for (int r = 0; r < 16; ++r) acc[r] = 0.f;
#pragma unroll 16
    for (int ks = 0; ks < 64; ++ks) { const bf16x8 a = *(const bf16x8*)(ap + 16 * ks), b = *(const bf16x8*)(bp + 16 * ks); acc = __builtin_amdgcn_mfma_f32_32x32x16_bf16(a, b, acc, 0, 0, 0); }
    float v[16]; const float rstd = row_rstd(ss, t);
#pragma unroll
    for (int r = 0; r < 16; ++r) v[r] = acc[r] * rstd + br[crow(r, hi)];
    float tv[4]; int ti[4];
#pragma unroll
    for (int k = 0; k < 4; ++k) { float best = -INFINITY; int bi = 64;
#pragma unroll
        for (int r = 0; r < 16; ++r) { if (v[r] > best) { best = v[r]; bi = crow(r, hi); } }
        tv[k] = best; ti[k] = bi;
#pragma unroll
        for (int r = 0; r < 16; ++r) if (crow(r, hi) == bi) v[r] = -INFINITY; }
    float cv[8]; int ci[8];
#pragma unroll
    for (int k = 0; k < 4; ++k) { cv[k] = tv[k]; ci[k] = ti[k]; cv[4 + k] = __shfl_xor(tv[k], 32); ci[4 + k] = __shfl_xor(ti[k], 32); }
#pragma unroll
    for (int k = 0; k < 4; ++k) { float best = -INFINITY; int bi = 64;
#pragma unroll
        for (int q = 0; q < 8; ++q) { if (cv[q] > best || (cv[q] == best && ci[q] < bi)) { best = cv[q]; bi = ci[q]; } }
        tv[k] = best; ti[k] = bi;
#pragma unroll
        for (int q = 0; q < 8; ++q) if (ci[q] == bi) cv[q] = -INFINITY; }
    const float e1 = __expf(tv[1] - tv[0]), e2 = __expf(tv[2] - tv[0]), e3 = __expf(tv[3] - tv[0]); const float inv = 1.0f / (1.0f + e1 + e2 + e3);
    const float g[4] = {inv, e1 * inv, e2 * inv, e3 * inv};
#pragma unroll
    for (int k = 0; k < 4; ++k) { oe[k] = ti[k]; ow[k] = g[k]; }
}
__device__ __forceinline__ void combine_task(int t, int lane, const bf16_t* xin, float* xout, const unsigned char* __restrict__ ys, const int* tab, const int* __restrict__ toke, const int* __restrict__ tokr,
                                                 const float* __restrict__ tokw, const float* __restrict__ gfin) {
    const u32x2* xr = (const u32x2*)(xin + (size_t)t * DM) + lane; f32x4* xo = (f32x4*)(xout + (size_t)t * DM) + lane; f32x4 v[4];
#pragma unroll
    for (int j = 0; j < 4; ++j) { const u32x2 w = xr[64 * j]; v[j] = (f32x4){bflo(w.x), bfhi(w.x), bflo(w.y), bfhi(w.y)}; }
    for (int k = 0; k < 4; ++k) { const int e = toke[t * 4 + k], r = tokr[t * 4 + k]; const float w = tokw[t * 4 + k]; const int start = tab[32 + e];
        const unsigned* yr = (const unsigned*)(ys + (size_t)(start + r) * DM) + lane;
#pragma unroll
        for (int j = 0; j < 4; ++j) { const int y = (int)yr[64 * j]; const f32x2 lo = __builtin_amdgcn_cvt_pk_f32_fp8(y, false), hi = __builtin_amdgcn_cvt_pk_f32_fp8(y, true);
            v[j].x += w * lo.x; v[j].y += w * lo.y; v[j].z += w * hi.x; v[j].w += w * hi.y; } }
    float s = 0.f;
#pragma unroll
    for (int j = 0; j < 4; ++j) s += v[j].x * v[j].x + v[j].y * v[j].y + v[j].z * v[j].z + v[j].w * v[j].w;
    const float rstd = 1.0f / sqrtf(wave_sum(s) * (1.f / DM) + EPS);
#pragma unroll
    for (int j = 0; j < 4; ++j) { const f32x4 g = *((const f32x4*)gfin + lane + 64 * j); xo[64 * j] = v[j] * rstd * g; }
}

#define GAS __attribute__((address_space(1)))
#define RLX_AGENT __ATOMIC_RELAXED, __HIP_MEMORY_SCOPE_AGENT
#define XB_TMO      128
#define XB_XCNT(j)  (256  + 64 * (j))
#define XB_XSUB(j)  (1280 + 64 * (j))
#define XB_XGEN(j)  (2304 + 64 * (j))
#define XB_TOP      3328
#define XB_TOPGEN   3392
#define XCD_BAR_WORDS 3456
#define XB_SPIN_CAP (1u << 18)
__device__ __forceinline__ unsigned xb_ld(unsigned* p)              { return __hip_atomic_load(p, __ATOMIC_RELAXED, __HIP_MEMORY_SCOPE_AGENT); }
__device__ __forceinline__ unsigned xb_add(unsigned* p, unsigned v) { return __hip_atomic_fetch_add(p, v, __ATOMIC_RELAXED, __HIP_MEMORY_SCOPE_AGENT); }
__device__ __forceinline__ unsigned xb_xcc_id() { return (unsigned)__builtin_amdgcn_s_getreg((3 << 11) | 20) & 0xFu; }
#define XB_SPIN(cond, bar) do { unsigned _sp = 0; while (cond) { __builtin_amdgcn_s_sleep(1); \
    if ((++_sp & 255u) == 0u) { if (xb_ld(&(bar)[XB_TMO])) break; if (_sp > XB_SPIN_CAP) { atomicAdd(&(bar)[XB_TMO], 1u); break; } } } } while (0)
struct XcdBarrier { unsigned* bar; unsigned x; volatile LDSP unsigned* st; };
__device__ __forceinline__ XcdBarrier xcd_barrier_post(unsigned* bar, volatile LDSP unsigned* st) {
    XcdBarrier b; b.bar = bar; b.x = xb_xcc_id(); b.st = st;
    if (threadIdx.x == 0) (void)xb_add(&bar[XB_XCNT(b.x)], 1u);
    return b;
}
__device__ __forceinline__ void xcd_barrier_complete(unsigned* bar, unsigned x, unsigned& nloc, unsigned& nx) {
    const unsigned G = gridDim.x * gridDim.y * gridDim.z;
    unsigned sum, cnt, mine, sp = 0u;
    for (;;) {
        sum = 0u; cnt = 0u; mine = 0u;
#pragma unroll
        for (unsigned j = 0; j < 16; ++j) { const unsigned c = xb_ld(&bar[XB_XCNT(j)]); sum += c; cnt += (c > 0u) ? 1u : 0u; mine = (j == x) ? c : mine; }
        if (sum == G) break;
        __builtin_amdgcn_s_sleep(1);
        if ((++sp & 255u) == 0u) { if (xb_ld(&bar[XB_TMO])) break; if (sp > XB_SPIN_CAP) { atomicAdd(&bar[XB_TMO], 1u); break; } }
    }
    nloc = mine > 0u ? mine : 1u; nx = cnt > 0u ? cnt : 1u;
}
__device__ __forceinline__ void xcd_barrier(const XcdBarrier& b) {
    asm volatile("s_waitcnt vmcnt(0)" ::: "memory");
    __syncthreads();
    if (threadIdx.x == 0) {
        unsigned* bar = b.bar;
        __builtin_amdgcn_s_waitcnt(0);
        unsigned nloc = b.st[0], nx = b.st[1];
        if (nloc == 0u) { xcd_barrier_complete(bar, b.x, nloc, nx); b.st[0] = nloc; b.st[1] = nx; }
        const unsigned old = xb_add(&bar[XB_XSUB(b.x)], 1u);
        const unsigned gen = old / nloc;
        if (old + 1u == (gen + 1u) * nloc) {
            __builtin_amdgcn_fence(__ATOMIC_RELEASE, "agent");
            asm volatile("s_waitcnt vmcnt(0)" ::: "memory");
            const unsigned og = xb_add(&bar[XB_TOP], 1u);
            const unsigned tg = og / nx;
            if (og + 1u == (tg + 1u) * nx) xb_add(&bar[XB_TOPGEN], 1u);
            else XB_SPIN(xb_ld(&bar[XB_TOPGEN]) == tg, bar);
            __builtin_amdgcn_fence(__ATOMIC_ACQUIRE, "agent");
            xb_add(&bar[XB_XGEN(b.x)], 1u);
            asm volatile("s_waitcnt vmcnt(0)" ::: "memory");
        } else {
            XB_SPIN(xb_ld(&bar[XB_XGEN(b.x)]) == gen, bar);
            __builtin_amdgcn_fence(__ATOMIC_ACQUIRE, "agent");
            asm volatile("s_waitcnt vmcnt(0)" ::: "memory");
        }
    }
    __syncthreads();
}

constexpr int LDS_BYTES = 147456;
constexpr int MISC_OFF = LDS_BYTES - 512;
constexpr int CW_BAR = 4096;
constexpr size_t CTL_ZERO_BYTES = 65536;
constexpr int NPHASE = 12;
struct Args { const float* in[22]; float* out; unsigned char* ws; int ph_lo, ph_hi; };

__global__ void __launch_bounds__(512, 2) mega(Args a) {
    extern __shared__ __attribute__((aligned(16))) unsigned char lds[];
    unsigned char* ws = a.ws; float* out = a.out;
    const float* x = a.in[0]; const float* mem = a.in[1]; const float* g_mix = a.in[2]; const float* w_in = a.in[3];
    const float* w_gla_gate = a.in[4]; const float* b_gla_gate = a.in[5]; const float* g_gla_head = a.in[6]; const float* w_out = a.in[7];
    const float* g_mem_q = a.in[8]; const float* g_mem_kv = a.in[9]; const float* w_mq = a.in[10]; const float* w_mk = a.in[11];
    const float* w_mv = a.in[12]; const float* w_mo = a.in[13]; const float* g_ffn = a.in[14]; const float* w_router = a.in[15];
    const float* b_router = a.in[16]; const float* w_gu = a.in[17]; const float* b_gu = a.in[18]; const float* w_down = a.in[19];
    const float* b_down = a.in[20]; const float* g_final = a.in[21];
    bf16_t* Wt_in = (bf16_t*)(ws + WS_WIN); bf16_t* Wt_out = (bf16_t*)(ws + WS_WOUT); bf16_t* Wq = (bf16_t*)(ws + WS_WQ); bf16_t* Wt_kv = (bf16_t*)(ws + WS_WKV);
    bf16_t* Wt_mo = (bf16_t*)(ws + WS_WMO); bf16_t* Wt_r = (bf16_t*)(ws + WS_WR); bf16_t* Wt_gu = (bf16_t*)(ws + WS_WGU); bf16_t* Wt_dn = (bf16_t*)(ws + WS_WDN);
    bf16_t* xn = (bf16_t*)(ws + WS_XN); bf16_t* memn = (bf16_t*)(ws + WS_MEMN); bf16_t* kv = (bf16_t*)(ws + WS_KV); bf16_t* Bs = (bf16_t*)(ws + WS_BS); bf16_t* Bo = (bf16_t*)(ws + WS_BO);
    bf16_t* proj = (bf16_t*)(ws + WS_PROJ); bf16_t* mix = (bf16_t*)(ws + WS_MIX);
    float* Sc = (float*)(ws + WS_S); bf16_t* P = (bf16_t*)(ws + WS_P); float* lg = (float*)(ws + WS_LG); int* toke = (int*)(ws + WS_TOKE); int* tokr = (int*)(ws + WS_TOKR);
    float* tokw = (float*)(ws + WS_TOKW); int* list = (int*)(ws + WS_LIST); unsigned char* ys = ws + WS_YS;
    unsigned char* Wq_gu = ws + WS_WGU; unsigned char* Wq_dn = ws + WS_WDN; unsigned char* x2q = ws + WS_S; unsigned char* act8 = ws + WS_ACT;
    float* lrs = (float*)(ws + WS_LG);
    float* UT = (float*)(ws + WS_S); float* decay = (float*)(ws + WS_LA); bf16_t* ST = (bf16_t*)(ws + WS_ORAW);
    unsigned* ctl = (unsigned*)(ws + WS_CTL); int* cnt = (int*)ctl + CW_CNT; float* ss1 = (float*)(ws + WS_LA + 8 * MiB); float* ss2 = (float*)(ws + WS_LA + 9 * MiB);

    const int G = gridDim.x, vb = blockIdx.x;
    volatile LDSP unsigned* MISC = (volatile LDSP unsigned*)(unsigned)(uintptr_t)(lds + MISC_OFF);
    if (threadIdx.x < 128) MISC[threadIdx.x] = 0u;
    __syncthreads();
    XcdBarrier bar = xcd_barrier_post(ctl + CW_BAR, MISC + 8);
    const int lo = a.ph_lo, hi = a.ph_hi;
    float* dmy = (float*)(ws + WS_DUMMY); (void)dmy;
#ifndef REPEAT_MASK
#define REPEAT_MASK 0
#endif
#define IN(k) (lo <= (k) && (k) < hi)
#define REP(k) for (int rep_ = 0; rep_ < 1 + ((REPEAT_MASK >> (k)) & 1); ++rep_)
#define SEAM(k) do { if (IN(k) && IN((k) + 1)) xcd_barrier(bar); } while (0)
#define TIDS() int tid = threadIdx.x; LAUNDER(tid); const int lane = tid & 63; const int wid = __builtin_amdgcn_readfirstlane(tid >> 6); (void)lane; (void)wid

    if (IN(0)) REP(0) { TIDS(); const size_t gt = (size_t)vb * 512 + tid, gs = (size_t)G * 512;
        float* scr = (float*)(lds + wid * 8448);
        const int gw = vb * 8 + wid, ngw = G * 8;
        rms_body(gw, ngw, lane, x, xn, NTOK);
        rms_body(gw, ngw, lane, mem, memn, NB * MEML);
        conv_n_body(gt, gs, w_mq, Wq, g_mem_q, 1024, 1024, LOG2E / 16.0f);
        constexpr int I_IN = 16 * 97, I_SQ = 16 * 32, I_R = 16, I_GU = 32 * 16 * 64, I_DN = 32 * 16 * 32;
        constexpr int NITEMS = I_IN + 4 * I_SQ + I_R + I_GU + I_DN;
        for (int it = gw; it < NITEMS; it += ngw) { int r = it;
            if (r < I_IN) { conv_item<1>(scr, w_in, Wt_in, g_mix, 3088, 1024, 3088, r / 97, r % 97, lane); continue; } r -= I_IN;
            if (r < I_SQ) { conv_item<0>(scr, w_out, Wt_out, nullptr, 1024, 1024, 1024, r >> 5, r & 31, lane); continue; } r -= I_SQ;
            if (r < I_SQ) { conv_item<0>(scr, w_mk, Wt_kv, g_mem_kv, 1024, 1024, 1024, r >> 5, r & 31, lane); continue; } r -= I_SQ;
            if (r < I_SQ) { conv_item<0>(scr, w_mv, Wt_kv + (size_t)1024 * 1024, g_mem_kv, 1024, 1024, 1024, r >> 5, r & 31, lane); continue; } r -= I_SQ;
            if (r < I_SQ) { conv_item<0>(scr, w_mo, Wt_mo, nullptr, 1024, 1024, 1024, r >> 5, r & 31, lane); continue; } r -= I_SQ;
            if (r < I_R) { conv_item<0>(scr, w_router, Wt_r, g_ffn, 32, 1024, 32, r, 0, lane); continue; } r -= I_R;
            if (r < I_GU) { const int e = r >> 10, q = r & 1023; conv_item8<2>(scr, w_gu + (size_t)e * 1024 * 2048, Wq_gu + (size_t)e * 2048 * 1024, g_ffn, 2048, 1024, 2048, q >> 6, q & 63, lane, (float)(1 << WSCALE_LOG2)); continue; } r -= I_GU;
            { const int e = r >> 9, q = r & 511; conv_item8<0>(scr, w_down + (size_t)e * 1024 * 1024, Wq_dn + (size_t)e * 1024 * 1024, nullptr, 1024, 1024, 1024, q >> 5, q & 31, lane, (float)(1 << WSCALE_LOG2)); } }
        __syncthreads(); }
    SEAM(0);
    if (IN(1)) REP(1) { DenseSched S{(const char*)xn, (const char*)Wt_in, 2048u, 2048u, 1024, 64, 12, 1 << 30, 0, G, vb}; EpiBf16 E{proj, PROJ_LD, 0}; gemm_run<true>(lds, S, E); }
    SEAM(1);
    if (IN(2)) REP(2) {
        for (int t = vb; t < 256; t += G) gla_pass_a(lds, t, xn, Wt_in + (size_t)3072 * 1024, proj, w_gla_gate, b_gla_gate, UT, decay);
        { TIDS(); for (int t = vb * 8 + wid; t < 4096; t += G * 8) sb_task(lds + wid * 4096, t, proj, mix, lane); }
        { TIDS(); for (int t = vb + G * wid; t < 1024; t += G * 8) memkv_task(t, lane, memn, Wt_kv, kv); } }
    SEAM(2);
    if (IN(3)) REP(3) {
        { TIDS(); for (int e = vb * 512 + tid; e < 65536; e += G * 512) gla_pass_b(e, UT, decay, ST); }
        { SchedWqk S{(const char*)kv, (const char*)Wq, 4096u, 2048u, 256, G / 2, vb - G / 2, 0}; EpiBf16 E{Bs, 1024, 0}; gemm_run<false>(lds, S, E); }
        { SchedVo S{(const char*)Wt_mo, (const char*)kv, 2048u, 4096u, 256, G / 2, vb - G / 2 - 32, 0}; EpiBf16 E{Bo, 1024, 0}; gemm_run<false>(lds, S, E); } }
    SEAM(3);
    if (IN(4)) REP(4) { TIDS(); for (int t = vb * 8 + wid; t < 2048; t += G * 8) gla_pass_c(lds + wid * 32 * GC_PITCH, t, ST, proj, g_gla_head, mix, lane); }
    SEAM(4);
#if PROBE_BARRIERS
    for (int pb_ = 0; pb_ < 8; ++pb_) xcd_barrier(bar);
#endif
    if (IN(5)) REP(5) { DenseSched S{(const char*)mix, (const char*)Wt_out, 2048u, 2048u, 1024, 64, 4, 1 << 30, 0, G, vb}; EpiResidSS<false> E{x, rep_ ? (bf16_t*)dmy : xn, rep_ ? dmy + 16 * 1024 * 1024 : ss1, nullptr}; gemm_run<false>(lds, S, E); }
    SEAM(5);
    if (IN(6)) REP(6) { DenseSched S{(const char*)xn, (const char*)Bs, 2048u, 2048u, 1024, 64, 4, 32, (size_t)1024 * 2048, G, vb}; EpiSoftmax E{ss1, P}; gemm_run<false>(lds, S, E); }
    SEAM(6);
    if (IN(7)) REP(7) { DenseSched S{(const char*)P, (const char*)Bo, 2048u, 2048u, 1024, 64, 4, 32, (size_t)1024 * 2048, G, vb}; EpiResidSS<true> E{xn, rep_ ? (bf16_t*)dmy : xn, rep_ ? dmy + 16 * 1024 * 1024 : ss2, rep_ ? (unsigned char*)dmy + 40 * 1024 * 1024 : x2q}; gemm_run<false>(lds, S, E); }
    SEAM(7);
    if (IN(8)) REP(8) { TIDS(); int* cntp = rep_ ? (int*)ctl + 2048 : cnt; int* listp = rep_ ? (int*)dmy + 1024 : list; float* lrsp = rep_ ? dmy + 4096 * 1024 : lrs; int* tokep = rep_ ? (int*)dmy + 1024 * 1024 : toke; int* tokrp = rep_ ? (int*)dmy + 2048 * 1024 : tokr; float* tokwp = rep_ ? dmy + 3072 * 1024 : tokw;
        int* lcnt = (int*)lds; int* gbase = (int*)lds + 32;
        for (int tb = vb; tb < NTOK / 64; tb += G) {
            if (tid < 32) lcnt[tid] = 0;
            __syncthreads();
            int oe[4] = {0, 0, 0, 0}; float ow[4] = {0.f, 0.f, 0.f, 0.f}; int lr[4] = {0, 0, 0, 0};
            if (wid < 2) { router_task(tb * 2 + wid, lane, xn, ss2, Wt_r, b_router, oe, ow);
                if (lane < 32) {
#pragma unroll
                    for (int k = 0; k < 4; ++k) lr[k] = atomicAdd(&lcnt[oe[k]], 1); } }
            __syncthreads();
            if (tid < 32) gbase[tid] = atomicAdd(&cntp[tid * 32], lcnt[tid]);
            __syncthreads();
            if (wid < 2 && lane < 32) { const int t = (tb * 2 + wid) * 32 + lane;
                const float rstd_t = row_rstd(ss2, t);
#pragma unroll
                for (int k = 0; k < 4; ++k) { const int r = gbase[oe[k]] + lr[k]; listp[oe[k] * NTOK + r] = t; lrsp[oe[k] * NTOK + r] = rstd_t; tokep[t * 4 + k] = oe[k]; tokrp[t * 4 + k] = r; tokwp[t * 4 + k] = ow[k]; } }
            __syncthreads(); } }
    SEAM(8);
    if (IN(9)) REP(9) { int* tab = (int*)(lds + 131072); { TIDS(); moe_build_table(tab, cnt, tid); }
        MoeSched<true> S{(const char*)x2q, (const char*)Wq_gu, 1024u, 1024u, 512, 8, (size_t)2048 * 1024, tab, list, 1, G, vb, 0}; EpiGU E{b_gu, act8, lrs}; gemm_run_fp8<true>(lds, S, E); }
    SEAM(9);
    if (IN(10)) REP(10) { int* tab = (int*)(lds + 131072); { TIDS(); moe_build_table(tab, cnt, tid); }
        MoeSched<false> S{(const char*)act8, (const char*)Wq_dn, 1024u, 1024u, 512, 4, (size_t)1024 * 1024, tab, list, 0, G, vb, 0}; EpiDown E{b_down, ys}; gemm_run_fp8<true>(lds, S, E); }
    SEAM(10);
    if (IN(11)) REP(11) { TIDS(); int* tab = (int*)(lds + 131072); moe_build_table(tab, cnt, tid);
        for (int t = vb * 8 + wid; t < NTOK; t += G * 8) combine_task(t, lane, xn, rep_ ? dmy : out, ys, tab, toke, tokr, tokw, g_final); }
#undef IN
#undef SEAM
#undef TIDS
}

#ifndef MK_PER_PHASE
#define MK_PER_PHASE 0
#endif
extern "C" void kernel_launch(void* const* d_in, const int* in_sizes, int n_in, void* d_out, int out_size, void* d_ws, size_t ws_size, hipStream_t stream) {
    static int grid = 0;
    if (grid == 0) {
        if (n_in != 22 || in_sizes[0] != NTOK * DM || out_size != NTOK * DM || ws_size < WS_END) { fprintf(stderr, "kernel_launch: unexpected shapes (n_in %d, ws %zu)\n", n_in, ws_size); grid = -1; return; }
        int dev = 0, cus = 0, per_cu = 0;
        if (hipGetDevice(&dev) != hipSuccess || hipDeviceGetAttribute(&cus, hipDeviceAttributeMultiprocessorCount, dev) != hipSuccess) { grid = -1; return; }
        if (hipFuncSetAttribute((const void*)mega, hipFuncAttributeMaxDynamicSharedMemorySize, LDS_BYTES) != hipSuccess) { fprintf(stderr, "kernel_launch: hipFuncSetAttribute failed\n"); grid = -1; return; }
        if (hipOccupancyMaxActiveBlocksPerMultiprocessor(&per_cu, (const void*)mega, 512, LDS_BYTES) != hipSuccess || per_cu < 1) fprintf(stderr, "kernel_launch: occupancy query says %d blocks/CU\n", per_cu);
        (void)hipGetLastError();
        grid = cus;
    }
    if (grid < 0) return;
    (void)hipMemsetAsync((char*)d_ws + WS_CTL, 0, CTL_ZERO_BYTES, stream);
    Args a{};
    for (int i = 0; i < 22; ++i) a.in[i] = (const float*)d_in[i];
    a.out = (float*)d_out; a.ws = (unsigned char*)d_ws;
#if MK_PER_PHASE
    for (int p = 0; p < NPHASE; ++p) { a.ph_lo = p; a.ph_hi = p + 1; hipLaunchKernelGGL(mega, dim3(grid), dim3(512), LDS_BYTES, stream, a); }
#else
    a.ph_lo = 0; a.ph_hi = NPHASE; hipLaunchKernelGGL(mega, dim3(grid), dim3(512), LDS_BYTES, stream, a);
#endif
}
```

```cpp
#include <hip/hip_runtime.h>
#include <cstdio>
#include <cstdint>
#ifndef PROBE_BARRIERS
#define PROBE_BARRIERS 0
#endif

typedef unsigned short bf16_t;
typedef short bf16x8 __attribute__((ext_vector_type(8)));
typedef float f32x4 __attribute__((ext_vector_type(4)));
typedef unsigned u32x4 __attribute__((ext_vector_type(4)));
typedef unsigned u32x2 __attribute__((ext_vector_type(2)));
typedef float f32x2 __attribute__((ext_vector_type(2)));
#define LDSP __attribute__((address_space(3)))
#define LAUNDER(x) asm volatile("" : "+v"(x))

constexpr int NB = 2, SEQ = 8192, NTOK = NB * SEQ, DM = 1024, MEML = 256;
constexpr int NEXP = 32, TOPK = 4, NASSIGN = NTOK * TOPK;
constexpr int PROJ_LD = 3072;
constexpr int C_QG = 0, C_KG = 256, C_VG = 512, C_RG = 1024, C_QS = 1536, C_KS = 2048, C_VS = 2560, C_GLR = 3072;
constexpr float LOG2E = 1.4426950408889634f;
constexpr float EPS = 1e-5f;

__device__ __forceinline__ unsigned f2bf(float f) { unsigned u = __float_as_uint(f); return (u + 0x7fffu + ((u >> 16) & 1u)) >> 16; }
__device__ __forceinline__ unsigned pk2(float lo, float hi) { return f2bf(lo) | (f2bf(hi) << 16); }
__device__ __forceinline__ float bf2f(bf16_t h) { return __uint_as_float(((unsigned)h) << 16); }
__device__ __forceinline__ float bflo(unsigned w) { return __uint_as_float(w << 16); }
__device__ __forceinline__ float bfhi(unsigned w) { return __uint_as_float(w & 0xffff0000u); }

constexpr size_t MiB = 1u << 20;
constexpr size_t WS_CTL = 0;
constexpr size_t WS_WIN = 1 * MiB;
constexpr size_t WS_WOUT = 8 * MiB;
constexpr size_t WS_WQ = 10 * MiB;
constexpr size_t WS_WKV = 12 * MiB;
constexpr size_t WS_WMO = 16 * MiB;
constexpr size_t WS_WR = 18 * MiB;
constexpr size_t WS_WGU = 20 * MiB;
constexpr size_t WS_WDN = 148 * MiB;
constexpr size_t WS_XN = 212 * MiB;
constexpr size_t WS_MEMN = 244 * MiB;
constexpr size_t WS_KV = 245 * MiB;
constexpr size_t WS_BS = 247 * MiB;
constexpr size_t WS_BO = 251 * MiB;
constexpr size_t WS_PROJ = 256 * MiB;
constexpr size_t WS_LA = 360 * MiB;
constexpr size_t WS_ORAW = 376 * MiB;
constexpr size_t WS_MIX = 408 * MiB;
constexpr size_t WS_S = 440 * MiB;
constexpr size_t WS_P = 504 * MiB;
constexpr size_t WS_LG = 536 * MiB;
constexpr size_t WS_TOKE = 538 * MiB;
constexpr size_t WS_TOKR = 539 * MiB;
constexpr size_t WS_TOKW = 540 * MiB;
constexpr size_t WS_LIST = 541 * MiB;
constexpr size_t WS_ACT = 544 * MiB;
constexpr size_t WS_YS = 674 * MiB;
constexpr size_t WS_DUMMY = 804 * MiB;
constexpr size_t WS_END = 872 * MiB;
constexpr int CW_CNT = 1024;

template <int MAP> __device__ __forceinline__ int srccol(int n, float& sc) {
    sc = 1.f;
    if (MAP == 0) return n;
    if (MAP == 1) {
        if (n < 256) { sc = 0.125f; return n; }
        if (n < 1024) return n;
        if (n < 3072) { if (n >= C_QS && n < C_KS) sc = 0.125f * LOG2E; return n + 16; }
        if (n < 3088) return 1024 + (n - 3072);
        return -1;
    }
    { const int ct = n >> 8, w = n & 255; return (w < 128) ? (128 * ct + w) : (1024 + 128 * ct + (w - 128)); }
}
template <int MAP>
__device__ __forceinline__ void conv_item(float* scr, const float* __restrict__ src, bf16_t* __restrict__ dst, const float* __restrict__ gain, int ldsrc, int K, int nrows, int kb, int nb, int lane) {
    const int k0 = kb * 64, n0 = nb * 32; float sc; const int c0 = srccol<MAP>(n0, sc);
    const int half = lane >> 5, l31 = lane & 31;
    const float* s0 = src + (size_t)(k0 + half) * ldsrc + c0 + l31;
    float v[32];
#pragma unroll
    for (int i = 0; i < 32; ++i) v[i] = __builtin_nontemporal_load(s0 + (size_t)(2 * i) * ldsrc);
#pragma unroll
    for (int i = 0; i < 32; ++i) { const int kk = 2 * i + half; const float g = (gain ? gain[k0 + kk] : 1.f) * sc; scr[kk * 33 + l31] = v[i] * g; }
    asm volatile("s_waitcnt lgkmcnt(0)" ::: "memory");
    const int c = lane & 7;
#pragma unroll
    for (int j = 0; j < 4; ++j) { const int n = (lane >> 3) + 8 * j; const float* s = scr + (8 * c) * 33 + n;
        u32x4 o; o.x = pk2(s[0 * 33], s[1 * 33]); o.y = pk2(s[2 * 33], s[3 * 33]); o.z = pk2(s[4 * 33], s[5 * 33]); o.w = pk2(s[6 * 33], s[7 * 33]);
        if (n0 + n < nrows) *(u32x4*)(dst + (size_t)(n0 + n) * K + k0 + 8 * c) = o; }
    asm volatile("s_waitcnt lgkmcnt(0)" ::: "memory");
}
__device__ __forceinline__ unsigned pk4_fp8(float a, float b, float c, float d) { int w = __builtin_amdgcn_cvt_pk_fp8_f32(a, b, 0, false); w = __builtin_amdgcn_cvt_pk_fp8_f32(c, d, w, true); return (unsigned)w; }
template <int MAP>
__device__ __forceinline__ void conv_item8(float* scr, const float* __restrict__ src, unsigned char* __restrict__ dst, const float* __restrict__ gain, int ldsrc, int K, int nrows, int kb, int nb, int lane, float mul) {
    const int k0 = kb * 64, n0 = nb * 32; float sc; const int c0 = srccol<MAP>(n0, sc); sc *= mul;
    const int half = lane >> 5, l31 = lane & 31;
    const float* s0 = src + (size_t)(k0 + half) * ldsrc + c0 + l31;
    float v[32];
#pragma unroll
    for (int i = 0; i < 32; ++i) v[i] = __builtin_nontemporal_load(s0 + (size_t)(2 * i) * ldsrc);
#pragma unroll
    for (int i = 0; i < 32; ++i) { const int kk = 2 * i + half; const float g = (gain ? gain[k0 + kk] : 1.f) * sc; scr[kk * 33 + l31] = v[i] * g; }
    asm volatile("s_waitcnt lgkmcnt(0)" ::: "memory");
    const int c = lane & 3;
#pragma unroll
    for (int j = 0; j < 2; ++j) { const int n = (lane >> 2) + 16 * j; const float* s = scr + (16 * c) * 33 + n;
        u32x4 o; o.x = pk4_fp8(s[0 * 33], s[1 * 33], s[2 * 33], s[3 * 33]); o.y = pk4_fp8(s[4 * 33], s[5 * 33], s[6 * 33], s[7 * 33]);
        o.z = pk4_fp8(s[8 * 33], s[9 * 33], s[10 * 33], s[11 * 33]); o.w = pk4_fp8(s[12 * 33], s[13 * 33], s[14 * 33], s[15 * 33]);
        if (n0 + n < nrows) __builtin_nontemporal_store(o, (u32x4*)(dst + (size_t)(n0 + n) * K + k0 + 16 * c)); }
    asm volatile("s_waitcnt lgkmcnt(0)" ::: "memory");
}
__device__ __forceinline__ void conv_n_body(size_t gtid, size_t gsz, const float* __restrict__ src, bf16_t* __restrict__ dst, const float* __restrict__ gain, int K, int nrows, float sc) {
    const int kc8 = K / 8; const size_t total = (size_t)nrows * kc8;
    for (size_t idx = gtid; idx < total; idx += gsz) {
        const int kc = (int)(idx % kc8), n = (int)(idx / kc8);
        const float g = gain[n] * sc; const f32x4 a = __builtin_nontemporal_load((const f32x4*)(src + (size_t)n * K + kc * 8)), b = __builtin_nontemporal_load((const f32x4*)(src + (size_t)n * K + kc * 8 + 4));
        u32x4 o; o.x = pk2(a.x * g, a.y * g); o.y = pk2(a.z * g, a.w * g); o.z = pk2(b.x * g, b.y * g); o.w = pk2(b.z * g, b.w * g);
        *(u32x4*)(dst + (size_t)n * K + kc * 8) = o;
    }
}

__device__ __forceinline__ float wave_sum(float v) {
#pragma unroll
    for (int o = 1; o < 64; o <<= 1) v += __shfl_xor(v, o);
    return v;
}
__device__ __forceinline__ void rms_body(int gw, int ngw, int lane, const float* __restrict__ x, bf16_t* __restrict__ out, int nrows) {
    for (int row = gw; row < nrows; row += ngw) {
        const f32x4* xr = (const f32x4*)(x + (size_t)row * DM) + lane; f32x4 v[4]; float s = 0.f;
#pragma unroll
        for (int j = 0; j < 4; ++j) { v[j] = __builtin_nontemporal_load(xr + 64 * j); s += v[j].x * v[j].x + v[j].y * v[j].y + v[j].z * v[j].z + v[j].w * v[j].w; }
        const float rstd = 1.0f / sqrtf(wave_sum(s) * (1.f / DM) + EPS);
        u32x2* o = (u32x2*)(out + (size_t)row * DM) + lane;
#pragma unroll
        for (int j = 0; j < 4; ++j) { u32x2 w; w.x = pk2(v[j].x * rstd, v[j].y * rstd); w.y = pk2(v[j].z * rstd, v[j].w * rstd); o[64 * j] = w; }
    }
}

struct GUnit { unsigned ao, bo; int row0, col0, e, valid, aux; };

__host__ __device__ __forceinline__ int lds_byte(int r, int c) { const int st = (r >> 4) * 2 + (c >> 5), rr = r & 15, cc = c & 31, ob = rr * 64 + cc * 2; return st * 1024 + (ob ^ (((ob >> 9) & 1) << 5)); }
__host__ __device__ __forceinline__ void stage_rc(int b, int& R, int& C) { const int st = b / 1024, sb = b % 1024, swz = sb ^ (((sb >> 9) & 1) << 5); R = (st >> 1) * 16 + swz / 64; C = (st & 1) * 32 + (swz % 64) / 2; }
__host__ __device__ __forceinline__ int perm32(int rho) { const int n = rho >> 4, i = rho & 15; return 8 * (i >> 2) + 4 * n + (i & 3); }
constexpr int HTB = 128 * 64 * 2;
typedef int v8i __attribute__((ext_vector_type(8)));
typedef int v4i __attribute__((ext_vector_type(4)));
struct Frag2 { bf16x8 h[2]; };
template <bool F> struct FragT { typedef Frag2 T; };
template <> struct FragT<true> { typedef v8i T; };
template <class Sched, class Epi, bool ALIGN_EPI, bool FP8 = false, int SCALE_B = 0x7f>
__device__ __forceinline__ void gemm_phase(unsigned char* lds_flat, const Sched& S, const Epi& E) {
    LDSP unsigned char* lds = (LDSP unsigned char*)(unsigned)(uintptr_t)lds_flat;
    int tid = threadIdx.x; LAUNDER(tid);
    const int wid = __builtin_amdgcn_readfirstlane(tid >> 6), lane = tid & 63, wr = wid >> 2, wc = wid & 3, fr = lane & 15, fq = lane >> 4;
    const int nt = S.K / 64;
    int Rr[2], Cc[2];
#pragma unroll
    for (int i = 0; i < 2; ++i) stage_rc(tid * 16 + i * 8192, Rr[i], Cc[i]);
    unsigned voffB[2][2];
#pragma unroll
    for (int h = 0; h < 2; ++h)
#pragma unroll
        for (int i = 0; i < 2; ++i) voffB[h][i] = (unsigned)(128 * h + (Rr[i] & ~31) + perm32(Rr[i] & 31)) * S.ldb + (unsigned)Cc[i] * 2u;
    const unsigned ldsw = (unsigned)wid * 1024u;
    const int aoff = lds_byte(wr * 64 + fr, fq * 8), boff = lds_byte(wc * 32 + fr, fq * 8);
    constexpr int KSUB = 1024;
#define PG8_SA(b, h) (((b) * 2 + (h)) * HTB)
#define PG8_SB(b, h) ((4 + (b) * 2 + (h)) * HTB)
#define PG8_STAGE(bufoff, rsrc, voff, soff) do { _Pragma("unroll") for (int _i = 0; _i < 2; ++_i) \
        __builtin_amdgcn_raw_ptr_buffer_load_lds(rsrc, (LDSP unsigned*)(lds + (bufoff) + ldsw + _i * 8192), 16, (int)(voff)[_i], (int)(soff), 0, 0); } while (0)
#define PG8_LDF(dst, addr) do { const bf16x8 lo_ = *(const LDSP bf16x8*)(addr); const bf16x8 hi_ = *(const LDSP bf16x8*)((addr) + KSUB); \
        if constexpr (FP8) dst = __builtin_shufflevector(__builtin_bit_cast(v4i, lo_), __builtin_bit_cast(v4i, hi_), 0, 1, 2, 3, 4, 5, 6, 7); else { dst.h[0] = lo_; dst.h[1] = hi_; } } while (0)
#define PG8_LDA(dst, b, h) do { _Pragma("unroll") for (int m = 0; m < 4; ++m) PG8_LDF(dst[m], lds + PG8_SA(b, h) + aoff + m * 2048); } while (0)
#define PG8_LDB(dst, b, h) do { _Pragma("unroll") for (int n = 0; n < 2; ++n) PG8_LDF(dst[n], lds + PG8_SB(b, h) + boff + n * 2048); } while (0)
#define PG8_MMA(ai, bj, At, Bt) do { __builtin_amdgcn_s_setprio(1); _Pragma("unroll") for (int m = 0; m < 4; ++m) _Pragma("unroll") for (int n = 0; n < 2; ++n) { \
        if constexpr (FP8) asm volatile("v_mfma_scale_f32_16x16x128_f8f6f4 %0, %1, %2, %0, %3, %4 op_sel_hi:[0,0,0]" : "+v"(acc[ai][bj][m][n]) : "v"(Bt[n]), "v"(At[m]), "v"(sclB), "v"(sclA)); \
        else { _Pragma("unroll") for (int k = 0; k < 2; ++k) acc[ai][bj][m][n] = __builtin_amdgcn_mfma_f32_16x16x32_bf16(Bt[n].h[k], At[m].h[k], acc[ai][bj][m][n], 0, 0, 0); } } \
        __builtin_amdgcn_s_setprio(0); } while (0)
#define PG8_WAIT_V(n) asm volatile("s_waitcnt vmcnt(" #n ")" ::: "memory")
#define PG8_WAIT_L(n) asm volatile("s_waitcnt lgkmcnt(" #n ")" ::: "memory")
#define PG8_BAR __builtin_amdgcn_s_barrier()
#define PG8_SCHED __builtin_amdgcn_sched_barrier(0)
    GUnit cur, nxt; int ui = 0;
    if (!S.next(0, cur)) return;
    const __amdgpu_buffer_rsrc_t rA = __builtin_amdgcn_make_buffer_rsrc((void*)S.A, 0, 0x7fffffff, 0x00020000);
    const __amdgpu_buffer_rsrc_t rB = __builtin_amdgcn_make_buffer_rsrc((void*)S.Bt, 0, 0x7fffffff, 0x00020000);
    unsigned oc[2][2], on[2][2];
#pragma unroll
    for (int h = 0; h < 2; ++h)
#pragma unroll
        for (int i = 0; i < 2; ++i) oc[h][i] = S.a_off(cur, 128 * h + Rr[i]) + (unsigned)Cc[i] * 2u;
    f32x4 acc[2][2][4][2];
#pragma unroll
    for (int a = 0; a < 2; ++a)
#pragma unroll
        for (int b = 0; b < 2; ++b)
#pragma unroll
            for (int m = 0; m < 4; ++m)
#pragma unroll
                for (int n = 0; n < 2; ++n) acc[a][b][m][n] = (f32x4){0.f, 0.f, 0.f, 0.f};
    typedef typename FragT<FP8>::T frag_t;
    frag_t At[4], B0[2], B1[2];
    const unsigned kstep = 128;
    const int sclB = SCALE_B * 0x01010101, sclA = 0x7f7f7f7f; (void)sclA; (void)sclB;
    PG8_STAGE(PG8_SB(0, 0), rB, voffB[0], cur.bo); PG8_STAGE(PG8_SB(0, 1), rB, voffB[1], cur.bo); PG8_STAGE(PG8_SA(0, 0), rA, oc[0], cur.ao); PG8_STAGE(PG8_SA(0, 1), rA, oc[1], cur.ao);
    if (wr == 1) PG8_BAR;
    PG8_WAIT_V(2); PG8_BAR;
    PG8_STAGE(PG8_SB(1, 0), rB, voffB[0], cur.bo + kstep); PG8_STAGE(PG8_SA(1, 0), rA, oc[0], cur.ao + kstep); PG8_STAGE(PG8_SB(1, 1), rB, voffB[1], cur.bo + kstep);
    PG8_WAIT_V(6); PG8_BAR;
    for (;;) {
        const bool has_next = S.next(ui + 1, nxt);
        if (!has_next) nxt = cur;
        const unsigned nA = nxt.ao, nB = nxt.bo;
        { int t2 = threadIdx.x; LAUNDER(t2);
#pragma unroll
          for (int i = 0; i < 2; ++i) { int R_, C_; stage_rc(t2 * 16 + i * 8192, R_, C_);
#pragma unroll
              for (int h = 0; h < 2; ++h) on[h][i] = S.a_off(nxt, 128 * h + R_) + (unsigned)C_ * 2u; } }
        for (int t = 0; t < nt; t += 2) {
            const bool last = (t == nt - 2);
            const unsigned k1 = cur.ao + (unsigned)(t + 1) * kstep;
            const unsigned a2 = last ? nA : cur.ao + (unsigned)(t + 2) * kstep, b2 = last ? nB : cur.bo + (unsigned)(t + 2) * kstep, a3 = a2 + kstep, b3 = b2 + kstep;
            unsigned o2[2][2];
#pragma unroll
            for (int h = 0; h < 2; ++h)
#pragma unroll
                for (int i = 0; i < 2; ++i) o2[h][i] = last ? on[h][i] : oc[h][i];
            PG8_LDB(B0, 0, 0); PG8_LDB(B1, 0, 1); PG8_SCHED; PG8_LDA(At, 0, 0); PG8_STAGE(PG8_SA(1, 1), rA, oc[1], k1);
            PG8_WAIT_V(8); PG8_WAIT_L(0); PG8_BAR; PG8_MMA(0, 0, At, B0); PG8_MMA(0, 1, At, B1); PG8_BAR; PG8_SCHED;
            PG8_LDA(At, 0, 1); PG8_STAGE(PG8_SB(0, 0), rB, voffB[0], b2); PG8_STAGE(PG8_SB(0, 1), rB, voffB[1], b2); PG8_STAGE(PG8_SA(0, 0), rA, o2[0], a2);
            PG8_WAIT_V(8); PG8_WAIT_L(0); PG8_BAR; PG8_MMA(1, 0, At, B0); PG8_MMA(1, 1, At, B1); PG8_BAR; PG8_SCHED;
            PG8_LDB(B0, 1, 0); PG8_LDB(B1, 1, 1); PG8_SCHED; PG8_LDA(At, 1, 0); PG8_STAGE(PG8_SA(0, 1), rA, o2[1], a2);
            PG8_WAIT_V(8); PG8_WAIT_L(0); PG8_BAR; PG8_MMA(0, 0, At, B0); PG8_MMA(0, 1, At, B1); PG8_BAR; PG8_SCHED;
            PG8_LDA(At, 1, 1); PG8_STAGE(PG8_SB(1, 0), rB, voffB[0], b3); PG8_STAGE(PG8_SB(1, 1), rB, voffB[1], b3); PG8_STAGE(PG8_SA(1, 0), rA, o2[0], a3);
            PG8_WAIT_V(8); PG8_WAIT_L(0); PG8_BAR; PG8_MMA(1, 0, At, B0); PG8_MMA(1, 1, At, B1); PG8_BAR; PG8_SCHED;
        }
        if constexpr (FP8) asm volatile("s_nop 15\n\ts_nop 15" ::: "memory");
        if constexpr (ALIGN_EPI) { if (wr == 0) PG8_BAR; }
        if constexpr (!Epi::AFTER_DRAIN) E(acc, cur, wr, wc, fr, fq);
        if (!has_next) break;
#pragma unroll
        for (int a = 0; a < 2; ++a)
#pragma unroll
            for (int b = 0; b < 2; ++b)
#pragma unroll
                for (int m = 0; m < 4; ++m)
#pragma unroll
                    for (int n = 0; n < 2; ++n) acc[a][b][m][n] = (f32x4){0.f, 0.f, 0.f, 0.f};
        cur = nxt; ++ui;
#pragma unroll
        for (int h = 0; h < 2; ++h)
#pragma unroll
            for (int i = 0; i < 2; ++i) oc[h][i] = on[h][i];
        if constexpr (ALIGN_EPI) { if (wr == 1) PG8_BAR; }
    }
    PG8_WAIT_V(0);
    if constexpr (!ALIGN_EPI) { if (wr == 0) PG8_BAR; }
    PG8_BAR;
    if constexpr (Epi::AFTER_DRAIN) E.fused(acc, cur, wr, wc, fr, fq, lds_flat, wid, lane);
#undef PG8_SA
#undef PG8_SB
#undef PG8_STAGE
#undef PG8_LDA
#undef PG8_LDF
#undef PG8_LDB
#undef PG8_MMA
#undef PG8_WAIT_V
#undef PG8_WAIT_L
#undef PG8_BAR
#undef PG8_SCHED
}
template <bool ALIGN, class Sched, class Epi> __device__ __forceinline__ void gemm_run(unsigned char* lds, const Sched& S, const Epi& E) {
    gemm_phase<Sched, Epi, ALIGN>(lds, S, E);
}
constexpr int WSCALE_LOG2 = 6;
template <bool ALIGN, class Sched, class Epi> __device__ __forceinline__ void gemm_run_fp8(unsigned char* lds, const Sched& S, const Epi& E) {
    gemm_phase<Sched, Epi, ALIGN, true, 127 - WSCALE_LOG2>(lds, S, E);
}

struct DenseSched {
    const char* A; const char* Bt; unsigned lda, ldb; int K; int nM, nN; int pm_per_b; size_t zB; int G, c;
    __device__ __forceinline__ bool next(int i, GUnit& u) const {
        int pm, pn;
        if (G == 256 && (nN & 3) == 0 && nM * nN >= 256) {
            const int j = c & 7, q = c >> 3, s = i * 8 + j, ncg = nN >> 2; pm = (s / ncg) * 8 + (q >> 2); pn = (s % ncg) * 4 + (q & 3); if (c < 0 || pm >= nM) return false; }
        else { const long L = (long)i * G + c; if (c < 0 || L >= (long)nM * nN) return false; pm = (int)(L / nN); pn = (int)(L % nN); }
        u.ao = (unsigned)pm * 256u * lda; u.bo = (unsigned)((size_t)(pm / pm_per_b) * zB) + (unsigned)pn * 256u * ldb; u.row0 = pm * 256; u.col0 = pn * 256; u.e = 0; u.valid = 256; u.aux = 0; return true;
    }
    __device__ __forceinline__ unsigned a_off(const GUnit&, int r) const { return (unsigned)r * lda; }
};
struct SchedWqk {
    const char* A; const char* Bt; unsigned lda, ldb; int K; int G, c, pad;
    __device__ __forceinline__ bool next(int i, GUnit& u) const {
        const int L = i * G + c; if (c < 0 || L >= 32) return false; const int z = L >> 2, pn = L & 3, b = z >> 2, h = z & 3;
        u.ao = (unsigned)b * 256u * 4096u + h * 512u; u.bo = (unsigned)pn * 256u * 2048u + h * 512u; u.row0 = z * 256; u.col0 = pn * 256; u.e = 0; u.valid = 256; u.aux = 0; return true;
    }
    __device__ __forceinline__ unsigned a_off(const GUnit&, int r) const { return (unsigned)r * lda; }
};
struct SchedVo {
    const char* A; const char* Bt; unsigned lda, ldb; int K; int G, c, pad;
    __device__ __forceinline__ bool next(int i, GUnit& u) const {
        const int L = i * G + c; if (c < 0 || L >= 32) return false; const int z = L >> 2, pm = L & 3, b = z >> 2, h = z & 3;
        u.ao = (unsigned)pm * 256u * 2048u + h * 512u; u.bo = (unsigned)b * 256u * 4096u + 2048u + h * 512u; u.row0 = b * 1024 + pm * 256; u.col0 = h * 256; u.e = 0; u.valid = 256; u.aux = 0; return true;
    }
    __device__ __forceinline__ unsigned a_off(const GUnit&, int r) const { return (unsigned)r * lda; }
};
template <bool GATHER> struct MoeSched {
    const char* A; const char* Bt; unsigned lda, ldb; int K; int nN; size_t zB;
    const int* tab; const int* list; int gather; int G, c, pad;
    __device__ __forceinline__ bool next(int i, GUnit& u) const {
        int T, pn;
        if (G == 256) { const int j = c & 7, q = c >> 3, s = i * 8 + j;
            if (nN == 8) { T = 4 * s + (q >> 3); pn = q & 7; } else { T = 8 * s + (q >> 2); pn = q & 3; } }
        else { const int L = i * G + c; T = L / nN; pn = L % nN; }
        if (T >= __builtin_amdgcn_readfirstlane(tab[64])) return false;
        const int w = __builtin_amdgcn_readfirstlane(tab[128 + T]); const int e = w & 255, rt = w >> 8; const int ce = __builtin_amdgcn_readfirstlane(tab[e]), start = __builtin_amdgcn_readfirstlane(tab[32 + e]);
        u.e = e; u.valid = min(256, ce - rt * 256); u.row0 = start + rt * 256; u.col0 = pn * 256; u.aux = rt * 256;
        u.ao = GATHER ? 0u : (unsigned)u.row0 * lda; u.bo = (unsigned)((size_t)e * zB) + (unsigned)pn * 256u * ldb; return true;
    }
    __device__ __forceinline__ unsigned a_off(const GUnit& u, int r) const {
        if (!GATHER) return (unsigned)r * lda;
        const int rr = r < u.valid ? r : 0; const int tok = list[u.e * NTOK + u.aux + rr]; return (unsigned)tok * lda;
    }
};
__device__ __forceinline__ void moe_build_table(int* tab, const int* __restrict__ cnt, int tid) {
    if (tid < 32) tab[tid] = cnt[tid * 32];
    __syncthreads();
    if (tid < 32) { int s = 0; for (int e = 0; e < tid; ++e) s += tab[e]; tab[32 + tid] = s; }
    if (tid < 320) { int tiles = 0, found = -1;
        for (int e = 0; e < NEXP; ++e) { const int te = (tab[e] + 255) >> 8; if (found < 0 && tid < tiles + te) found = e | ((tid - tiles) << 8); tiles += te; }
        if (found >= 0) tab[128 + tid] = found; if (tid == 0) tab[64] = tiles; }
    __syncthreads();
}

__device__ __forceinline__ u32x4 pack8(const f32x4& a, const f32x4& b) { u32x4 w; w.x = pk2(a[0], a[1]); w.y = pk2(a[2], a[3]); w.z = pk2(b[0], b[1]); w.w = pk2(b[2], b[3]); return w; }
struct EpiBf16 { static constexpr bool AFTER_DRAIN = false; bf16_t* O; int ldc, pad;
    __device__ __forceinline__ void operator()(const f32x4 (&acc)[2][2][4][2], const GUnit& u, int wr, int wc, int fr, int fq) const {
        LAUNDER(fr); LAUNDER(fq);
#pragma unroll
        for (int ai = 0; ai < 2; ++ai)
#pragma unroll
            for (int m = 0; m < 4; ++m) { const int r = 128 * ai + 64 * wr + 16 * m + fr;
#pragma unroll
                for (int bj = 0; bj < 2; ++bj) *(u32x4*)(O + (size_t)(u.row0 + r) * ldc + u.col0 + 128 * bj + 32 * wc + 8 * fq) = pack8(acc[ai][bj][m][0], acc[ai][bj][m][1]); } } };
__device__ __forceinline__ float row_rstd(const float* __restrict__ ssp, int row) { const f32x4* p = (const f32x4*)(ssp + (size_t)row * 16); const f32x4 a = p[0], b = p[1], c = p[2], d = p[3];
    const float s = (((a[0] + a[1]) + (a[2] + a[3])) + ((b[0] + b[1]) + (b[2] + b[3]))) + (((c[0] + c[1]) + (c[2] + c[3])) + ((d[0] + d[1]) + (d[2] + d[3]))); return 1.0f / sqrtf(s * (1.0f / 1024.0f) + EPS); }
template <bool BASE_BF16> struct EpiResidSS { static constexpr bool AFTER_DRAIN = false; const void* base; bf16_t* xb; float* ss; unsigned char* xq;
    __device__ __forceinline__ void operator()(const f32x4 (&acc)[2][2][4][2], const GUnit& u, int wr, int wc, int fr, int fq) const {
        LAUNDER(fr); LAUNDER(fq);
#pragma unroll
        for (int ai = 0; ai < 2; ++ai) {
            f32x4 b[4][2][2];
#pragma unroll
            for (int m = 0; m < 4; ++m)
#pragma unroll
                for (int bj = 0; bj < 2; ++bj) { const size_t o = (size_t)(u.row0 + 128 * ai + 64 * wr + 16 * m + fr) * 1024 + u.col0 + 128 * bj + 32 * wc + 8 * fq;
                    if (BASE_BF16) { const u32x4 w = *(const u32x4*)((const bf16_t*)base + o); b[m][bj][0] = (f32x4){bflo(w.x), bfhi(w.x), bflo(w.y), bfhi(w.y)}; b[m][bj][1] = (f32x4){bflo(w.z), bfhi(w.z), bflo(w.w), bfhi(w.w)}; }
                    else { b[m][bj][0] = __builtin_nontemporal_load((const f32x4*)((const float*)base + o)); b[m][bj][1] = __builtin_nontemporal_load((const f32x4*)((const float*)base + o + 4)); } }
#pragma unroll
            for (int m = 0; m < 4; ++m) { const int r = 128 * ai + 64 * wr + 16 * m + fr; float part = 0.f;
#pragma unroll
                for (int bj = 0; bj < 2; ++bj) { const size_t o = (size_t)(u.row0 + r) * 1024 + u.col0 + 128 * bj + 32 * wc + 8 * fq;
                    const f32x4 y0 = b[m][bj][0] + acc[ai][bj][m][0], y1 = b[m][bj][1] + acc[ai][bj][m][1]; *(u32x4*)(xb + o) = pack8(y0, y1);
                    if (xq) { u32x2 q; q.x = pk4_fp8(y0[0], y0[1], y0[2], y0[3]); q.y = pk4_fp8(y1[0], y1[1], y1[2], y1[3]); *(u32x2*)(xq + o) = q; }
                    part += (y0[0] * y0[0] + y0[1] * y0[1] + y0[2] * y0[2] + y0[3] * y0[3]) + (y1[0] * y1[0] + y1[1] * y1[1] + y1[2] * y1[2] + y1[3] * y1[3]); }
                part += __shfl_xor(part, 16); part += __shfl_xor(part, 32);
                if (fq == 0) ss[(size_t)(u.row0 + r) * 16 + (u.col0 >> 8) * 4 + wc] = part; } } } };
struct EpiSoftmax { static constexpr bool AFTER_DRAIN = true; const float* ss; bf16_t* P;
    __device__ __forceinline__ void operator()(const f32x4 (&)[2][2][4][2], const GUnit&, int, int, int, int) const {}
    __device__ __forceinline__ void fused(f32x4 (&acc)[2][2][4][2], const GUnit& u, int wr, int wc, int fr, int fq, unsigned char* lds, int wid, int lane) const {
        float* Pm = (float*)lds; float* Ps = (float*)(lds + 4096);
        LAUNDER(fr); LAUNDER(fq);
#pragma unroll
        for (int ai = 0; ai < 2; ++ai)
#pragma unroll
            for (int m = 0; m < 4; ++m) { const int r = 128 * ai + 64 * wr + 16 * m + fr; const float rstd = row_rstd(ss, u.row0 + r); float mv = -INFINITY;
#pragma unroll
                for (int bj = 0; bj < 2; ++bj)
#pragma unroll
                    for (int n = 0; n < 2; ++n) { f32x4 s = acc[ai][bj][m][n] * rstd; acc[ai][bj][m][n] = s; mv = fmaxf(mv, fmaxf(fmaxf(s[0], s[1]), fmaxf(s[2], s[3]))); }
                mv = fmaxf(mv, __shfl_xor(mv, 16)); mv = fmaxf(mv, __shfl_xor(mv, 32));
                if (fq == 0) Pm[r * 4 + wc] = mv; }
        __syncthreads();
#pragma unroll
        for (int ai = 0; ai < 2; ++ai)
#pragma unroll
            for (int m = 0; m < 4; ++m) { const int r = 128 * ai + 64 * wr + 16 * m + fr; const f32x4 pm = *(const f32x4*)(Pm + r * 4); const float mv = fmaxf(fmaxf(pm[0], pm[1]), fmaxf(pm[2], pm[3])); float sum = 0.f;
#pragma unroll
                for (int bj = 0; bj < 2; ++bj)
#pragma unroll
                    for (int n = 0; n < 2; ++n) { f32x4 s = acc[ai][bj][m][n]; s[0] = __builtin_amdgcn_exp2f(s[0] - mv); s[1] = __builtin_amdgcn_exp2f(s[1] - mv); s[2] = __builtin_amdgcn_exp2f(s[2] - mv); s[3] = __builtin_amdgcn_exp2f(s[3] - mv);
                        acc[ai][bj][m][n] = s; sum += (s[0] + s[1]) + (s[2] + s[3]); }
                sum += __shfl_xor(sum, 16); sum += __shfl_xor(sum, 32);
                if (fq == 0) Ps[r * 4 + wc] = sum; }
        __syncthreads();
#pragma unroll
        for (int ai = 0; ai < 2; ++ai)
#pragma unroll
            for (int m = 0; m < 4; ++m) { const int r = 128 * ai + 64 * wr + 16 * m + fr; const f32x4 ps = *(const f32x4*)(Ps + r * 4); const float inv = 1.0f / ((ps[0] + ps[1]) + (ps[2] + ps[3]));
#pragma unroll
                for (int bj = 0; bj < 2; ++bj) *(u32x4*)(P + (size_t)(u.row0 + r) * 1024 + u.col0 + 128 * bj + 32 * wc + 8 * fq) = pack8(acc[ai][bj][m][0] * inv, acc[ai][bj][m][1] * inv); }
        (void)wid; (void)lane;
        __syncthreads();
    } };
struct EpiGU { static constexpr bool AFTER_DRAIN = false; const float* bgu; unsigned char* act  ; const float* lrs  ;
    __device__ __forceinline__ void operator()(const f32x4 (&acc)[2][2][4][2], const GUnit& u, int wr, int wc, int fr, int fq) const {
        const int pn = u.col0 >> 8; const float* bg = bgu + (size_t)u.e * 2048; LAUNDER(fr); LAUNDER(fq);
        float rs[8];
#pragma unroll
        for (int i = 0; i < 8; ++i) { const int r = 128 * (i >> 2) + 64 * wr + 16 * (i & 3) + fr; rs[i] = lrs[(size_t)u.e * NTOK + u.aux + (r < u.valid ? r : 0)]; }
        const int col = 128 * pn + 32 * wc + 8 * fq;
        f32x4 bgv[2], blv[2];
#pragma unroll
        for (int n = 0; n < 2; ++n) { bgv[n] = *(const f32x4*)(bg + col + 4 * n); blv[n] = *(const f32x4*)(bg + 1024 + col + 4 * n); }
#pragma unroll
        for (int ai = 0; ai < 2; ++ai)
#pragma unroll
            for (int m = 0; m < 4; ++m) { const int r = 128 * ai + 64 * wr + 16 * m + fr; const float rstd = rs[ai * 4 + m]; u32x2 q;
#pragma unroll
                for (int n = 0; n < 2; ++n) { const f32x4 g = acc[ai][0][m][n] * rstd + bgv[n], l = acc[ai][1][m][n] * rstd + blv[n]; float o[4];
#pragma unroll
                    for (int j = 0; j < 4; ++j) { const float gg = fminf(g[j], 7.0f), ll = fminf(fmaxf(l[j], -7.0f), 7.0f); o[j] = (ll + 1.0f) * (gg * __builtin_amdgcn_rcpf(1.0f + __builtin_amdgcn_exp2f(-1.702f * LOG2E * gg))); }
                    const unsigned w = pk4_fp8(o[0], o[1], o[2], o[3]); if (n == 0) q.x = w; else q.y = w; }
                if (r < u.valid) *(u32x2*)(act + (size_t)(u.row0 + r) * 1024 + col) = q; } } };
struct EpiDown { static constexpr bool AFTER_DRAIN = false; const float* bdn; unsigned char* ys  ;
    __device__ __forceinline__ void operator()(const f32x4 (&acc)[2][2][4][2], const GUnit& u, int wr, int wc, int fr, int fq) const {
        const float* bd = bdn + (size_t)u.e * 1024; LAUNDER(fr); LAUNDER(fq);
        f32x4 bv[2][2];
#pragma unroll
        for (int bj = 0; bj < 2; ++bj)
#pragma unroll
            for (int n = 0; n < 2; ++n) bv[bj][n] = *(const f32x4*)(bd + u.col0 + 128 * bj + 32 * wc + 8 * fq + 4 * n);
#pragma unroll
        for (int ai = 0; ai < 2; ++ai)
#pragma unroll
            for (int m = 0; m < 4; ++m) { const int r = 128 * ai + 64 * wr + 16 * m + fr; if (r < u.valid) {
#pragma unroll
                for (int bj = 0; bj < 2; ++bj) { const f32x4 y0 = acc[ai][bj][m][0] + bv[bj][0], y1 = acc[ai][bj][m][1] + bv[bj][1]; u32x2 q; q.x = pk4_fp8(y0[0], y0[1], y0[2], y0[3]); q.y = pk4_fp8(y1[0], y1[1], y1[2], y1[3]);
                    *(u32x2*)(ys + (size_t)(u.row0 + r) * 1024 + u.col0 + 128 * bj + 32 * wc + 8 * fq) = q; } } } } };


typedef float f32x16 __attribute__((ext_vector_type(16)));
typedef short s16x4 __attribute__((ext_vector_type(4)));
__device__ __forceinline__ int crow(int r, int hi) { return (r & 3) + 8 * (r >> 2) + 4 * hi; }
__device__ __forceinline__ s16x4 tr_read(const unsigned char* p) { return __builtin_bit_cast(s16x4, __builtin_amdgcn_ds_read_tr16_b64_v4i16((LDSP s16x4*)(unsigned)(uintptr_t)p)); }
__device__ __forceinline__ bf16x8 tr_frag(const unsigned char* img, int pitch, int k0, int f0, int lane) {
    const unsigned char* p = img + (k0 + 8 * (lane >> 5) + ((lane & 15) >> 2)) * pitch + (f0 + 16 * ((lane >> 4) & 1) + 4 * (lane & 3)) * 2;
    const s16x4 lo = tr_read(p), hi = tr_read(p + 4 * pitch);
    return (bf16x8){lo[0], lo[1], lo[2], lo[3], hi[0], hi[1], hi[2], hi[3]};
}
constexpr int GA_PK = 576, GA_PV = 1088;
constexpr int GA_V = 0, GA_PART = 0, GA_GLR = 69632, GA_TOT = 73728, GA_KD = 75776, GA_END = GA_KD + 64 * GA_PK;
__device__ __forceinline__ void gla_pass_a(unsigned char* lds, int task, const bf16_t* __restrict__ xn, const bf16_t* __restrict__ wglr  , const bf16_t* __restrict__ proj,
                                           const float* __restrict__ wg, const float* __restrict__ bg, float* __restrict__ UT, float* __restrict__ decay) {
    int tid = threadIdx.x; LAUNDER(tid); int wid = tid >> 6, lane = tid & 63, fr = lane & 15, fq = lane >> 4;
    const size_t t0 = (size_t)task * 64;
    { f32x4 acc[4];
#pragma unroll
      for (int m = 0; m < 4; ++m) acc[m] = (f32x4){0.f, 0.f, 0.f, 0.f};
#pragma unroll
      for (int ks = 0; ks < 4; ++ks) { const int k = 128 * wid + 32 * ks + 8 * fq; const bf16x8 bfr = *(const bf16x8*)(wglr + (size_t)fr * 1024 + k);
#pragma unroll
          for (int m = 0; m < 4; ++m) { const bf16x8 afr = *(const bf16x8*)(xn + (t0 + 16 * m + fr) * DM + k); acc[m] = __builtin_amdgcn_mfma_f32_16x16x32_bf16(afr, bfr, acc[m], 0, 0, 0); } }
      float* part = (float*)(lds + GA_PART) + wid * 1024;
#pragma unroll
      for (int m = 0; m < 4; ++m)
#pragma unroll
          for (int j = 0; j < 4; ++j) part[(16 * m + 4 * fq + j) * 16 + fr] = acc[m][j]; }
    __syncthreads();
    { float* glr = (float*)(lds + GA_GLR); const float* part = (const float*)(lds + GA_PART);
      for (int i = tid; i < 1024; i += 512) { float s = 0.f;
#pragma unroll
          for (int w = 0; w < 8; ++w) s += part[w * 1024 + i];
          glr[i] = s; } }
    __syncthreads();
    LAUNDER(tid);
    { const int cv = tid & 63, tk = tid >> 6;
#pragma unroll
      for (int i = 0; i < 8; ++i) { const int tok = tk + 8 * i; const u32x4 v = *(const u32x4*)(proj + (t0 + tok) * PROJ_LD + C_VG + cv * 8); *(u32x4*)(lds + GA_V + tok * GA_PV + cv * 16) = v; } }
    LAUNDER(tid);
    { const int j = tid & 255, half = tid >> 8; const float* glr = (const float*)(lds + GA_GLR); float* tot = (float*)(lds + GA_TOT);
      float w[16];
#pragma unroll
      for (int i = 0; i < 16; ++i) w[i] = wg[i * 256 + j];
      const float bj = bg[j]; float run = 0.f;
      bf16_t kk16[32];
#pragma unroll
      for (int s = 0; s < 32; ++s) kk16[s] = proj[(t0 + 32 * half + s) * PROJ_LD + C_KG + j];
#pragma unroll 2
      for (int s = 0; s < 32; ++s) { const float* gl = glr + (32 * half + s) * 16; float u = bj;
#pragma unroll
          for (int i = 0; i < 16; ++i) u += gl[i] * w[i];
          const float ls = fminf(u, 0.f) - __logf(1.0f + __expf(-fabsf(u)));
          run += ls * (1.0f / 16.0f); }
      tot[half * 256 + j] = run;
      __syncthreads();
      const float t0v = tot[j], t1v = tot[256 + j]; const float gend = t0v + t1v;
      if (half == 0) decay[(size_t)task * 256 + j] = __expf(gend);
      run = half ? t0v : 0.f;
#pragma unroll
      for (int s = 0; s < 32; ++s) { const int tok = 32 * half + s; const float* gl = glr + tok * 16; float u = bj;
#pragma unroll
          for (int i = 0; i < 16; ++i) u += gl[i] * w[i];
          const float ls = fminf(u, 0.f) - __logf(1.0f + __expf(-fabsf(u)));
          run += ls * (1.0f / 16.0f);
          const float kk = bf2f(kk16[s]);
          *(bf16_t*)(lds + GA_KD + tok * GA_PK + j * 2) = (bf16_t)f2bf(kk * __expf(gend - run)); } }
    __syncthreads();
    LAUNDER(tid); wid = __builtin_amdgcn_readfirstlane(tid >> 6); lane = tid & 63;
    { const int h = wid >> 1, nt = wid & 1, hi = lane >> 5, c32 = lane & 31; f32x16 acc[4];
#pragma unroll
      for (int m = 0; m < 4; ++m)
#pragma unroll
          for (int r = 0; r < 16; ++r) acc[m][r] = 0.f;
#pragma unroll
      for (int ks = 0; ks < 4; ++ks) { const bf16x8 bfr = tr_frag(lds + GA_KD, GA_PK, 16 * ks, h * 64 + 32 * nt, lane);
#pragma unroll
          for (int m = 0; m < 4; ++m) { const bf16x8 afr = tr_frag(lds + GA_V, GA_PV, 16 * ks, h * 128 + 32 * m, lane); acc[m] = __builtin_amdgcn_mfma_f32_32x32x16_bf16(afr, bfr, acc[m], 0, 0, 0); } }
      float* u = UT + ((size_t)task * 4 + h) * 8192;
#pragma unroll
      for (int m = 0; m < 4; ++m)
#pragma unroll
          for (int r = 0; r < 16; ++r) __builtin_nontemporal_store(acc[m][r], u + (32 * m + crow(r, hi)) * 64 + 32 * nt + c32); }
    __syncthreads();
}
__device__ __forceinline__ void gla_pass_b(int e, const float* __restrict__ UT, const float* __restrict__ decay, bf16_t* __restrict__ ST) {
    const int dk = e & 63, dv = (e >> 6) & 127, h = (e >> 13) & 3, b = e >> 15; float s = 0.f;
    const size_t base = ((size_t)b * 128 * 4 + h) * 8192 + dv * 64 + dk; const size_t dbase = (size_t)b * 128 * 256 + h * 64 + dk;
    for (int c0 = 0; c0 < 128; c0 += 32) { float u[32], d[32];
#pragma unroll
        for (int i = 0; i < 32; ++i) { u[i] = __builtin_nontemporal_load(UT + base + (size_t)(c0 + i) * 4 * 8192); d[i] = decay[dbase + (size_t)(c0 + i) * 256]; }
#pragma unroll
        for (int i = 0; i < 32; ++i) { s = d[i] * s + u[i]; __builtin_nontemporal_store((bf16_t)f2bf(s), ST + base + (size_t)(c0 + i) * 4 * 8192); } }
}
constexpr int GC_PITCH = 520;
__device__ __forceinline__ void gla_pass_c(unsigned char* wlds  , int wtask, const bf16_t* __restrict__ ST, const bf16_t* __restrict__ proj, const float* __restrict__ ghead, bf16_t* __restrict__ mix, int lane) {
    const int nh = wtask & 1, h = (wtask >> 1) & 3, bc = wtask >> 3; const int c32 = lane & 31, hi = lane >> 5;
    const size_t t0 = (size_t)bc * 64 + 32 * nh; const bf16_t* st = ST + ((size_t)bc * 4 + h) * 8192;
    f32x16 acc[4];
#pragma unroll
    for (int m = 0; m < 4; ++m)
#pragma unroll
        for (int r = 0; r < 16; ++r) acc[m][r] = 0.f;
#pragma unroll
    for (int ks = 0; ks < 4; ++ks) { const bf16x8 bfr = *(const bf16x8*)(proj + (t0 + c32) * PROJ_LD + C_QG + h * 64 + 16 * ks + 8 * hi);
#pragma unroll
        for (int m = 0; m < 4; ++m) { const bf16x8 afr = *(const bf16x8*)(st + (32 * m + c32) * 64 + 16 * ks + 8 * hi); acc[m] = __builtin_amdgcn_mfma_f32_32x32x16_bf16(afr, bfr, acc[m], 0, 0, 0); } }
    float ss = 0.f;
#pragma unroll
    for (int m = 0; m < 4; ++m)
#pragma unroll
        for (int r = 0; r < 16; ++r) ss += acc[m][r] * acc[m][r];
    ss += __shfl_xor(ss, 32);
    const float rstd = 1.0f / sqrtf(ss * (1.0f / 128.0f) + EPS);
#pragma unroll
    for (int m = 0; m < 4; ++m)
#pragma unroll
        for (int r = 0; r < 16; ++r) *(float*)(wlds + c32 * GC_PITCH + (32 * m + crow(r, hi)) * 4) = acc[m][r] * rstd;
#pragma unroll
    for (int i = 0; i < 8; ++i) { const int q = lane + 64 * i, tok = q >> 4, dv0 = (q & 15) * 8; const float* src = (const float*)(wlds + tok * GC_PITCH + dv0 * 4);
        const u32x4 rgw = *(const u32x4*)(proj + (t0 + tok) * PROJ_LD + C_RG + h * 128 + dv0); const f32x4 g0 = *(const f32x4*)(ghead + dv0), g1 = *(const f32x4*)(ghead + dv0 + 4);
        const float rg[8] = {bflo(rgw.x), bfhi(rgw.x), bflo(rgw.y), bfhi(rgw.y), bflo(rgw.z), bfhi(rgw.z), bflo(rgw.w), bfhi(rgw.w)}; const float gg[8] = {g0.x, g0.y, g0.z, g0.w, g1.x, g1.y, g1.z, g1.w}; float y[8];
#pragma unroll
        for (int k = 0; k < 8; ++k) y[k] = src[k] * gg[k] * (rg[k] / (1.0f + __expf(-rg[k])));
        u32x4 o; o.x = pk2(y[0], y[1]); o.y = pk2(y[2], y[3]); o.z = pk2(y[4], y[5]); o.w = pk2(y[6], y[7]);
        *(u32x4*)(mix + (t0 + tok) * 1024 + h * 128 + dv0) = o; }
}
__device__ __forceinline__ void sb_task(unsigned char* vl  , int wtask, const bf16_t* __restrict__ proj, bf16_t* __restrict__ mix, int lane) {
    const int qt = wtask & 255, h = (wtask >> 8) & 7, b = wtask >> 11; const int c = lane & 31, hi = lane >> 5;
    const int t0 = qt * 32; const size_t rowb = (size_t)b * SEQ;
    bf16x8 qf[4];
#pragma unroll
    for (int d0 = 0; d0 < 4; ++d0) qf[d0] = *(const bf16x8*)(proj + (rowb + t0 + c) * PROJ_LD + C_QS + h * 64 + 16 * d0 + 8 * hi);
    const int kap = 16 * ((c >> 2) & 1) + (c & 3) + 4 * (c >> 3);
    f32x16 o0, o1;
#pragma unroll
    for (int r = 0; r < 16; ++r) { o0[r] = 0.f; o1[r] = 0.f; }
    float Dc = 1.0f;
    const bf16_t* kbase = proj + rowb * PROJ_LD + C_KS + h * 64 + 8 * hi + (size_t)kap * PROJ_LD;
    const bf16_t* vbase = proj + rowb * PROJ_LD + C_VS + h * 64 + (lane & 7) * 8 + (size_t)(lane >> 3) * PROJ_LD;
    bf16x8 kf[4]; u32x4 vr[4];
#pragma unroll
    for (int d0 = 0; d0 < 4; ++d0) kf[d0] = *(const bf16x8*)(kbase + (size_t)t0 * PROJ_LD + 16 * d0);
#pragma unroll
    for (int i = 0; i < 4; ++i) vr[i] = *(const u32x4*)(vbase + (size_t)(t0 + 8 * i) * PROJ_LD);
    for (int j0 = t0; j0 >= 0; j0 -= 32) {
#pragma unroll
        for (int i = 0; i < 4; ++i) { const int key = (lane >> 3) + 8 * i, ch = lane & 7; *(u32x4*)(vl + (ch >> 2) * 2048 + key * 64 + (ch & 3) * 16) = vr[i]; }
        f32x16 z;
#pragma unroll
        for (int r = 0; r < 16; ++r) z[r] = 0.f;
#pragma unroll
        for (int d0 = 0; d0 < 4; ++d0) z = __builtin_amdgcn_mfma_f32_32x32x16_bf16(kf[d0], qf[d0], z, 0, 0, 0);
        asm volatile("" ::: "memory");
        { const int jn = (j0 >= 32) ? j0 - 32 : j0;
#pragma unroll
          for (int d0 = 0; d0 < 4; ++d0) kf[d0] = *(const bf16x8*)(kbase + (size_t)jn * PROJ_LD + 16 * d0);
#pragma unroll
          for (int i = 0; i < 4; ++i) vr[i] = *(const u32x4*)(vbase + (size_t)(jn + 8 * i) * PROJ_LD); }
        asm volatile("" ::: "memory");
        float e[16], Dl[16];
        const bool diag = (j0 == t0);
#pragma unroll
        for (int r = 0; r < 16; ++r) { float ev = __builtin_amdgcn_exp2f(fminf(z[r], 126.0f)); if (diag && (16 * hi + r >= c)) ev = 0.f; e[r] = ev; }
        float D = hi ? Dc : 1.0f;
#pragma unroll
        for (int r = 15; r >= 0; --r) { D = fmaf(D, e[r], D); Dl[r] = D; }
        const float other = __shfl_xor(D, 32);
        const float mult = hi ? 1.0f : other;
        Dc = D * other;
        unsigned pw[8];
#pragma unroll
        for (int r = 0; r < 16; r += 2) { const float a0 = e[r] * __builtin_amdgcn_rcpf(Dl[r] * mult), a1 = e[r + 1] * __builtin_amdgcn_rcpf(Dl[r + 1] * mult); pw[r >> 1] = pk2(a0, a1); }
#pragma unroll
        for (int ks = 0; ks < 2; ++ks) { const bf16x8 pa = __builtin_bit_cast(bf16x8, (u32x4){pw[4 * ks], pw[4 * ks + 1], pw[4 * ks + 2], pw[4 * ks + 3]});
            const unsigned char* vb = vl + (16 * hi + 8 * ks + ((lane & 15) >> 2)) * 64 + (16 * ((lane >> 4) & 1) + 4 * (lane & 3)) * 2;
            { const s16x4 lo = tr_read(vb), hh = tr_read(vb + 256); o0 = __builtin_amdgcn_mfma_f32_32x32x16_bf16(pa, (bf16x8){lo[0], lo[1], lo[2], lo[3], hh[0], hh[1], hh[2], hh[3]}, o0, 0, 0, 0); }
            { const s16x4 lo = tr_read(vb + 2048), hh = tr_read(vb + 2048 + 256); o1 = __builtin_amdgcn_mfma_f32_32x32x16_bf16(pa, (bf16x8){lo[0], lo[1], lo[2], lo[3], hh[0], hh[1], hh[2], hh[3]}, o1, 0, 0, 0); } }
        if (__all(!(Dc < 3.0e38f))) break;
    }
    bf16_t* ob = mix + (rowb + t0) * 1024 + 512 + h * 64 + c;
#pragma unroll
    for (int r = 0; r < 16; ++r) { const int q = crow(r, hi); ob[(size_t)q * 1024] = (bf16_t)f2bf(o0[r]); ob[(size_t)q * 1024 + 32] = (bf16_t)f2bf(o1[r]); }
}
__device__ __forceinline__ void memkv_task(int wtask, int lane, const bf16_t* __restrict__ memn, const bf16_t* __restrict__ wkv, bf16_t* __restrict__ kv) {
    const int tm = wtask >> 6, tn = wtask & 63; const int c = lane & 31, hi = lane >> 5;
    const bf16_t* ap = memn + (size_t)(tm * 32 + c) * DM + 8 * hi; const bf16_t* bp = wkv + (size_t)(tn * 32 + c) * DM + 8 * hi;
    f32x16 acc;
#pragma unroll
    for (int r = 0; r < 16; ++r) acc[r] = 0.f;
#pragma unroll 16
    for (int ks = 0; ks < 64; ++ks) { const bf16x8 a = *(const bf16x8*)(ap + 16 * ks), b = *(const bf16x8*)(bp + 16 * ks); acc = __builtin_amdgcn_mfma_f32_32x32x16_bf16(a, b, acc, 0, 0, 0); }
    bf16_t* o = kv + (size_t)(tm * 32) * 2048 + tn * 32 + c;
#pragma unroll
    for (int r = 0; r < 16; ++r) o[(size_t)crow(r, hi) * 2048] = (bf16_t)f2bf(acc[r]);
}
__device__ __forceinline__ void router_task(int wtask, int lane, const bf16_t* __restrict__ xn, const float* __restrict__ ss, const bf16_t* __restrict__ wr, const float* __restrict__ br,
                                            int (&oe)[4], float (&ow)[4]) {
    const int c = lane & 31, hi = lane >> 5; const int t = wtask * 32 + c;
    const bf16_t* ap = wr + (size_t)c * DM + 8 * hi; const bf16_t* bp = xn + (size_t)t * DM + 8 * hi;
    f32x16 acc;
#pragma unroll
    for (int r = 0; r < 16; ++r) acc[r] = 0.f;
#pragma unroll 16
    for (int ks = 0; ks < 64; ++ks) { const bf16x8 a = *(const bf16x8*)(ap + 16 * ks), b = *(const bf16x8*)(bp + 16 * ks); acc = __builtin_amdgcn_mfma_f32_32x32x16_bf16(a, b, acc, 0, 0, 0); }
    float v[16]; const float rstd = row_rstd(ss, t);
#pragma unroll
    for (int r = 0; r < 16; ++r) v[r] = acc[r] * rstd + br[crow(r, hi)];
    float tv[4]; int ti[4];
#pragma unroll
    for (int k = 0; k < 4; ++k) { float best = -INFINITY; int bi = 64;
#pragma unroll
        for (int r = 0; r < 16; ++r) { if (v[r] > best) { best = v[r]; bi = crow(r, hi); } }
        tv[k] = best; ti[k] = bi;
#pragma unroll
        for (int r = 0; r < 16; ++r) if (crow(r, hi) == bi) v[r] = -INFINITY; }
    float cv[8]; int ci[8];
#pragma unroll
    for (int k = 0; k < 4; ++k) { cv[k] = tv[k]; ci[k] = ti[k]; cv[4 + k] = __shfl_xor(tv[k], 32); ci[4 + k] = __shfl_xor(ti[k], 32); }
#pragma unroll
    for (int k = 0; k < 4; ++k) { float best = -INFINITY; int bi = 64;
#pragma unroll
        for (int q = 0; q < 8; ++q) { if (cv[q] > best || (cv[q] == best && ci[q] < bi)) { best = cv[q]; bi = ci[q]; } }
        tv[k] = best; ti[k] = bi;
#pragma unroll
        for (int q = 0; q < 8; ++q) if (ci[q] == bi) cv[q] = -INFINITY; }
    const float e1 = __expf(tv[1] - tv[0]), e2 = __expf(tv[2] - tv[0]), e3 = __expf(tv[3] - tv[0]); const float inv = 1.0f / (1.0f + e1 + e2 + e3);
    const float g[4] = {inv, e1 * inv, e2 * inv, e3 * inv};
#pragma unroll
    for (int k = 0; k < 4; ++k) { oe[k] = ti[k]; ow[k] = g[k]; }
}
__device__ __forceinline__ void combine_task(int t, int lane, const bf16_t* xin, float* xout, const unsigned char* __restrict__ ys, const int* tab, const int* __restrict__ toke, const int* __restrict__ tokr,
                                                 const float* __restrict__ tokw, const float* __restrict__ gfin) {
    const u32x2* xr = (const u32x2*)(xin + (size_t)t * DM) + lane; f32x4* xo = (f32x4*)(xout + (size_t)t * DM) + lane; f32x4 v[4];
#pragma unroll
    for (int j = 0; j < 4; ++j) { const u32x2 w = __builtin_nontemporal_load(xr + 64 * j); v[j] = (f32x4){bflo(w.x), bfhi(w.x), bflo(w.y), bfhi(w.y)}; }
    for (int k = 0; k < 4; ++k) { const int e = toke[t * 4 + k], r = tokr[t * 4 + k]; const float w = tokw[t * 4 + k]; const int start = tab[32 + e];
        const unsigned* yr = (const unsigned*)(ys + (size_t)(start + r) * DM) + lane;
#pragma unroll
        for (int j = 0; j < 4; ++j) { const int y = (int)__builtin_nontemporal_load(yr + 64 * j); const f32x2 lo = __builtin_amdgcn_cvt_pk_f32_fp8(y, false), hi = __builtin_amdgcn_cvt_pk_f32_fp8(y, true);
            v[j].x += w * lo.x; v[j].y += w * lo.y; v[j].z += w * hi.x; v[j].w += w * hi.y; } }
    float s = 0.f;
#pragma unroll
    for (int j = 0; j < 4; ++j) s += v[j].x * v[j].x + v[j].y * v[j].y + v[j].z * v[j].z + v[j].w * v[j].w;
    const float rstd = 1.0f / sqrtf(wave_sum(s) * (1.f / DM) + EPS);
#pragma unroll
    for (int j = 0; j < 4; ++j) { const f32x4 g = *((const f32x4*)gfin + lane + 64 * j); __builtin_nontemporal_store(v[j] * rstd * g, xo + 64 * j); }
}

#define GAS __attribute__((address_space(1)))
#define RLX_AGENT __ATOMIC_RELAXED, __HIP_MEMORY_SCOPE_AGENT
#define XB_TMO      128
#define XB_XCNT(j)  (256  + 64 * (j))
#define XB_XSUB(j)  (1280 + 64 * (j))
#define XB_XGEN(j)  (2304 + 64 * (j))
#define XB_TOP      3328
#define XB_TOPGEN   3392
#define XCD_BAR_WORDS 3456
#define XB_SPIN_CAP (1u << 18)
__device__ __forceinline__ unsigned xb_ld(unsigned* p)              { return __hip_atomic_load(p, __ATOMIC_RELAXED, __HIP_MEMORY_SCOPE_AGENT); }
__device__ __forceinline__ unsigned xb_add(unsigned* p, unsigned v) { return __hip_atomic_fetch_add(p, v, __ATOMIC_RELAXED, __HIP_MEMORY_SCOPE_AGENT); }
__device__ __forceinline__ unsigned xb_xcc_id() { return (unsigned)__builtin_amdgcn_s_getreg((3 << 11) | 20) & 0xFu; }
#define XB_SPIN(cond, bar) do { unsigned _sp = 0; while (cond) { __builtin_amdgcn_s_sleep(1); \
    if ((++_sp & 255u) == 0u) { if (xb_ld(&(bar)[XB_TMO])) break; if (_sp > XB_SPIN_CAP) { atomicAdd(&(bar)[XB_TMO], 1u); break; } } } } while (0)
struct XcdBarrier { unsigned* bar; unsigned x; volatile LDSP unsigned* st; };
__device__ __forceinline__ XcdBarrier xcd_barrier_post(unsigned* bar, volatile LDSP unsigned* st) {
    XcdBarrier b; b.bar = bar; b.x = xb_xcc_id(); b.st = st;
    if (threadIdx.x == 0) (void)xb_add(&bar[XB_XCNT(b.x)], 1u);
    return b;
}
__device__ __forceinline__ void xcd_barrier_complete(unsigned* bar, unsigned x, unsigned& nloc, unsigned& nx) {
    const unsigned G = gridDim.x * gridDim.y * gridDim.z;
    unsigned sum, cnt, mine, sp = 0u;
    for (;;) {
        sum = 0u; cnt = 0u; mine = 0u;
#pragma unroll
        for (unsigned j = 0; j < 16; ++j) { const unsigned c = xb_ld(&bar[XB_XCNT(j)]); sum += c; cnt += (c > 0u) ? 1u : 0u; mine = (j == x) ? c : mine; }
        if (sum == G) break;
        __builtin_amdgcn_s_sleep(1);
        if ((++sp & 255u) == 0u) { if (xb_ld(&bar[XB_TMO])) break; if (sp > XB_SPIN_CAP) { atomicAdd(&bar[XB_TMO], 1u); break; } }
    }
    nloc = mine > 0u ? mine : 1u; nx = cnt > 0u ? cnt : 1u;
}
__device__ __forceinline__ void xcd_barrier(const XcdBarrier& b) {
    asm volatile("s_waitcnt vmcnt(0)" ::: "memory");
    __syncthreads();
    if (threadIdx.x == 0) {
        unsigned* bar = b.bar;
        __builtin_amdgcn_s_waitcnt(0);
        unsigned nloc = b.st[0], nx = b.st[1];
        if (nloc == 0u) { xcd_barrier_complete(bar, b.x, nloc, nx); b.st[0] = nloc; b.st[1] = nx; }
        const unsigned old = xb_add(&bar[XB_XSUB(b.x)], 1u);
        const unsigned gen = old / nloc;
        if (old + 1u == (gen + 1u) * nloc) {
            __builtin_amdgcn_fence(__ATOMIC_RELEASE, "agent");
            asm volatile("s_waitcnt vmcnt(0)" ::: "memory");
            const unsigned og = xb_add(&bar[XB_TOP], 1u);
            const unsigned tg = og / nx;
            if (og + 1u == (tg + 1u) * nx) xb_add(&bar[XB_TOPGEN], 1u);
            else XB_SPIN(xb_ld(&bar[XB_TOPGEN]) == tg, bar);
            __builtin_amdgcn_fence(__ATOMIC_ACQUIRE, "agent");
            xb_add(&bar[XB_XGEN(b.x)], 1u);
            asm volatile("s_waitcnt vmcnt(0)" ::: "memory");
        } else {
            XB_SPIN(xb_ld(&bar[XB_XGEN(b.x)]) == gen, bar);
            __builtin_amdgcn_fence(__ATOMIC_ACQUIRE, "agent");
            asm volatile("s_waitcnt vmcnt(0)" ::: "memory");
        }
    }
    __syncthreads();
}

constexpr int LDS_BYTES = 147456;
constexpr int MISC_OFF = LDS_BYTES - 512;
constexpr int CW_BAR = 4096;
constexpr size_t CTL_ZERO_BYTES = 65536;
constexpr int NPHASE = 12;
struct Args { const float* in[22]; float* out; unsigned char* ws; int ph_lo, ph_hi; };

__global__ void __launch_bounds__(512, 2) mega(Args a) {
    extern __shared__ __attribute__((aligned(16))) unsigned char lds[];
    unsigned char* ws = a.ws; float* out = a.out;
    const float* x = a.in[0]; const float* mem = a.in[1]; const float* g_mix = a.in[2]; const float* w_in = a.in[3];
    const float* w_gla_gate = a.in[4]; const float* b_gla_gate = a.in[5]; const float* g_gla_head = a.in[6]; const float* w_out = a.in[7];
    const float* g_mem_q = a.in[8]; const float* g_mem_kv = a.in[9]; const float* w_mq = a.in[10]; const float* w_mk = a.in[11];
    const float* w_mv = a.in[12]; const float* w_mo = a.in[13]; const float* g_ffn = a.in[14]; const float* w_router = a.in[15];
    const float* b_router = a.in[16]; const float* w_gu = a.in[17]; const float* b_gu = a.in[18]; const float* w_down = a.in[19];
    const float* b_down = a.in[20]; const float* g_final = a.in[21];
    bf16_t* Wt_in = (bf16_t*)(ws + WS_WIN); bf16_t* Wt_out = (bf16_t*)(ws + WS_WOUT); bf16_t* Wq = (bf16_t*)(ws + WS_WQ); bf16_t* Wt_kv = (bf16_t*)(ws + WS_WKV);
    bf16_t* Wt_mo = (bf16_t*)(ws + WS_WMO); bf16_t* Wt_r = (bf16_t*)(ws + WS_WR); bf16_t* Wt_gu = (bf16_t*)(ws + WS_WGU); bf16_t* Wt_dn = (bf16_t*)(ws + WS_WDN);
    bf16_t* xn = (bf16_t*)(ws + WS_XN); bf16_t* memn = (bf16_t*)(ws + WS_MEMN); bf16_t* kv = (bf16_t*)(ws + WS_KV); bf16_t* Bs = (bf16_t*)(ws + WS_BS); bf16_t* Bo = (bf16_t*)(ws + WS_BO);
    bf16_t* proj = (bf16_t*)(ws + WS_PROJ); bf16_t* mix = (bf16_t*)(ws + WS_MIX);
    float* Sc = (float*)(ws + WS_S); bf16_t* P = (bf16_t*)(ws + WS_P); float* lg = (float*)(ws + WS_LG); int* toke = (int*)(ws + WS_TOKE); int* tokr = (int*)(ws + WS_TOKR);
    float* tokw = (float*)(ws + WS_TOKW); int* list = (int*)(ws + WS_LIST); unsigned char* ys = ws + WS_YS;
    unsigned char* Wq_gu = ws + WS_WGU; unsigned char* Wq_dn = ws + WS_WDN; unsigned char* x2q = ws + WS_S; unsigned char* act8 = ws + WS_ACT;
    float* lrs = (float*)(ws + WS_LG);
    float* UT = (float*)(ws + WS_S); float* decay = (float*)(ws + WS_LA); bf16_t* ST = (bf16_t*)(ws + WS_ORAW);
    unsigned* ctl = (unsigned*)(ws + WS_CTL); int* cnt = (int*)ctl + CW_CNT; float* ss1 = (float*)(ws + WS_LA + 8 * MiB); float* ss2 = (float*)(ws + WS_LA + 9 * MiB);

    const int G = gridDim.x, vb = blockIdx.x;
    volatile LDSP unsigned* MISC = (volatile LDSP unsigned*)(unsigned)(uintptr_t)(lds + MISC_OFF);
    if (threadIdx.x < 128) MISC[threadIdx.x] = 0u;
    __syncthreads();
    XcdBarrier bar = xcd_barrier_post(ctl + CW_BAR, MISC + 8);
    const int lo = a.ph_lo, hi = a.ph_hi;
    float* dmy = (float*)(ws + WS_DUMMY); (void)dmy;
#ifndef REPEAT_MASK
#define REPEAT_MASK 0
#endif
#define IN(k) (lo <= (k) && (k) < hi)
#define REP(k) for (int rep_ = 0; rep_ < 1 + ((REPEAT_MASK >> (k)) & 1); ++rep_)
#define SEAM(k) do { if (IN(k) && IN((k) + 1)) xcd_barrier(bar); } while (0)
#define TIDS() int tid = threadIdx.x; LAUNDER(tid); const int lane = tid & 63; const int wid = __builtin_amdgcn_readfirstlane(tid >> 6); (void)lane; (void)wid

    if (IN(0)) REP(0) { TIDS(); const size_t gt = (size_t)vb * 512 + tid, gs = (size_t)G * 512;
        float* scr = (float*)(lds + wid * 8448);
        const int gw = vb * 8 + wid, ngw = G * 8;
        rms_body(gw, ngw, lane, x, xn, NTOK);
        rms_body(gw, ngw, lane, mem, memn, NB * MEML);
        conv_n_body(gt, gs, w_mq, Wq, g_mem_q, 1024, 1024, LOG2E / 16.0f);
        constexpr int I_IN = 16 * 97, I_SQ = 16 * 32, I_R = 16, I_GU = 32 * 16 * 64, I_DN = 32 * 16 * 32;
        constexpr int NITEMS = I_IN + 4 * I_SQ + I_R + I_GU + I_DN;
        for (int it = gw; it < NITEMS; it += ngw) { int r = it;
            if (r < I_IN) { conv_item<1>(scr, w_in, Wt_in, g_mix, 3088, 1024, 3088, r / 97, r % 97, lane); continue; } r -= I_IN;
            if (r < I_SQ) { conv_item<0>(scr, w_out, Wt_out, nullptr, 1024, 1024, 1024, r >> 5, r & 31, lane); continue; } r -= I_SQ;
            if (r < I_SQ) { conv_item<0>(scr, w_mk, Wt_kv, g_mem_kv, 1024, 1024, 1024, r >> 5, r & 31, lane); continue; } r -= I_SQ;
            if (r < I_SQ) { conv_item<0>(scr, w_mv, Wt_kv + (size_t)1024 * 1024, g_mem_kv, 1024, 1024, 1024, r >> 5, r & 31, lane); continue; } r -= I_SQ;
            if (r < I_SQ) { conv_item<0>(scr, w_mo, Wt_mo, nullptr, 1024, 1024, 1024, r >> 5, r & 31, lane); continue; } r -= I_SQ;
            if (r < I_R) { conv_item<0>(scr, w_router, Wt_r, g_ffn, 32, 1024, 32, r, 0, lane); continue; } r -= I_R;
            if (r < I_GU) { const int e = r >> 10, q = r & 1023; conv_item8<2>(scr, w_gu + (size_t)e * 1024 * 2048, Wq_gu + (size_t)e * 2048 * 1024, g_ffn, 2048, 1024, 2048, q >> 6, q & 63, lane, (float)(1 << WSCALE_LOG2)); continue; } r -= I_GU;
            { const int e = r >> 9, q = r & 511; conv_item8<0>(scr, w_down + (size_t)e * 1024 * 1024, Wq_dn + (size_t)e * 1024 * 1024, nullptr, 1024, 1024, 1024, q >> 5, q & 31, lane, (float)(1 << WSCALE_LOG2)); } }
        __syncthreads(); }
    SEAM(0);
    if (IN(1)) REP(1) { DenseSched S{(const char*)xn, (const char*)Wt_in, 2048u, 2048u, 1024, 64, 12, 1 << 30, 0, G, vb}; EpiBf16 E{proj, PROJ_LD, 0}; gemm_run<true>(lds, S, E); }
    SEAM(1);
    if (IN(2)) REP(2) {
        for (int t = vb; t < 256; t += G) gla_pass_a(lds, t, xn, Wt_in + (size_t)3072 * 1024, proj, w_gla_gate, b_gla_gate, UT, decay);
        { TIDS(); for (int t = vb * 8 + wid; t < 4096; t += G * 8) sb_task(lds + wid * 4096, t, proj, mix, lane); }
        { TIDS(); for (int t = vb + G * wid; t < 1024; t += G * 8) memkv_task(t, lane, memn, Wt_kv, kv); } }
    SEAM(2);
    if (IN(3)) REP(3) {
        { TIDS(); for (int e = vb * 512 + tid; e < 65536; e += G * 512) gla_pass_b(e, UT, decay, ST); }
        { SchedWqk S{(const char*)kv, (const char*)Wq, 4096u, 2048u, 256, G / 2, vb - G / 2, 0}; EpiBf16 E{Bs, 1024, 0}; gemm_run<false>(lds, S, E); }
        { SchedVo S{(const char*)Wt_mo, (const char*)kv, 2048u, 4096u, 256, G / 2, vb - G / 2 - 32, 0}; EpiBf16 E{Bo, 1024, 0}; gemm_run<false>(lds, S, E); } }
    SEAM(3);
    if (IN(4)) REP(4) { TIDS(); for (int t = vb * 8 + wid; t < 2048; t += G * 8) gla_pass_c(lds + wid * 32 * GC_PITCH, t, ST, proj, g_gla_head, mix, lane); }
    SEAM(4);
#if PROBE_BARRIERS
    for (int pb_ = 0; pb_ < 8; ++pb_) xcd_barrier(bar);
#endif
    if (IN(5)) REP(5) { DenseSched S{(const char*)mix, (const char*)Wt_out, 2048u, 2048u, 1024, 64, 4, 1 << 30, 0, G, vb}; EpiResidSS<false> E{x, rep_ ? (bf16_t*)dmy : xn, rep_ ? dmy + 16 * 1024 * 1024 : ss1, nullptr}; gemm_run<false>(lds, S, E); }
    SEAM(5);
    if (IN(6)) REP(6) { DenseSched S{(const char*)xn, (const char*)Bs, 2048u, 2048u, 1024, 64, 4, 32, (size_t)1024 * 2048, G, vb}; EpiSoftmax E{ss1, P}; gemm_run<false>(lds, S, E); }
    SEAM(6);
    if (IN(7)) REP(7) { DenseSched S{(const char*)P, (const char*)Bo, 2048u, 2048u, 1024, 64, 4, 32, (size_t)1024 * 2048, G, vb}; EpiResidSS<true> E{xn, rep_ ? (bf16_t*)dmy : xn, rep_ ? dmy + 16 * 1024 * 1024 : ss2, rep_ ? (unsigned char*)dmy + 40 * 1024 * 1024 : x2q}; gemm_run<false>(lds, S, E); }
    SEAM(7);
    if (IN(8)) REP(8) { TIDS(); int* cntp = rep_ ? (int*)ctl + 2048 : cnt; int* listp = rep_ ? (int*)dmy + 1024 : list; float* lrsp = rep_ ? dmy + 4096 * 1024 : lrs; int* tokep = rep_ ? (int*)dmy + 1024 * 1024 : toke; int* tokrp = rep_ ? (int*)dmy + 2048 * 1024 : tokr; float* tokwp = rep_ ? dmy + 3072 * 1024 : tokw;
        int* lcnt = (int*)lds; int* gbase = (int*)lds + 32;
        for (int tb = vb; tb < NTOK / 64; tb += G) {
            if (tid < 32) lcnt[tid] = 0;
            __syncthreads();
            int oe[4] = {0, 0, 0, 0}; float ow[4] = {0.f, 0.f, 0.f, 0.f}; int lr[4] = {0, 0, 0, 0};
            if (wid < 2) { router_task(tb * 2 + wid, lane, xn, ss2, Wt_r, b_router, oe, ow);
                if (lane < 32) {
#pragma unroll
                    for (int k = 0; k < 4; ++k) lr[k] = atomicAdd(&lcnt[oe[k]], 1); } }
            __syncthreads();
            if (tid < 32) gbase[tid] = atomicAdd(&cntp[tid * 32], lcnt[tid]);
            __syncthreads();
            if (wid < 2 && lane < 32) { const int t = (tb * 2 + wid) * 32 + lane;
                const float rstd_t = row_rstd(ss2, t);
#pragma unroll
                for (int k = 0; k < 4; ++k) { const int r = gbase[oe[k]] + lr[k]; listp[oe[k] * NTOK + r] = t; lrsp[oe[k] * NTOK + r] = rstd_t; tokep[t * 4 + k] = oe[k]; tokrp[t * 4 + k] = r; tokwp[t * 4 + k] = ow[k]; } }
            __syncthreads(); } }
    SEAM(8);
    if (IN(9)) REP(9) { int* tab = (int*)(lds + 131072); { TIDS(); moe_build_table(tab, cnt, tid); }
        MoeSched<true> S{(const char*)x2q, (const char*)Wq_gu, 1024u, 1024u, 512, 8, (size_t)2048 * 1024, tab, list, 1, G, vb, 0}; EpiGU E{b_gu, act8, lrs}; gemm_run_fp8<true>(lds, S, E); }
    SEAM(9);
    if (IN(10)) REP(10) { int* tab = (int*)(lds + 131072); { TIDS(); moe_build_table(tab, cnt, tid); }
        MoeSched<false> S{(const char*)act8, (const char*)Wq_dn, 1024u, 1024u, 512, 4, (size_t)1024 * 1024, tab, list, 0, G, vb, 0}; EpiDown E{b_down, ys}; gemm_run_fp8<true>(lds, S, E); }
    SEAM(10);
    if (IN(11)) REP(11) { TIDS(); int* tab = (int*)(lds + 131072); moe_build_table(tab, cnt, tid);
        for (int t = vb * 8 + wid; t < NTOK; t += G * 8) combine_task(t, lane, xn, rep_ ? dmy : out, ys, tab, toke, tokr, tokw, g_final); }
#undef IN
#undef SEAM
#undef TIDS
}

#ifndef MK_PER_PHASE
#define MK_PER_PHASE 0
#endif
extern "C" void kernel_launch(void* const* d_in, const int* in_sizes, int n_in, void* d_out, int out_size, void* d_ws, size_t ws_size, hipStream_t stream) {
    static int grid = 0;
    if (grid == 0) {
        if (n_in != 22 || in_sizes[0] != NTOK * DM || out_size != NTOK * DM || ws_size < WS_END) { fprintf(stderr, "kernel_launch: unexpected shapes (n_in %d, ws %zu)\n", n_in, ws_size); grid = -1; return; }
        int dev = 0, cus = 0, per_cu = 0;
        if (hipGetDevice(&dev) != hipSuccess || hipDeviceGetAttribute(&cus, hipDeviceAttributeMultiprocessorCount, dev) != hipSuccess) { grid = -1; return; }
        if (hipFuncSetAttribute((const void*)mega, hipFuncAttributeMaxDynamicSharedMemorySize, LDS_BYTES) != hipSuccess) { fprintf(stderr, "kernel_launch: hipFuncSetAttribute failed\n"); grid = -1; return; }
        if (hipOccupancyMaxActiveBlocksPerMultiprocessor(&per_cu, (const void*)mega, 512, LDS_BYTES) != hipSuccess || per_cu < 1) fprintf(stderr, "kernel_launch: occupancy query says %d blocks/CU\n", per_cu);
        (void)hipGetLastError();
        grid = cus;
    }
    if (grid < 0) return;
    (void)hipMemsetAsync((char*)d_ws + WS_CTL, 0, CTL_ZERO_BYTES, stream);
    Args a{};
    for (int i = 0; i < 22; ++i) a.in[i] = (const float*)d_in[i];
    a.out = (float*)d_out; a.ws = (unsigned char*)d_ws;
#if MK_PER_PHASE
    for (int p = 0; p < NPHASE; ++p) { a.ph_lo = p; a.ph_hi = p + 1; hipLaunchKernelGGL(mega, dim3(grid), dim3(512), LDS_BYTES, stream, a); }
#else
    a.ph_lo = 0; a.ph_hi = NPHASE; hipLaunchKernelGGL(mega, dim3(grid), dim3(512), LDS_BYTES, stream, a);
#endif
}
```

```cpp
#include <hip/hip_runtime.h>
#include <cstdio>
#include <cstdint>
#ifndef PROBE_BARRIERS
#define PROBE_BARRIERS 0
#endif

typedef unsigned short bf16_t;
typedef short bf16x8 __attribute__((ext_vector_type(8)));
typedef float f32x4 __attribute__((ext_vector_type(4)));
typedef unsigned u32x4 __attribute__((ext_vector_type(4)));
typedef unsigned u32x2 __attribute__((ext_vector_type(2)));
typedef float f32x2 __attribute__((ext_vector_type(2)));
#define LDSP __attribute__((address_space(3)))
#define LAUNDER(x) asm volatile("" : "+v"(x))

constexpr int NB = 2, SEQ = 8192, NTOK = NB * SEQ, DM = 1024, MEML = 256;
constexpr int NEXP = 32, TOPK = 4, NASSIGN = NTOK * TOPK;
constexpr int PROJ_LD = 3072;
constexpr int C_QG = 0, C_KG = 256, C_VG = 512, C_RG = 1024, C_QS = 1536, C_KS = 2048, C_VS = 2560, C_GLR = 3072;
constexpr float LOG2E = 1.4426950408889634f;
constexpr float EPS = 1e-5f;

__device__ __forceinline__ unsigned f2bf(float f) { unsigned u = __float_as_uint(f); return (u + 0x7fffu + ((u >> 16) & 1u)) >> 16; }
__device__ __forceinline__ unsigned pk2(float lo, float hi) { return f2bf(lo) | (f2bf(hi) << 16); }
__device__ __forceinline__ float bf2f(bf16_t h) { return __uint_as_float(((unsigned)h) << 16); }
__device__ __forceinline__ float bflo(unsigned w) { return __uint_as_float(w << 16); }
__device__ __forceinline__ float bfhi(unsigned w) { return __uint_as_float(w & 0xffff0000u); }

constexpr size_t MiB = 1u << 20;
constexpr size_t WS_CTL = 0;
constexpr size_t WS_WIN = 1 * MiB;
constexpr size_t WS_WOUT = 8 * MiB;
constexpr size_t WS_WQ = 10 * MiB;
constexpr size_t WS_WKV = 12 * MiB;
constexpr size_t WS_WMO = 16 * MiB;
constexpr size_t WS_WR = 18 * MiB;
constexpr size_t WS_WGU = 20 * MiB;
constexpr size_t WS_WDN = 148 * MiB;
constexpr size_t WS_XN = 212 * MiB;
constexpr size_t WS_MEMN = 244 * MiB;
constexpr size_t WS_KV = 245 * MiB;
constexpr size_t WS_BS = 247 * MiB;
constexpr size_t WS_BO = 251 * MiB;
constexpr size_t WS_PROJ = 256 * MiB;
constexpr size_t WS_LA = 360 * MiB;
constexpr size_t WS_ORAW = 376 * MiB;
constexpr size_t WS_MIX = 408 * MiB;
constexpr size_t WS_S = 440 * MiB;
constexpr size_t WS_P = 504 * MiB;
constexpr size_t WS_LG = 536 * MiB;
constexpr size_t WS_TOKE = 538 * MiB;
constexpr size_t WS_TOKR = 539 * MiB;
constexpr size_t WS_TOKW = 540 * MiB;
constexpr size_t WS_LIST = 541 * MiB;
constexpr size_t WS_ACT = 544 * MiB;
constexpr size_t WS_YS = 674 * MiB;
constexpr size_t WS_DUMMY = 804 * MiB;
constexpr size_t WS_END = 872 * MiB;
constexpr int CW_CNT = 1024;

template <int MAP> __device__ __forceinline__ int srccol(int n, float& sc) {
    sc = 1.f;
    if (MAP == 0) return n;
    if (MAP == 1) {
        if (n < 256) { sc = 0.125f; return n; }
        if (n < 1024) return n;
        if (n < 3072) { if (n >= C_QS && n < C_KS) sc = 0.125f * LOG2E; return n + 16; }
        if (n < 3088) return 1024 + (n - 3072);
        return -1;
    }
    { const int ct = n >> 8, w = n & 255; return (w < 128) ? (128 * ct + w) : (1024 + 128 * ct + (w - 128)); }
}
template <int MAP>
__device__ __forceinline__ void conv_item(float* scr, const float* __restrict__ src, bf16_t* __restrict__ dst, const float* __restrict__ gain, int ldsrc, int K, int nrows, int kb, int nb, int lane) {
    const int k0 = kb * 64, n0 = nb * 32; float sc; const int c0 = srccol<MAP>(n0, sc);
    const int half = lane >> 5, l31 = lane & 31;
    const float* s0 = src + (size_t)(k0 + half) * ldsrc + c0 + l31;
    float v[32];
#pragma unroll
    for (int i = 0; i < 32; ++i) v[i] = __builtin_nontemporal_load(s0 + (size_t)(2 * i) * ldsrc);
#pragma unroll
    for (int i = 0; i < 32; ++i) { const int kk = 2 * i + half; const float g = (gain ? gain[k0 + kk] : 1.f) * sc; scr[kk * 33 + l31] = v[i] * g; }
    asm volatile("s_waitcnt lgkmcnt(0)" ::: "memory");
    const int c = lane & 7;
#pragma unroll
    for (int j = 0; j < 4; ++j) { const int n = (lane >> 3) + 8 * j; const float* s = scr + (8 * c) * 33 + n;
        u32x4 o; o.x = pk2(s[0 * 33], s[1 * 33]); o.y = pk2(s[2 * 33], s[3 * 33]); o.z = pk2(s[4 * 33], s[5 * 33]); o.w = pk2(s[6 * 33], s[7 * 33]);
        if (n0 + n < nrows) *(u32x4*)(dst + (size_t)(n0 + n) * K + k0 + 8 * c) = o; }
    asm volatile("s_waitcnt lgkmcnt(0)" ::: "memory");
}
__device__ __forceinline__ unsigned pk4_fp8(float a, float b, float c, float d) { int w = __builtin_amdgcn_cvt_pk_fp8_f32(a, b, 0, false); w = __builtin_amdgcn_cvt_pk_fp8_f32(c, d, w, true); return (unsigned)w; }
template <int MAP>
__device__ __forceinline__ void conv_item8(float* scr, const float* __restrict__ src, unsigned char* __restrict__ dst, const float* __restrict__ gain, int ldsrc, int K, int nrows, int kb, int nb, int lane, float mul) {
    const int k0 = kb * 64, n0 = nb * 32; float sc; const int c0 = srccol<MAP>(n0, sc); sc *= mul;
    const int half = lane >> 5, l31 = lane & 31;
    const float* s0 = src + (size_t)(k0 + half) * ldsrc + c0 + l31;
    float v[32];
#pragma unroll
    for (int i = 0; i < 32; ++i) v[i] = __builtin_nontemporal_load(s0 + (size_t)(2 * i) * ldsrc);
#pragma unroll
    for (int i = 0; i < 32; ++i) { const int kk = 2 * i + half; const float g = (gain ? gain[k0 + kk] : 1.f) * sc; scr[kk * 33 + l31] = v[i] * g; }
    asm volatile("s_waitcnt lgkmcnt(0)" ::: "memory");
    const int c = lane & 3;
#pragma unroll
    for (int j = 0; j < 2; ++j) { const int n = (lane >> 2) + 16 * j; const float* s = scr + (16 * c) * 33 + n;
        u32x4 o; o.x = pk4_fp8(s[0 * 33], s[1 * 33], s[2 * 33], s[3 * 33]); o.y = pk4_fp8(s[4 * 33], s[5 * 33], s[6 * 33], s[7 * 33]);
        o.z = pk4_fp8(s[8 * 33], s[9 * 33], s[10 * 33], s[11 * 33]); o.w = pk4_fp8(s[12 * 33], s[13 * 33], s[14 * 33], s[15 * 33]);
        if (n0 + n < nrows) __builtin_nontemporal_store(o, (u32x4*)(dst + (size_t)(n0 + n) * K + k0 + 16 * c)); }
    asm volatile("s_waitcnt lgkmcnt(0)" ::: "memory");
}
__device__ __forceinline__ void conv_n_body(size_t gtid, size_t gsz, const float* __restrict__ src, bf16_t* __restrict__ dst, const float* __restrict__ gain, int K, int nrows, float sc) {
    const int kc8 = K / 8; const size_t total = (size_t)nrows * kc8;
    for (size_t idx = gtid; idx < total; idx += gsz) {
        const int kc = (int)(idx % kc8), n = (int)(idx / kc8);
        const float g = gain[n] * sc; const f32x4 a = __builtin_nontemporal_load((const f32x4*)(src + (size_t)n * K + kc * 8)), b = __builtin_nontemporal_load((const f32x4*)(src + (size_t)n * K + kc * 8 + 4));
        u32x4 o; o.x = pk2(a.x * g, a.y * g); o.y = pk2(a.z * g, a.w * g); o.z = pk2(b.x * g, b.y * g); o.w = pk2(b.z * g, b.w * g);
        *(u32x4*)(dst + (size_t)n * K + kc * 8) = o;
    }
}

__device__ __forceinline__ float wave_sum(float v) {
#pragma unroll
    for (int o = 1; o < 64; o <<= 1) v += __shfl_xor(v, o);
    return v;
}
__device__ __forceinline__ void rms_body(int gw, int ngw, int lane, const float* __restrict__ x, bf16_t* __restrict__ out, int nrows) {
    for (int row = gw; row < nrows; row += ngw) {
        const f32x4* xr = (const f32x4*)(x + (size_t)row * DM) + lane; f32x4 v[4]; float s = 0.f;
#pragma unroll
        for (int j = 0; j < 4; ++j) { v[j] = __builtin_nontemporal_load(xr + 64 * j); s += v[j].x * v[j].x + v[j].y * v[j].y + v[j].z * v[j].z + v[j].w * v[j].w; }
        const float rstd = 1.0f / sqrtf(wave_sum(s) * (1.f / DM) + EPS);
        u32x2* o = (u32x2*)(out + (size_t)row * DM) + lane;
#pragma unroll
        for (int j = 0; j < 4; ++j) { u32x2 w; w.x = pk2(v[j].x * rstd, v[j].y * rstd); w.y = pk2(v[j].z * rstd, v[j].w * rstd); o[64 * j] = w; }
    }
}

struct GUnit { unsigned ao, bo; int row0, col0, e, valid, aux; };

__host__ __device__ __forceinline__ int lds_byte(int r, int c) { const int st = (r >> 4) * 2 + (c >> 5), rr = r & 15, cc = c & 31, ob = rr * 64 + cc * 2; return st * 1024 + (ob ^ (((ob >> 9) & 1) << 5)); }
__host__ __device__ __forceinline__ void stage_rc(int b, int& R, int& C) { const int st = b / 1024, sb = b % 1024, swz = sb ^ (((sb >> 9) & 1) << 5); R = (st >> 1) * 16 + swz / 64; C = (st & 1) * 32 + (swz % 64) / 2; }
__host__ __device__ __forceinline__ int perm32(int rho) { const int n = rho >> 4, i = rho & 15; return 8 * (i >> 2) + 4 * n + (i & 3); }
constexpr int HTB = 128 * 64 * 2;
typedef int v8i __attribute__((ext_vector_type(8)));
typedef int v4i __attribute__((ext_vector_type(4)));
struct Frag2 { bf16x8 h[2]; };
template <bool F> struct FragT { typedef Frag2 T; };
template <> struct FragT<true> { typedef v8i T; };
template <class Sched, class Epi, bool ALIGN_EPI, bool FP8 = false, int SCALE_B = 0x7f>
__device__ __forceinline__ void gemm_phase(unsigned char* lds_flat, const Sched& S, const Epi& E) {
    LDSP unsigned char* lds = (LDSP unsigned char*)(unsigned)(uintptr_t)lds_flat;
    int tid = threadIdx.x; LAUNDER(tid);
    const int wid = __builtin_amdgcn_readfirstlane(tid >> 6), lane = tid & 63, wr = wid >> 2, wc = wid & 3, fr = lane & 15, fq = lane >> 4;
    const int nt = S.K / 64;
    int Rr[2], Cc[2];
#pragma unroll
    for (int i = 0; i < 2; ++i) stage_rc(tid * 16 + i * 8192, Rr[i], Cc[i]);
    unsigned voffB[2][2];
#pragma unroll
    for (int h = 0; h < 2; ++h)
#pragma unroll
        for (int i = 0; i < 2; ++i) voffB[h][i] = (unsigned)(128 * h + (Rr[i] & ~31) + perm32(Rr[i] & 31)) * S.ldb + (unsigned)Cc[i] * 2u;
    const unsigned ldsw = (unsigned)wid * 1024u;
    const int aoff = lds_byte(wr * 64 + fr, fq * 8), boff = lds_byte(wc * 32 + fr, fq * 8);
    constexpr int KSUB = 1024;
#define PG8_SA(b, h) (((b) * 2 + (h)) * HTB)
#define PG8_SB(b, h) ((4 + (b) * 2 + (h)) * HTB)
#define PG8_STAGE(bufoff, rsrc, voff, soff) do { _Pragma("unroll") for (int _i = 0; _i < 2; ++_i) \
        __builtin_amdgcn_raw_ptr_buffer_load_lds(rsrc, (LDSP unsigned*)(lds + (bufoff) + ldsw + _i * 8192), 16, (int)(voff)[_i], (int)(soff), 0, 0); } while (0)
#define PG8_LDF(dst, addr) do { const bf16x8 lo_ = *(const LDSP bf16x8*)(addr); const bf16x8 hi_ = *(const LDSP bf16x8*)((addr) + KSUB); \
        if constexpr (FP8) dst = __builtin_shufflevector(__builtin_bit_cast(v4i, lo_), __builtin_bit_cast(v4i, hi_), 0, 1, 2, 3, 4, 5, 6, 7); else { dst.h[0] = lo_; dst.h[1] = hi_; } } while (0)
#define PG8_LDA(dst, b, h) do { _Pragma("unroll") for (int m = 0; m < 4; ++m) PG8_LDF(dst[m], lds + PG8_SA(b, h) + aoff + m * 2048); } while (0)
#define PG8_LDB(dst, b, h) do { _Pragma("unroll") for (int n = 0; n < 2; ++n) PG8_LDF(dst[n], lds + PG8_SB(b, h) + boff + n * 2048); } while (0)
#define PG8_MMA(ai, bj, At, Bt) do { __builtin_amdgcn_s_setprio(1); _Pragma("unroll") for (int m = 0; m < 4; ++m) _Pragma("unroll") for (int n = 0; n < 2; ++n) { \
        if constexpr (FP8) asm volatile("v_mfma_scale_f32_16x16x128_f8f6f4 %0, %1, %2, %0, %3, %4 op_sel_hi:[0,0,0]" : "+v"(acc[ai][bj][m][n]) : "v"(Bt[n]), "v"(At[m]), "v"(sclB), "v"(sclA)); \
        else { _Pragma("unroll") for (int k = 0; k < 2; ++k) acc[ai][bj][m][n] = __builtin_amdgcn_mfma_f32_16x16x32_bf16(Bt[n].h[k], At[m].h[k], acc[ai][bj][m][n], 0, 0, 0); } } \
        __builtin_amdgcn_s_setprio(0); } while (0)
#define PG8_WAIT_V(n) asm volatile("s_waitcnt vmcnt(" #n ")" ::: "memory")
#define PG8_WAIT_L(n) asm volatile("s_waitcnt lgkmcnt(" #n ")" ::: "memory")
#define PG8_BAR __builtin_amdgcn_s_barrier()
#define PG8_SCHED __builtin_amdgcn_sched_barrier(0)
    GUnit cur, nxt; int ui = 0;
    if (!S.next(0, cur)) return;
    const __amdgpu_buffer_rsrc_t rA = __builtin_amdgcn_make_buffer_rsrc((void*)S.A, 0, 0x7fffffff, 0x00020000);
    const __amdgpu_buffer_rsrc_t rB = __builtin_amdgcn_make_buffer_rsrc((void*)S.Bt, 0, 0x7fffffff, 0x00020000);
    unsigned oc[2][2], on[2][2];
#pragma unroll
    for (int h = 0; h < 2; ++h)
#pragma unroll
        for (int i = 0; i < 2; ++i) oc[h][i] = S.a_off(cur, 128 * h + Rr[i]) + (unsigned)Cc[i] * 2u;
    f32x4 acc[2][2][4][2];
#pragma unroll
    for (int a = 0; a < 2; ++a)
#pragma unroll
        for (int b = 0; b < 2; ++b)
#pragma unroll
            for (int m = 0; m < 4; ++m)
#pragma unroll
                for (int n = 0; n < 2; ++n) acc[a][b][m][n] = (f32x4){0.f, 0.f, 0.f, 0.f};
    typedef typename FragT<FP8>::T frag_t;
    frag_t At[4], B0[2], B1[2];
    const unsigned kstep = 128;
    const int sclB = SCALE_B * 0x01010101, sclA = 0x7f7f7f7f; (void)sclA; (void)sclB;
    PG8_STAGE(PG8_SB(0, 0), rB, voffB[0], cur.bo); PG8_STAGE(PG8_SB(0, 1), rB, voffB[1], cur.bo); PG8_STAGE(PG8_SA(0, 0), rA, oc[0], cur.ao); PG8_STAGE(PG8_SA(0, 1), rA, oc[1], cur.ao);
    if (wr == 1) PG8_BAR;
    PG8_WAIT_V(2); PG8_BAR;
    PG8_STAGE(PG8_SB(1, 0), rB, voffB[0], cur.bo + kstep); PG8_STAGE(PG8_SA(1, 0), rA, oc[0], cur.ao + kstep); PG8_STAGE(PG8_SB(1, 1), rB, voffB[1], cur.bo + kstep);
    PG8_WAIT_V(6); PG8_BAR;
    for (;;) {
        const bool has_next = S.next(ui + 1, nxt);
        if (!has_next) nxt = cur;
        const unsigned nA = nxt.ao, nB = nxt.bo;
        { int t2 = threadIdx.x; LAUNDER(t2);
#pragma unroll
          for (int i = 0; i < 2; ++i) { int R_, C_; stage_rc(t2 * 16 + i * 8192, R_, C_);
#pragma unroll
              for (int h = 0; h < 2; ++h) on[h][i] = S.a_off(nxt, 128 * h + R_) + (unsigned)C_ * 2u; } }
        for (int t = 0; t < nt; t += 2) {
            const bool last = (t == nt - 2);
            const unsigned k1 = cur.ao + (unsigned)(t + 1) * kstep;
            const unsigned a2 = last ? nA : cur.ao + (unsigned)(t + 2) * kstep, b2 = last ? nB : cur.bo + (unsigned)(t + 2) * kstep, a3 = a2 + kstep, b3 = b2 + kstep;
            unsigned o2[2][2];
#pragma unroll
            for (int h = 0; h < 2; ++h)
#pragma unroll
                for (int i = 0; i < 2; ++i) o2[h][i] = last ? on[h][i] : oc[h][i];
            PG8_LDB(B0, 0, 0); PG8_LDB(B1, 0, 1); PG8_SCHED; PG8_LDA(At, 0, 0); PG8_STAGE(PG8_SA(1, 1), rA, oc[1], k1);
            PG8_WAIT_V(8); PG8_WAIT_L(0); PG8_BAR; PG8_MMA(0, 0, At, B0); PG8_MMA(0, 1, At, B1); PG8_BAR; PG8_SCHED;
            PG8_LDA(At, 0, 1); PG8_STAGE(PG8_SB(0, 0), rB, voffB[0], b2); PG8_STAGE(PG8_SB(0, 1), rB, voffB[1], b2); PG8_STAGE(PG8_SA(0, 0), rA, o2[0], a2);
            PG8_WAIT_V(8); PG8_WAIT_L(0); PG8_BAR; PG8_MMA(1, 0, At, B0); PG8_MMA(1, 1, At, B1); PG8_BAR; PG8_SCHED;
            PG8_LDB(B0, 1, 0); PG8_LDB(B1, 1, 1); PG8_SCHED; PG8_LDA(At, 1, 0); PG8_STAGE(PG8_SA(0, 1), rA, o2[1], a2);
            PG8_WAIT_V(8); PG8_WAIT_L(0); PG8_BAR; PG8_MMA(0, 0, At, B0); PG8_MMA(0, 1, At, B1); PG8_BAR; PG8_SCHED;
            PG8_LDA(At, 1, 1); PG8_STAGE(PG8_SB(1, 0), rB, voffB[0], b3); PG8_STAGE(PG8_SB(1, 1), rB, voffB[1], b3); PG8_STAGE(PG8_SA(1, 0), rA, o2[0], a3);
            PG8_WAIT_V(8); PG8_WAIT_L(0); PG8_BAR; PG8_MMA(1, 0, At, B0); PG8_MMA(1, 1, At, B1); PG8_BAR; PG8_SCHED;
        }
        if constexpr (FP8) asm volatile("s_nop 15\n\ts_nop 15" ::: "memory");
        if constexpr (ALIGN_EPI) { if (wr == 0) PG8_BAR; }
        if constexpr (!Epi::AFTER_DRAIN) E(acc, cur, wr, wc, fr, fq);
        if (!has_next) break;
#pragma unroll
        for (int a = 0; a < 2; ++a)
#pragma unroll
            for (int b = 0; b < 2; ++b)
#pragma unroll
                for (int m = 0; m < 4; ++m)
#pragma unroll
                    for (int n = 0; n < 2; ++n) acc[a][b][m][n] = (f32x4){0.f, 0.f, 0.f, 0.f};
        cur = nxt; ++ui;
#pragma unroll
        for (int h = 0; h < 2; ++h)
#pragma unroll
            for (int i = 0; i < 2; ++i) oc[h][i] = on[h][i];
        if constexpr (ALIGN_EPI) { if (wr == 1) PG8_BAR; }
    }
    PG8_WAIT_V(0);
    if constexpr (!ALIGN_EPI) { if (wr == 0) PG8_BAR; }
    PG8_BAR;
    if constexpr (Epi::AFTER_DRAIN) E.fused(acc, cur, wr, wc, fr, fq, lds_flat, wid, lane);
#undef PG8_SA
#undef PG8_SB
#undef PG8_STAGE
#undef PG8_LDA
#undef PG8_LDF
#undef PG8_LDB
#undef PG8_MMA
#undef PG8_WAIT_V
#undef PG8_WAIT_L
#undef PG8_BAR
#undef PG8_SCHED
}
template <bool ALIGN, class Sched, class Epi> __device__ __forceinline__ void gemm_run(unsigned char* lds, const Sched& S, const Epi& E) {
    gemm_phase<Sched, Epi, ALIGN>(lds, S, E);
}
constexpr int WSCALE_LOG2 = 6;
template <bool ALIGN, class Sched, class Epi> __device__ __forceinline__ void gemm_run_fp8(unsigned char* lds, const Sched& S, const Epi& E) {
    gemm_phase<Sched, Epi, ALIGN, true, 127 - WSCALE_LOG2>(lds, S, E);
}

struct DenseSched {
    const char* A; const char* Bt; unsigned lda, ldb; int K; int nM, nN; int pm_per_b; size_t zB; int G, c;
    __device__ __forceinline__ bool next(int i, GUnit& u) const {
        int pm, pn;
        if (G == 256 && (nN & 3) == 0 && nM * nN >= 256) {
            const int j = c & 7, q = c >> 3, s = i * 8 + j, ncg = nN >> 2; pm = (s / ncg) * 8 + (q >> 2); pn = (s % ncg) * 4 + (q & 3); if (c < 0 || pm >= nM) return false; }
        else { const long L = (long)i * G + c; if (c < 0 || L >= (long)nM * nN) return false; pm = (int)(L / nN); pn = (int)(L % nN); }
        u.ao = (unsigned)pm * 256u * lda; u.bo = (unsigned)((size_t)(pm / pm_per_b) * zB) + (unsigned)pn * 256u * ldb; u.row0 = pm * 256; u.col0 = pn * 256; u.e = 0; u.valid = 256; u.aux = 0; return true;
    }
    __device__ __forceinline__ unsigned a_off(const GUnit&, int r) const { return (unsigned)r * lda; }
};
struct SchedWqk {
    const char* A; const char* Bt; unsigned lda, ldb; int K; int G, c, pad;
    __device__ __forceinline__ bool next(int i, GUnit& u) const {
        const int L = i * G + c; if (c < 0 || L >= 32) return false; const int z = L >> 2, pn = L & 3, b = z >> 2, h = z & 3;
        u.ao = (unsigned)b * 256u * 4096u + h * 512u; u.bo = (unsigned)pn * 256u * 2048u + h * 512u; u.row0 = z * 256; u.col0 = pn * 256; u.e = 0; u.valid = 256; u.aux = 0; return true;
    }
    __device__ __forceinline__ unsigned a_off(const GUnit&, int r) const { return (unsigned)r * lda; }
};
struct SchedVo {
    const char* A; const char* Bt; unsigned lda, ldb; int K; int G, c, pad;
    __device__ __forceinline__ bool next(int i, GUnit& u) const {
        const int L = i * G + c; if (c < 0 || L >= 32) return false; const int z = L >> 2, pm = L & 3, b = z >> 2, h = z & 3;
        u.ao = (unsigned)pm * 256u * 2048u + h * 512u; u.bo = (unsigned)b * 256u * 4096u + 2048u + h * 512u; u.row0 = b * 1024 + pm * 256; u.col0 = h * 256; u.e = 0; u.valid = 256; u.aux = 0; return true;
    }
    __device__ __forceinline__ unsigned a_off(const GUnit&, int r) const { return (unsigned)r * lda; }
};
template <bool GATHER> struct MoeSched {
    const char* A; const char* Bt; unsigned lda, ldb; int K; int nN; size_t zB;
    const int* tab; const int* list; int gather; int G, c, pad;
    __device__ __forceinline__ bool next(int i, GUnit& u) const {
        int T, pn;
        if (G == 256) { const int j = c & 7, q = c >> 3, s = i * 8 + j;
            if (nN == 8) { T = 4 * s + (q >> 3); pn = q & 7; } else { T = 8 * s + (q >> 2); pn = q & 3; } }
        else { const int L = i * G + c; T = L / nN; pn = L % nN; }
        if (T >= __builtin_amdgcn_readfirstlane(tab[64])) return false;
        const int w = __builtin_amdgcn_readfirstlane(tab[128 + T]); const int e = w & 255, rt = w >> 8; const int ce = __builtin_amdgcn_readfirstlane(tab[e]), start = __builtin_amdgcn_readfirstlane(tab[32 + e]);
        u.e = e; u.valid = min(256, ce - rt * 256); u.row0 = start + rt * 256; u.col0 = pn * 256; u.aux = rt * 256;
        u.ao = GATHER ? 0u : (unsigned)u.row0 * lda; u.bo = (unsigned)((size_t)e * zB) + (unsigned)pn * 256u * ldb; return true;
    }
    __device__ __forceinline__ unsigned a_off(const GUnit& u, int r) const {
        if (!GATHER) return (unsigned)r * lda;
        const int rr = r < u.valid ? r : 0; const int tok = list[u.e * NTOK + u.aux + rr]; return (unsigned)tok * lda;
    }
};
__device__ __forceinline__ void moe_build_table(int* tab, const int* __restrict__ cnt, int tid) {
    if (tid < 32) tab[tid] = cnt[tid * 32];
    __syncthreads();
    if (tid < 32) { int s = 0; for (int e = 0; e < tid; ++e) s += tab[e]; tab[32 + tid] = s; }
    if (tid < 320) { int tiles = 0, found = -1;
        for (int e = 0; e < NEXP; ++e) { const int te = (tab[e] + 255) >> 8; if (found < 0 && tid < tiles + te) found = e | ((tid - tiles) << 8); tiles += te; }
        if (found >= 0) tab[128 + tid] = found; if (tid == 0) tab[64] = tiles; }
    __syncthreads();
}

__device__ __forceinline__ u32x4 pack8(const f32x4& a, const f32x4& b) { u32x4 w; w.x = pk2(a[0], a[1]); w.y = pk2(a[2], a[3]); w.z = pk2(b[0], b[1]); w.w = pk2(b[2], b[3]); return w; }
struct EpiBf16 { static constexpr bool AFTER_DRAIN = false; bf16_t* O; int ldc, pad;
    __device__ __forceinline__ void operator()(const f32x4 (&acc)[2][2][4][2], const GUnit& u, int wr, int wc, int fr, int fq) const {
        LAUNDER(fr); LAUNDER(fq);
#pragma unroll
        for (int ai = 0; ai < 2; ++ai)
#pragma unroll
            for (int m = 0; m < 4; ++m) { const int r = 128 * ai + 64 * wr + 16 * m + fr;
#pragma unroll
                for (int bj = 0; bj < 2; ++bj) *(u32x4*)(O + (size_t)(u.row0 + r) * ldc + u.col0 + 128 * bj + 32 * wc + 8 * fq) = pack8(acc[ai][bj][m][0], acc[ai][bj][m][1]); } } };
__device__ __forceinline__ float row_rstd(const float* __restrict__ ssp, int row) { const f32x4* p = (const f32x4*)(ssp + (size_t)row * 16); const f32x4 a = p[0], b = p[1], c = p[2], d = p[3];
    const float s = (((a[0] + a[1]) + (a[2] + a[3])) + ((b[0] + b[1]) + (b[2] + b[3]))) + (((c[0] + c[1]) + (c[2] + c[3])) + ((d[0] + d[1]) + (d[2] + d[3]))); return 1.0f / sqrtf(s * (1.0f / 1024.0f) + EPS); }
template <bool BASE_BF16> struct EpiResidSS { static constexpr bool AFTER_DRAIN = false; const void* base; bf16_t* xb; float* ss; unsigned char* xq;
    __device__ __forceinline__ void operator()(const f32x4 (&acc)[2][2][4][2], const GUnit& u, int wr, int wc, int fr, int fq) const {
        LAUNDER(fr); LAUNDER(fq);
#pragma unroll
        for (int ai = 0; ai < 2; ++ai) {
            f32x4 b[4][2][2];
#pragma unroll
            for (int m = 0; m < 4; ++m)
#pragma unroll
                for (int bj = 0; bj < 2; ++bj) { const size_t o = (size_t)(u.row0 + 128 * ai + 64 * wr + 16 * m + fr) * 1024 + u.col0 + 128 * bj + 32 * wc + 8 * fq;
                    if (BASE_BF16) { const u32x4 w = *(const u32x4*)((const bf16_t*)base + o); b[m][bj][0] = (f32x4){bflo(w.x), bfhi(w.x), bflo(w.y), bfhi(w.y)}; b[m][bj][1] = (f32x4){bflo(w.z), bfhi(w.z), bflo(w.w), bfhi(w.w)}; }
                    else { b[m][bj][0] = __builtin_nontemporal_load((const f32x4*)((const float*)base + o)); b[m][bj][1] = __builtin_nontemporal_load((const f32x4*)((const float*)base + o + 4)); } }
#pragma unroll
            for (int m = 0; m < 4; ++m) { const int r = 128 * ai + 64 * wr + 16 * m + fr; float part = 0.f;
#pragma unroll
                for (int bj = 0; bj < 2; ++bj) { const size_t o = (size_t)(u.row0 + r) * 1024 + u.col0 + 128 * bj + 32 * wc + 8 * fq;
                    const f32x4 y0 = b[m][bj][0] + acc[ai][bj][m][0], y1 = b[m][bj][1] + acc[ai][bj][m][1]; *(u32x4*)(xb + o) = pack8(y0, y1);
                    if (xq) { u32x2 q; q.x = pk4_fp8(y0[0], y0[1], y0[2], y0[3]); q.y = pk4_fp8(y1[0], y1[1], y1[2], y1[3]); *(u32x2*)(xq + o) = q; }
                    part += (y0[0] * y0[0] + y0[1] * y0[1] + y0[2] * y0[2] + y0[3] * y0[3]) + (y1[0] * y1[0] + y1[1] * y1[1] + y1[2] * y1[2] + y1[3] * y1[3]); }
                part += __shfl_xor(part, 16); part += __shfl_xor(part, 32);
                if (fq == 0) ss[(size_t)(u.row0 + r) * 16 + (u.col0 >> 8) * 4 + wc] = part; } } } };
struct EpiSoftmax { static constexpr bool AFTER_DRAIN = true; const float* ss; bf16_t* P;
    __device__ __forceinline__ void operator()(const f32x4 (&)[2][2][4][2], const GUnit&, int, int, int, int) const {}
    __device__ __forceinline__ void fused(f32x4 (&acc)[2][2][4][2], const GUnit& u, int wr, int wc, int fr, int fq, unsigned char* lds, int wid, int lane) const {
        float* Pm = (float*)lds; float* Ps = (float*)(lds + 4096);
        LAUNDER(fr); LAUNDER(fq);
#pragma unroll
        for (int ai = 0; ai < 2; ++ai)
#pragma unroll
            for (int m = 0; m < 4; ++m) { const int r = 128 * ai + 64 * wr + 16 * m + fr; const float rstd = row_rstd(ss, u.row0 + r); float mv = -INFINITY;
#pragma unroll
                for (int bj = 0; bj < 2; ++bj)
#pragma unroll
                    for (int n = 0; n < 2; ++n) { f32x4 s = acc[ai][bj][m][n] * rstd; acc[ai][bj][m][n] = s; mv = fmaxf(mv, fmaxf(fmaxf(s[0], s[1]), fmaxf(s[2], s[3]))); }
                mv = fmaxf(mv, __shfl_xor(mv, 16)); mv = fmaxf(mv, __shfl_xor(mv, 32));
                if (fq == 0) Pm[r * 4 + wc] = mv; }
        __syncthreads();
#pragma unroll
        for (int ai = 0; ai < 2; ++ai)
#pragma unroll
            for (int m = 0; m < 4; ++m) { const int r = 128 * ai + 64 * wr + 16 * m + fr; const f32x4 pm = *(const f32x4*)(Pm + r * 4); const float mv = fmaxf(fmaxf(pm[0], pm[1]), fmaxf(pm[2], pm[3])); float sum = 0.f;
#pragma unroll
                for (int bj = 0; bj < 2; ++bj)
#pragma unroll
                    for (int n = 0; n < 2; ++n) { f32x4 s = acc[ai][bj][m][n]; s[0] = __builtin_amdgcn_exp2f(s[0] - mv); s[1] = __builtin_amdgcn_exp2f(s[1] - mv); s[2] = __builtin_amdgcn_exp2f(s[2] - mv); s[3] = __builtin_amdgcn_exp2f(s[3] - mv);
                        acc[ai][bj][m][n] = s; sum += (s[0] + s[1]) + (s[2] + s[3]); }
                sum += __shfl_xor(sum, 16); sum += __shfl_xor(sum, 32);
                if (fq == 0) Ps[r * 4 + wc] = sum; }
        __syncthreads();
#pragma unroll
        for (int ai = 0; ai < 2; ++ai)
#pragma unroll
            for (int m = 0; m < 4; ++m) { const int r = 128 * ai + 64 * wr + 16 * m + fr; const f32x4 ps = *(const f32x4*)(Ps + r * 4); const float inv = 1.0f / ((ps[0] + ps[1]) + (ps[2] + ps[3]));
#pragma unroll
                for (int bj = 0; bj < 2; ++bj) *(u32x4*)(P + (size_t)(u.row0 + r) * 1024 + u.col0 + 128 * bj + 32 * wc + 8 * fq) = pack8(acc[ai][bj][m][0] * inv, acc[ai][bj][m][1] * inv); }
        (void)wid; (void)lane;
        __syncthreads();
    } };
struct EpiGU { static constexpr bool AFTER_DRAIN = false; const float* bgu; unsigned char* act  ; const float* lrs  ;
    __device__ __forceinline__ void operator()(const f32x4 (&acc)[2][2][4][2], const GUnit& u, int wr, int wc, int fr, int fq) const {
        const int pn = u.col0 >> 8; const float* bg = bgu + (size_t)u.e * 2048; LAUNDER(fr); LAUNDER(fq);
        float rs[8];
#pragma unroll
        for (int i = 0; i < 8; ++i) { const int r = 128 * (i >> 2) + 64 * wr + 16 * (i & 3) + fr; rs[i] = lrs[(size_t)u.e * NTOK + u.aux + (r < u.valid ? r : 0)]; }
        const int col = 128 * pn + 32 * wc + 8 * fq;
        f32x4 bgv[2], blv[2];
#pragma unroll
        for (int n = 0; n < 2; ++n) { bgv[n] = *(const f32x4*)(bg + col + 4 * n); blv[n] = *(const f32x4*)(bg + 1024 + col + 4 * n); }
#pragma unroll
        for (int ai = 0; ai < 2; ++ai)
#pragma unroll
            for (int m = 0; m < 4; ++m) { const int r = 128 * ai + 64 * wr + 16 * m + fr; const float rstd = rs[ai * 4 + m]; u32x2 q;
#pragma unroll
                for (int n = 0; n < 2; ++n) { const f32x4 g = acc[ai][0][m][n] * rstd + bgv[n], l = acc[ai][1][m][n] * rstd + blv[n]; float o[4];
#pragma unroll
                    for (int j = 0; j < 4; ++j) { const float gg = fminf(g[j], 7.0f), ll = fminf(fmaxf(l[j], -7.0f), 7.0f); o[j] = (ll + 1.0f) * (gg * __builtin_amdgcn_rcpf(1.0f + __builtin_amdgcn_exp2f(-1.702f * LOG2E * gg))); }
                    const unsigned w = pk4_fp8(o[0], o[1], o[2], o[3]); if (n == 0) q.x = w; else q.y = w; }
                if (r < u.valid) *(u32x2*)(act + (size_t)(u.row0 + r) * 1024 + col) = q; } } };
struct EpiDown { static constexpr bool AFTER_DRAIN = false; const float* bdn; unsigned char* ys  ;
    __device__ __forceinline__ void operator()(const f32x4 (&acc)[2][2][4][2], const GUnit& u, int wr, int wc, int fr, int fq) const {
        const float* bd = bdn + (size_t)u.e * 1024; LAUNDER(fr); LAUNDER(fq);
        f32x4 bv[2][2];
#pragma unroll
        for (int bj = 0; bj < 2; ++bj)
#pragma unroll
            for (int n = 0; n < 2; ++n) bv[bj][n] = *(const f32x4*)(bd + u.col0 + 128 * bj + 32 * wc + 8 * fq + 4 * n);
#pragma unroll
        for (int ai = 0; ai < 2; ++ai)
#pragma unroll
            for (int m = 0; m < 4; ++m) { const int r = 128 * ai + 64 * wr + 16 * m + fr; if (r < u.valid) {
#pragma unroll
                for (int bj = 0; bj < 2; ++bj) { const f32x4 y0 = acc[ai][bj][m][0] + bv[bj][0], y1 = acc[ai][bj][m][1] + bv[bj][1]; u32x2 q; q.x = pk4_fp8(y0[0], y0[1], y0[2], y0[3]); q.y = pk4_fp8(y1[0], y1[1], y1[2], y1[3]);
                    *(u32x2*)(ys + (size_t)(u.row0 + r) * 1024 + u.col0 + 128 * bj + 32 * wc + 8 * fq) = q; } } } } };


typedef float f32x16 __attribute__((ext_vector_type(16)));
typedef short s16x4 __attribute__((ext_vector_type(4)));
__device__ __forceinline__ int crow(int r, int hi) { return (r & 3) + 8 * (r >> 2) + 4 * hi; }
__device__ __forceinline__ s16x4 tr_read(const unsigned char* p) { return __builtin_bit_cast(s16x4, __builtin_amdgcn_ds_read_tr16_b64_v4i16((LDSP s16x4*)(unsigned)(uintptr_t)p)); }
__device__ __forceinline__ bf16x8 tr_frag(const unsigned char* img, int pitch, int k0, int f0, int lane) {
    const unsigned char* p = img + (k0 + 8 * (lane >> 5) + ((lane & 15) >> 2)) * pitch + (f0 + 16 * ((lane >> 4) & 1) + 4 * (lane & 3)) * 2;
    const s16x4 lo = tr_read(p), hi = tr_read(p + 4 * pitch);
    return (bf16x8){lo[0], lo[1], lo[2], lo[3], hi[0], hi[1], hi[2], hi[3]};
}
constexpr int GA_PK = 576, GA_PV = 1088;
constexpr int GA_V = 0, GA_PART = 0, GA_GLR = 69632, GA_TOT = 73728, GA_KD = 75776, GA_END = GA_KD + 64 * GA_PK;
__device__ __forceinline__ void gla_pass_a(unsigned char* lds, int task, const bf16_t* __restrict__ xn, const bf16_t* __restrict__ wglr  , const bf16_t* __restrict__ proj,
                                           const float* __restrict__ wg, const float* __restrict__ bg, float* __restrict__ UT, float* __restrict__ decay) {
    int tid = threadIdx.x; LAUNDER(tid); int wid = tid >> 6, lane = tid & 63, fr = lane & 15, fq = lane >> 4;
    const size_t t0 = (size_t)task * 64;
    { f32x4 acc[4];
#pragma unroll
      for (int m = 0; m < 4; ++m) acc[m] = (f32x4){0.f, 0.f, 0.f, 0.f};
#pragma unroll
      for (int ks = 0; ks < 4; ++ks) { const int k = 128 * wid + 32 * ks + 8 * fq; const bf16x8 bfr = *(const bf16x8*)(wglr + (size_t)fr * 1024 + k);
#pragma unroll
          for (int m = 0; m < 4; ++m) { const bf16x8 afr = *(const bf16x8*)(xn + (t0 + 16 * m + fr) * DM + k); acc[m] = __builtin_amdgcn_mfma_f32_16x16x32_bf16(afr, bfr, acc[m], 0, 0, 0); } }
      float* part = (float*)(lds + GA_PART) + wid * 1024;
#pragma unroll
      for (int m = 0; m < 4; ++m)
#pragma unroll
          for (int j = 0; j < 4; ++j) part[(16 * m + 4 * fq + j) * 16 + fr] = acc[m][j]; }
    __syncthreads();
    { float* glr = (float*)(lds + GA_GLR); const float* part = (const float*)(lds + GA_PART);
      for (int i = tid; i < 1024; i += 512) { float s = 0.f;
#pragma unroll
          for (int w = 0; w < 8; ++w) s += part[w * 1024 + i];
          glr[i] = s; } }
    __syncthreads();
    LAUNDER(tid);
    { const int cv = tid & 63, tk = tid >> 6;
#pragma unroll
      for (int i = 0; i < 8; ++i) { const int tok = tk + 8 * i; const u32x4 v = *(const u32x4*)(proj + (t0 + tok) * PROJ_LD + C_VG + cv * 8); *(u32x4*)(lds + GA_V + tok * GA_PV + cv * 16) = v; } }
    LAUNDER(tid);
    { const int j = tid & 255, half = tid >> 8; const float* glr = (const float*)(lds + GA_GLR); float* tot = (float*)(lds + GA_TOT);
      float w[16];
#pragma unroll
      for (int i = 0; i < 16; ++i) w[i] = wg[i * 256 + j];
      const float bj = bg[j]; float run = 0.f;
      bf16_t kk16[32];
#pragma unroll
      for (int s = 0; s < 32; ++s) kk16[s] = proj[(t0 + 32 * half + s) * PROJ_LD + C_KG + j];
      float Gc[32];
#pragma unroll
      for (int s = 0; s < 32; ++s) { const float* gl = glr + (32 * half + s) * 16; float u = bj;
#pragma unroll
          for (int i = 0; i < 16; ++i) u += gl[i] * w[i];
          const float ls = fminf(u, 0.f) - __logf(1.0f + __expf(-fabsf(u)));
          run += ls * (1.0f / 16.0f); Gc[s] = run; }
      tot[half * 256 + j] = run;
      __syncthreads();
      const float t0v = tot[j], t1v = tot[256 + j]; const float gend = t0v + t1v;
      if (half == 0) decay[(size_t)task * 256 + j] = __expf(gend);
      const float rel = gend - (half ? t0v : 0.f);
#pragma unroll
      for (int s = 0; s < 32; ++s) { const int tok = 32 * half + s;
          *(bf16_t*)(lds + GA_KD + tok * GA_PK + j * 2) = (bf16_t)f2bf(bf2f(kk16[s]) * __expf(rel - Gc[s])); } }
    __syncthreads();
    LAUNDER(tid); wid = __builtin_amdgcn_readfirstlane(tid >> 6); lane = tid & 63;
    { const int h = wid >> 1, nt = wid & 1, hi = lane >> 5, c32 = lane & 31; f32x16 acc[4];
#pragma unroll
      for (int m = 0; m < 4; ++m)
#pragma unroll
          for (int r = 0; r < 16; ++r) acc[m][r] = 0.f;
#pragma unroll
      for (int ks = 0; ks < 4; ++ks) { const bf16x8 bfr = tr_frag(lds + GA_KD, GA_PK, 16 * ks, h * 64 + 32 * nt, lane);
#pragma unroll
          for (int m = 0; m < 4; ++m) { const bf16x8 afr = tr_frag(lds + GA_V, GA_PV, 16 * ks, h * 128 + 32 * m, lane); acc[m] = __builtin_amdgcn_mfma_f32_32x32x16_bf16(afr, bfr, acc[m], 0, 0, 0); } }
      float* u = UT + ((size_t)task * 4 + h) * 8192;
#pragma unroll
      for (int m = 0; m < 4; ++m)
#pragma unroll
          for (int r = 0; r < 16; ++r) __builtin_nontemporal_store(acc[m][r], u + (32 * m + crow(r, hi)) * 64 + 32 * nt + c32); }
    __syncthreads();
}
__device__ __forceinline__ void gla_pass_b(int e, const float* __restrict__ UT, const float* __restrict__ decay, bf16_t* __restrict__ ST) {
    const int dk = e & 63, dv = (e >> 6) & 127, h = (e >> 13) & 3, b = e >> 15; float s = 0.f;
    const size_t base = ((size_t)b * 128 * 4 + h) * 8192 + dv * 64 + dk; const size_t dbase = (size_t)b * 128 * 256 + h * 64 + dk;
    for (int c0 = 0; c0 < 128; c0 += 32) { float u[32], d[32];
#pragma unroll
        for (int i = 0; i < 32; ++i) { u[i] = __builtin_nontemporal_load(UT + base + (size_t)(c0 + i) * 4 * 8192); d[i] = decay[dbase + (size_t)(c0 + i) * 256]; }
#pragma unroll
        for (int i = 0; i < 32; ++i) { s = d[i] * s + u[i]; __builtin_nontemporal_store((bf16_t)f2bf(s), ST + base + (size_t)(c0 + i) * 4 * 8192); } }
}
constexpr int GC_PITCH = 520;
__device__ __forceinline__ void gla_pass_c(unsigned char* wlds  , int wtask, const bf16_t* __restrict__ ST, const bf16_t* __restrict__ proj, const float* __restrict__ ghead, bf16_t* __restrict__ mix, int lane) {
    const int nh = wtask & 1, h = (wtask >> 1) & 3, bc = wtask >> 3; const int c32 = lane & 31, hi = lane >> 5;
    const size_t t0 = (size_t)bc * 64 + 32 * nh; const bf16_t* st = ST + ((size_t)bc * 4 + h) * 8192;
    f32x16 acc[4];
#pragma unroll
    for (int m = 0; m < 4; ++m)
#pragma unroll
        for (int r = 0; r < 16; ++r) acc[m][r] = 0.f;
#pragma unroll
    for (int ks = 0; ks < 4; ++ks) { const bf16x8 bfr = *(const bf16x8*)(proj + (t0 + c32) * PROJ_LD + C_QG + h * 64 + 16 * ks + 8 * hi);
#pragma unroll
        for (int m = 0; m < 4; ++m) { const bf16x8 afr = *(const bf16x8*)(st + (32 * m + c32) * 64 + 16 * ks + 8 * hi); acc[m] = __builtin_amdgcn_mfma_f32_32x32x16_bf16(afr, bfr, acc[m], 0, 0, 0); } }
    float ss = 0.f;
#pragma unroll
    for (int m = 0; m < 4; ++m)
#pragma unroll
        for (int r = 0; r < 16; ++r) ss += acc[m][r] * acc[m][r];
    ss += __shfl_xor(ss, 32);
    const float rstd = 1.0f / sqrtf(ss * (1.0f / 128.0f) + EPS);
#pragma unroll
    for (int m = 0; m < 4; ++m)
#pragma unroll
        for (int r = 0; r < 16; ++r) *(float*)(wlds + c32 * GC_PITCH + (32 * m + crow(r, hi)) * 4) = acc[m][r] * rstd;
#pragma unroll
    for (int i = 0; i < 8; ++i) { const int q = lane + 64 * i, tok = q >> 4, dv0 = (q & 15) * 8; const float* src = (const float*)(wlds + tok * GC_PITCH + dv0 * 4);
        const u32x4 rgw = *(const u32x4*)(proj + (t0 + tok) * PROJ_LD + C_RG + h * 128 + dv0); const f32x4 g0 = *(const f32x4*)(ghead + dv0), g1 = *(const f32x4*)(ghead + dv0 + 4);
        const float rg[8] = {bflo(rgw.x), bfhi(rgw.x), bflo(rgw.y), bfhi(rgw.y), bflo(rgw.z), bfhi(rgw.z), bflo(rgw.w), bfhi(rgw.w)}; const float gg[8] = {g0.x, g0.y, g0.z, g0.w, g1.x, g1.y, g1.z, g1.w}; float y[8];
#pragma unroll
        for (int k = 0; k < 8; ++k) y[k] = src[k] * gg[k] * (rg[k] / (1.0f + __expf(-rg[k])));
        u32x4 o; o.x = pk2(y[0], y[1]); o.y = pk2(y[2], y[3]); o.z = pk2(y[4], y[5]); o.w = pk2(y[6], y[7]);
        *(u32x4*)(mix + (t0 + tok) * 1024 + h * 128 + dv0) = o; }
}
__device__ __forceinline__ void sb_task(unsigned char* vl  , int wtask, const bf16_t* __restrict__ proj, bf16_t* __restrict__ mix, int lane) {
    const int qt = wtask & 255, h = (wtask >> 8) & 7, b = wtask >> 11; const int c = lane & 31, hi = lane >> 5;
    const int t0 = qt * 32; const size_t rowb = (size_t)b * SEQ;
    bf16x8 qf[4];
#pragma unroll
    for (int d0 = 0; d0 < 4; ++d0) qf[d0] = *(const bf16x8*)(proj + (rowb + t0 + c) * PROJ_LD + C_QS + h * 64 + 16 * d0 + 8 * hi);
    const int kap = 16 * ((c >> 2) & 1) + (c & 3) + 4 * (c >> 3);
    f32x16 o0, o1;
#pragma unroll
    for (int r = 0; r < 16; ++r) { o0[r] = 0.f; o1[r] = 0.f; }
    float Dc = 1.0f;
    const bf16_t* kbase = proj + rowb * PROJ_LD + C_KS + h * 64 + 8 * hi + (size_t)kap * PROJ_LD;
    const bf16_t* vbase = proj + rowb * PROJ_LD + C_VS + h * 64 + (lane & 7) * 8 + (size_t)(lane >> 3) * PROJ_LD;
    bf16x8 kf[4]; u32x4 vr[4];
#pragma unroll
    for (int d0 = 0; d0 < 4; ++d0) kf[d0] = *(const bf16x8*)(kbase + (size_t)t0 * PROJ_LD + 16 * d0);
#pragma unroll
    for (int i = 0; i < 4; ++i) vr[i] = *(const u32x4*)(vbase + (size_t)(t0 + 8 * i) * PROJ_LD);
    for (int j0 = t0; j0 >= 0; j0 -= 32) {
#pragma unroll
        for (int i = 0; i < 4; ++i) { const int key = (lane >> 3) + 8 * i, ch = lane & 7; *(u32x4*)(vl + (ch >> 2) * 2048 + key * 64 + (ch & 3) * 16) = vr[i]; }
        f32x16 z;
#pragma unroll
        for (int r = 0; r < 16; ++r) z[r] = 0.f;
#pragma unroll
        for (int d0 = 0; d0 < 4; ++d0) z = __builtin_amdgcn_mfma_f32_32x32x16_bf16(kf[d0], qf[d0], z, 0, 0, 0);
        asm volatile("" ::: "memory");
        { const int jn = (j0 >= 32) ? j0 - 32 : j0;
#pragma unroll
          for (int d0 = 0; d0 < 4; ++d0) kf[d0] = *(const bf16x8*)(kbase + (size_t)jn * PROJ_LD + 16 * d0);
#pragma unroll
          for (int i = 0; i < 4; ++i) vr[i] = *(const u32x4*)(vbase + (size_t)(jn + 8 * i) * PROJ_LD); }
        asm volatile("" ::: "memory");
        float e[16], Dl[16];
        const bool diag = (j0 == t0);
#pragma unroll
        for (int r = 0; r < 16; ++r) { float ev = __builtin_amdgcn_exp2f(fminf(z[r], 126.0f)); if (diag && (16 * hi + r >= c)) ev = 0.f; e[r] = ev; }
        float D = hi ? Dc : 1.0f;
#pragma unroll
        for (int r = 15; r >= 0; --r) { D = fmaf(D, e[r], D); Dl[r] = D; }
        const float other = __shfl_xor(D, 32);
        const float mult = hi ? 1.0f : other;
        Dc = D * other;
        unsigned pw[8];
#pragma unroll
        for (int r = 0; r < 16; r += 2) { const float a0 = e[r] * __builtin_amdgcn_rcpf(Dl[r] * mult), a1 = e[r + 1] * __builtin_amdgcn_rcpf(Dl[r + 1] * mult); pw[r >> 1] = pk2(a0, a1); }
#pragma unroll
        for (int ks = 0; ks < 2; ++ks) { const bf16x8 pa = __builtin_bit_cast(bf16x8, (u32x4){pw[4 * ks], pw[4 * ks + 1], pw[4 * ks + 2], pw[4 * ks + 3]});
            const unsigned char* vb = vl + (16 * hi + 8 * ks + ((lane & 15) >> 2)) * 64 + (16 * ((lane >> 4) & 1) + 4 * (lane & 3)) * 2;
            { const s16x4 lo = tr_read(vb), hh = tr_read(vb + 256); o0 = __builtin_amdgcn_mfma_f32_32x32x16_bf16(pa, (bf16x8){lo[0], lo[1], lo[2], lo[3], hh[0], hh[1], hh[2], hh[3]}, o0, 0, 0, 0); }
            { const s16x4 lo = tr_read(vb + 2048), hh = tr_read(vb + 2048 + 256); o1 = __builtin_amdgcn_mfma_f32_32x32x16_bf16(pa, (bf16x8){lo[0], lo[1], lo[2], lo[3], hh[0], hh[1], hh[2], hh[3]}, o1, 0, 0, 0); } }
        if (__all(!(Dc < 3.0e38f))) break;
    }
    bf16_t* ob = mix + (rowb + t0) * 1024 + 512 + h * 64 + c;
#pragma unroll
    for (int r = 0; r < 16; ++r) { const int q = crow(r, hi); ob[(size_t)q * 1024] = (bf16_t)f2bf(o0[r]); ob[(size_t)q * 1024 + 32] = (bf16_t)f2bf(o1[r]); }
}
__device__ __forceinline__ void memkv_task(int wtask, int lane, const bf16_t* __restrict__ memn, const bf16_t* __restrict__ wkv, bf16_t* __restrict__ kv) {
    const int tm = wtask >> 6, tn = wtask & 63; const int c = lane & 31, hi = lane >> 5;
    const bf16_t* ap = memn + (size_t)(tm * 32 + c) * DM + 8 * hi; const bf16_t* bp = wkv + (size_t)(tn * 32 + c) * DM + 8 * hi;
    f32x16 acc;
#pragma unroll
    for (int r = 0; r < 16; ++r) acc[r] = 0.f;
#pragma unroll 16
    for (int ks = 0; ks < 64; ++ks) { const bf16x8 a = *(const bf16x8*)(ap + 16 * ks), b = *(const bf16x8*)(bp + 16 * ks); acc = __builtin_amdgcn_mfma_f32_32x32x16_bf16(a, b, acc, 0, 0, 0); }
    bf16_t* o = kv + (size_t)(tm * 32) * 2048 + tn * 32 + c;
#pragma unroll
    for (int r = 0; r < 16; ++r) o[(size_t)crow(r, hi) * 2048] = (bf16_t)f2bf(acc[r]);
}
__device__ __forceinline__ void router_task(int wtask, int lane, const bf16_t* __restrict__ xn, const float* __restrict__ ss, const bf16_t* __restrict__ wr, const float* __restrict__ br,
                                            int (&oe)[4], float (&ow)[4]) {
    const int c = lane & 31, hi = lane >> 5; const int t = wtask * 32 + c;
    const bf16_t* ap = wr + (size_t)c * DM + 8 * hi; const bf16_t* bp = xn + (size_t)t * DM + 8 * hi;
    f32x16 acc;
#pragma unroll
    for (int r = 0; r < 16; ++r) acc[r] = 0.f;
#pragma unroll 16
    for (int ks = 0; ks < 64; ++ks) { const bf16x8 a = *(const bf16x8*)(ap + 16 * ks), b = *(const bf16x8*)(bp + 16 * ks); acc = __builtin_amdgcn_mfma_f32_32x32x16_bf16(a, b, acc, 0, 0, 0); }
    float v[16]; const float rstd = row_rstd(ss, t);
#pragma unroll
    for (int r = 0; r < 16; ++r) v[r] = acc[r] * rstd + br[crow(r, hi)];
    float tv[4]; int ti[4];
#pragma unroll
    for (int k = 0; k < 4; ++k) { float best = -INFINITY; int bi = 64;
#pragma unroll
        for (int r = 0; r < 16; ++r) { if (v[r] > best) { best = v[r]; bi = crow(r, hi); } }
        tv[k] = best; ti[k] = bi;
#pragma unroll
        for (int r = 0; r < 16; ++r) if (crow(r, hi) == bi) v[r] = -INFINITY; }
    float cv[8]; int ci[8];
#pragma unroll
    for (int k = 0; k < 4; ++k) { cv[k] = tv[k]; ci[k] = ti[k]; cv[4 + k] = __shfl_xor(tv[k], 32); ci[4 + k] = __shfl_xor(ti[k], 32); }
#pragma unroll
    for (int k = 0; k < 4; ++k) { float best = -INFINITY; int bi = 64;
#pragma unroll
        for (int q = 0; q < 8; ++q) { if (cv[q] > best || (cv[q] == best && ci[q] < bi)) { best = cv[q]; bi = ci[q]; } }
        tv[k] = best; ti[k] = bi;
#pragma unroll
        for (int q = 0; q < 8; ++q) if (ci[q] == bi) cv[q] = -INFINITY; }
    const float e1 = __expf(tv[1] - tv[0]), e2 = __expf(tv[2] - tv[0]), e3 = __expf(tv[3] - tv[0]); const float inv = 1.0f / (1.0f + e1 + e2 + e3);
    const float g[4] = {inv, e1 * inv, e2 * inv, e3 * inv};
#pragma unroll
    for (int k = 0; k < 4; ++k) { oe[k] = ti[k]; ow[k] = g[k]; }
}
__device__ __forceinline__ void combine_task(int t, int lane, const bf16_t* xin, float* xout, const unsigned char* __restrict__ ys, const int* tab, const int* __restrict__ toke, const int* __restrict__ tokr,
                                                 const float* __restrict__ tokw, const float* __restrict__ gfin) {
    const u32x2* xr = (const u32x2*)(xin + (size_t)t * DM) + lane; f32x4* xo = (f32x4*)(xout + (size_t)t * DM) + lane; f32x4 v[4];
#pragma unroll
    for (int j = 0; j < 4; ++j) { const u32x2 w = __builtin_nontemporal_load(xr + 64 * j); v[j] = (f32x4){bflo(w.x), bfhi(w.x), bflo(w.y), bfhi(w.y)}; }
    for (int k = 0; k < 4; ++k) { const int e = toke[t * 4 + k], r = tokr[t * 4 + k]; const float w = tokw[t * 4 + k]; const int start = tab[32 + e];
        const unsigned* yr = (const unsigned*)(ys + (size_t)(start + r) * DM) + lane;
#pragma unroll
        for (int j = 0; j < 4; ++j) { const int y = (int)__builtin_nontemporal_load(yr + 64 * j); const f32x2 lo = __builtin_amdgcn_cvt_pk_f32_fp8(y, false), hi = __builtin_amdgcn_cvt_pk_f32_fp8(y, true);
            v[j].x += w * lo.x; v[j].y += w * lo.y; v[j].z += w * hi.x; v[j].w += w * hi.y; } }
    float s = 0.f;
#pragma unroll
    for (int j = 0; j < 4; ++j) s += v[j].x * v[j].x + v[j].y * v[j].y + v[j].z * v[j].z + v[j].w * v[j].w;
    const float rstd = 1.0f / sqrtf(wave_sum(s) * (1.f / DM) + EPS);
#pragma unroll
    for (int j = 0; j < 4; ++j) { const f32x4 g = *((const f32x4*)gfin + lane + 64 * j); __builtin_nontemporal_store(v[j] * rstd * g, xo + 64 * j); }
}

#define GAS __attribute__((address_space(1)))
#define RLX_AGENT __ATOMIC_RELAXED, __HIP_MEMORY_SCOPE_AGENT
#define XB_TMO      128
#define XB_XCNT(j)  (256  + 64 * (j))
#define XB_XSUB(j)  (1280 + 64 * (j))
#define XB_XGEN(j)  (2304 + 64 * (j))
#define XB_TOP      3328
#define XB_TOPGEN   3392
#define XCD_BAR_WORDS 3456
#define XB_SPIN_CAP (1u << 18)
__device__ __forceinline__ unsigned xb_ld(unsigned* p)              { return __hip_atomic_load(p, __ATOMIC_RELAXED, __HIP_MEMORY_SCOPE_AGENT); }
__device__ __forceinline__ unsigned xb_add(unsigned* p, unsigned v) { return __hip_atomic_fetch_add(p, v, __ATOMIC_RELAXED, __HIP_MEMORY_SCOPE_AGENT); }
__device__ __forceinline__ unsigned xb_xcc_id() { return (unsigned)__builtin_amdgcn_s_getreg((3 << 11) | 20) & 0xFu; }
#define XB_SPIN(cond, bar) do { unsigned _sp = 0; while (cond) { __builtin_amdgcn_s_sleep(1); \
    if ((++_sp & 255u) == 0u) { if (xb_ld(&(bar)[XB_TMO])) break; if (_sp > XB_SPIN_CAP) { atomicAdd(&(bar)[XB_TMO], 1u); break; } } } } while (0)
struct XcdBarrier { unsigned* bar; unsigned x; volatile LDSP unsigned* st; };
__device__ __forceinline__ XcdBarrier xcd_barrier_post(unsigned* bar, volatile LDSP unsigned* st) {
    XcdBarrier b; b.bar = bar; b.x = xb_xcc_id(); b.st = st;
    if (threadIdx.x == 0) (void)xb_add(&bar[XB_XCNT(b.x)], 1u);
    return b;
}
__device__ __forceinline__ void xcd_barrier_complete(unsigned* bar, unsigned x, unsigned& nloc, unsigned& nx) {
    const unsigned G = gridDim.x * gridDim.y * gridDim.z;
    unsigned sum, cnt, mine, sp = 0u;
    for (;;) {
        sum = 0u; cnt = 0u; mine = 0u;
#pragma unroll
        for (unsigned j = 0; j < 16; ++j) { const unsigned c = xb_ld(&bar[XB_XCNT(j)]); sum += c; cnt += (c > 0u) ? 1u : 0u; mine = (j == x) ? c : mine; }
        if (sum == G) break;
        __builtin_amdgcn_s_sleep(1);
        if ((++sp & 255u) == 0u) { if (xb_ld(&bar[XB_TMO])) break; if (sp > XB_SPIN_CAP) { atomicAdd(&bar[XB_TMO], 1u); break; } }
    }
    nloc = mine > 0u ? mine : 1u; nx = cnt > 0u ? cnt : 1u;
}
__device__ __forceinline__ void xcd_barrier(const XcdBarrier& b) {
    asm volatile("s_waitcnt vmcnt(0)" ::: "memory");
    __syncthreads();
    if (threadIdx.x == 0) {
        unsigned* bar = b.bar;
        __builtin_amdgcn_s_waitcnt(0);
        unsigned nloc = b.st[0], nx = b.st[1];
        if (nloc == 0u) { xcd_barrier_complete(bar, b.x, nloc, nx); b.st[0] = nloc; b.st[1] = nx; }
        const unsigned old = xb_add(&bar[XB_XSUB(b.x)], 1u);
        const unsigned gen = old / nloc;
        if (old + 1u == (gen + 1u) * nloc) {
            __builtin_amdgcn_fence(__ATOMIC_RELEASE, "agent");
            asm volatile("s_waitcnt vmcnt(0)" ::: "memory");
            const unsigned og = xb_add(&bar[XB_TOP], 1u);
            const unsigned tg = og / nx;
            if (og + 1u == (tg + 1u) * nx) xb_add(&bar[XB_TOPGEN], 1u);
            else XB_SPIN(xb_ld(&bar[XB_TOPGEN]) == tg, bar);
            __builtin_amdgcn_fence(__ATOMIC_ACQUIRE, "agent");
            xb_add(&bar[XB_XGEN(b.x)], 1u);
            asm volatile("s_waitcnt vmcnt(0)" ::: "memory");
        } else {
            XB_SPIN(xb_ld(&bar[XB_XGEN(b.x)]) == gen, bar);
            __builtin_amdgcn_fence(__ATOMIC_ACQUIRE, "agent");
            asm volatile("s_waitcnt vmcnt(0)" ::: "memory");
        }
    }
    __syncthreads();
}

constexpr int LDS_BYTES = 147456;
constexpr int MISC_OFF = LDS_BYTES - 512;
constexpr int CW_BAR = 4096;
constexpr size_t CTL_ZERO_BYTES = 65536;
constexpr int NPHASE = 12;
struct Args { const float* in[22]; float* out; unsigned char* ws; int ph_lo, ph_hi; };

__global__ void __launch_bounds__(512, 2) mega(Args a) {
    extern __shared__ __attribute__((aligned(16))) unsigned char lds[];
    unsigned char* ws = a.ws; float* out = a.out;
    const float* x = a.in[0]; const float* mem = a.in[1]; const float* g_mix = a.in[2]; const float* w_in = a.in[3];
    const float* w_gla_gate = a.in[4]; const float* b_gla_gate = a.in[5]; const float* g_gla_head = a.in[6]; const float* w_out = a.in[7];
    const float* g_mem_q = a.in[8]; const float* g_mem_kv = a.in[9]; const float* w_mq = a.in[10]; const float* w_mk = a.in[11];
    const float* w_mv = a.in[12]; const float* w_mo = a.in[13]; const float* g_ffn = a.in[14]; const float* w_router = a.in[15];
    const float* b_router = a.in[16]; const float* w_gu = a.in[17]; const float* b_gu = a.in[18]; const float* w_down = a.in[19];
    const float* b_down = a.in[20]; const float* g_final = a.in[21];
    bf16_t* Wt_in = (bf16_t*)(ws + WS_WIN); bf16_t* Wt_out = (bf16_t*)(ws + WS_WOUT); bf16_t* Wq = (bf16_t*)(ws + WS_WQ); bf16_t* Wt_kv = (bf16_t*)(ws + WS_WKV);
    bf16_t* Wt_mo = (bf16_t*)(ws + WS_WMO); bf16_t* Wt_r = (bf16_t*)(ws + WS_WR); bf16_t* Wt_gu = (bf16_t*)(ws + WS_WGU); bf16_t* Wt_dn = (bf16_t*)(ws + WS_WDN);
    bf16_t* xn = (bf16_t*)(ws + WS_XN); bf16_t* memn = (bf16_t*)(ws + WS_MEMN); bf16_t* kv = (bf16_t*)(ws + WS_KV); bf16_t* Bs = (bf16_t*)(ws + WS_BS); bf16_t* Bo = (bf16_t*)(ws + WS_BO);
    bf16_t* proj = (bf16_t*)(ws + WS_PROJ); bf16_t* mix = (bf16_t*)(ws + WS_MIX);
    float* Sc = (float*)(ws + WS_S); bf16_t* P = (bf16_t*)(ws + WS_P); float* lg = (float*)(ws + WS_LG); int* toke = (int*)(ws + WS_TOKE); int* tokr = (int*)(ws + WS_TOKR);
    float* tokw = (float*)(ws + WS_TOKW); int* list = (int*)(ws + WS_LIST); unsigned char* ys = ws + WS_YS;
    unsigned char* Wq_gu = ws + WS_WGU; unsigned char* Wq_dn = ws + WS_WDN; unsigned char* x2q = ws + WS_S; unsigned char* act8 = ws + WS_ACT;
    float* lrs = (float*)(ws + WS_LG);
    float* UT = (float*)(ws + WS_S); float* decay = (float*)(ws + WS_LA); bf16_t* ST = (bf16_t*)(ws + WS_ORAW);
    unsigned* ctl = (unsigned*)(ws + WS_CTL); int* cnt = (int*)ctl + CW_CNT; float* ss1 = (float*)(ws + WS_LA + 8 * MiB); float* ss2 = (float*)(ws + WS_LA + 9 * MiB);

    const int G = gridDim.x, vb = blockIdx.x;
    volatile LDSP unsigned* MISC = (volatile LDSP unsigned*)(unsigned)(uintptr_t)(lds + MISC_OFF);
    if (threadIdx.x < 128) MISC[threadIdx.x] = 0u;
    __syncthreads();
    XcdBarrier bar = xcd_barrier_post(ctl + CW_BAR, MISC + 8);
    const int lo = a.ph_lo, hi = a.ph_hi;
    float* dmy = (float*)(ws + WS_DUMMY); (void)dmy;
#ifndef REPEAT_MASK
#define REPEAT_MASK 0
#endif
#define IN(k) (lo <= (k) && (k) < hi)
#define REP(k) for (int rep_ = 0; rep_ < 1 + ((REPEAT_MASK >> (k)) & 1); ++rep_)
#define SEAM(k) do { if (IN(k) && IN((k) + 1)) xcd_barrier(bar); } while (0)
#define TIDS() int tid = threadIdx.x; LAUNDER(tid); const int lane = tid & 63; const int wid = __builtin_amdgcn_readfirstlane(tid >> 6); (void)lane; (void)wid

    if (IN(0)) REP(0) { TIDS(); const size_t gt = (size_t)vb * 512 + tid, gs = (size_t)G * 512;
        float* scr = (float*)(lds + wid * 8448);
        const int gw = vb * 8 + wid, ngw = G * 8;
        rms_body(gw, ngw, lane, x, xn, NTOK);
        rms_body(gw, ngw, lane, mem, memn, NB * MEML);
        conv_n_body(gt, gs, w_mq, Wq, g_mem_q, 1024, 1024, LOG2E / 16.0f);
        constexpr int I_IN = 16 * 97, I_SQ = 16 * 32, I_R = 16, I_GU = 32 * 16 * 64, I_DN = 32 * 16 * 32;
        constexpr int NITEMS = I_IN + 4 * I_SQ + I_R + I_GU + I_DN;
        for (int it = gw; it < NITEMS; it += ngw) { int r = it;
            if (r < I_IN) { conv_item<1>(scr, w_in, Wt_in, g_mix, 3088, 1024, 3088, r / 97, r % 97, lane); continue; } r -= I_IN;
            if (r < I_SQ) { conv_item<0>(scr, w_out, Wt_out, nullptr, 1024, 1024, 1024, r >> 5, r & 31, lane); continue; } r -= I_SQ;
            if (r < I_SQ) { conv_item<0>(scr, w_mk, Wt_kv, g_mem_kv, 1024, 1024, 1024, r >> 5, r & 31, lane); continue; } r -= I_SQ;
            if (r < I_SQ) { conv_item<0>(scr, w_mv, Wt_kv + (size_t)1024 * 1024, g_mem_kv, 1024, 1024, 1024, r >> 5, r & 31, lane); continue; } r -= I_SQ;
            if (r < I_SQ) { conv_item<0>(scr, w_mo, Wt_mo, nullptr, 1024, 1024, 1024, r >> 5, r & 31, lane); continue; } r -= I_SQ;
            if (r < I_R) { conv_item<0>(scr, w_router, Wt_r, g_ffn, 32, 1024, 32, r, 0, lane); continue; } r -= I_R;
            if (r < I_GU) { const int e = r >> 10, q = r & 1023; conv_item8<2>(scr, w_gu + (size_t)e * 1024 * 2048, Wq_gu + (size_t)e * 2048 * 1024, g_ffn, 2048, 1024, 2048, q >> 6, q & 63, lane, (float)(1 << WSCALE_LOG2)); continue; } r -= I_GU;
            { const int e = r >> 9, q = r & 511; conv_item8<0>(scr, w_down + (size_t)e * 1024 * 1024, Wq_dn + (size_t)e * 1024 * 1024, nullptr, 1024, 1024, 1024, q >> 5, q & 31, lane, (float)(1 << WSCALE_LOG2)); } }
        __syncthreads(); }
    SEAM(0);
    if (IN(1)) REP(1) { DenseSched S{(const char*)xn, (const char*)Wt_in, 2048u, 2048u, 1024, 64, 12, 1 << 30, 0, G, vb}; EpiBf16 E{proj, PROJ_LD, 0}; gemm_run<true>(lds, S, E); }
    SEAM(1);
    if (IN(2)) REP(2) {
        for (int t = vb; t < 256; t += G) gla_pass_a(lds, t, xn, Wt_in + (size_t)3072 * 1024, proj, w_gla_gate, b_gla_gate, UT, decay);
        { TIDS(); for (int t = vb * 8 + wid; t < 4096; t += G * 8) sb_task(lds + wid * 4096, t, proj, mix, lane); }
        { TIDS(); for (int t = vb + G * wid; t < 1024; t += G * 8) memkv_task(t, lane, memn, Wt_kv, kv); } }
    SEAM(2);
    if (IN(3)) REP(3) {
        { TIDS(); for (int e = vb * 512 + tid; e < 65536; e += G * 512) gla_pass_b(e, UT, decay, ST); }
        { SchedWqk S{(const char*)kv, (const char*)Wq, 4096u, 2048u, 256, G / 2, vb - G / 2, 0}; EpiBf16 E{Bs, 1024, 0}; gemm_run<false>(lds, S, E); }
        { SchedVo S{(const char*)Wt_mo, (const char*)kv, 2048u, 4096u, 256, G / 2, vb - G / 2 - 32, 0}; EpiBf16 E{Bo, 1024, 0}; gemm_run<false>(lds, S, E); } }
    SEAM(3);
    if (IN(4)) REP(4) { TIDS(); for (int t = vb * 8 + wid; t < 2048; t += G * 8) gla_pass_c(lds + wid * 32 * GC_PITCH, t, ST, proj, g_gla_head, mix, lane); }
    SEAM(4);
#if PROBE_BARRIERS
    for (int pb_ = 0; pb_ < 8; ++pb_) xcd_barrier(bar);
#endif
    if (IN(5)) REP(5) { DenseSched S{(const char*)mix, (const char*)Wt_out, 2048u, 2048u, 1024, 64, 4, 1 << 30, 0, G, vb}; EpiResidSS<false> E{x, rep_ ? (bf16_t*)dmy : xn, rep_ ? dmy + 16 * 1024 * 1024 : ss1, nullptr}; gemm_run<false>(lds, S, E); }
    SEAM(5);
    if (IN(6)) REP(6) { DenseSched S{(const char*)xn, (const char*)Bs, 2048u, 2048u, 1024, 64, 4, 32, (size_t)1024 * 2048, G, vb}; EpiSoftmax E{ss1, P}; gemm_run<false>(lds, S, E); }
    SEAM(6);
    if (IN(7)) REP(7) { DenseSched S{(const char*)P, (const char*)Bo, 2048u, 2048u, 1024, 64, 4, 32, (size_t)1024 * 2048, G, vb}; EpiResidSS<true> E{xn, rep_ ? (bf16_t*)dmy : xn, rep_ ? dmy + 16 * 1024 * 1024 : ss2, rep_ ? (unsigned char*)dmy + 40 * 1024 * 1024 : x2q}; gemm_run<false>(lds, S, E); }
    SEAM(7);
    if (IN(8)) REP(8) { TIDS(); int* cntp = rep_ ? (int*)ctl + 2048 : cnt; int* listp = rep_ ? (int*)dmy + 1024 : list; float* lrsp = rep_ ? dmy + 4096 * 1024 : lrs; int* tokep = rep_ ? (int*)dmy + 1024 * 1024 : toke; int* tokrp = rep_ ? (int*)dmy + 2048 * 1024 : tokr; float* tokwp = rep_ ? dmy + 3072 * 1024 : tokw;
        int* lcnt = (int*)lds; int* gbase = (int*)lds + 32;
        for (int tb = vb; tb < NTOK / 64; tb += G) {
            if (tid < 32) lcnt[tid] = 0;
            __syncthreads();
            int oe[4] = {0, 0, 0, 0}; float ow[4] = {0.f, 0.f, 0.f, 0.f}; int lr[4] = {0, 0, 0, 0};
            if (wid < 2) { router_task(tb * 2 + wid, lane, xn, ss2, Wt_r, b_router, oe, ow);
                if (lane < 32) {
#pragma unroll
                    for (int k = 0; k < 4; ++k) lr[k] = atomicAdd(&lcnt[oe[k]], 1); } }
            __syncthreads();
            if (tid < 32) gbase[tid] = atomicAdd(&cntp[tid * 32], lcnt[tid]);
            __syncthreads();
            if (wid < 2 && lane < 32) { const int t = (tb * 2 + wid) * 32 + lane;
                const float rstd_t = row_rstd(ss2, t);
#pragma unroll
                for (int k = 0; k < 4; ++k) { const int r = gbase[oe[k]] + lr[k]; listp[oe[k] * NTOK + r] = t; lrsp[oe[k] * NTOK + r] = rstd_t; tokep[t * 4 + k] = oe[k]; tokrp[t * 4 + k] = r; tokwp[t * 4 + k] = ow[k]; } }
            __syncthreads(); } }
    SEAM(8);
    if (IN(9)) REP(9) { int* tab = (int*)(lds + 131072); { TIDS(); moe_build_table(tab, cnt, tid); }
        MoeSched<true> S{(const char*)x2q, (const char*)Wq_gu, 1024u, 1024u, 512, 8, (size_t)2048 * 1024, tab, list, 1, G, vb, 0}; EpiGU E{b_gu, act8, lrs}; gemm_run_fp8<true>(lds, S, E); }
    SEAM(9);
    if (IN(10)) REP(10) { int* tab = (int*)(lds + 131072); { TIDS(); moe_build_table(tab, cnt, tid); }
        MoeSched<false> S{(const char*)act8, (const char*)Wq_dn, 1024u, 1024u, 512, 4, (size_t)1024 * 1024, tab, list, 0, G, vb, 0}; EpiDown E{b_down, ys}; gemm_run_fp8<true>(lds, S, E); }
    SEAM(10);
    if (IN(11)) REP(11) { TIDS(); int* tab = (int*)(lds + 131072); moe_build_table(tab, cnt, tid);
        for (int t = vb * 8 + wid; t < NTOK; t += G * 8) combine_task(t, lane, xn, rep_ ? dmy : out, ys, tab, toke, tokr, tokw, g_final); }
#undef IN
#undef SEAM
#undef TIDS
}

#ifndef MK_PER_PHASE
#define MK_PER_PHASE 0
#endif
extern "C" void kernel_launch(void* const* d_in, const int* in_sizes, int n_in, void* d_out, int out_size, void* d_ws, size_t ws_size, hipStream_t stream) {
    static int grid = 0;
    if (grid == 0) {
        if (n_in != 22 || in_sizes[0] != NTOK * DM || out_size != NTOK * DM || ws_size < WS_END) { fprintf(stderr, "kernel_launch: unexpected shapes (n_in %d, ws %zu)\n", n_in, ws_size); grid = -1; return; }
        int dev = 0, cus = 0, per_cu = 0;
        if (hipGetDevice(&dev) != hipSuccess || hipDeviceGetAttribute(&cus, hipDeviceAttributeMultiprocessorCount, dev) != hipSuccess) { grid = -1; return; }
        if (hipFuncSetAttribute((const void*)mega, hipFuncAttributeMaxDynamicSharedMemorySize, LDS_BYTES) != hipSuccess) { fprintf(stderr, "kernel_launch: hipFuncSetAttribute failed\n"); grid = -1; return; }
        if (hipOccupancyMaxActiveBlocksPerMultiprocessor(&per_cu, (const void*)mega, 512, LDS_BYTES) != hipSuccess || per_cu < 1) fprintf(stderr, "kernel_launch: occupancy query says %d blocks/CU\n", per_cu);
        (void)hipGetLastError();
        grid = cus;
    }
    if (grid < 0) return;
    (void)hipMemsetAsync((char*)d_ws + WS_CTL, 0, CTL_ZERO_BYTES, stream);
    Args a{};
    for (int i = 0; i < 22; ++i) a.in[i] = (const float*)d_in[i];
    a.out = (float*)d_out; a.ws = (unsigned char*)d_ws;
#if MK_PER_PHASE
    for (int p = 0; p < NPHASE; ++p) { a.ph_lo = p; a.ph_hi = p + 1; hipLaunchKernelGGL(mega, dim3(grid), dim3(512), LDS_BYTES, stream, a); }
#else
    a.ph_lo = 0; a.ph_hi = NPHASE; hipLaunchKernelGGL(mega, dim3(grid), dim3(512), LDS_BYTES, stream, a);
#endif
}
```

```cpp
#include <hip/hip_runtime.h>
#include <cstdio>
#include <cstdint>
#ifndef PROBE_BARRIERS
#define PROBE_BARRIERS 0
#endif

typedef unsigned short bf16_t;
typedef short bf16x8 __attribute__((ext_vector_type(8)));
typedef float f32x4 __attribute__((ext_vector_type(4)));
typedef unsigned u32x4 __attribute__((ext_vector_type(4)));
typedef unsigned u32x2 __attribute__((ext_vector_type(2)));
typedef float f32x2 __attribute__((ext_vector_type(2)));
#define LDSP __attribute__((address_space(3)))
#define LAUNDER(x) asm volatile("" : "+v"(x))

constexpr int NB = 2, SEQ = 8192, NTOK = NB * SEQ, DM = 1024, MEML = 256;
constexpr int NEXP = 32, TOPK = 4, NASSIGN = NTOK * TOPK;
constexpr int PROJ_LD = 3072;
constexpr int C_QG = 0, C_KG = 256, C_VG = 512, C_RG = 1024, C_QS = 1536, C_KS = 2048, C_VS = 2560, C_GLR = 3072;
constexpr float LOG2E = 1.4426950408889634f;
constexpr float EPS = 1e-5f;

__device__ __forceinline__ unsigned f2bf(float f) { unsigned u = __float_as_uint(f); return (u + 0x7fffu + ((u >> 16) & 1u)) >> 16; }
__device__ __forceinline__ unsigned pk2(float lo, float hi) { return f2bf(lo) | (f2bf(hi) << 16); }
__device__ __forceinline__ float bf2f(bf16_t h) { return __uint_as_float(((unsigned)h) << 16); }
__device__ __forceinline__ float bflo(unsigned w) { return __uint_as_float(w << 16); }
__device__ __forceinline__ float bfhi(unsigned w) { return __uint_as_float(w & 0xffff0000u); }

constexpr size_t MiB = 1u << 20;
constexpr size_t WS_CTL = 0;
constexpr size_t WS_WIN = 1 * MiB;
constexpr size_t WS_WOUT = 8 * MiB;
constexpr size_t WS_WQ = 10 * MiB;
constexpr size_t WS_WKV = 12 * MiB;
constexpr size_t WS_WMO = 16 * MiB;
constexpr size_t WS_WR = 18 * MiB;
constexpr size_t WS_WGU = 20 * MiB;
constexpr size_t WS_WDN = 148 * MiB;
constexpr size_t WS_XN = 212 * MiB;
constexpr size_t WS_MEMN = 244 * MiB;
constexpr size_t WS_KV = 245 * MiB;
constexpr size_t WS_BS = 247 * MiB;
constexpr size_t WS_BO = 251 * MiB;
constexpr size_t WS_PROJ = 256 * MiB;
constexpr size_t WS_LA = 360 * MiB;
constexpr size_t WS_ORAW = 376 * MiB;
constexpr size_t WS_MIX = 408 * MiB;
constexpr size_t WS_S = 440 * MiB;
constexpr size_t WS_P = 504 * MiB;
constexpr size_t WS_LG = 536 * MiB;
constexpr size_t WS_TOKE = 538 * MiB;
constexpr size_t WS_TOKR = 539 * MiB;
constexpr size_t WS_TOKW = 540 * MiB;
constexpr size_t WS_LIST = 541 * MiB;
constexpr size_t WS_ACT = 544 * MiB;
constexpr size_t WS_YS = 674 * MiB;
constexpr size_t WS_DUMMY = 804 * MiB;
constexpr size_t WS_END = 872 * MiB;
constexpr int CW_CNT = 1024;

template <int MAP> __device__ __forceinline__ int srccol(int n, float& sc) {
    sc = 1.f;
    if (MAP == 0) return n;
    if (MAP == 1) {
        if (n < 256) { sc = 0.125f; return n; }
        if (n < 1024) return n;
        if (n < 3072) { if (n >= C_QS && n < C_KS) sc = 0.125f * LOG2E; return n + 16; }
        if (n < 3088) return 1024 + (n - 3072);
        return -1;
    }
    { const int ct = n >> 8, w = n & 255; return (w < 128) ? (128 * ct + w) : (1024 + 128 * ct + (w - 128)); }
}
template <int MAP>
__device__ __forceinline__ void conv_item(float* scr, const float* __restrict__ src, bf16_t* __restrict__ dst, const float* __restrict__ gain, int ldsrc, int K, int nrows, int kb, int nb, int lane) {
    const int k0 = kb * 64, n0 = nb * 32; float sc; const int c0 = srccol<MAP>(n0, sc);
    const int half = lane >> 5, l31 = lane & 31;
    const float* s0 = src + (size_t)(k0 + half) * ldsrc + c0 + l31;
    float v[32];
#pragma unroll
    for (int i = 0; i < 32; ++i) v[i] = __builtin_nontemporal_load(s0 + (size_t)(2 * i) * ldsrc);
#pragma unroll
    for (int i = 0; i < 32; ++i) { const int kk = 2 * i + half; const float g = (gain ? gain[k0 + kk] : 1.f) * sc; scr[kk * 33 + l31] = v[i] * g; }
    asm volatile("s_waitcnt lgkmcnt(0)" ::: "memory");
    const int c = lane & 7;
#pragma unroll
    for (int j = 0; j < 4; ++j) { const int n = (lane >> 3) + 8 * j; const float* s = scr + (8 * c) * 33 + n;
        u32x4 o; o.x = pk2(s[0 * 33], s[1 * 33]); o.y = pk2(s[2 * 33], s[3 * 33]); o.z = pk2(s[4 * 33], s[5 * 33]); o.w = pk2(s[6 * 33], s[7 * 33]);
        if (n0 + n < nrows) *(u32x4*)(dst + (size_t)(n0 + n) * K + k0 + 8 * c) = o; }
    asm volatile("s_waitcnt lgkmcnt(0)" ::: "memory");
}
__device__ __forceinline__ unsigned pk4_fp8(float a, float b, float c, float d) { int w = __builtin_amdgcn_cvt_pk_fp8_f32(a, b, 0, false); w = __builtin_amdgcn_cvt_pk_fp8_f32(c, d, w, true); return (unsigned)w; }
template <int MAP>
__device__ __forceinline__ void conv_item8(float* scr, const float* __restrict__ src, unsigned char* __restrict__ dst, const float* __restrict__ gain, int ldsrc, int K, int nrows, int kb, int nb, int lane, float mul) {
    const int k0 = kb * 64, n0 = nb * 32; float sc; const int c0 = srccol<MAP>(n0, sc); sc *= mul;
    const int half = lane >> 5, l31 = lane & 31;
    const float* s0 = src + (size_t)(k0 + half) * ldsrc + c0 + l31;
    float v[32];
#pragma unroll
    for (int i = 0; i < 32; ++i) v[i] = __builtin_nontemporal_load(s0 + (size_t)(2 * i) * ldsrc);
#pragma unroll
    for (int i = 0; i < 32; ++i) { const int kk = 2 * i + half; const float g = (gain ? gain[k0 + kk] : 1.f) * sc; scr[kk * 33 + l31] = v[i] * g; }
    asm volatile("s_waitcnt lgkmcnt(0)" ::: "memory");
    const int c = lane & 3;
#pragma unroll
    for (int j = 0; j < 2; ++j) { const int n = (lane >> 2) + 16 * j; const float* s = scr + (16 * c) * 33 + n;
        u32x4 o; o.x = pk4_fp8(s[0 * 33], s[1 * 33], s[2 * 33], s[3 * 33]); o.y = pk4_fp8(s[4 * 33], s[5 * 33], s[6 * 33], s[7 * 33]);
        o.z = pk4_fp8(s[8 * 33], s[9 * 33], s[10 * 33], s[11 * 33]); o.w = pk4_fp8(s[12 * 33], s[13 * 33], s[14 * 33], s[15 * 33]);
        if (n0 + n < nrows) __builtin_nontemporal_store(o, (u32x4*)(dst + (size_t)(n0 + n) * K + k0 + 16 * c)); }
    asm volatile("s_waitcnt lgkmcnt(0)" ::: "memory");
}
__device__ __forceinline__ void conv_n_body(size_t gtid, size_t gsz, const float* __restrict__ src, bf16_t* __restrict__ dst, const float* __restrict__ gain, int K, int nrows, float sc) {
    const int kc8 = K / 8; const size_t total = (size_t)nrows * kc8;
    for (size_t idx = gtid; idx < total; idx += gsz) {
        const int kc = (int)(idx % kc8), n = (int)(idx / kc8);
        const float g = gain[n] * sc; const f32x4 a = __builtin_nontemporal_load((const f32x4*)(src + (size_t)n * K + kc * 8)), b = __builtin_nontemporal_load((const f32x4*)(src + (size_t)n * K + kc * 8 + 4));
        u32x4 o; o.x = pk2(a.x * g, a.y * g); o.y = pk2(a.z * g, a.w * g); o.z = pk2(b.x * g, b.y * g); o.w = pk2(b.z * g, b.w * g);
        *(u32x4*)(dst + (size_t)n * K + kc * 8) = o;
    }
}

__device__ __forceinline__ float wave_sum(float v) {
#pragma unroll
    for (int o = 1; o < 64; o <<= 1) v += __shfl_xor(v, o);
    return v;
}
__device__ __forceinline__ void rms_body(int gw, int ngw, int lane, const float* __restrict__ x, bf16_t* __restrict__ out, int nrows) {
    for (int row = gw; row < nrows; row += ngw) {
        const f32x4* xr = (const f32x4*)(x + (size_t)row * DM) + lane; f32x4 v[4]; float s = 0.f;
#pragma unroll
        for (int j = 0; j < 4; ++j) { v[j] = __builtin_nontemporal_load(xr + 64 * j); s += v[j].x * v[j].x + v[j].y * v[j].y + v[j].z * v[j].z + v[j].w * v[j].w; }
        const float rstd = 1.0f / sqrtf(wave_sum(s) * (1.f / DM) + EPS);
        u32x2* o = (u32x2*)(out + (size_t)row * DM) + lane;
#pragma unroll
        for (int j = 0; j < 4; ++j) { u32x2 w; w.x = pk2(v[j].x * rstd, v[j].y * rstd); w.y = pk2(v[j].z * rstd, v[j].w * rstd); o[64 * j] = w; }
    }
}

constexpr int CH_GU = 32 * 64 * 64;
constexpr int CH_TOTAL = CH_GU + 32 * 32 * 64;
typedef unsigned v2u __attribute__((ext_vector_type(2)));
struct ConvHost { const float* src; unsigned char* ws; int h, nW, hi; unsigned dX, dY; };
template <bool GU> __device__ __forceinline__ void ch_decode(int h, unsigned& soff, unsigned& doff) {
    if (GU) { const unsigned e = (unsigned)h >> 12, nb = ((unsigned)h >> 6) & 63u, k16 = (unsigned)h & 63u;
        soff = (e << 23) | (k16 << 17) | ((nb & 4u) << 10) | ((nb >> 3) << 9) | ((nb & 3u) << 7);
        doff = (unsigned)WS_WGU + (e << 21) + (nb << 15) + (k16 << 4); }
    else { const unsigned hh = (unsigned)(h - CH_GU), e = hh >> 11, nb = (hh >> 6) & 31u, k16 = hh & 63u;
        soff = (e << 22) | (k16 << 16) | (nb << 7);
        doff = (unsigned)WS_WDN + (e << 20) + (nb << 15) + (k16 << 4); }
}
template <bool GU> __device__ __forceinline__ void ch_issue(ConvHost& H, unsigned& dslot, float (&cv)[8], int j0, int j1, unsigned voffL) {
    constexpr unsigned LD4 = GU ? 8192u : 4096u;
    const int hn = __builtin_amdgcn_readfirstlane(H.h); const bool ok = hn < H.hi; const int h = ok ? hn : H.hi - 1;
    unsigned soff, doff; ch_decode<GU>(h, soff, doff);
    const __amdgpu_buffer_rsrc_t r = __builtin_amdgcn_make_buffer_rsrc((void*)H.src, 0, 0x7fffffff, 0x00020000);
#pragma unroll
    for (int j = j0; j < j1; ++j) cv[j] = __builtin_bit_cast(float, __builtin_amdgcn_raw_buffer_load_b32(r, (int)voffL, (int)(soff + (unsigned)j * LD4), 2));
    if (j0 == 0) dslot = ok ? doff : (unsigned)WS_DUMMY;
    if (j1 == 8) H.h = hn + H.nW;
}
__device__ __forceinline__ void ch_finish(const ConvHost& H, unsigned dslot, const float (&cv)[8], unsigned voffS) {
    constexpr float SC = (float)(1 << 6);
    v2u o; o.x = pk4_fp8(cv[0] * SC, cv[1] * SC, cv[2] * SC, cv[3] * SC); o.y = pk4_fp8(cv[4] * SC, cv[5] * SC, cv[6] * SC, cv[7] * SC);
    const __amdgpu_buffer_rsrc_t w = __builtin_amdgcn_make_buffer_rsrc((void*)H.ws, 0, 0x7fffffff, 0x00020000);
    __builtin_amdgcn_raw_buffer_store_b64(o, w, (int)voffS, (int)dslot, 0);
}

struct GUnit { unsigned ao, bo; int row0, col0, e, valid, aux; };

__host__ __device__ __forceinline__ int lds_byte(int r, int c) { const int st = (r >> 4) * 2 + (c >> 5), rr = r & 15, cc = c & 31, ob = rr * 64 + cc * 2; return st * 1024 + (ob ^ (((ob >> 9) & 1) << 5)); }
__host__ __device__ __forceinline__ void stage_rc(int b, int& R, int& C) { const int st = b / 1024, sb = b % 1024, swz = sb ^ (((sb >> 9) & 1) << 5); R = (st >> 1) * 16 + swz / 64; C = (st & 1) * 32 + (swz % 64) / 2; }
__host__ __device__ __forceinline__ int perm32(int rho) { const int n = rho >> 4, i = rho & 15; return 8 * (i >> 2) + 4 * n + (i & 3); }
constexpr int HTB = 128 * 64 * 2;
typedef int v8i __attribute__((ext_vector_type(8)));
typedef int v4i __attribute__((ext_vector_type(4)));
struct Frag2 { bf16x8 h[2]; };
template <bool F> struct FragT { typedef Frag2 T; };
template <> struct FragT<true> { typedef v8i T; };
template <class Sched, class Epi, bool ALIGN_EPI, bool FP8 = false, int SCALE_B = 0x7f, int HOSTM = 0>
__device__ __forceinline__ void gemm_phase(unsigned char* lds_flat, const Sched& S, const Epi& E, ConvHost& H) {
    LDSP unsigned char* lds = (LDSP unsigned char*)(unsigned)(uintptr_t)lds_flat;
    int tid = threadIdx.x; LAUNDER(tid);
    const int wid = __builtin_amdgcn_readfirstlane(tid >> 6), lane = tid & 63, wr = wid >> 2, wc = wid & 3, fr = lane & 15, fq = lane >> 4;
    const int nt = S.K / 64;
    int Rr[2], Cc[2];
#pragma unroll
    for (int i = 0; i < 2; ++i) stage_rc(tid * 16 + i * 8192, Rr[i], Cc[i]);
    unsigned voffB[2][2];
#pragma unroll
    for (int h = 0; h < 2; ++h)
#pragma unroll
        for (int i = 0; i < 2; ++i) voffB[h][i] = (unsigned)(128 * h + (Rr[i] & ~31) + perm32(Rr[i] & 31)) * S.ldb + (unsigned)Cc[i] * 2u;
    const unsigned ldsw = (unsigned)wid * 1024u;
    constexpr bool HOST = HOSTM != 0, HGU = HOSTM == 1;
    const int aoff = lds_byte(wr * 64 + fr, fq * 8), boff = lds_byte(wc * 32 + fr, fq * 8);
    constexpr int KSUB = 1024;
#define PG8_SA(b, h) (((b) * 2 + (h)) * HTB)
#define PG8_SB(b, h) ((4 + (b) * 2 + (h)) * HTB)
#define PG8_STAGE(bufoff, rsrc, voff, soff) do { _Pragma("unroll") for (int _i = 0; _i < 2; ++_i) \
        __builtin_amdgcn_raw_ptr_buffer_load_lds(rsrc, (LDSP unsigned*)(lds + (bufoff) + ldsw + _i * 8192), 16, (int)(voff)[_i], (int)(soff), 0, 0); } while (0)
#define PG8_LDF(dst, addr) do { const bf16x8 lo_ = *(const LDSP bf16x8*)(addr); const bf16x8 hi_ = *(const LDSP bf16x8*)((addr) + KSUB); \
        if constexpr (FP8) dst = __builtin_shufflevector(__builtin_bit_cast(v4i, lo_), __builtin_bit_cast(v4i, hi_), 0, 1, 2, 3, 4, 5, 6, 7); else { dst.h[0] = lo_; dst.h[1] = hi_; } } while (0)
#define PG8_LDA(dst, b, h) do { _Pragma("unroll") for (int m = 0; m < 4; ++m) PG8_LDF(dst[m], lds + PG8_SA(b, h) + aoff + m * 2048); } while (0)
#define PG8_LDB(dst, b, h) do { _Pragma("unroll") for (int n = 0; n < 2; ++n) PG8_LDF(dst[n], lds + PG8_SB(b, h) + boff + n * 2048); } while (0)
#define PG8_MMA(ai, bj, At, Bt) do { __builtin_amdgcn_s_setprio(1); _Pragma("unroll") for (int m = 0; m < 4; ++m) _Pragma("unroll") for (int n = 0; n < 2; ++n) { \
        if constexpr (FP8) asm volatile("v_mfma_scale_f32_16x16x128_f8f6f4 %0, %1, %2, %0, %3, %4 op_sel_hi:[0,0,0]" : "+v"(acc[ai][bj][m][n]) : "v"(Bt[n]), "v"(At[m]), "v"(sclB), "v"(sclA)); \
        else { _Pragma("unroll") for (int k = 0; k < 2; ++k) acc[ai][bj][m][n] = __builtin_amdgcn_mfma_f32_16x16x32_bf16(Bt[n].h[k], At[m].h[k], acc[ai][bj][m][n], 0, 0, 0); } } \
        __builtin_amdgcn_s_setprio(0); } while (0)
#define PG8_MMA_M(ai, bj, m, At, Bt) do { _Pragma("unroll") for (int n = 0; n < 2; ++n) _Pragma("unroll") for (int k = 0; k < 2; ++k) \
        acc[ai][bj][m][n] = __builtin_amdgcn_mfma_f32_16x16x32_bf16(Bt[n].h[k], At[m].h[k], acc[ai][bj][m][n], 0, 0, 0); } while (0)
#define PG8_MMA_H(cv, dsl) do { if constexpr (!FP8) { __builtin_amdgcn_s_setprio(1); \
        PG8_MMA_M(0, 0, 0, At, B0); PG8_SCHED; ch_finish(H, dsl, cv, voffS); PG8_SCHED; \
        PG8_MMA_M(0, 0, 1, At, B0); PG8_MMA_M(0, 0, 2, At, B0); PG8_SCHED; ch_issue<HGU>(H, dsl, cv, 0, 4, voffL); PG8_SCHED; \
        PG8_MMA_M(0, 0, 3, At, B0); PG8_MMA_M(0, 1, 0, At, B1); PG8_SCHED; ch_issue<HGU>(H, dsl, cv, 4, 8, voffL); PG8_SCHED; \
        PG8_MMA_M(0, 1, 1, At, B1); PG8_MMA_M(0, 1, 2, At, B1); PG8_MMA_M(0, 1, 3, At, B1); __builtin_amdgcn_s_setprio(0); } } while (0)
#define PG8_WAIT_V(n) asm volatile("s_waitcnt vmcnt(" #n ")" ::: "memory")
#define PG8_WAIT_L(n) asm volatile("s_waitcnt lgkmcnt(" #n ")" ::: "memory")
#define PG8_BAR __builtin_amdgcn_s_barrier()
#define PG8_SCHED __builtin_amdgcn_sched_barrier(0)
    GUnit cur, nxt; int ui = 0;
    float cvx[8], cvy[8]; unsigned voffL = 0, voffS = 0; (void)voffL; (void)voffS;
    if constexpr (HOST) { voffL = (unsigned)(lane >> 5) * 8u * (HGU ? 8192u : 4096u) + (unsigned)(lane & 31) * 4u; voffS = (unsigned)(lane & 31) * 1024u + (unsigned)(lane >> 5) * 8u;
#pragma unroll
        for (int i = 0; i < 8; ++i) { cvx[i] = 0.f; cvy[i] = 0.f; }
        H.dX = (unsigned)WS_DUMMY; H.dY = (unsigned)WS_DUMMY; }
    if (S.next(0, cur)) {
    const __amdgpu_buffer_rsrc_t rA = __builtin_amdgcn_make_buffer_rsrc((void*)S.A, 0, 0x7fffffff, 0x00020000);
    const __amdgpu_buffer_rsrc_t rB = __builtin_amdgcn_make_buffer_rsrc((void*)S.Bt, 0, 0x7fffffff, 0x00020000);
    unsigned oc[2][2], on[2][2];
#pragma unroll
    for (int h = 0; h < 2; ++h)
#pragma unroll
        for (int i = 0; i < 2; ++i) oc[h][i] = S.a_off(cur, 128 * h + Rr[i]) + (unsigned)Cc[i] * 2u;
    f32x4 acc[2][2][4][2];
#pragma unroll
    for (int a = 0; a < 2; ++a)
#pragma unroll
        for (int b = 0; b < 2; ++b)
#pragma unroll
            for (int m = 0; m < 4; ++m)
#pragma unroll
                for (int n = 0; n < 2; ++n) acc[a][b][m][n] = (f32x4){0.f, 0.f, 0.f, 0.f};
    typedef typename FragT<FP8>::T frag_t;
    frag_t At[4], B0[2], B1[2];
    const unsigned kstep = 128;
    const int sclB = SCALE_B * 0x01010101, sclA = 0x7f7f7f7f; (void)sclA; (void)sclB;
    PG8_STAGE(PG8_SB(0, 0), rB, voffB[0], cur.bo); PG8_STAGE(PG8_SB(0, 1), rB, voffB[1], cur.bo); PG8_STAGE(PG8_SA(0, 0), rA, oc[0], cur.ao); PG8_STAGE(PG8_SA(0, 1), rA, oc[1], cur.ao);
    if (wr == 1) PG8_BAR;
    PG8_WAIT_V(2); PG8_BAR;
    PG8_STAGE(PG8_SB(1, 0), rB, voffB[0], cur.bo + kstep); PG8_STAGE(PG8_SA(1, 0), rA, oc[0], cur.ao + kstep); PG8_STAGE(PG8_SB(1, 1), rB, voffB[1], cur.bo + kstep);
    PG8_WAIT_V(6); PG8_BAR;
    for (;;) {
        const bool has_next = S.next(ui + 1, nxt);
        if (!has_next) nxt = cur;
        const unsigned nA = nxt.ao, nB = nxt.bo;
        { int t2 = threadIdx.x; LAUNDER(t2);
#pragma unroll
          for (int i = 0; i < 2; ++i) { int R_, C_; stage_rc(t2 * 16 + i * 8192, R_, C_);
#pragma unroll
              for (int h = 0; h < 2; ++h) on[h][i] = S.a_off(nxt, 128 * h + R_) + (unsigned)C_ * 2u; } }
        for (int t = 0; t < nt; t += 2) {
            const bool last = (t == nt - 2);
            const unsigned k1 = cur.ao + (unsigned)(t + 1) * kstep;
            const unsigned a2 = last ? nA : cur.ao + (unsigned)(t + 2) * kstep, b2 = last ? nB : cur.bo + (unsigned)(t + 2) * kstep, a3 = a2 + kstep, b3 = b2 + kstep;
            unsigned o2[2][2];
#pragma unroll
            for (int h = 0; h < 2; ++h)
#pragma unroll
                for (int i = 0; i < 2; ++i) o2[h][i] = last ? on[h][i] : oc[h][i];
            PG8_LDB(B0, 0, 0); PG8_LDB(B1, 0, 1); PG8_SCHED; PG8_LDA(At, 0, 0); PG8_STAGE(PG8_SA(1, 1), rA, oc[1], k1);
            if constexpr (HOST) PG8_WAIT_V(17); else PG8_WAIT_V(8);
            PG8_WAIT_L(0); PG8_BAR;
            if constexpr (HOST) { PG8_MMA_H(cvx, H.dX); } else { PG8_MMA(0, 0, At, B0); PG8_MMA(0, 1, At, B1); }
            PG8_BAR; PG8_SCHED;
            PG8_LDA(At, 0, 1); PG8_STAGE(PG8_SB(0, 0), rB, voffB[0], b2); PG8_STAGE(PG8_SB(0, 1), rB, voffB[1], b2); PG8_STAGE(PG8_SA(0, 0), rA, o2[0], a2);
            if constexpr (HOST) PG8_WAIT_V(17); else PG8_WAIT_V(8);
            PG8_WAIT_L(0); PG8_BAR; PG8_MMA(1, 0, At, B0); PG8_MMA(1, 1, At, B1); PG8_BAR; PG8_SCHED;
            PG8_LDB(B0, 1, 0); PG8_LDB(B1, 1, 1); PG8_SCHED; PG8_LDA(At, 1, 0); PG8_STAGE(PG8_SA(0, 1), rA, o2[1], a2);
            if constexpr (HOST) PG8_WAIT_V(17); else PG8_WAIT_V(8);
            PG8_WAIT_L(0); PG8_BAR;
            if constexpr (HOST) { PG8_MMA_H(cvy, H.dY); } else { PG8_MMA(0, 0, At, B0); PG8_MMA(0, 1, At, B1); }
            PG8_BAR; PG8_SCHED;
            PG8_LDA(At, 1, 1); PG8_STAGE(PG8_SB(1, 0), rB, voffB[0], b3); PG8_STAGE(PG8_SB(1, 1), rB, voffB[1], b3); PG8_STAGE(PG8_SA(1, 0), rA, o2[0], a3);
            if constexpr (HOST) PG8_WAIT_V(17); else PG8_WAIT_V(8);
            PG8_WAIT_L(0); PG8_BAR; PG8_MMA(1, 0, At, B0); PG8_MMA(1, 1, At, B1); PG8_BAR; PG8_SCHED;
        }
        if constexpr (FP8) asm volatile("s_nop 15\n\ts_nop 15" ::: "memory");
        if constexpr (ALIGN_EPI) { if (wr == 0) PG8_BAR; }
        if constexpr (!Epi::AFTER_DRAIN) E(acc, cur, wr, wc, fr, fq);
        if (!has_next) break;
#pragma unroll
        for (int a = 0; a < 2; ++a)
#pragma unroll
            for (int b = 0; b < 2; ++b)
#pragma unroll
                for (int m = 0; m < 4; ++m)
#pragma unroll
                    for (int n = 0; n < 2; ++n) acc[a][b][m][n] = (f32x4){0.f, 0.f, 0.f, 0.f};
        cur = nxt; ++ui;
#pragma unroll
        for (int h = 0; h < 2; ++h)
#pragma unroll
            for (int i = 0; i < 2; ++i) oc[h][i] = on[h][i];
        if constexpr (ALIGN_EPI) { if (wr == 1) PG8_BAR; }
    }
    PG8_WAIT_V(0);
    if constexpr (HOST) { ch_finish(H, H.dX, cvx, voffS); ch_finish(H, H.dY, cvy, voffS); }
    if constexpr (!ALIGN_EPI) { if (wr == 0) PG8_BAR; }
    PG8_BAR;
    if constexpr (Epi::AFTER_DRAIN) E.fused(acc, cur, wr, wc, fr, fq, lds_flat, wid, lane);
    }
    if constexpr (HOST) {
        while (__builtin_amdgcn_readfirstlane(H.h) < H.hi) { unsigned d_; ch_issue<HGU>(H, d_, cvx, 0, 8, voffL); ch_finish(H, d_, cvx, voffS); } }
#undef PG8_SA
#undef PG8_SB
#undef PG8_STAGE
#undef PG8_LDA
#undef PG8_LDF
#undef PG8_LDB
#undef PG8_MMA
#undef PG8_WAIT_V
#undef PG8_WAIT_L
#undef PG8_BAR
#undef PG8_SCHED
#undef PG8_MMA_M
#undef PG8_MMA_H
}
template <bool ALIGN, class Sched, class Epi> __device__ __forceinline__ void gemm_run(unsigned char* lds, const Sched& S, const Epi& E) {
    ConvHost none{}; gemm_phase<Sched, Epi, ALIGN>(lds, S, E, none);
}
template <bool ALIGN, int HOSTM, class Sched, class Epi> __device__ __forceinline__ void gemm_run_host(unsigned char* lds, const Sched& S, const Epi& E, const float* src, unsigned char* ws, int lo, int hi, int gw, int nW) {
    ConvHost H{src, ws, lo + gw, nW, hi, 0u, 0u}; gemm_phase<Sched, Epi, ALIGN, false, 0x7f, HOSTM>(lds, S, E, H);
}
constexpr int WSCALE_LOG2 = 6;
template <bool ALIGN, class Sched, class Epi> __device__ __forceinline__ void gemm_run_fp8(unsigned char* lds, const Sched& S, const Epi& E) {
    ConvHost none{}; gemm_phase<Sched, Epi, ALIGN, true, 127 - WSCALE_LOG2>(lds, S, E, none);
}

struct DenseSched {
    const char* A; const char* Bt; unsigned lda, ldb; int K; int nM, nN; int pm_per_b; size_t zB; int G, c;
    __device__ __forceinline__ bool next(int i, GUnit& u) const {
        int pm, pn;
        if (G == 256 && (nN & 3) == 0 && nM * nN >= 256) {
            const int j = c & 7, q = c >> 3, s = i * 8 + j, ncg = nN >> 2; pm = (s / ncg) * 8 + (q >> 2); pn = (s % ncg) * 4 + (q & 3); if (c < 0 || pm >= nM) return false; }
        else { const long L = (long)i * G + c; if (c < 0 || L >= (long)nM * nN) return false; pm = (int)(L / nN); pn = (int)(L % nN); }
        u.ao = (unsigned)pm * 256u * lda; u.bo = (unsigned)((size_t)(pm / pm_per_b) * zB) + (unsigned)pn * 256u * ldb; u.row0 = pm * 256; u.col0 = pn * 256; u.e = 0; u.valid = 256; u.aux = 0; return true;
    }
    __device__ __forceinline__ unsigned a_off(const GUnit&, int r) const { return (unsigned)r * lda; }
};
struct SchedWqk {
    const char* A; const char* Bt; unsigned lda, ldb; int K; int G, c, pad;
    __device__ __forceinline__ bool next(int i, GUnit& u) const {
        const int L = i * G + c; if (c < 0 || L >= 32) return false; const int z = L >> 2, pn = L & 3, b = z >> 2, h = z & 3;
        u.ao = (unsigned)b * 256u * 4096u + h * 512u; u.bo = (unsigned)pn * 256u * 2048u + h * 512u; u.row0 = z * 256; u.col0 = pn * 256; u.e = 0; u.valid = 256; u.aux = 0; return true;
    }
    __device__ __forceinline__ unsigned a_off(const GUnit&, int r) const { return (unsigned)r * lda; }
};
struct SchedVo {
    const char* A; const char* Bt; unsigned lda, ldb; int K; int G, c, pad;
    __device__ __forceinline__ bool next(int i, GUnit& u) const {
        const int L = i * G + c; if (c < 0 || L >= 32) return false; const int z = L >> 2, pm = L & 3, b = z >> 2, h = z & 3;
        u.ao = (unsigned)pm * 256u * 2048u + h * 512u; u.bo = (unsigned)b * 256u * 4096u + 2048u + h * 512u; u.row0 = b * 1024 + pm * 256; u.col0 = h * 256; u.e = 0; u.valid = 256; u.aux = 0; return true;
    }
    __device__ __forceinline__ unsigned a_off(const GUnit&, int r) const { return (unsigned)r * lda; }
};
template <bool GATHER> struct MoeSched {
    const char* A; const char* Bt; unsigned lda, ldb; int K; int nN; size_t zB;
    const int* tab; const int* list; int gather; int G, c, pad;
    __device__ __forceinline__ bool next(int i, GUnit& u) const {
        int T, pn;
        if (G == 256) { const int j = c & 7, q = c >> 3, s = i * 8 + j;
            if (nN == 8) { T = 4 * s + (q >> 3); pn = q & 7; } else { T = 8 * s + (q >> 2); pn = q & 3; } }
        else { const int L = i * G + c; T = L / nN; pn = L % nN; }
        if (T >= __builtin_amdgcn_readfirstlane(tab[64])) return false;
        const int w = __builtin_amdgcn_readfirstlane(tab[128 + T]); const int e = w & 255, rt = w >> 8; const int ce = __builtin_amdgcn_readfirstlane(tab[e]), start = __builtin_amdgcn_readfirstlane(tab[32 + e]);
        u.e = e; u.valid = min(256, ce - rt * 256); u.row0 = start + rt * 256; u.col0 = pn * 256; u.aux = rt * 256;
        u.ao = GATHER ? 0u : (unsigned)u.row0 * lda; u.bo = (unsigned)((size_t)e * zB) + (unsigned)pn * 256u * ldb; return true;
    }
    __device__ __forceinline__ unsigned a_off(const GUnit& u, int r) const {
        if (!GATHER) return (unsigned)r * lda;
        const int rr = r < u.valid ? r : 0; const int tok = list[u.e * NTOK + u.aux + rr]; return (unsigned)tok * lda;
    }
};
__device__ __forceinline__ void moe_build_table(int* tab, const int* __restrict__ cnt, int tid) {
    if (tid < 32) tab[tid] = cnt[tid * 32];
    __syncthreads();
    if (tid < 32) { int s = 0; for (int e = 0; e < tid; ++e) s += tab[e]; tab[32 + tid] = s; }
    if (tid < 320) { int tiles = 0, found = -1;
        for (int e = 0; e < NEXP; ++e) { const int te = (tab[e] + 255) >> 8; if (found < 0 && tid < tiles + te) found = e | ((tid - tiles) << 8); tiles += te; }
        if (found >= 0) tab[128 + tid] = found; if (tid == 0) tab[64] = tiles; }
    __syncthreads();
}

__device__ __forceinline__ u32x4 pack8(const f32x4& a, const f32x4& b) { u32x4 w; w.x = pk2(a[0], a[1]); w.y = pk2(a[2], a[3]); w.z = pk2(b[0], b[1]); w.w = pk2(b[2], b[3]); return w; }
struct EpiBf16 { static constexpr bool AFTER_DRAIN = false; bf16_t* O; int ldc, pad;
    __device__ __forceinline__ void operator()(const f32x4 (&acc)[2][2][4][2], const GUnit& u, int wr, int wc, int fr, int fq) const {
        LAUNDER(fr); LAUNDER(fq);
#pragma unroll
        for (int ai = 0; ai < 2; ++ai)
#pragma unroll
            for (int m = 0; m < 4; ++m) { const int r = 128 * ai + 64 * wr + 16 * m + fr;
#pragma unroll
                for (int bj = 0; bj < 2; ++bj) *(u32x4*)(O + (size_t)(u.row0 + r) * ldc + u.col0 + 128 * bj + 32 * wc + 8 * fq) = pack8(acc[ai][bj][m][0], acc[ai][bj][m][1]); } } };
__device__ __forceinline__ float row_rstd(const float* __restrict__ ssp, int row) { const f32x4* p = (const f32x4*)(ssp + (size_t)row * 16); const f32x4 a = p[0], b = p[1], c = p[2], d = p[3];
    const float s = (((a[0] + a[1]) + (a[2] + a[3])) + ((b[0] + b[1]) + (b[2] + b[3]))) + (((c[0] + c[1]) + (c[2] + c[3])) + ((d[0] + d[1]) + (d[2] + d[3]))); return 1.0f / sqrtf(s * (1.0f / 1024.0f) + EPS); }
template <bool BASE_BF16> struct EpiResidSS { static constexpr bool AFTER_DRAIN = false; const void* base; bf16_t* xb; float* ss; unsigned char* xq; const float* qg;
    __device__ __forceinline__ void operator()(const f32x4 (&acc)[2][2][4][2], const GUnit& u, int wr, int wc, int fr, int fq) const {
        LAUNDER(fr); LAUNDER(fq);
#pragma unroll
        for (int ai = 0; ai < 2; ++ai) {
            f32x4 b[4][2][2];
#pragma unroll
            for (int m = 0; m < 4; ++m)
#pragma unroll
                for (int bj = 0; bj < 2; ++bj) { const size_t o = (size_t)(u.row0 + 128 * ai + 64 * wr + 16 * m + fr) * 1024 + u.col0 + 128 * bj + 32 * wc + 8 * fq;
                    if (BASE_BF16) { const u32x4 w = *(const u32x4*)((const bf16_t*)base + o); b[m][bj][0] = (f32x4){bflo(w.x), bfhi(w.x), bflo(w.y), bfhi(w.y)}; b[m][bj][1] = (f32x4){bflo(w.z), bfhi(w.z), bflo(w.w), bfhi(w.w)}; }
                    else { b[m][bj][0] = __builtin_nontemporal_load((const f32x4*)((const float*)base + o)); b[m][bj][1] = __builtin_nontemporal_load((const f32x4*)((const float*)base + o + 4)); } }
#pragma unroll
            for (int m = 0; m < 4; ++m) { const int r = 128 * ai + 64 * wr + 16 * m + fr; float part = 0.f;
#pragma unroll
                for (int bj = 0; bj < 2; ++bj) { const size_t o = (size_t)(u.row0 + r) * 1024 + u.col0 + 128 * bj + 32 * wc + 8 * fq;
                    const f32x4 y0 = b[m][bj][0] + acc[ai][bj][m][0], y1 = b[m][bj][1] + acc[ai][bj][m][1]; *(u32x4*)(xb + o) = pack8(y0, y1);
                    if (xq) { const int cq = u.col0 + 128 * bj + 32 * wc + 8 * fq; const f32x4 g0 = *(const f32x4*)(qg + cq), g1 = *(const f32x4*)(qg + cq + 4); const f32x4 z0 = y0 * g0, z1 = y1 * g1;
                        u32x2 q; q.x = pk4_fp8(z0[0], z0[1], z0[2], z0[3]); q.y = pk4_fp8(z1[0], z1[1], z1[2], z1[3]); *(u32x2*)(xq + o) = q; }
                    part += (y0[0] * y0[0] + y0[1] * y0[1] + y0[2] * y0[2] + y0[3] * y0[3]) + (y1[0] * y1[0] + y1[1] * y1[1] + y1[2] * y1[2] + y1[3] * y1[3]); }
                part += __shfl_xor(part, 16); part += __shfl_xor(part, 32);
                if (fq == 0) ss[(size_t)(u.row0 + r) * 16 + (u.col0 >> 8) * 4 + wc] = part; } } } };
struct EpiSoftmax { static constexpr bool AFTER_DRAIN = true; const float* ss; bf16_t* P;
    __device__ __forceinline__ void operator()(const f32x4 (&)[2][2][4][2], const GUnit&, int, int, int, int) const {}
    __device__ __forceinline__ void fused(f32x4 (&acc)[2][2][4][2], const GUnit& u, int wr, int wc, int fr, int fq, unsigned char* lds, int wid, int lane) const {
        float* Pm = (float*)lds; float* Ps = (float*)(lds + 4096);
        LAUNDER(fr); LAUNDER(fq);
#pragma unroll
        for (int ai = 0; ai < 2; ++ai)
#pragma unroll
            for (int m = 0; m < 4; ++m) { const int r = 128 * ai + 64 * wr + 16 * m + fr; const float rstd = row_rstd(ss, u.row0 + r); float mv = -INFINITY;
#pragma unroll
                for (int bj = 0; bj < 2; ++bj)
#pragma unroll
                    for (int n = 0; n < 2; ++n) { f32x4 s = acc[ai][bj][m][n] * rstd; acc[ai][bj][m][n] = s; mv = fmaxf(mv, fmaxf(fmaxf(s[0], s[1]), fmaxf(s[2], s[3]))); }
                mv = fmaxf(mv, __shfl_xor(mv, 16)); mv = fmaxf(mv, __shfl_xor(mv, 32));
                if (fq == 0) Pm[r * 4 + wc] = mv; }
        __syncthreads();
#pragma unroll
        for (int ai = 0; ai < 2; ++ai)
#pragma unroll
            for (int m = 0; m < 4; ++m) { const int r = 128 * ai + 64 * wr + 16 * m + fr; const f32x4 pm = *(const f32x4*)(Pm + r * 4); const float mv = fmaxf(fmaxf(pm[0], pm[1]), fmaxf(pm[2], pm[3])); float sum = 0.f;
#pragma unroll
                for (int bj = 0; bj < 2; ++bj)
#pragma unroll
                    for (int n = 0; n < 2; ++n) { f32x4 s = acc[ai][bj][m][n]; s[0] = __builtin_amdgcn_exp2f(s[0] - mv); s[1] = __builtin_amdgcn_exp2f(s[1] - mv); s[2] = __builtin_amdgcn_exp2f(s[2] - mv); s[3] = __builtin_amdgcn_exp2f(s[3] - mv);
                        acc[ai][bj][m][n] = s; sum += (s[0] + s[1]) + (s[2] + s[3]); }
                sum += __shfl_xor(sum, 16); sum += __shfl_xor(sum, 32);
                if (fq == 0) Ps[r * 4 + wc] = sum; }
        __syncthreads();
#pragma unroll
        for (int ai = 0; ai < 2; ++ai)
#pragma unroll
            for (int m = 0; m < 4; ++m) { const int r = 128 * ai + 64 * wr + 16 * m + fr; const f32x4 ps = *(const f32x4*)(Ps + r * 4); const float inv = 1.0f / ((ps[0] + ps[1]) + (ps[2] + ps[3]));
#pragma unroll
                for (int bj = 0; bj < 2; ++bj) *(u32x4*)(P + (size_t)(u.row0 + r) * 1024 + u.col0 + 128 * bj + 32 * wc + 8 * fq) = pack8(acc[ai][bj][m][0] * inv, acc[ai][bj][m][1] * inv); }
        (void)wid; (void)lane;
        __syncthreads();
    } };
struct EpiGU { static constexpr bool AFTER_DRAIN = false; const float* bgu; unsigned char* act  ; const float* lrs  ;
    __device__ __forceinline__ void operator()(const f32x4 (&acc)[2][2][4][2], const GUnit& u, int wr, int wc, int fr, int fq) const {
        const int pn = u.col0 >> 8; const float* bg = bgu + (size_t)u.e * 2048; LAUNDER(fr); LAUNDER(fq);
        float rs[8];
#pragma unroll
        for (int i = 0; i < 8; ++i) { const int r = 128 * (i >> 2) + 64 * wr + 16 * (i & 3) + fr; rs[i] = lrs[(size_t)u.e * NTOK + u.aux + (r < u.valid ? r : 0)]; }
        const int col = 128 * pn + 32 * wc + 8 * fq;
        f32x4 bgv[2], blv[2];
#pragma unroll
        for (int n = 0; n < 2; ++n) { bgv[n] = *(const f32x4*)(bg + col + 4 * n); blv[n] = *(const f32x4*)(bg + 1024 + col + 4 * n); }
#pragma unroll
        for (int ai = 0; ai < 2; ++ai)
#pragma unroll
            for (int m = 0; m < 4; ++m) { const int r = 128 * ai + 64 * wr + 16 * m + fr; const float rstd = rs[ai * 4 + m]; u32x2 q;
#pragma unroll
                for (int n = 0; n < 2; ++n) { const f32x4 g = acc[ai][0][m][n] * rstd + bgv[n], l = acc[ai][1][m][n] * rstd + blv[n]; float o[4];
#pragma unroll
                    for (int j = 0; j < 4; ++j) { const float gg = fminf(g[j], 7.0f), ll = fminf(fmaxf(l[j], -7.0f), 7.0f); o[j] = (ll + 1.0f) * (gg * __builtin_amdgcn_rcpf(1.0f + __builtin_amdgcn_exp2f(-1.702f * LOG2E * gg))); }
                    const unsigned w = pk4_fp8(o[0], o[1], o[2], o[3]); if (n == 0) q.x = w; else q.y = w; }
                if (r < u.valid) *(u32x2*)(act + (size_t)(u.row0 + r) * 1024 + col) = q; } } };
struct EpiDown { static constexpr bool AFTER_DRAIN = false; const float* bdn; unsigned char* ys  ;
    __device__ __forceinline__ void operator()(const f32x4 (&acc)[2][2][4][2], const GUnit& u, int wr, int wc, int fr, int fq) const {
        const float* bd = bdn + (size_t)u.e * 1024; LAUNDER(fr); LAUNDER(fq);
        f32x4 bv[2][2];
#pragma unroll
        for (int bj = 0; bj < 2; ++bj)
#pragma unroll
            for (int n = 0; n < 2; ++n) bv[bj][n] = *(const f32x4*)(bd + u.col0 + 128 * bj + 32 * wc + 8 * fq + 4 * n);
#pragma unroll
        for (int ai = 0; ai < 2; ++ai)
#pragma unroll
            for (int m = 0; m < 4; ++m) { const int r = 128 * ai + 64 * wr + 16 * m + fr; if (r < u.valid) {
#pragma unroll
                for (int bj = 0; bj < 2; ++bj) { const f32x4 y0 = acc[ai][bj][m][0] + bv[bj][0], y1 = acc[ai][bj][m][1] + bv[bj][1]; u32x2 q; q.x = pk4_fp8(y0[0], y0[1], y0[2], y0[3]); q.y = pk4_fp8(y1[0], y1[1], y1[2], y1[3]);
                    *(u32x2*)(ys + (size_t)(u.row0 + r) * 1024 + u.col0 + 128 * bj + 32 * wc + 8 * fq) = q; } } } } };


typedef float f32x16 __attribute__((ext_vector_type(16)));
typedef short s16x4 __attribute__((ext_vector_type(4)));
__device__ __forceinline__ int crow(int r, int hi) { return (r & 3) + 8 * (r >> 2) + 4 * hi; }
__device__ __forceinline__ s16x4 tr_read(const unsigned char* p) { return __builtin_bit_cast(s16x4, __builtin_amdgcn_ds_read_tr16_b64_v4i16((LDSP s16x4*)(unsigned)(uintptr_t)p)); }
__device__ __forceinline__ bf16x8 tr_frag(const unsigned char* img, int pitch, int k0, int f0, int lane) {
    const unsigned char* p = img + (k0 + 8 * (lane >> 5) + ((lane & 15) >> 2)) * pitch + (f0 + 16 * ((lane >> 4) & 1) + 4 * (lane & 3)) * 2;
    const s16x4 lo = tr_read(p), hi = tr_read(p + 4 * pitch);
    return (bf16x8){lo[0], lo[1], lo[2], lo[3], hi[0], hi[1], hi[2], hi[3]};
}
constexpr int GA_PK = 576, GA_PV = 1088;
constexpr int GA_V = 0, GA_PART = 0, GA_GLR = 69632, GA_TOT = 73728, GA_KD = 75776, GA_END = GA_KD + 64 * GA_PK;
__device__ __forceinline__ void gla_pass_a(unsigned char* lds, int task, const bf16_t* __restrict__ xn, const bf16_t* __restrict__ wglr  , const bf16_t* __restrict__ proj,
                                           const float* __restrict__ wg, const float* __restrict__ bg, float* __restrict__ UT, float* __restrict__ decay) {
    int tid = threadIdx.x; LAUNDER(tid); int wid = tid >> 6, lane = tid & 63, fr = lane & 15, fq = lane >> 4;
    const size_t t0 = (size_t)task * 64;
    { f32x4 acc[4];
#pragma unroll
      for (int m = 0; m < 4; ++m) acc[m] = (f32x4){0.f, 0.f, 0.f, 0.f};
#pragma unroll
      for (int ks = 0; ks < 4; ++ks) { const int k = 128 * wid + 32 * ks + 8 * fq; const bf16x8 bfr = *(const bf16x8*)(wglr + (size_t)fr * 1024 + k);
#pragma unroll
          for (int m = 0; m < 4; ++m) { const bf16x8 afr = *(const bf16x8*)(xn + (t0 + 16 * m + fr) * DM + k); acc[m] = __builtin_amdgcn_mfma_f32_16x16x32_bf16(afr, bfr, acc[m], 0, 0, 0); } }
      float* part = (float*)(lds + GA_PART) + wid * 1024;
#pragma unroll
      for (int m = 0; m < 4; ++m)
#pragma unroll
          for (int j = 0; j < 4; ++j) part[(16 * m + 4 * fq + j) * 16 + fr] = acc[m][j]; }
    __syncthreads();
    { float* glr = (float*)(lds + GA_GLR); const float* part = (const float*)(lds + GA_PART);
      for (int i = tid; i < 1024; i += 512) { float s = 0.f;
#pragma unroll
          for (int w = 0; w < 8; ++w) s += part[w * 1024 + i];
          glr[i] = s; } }
    __syncthreads();
    LAUNDER(tid);
    { const int cv = tid & 63, tk = tid >> 6;
#pragma unroll
      for (int i = 0; i < 8; ++i) { const int tok = tk + 8 * i; const u32x4 v = *(const u32x4*)(proj + (t0 + tok) * PROJ_LD + C_VG + cv * 8); *(u32x4*)(lds + GA_V + tok * GA_PV + cv * 16) = v; } }
    LAUNDER(tid);
    { const int j = tid & 255, half = tid >> 8; const float* glr = (const float*)(lds + GA_GLR); float* tot = (float*)(lds + GA_TOT);
      float w[16];
#pragma unroll
      for (int i = 0; i < 16; ++i) w[i] = wg[i * 256 + j];
      const float bj = bg[j]; float run = 0.f;
      bf16_t kk16[32];
#pragma unroll
      for (int s = 0; s < 32; ++s) kk16[s] = proj[(t0 + 32 * half + s) * PROJ_LD + C_KG + j];
      float Gc[32];
#pragma unroll
      for (int s = 0; s < 32; ++s) { const float* gl = glr + (32 * half + s) * 16; float u = bj;
#pragma unroll
          for (int i = 0; i < 16; ++i) u += gl[i] * w[i];
          const float ls = fminf(u, 0.f) - __logf(1.0f + __expf(-fabsf(u)));
          run += ls * (1.0f / 16.0f); Gc[s] = run; }
      tot[half * 256 + j] = run;
      __syncthreads();
      const float t0v = tot[j], t1v = tot[256 + j]; const float gend = t0v + t1v;
      if (half == 0) decay[(size_t)task * 256 + j] = __expf(gend);
      const float rel = gend - (half ? t0v : 0.f);
#pragma unroll
      for (int s = 0; s < 32; ++s) { const int tok = 32 * half + s;
          *(bf16_t*)(lds + GA_KD + tok * GA_PK + j * 2) = (bf16_t)f2bf(bf2f(kk16[s]) * __expf(rel - Gc[s])); } }
    __syncthreads();
    LAUNDER(tid); wid = __builtin_amdgcn_readfirstlane(tid >> 6); lane = tid & 63;
    { const int h = wid >> 1, nt = wid & 1, hi = lane >> 5, c32 = lane & 31; f32x16 acc[4];
#pragma unroll
      for (int m = 0; m < 4; ++m)
#pragma unroll
          for (int r = 0; r < 16; ++r) acc[m][r] = 0.f;
#pragma unroll
      for (int ks = 0; ks < 4; ++ks) { const bf16x8 bfr = tr_frag(lds + GA_KD, GA_PK, 16 * ks, h * 64 + 32 * nt, lane);
#pragma unroll
          for (int m = 0; m < 4; ++m) { const bf16x8 afr = tr_frag(lds + GA_V, GA_PV, 16 * ks, h * 128 + 32 * m, lane); acc[m] = __builtin_amdgcn_mfma_f32_32x32x16_bf16(afr, bfr, acc[m], 0, 0, 0); } }
      float* u = UT + ((size_t)task * 4 + h) * 8192;
#pragma unroll
      for (int m = 0; m < 4; ++m)
#pragma unroll
          for (int r = 0; r < 16; ++r) __builtin_nontemporal_store(acc[m][r], u + (32 * m + crow(r, hi)) * 64 + 32 * nt + c32); }
    __syncthreads();
}
__device__ __forceinline__ void gla_pass_b(int e, const float* __restrict__ UT, const float* __restrict__ decay, bf16_t* __restrict__ ST) {
    const int dk = e & 63, dv = (e >> 6) & 127, h = (e >> 13) & 3, b = e >> 15; float s = 0.f;
    const size_t base = ((size_t)b * 128 * 4 + h) * 8192 + dv * 64 + dk; const size_t dbase = (size_t)b * 128 * 256 + h * 64 + dk;
    for (int c0 = 0; c0 < 128; c0 += 32) { float u[32], d[32];
#pragma unroll
        for (int i = 0; i < 32; ++i) { u[i] = __builtin_nontemporal_load(UT + base + (size_t)(c0 + i) * 4 * 8192); d[i] = decay[dbase + (size_t)(c0 + i) * 256]; }
#pragma unroll
        for (int i = 0; i < 32; ++i) { s = d[i] * s + u[i]; __builtin_nontemporal_store((bf16_t)f2bf(s), ST + base + (size_t)(c0 + i) * 4 * 8192); } }
}
constexpr int GC_PITCH = 520;
__device__ __forceinline__ void gla_pass_c(unsigned char* wlds  , int wtask, const bf16_t* __restrict__ ST, const bf16_t* __restrict__ proj, const float* __restrict__ ghead, bf16_t* __restrict__ mix, int lane) {
    const int nh = wtask & 1, h = (wtask >> 1) & 3, bc = wtask >> 3; const int c32 = lane & 31, hi = lane >> 5;
    const size_t t0 = (size_t)bc * 64 + 32 * nh; const bf16_t* st = ST + ((size_t)bc * 4 + h) * 8192;
    f32x16 acc[4];
#pragma unroll
    for (int m = 0; m < 4; ++m)
#pragma unroll
        for (int r = 0; r < 16; ++r) acc[m][r] = 0.f;
#pragma unroll
    for (int ks = 0; ks < 4; ++ks) { const bf16x8 bfr = *(const bf16x8*)(proj + (t0 + c32) * PROJ_LD + C_QG + h * 64 + 16 * ks + 8 * hi);
#pragma unroll
        for (int m = 0; m < 4; ++m) { const bf16x8 afr = *(const bf16x8*)(st + (32 * m + c32) * 64 + 16 * ks + 8 * hi); acc[m] = __builtin_amdgcn_mfma_f32_32x32x16_bf16(afr, bfr, acc[m], 0, 0, 0); } }
    float ss = 0.f;
#pragma unroll
    for (int m = 0; m < 4; ++m)
#pragma unroll
        for (int r = 0; r < 16; ++r) ss += acc[m][r] * acc[m][r];
    ss += __shfl_xor(ss, 32);
    const float rstd = 1.0f / sqrtf(ss * (1.0f / 128.0f) + EPS);
#pragma unroll
    for (int m = 0; m < 4; ++m)
#pragma unroll
        for (int r = 0; r < 16; ++r) *(float*)(wlds + c32 * GC_PITCH + (32 * m + crow(r, hi)) * 4) = acc[m][r] * rstd;
#pragma unroll
    for (int i = 0; i < 8; ++i) { const int q = lane + 64 * i, tok = q >> 4, dv0 = (q & 15) * 8; const float* src = (const float*)(wlds + tok * GC_PITCH + dv0 * 4);
        const u32x4 rgw = *(const u32x4*)(proj + (t0 + tok) * PROJ_LD + C_RG + h * 128 + dv0); const f32x4 g0 = *(const f32x4*)(ghead + dv0), g1 = *(const f32x4*)(ghead + dv0 + 4);
        const float rg[8] = {bflo(rgw.x), bfhi(rgw.x), bflo(rgw.y), bfhi(rgw.y), bflo(rgw.z), bfhi(rgw.z), bflo(rgw.w), bfhi(rgw.w)}; const float gg[8] = {g0.x, g0.y, g0.z, g0.w, g1.x, g1.y, g1.z, g1.w}; float y[8];
#pragma unroll
        for (int k = 0; k < 8; ++k) y[k] = src[k] * gg[k] * (rg[k] / (1.0f + __expf(-rg[k])));
        u32x4 o; o.x = pk2(y[0], y[1]); o.y = pk2(y[2], y[3]); o.z = pk2(y[4], y[5]); o.w = pk2(y[6], y[7]);
        *(u32x4*)(mix + (t0 + tok) * 1024 + h * 128 + dv0) = o; }
}
__device__ __forceinline__ void sb_task(unsigned char* vl  , int wtask, const bf16_t* __restrict__ proj, bf16_t* __restrict__ mix, int lane) {
    const int qt = wtask & 255, h = (wtask >> 8) & 7, b = wtask >> 11; const int c = lane & 31, hi = lane >> 5;
    const int t0 = qt * 32; const size_t rowb = (size_t)b * SEQ;
    bf16x8 qf[4];
#pragma unroll
    for (int d0 = 0; d0 < 4; ++d0) qf[d0] = *(const bf16x8*)(proj + (rowb + t0 + c) * PROJ_LD + C_QS + h * 64 + 16 * d0 + 8 * hi);
    const int kap = 16 * ((c >> 2) & 1) + (c & 3) + 4 * (c >> 3);
    f32x16 o0, o1;
#pragma unroll
    for (int r = 0; r < 16; ++r) { o0[r] = 0.f; o1[r] = 0.f; }
    float Dc = 1.0f;
    const bf16_t* kbase = proj + rowb * PROJ_LD + C_KS + h * 64 + 8 * hi + (size_t)kap * PROJ_LD;
    const bf16_t* vbase = proj + rowb * PROJ_LD + C_VS + h * 64 + (lane & 7) * 8 + (size_t)(lane >> 3) * PROJ_LD;
    bf16x8 kf[4]; u32x4 vr[4];
#pragma unroll
    for (int d0 = 0; d0 < 4; ++d0) kf[d0] = *(const bf16x8*)(kbase + (size_t)t0 * PROJ_LD + 16 * d0);
#pragma unroll
    for (int i = 0; i < 4; ++i) vr[i] = *(const u32x4*)(vbase + (size_t)(t0 + 8 * i) * PROJ_LD);
    for (int j0 = t0; j0 >= 0; j0 -= 32) {
#pragma unroll
        for (int i = 0; i < 4; ++i) { const int key = (lane >> 3) + 8 * i, ch = lane & 7; *(u32x4*)(vl + (ch >> 2) * 2048 + key * 64 + (ch & 3) * 16) = vr[i]; }
        f32x16 z;
#pragma unroll
        for (int r = 0; r < 16; ++r) z[r] = 0.f;
#pragma unroll
        for (int d0 = 0; d0 < 4; ++d0) z = __builtin_amdgcn_mfma_f32_32x32x16_bf16(kf[d0], qf[d0], z, 0, 0, 0);
        asm volatile("" ::: "memory");
        { const int jn = (j0 >= 32) ? j0 - 32 : j0;
#pragma unroll
          for (int d0 = 0; d0 < 4; ++d0) kf[d0] = *(const bf16x8*)(kbase + (size_t)jn * PROJ_LD + 16 * d0);
#pragma unroll
          for (int i = 0; i < 4; ++i) vr[i] = *(const u32x4*)(vbase + (size_t)(jn + 8 * i) * PROJ_LD); }
        asm volatile("" ::: "memory");
        float e[16], Dl[16];
        const bool diag = (j0 == t0);
#pragma unroll
        for (int r = 0; r < 16; ++r) { float ev = __builtin_amdgcn_exp2f(fminf(z[r], 126.0f)); if (diag && (16 * hi + r >= c)) ev = 0.f; e[r] = ev; }
        float D = hi ? Dc : 1.0f;
#pragma unroll
        for (int r = 15; r >= 0; --r) { D = fmaf(D, e[r], D); Dl[r] = D; }
        const float other = __shfl_xor(D, 32);
        const float mult = hi ? 1.0f : other;
        Dc = D * other;
        unsigned pw[8];
#pragma unroll
        for (int r = 0; r < 16; r += 2) { const float a0 = e[r] * __builtin_amdgcn_rcpf(Dl[r] * mult), a1 = e[r + 1] * __builtin_amdgcn_rcpf(Dl[r + 1] * mult); pw[r >> 1] = pk2(a0, a1); }
#pragma unroll
        for (int ks = 0; ks < 2; ++ks) { const bf16x8 pa = __builtin_bit_cast(bf16x8, (u32x4){pw[4 * ks], pw[4 * ks + 1], pw[4 * ks + 2], pw[4 * ks + 3]});
            const unsigned char* vb = vl + (16 * hi + 8 * ks + ((lane & 15) >> 2)) * 64 + (16 * ((lane >> 4) & 1) + 4 * (lane & 3)) * 2;
            { const s16x4 lo = tr_read(vb), hh = tr_read(vb + 256); o0 = __builtin_amdgcn_mfma_f32_32x32x16_bf16(pa, (bf16x8){lo[0], lo[1], lo[2], lo[3], hh[0], hh[1], hh[2], hh[3]}, o0, 0, 0, 0); }
            { const s16x4 lo = tr_read(vb + 2048), hh = tr_read(vb + 2048 + 256); o1 = __builtin_amdgcn_mfma_f32_32x32x16_bf16(pa, (bf16x8){lo[0], lo[1], lo[2], lo[3], hh[0], hh[1], hh[2], hh[3]}, o1, 0, 0, 0); } }
        if (__all(!(Dc < 3.0e38f))) break;
    }
    bf16_t* ob = mix + (rowb + t0) * 1024 + 512 + h * 64 + c;
#pragma unroll
    for (int r = 0; r < 16; ++r) { const int q = crow(r, hi); ob[(size_t)q * 1024] = (bf16_t)f2bf(o0[r]); ob[(size_t)q * 1024 + 32] = (bf16_t)f2bf(o1[r]); }
}
__device__ __forceinline__ void memkv_task(int wtask, int lane, const bf16_t* __restrict__ memn, const bf16_t* __restrict__ wkv, bf16_t* __restrict__ kv) {
    const int tm = wtask >> 6, tn = wtask & 63; const int c = lane & 31, hi = lane >> 5;
    const bf16_t* ap = memn + (size_t)(tm * 32 + c) * DM + 8 * hi; const bf16_t* bp = wkv + (size_t)(tn * 32 + c) * DM + 8 * hi;
    f32x16 acc;
#pragma unroll
    for (int r = 0; r < 16; ++r) acc[r] = 0.f;
#pragma unroll 16
    for (int ks = 0; ks < 64; ++ks) { const bf16x8 a = *(const bf16x8*)(ap + 16 * ks), b = *(const bf16x8*)(bp + 16 * ks); acc = __builtin_amdgcn_mfma_f32_32x32x16_bf16(a, b, acc, 0, 0, 0); }
    bf16_t* o = kv + (size_t)(tm * 32) * 2048 + tn * 32 + c;
#pragma unroll
    for (int r = 0; r < 16; ++r) o[(size_t)crow(r, hi) * 2048] = (bf16_t)f2bf(acc[r]);
}
__device__ __forceinline__ void router_task(int wtask, int lane, const bf16_t* __restrict__ xn, const float* __restrict__ ss, const bf16_t* __restrict__ wr, const float* __restrict__ br,
                                            int (&oe)[4], float (&ow)[4]) {
    const int c = lane & 31, hi = lane >> 5; const int t = wtask * 32 + c;
    const bf16_t* ap = wr + (size_t)c * DM + 8 * hi; const bf16_t* bp = xn + (size_t)t * DM + 8 * hi;
    f32x16 acc;
#pragma unroll
    for (int r = 0; r < 16; ++r) acc[r] = 0.f;
#pragma unroll 16
    for (int ks = 0; ks < 64; ++ks) { const bf16x8 a = *(const bf16x8*)(ap + 16 * ks), b = *(const bf16x8*)(bp + 16 * ks); acc = __builtin_amdgcn_mfma_f32_32x32x16_bf16(a, b, acc, 0, 0, 0); }
    float v[16]; const float rstd = row_rstd(ss, t);
#pragma unroll
    for (int r = 0; r < 16; ++r) v[r] = acc[r] * rstd + br[crow(r, hi)];
    float tv[4]; int ti[4];
#pragma unroll
    for (int k = 0; k < 4; ++k) { float best = -INFINITY; int bi = 64;
#pragma unroll
        for (int r = 0; r < 16; ++r) { if (v[r] > best) { best = v[r]; bi = crow(r, hi); } }
        tv[k] = best; ti[k] = bi;
#pragma unroll
        for (int r = 0; r < 16; ++r) if (crow(r, hi) == bi) v[r] = -INFINITY; }
    float cv[8]; int ci[8];
#pragma unroll
    for (int k = 0; k < 4; ++k) { cv[k] = tv[k]; ci[k] = ti[k]; cv[4 + k] = __shfl_xor(tv[k], 32); ci[4 + k] = __shfl_xor(ti[k], 32); }
#pragma unroll
    for (int k = 0; k < 4; ++k) { float best = -INFINITY; int bi = 64;
#pragma unroll
        for (int q = 0; q < 8; ++q) { if (cv[q] > best || (cv[q] == best && ci[q] < bi)) { best = cv[q]; bi = ci[q]; } }
        tv[k] = best; ti[k] = bi;
#pragma unroll
        for (int q = 0; q < 8; ++q) if (ci[q] == bi) cv[q] = -INFINITY; }
    const float e1 = __expf(tv[1] - tv[0]), e2 = __expf(tv[2] - tv[0]), e3 = __expf(tv[3] - tv[0]); const float inv = 1.0f / (1.0f + e1 + e2 + e3);
    const float g[4] = {inv, e1 * inv, e2 * inv, e3 * inv};
#pragma unroll
    for (int k = 0; k < 4; ++k) { oe[k] = ti[k]; ow[k] = g[k]; }
}
__device__ __forceinline__ void combine_task(int t, int lane, const bf16_t* xin, float* xout, const unsigned char* __restrict__ ys, const int* tab, const int* __restrict__ toke, const int* __restrict__ tokr,
                                                 const float* __restrict__ tokw, const float* __restrict__ gfin) {
    const u32x2* xr = (const u32x2*)(xin + (size_t)t * DM) + lane; f32x4* xo = (f32x4*)(xout + (size_t)t * DM) + lane; f32x4 v[4];
#pragma unroll
    for (int j = 0; j < 4; ++j) { const u32x2 w = __builtin_nontemporal_load(xr + 64 * j); v[j] = (f32x4){bflo(w.x), bfhi(w.x), bflo(w.y), bfhi(w.y)}; }
    for (int k = 0; k < 4; ++k) { const int e = toke[t * 4 + k], r = tokr[t * 4 + k]; const float w = tokw[t * 4 + k]; const int start = tab[32 + e];
        const unsigned* yr = (const unsigned*)(ys + (size_t)(start + r) * DM) + lane;
#pragma unroll
        for (int j = 0; j < 4; ++j) { const int y = (int)__builtin_nontemporal_load(yr + 64 * j); const f32x2 lo = __builtin_amdgcn_cvt_pk_f32_fp8(y, false), hi = __builtin_amdgcn_cvt_pk_f32_fp8(y, true);
            v[j].x += w * lo.x; v[j].y += w * lo.y; v[j].z += w * hi.x; v[j].w += w * hi.y; } }
    float s = 0.f;
#pragma unroll
    for (int j = 0; j < 4; ++j) s += v[j].x * v[j].x + v[j].y * v[j].y + v[j].z * v[j].z + v[j].w * v[j].w;
    const float rstd = 1.0f / sqrtf(wave_sum(s) * (1.f / DM) + EPS);
#pragma unroll
    for (int j = 0; j < 4; ++j) { const f32x4 g = *((const f32x4*)gfin + lane + 64 * j); __builtin_nontemporal_store(v[j] * rstd * g, xo + 64 * j); }
}

#define GAS __attribute__((address_space(1)))
#define RLX_AGENT __ATOMIC_RELAXED, __HIP_MEMORY_SCOPE_AGENT
#define XB_TMO      128
#define XB_XCNT(j)  (256  + 64 * (j))
#define XB_XSUB(j)  (1280 + 64 * (j))
#define XB_XGEN(j)  (2304 + 64 * (j))
#define XB_TOP      3328
#define XB_TOPGEN   3392
#define XCD_BAR_WORDS 3456
#define XB_SPIN_CAP (1u << 18)
__device__ __forceinline__ unsigned xb_ld(unsigned* p)              { return __hip_atomic_load(p, __ATOMIC_RELAXED, __HIP_MEMORY_SCOPE_AGENT); }
__device__ __forceinline__ unsigned xb_add(unsigned* p, unsigned v) { return __hip_atomic_fetch_add(p, v, __ATOMIC_RELAXED, __HIP_MEMORY_SCOPE_AGENT); }
__device__ __forceinline__ unsigned xb_xcc_id() { return (unsigned)__builtin_amdgcn_s_getreg((3 << 11) | 20) & 0xFu; }
#define XB_SPIN(cond, bar) do { unsigned _sp = 0; while (cond) { __builtin_amdgcn_s_sleep(1); \
    if ((++_sp & 255u) == 0u) { if (xb_ld(&(bar)[XB_TMO])) break; if (_sp > XB_SPIN_CAP) { atomicAdd(&(bar)[XB_TMO], 1u); break; } } } } while (0)
struct XcdBarrier { unsigned* bar; unsigned x; };
__device__ __forceinline__ XcdBarrier xcd_barrier_post(unsigned* bar) {
    XcdBarrier b; b.bar = bar; b.x = xb_xcc_id();
    if (threadIdx.x == 0) (void)xb_add(&bar[XB_XCNT(b.x)], 1u);
    return b;
}
__device__ __forceinline__ void xcd_barrier_complete(unsigned* bar, unsigned x, unsigned& nloc, unsigned& nx) {
    const unsigned G = gridDim.x * gridDim.y * gridDim.z;
    unsigned sum, cnt, mine, sp = 0u;
    for (;;) {
        sum = 0u; cnt = 0u; mine = 0u;
#pragma unroll
        for (unsigned j = 0; j < 16; ++j) { const unsigned c = xb_ld(&bar[XB_XCNT(j)]); sum += c; cnt += (c > 0u) ? 1u : 0u; mine = (j == x) ? c : mine; }
        if (sum == G) break;
        __builtin_amdgcn_s_sleep(1);
        if ((++sp & 255u) == 0u) { if (xb_ld(&bar[XB_TMO])) break; if (sp > XB_SPIN_CAP) { atomicAdd(&bar[XB_TMO], 1u); break; } }
    }
    nloc = mine > 0u ? mine : 1u; nx = cnt > 0u ? cnt : 1u;
}
__device__ __forceinline__ void xcd_barrier(const XcdBarrier& b, unsigned& st  ) {
    asm volatile("s_waitcnt vmcnt(0)" ::: "memory");
    __syncthreads();
    unsigned stv = st;
    if (threadIdx.x == 0) {
        unsigned* bar = b.bar;
        __builtin_amdgcn_s_waitcnt(0);
        unsigned nloc = st & 0xffffu, nx = st >> 16;
        if (nloc == 0u) { xcd_barrier_complete(bar, b.x, nloc, nx); stv = nloc | (nx << 16); }
        const unsigned old = xb_add(&bar[XB_XSUB(b.x)], 1u);
        const unsigned gen = old / nloc;
        if (old + 1u == (gen + 1u) * nloc) {
            __builtin_amdgcn_fence(__ATOMIC_RELEASE, "agent");
            asm volatile("s_waitcnt vmcnt(0)" ::: "memory");
            const unsigned og = xb_add(&bar[XB_TOP], 1u);
            const unsigned tg = og / nx;
            if (og + 1u == (tg + 1u) * nx) xb_add(&bar[XB_TOPGEN], 1u);
            else XB_SPIN(xb_ld(&bar[XB_TOPGEN]) == tg, bar);
            __builtin_amdgcn_fence(__ATOMIC_ACQUIRE, "agent");
            xb_add(&bar[XB_XGEN(b.x)], 1u);
            asm volatile("s_waitcnt vmcnt(0)" ::: "memory");
        } else {
            XB_SPIN(xb_ld(&bar[XB_XGEN(b.x)]) == gen, bar);
            __builtin_amdgcn_fence(__ATOMIC_ACQUIRE, "agent");
            asm volatile("s_waitcnt vmcnt(0)" ::: "memory");
        }
    }
    st = __builtin_amdgcn_readfirstlane(stv);
    __syncthreads();
}

constexpr int LDS_BYTES = 147456;
constexpr int CW_BAR = 4096;
constexpr size_t CTL_ZERO_BYTES = 65536;
constexpr int NPHASE = 12;
struct Args { const float* in[22]; float* out; unsigned char* ws; int ph_lo, ph_hi; };

__global__ void __launch_bounds__(512, 2) mega(Args a) {
    extern __shared__ __attribute__((aligned(16))) unsigned char lds[];
    unsigned char* ws = a.ws; float* out = a.out;
    const float* x = a.in[0]; const float* mem = a.in[1]; const float* g_mix = a.in[2]; const float* w_in = a.in[3];
    const float* w_gla_gate = a.in[4]; const float* b_gla_gate = a.in[5]; const float* g_gla_head = a.in[6]; const float* w_out = a.in[7];
    const float* g_mem_q = a.in[8]; const float* g_mem_kv = a.in[9]; const float* w_mq = a.in[10]; const float* w_mk = a.in[11];
    const float* w_mv = a.in[12]; const float* w_mo = a.in[13]; const float* g_ffn = a.in[14]; const float* w_router = a.in[15];
    const float* b_router = a.in[16]; const float* w_gu = a.in[17]; const float* b_gu = a.in[18]; const float* w_down = a.in[19];
    const float* b_down = a.in[20]; const float* g_final = a.in[21];
    bf16_t* Wt_in = (bf16_t*)(ws + WS_WIN); bf16_t* Wt_out = (bf16_t*)(ws + WS_WOUT); bf16_t* Wq = (bf16_t*)(ws + WS_WQ); bf16_t* Wt_kv = (bf16_t*)(ws + WS_WKV);
    bf16_t* Wt_mo = (bf16_t*)(ws + WS_WMO); bf16_t* Wt_r = (bf16_t*)(ws + WS_WR); bf16_t* Wt_gu = (bf16_t*)(ws + WS_WGU); bf16_t* Wt_dn = (bf16_t*)(ws + WS_WDN);
    bf16_t* xn = (bf16_t*)(ws + WS_XN); bf16_t* memn = (bf16_t*)(ws + WS_MEMN); bf16_t* kv = (bf16_t*)(ws + WS_KV); bf16_t* Bs = (bf16_t*)(ws + WS_BS); bf16_t* Bo = (bf16_t*)(ws + WS_BO);
    bf16_t* proj = (bf16_t*)(ws + WS_PROJ); bf16_t* mix = (bf16_t*)(ws + WS_MIX);
    float* Sc = (float*)(ws + WS_S); bf16_t* P = (bf16_t*)(ws + WS_P); float* lg = (float*)(ws + WS_LG); int* toke = (int*)(ws + WS_TOKE); int* tokr = (int*)(ws + WS_TOKR);
    float* tokw = (float*)(ws + WS_TOKW); int* list = (int*)(ws + WS_LIST); unsigned char* ys = ws + WS_YS;
    unsigned char* Wq_gu = ws + WS_WGU; unsigned char* Wq_dn = ws + WS_WDN; unsigned char* x2q = ws + WS_S; unsigned char* act8 = ws + WS_ACT;
    float* lrs = (float*)(ws + WS_LG);
    float* UT = (float*)(ws + WS_S); float* decay = (float*)(ws + WS_LA); bf16_t* ST = (bf16_t*)(ws + WS_ORAW);
    unsigned* ctl = (unsigned*)(ws + WS_CTL); int* cnt = (int*)ctl + CW_CNT; float* ss1 = (float*)(ws + WS_LA + 8 * MiB); float* ss2 = (float*)(ws + WS_LA + 9 * MiB);

    const int G = gridDim.x, vb = blockIdx.x;
    XcdBarrier bar = xcd_barrier_post(ctl + CW_BAR); unsigned bar_st = 0u;
    const int ch_gw = __builtin_amdgcn_readfirstlane(vb * 8 + (int)(threadIdx.x >> 6)), ch_nW = G * 8;
    const int lo = a.ph_lo, hi = a.ph_hi;
    float* dmy = (float*)(ws + WS_DUMMY); (void)dmy;
#ifndef REPEAT_MASK
#define REPEAT_MASK 0
#endif
#define IN(k) (lo <= (k) && (k) < hi)
#define REP(k) for (int rep_ = 0; rep_ < 1 + ((REPEAT_MASK >> (k)) & 1); ++rep_)
#define SEAM(k) do { if (IN(k) && IN((k) + 1)) xcd_barrier(bar, bar_st); } while (0)
#define TIDS() int tid = threadIdx.x; LAUNDER(tid); const int lane = tid & 63; const int wid = __builtin_amdgcn_readfirstlane(tid >> 6); (void)lane; (void)wid

    if (IN(0)) REP(0) { TIDS(); const size_t gt = (size_t)vb * 512 + tid, gs = (size_t)G * 512;
        float* scr = (float*)(lds + wid * 8448);
        const int gw = vb * 8 + wid, ngw = G * 8;
        rms_body(gw, ngw, lane, x, xn, NTOK);
        rms_body(gw, ngw, lane, mem, memn, NB * MEML);
        conv_n_body(gt, gs, w_mq, Wq, g_mem_q, 1024, 1024, LOG2E / 16.0f);
        constexpr int I_IN = 16 * 97, I_SQ = 16 * 32, I_R = 16;
        constexpr int NITEMS = I_IN + 4 * I_SQ + I_R;
        for (int it = gw; it < NITEMS; it += ngw) { int r = it;
            if (r < I_IN) { conv_item<1>(scr, w_in, Wt_in, g_mix, 3088, 1024, 3088, r / 97, r % 97, lane); continue; } r -= I_IN;
            if (r < I_SQ) { conv_item<0>(scr, w_out, Wt_out, nullptr, 1024, 1024, 1024, r >> 5, r & 31, lane); continue; } r -= I_SQ;
            if (r < I_SQ) { conv_item<0>(scr, w_mk, Wt_kv, g_mem_kv, 1024, 1024, 1024, r >> 5, r & 31, lane); continue; } r -= I_SQ;
            if (r < I_SQ) { conv_item<0>(scr, w_mv, Wt_kv + (size_t)1024 * 1024, g_mem_kv, 1024, 1024, 1024, r >> 5, r & 31, lane); continue; } r -= I_SQ;
            if (r < I_SQ) { conv_item<0>(scr, w_mo, Wt_mo, nullptr, 1024, 1024, 1024, r >> 5, r & 31, lane); continue; } r -= I_SQ;
            { conv_item<0>(scr, w_router, Wt_r, g_ffn, 32, 1024, 32, r, 0, lane); } }
        __syncthreads(); }
    SEAM(0);
    if (IN(1)) REP(1) { DenseSched S{(const char*)xn, (const char*)Wt_in, 2048u, 2048u, 1024, 64, 12, 1 << 30, 0, G, vb}; EpiBf16 E{proj, PROJ_LD, 0}; gemm_run_host<true, 1>(lds, S, E, w_gu, ws, 0, 98304, ch_gw, ch_nW); }
    SEAM(1);
    if (IN(2)) REP(2) {
        for (int t = vb; t < 256; t += G) gla_pass_a(lds, t, xn, Wt_in + (size_t)3072 * 1024, proj, w_gla_gate, b_gla_gate, UT, decay);
        { TIDS(); for (int t = vb * 8 + wid; t < 4096; t += G * 8) sb_task(lds + wid * 4096, t, proj, mix, lane); }
        { TIDS(); for (int t = vb + G * wid; t < 1024; t += G * 8) memkv_task(t, lane, memn, Wt_kv, kv); } }
    SEAM(2);
    if (IN(3)) REP(3) {
        { TIDS(); for (int e = vb * 512 + tid; e < 65536; e += G * 512) gla_pass_b(e, UT, decay, ST); }
        { SchedWqk S{(const char*)kv, (const char*)Wq, 4096u, 2048u, 256, G / 2, vb - G / 2, 0}; EpiBf16 E{Bs, 1024, 0}; gemm_run<false>(lds, S, E); }
        { SchedVo S{(const char*)Wt_mo, (const char*)kv, 2048u, 4096u, 256, G / 2, vb - G / 2 - 32, 0}; EpiBf16 E{Bo, 1024, 0}; gemm_run<false>(lds, S, E); } }
    SEAM(3);
    if (IN(4)) REP(4) { TIDS(); for (int t = vb * 8 + wid; t < 2048; t += G * 8) gla_pass_c(lds + wid * 32 * GC_PITCH, t, ST, proj, g_gla_head, mix, lane); }
    SEAM(4);
#if PROBE_BARRIERS
    for (int pb_ = 0; pb_ < 8; ++pb_) xcd_barrier(bar, bar_st);
#endif
    if (IN(5)) REP(5) { DenseSched S{(const char*)mix, (const char*)Wt_out, 2048u, 2048u, 1024, 64, 4, 1 << 30, 0, G, vb}; EpiResidSS<false> E{x, rep_ ? (bf16_t*)dmy : xn, rep_ ? dmy + 16 * 1024 * 1024 : ss1, nullptr, nullptr}; gemm_run_host<false, 1>(lds, S, E, w_gu, ws, 98304, CH_GU, ch_gw, ch_nW); }
    SEAM(5);
    if (IN(6)) REP(6) { DenseSched S{(const char*)xn, (const char*)Bs, 2048u, 2048u, 1024, 64, 4, 32, (size_t)1024 * 2048, G, vb}; EpiSoftmax E{ss1, P}; gemm_run_host<false, 2>(lds, S, E, w_down, ws, CH_GU, CH_GU + 32768, ch_gw, ch_nW); }
    SEAM(6);
    if (IN(7)) REP(7) { DenseSched S{(const char*)P, (const char*)Bo, 2048u, 2048u, 1024, 64, 4, 32, (size_t)1024 * 2048, G, vb}; EpiResidSS<true> E{xn, rep_ ? (bf16_t*)dmy : xn, rep_ ? dmy + 16 * 1024 * 1024 : ss2, rep_ ? (unsigned char*)dmy + 40 * 1024 * 1024 : x2q, g_ffn}; gemm_run_host<false, 2>(lds, S, E, w_down, ws, CH_GU + 32768, CH_TOTAL, ch_gw, ch_nW); }
    SEAM(7);
    if (IN(8)) REP(8) { TIDS(); int* cntp = rep_ ? (int*)ctl + 2048 : cnt; int* listp = rep_ ? (int*)dmy + 1024 : list; float* lrsp = rep_ ? dmy + 4096 * 1024 : lrs; int* tokep = rep_ ? (int*)dmy + 1024 * 1024 : toke; int* tokrp = rep_ ? (int*)dmy + 2048 * 1024 : tokr; float* tokwp = rep_ ? dmy + 3072 * 1024 : tokw;
        int* lcnt = (int*)lds; int* gbase = (int*)lds + 32;
        for (int tb = vb; tb < NTOK / 64; tb += G) {
            if (tid < 32) lcnt[tid] = 0;
            __syncthreads();
            int oe[4] = {0, 0, 0, 0}; float ow[4] = {0.f, 0.f, 0.f, 0.f}; int lr[4] = {0, 0, 0, 0};
            if (wid < 2) { router_task(tb * 2 + wid, lane, xn, ss2, Wt_r, b_router, oe, ow);
                if (lane < 32) {
#pragma unroll
                    for (int k = 0; k < 4; ++k) lr[k] = atomicAdd(&lcnt[oe[k]], 1); } }
            __syncthreads();
            if (tid < 32) gbase[tid] = atomicAdd(&cntp[tid * 32], lcnt[tid]);
            __syncthreads();
            if (wid < 2 && lane < 32) { const int t = (tb * 2 + wid) * 32 + lane;
                const float rstd_t = row_rstd(ss2, t);
#pragma unroll
                for (int k = 0; k < 4; ++k) { const int r = gbase[oe[k]] + lr[k]; listp[oe[k] * NTOK + r] = t; lrsp[oe[k] * NTOK + r] = rstd_t; tokep[t * 4 + k] = oe[k]; tokrp[t * 4 + k] = r; tokwp[t * 4 + k] = ow[k]; } }
            __syncthreads(); } }
    SEAM(8);
    if (IN(9)) REP(9) { int* tab = (int*)(lds + 131072); { TIDS(); moe_build_table(tab, cnt, tid); }
        MoeSched<true> S{(const char*)x2q, (const char*)Wq_gu, 1024u, 1024u, 512, 8, (size_t)2048 * 1024, tab, list, 1, G, vb, 0}; EpiGU E{b_gu, act8, lrs}; gemm_run_fp8<true>(lds, S, E); }
    SEAM(9);
    if (IN(10)) REP(10) { int* tab = (int*)(lds + 131072); { TIDS(); moe_build_table(tab, cnt, tid); }
        MoeSched<false> S{(const char*)act8, (const char*)Wq_dn, 1024u, 1024u, 512, 4, (size_t)1024 * 1024, tab, list, 0, G, vb, 0}; EpiDown E{b_down, ys}; gemm_run_fp8<true>(lds, S, E); }
    SEAM(10);
    if (IN(11)) REP(11) { TIDS(); int* tab = (int*)(lds + 131072); moe_build_table(tab, cnt, tid);
        for (int t = vb * 8 + wid; t < NTOK; t += G * 8) combine_task(t, lane, xn, rep_ ? dmy : out, ys, tab, toke, tokr, tokw, g_final); }
#undef IN
#undef SEAM
#undef TIDS
}

#ifndef MK_PER_PHASE
#define MK_PER_PHASE 0
#endif
extern "C" void kernel_launch(void* const* d_in, const int* in_sizes, int n_in, void* d_out, int out_size, void* d_ws, size_t ws_size, hipStream_t stream) {
    static int grid = 0;
    if (grid == 0) {
        if (n_in != 22 || in_sizes[0] != NTOK * DM || out_size != NTOK * DM || ws_size < WS_END) { fprintf(stderr, "kernel_launch: unexpected shapes (n_in %d, ws %zu)\n", n_in, ws_size); grid = -1; return; }
        int dev = 0, cus = 0, per_cu = 0;
        if (hipGetDevice(&dev) != hipSuccess || hipDeviceGetAttribute(&cus, hipDeviceAttributeMultiprocessorCount, dev) != hipSuccess) { grid = -1; return; }
        if (hipFuncSetAttribute((const void*)mega, hipFuncAttributeMaxDynamicSharedMemorySize, LDS_BYTES) != hipSuccess) { fprintf(stderr, "kernel_launch: hipFuncSetAttribute failed\n"); grid = -1; return; }
        if (hipOccupancyMaxActiveBlocksPerMultiprocessor(&per_cu, (const void*)mega, 512, LDS_BYTES) != hipSuccess || per_cu < 1) fprintf(stderr, "kernel_launch: occupancy query says %d blocks/CU\n", per_cu);
        (void)hipGetLastError();
        grid = cus;
    }
    if (grid < 0) return;
    (void)hipMemsetAsync((char*)d_ws + WS_CTL, 0, CTL_ZERO_BYTES, stream);
    Args a{};
    for (int i = 0; i < 22; ++i) a.in[i] = (const float*)d_in[i];
    a.out = (float*)d_out; a.ws = (unsigned char*)d_ws;
#if MK_PER_PHASE
    for (int p = 0; p < NPHASE; ++p) { a.ph_lo = p; a.ph_hi = p + 1; hipLaunchKernelGGL(mega, dim3(grid), dim3(512), LDS_BYTES, stream, a); }
#else
    a.ph_lo = 0; a.ph_hi = NPHASE; hipLaunchKernelGGL(mega, dim3(grid), dim3(512), LDS_BYTES, stream, a);
#endif
}
```

```cpp
#include <hip/hip_runtime.h>
#include <cstdio>
#include <cstdint>
#ifndef PROBE_BARRIERS
#define PROBE_BARRIERS 0
#endif

typedef unsigned short bf16_t;
typedef short bf16x8 __attribute__((ext_vector_type(8)));
typedef float f32x4 __attribute__((ext_vector_type(4)));
typedef unsigned u32x4 __attribute__((ext_vector_type(4)));
typedef unsigned u32x2 __attribute__((ext_vector_type(2)));
typedef float f32x2 __attribute__((ext_vector_type(2)));
#define LDSP __attribute__((address_space(3)))
#define LAUNDER(x) asm volatile("" : "+v"(x))

constexpr int NB = 2, SEQ = 8192, NTOK = NB * SEQ, DM = 1024, MEML = 256;
constexpr int NEXP = 32, TOPK = 4, NASSIGN = NTOK * TOPK;
constexpr int PROJ_LD = 3072;
constexpr int C_QG = 0, C_KG = 256, C_VG = 512, C_RG = 1024, C_QS = 1536, C_KS = 2048, C_VS = 2560, C_GLR = 3072;
constexpr float LOG2E = 1.4426950408889634f;
constexpr float EPS = 1e-5f;

__device__ __forceinline__ unsigned f2bf(float f) { unsigned u = __float_as_uint(f); return (u + 0x7fffu + ((u >> 16) & 1u)) >> 16; }
__device__ __forceinline__ unsigned pk2(float lo, float hi) { return f2bf(lo) | (f2bf(hi) << 16); }
__device__ __forceinline__ float bf2f(bf16_t h) { return __uint_as_float(((unsigned)h) << 16); }
__device__ __forceinline__ float bflo(unsigned w) { return __uint_as_float(w << 16); }
__device__ __forceinline__ float bfhi(unsigned w) { return __uint_as_float(w & 0xffff0000u); }

constexpr size_t MiB = 1u << 20;
constexpr size_t WS_CTL = 0;
constexpr size_t WS_WIN = 1 * MiB;
constexpr size_t WS_WOUT = 8 * MiB;
constexpr size_t WS_WQ = 10 * MiB;
constexpr size_t WS_WKV = 12 * MiB;
constexpr size_t WS_WMO = 16 * MiB;
constexpr size_t WS_WR = 18 * MiB;
constexpr size_t WS_WGU = 20 * MiB;
constexpr size_t WS_WDN = 148 * MiB;
constexpr size_t WS_XN = 212 * MiB;
constexpr size_t WS_MEMN = 244 * MiB;
constexpr size_t WS_KV = 245 * MiB;
constexpr size_t WS_BS = 247 * MiB;
constexpr size_t WS_BO = 251 * MiB;
constexpr size_t WS_PROJ = 256 * MiB;
constexpr size_t WS_LA = 360 * MiB;
constexpr size_t WS_ORAW = 376 * MiB;
constexpr size_t WS_MIX = 408 * MiB;
constexpr size_t WS_S = 440 * MiB;
constexpr size_t WS_P = 504 * MiB;
constexpr size_t WS_LG = 536 * MiB;
constexpr size_t WS_TOKE = 538 * MiB;
constexpr size_t WS_TOKR = 539 * MiB;
constexpr size_t WS_TOKW = 540 * MiB;
constexpr size_t WS_LIST = 541 * MiB;
constexpr size_t WS_ACT = 544 * MiB;
constexpr size_t WS_YS = 674 * MiB;
constexpr size_t WS_DUMMY = 804 * MiB;
constexpr size_t WS_END = 872 * MiB;
constexpr int CW_CNT = 1024;

template <int MAP> __device__ __forceinline__ int srccol(int n, float& sc) {
    sc = 1.f;
    if (MAP == 0) return n;
    if (MAP == 1) {
        if (n < 256) { sc = 0.125f; return n; }
        if (n < 1024) return n;
        if (n < 3072) { if (n >= C_QS && n < C_KS) sc = 0.125f * LOG2E; return n + 16; }
        if (n < 3088) return 1024 + (n - 3072);
        return -1;
    }
    { const int ct = n >> 8, w = n & 255; return (w < 128) ? (128 * ct + w) : (1024 + 128 * ct + (w - 128)); }
}
template <int MAP>
__device__ __forceinline__ void conv_item(float* scr, const float* __restrict__ src, bf16_t* __restrict__ dst, const float* __restrict__ gain, int ldsrc, int K, int nrows, int kb, int nb, int lane) {
    const int k0 = kb * 64, n0 = nb * 32; float sc; const int c0 = srccol<MAP>(n0, sc);
    const int half = lane >> 5, l31 = lane & 31;
    const float* s0 = src + (size_t)(k0 + half) * ldsrc + c0 + l31;
    float v[32];
#pragma unroll
    for (int i = 0; i < 32; ++i) v[i] = __builtin_nontemporal_load(s0 + (size_t)(2 * i) * ldsrc);
#pragma unroll
    for (int i = 0; i < 32; ++i) { const int kk = 2 * i + half; const float g = (gain ? gain[k0 + kk] : 1.f) * sc; scr[kk * 33 + l31] = v[i] * g; }
    asm volatile("s_waitcnt lgkmcnt(0)" ::: "memory");
    const int c = lane & 7;
#pragma unroll
    for (int j = 0; j < 4; ++j) { const int n = (lane >> 3) + 8 * j; const float* s = scr + (8 * c) * 33 + n;
        u32x4 o; o.x = pk2(s[0 * 33], s[1 * 33]); o.y = pk2(s[2 * 33], s[3 * 33]); o.z = pk2(s[4 * 33], s[5 * 33]); o.w = pk2(s[6 * 33], s[7 * 33]);
        if (n0 + n < nrows) *(u32x4*)(dst + (size_t)(n0 + n) * K + k0 + 8 * c) = o; }
    asm volatile("s_waitcnt lgkmcnt(0)" ::: "memory");
}
__device__ __forceinline__ unsigned pk4_fp8(float a, float b, float c, float d) { int w = __builtin_amdgcn_cvt_pk_fp8_f32(a, b, 0, false); w = __builtin_amdgcn_cvt_pk_fp8_f32(c, d, w, true); return (unsigned)w; }
template <int MAP>
__device__ __forceinline__ void conv_item8(float* scr, const float* __restrict__ src, unsigned char* __restrict__ dst, const float* __restrict__ gain, int ldsrc, int K, int nrows, int kb, int nb, int lane, float mul) {
    const int k0 = kb * 64, n0 = nb * 32; float sc; const int c0 = srccol<MAP>(n0, sc); sc *= mul;
    const int half = lane >> 5, l31 = lane & 31;
    const float* s0 = src + (size_t)(k0 + half) * ldsrc + c0 + l31;
    float v[32];
#pragma unroll
    for (int i = 0; i < 32; ++i) v[i] = __builtin_nontemporal_load(s0 + (size_t)(2 * i) * ldsrc);
#pragma unroll
    for (int i = 0; i < 32; ++i) { const int kk = 2 * i + half; const float g = (gain ? gain[k0 + kk] : 1.f) * sc; scr[kk * 33 + l31] = v[i] * g; }
    asm volatile("s_waitcnt lgkmcnt(0)" ::: "memory");
    const int c = lane & 3;
#pragma unroll
    for (int j = 0; j < 2; ++j) { const int n = (lane >> 2) + 16 * j; const float* s = scr + (16 * c) * 33 + n;
        u32x4 o; o.x = pk4_fp8(s[0 * 33], s[1 * 33], s[2 * 33], s[3 * 33]); o.y = pk4_fp8(s[4 * 33], s[5 * 33], s[6 * 33], s[7 * 33]);
        o.z = pk4_fp8(s[8 * 33], s[9 * 33], s[10 * 33], s[11 * 33]); o.w = pk4_fp8(s[12 * 33], s[13 * 33], s[14 * 33], s[15 * 33]);
        if (n0 + n < nrows) __builtin_nontemporal_store(o, (u32x4*)(dst + (size_t)(n0 + n) * K + k0 + 16 * c)); }
    asm volatile("s_waitcnt lgkmcnt(0)" ::: "memory");
}
__device__ __forceinline__ void conv_n_body(size_t gtid, size_t gsz, const float* __restrict__ src, bf16_t* __restrict__ dst, const float* __restrict__ gain, int K, int nrows, float sc) {
    const int kc8 = K / 8; const size_t total = (size_t)nrows * kc8;
    for (size_t idx = gtid; idx < total; idx += gsz) {
        const int kc = (int)(idx % kc8), n = (int)(idx / kc8);
        const float g = gain[n] * sc; const f32x4 a = __builtin_nontemporal_load((const f32x4*)(src + (size_t)n * K + kc * 8)), b = __builtin_nontemporal_load((const f32x4*)(src + (size_t)n * K + kc * 8 + 4));
        u32x4 o; o.x = pk2(a.x * g, a.y * g); o.y = pk2(a.z * g, a.w * g); o.z = pk2(b.x * g, b.y * g); o.w = pk2(b.z * g, b.w * g);
        *(u32x4*)(dst + (size_t)n * K + kc * 8) = o;
    }
}

__device__ __forceinline__ float wave_sum(float v) {
#pragma unroll
    for (int o = 1; o < 64; o <<= 1) v += __shfl_xor(v, o);
    return v;
}
__device__ __forceinline__ void rms_body(int gw, int ngw, int lane, const float* __restrict__ x, bf16_t* __restrict__ out, int nrows) {
    for (int row = gw; row < nrows; row += ngw) {
        const f32x4* xr = (const f32x4*)(x + (size_t)row * DM) + lane; f32x4 v[4]; float s = 0.f;
#pragma unroll
        for (int j = 0; j < 4; ++j) { v[j] = __builtin_nontemporal_load(xr + 64 * j); s += v[j].x * v[j].x + v[j].y * v[j].y + v[j].z * v[j].z + v[j].w * v[j].w; }
        const float rstd = 1.0f / sqrtf(wave_sum(s) * (1.f / DM) + EPS);
        u32x2* o = (u32x2*)(out + (size_t)row * DM) + lane;
#pragma unroll
        for (int j = 0; j < 4; ++j) { u32x2 w; w.x = pk2(v[j].x * rstd, v[j].y * rstd); w.y = pk2(v[j].z * rstd, v[j].w * rstd); o[64 * j] = w; }
    }
}

constexpr int CH_GU_ITEMS = 32 * 32 * 32;
constexpr int CH_ITEMS = CH_GU_ITEMS + 32 * 16 * 32;
constexpr int CH_LDS = 131072;
typedef unsigned v2u __attribute__((ext_vector_type(2)));
typedef unsigned v4u __attribute__((ext_vector_type(4)));
struct ConvHost { const float* src; unsigned char* ws; int it0, nW, hi, q; };
template <bool GU> __device__ __forceinline__ void ch_decode(int it, unsigned& soff, unsigned& doff) {
    if (GU) { const unsigned e = (unsigned)it >> 10, nb = ((unsigned)it >> 5) & 31u, k32 = (unsigned)it & 31u;
        soff = (e << 23) | (k32 << 18) | ((nb & 2u) << 11) | ((nb >> 2) << 9) | ((nb & 1u) << 8);
        doff = (unsigned)WS_WGU + (e << 21) + (nb << 16) + (k32 << 5); }
    else { const unsigned t = (unsigned)(it - CH_GU_ITEMS), e = t >> 9, nb = (t >> 5) & 15u, k32 = t & 31u;
        soff = (e << 22) | (k32 << 17) | (nb << 8);
        doff = (unsigned)WS_WDN + (e << 20) + (nb << 16) + (k32 << 5); }
}
template <bool GU> __device__ __forceinline__ void ch_issue(ConvHost& H, f32x2 (&cv)[4], unsigned voffL) {
    constexpr unsigned LD4 = GU ? 8192u : 4096u;
    const int q = __builtin_amdgcn_readfirstlane(H.q); const int it = H.it0 + H.nW * (q >> 2), itc = it < H.hi ? it : H.hi - 1;
    unsigned soff, doff; ch_decode<GU>(itc, soff, doff); soff += (unsigned)(q & 3) * 8u * LD4;
    const __amdgpu_buffer_rsrc_t r = __builtin_amdgcn_make_buffer_rsrc((void*)H.src, 0, 0x7fffffff, 0x00020000);
#pragma unroll
    for (int i = 0; i < 4; ++i) cv[i] = __builtin_bit_cast(f32x2, __builtin_amdgcn_raw_buffer_load_b64(r, (int)voffL, (int)(soff + (unsigned)i * LD4), 2));
    H.q = q + 1;
}
template <bool GU> __device__ __forceinline__ void ch_finish(const ConvHost& H, int qf, const f32x2 (&cv)[4], LDSP unsigned char* tile, int lane) {
    constexpr float SC = (float)(1 << 6);
    const int sf = qf & 3, itf = H.it0 + H.nW * (qf >> 2);
    v2u o; o.x = pk4_fp8(cv[0].x * SC, cv[1].x * SC, cv[2].x * SC, cv[3].x * SC); o.y = pk4_fp8(cv[0].y * SC, cv[1].y * SC, cv[2].y * SC, cv[3].y * SC);
    *(LDSP v2u*)(tile + (unsigned)((2 * sf + (lane >> 5)) * 64 + 2 * (lane & 31)) * 4u) = o;
    if (qf >= 0 && sf == 3 && itf < H.hi) {
        unsigned soff, doff; ch_decode<GU>(itf, soff, doff);
        const int r = lane >> 1, c = lane & 1; const LDSP unsigned* tw = (const LDSP unsigned*)tile + (4 * c) * 64 + r;
        v4u a, b; a.x = tw[0]; a.y = tw[64]; a.z = tw[128]; a.w = tw[192]; b.x = tw[32]; b.y = tw[96]; b.z = tw[160]; b.w = tw[224];
        const __amdgpu_buffer_rsrc_t w = __builtin_amdgcn_make_buffer_rsrc((void*)H.ws, 0, 0x7fffffff, 0x00020000);
        const unsigned voffS = (unsigned)r * 1024u + (unsigned)c * 16u;
        __builtin_amdgcn_raw_buffer_store_b128(a, w, (int)voffS, (int)doff, 0);
        __builtin_amdgcn_raw_buffer_store_b128(b, w, (int)voffS, (int)(doff + 32768u), 0); }
}

struct GUnit { unsigned ao, bo; int row0, col0, e, valid, aux; };

__host__ __device__ __forceinline__ int lds_byte(int r, int c) { const int st = (r >> 4) * 2 + (c >> 5), rr = r & 15, cc = c & 31, ob = rr * 64 + cc * 2; return st * 1024 + (ob ^ (((ob >> 9) & 1) << 5)); }
__host__ __device__ __forceinline__ void stage_rc(int b, int& R, int& C) { const int st = b / 1024, sb = b % 1024, swz = sb ^ (((sb >> 9) & 1) << 5); R = (st >> 1) * 16 + swz / 64; C = (st & 1) * 32 + (swz % 64) / 2; }
__host__ __device__ __forceinline__ int perm32(int rho) { const int n = rho >> 4, i = rho & 15; return 8 * (i >> 2) + 4 * n + (i & 3); }
constexpr int HTB = 128 * 64 * 2;
typedef int v8i __attribute__((ext_vector_type(8)));
typedef int v4i __attribute__((ext_vector_type(4)));
struct Frag2 { bf16x8 h[2]; };
template <bool F> struct FragT { typedef Frag2 T; };
template <> struct FragT<true> { typedef v8i T; };
template <class Sched, class Epi, bool ALIGN_EPI, bool FP8 = false, int SCALE_B = 0x7f, int HOSTM = 0>
__device__ __forceinline__ void gemm_phase(unsigned char* lds_flat, const Sched& S, const Epi& E, ConvHost& H) {
    LDSP unsigned char* lds = (LDSP unsigned char*)(unsigned)(uintptr_t)lds_flat;
    int tid = threadIdx.x; LAUNDER(tid);
    const int wid = __builtin_amdgcn_readfirstlane(tid >> 6), lane = tid & 63, wr = wid >> 2, wc = wid & 3, fr = lane & 15, fq = lane >> 4;
    const int nt = S.K / 64;
    int Rr[2], Cc[2];
#pragma unroll
    for (int i = 0; i < 2; ++i) stage_rc(tid * 16 + i * 8192, Rr[i], Cc[i]);
    unsigned voffB[2][2];
#pragma unroll
    for (int h = 0; h < 2; ++h)
#pragma unroll
        for (int i = 0; i < 2; ++i) voffB[h][i] = (unsigned)(128 * h + (Rr[i] & ~31) + perm32(Rr[i] & 31)) * S.ldb + (unsigned)Cc[i] * 2u;
    const unsigned ldsw = (unsigned)wid * 1024u;
    constexpr bool HOST = HOSTM != 0, HGU = HOSTM == 1;
    const int aoff = lds_byte(wr * 64 + fr, fq * 8), boff = lds_byte(wc * 32 + fr, fq * 8);
    constexpr int KSUB = 1024;
#define PG8_SA(b, h) (((b) * 2 + (h)) * HTB)
#define PG8_SB(b, h) ((4 + (b) * 2 + (h)) * HTB)
#define PG8_STAGE(bufoff, rsrc, voff, soff) do { _Pragma("unroll") for (int _i = 0; _i < 2; ++_i) \
        __builtin_amdgcn_raw_ptr_buffer_load_lds(rsrc, (LDSP unsigned*)(lds + (bufoff) + ldsw + _i * 8192), 16, (int)(voff)[_i], (int)(soff), 0, 0); } while (0)
#define PG8_LDF(dst, addr) do { const bf16x8 lo_ = *(const LDSP bf16x8*)(addr); const bf16x8 hi_ = *(const LDSP bf16x8*)((addr) + KSUB); \
        if constexpr (FP8) dst = __builtin_shufflevector(__builtin_bit_cast(v4i, lo_), __builtin_bit_cast(v4i, hi_), 0, 1, 2, 3, 4, 5, 6, 7); else { dst.h[0] = lo_; dst.h[1] = hi_; } } while (0)
#define PG8_LDA(dst, b, h) do { _Pragma("unroll") for (int m = 0; m < 4; ++m) PG8_LDF(dst[m], lds + PG8_SA(b, h) + aoff + m * 2048); } while (0)
#define PG8_LDB(dst, b, h) do { _Pragma("unroll") for (int n = 0; n < 2; ++n) PG8_LDF(dst[n], lds + PG8_SB(b, h) + boff + n * 2048); } while (0)
#define PG8_MMA(ai, bj, At, Bt) do { __builtin_amdgcn_s_setprio(1); _Pragma("unroll") for (int m = 0; m < 4; ++m) _Pragma("unroll") for (int n = 0; n < 2; ++n) { \
        if constexpr (FP8) asm volatile("v_mfma_scale_f32_16x16x128_f8f6f4 %0, %1, %2, %0, %3, %4 op_sel_hi:[0,0,0]" : "+v"(acc[ai][bj][m][n]) : "v"(Bt[n]), "v"(At[m]), "v"(sclB), "v"(sclA)); \
        else { _Pragma("unroll") for (int k = 0; k < 2; ++k) acc[ai][bj][m][n] = __builtin_amdgcn_mfma_f32_16x16x32_bf16(Bt[n].h[k], At[m].h[k], acc[ai][bj][m][n], 0, 0, 0); } } \
        __builtin_amdgcn_s_setprio(0); } while (0)
#define PG8_MMA_M(ai, bj, m, At, Bt) do { _Pragma("unroll") for (int n = 0; n < 2; ++n) _Pragma("unroll") for (int k = 0; k < 2; ++k) \
        acc[ai][bj][m][n] = __builtin_amdgcn_mfma_f32_16x16x32_bf16(Bt[n].h[k], At[m].h[k], acc[ai][bj][m][n], 0, 0, 0); } while (0)
#define PG8_MMA_H(cv) do { if constexpr (!FP8) { __builtin_amdgcn_s_setprio(1); \
        PG8_MMA_M(0, 0, 0, At, B0); PG8_SCHED; { CH_LANE(); ch_finish<HGU>(H, __builtin_amdgcn_readfirstlane(H.q) - 2, cv, ctile, cl_); } PG8_SCHED; \
        PG8_MMA_M(0, 0, 1, At, B0); PG8_MMA_M(0, 0, 2, At, B0); PG8_MMA_M(0, 0, 3, At, B0); PG8_SCHED; ch_issue<HGU>(H, cv, voffL); PG8_SCHED; \
        PG8_MMA_M(0, 1, 0, At, B1); PG8_MMA_M(0, 1, 1, At, B1); PG8_MMA_M(0, 1, 2, At, B1); PG8_MMA_M(0, 1, 3, At, B1); __builtin_amdgcn_s_setprio(0); } } while (0)
#define CH_LANE() int cl_ = threadIdx.x; LAUNDER(cl_); cl_ &= 63
#define PG8_WAIT_V(n) asm volatile("s_waitcnt vmcnt(" #n ")" ::: "memory")
#define PG8_WAIT_L(n) asm volatile("s_waitcnt lgkmcnt(" #n ")" ::: "memory")
#define PG8_BAR __builtin_amdgcn_s_barrier()
#define PG8_SCHED __builtin_amdgcn_sched_barrier(0)
    GUnit cur, nxt; int ui = 0;
    f32x2 cvx[4], cvy[4]; unsigned voffL = 0; (void)voffL; LDSP unsigned char* const ctile = lds + CH_LDS + wid * 2048; (void)ctile;
    if constexpr (HOST) { voffL = (unsigned)(lane >> 5) * 4u * (HGU ? 8192u : 4096u) + (unsigned)(lane & 31) * 8u;
#pragma unroll
        for (int i = 0; i < 4; ++i) { cvx[i] = (f32x2){0.f, 0.f}; cvy[i] = (f32x2){0.f, 0.f}; } }
    if (S.next(0, cur)) {
    const __amdgpu_buffer_rsrc_t rA = __builtin_amdgcn_make_buffer_rsrc((void*)S.A, 0, 0x7fffffff, 0x00020000);
    const __amdgpu_buffer_rsrc_t rB = __builtin_amdgcn_make_buffer_rsrc((void*)S.Bt, 0, 0x7fffffff, 0x00020000);
    unsigned oc[2][2], on[2][2];
#pragma unroll
    for (int h = 0; h < 2; ++h)
#pragma unroll
        for (int i = 0; i < 2; ++i) oc[h][i] = S.a_off(cur, 128 * h + Rr[i]) + (unsigned)Cc[i] * 2u;
    f32x4 acc[2][2][4][2];
#pragma unroll
    for (int a = 0; a < 2; ++a)
#pragma unroll
        for (int b = 0; b < 2; ++b)
#pragma unroll
            for (int m = 0; m < 4; ++m)
#pragma unroll
                for (int n = 0; n < 2; ++n) acc[a][b][m][n] = (f32x4){0.f, 0.f, 0.f, 0.f};
    typedef typename FragT<FP8>::T frag_t;
    frag_t At[4], B0[2], B1[2];
    const unsigned kstep = 128;
    const int sclB = SCALE_B * 0x01010101, sclA = 0x7f7f7f7f; (void)sclA; (void)sclB;
    PG8_STAGE(PG8_SB(0, 0), rB, voffB[0], cur.bo); PG8_STAGE(PG8_SB(0, 1), rB, voffB[1], cur.bo); PG8_STAGE(PG8_SA(0, 0), rA, oc[0], cur.ao); PG8_STAGE(PG8_SA(0, 1), rA, oc[1], cur.ao);
    if (wr == 1) PG8_BAR;
    PG8_WAIT_V(2); PG8_BAR;
    PG8_STAGE(PG8_SB(1, 0), rB, voffB[0], cur.bo + kstep); PG8_STAGE(PG8_SA(1, 0), rA, oc[0], cur.ao + kstep); PG8_STAGE(PG8_SB(1, 1), rB, voffB[1], cur.bo + kstep);
    PG8_WAIT_V(6); PG8_BAR;
    for (;;) {
        const bool has_next = S.next(ui + 1, nxt);
        if (!has_next) nxt = cur;
        const unsigned nA = nxt.ao, nB = nxt.bo;
        { int t2 = threadIdx.x; LAUNDER(t2);
#pragma unroll
          for (int i = 0; i < 2; ++i) { int R_, C_; stage_rc(t2 * 16 + i * 8192, R_, C_);
#pragma unroll
              for (int h = 0; h < 2; ++h) on[h][i] = S.a_off(nxt, 128 * h + R_) + (unsigned)C_ * 2u; } }
        for (int t = 0; t < nt; t += 2) {
            const bool last = (t == nt - 2);
            const unsigned k1 = cur.ao + (unsigned)(t + 1) * kstep;
            const unsigned a2 = last ? nA : cur.ao + (unsigned)(t + 2) * kstep, b2 = last ? nB : cur.bo + (unsigned)(t + 2) * kstep, a3 = a2 + kstep, b3 = b2 + kstep;
            unsigned o2[2][2];
#pragma unroll
            for (int h = 0; h < 2; ++h)
#pragma unroll
                for (int i = 0; i < 2; ++i) o2[h][i] = last ? on[h][i] : oc[h][i];
            PG8_LDB(B0, 0, 0); PG8_LDB(B1, 0, 1); PG8_SCHED; PG8_LDA(At, 0, 0); PG8_STAGE(PG8_SA(1, 1), rA, oc[1], k1);
            if constexpr (HOST) PG8_WAIT_V(12); else PG8_WAIT_V(8);
            PG8_WAIT_L(0); PG8_BAR;
            if constexpr (HOST) { PG8_MMA_H(cvx); } else { PG8_MMA(0, 0, At, B0); PG8_MMA(0, 1, At, B1); }
            PG8_BAR; PG8_SCHED;
            PG8_LDA(At, 0, 1); PG8_STAGE(PG8_SB(0, 0), rB, voffB[0], b2); PG8_STAGE(PG8_SB(0, 1), rB, voffB[1], b2); PG8_STAGE(PG8_SA(0, 0), rA, o2[0], a2);
            if constexpr (HOST) PG8_WAIT_V(12); else PG8_WAIT_V(8);
            PG8_WAIT_L(0); PG8_BAR; PG8_MMA(1, 0, At, B0); PG8_MMA(1, 1, At, B1); PG8_BAR; PG8_SCHED;
            PG8_LDB(B0, 1, 0); PG8_LDB(B1, 1, 1); PG8_SCHED; PG8_LDA(At, 1, 0); PG8_STAGE(PG8_SA(0, 1), rA, o2[1], a2);
            if constexpr (HOST) PG8_WAIT_V(12); else PG8_WAIT_V(8);
            PG8_WAIT_L(0); PG8_BAR;
            if constexpr (HOST) { PG8_MMA_H(cvy); } else { PG8_MMA(0, 0, At, B0); PG8_MMA(0, 1, At, B1); }
            PG8_BAR; PG8_SCHED;
            PG8_LDA(At, 1, 1); PG8_STAGE(PG8_SB(1, 0), rB, voffB[0], b3); PG8_STAGE(PG8_SB(1, 1), rB, voffB[1], b3); PG8_STAGE(PG8_SA(1, 0), rA, o2[0], a3);
            if constexpr (HOST) PG8_WAIT_V(12); else PG8_WAIT_V(8);
            PG8_WAIT_L(0); PG8_BAR; PG8_MMA(1, 0, At, B0); PG8_MMA(1, 1, At, B1); PG8_BAR; PG8_SCHED;
        }
        if constexpr (FP8) asm volatile("s_nop 15\n\ts_nop 15" ::: "memory");
        if constexpr (ALIGN_EPI) { if (wr == 0) PG8_BAR; }
        if constexpr (!Epi::AFTER_DRAIN) E(acc, cur, wr, wc, fr, fq);
        if (!has_next) break;
#pragma unroll
        for (int a = 0; a < 2; ++a)
#pragma unroll
            for (int b = 0; b < 2; ++b)
#pragma unroll
                for (int m = 0; m < 4; ++m)
#pragma unroll
                    for (int n = 0; n < 2; ++n) acc[a][b][m][n] = (f32x4){0.f, 0.f, 0.f, 0.f};
        cur = nxt; ++ui;
#pragma unroll
        for (int h = 0; h < 2; ++h)
#pragma unroll
            for (int i = 0; i < 2; ++i) oc[h][i] = on[h][i];
        if constexpr (ALIGN_EPI) { if (wr == 1) PG8_BAR; }
    }
    PG8_WAIT_V(0);
    if constexpr (HOST) { CH_LANE(); const int q_ = __builtin_amdgcn_readfirstlane(H.q); if (q_ >= 2) { ch_finish<HGU>(H, q_ - 2, cvx, ctile, cl_); ch_finish<HGU>(H, q_ - 1, cvy, ctile, cl_); } }
    if constexpr (!ALIGN_EPI) { if (wr == 0) PG8_BAR; }
    PG8_BAR;
    if constexpr (Epi::AFTER_DRAIN) E.fused(acc, cur, wr, wc, fr, fq, lds_flat, wid, lane);
    }
    if constexpr (HOST) {
        CH_LANE(); H.q = (__builtin_amdgcn_readfirstlane(H.q) + 3) & ~3;
        while (H.it0 + H.nW * (__builtin_amdgcn_readfirstlane(H.q) >> 2) < H.hi) { const int q_ = __builtin_amdgcn_readfirstlane(H.q); ch_issue<HGU>(H, cvx, voffL); ch_finish<HGU>(H, q_, cvx, ctile, cl_); } }
#undef PG8_SA
#undef PG8_SB
#undef PG8_STAGE
#undef PG8_LDA
#undef PG8_LDF
#undef PG8_LDB
#undef PG8_MMA
#undef PG8_WAIT_V
#undef PG8_WAIT_L
#undef PG8_BAR
#undef PG8_SCHED
#undef PG8_MMA_M
#undef PG8_MMA_H
#undef CH_LANE
}
template <bool ALIGN, class Sched, class Epi> __device__ __forceinline__ void gemm_run(unsigned char* lds, const Sched& S, const Epi& E) {
    ConvHost none{}; gemm_phase<Sched, Epi, ALIGN>(lds, S, E, none);
}
template <bool ALIGN, int HOSTM, class Sched, class Epi> __device__ __forceinline__ void gemm_run_host(unsigned char* lds, const Sched& S, const Epi& E, const float* src, unsigned char* ws, int lo, int hi, int gw, int nW) {
    ConvHost H{src, ws, lo + gw, nW, hi, 0}; gemm_phase<Sched, Epi, ALIGN, false, 0x7f, HOSTM>(lds, S, E, H);
}
constexpr int WSCALE_LOG2 = 6;
template <bool ALIGN, class Sched, class Epi> __device__ __forceinline__ void gemm_run_fp8(unsigned char* lds, const Sched& S, const Epi& E) {
    ConvHost none{}; gemm_phase<Sched, Epi, ALIGN, true, 127 - WSCALE_LOG2>(lds, S, E, none);
}

struct DenseSched {
    const char* A; const char* Bt; unsigned lda, ldb; int K; int nM, nN; int pm_per_b; size_t zB; int G, c;
    __device__ __forceinline__ bool next(int i, GUnit& u) const {
        int pm, pn;
        if (G == 256 && (nN & 3) == 0 && nM * nN >= 256) {
            const int j = c & 7, q = c >> 3, s = i * 8 + j, ncg = nN >> 2; pm = (s / ncg) * 8 + (q >> 2); pn = (s % ncg) * 4 + (q & 3); if (c < 0 || pm >= nM) return false; }
        else { const long L = (long)i * G + c; if (c < 0 || L >= (long)nM * nN) return false; pm = (int)(L / nN); pn = (int)(L % nN); }
        u.ao = (unsigned)pm * 256u * lda; u.bo = (unsigned)((size_t)(pm / pm_per_b) * zB) + (unsigned)pn * 256u * ldb; u.row0 = pm * 256; u.col0 = pn * 256; u.e = 0; u.valid = 256; u.aux = 0; return true;
    }
    __device__ __forceinline__ unsigned a_off(const GUnit&, int r) const { return (unsigned)r * lda; }
};
struct SchedWqk {
    const char* A; const char* Bt; unsigned lda, ldb; int K; int G, c, pad;
    __device__ __forceinline__ bool next(int i, GUnit& u) const {
        const int L = i * G + c; if (c < 0 || L >= 32) return false; const int z = L >> 2, pn = L & 3, b = z >> 2, h = z & 3;
        u.ao = (unsigned)b * 256u * 4096u + h * 512u; u.bo = (unsigned)pn * 256u * 2048u + h * 512u; u.row0 = z * 256; u.col0 = pn * 256; u.e = 0; u.valid = 256; u.aux = 0; return true;
    }
    __device__ __forceinline__ unsigned a_off(const GUnit&, int r) const { return (unsigned)r * lda; }
};
struct SchedVo {
    const char* A; const char* Bt; unsigned lda, ldb; int K; int G, c, pad;
    __device__ __forceinline__ bool next(int i, GUnit& u) const {
        const int L = i * G + c; if (c < 0 || L >= 32) return false; const int z = L >> 2, pm = L & 3, b = z >> 2, h = z & 3;
        u.ao = (unsigned)pm * 256u * 2048u + h * 512u; u.bo = (unsigned)b * 256u * 4096u + 2048u + h * 512u; u.row0 = b * 1024 + pm * 256; u.col0 = h * 256; u.e = 0; u.valid = 256; u.aux = 0; return true;
    }
    __device__ __forceinline__ unsigned a_off(const GUnit&, int r) const { return (unsigned)r * lda; }
};
template <bool GATHER> struct MoeSched {
    const char* A; const char* Bt; unsigned lda, ldb; int K; int nN; size_t zB;
    const int* tab; const int* list; int gather; int G, c, pad;
    __device__ __forceinline__ bool next(int i, GUnit& u) const {
        int T, pn;
        if (G == 256) { const int j = c & 7, q = c >> 3, s = i * 8 + j;
            if (nN == 8) { T = 4 * s + (q >> 3); pn = q & 7; } else { T = 8 * s + (q >> 2); pn = q & 3; } }
        else { const int L = i * G + c; T = L / nN; pn = L % nN; }
        if (T >= __builtin_amdgcn_readfirstlane(tab[64])) return false;
        const int w = __builtin_amdgcn_readfirstlane(tab[128 + T]); const int e = w & 255, rt = w >> 8; const int ce = __builtin_amdgcn_readfirstlane(tab[e]), start = __builtin_amdgcn_readfirstlane(tab[32 + e]);
        u.e = e; u.valid = min(256, ce - rt * 256); u.row0 = start + rt * 256; u.col0 = pn * 256; u.aux = rt * 256;
        u.ao = GATHER ? 0u : (unsigned)u.row0 * lda; u.bo = (unsigned)((size_t)e * zB) + (unsigned)pn * 256u * ldb; return true;
    }
    __device__ __forceinline__ unsigned a_off(const GUnit& u, int r) const {
        if (!GATHER) return (unsigned)r * lda;
        const int rr = r < u.valid ? r : 0; const int tok = list[u.e * NTOK + u.aux + rr]; return (unsigned)tok * lda;
    }
};
__device__ __forceinline__ void moe_build_table(int* tab, const int* __restrict__ cnt, int tid) {
    if (tid < 32) tab[tid] = cnt[tid * 32];
    __syncthreads();
    if (tid < 32) { int s = 0; for (int e = 0; e < tid; ++e) s += tab[e]; tab[32 + tid] = s; }
    if (tid < 320) { int tiles = 0, found = -1;
        for (int e = 0; e < NEXP; ++e) { const int te = (tab[e] + 255) >> 8; if (found < 0 && tid < tiles + te) found = e | ((tid - tiles) << 8); tiles += te; }
        if (found >= 0) tab[128 + tid] = found; if (tid == 0) tab[64] = tiles; }
    __syncthreads();
}

__device__ __forceinline__ u32x4 pack8(const f32x4& a, const f32x4& b) { u32x4 w; w.x = pk2(a[0], a[1]); w.y = pk2(a[2], a[3]); w.z = pk2(b[0], b[1]); w.w = pk2(b[2], b[3]); return w; }
struct EpiBf16 { static constexpr bool AFTER_DRAIN = false; bf16_t* O; int ldc, pad;
    __device__ __forceinline__ void operator()(const f32x4 (&acc)[2][2][4][2], const GUnit& u, int wr, int wc, int fr, int fq) const {
        LAUNDER(fr); LAUNDER(fq);
#pragma unroll
        for (int ai = 0; ai < 2; ++ai)
#pragma unroll
            for (int m = 0; m < 4; ++m) { const int r = 128 * ai + 64 * wr + 16 * m + fr;
#pragma unroll
                for (int bj = 0; bj < 2; ++bj) *(u32x4*)(O + (size_t)(u.row0 + r) * ldc + u.col0 + 128 * bj + 32 * wc + 8 * fq) = pack8(acc[ai][bj][m][0], acc[ai][bj][m][1]); } } };
__device__ __forceinline__ float row_rstd(const float* __restrict__ ssp, int row) { const f32x4* p = (const f32x4*)(ssp + (size_t)row * 16); const f32x4 a = p[0], b = p[1], c = p[2], d = p[3];
    const float s = (((a[0] + a[1]) + (a[2] + a[3])) + ((b[0] + b[1]) + (b[2] + b[3]))) + (((c[0] + c[1]) + (c[2] + c[3])) + ((d[0] + d[1]) + (d[2] + d[3]))); return 1.0f / sqrtf(s * (1.0f / 1024.0f) + EPS); }
template <bool BASE_BF16> struct EpiResidSS { static constexpr bool AFTER_DRAIN = false; const void* base; bf16_t* xb; float* ss; unsigned char* xq; const float* qg;
    __device__ __forceinline__ void operator()(const f32x4 (&acc)[2][2][4][2], const GUnit& u, int wr, int wc, int fr, int fq) const {
        LAUNDER(fr); LAUNDER(fq);
#pragma unroll
        for (int ai = 0; ai < 2; ++ai) {
            f32x4 b[4][2][2];
#pragma unroll
            for (int m = 0; m < 4; ++m)
#pragma unroll
                for (int bj = 0; bj < 2; ++bj) { const size_t o = (size_t)(u.row0 + 128 * ai + 64 * wr + 16 * m + fr) * 1024 + u.col0 + 128 * bj + 32 * wc + 8 * fq;
                    if (BASE_BF16) { const u32x4 w = *(const u32x4*)((const bf16_t*)base + o); b[m][bj][0] = (f32x4){bflo(w.x), bfhi(w.x), bflo(w.y), bfhi(w.y)}; b[m][bj][1] = (f32x4){bflo(w.z), bfhi(w.z), bflo(w.w), bfhi(w.w)}; }
                    else { b[m][bj][0] = __builtin_nontemporal_load((const f32x4*)((const float*)base + o)); b[m][bj][1] = __builtin_nontemporal_load((const f32x4*)((const float*)base + o + 4)); } }
#pragma unroll
            for (int m = 0; m < 4; ++m) { const int r = 128 * ai + 64 * wr + 16 * m + fr; float part = 0.f;
#pragma unroll
                for (int bj = 0; bj < 2; ++bj) { const size_t o = (size_t)(u.row0 + r) * 1024 + u.col0 + 128 * bj + 32 * wc + 8 * fq;
                    const f32x4 y0 = b[m][bj][0] + acc[ai][bj][m][0], y1 = b[m][bj][1] + acc[ai][bj][m][1]; *(u32x4*)(xb + o) = pack8(y0, y1);
                    if (xq) { const int cq = u.col0 + 128 * bj + 32 * wc + 8 * fq; const f32x4 g0 = *(const f32x4*)(qg + cq), g1 = *(const f32x4*)(qg + cq + 4); const f32x4 z0 = y0 * g0, z1 = y1 * g1;
                        u32x2 q; q.x = pk4_fp8(z0[0], z0[1], z0[2], z0[3]); q.y = pk4_fp8(z1[0], z1[1], z1[2], z1[3]); *(u32x2*)(xq + o) = q; }
                    part += (y0[0] * y0[0] + y0[1] * y0[1] + y0[2] * y0[2] + y0[3] * y0[3]) + (y1[0] * y1[0] + y1[1] * y1[1] + y1[2] * y1[2] + y1[3] * y1[3]); }
                part += __shfl_xor(part, 16); part += __shfl_xor(part, 32);
                if (fq == 0) ss[(size_t)(u.row0 + r) * 16 + (u.col0 >> 8) * 4 + wc] = part; } } } };
struct EpiSoftmax { static constexpr bool AFTER_DRAIN = true; const float* ss; bf16_t* P;
    __device__ __forceinline__ void operator()(const f32x4 (&)[2][2][4][2], const GUnit&, int, int, int, int) const {}
    __device__ __forceinline__ void fused(f32x4 (&acc)[2][2][4][2], const GUnit& u, int wr, int wc, int fr, int fq, unsigned char* lds, int wid, int lane) const {
        float* Pm = (float*)lds; float* Ps = (float*)(lds + 4096);
        LAUNDER(fr); LAUNDER(fq);
#pragma unroll
        for (int ai = 0; ai < 2; ++ai)
#pragma unroll
            for (int m = 0; m < 4; ++m) { const int r = 128 * ai + 64 * wr + 16 * m + fr; const float rstd = row_rstd(ss, u.row0 + r); float mv = -INFINITY;
#pragma unroll
                for (int bj = 0; bj < 2; ++bj)
#pragma unroll
                    for (int n = 0; n < 2; ++n) { f32x4 s = acc[ai][bj][m][n] * rstd; acc[ai][bj][m][n] = s; mv = fmaxf(mv, fmaxf(fmaxf(s[0], s[1]), fmaxf(s[2], s[3]))); }
                mv = fmaxf(mv, __shfl_xor(mv, 16)); mv = fmaxf(mv, __shfl_xor(mv, 32));
                if (fq == 0) Pm[r * 4 + wc] = mv; }
        __syncthreads();
#pragma unroll
        for (int ai = 0; ai < 2; ++ai)
#pragma unroll
            for (int m = 0; m < 4; ++m) { const int r = 128 * ai + 64 * wr + 16 * m + fr; const f32x4 pm = *(const f32x4*)(Pm + r * 4); const float mv = fmaxf(fmaxf(pm[0], pm[1]), fmaxf(pm[2], pm[3])); float sum = 0.f;
#pragma unroll
                for (int bj = 0; bj < 2; ++bj)
#pragma unroll
                    for (int n = 0; n < 2; ++n) { f32x4 s = acc[ai][bj][m][n]; s[0] = __builtin_amdgcn_exp2f(s[0] - mv); s[1] = __builtin_amdgcn_exp2f(s[1] - mv); s[2] = __builtin_amdgcn_exp2f(s[2] - mv); s[3] = __builtin_amdgcn_exp2f(s[3] - mv);
                        acc[ai][bj][m][n] = s; sum += (s[0] + s[1]) + (s[2] + s[3]); }
                sum += __shfl_xor(sum, 16); sum += __shfl_xor(sum, 32);
                if (fq == 0) Ps[r * 4 + wc] = sum; }
        __syncthreads();
#pragma unroll
        for (int ai = 0; ai < 2; ++ai)
#pragma unroll
            for (int m = 0; m < 4; ++m) { const int r = 128 * ai + 64 * wr + 16 * m + fr; const f32x4 ps = *(const f32x4*)(Ps + r * 4); const float inv = 1.0f / ((ps[0] + ps[1]) + (ps[2] + ps[3]));
#pragma unroll
                for (int bj = 0; bj < 2; ++bj) *(u32x4*)(P + (size_t)(u.row0 + r) * 1024 + u.col0 + 128 * bj + 32 * wc + 8 * fq) = pack8(acc[ai][bj][m][0] * inv, acc[ai][bj][m][1] * inv); }
        (void)wid; (void)lane;
        __syncthreads();
    } };
struct EpiGU { static constexpr bool AFTER_DRAIN = false; const float* bgu; unsigned char* act  ; const float* lrs  ;
    __device__ __forceinline__ void operator()(const f32x4 (&acc)[2][2][4][2], const GUnit& u, int wr, int wc, int fr, int fq) const {
        const int pn = u.col0 >> 8; const float* bg = bgu + (size_t)u.e * 2048; LAUNDER(fr); LAUNDER(fq);
        float rs[8];
#pragma unroll
        for (int i = 0; i < 8; ++i) { const int r = 128 * (i >> 2) + 64 * wr + 16 * (i & 3) + fr; rs[i] = lrs[(size_t)u.e * NTOK + u.aux + (r < u.valid ? r : 0)]; }
        const int col = 128 * pn + 32 * wc + 8 * fq;
        f32x4 bgv[2], blv[2];
#pragma unroll
        for (int n = 0; n < 2; ++n) { bgv[n] = *(const f32x4*)(bg + col + 4 * n); blv[n] = *(const f32x4*)(bg + 1024 + col + 4 * n); }
#pragma unroll
        for (int ai = 0; ai < 2; ++ai)
#pragma unroll
            for (int m = 0; m < 4; ++m) { const int r = 128 * ai + 64 * wr + 16 * m + fr; const float rstd = rs[ai * 4 + m]; u32x2 q;
#pragma unroll
                for (int n = 0; n < 2; ++n) { const f32x4 g = acc[ai][0][m][n] * rstd + bgv[n], l = acc[ai][1][m][n] * rstd + blv[n]; float o[4];
#pragma unroll
                    for (int j = 0; j < 4; ++j) { const float gg = fminf(g[j], 7.0f), ll = fminf(fmaxf(l[j], -7.0f), 7.0f); o[j] = (ll + 1.0f) * (gg * __builtin_amdgcn_rcpf(1.0f + __builtin_amdgcn_exp2f(-1.702f * LOG2E * gg))); }
                    const unsigned w = pk4_fp8(o[0], o[1], o[2], o[3]); if (n == 0) q.x = w; else q.y = w; }
                if (r < u.valid) *(u32x2*)(act + (size_t)(u.row0 + r) * 1024 + col) = q; } } };
struct EpiDown { static constexpr bool AFTER_DRAIN = false; const float* bdn; unsigned char* ys  ;
    __device__ __forceinline__ void operator()(const f32x4 (&acc)[2][2][4][2], const GUnit& u, int wr, int wc, int fr, int fq) const {
        const float* bd = bdn + (size_t)u.e * 1024; LAUNDER(fr); LAUNDER(fq);
        f32x4 bv[2][2];
#pragma unroll
        for (int bj = 0; bj < 2; ++bj)
#pragma unroll
            for (int n = 0; n < 2; ++n) bv[bj][n] = *(const f32x4*)(bd + u.col0 + 128 * bj + 32 * wc + 8 * fq + 4 * n);
#pragma unroll
        for (int ai = 0; ai < 2; ++ai)
#pragma unroll
            for (int m = 0; m < 4; ++m) { const int r = 128 * ai + 64 * wr + 16 * m + fr; if (r < u.valid) {
#pragma unroll
                for (int bj = 0; bj < 2; ++bj) { const f32x4 y0 = acc[ai][bj][m][0] + bv[bj][0], y1 = acc[ai][bj][m][1] + bv[bj][1]; u32x2 q; q.x = pk4_fp8(y0[0], y0[1], y0[2], y0[3]); q.y = pk4_fp8(y1[0], y1[1], y1[2], y1[3]);
                    *(u32x2*)(ys + (size_t)(u.row0 + r) * 1024 + u.col0 + 128 * bj + 32 * wc + 8 * fq) = q; } } } } };


typedef float f32x16 __attribute__((ext_vector_type(16)));
typedef short s16x4 __attribute__((ext_vector_type(4)));
__device__ __forceinline__ int crow(int r, int hi) { return (r & 3) + 8 * (r >> 2) + 4 * hi; }
__device__ __forceinline__ s16x4 tr_read(const unsigned char* p) { return __builtin_bit_cast(s16x4, __builtin_amdgcn_ds_read_tr16_b64_v4i16((LDSP s16x4*)(unsigned)(uintptr_t)p)); }
__device__ __forceinline__ bf16x8 tr_frag(const unsigned char* img, int pitch, int k0, int f0, int lane) {
    const unsigned char* p = img + (k0 + 8 * (lane >> 5) + ((lane & 15) >> 2)) * pitch + (f0 + 16 * ((lane >> 4) & 1) + 4 * (lane & 3)) * 2;
    const s16x4 lo = tr_read(p), hi = tr_read(p + 4 * pitch);
    return (bf16x8){lo[0], lo[1], lo[2], lo[3], hi[0], hi[1], hi[2], hi[3]};
}
constexpr int GA_PK = 576, GA_PV = 1088;
constexpr int GA_V = 0, GA_PART = 0, GA_GLR = 69632, GA_TOT = 73728, GA_KD = 75776, GA_END = GA_KD + 64 * GA_PK;
__device__ __forceinline__ void gla_pass_a(unsigned char* lds, int task, const bf16_t* __restrict__ xn, const bf16_t* __restrict__ wglr  , const bf16_t* __restrict__ proj,
                                           const float* __restrict__ wg, const float* __restrict__ bg, float* __restrict__ UT, float* __restrict__ decay) {
    int tid = threadIdx.x; LAUNDER(tid); int wid = tid >> 6, lane = tid & 63, fr = lane & 15, fq = lane >> 4;
    const size_t t0 = (size_t)task * 64;
    { f32x4 acc[4];
#pragma unroll
      for (int m = 0; m < 4; ++m) acc[m] = (f32x4){0.f, 0.f, 0.f, 0.f};
#pragma unroll
      for (int ks = 0; ks < 4; ++ks) { const int k = 128 * wid + 32 * ks + 8 * fq; const bf16x8 bfr = *(const bf16x8*)(wglr + (size_t)fr * 1024 + k);
#pragma unroll
          for (int m = 0; m < 4; ++m) { const bf16x8 afr = *(const bf16x8*)(xn + (t0 + 16 * m + fr) * DM + k); acc[m] = __builtin_amdgcn_mfma_f32_16x16x32_bf16(afr, bfr, acc[m], 0, 0, 0); } }
      float* part = (float*)(lds + GA_PART) + wid * 1024;
#pragma unroll
      for (int m = 0; m < 4; ++m)
#pragma unroll
          for (int j = 0; j < 4; ++j) part[(16 * m + 4 * fq + j) * 16 + fr] = acc[m][j]; }
    __syncthreads();
    { float* glr = (float*)(lds + GA_GLR); const float* part = (const float*)(lds + GA_PART);
      for (int i = tid; i < 1024; i += 512) { float s = 0.f;
#pragma unroll
          for (int w = 0; w < 8; ++w) s += part[w * 1024 + i];
          glr[i] = s; } }
    __syncthreads();
    LAUNDER(tid);
    { const int cv = tid & 63, tk = tid >> 6;
#pragma unroll
      for (int i = 0; i < 8; ++i) { const int tok = tk + 8 * i; const u32x4 v = *(const u32x4*)(proj + (t0 + tok) * PROJ_LD + C_VG + cv * 8); *(u32x4*)(lds + GA_V + tok * GA_PV + cv * 16) = v; } }
    LAUNDER(tid);
    { const int j = tid & 255, half = tid >> 8; const float* glr = (const float*)(lds + GA_GLR); float* tot = (float*)(lds + GA_TOT);
      float w[16];
#pragma unroll
      for (int i = 0; i < 16; ++i) w[i] = wg[i * 256 + j];
      const float bj = bg[j]; float run = 0.f;
      bf16_t kk16[32];
#pragma unroll
      for (int s = 0; s < 32; ++s) kk16[s] = proj[(t0 + 32 * half + s) * PROJ_LD + C_KG + j];
      float Gc[32];
#pragma unroll
      for (int s = 0; s < 32; ++s) { const float* gl = glr + (32 * half + s) * 16; float u = bj;
#pragma unroll
          for (int i = 0; i < 16; ++i) u += gl[i] * w[i];
          const float ls = fminf(u, 0.f) - __logf(1.0f + __expf(-fabsf(u)));
          run += ls * (1.0f / 16.0f); Gc[s] = run; }
      tot[half * 256 + j] = run;
      __syncthreads();
      const float t0v = tot[j], t1v = tot[256 + j]; const float gend = t0v + t1v;
      if (half == 0) decay[(size_t)task * 256 + j] = __expf(gend);
      const float rel = gend - (half ? t0v : 0.f);
#pragma unroll
      for (int s = 0; s < 32; ++s) { const int tok = 32 * half + s;
          *(bf16_t*)(lds + GA_KD + tok * GA_PK + j * 2) = (bf16_t)f2bf(bf2f(kk16[s]) * __expf(rel - Gc[s])); } }
    __syncthreads();
    LAUNDER(tid); wid = __builtin_amdgcn_readfirstlane(tid >> 6); lane = tid & 63;
    { const int h = wid >> 1, nt = wid & 1, hi = lane >> 5, c32 = lane & 31; f32x16 acc[4];
#pragma unroll
      for (int m = 0; m < 4; ++m)
#pragma unroll
          for (int r = 0; r < 16; ++r) acc[m][r] = 0.f;
#pragma unroll
      for (int ks = 0; ks < 4; ++ks) { const bf16x8 bfr = tr_frag(lds + GA_KD, GA_PK, 16 * ks, h * 64 + 32 * nt, lane);
#pragma unroll
          for (int m = 0; m < 4; ++m) { const bf16x8 afr = tr_frag(lds + GA_V, GA_PV, 16 * ks, h * 128 + 32 * m, lane); acc[m] = __builtin_amdgcn_mfma_f32_32x32x16_bf16(afr, bfr, acc[m], 0, 0, 0); } }
      float* u = UT + ((size_t)task * 4 + h) * 8192;
#pragma unroll
      for (int m = 0; m < 4; ++m)
#pragma unroll
          for (int r = 0; r < 16; ++r) __builtin_nontemporal_store(acc[m][r], u + (32 * m + crow(r, hi)) * 64 + 32 * nt + c32); }
    __syncthreads();
}
__device__ __forceinline__ void gla_pass_b(int e, const float* __restrict__ UT, const float* __restrict__ decay, bf16_t* __restrict__ ST) {
    const int dk = e & 63, dv = (e >> 6) & 127, h = (e >> 13) & 3, b = e >> 15; float s = 0.f;
    const size_t base = ((size_t)b * 128 * 4 + h) * 8192 + dv * 64 + dk; const size_t dbase = (size_t)b * 128 * 256 + h * 64 + dk;
    for (int c0 = 0; c0 < 128; c0 += 32) { float u[32], d[32];
#pragma unroll
        for (int i = 0; i < 32; ++i) { u[i] = __builtin_nontemporal_load(UT + base + (size_t)(c0 + i) * 4 * 8192); d[i] = decay[dbase + (size_t)(c0 + i) * 256]; }
#pragma unroll
        for (int i = 0; i < 32; ++i) { s = d[i] * s + u[i]; __builtin_nontemporal_store((bf16_t)f2bf(s), ST + base + (size_t)(c0 + i) * 4 * 8192); } }
}
constexpr int GC_PITCH = 520;
__device__ __forceinline__ void gla_pass_c(unsigned char* wlds  , int wtask, const bf16_t* __restrict__ ST, const bf16_t* __restrict__ proj, const float* __restrict__ ghead, bf16_t* __restrict__ mix, int lane) {
    const int nh = wtask & 1, h = (wtask >> 1) & 3, bc = wtask >> 3; const int c32 = lane & 31, hi = lane >> 5;
    const size_t t0 = (size_t)bc * 64 + 32 * nh; const bf16_t* st = ST + ((size_t)bc * 4 + h) * 8192;
    f32x16 acc[4];
#pragma unroll
    for (int m = 0; m < 4; ++m)
#pragma unroll
        for (int r = 0; r < 16; ++r) acc[m][r] = 0.f;
#pragma unroll
    for (int ks = 0; ks < 4; ++ks) { const bf16x8 bfr = *(const bf16x8*)(proj + (t0 + c32) * PROJ_LD + C_QG + h * 64 + 16 * ks + 8 * hi);
#pragma unroll
        for (int m = 0; m < 4; ++m) { const bf16x8 afr = *(const bf16x8*)(st + (32 * m + c32) * 64 + 16 * ks + 8 * hi); acc[m] = __builtin_amdgcn_mfma_f32_32x32x16_bf16(afr, bfr, acc[m], 0, 0, 0); } }
    float ss = 0.f;
#pragma unroll
    for (int m = 0; m < 4; ++m)
#pragma unroll
        for (int r = 0; r < 16; ++r) ss += acc[m][r] * acc[m][r];
    ss += __shfl_xor(ss, 32);
    const float rstd = 1.0f / sqrtf(ss * (1.0f / 128.0f) + EPS);
#pragma unroll
    for (int m = 0; m < 4; ++m)
#pragma unroll
        for (int r = 0; r < 16; ++r) *(float*)(wlds + c32 * GC_PITCH + (32 * m + crow(r, hi)) * 4) = acc[m][r] * rstd;
#pragma unroll
    for (int i = 0; i < 8; ++i) { const int q = lane + 64 * i, tok = q >> 4, dv0 = (q & 15) * 8; const float* src = (const float*)(wlds + tok * GC_PITCH + dv0 * 4);
        const u32x4 rgw = *(const u32x4*)(proj + (t0 + tok) * PROJ_LD + C_RG + h * 128 + dv0); const f32x4 g0 = *(const f32x4*)(ghead + dv0), g1 = *(const f32x4*)(ghead + dv0 + 4);
        const float rg[8] = {bflo(rgw.x), bfhi(rgw.x), bflo(rgw.y), bfhi(rgw.y), bflo(rgw.z), bfhi(rgw.z), bflo(rgw.w), bfhi(rgw.w)}; const float gg[8] = {g0.x, g0.y, g0.z, g0.w, g1.x, g1.y, g1.z, g1.w}; float y[8];
#pragma unroll
        for (int k = 0; k < 8; ++k) y[k] = src[k] * gg[k] * (rg[k] / (1.0f + __expf(-rg[k])));
        u32x4 o; o.x = pk2(y[0], y[1]); o.y = pk2(y[2], y[3]); o.z = pk2(y[4], y[5]); o.w = pk2(y[6], y[7]);
        *(u32x4*)(mix + (t0 + tok) * 1024 + h * 128 + dv0) = o; }
}
__device__ __forceinline__ void sb_task(unsigned char* vl  , int wtask, const bf16_t* __restrict__ proj, bf16_t* __restrict__ mix, int lane) {
    const int qt = wtask & 255, h = (wtask >> 8) & 7, b = wtask >> 11; const int c = lane & 31, hi = lane >> 5;
    const int t0 = qt * 32; const size_t rowb = (size_t)b * SEQ;
    bf16x8 qf[4];
#pragma unroll
    for (int d0 = 0; d0 < 4; ++d0) qf[d0] = *(const bf16x8*)(proj + (rowb + t0 + c) * PROJ_LD + C_QS + h * 64 + 16 * d0 + 8 * hi);
    const int kap = 16 * ((c >> 2) & 1) + (c & 3) + 4 * (c >> 3);
    f32x16 o0, o1;
#pragma unroll
    for (int r = 0; r < 16; ++r) { o0[r] = 0.f; o1[r] = 0.f; }
    float Dc = 1.0f;
    const bf16_t* kbase = proj + rowb * PROJ_LD + C_KS + h * 64 + 8 * hi + (size_t)kap * PROJ_LD;
    const bf16_t* vbase = proj + rowb * PROJ_LD + C_VS + h * 64 + (lane & 7) * 8 + (size_t)(lane >> 3) * PROJ_LD;
    bf16x8 kf[4]; u32x4 vr[4];
#pragma unroll
    for (int d0 = 0; d0 < 4; ++d0) kf[d0] = *(const bf16x8*)(kbase + (size_t)t0 * PROJ_LD + 16 * d0);
#pragma unroll
    for (int i = 0; i < 4; ++i) vr[i] = *(const u32x4*)(vbase + (size_t)(t0 + 8 * i) * PROJ_LD);
    for (int j0 = t0; j0 >= 0; j0 -= 32) {
#pragma unroll
        for (int i = 0; i < 4; ++i) { const int key = (lane >> 3) + 8 * i, ch = lane & 7; *(u32x4*)(vl + (ch >> 2) * 2048 + key * 64 + (ch & 3) * 16) = vr[i]; }
        f32x16 z;
#pragma unroll
        for (int r = 0; r < 16; ++r) z[r] = 0.f;
#pragma unroll
        for (int d0 = 0; d0 < 4; ++d0) z = __builtin_amdgcn_mfma_f32_32x32x16_bf16(kf[d0], qf[d0], z, 0, 0, 0);
        asm volatile("" ::: "memory");
        { const int jn = (j0 >= 32) ? j0 - 32 : j0;
#pragma unroll
          for (int d0 = 0; d0 < 4; ++d0) kf[d0] = *(const bf16x8*)(kbase + (size_t)jn * PROJ_LD + 16 * d0);
#pragma unroll
          for (int i = 0; i < 4; ++i) vr[i] = *(const u32x4*)(vbase + (size_t)(jn + 8 * i) * PROJ_LD); }
        asm volatile("" ::: "memory");
        float e[16], Dl[16];
        const bool diag = (j0 == t0);
#pragma unroll
        for (int r = 0; r < 16; ++r) { float ev = __builtin_amdgcn_exp2f(fminf(z[r], 126.0f)); if (diag && (16 * hi + r >= c)) ev = 0.f; e[r] = ev; }
        float D = hi ? Dc : 1.0f;
#pragma unroll
        for (int r = 15; r >= 0; --r) { D = fmaf(D, e[r], D); Dl[r] = D; }
        const float other = __shfl_xor(D, 32);
        const float mult = hi ? 1.0f : other;
        Dc = D * other;
        unsigned pw[8];
#pragma unroll
        for (int r = 0; r < 16; r += 2) { const float a0 = e[r] * __builtin_amdgcn_rcpf(Dl[r] * mult), a1 = e[r + 1] * __builtin_amdgcn_rcpf(Dl[r + 1] * mult); pw[r >> 1] = pk2(a0, a1); }
#pragma unroll
        for (int ks = 0; ks < 2; ++ks) { const bf16x8 pa = __builtin_bit_cast(bf16x8, (u32x4){pw[4 * ks], pw[4 * ks + 1], pw[4 * ks + 2], pw[4 * ks + 3]});
            const unsigned char* vb = vl + (16 * hi + 8 * ks + ((lane & 15) >> 2)) * 64 + (16 * ((lane >> 4) & 1) + 4 * (lane & 3)) * 2;
            { const s16x4 lo = tr_read(vb), hh = tr_read(vb + 256); o0 = __builtin_amdgcn_mfma_f32_32x32x16_bf16(pa, (bf16x8){lo[0], lo[1], lo[2], lo[3], hh[0], hh[1], hh[2], hh[3]}, o0, 0, 0, 0); }
            { const s16x4 lo = tr_read(vb + 2048), hh = tr_read(vb + 2048 + 256); o1 = __builtin_amdgcn_mfma_f32_32x32x16_bf16(pa, (bf16x8){lo[0], lo[1], lo[2], lo[3], hh[0], hh[1], hh[2], hh[3]}, o1, 0, 0, 0); } }
        if (__all(!(Dc < 3.0e38f))) break;
    }
    bf16_t* ob = mix + (rowb + t0) * 1024 + 512 + h * 64 + c;
#pragma unroll
    for (int r = 0; r < 16; ++r) { const int q = crow(r, hi); ob[(size_t)q * 1024] = (bf16_t)f2bf(o0[r]); ob[(size_t)q * 1024 + 32] = (bf16_t)f2bf(o1[r]); }
}
__device__ __forceinline__ void memkv_task(int wtask, int lane, const bf16_t* __restrict__ memn, const bf16_t* __restrict__ wkv, bf16_t* __restrict__ kv) {
    const int tm = wtask >> 6, tn = wtask & 63; const int c = lane & 31, hi = lane >> 5;
    const bf16_t* ap = memn + (size_t)(tm * 32 + c) * DM + 8 * hi; const bf16_t* bp = wkv + (size_t)(tn * 32 + c) * DM + 8 * hi;
    f32x16 acc;
#pragma unroll
    for (int r = 0; r < 16; ++r) acc[r] = 0.f;
#pragma unroll 16
    for (int ks = 0; ks < 64; ++ks) { const bf16x8 a = *(const bf16x8*)(ap + 16 * ks), b = *(const bf16x8*)(bp + 16 * ks); acc = __builtin_amdgcn_mfma_f32_32x32x16_bf16(a, b, acc, 0, 0, 0); }
    bf16_t* o = kv + (size_t)(tm * 32) * 2048 + tn * 32 + c;
#pragma unroll
    for (int r = 0; r < 16; ++r) o[(size_t)crow(r, hi) * 2048] = (bf16_t)f2bf(acc[r]);
}
__device__ __forceinline__ void router_task(int wtask, int lane, const bf16_t* __restrict__ xn, const float* __restrict__ ss, const bf16_t* __restrict__ wr, const float* __restrict__ br,
                                            int (&oe)[4], float (&ow)[4]) {
    const int c = lane & 31, hi = lane >> 5; const int t = wtask * 32 + c;
    const bf16_t* ap = wr + (size_t)c * DM + 8 * hi; const bf16_t* bp = xn + (size_t)t * DM + 8 * hi;
    f32x16 acc;
#pragma unroll
    for (int r = 0; r < 16; ++r) acc[r] = 0.f;
#pragma unroll 16
    for (int ks = 0; ks < 64; ++ks) { const bf16x8 a = *(const bf16x8*)(ap + 16 * ks), b = *(const bf16x8*)(bp + 16 * ks); acc = __builtin_amdgcn_mfma_f32_32x32x16_bf16(a, b, acc, 0, 0, 0); }
    float v[16]; const float rstd = row_rstd(ss, t);
#pragma unroll
    for (int r = 0; r < 16; ++r) v[r] = acc[r] * rstd + br[crow(r, hi)];
    float tv[4]; int ti[4];
#pragma unroll
    for (int k = 0; k < 4; ++k) { float best = -INFINITY; int bi = 64;
#pragma unroll
        for (int r = 0; r < 16; ++r) { if (v[r] > best) { best = v[r]; bi = crow(r, hi); } }
        tv[k] = best; ti[k] = bi;
#pragma unroll
        for (int r = 0; r < 16; ++r) if (crow(r, hi) == bi) v[r] = -INFINITY; }
    float cv[8]; int ci[8];
#pragma unroll
    for (int k = 0; k < 4; ++k) { cv[k] = tv[k]; ci[k] = ti[k]; cv[4 + k] = __shfl_xor(tv[k], 32); ci[4 + k] = __shfl_xor(ti[k], 32); }
#pragma unroll
    for (int k = 0; k < 4; ++k) { float best = -INFINITY; int bi = 64;
#pragma unroll
        for (int q = 0; q < 8; ++q) { if (cv[q] > best || (cv[q] == best && ci[q] < bi)) { best = cv[q]; bi = ci[q]; } }
        tv[k] = best; ti[k] = bi;
#pragma unroll
        for (int q = 0; q < 8; ++q) if (ci[q] == bi) cv[q] = -INFINITY; }
    const float e1 = __expf(tv[1] - tv[0]), e2 = __expf(tv[2] - tv[0]), e3 = __expf(tv[3] - tv[0]); const float inv = 1.0f / (1.0f + e1 + e2 + e3);
    const float g[4] = {inv, e1 * inv, e2 * inv, e3 * inv};
#pragma unroll
    for (int k = 0; k < 4; ++k) { oe[k] = ti[k]; ow[k] = g[k]; }
}
__device__ __forceinline__ void combine_task(int t, int lane, const bf16_t* xin, float* xout, const unsigned char* __restrict__ ys, const int* tab, const int* __restrict__ toke, const int* __restrict__ tokr,
                                                 const float* __restrict__ tokw, const float* __restrict__ gfin) {
    const u32x2* xr = (const u32x2*)(xin + (size_t)t * DM) + lane; f32x4* xo = (f32x4*)(xout + (size_t)t * DM) + lane; f32x4 v[4];
#pragma unroll
    for (int j = 0; j < 4; ++j) { const u32x2 w = __builtin_nontemporal_load(xr + 64 * j); v[j] = (f32x4){bflo(w.x), bfhi(w.x), bflo(w.y), bfhi(w.y)}; }
    for (int k = 0; k < 4; ++k) { const int e = toke[t * 4 + k], r = tokr[t * 4 + k]; const float w = tokw[t * 4 + k]; const int start = tab[32 + e];
        const unsigned* yr = (const unsigned*)(ys + (size_t)(start + r) * DM) + lane;
#pragma unroll
        for (int j = 0; j < 4; ++j) { const int y = (int)__builtin_nontemporal_load(yr + 64 * j); const f32x2 lo = __builtin_amdgcn_cvt_pk_f32_fp8(y, false), hi = __builtin_amdgcn_cvt_pk_f32_fp8(y, true);
            v[j].x += w * lo.x; v[j].y += w * lo.y; v[j].z += w * hi.x; v[j].w += w * hi.y; } }
    float s = 0.f;
#pragma unroll
    for (int j = 0; j < 4; ++j) s += v[j].x * v[j].x + v[j].y * v[j].y + v[j].z * v[j].z + v[j].w * v[j].w;
    const float rstd = 1.0f / sqrtf(wave_sum(s) * (1.f / DM) + EPS);
#pragma unroll
    for (int j = 0; j < 4; ++j) { const f32x4 g = *((const f32x4*)gfin + lane + 64 * j); __builtin_nontemporal_store(v[j] * rstd * g, xo + 64 * j); }
}

#define GAS __attribute__((address_space(1)))
#define RLX_AGENT __ATOMIC_RELAXED, __HIP_MEMORY_SCOPE_AGENT
#define XB_TMO      128
#define XB_XCNT(j)  (256  + 64 * (j))
#define XB_XSUB(j)  (1280 + 64 * (j))
#define XB_XGEN(j)  (2304 + 64 * (j))
#define XB_TOP      3328
#define XB_TOPGEN   3392
#define XCD_BAR_WORDS 3456
#define XB_SPIN_CAP (1u << 18)
__device__ __forceinline__ unsigned xb_ld(unsigned* p)              { return __hip_atomic_load(p, __ATOMIC_RELAXED, __HIP_MEMORY_SCOPE_AGENT); }
__device__ __forceinline__ unsigned xb_add(unsigned* p, unsigned v) { return __hip_atomic_fetch_add(p, v, __ATOMIC_RELAXED, __HIP_MEMORY_SCOPE_AGENT); }
__device__ __forceinline__ unsigned xb_xcc_id() { return (unsigned)__builtin_amdgcn_s_getreg((3 << 11) | 20) & 0xFu; }
#define XB_SPIN(cond, bar) do { unsigned _sp = 0; while (cond) { __builtin_amdgcn_s_sleep(1); \
    if ((++_sp & 255u) == 0u) { if (xb_ld(&(bar)[XB_TMO])) break; if (_sp > XB_SPIN_CAP) { atomicAdd(&(bar)[XB_TMO], 1u); break; } } } } while (0)
struct XcdBarrier { unsigned* bar; unsigned x; };
__device__ __forceinline__ XcdBarrier xcd_barrier_post(unsigned* bar) {
    XcdBarrier b; b.bar = bar; b.x = xb_xcc_id();
    if (threadIdx.x == 0) (void)xb_add(&bar[XB_XCNT(b.x)], 1u);
    return b;
}
__device__ __forceinline__ void xcd_barrier_complete(unsigned* bar, unsigned x, unsigned& nloc, unsigned& nx) {
    const unsigned G = gridDim.x * gridDim.y * gridDim.z;
    unsigned sum, cnt, mine, sp = 0u;
    for (;;) {
        sum = 0u; cnt = 0u; mine = 0u;
#pragma unroll
        for (unsigned j = 0; j < 16; ++j) { const unsigned c = xb_ld(&bar[XB_XCNT(j)]); sum += c; cnt += (c > 0u) ? 1u : 0u; mine = (j == x) ? c : mine; }
        if (sum == G) break;
        __builtin_amdgcn_s_sleep(1);
        if ((++sp & 255u) == 0u) { if (xb_ld(&bar[XB_TMO])) break; if (sp > XB_SPIN_CAP) { atomicAdd(&bar[XB_TMO], 1u); break; } }
    }
    nloc = mine > 0u ? mine : 1u; nx = cnt > 0u ? cnt : 1u;
}
__device__ __forceinline__ void xcd_barrier(const XcdBarrier& b, unsigned& st  ) {
    asm volatile("s_waitcnt vmcnt(0)" ::: "memory");
    __syncthreads();
    unsigned stv = st;
    if (threadIdx.x == 0) {
        unsigned* bar = b.bar;
        __builtin_amdgcn_s_waitcnt(0);
        unsigned nloc = st & 0xffffu, nx = st >> 16;
        if (nloc == 0u) { xcd_barrier_complete(bar, b.x, nloc, nx); stv = nloc | (nx << 16); }
        const unsigned old = xb_add(&bar[XB_XSUB(b.x)], 1u);
        const unsigned gen = old / nloc;
        if (old + 1u == (gen + 1u) * nloc) {
            __builtin_amdgcn_fence(__ATOMIC_RELEASE, "agent");
            asm volatile("s_waitcnt vmcnt(0)" ::: "memory");
            const unsigned og = xb_add(&bar[XB_TOP], 1u);
            const unsigned tg = og / nx;
            if (og + 1u == (tg + 1u) * nx) xb_add(&bar[XB_TOPGEN], 1u);
            else XB_SPIN(xb_ld(&bar[XB_TOPGEN]) == tg, bar);
            __builtin_amdgcn_fence(__ATOMIC_ACQUIRE, "agent");
            xb_add(&bar[XB_XGEN(b.x)], 1u);
            asm volatile("s_waitcnt vmcnt(0)" ::: "memory");
        } else {
            XB_SPIN(xb_ld(&bar[XB_XGEN(b.x)]) == gen, bar);
            __builtin_amdgcn_fence(__ATOMIC_ACQUIRE, "agent");
            asm volatile("s_waitcnt vmcnt(0)" ::: "memory");
        }
    }
    st = __builtin_amdgcn_readfirstlane(stv);
    __syncthreads();
}

constexpr int LDS_BYTES = 147456;
constexpr int CW_BAR = 4096;
constexpr size_t CTL_ZERO_BYTES = 65536;
constexpr int NPHASE = 12;
struct Args { const float* in[22]; float* out; unsigned char* ws; int ph_lo, ph_hi; };

__global__ void __launch_bounds__(512, 2) mega(Args a) {
    extern __shared__ __attribute__((aligned(16))) unsigned char lds[];
    unsigned char* ws = a.ws; float* out = a.out;
    const float* x = a.in[0]; const float* mem = a.in[1]; const float* g_mix = a.in[2]; const float* w_in = a.in[3];
    const float* w_gla_gate = a.in[4]; const float* b_gla_gate = a.in[5]; const float* g_gla_head = a.in[6]; const float* w_out = a.in[7];
    const float* g_mem_q = a.in[8]; const float* g_mem_kv = a.in[9]; const float* w_mq = a.in[10]; const float* w_mk = a.in[11];
    const float* w_mv = a.in[12]; const float* w_mo = a.in[13]; const float* g_ffn = a.in[14]; const float* w_router = a.in[15];
    const float* b_router = a.in[16]; const float* w_gu = a.in[17]; const float* b_gu = a.in[18]; const float* w_down = a.in[19];
    const float* b_down = a.in[20]; const float* g_final = a.in[21];
    bf16_t* Wt_in = (bf16_t*)(ws + WS_WIN); bf16_t* Wt_out = (bf16_t*)(ws + WS_WOUT); bf16_t* Wq = (bf16_t*)(ws + WS_WQ); bf16_t* Wt_kv = (bf16_t*)(ws + WS_WKV);
    bf16_t* Wt_mo = (bf16_t*)(ws + WS_WMO); bf16_t* Wt_r = (bf16_t*)(ws + WS_WR); bf16_t* Wt_gu = (bf16_t*)(ws + WS_WGU); bf16_t* Wt_dn = (bf16_t*)(ws + WS_WDN);
    bf16_t* xn = (bf16_t*)(ws + WS_XN); bf16_t* memn = (bf16_t*)(ws + WS_MEMN); bf16_t* kv = (bf16_t*)(ws + WS_KV); bf16_t* Bs = (bf16_t*)(ws + WS_BS); bf16_t* Bo = (bf16_t*)(ws + WS_BO);
    bf16_t* proj = (bf16_t*)(ws + WS_PROJ); bf16_t* mix = (bf16_t*)(ws + WS_MIX);
    float* Sc = (float*)(ws + WS_S); bf16_t* P = (bf16_t*)(ws + WS_P); float* lg = (float*)(ws + WS_LG); int* toke = (int*)(ws + WS_TOKE); int* tokr = (int*)(ws + WS_TOKR);
    float* tokw = (float*)(ws + WS_TOKW); int* list = (int*)(ws + WS_LIST); unsigned char* ys = ws + WS_YS;
    unsigned char* Wq_gu = ws + WS_WGU; unsigned char* Wq_dn = ws + WS_WDN; unsigned char* x2q = ws + WS_S; unsigned char* act8 = ws + WS_ACT;
    float* lrs = (float*)(ws + WS_LG);
    float* UT = (float*)(ws + WS_S); float* decay = (float*)(ws + WS_LA); bf16_t* ST = (bf16_t*)(ws + WS_ORAW);
    unsigned* ctl = (unsigned*)(ws + WS_CTL); int* cnt = (int*)ctl + CW_CNT; float* ss1 = (float*)(ws + WS_LA + 8 * MiB); float* ss2 = (float*)(ws + WS_LA + 9 * MiB);

    const int G = gridDim.x, vb = blockIdx.x;
    XcdBarrier bar = xcd_barrier_post(ctl + CW_BAR); unsigned bar_st = 0u;
    const int ch_gw = __builtin_amdgcn_readfirstlane(vb * 8 + (int)(threadIdx.x >> 6)), ch_nW = G * 8;
    const int lo = a.ph_lo, hi = a.ph_hi;
    float* dmy = (float*)(ws + WS_DUMMY); (void)dmy;
#ifndef REPEAT_MASK
#define REPEAT_MASK 0
#endif
#define IN(k) (lo <= (k) && (k) < hi)
#define REP(k) for (int rep_ = 0; rep_ < 1 + ((REPEAT_MASK >> (k)) & 1); ++rep_)
#define SEAM(k) do { if (IN(k) && IN((k) + 1)) xcd_barrier(bar, bar_st); } while (0)
#define TIDS() int tid = threadIdx.x; LAUNDER(tid); const int lane = tid & 63; const int wid = __builtin_amdgcn_readfirstlane(tid >> 6); (void)lane; (void)wid

    if (IN(0)) REP(0) { TIDS(); const size_t gt = (size_t)vb * 512 + tid, gs = (size_t)G * 512;
        float* scr = (float*)(lds + wid * 8448);
        const int gw = vb * 8 + wid, ngw = G * 8;
        rms_body(gw, ngw, lane, x, xn, NTOK);
        rms_body(gw, ngw, lane, mem, memn, NB * MEML);
        conv_n_body(gt, gs, w_mq, Wq, g_mem_q, 1024, 1024, LOG2E / 16.0f);
        constexpr int I_IN = 16 * 97, I_SQ = 16 * 32, I_R = 16;
        constexpr int NITEMS = I_IN + 4 * I_SQ + I_R;
        for (int it = gw; it < NITEMS; it += ngw) { int r = it;
            if (r < I_IN) { conv_item<1>(scr, w_in, Wt_in, g_mix, 3088, 1024, 3088, r / 97, r % 97, lane); continue; } r -= I_IN;
            if (r < I_SQ) { conv_item<0>(scr, w_out, Wt_out, nullptr, 1024, 1024, 1024, r >> 5, r & 31, lane); continue; } r -= I_SQ;
            if (r < I_SQ) { conv_item<0>(scr, w_mk, Wt_kv, g_mem_kv, 1024, 1024, 1024, r >> 5, r & 31, lane); continue; } r -= I_SQ;
            if (r < I_SQ) { conv_item<0>(scr, w_mv, Wt_kv + (size_t)1024 * 1024, g_mem_kv, 1024, 1024, 1024, r >> 5, r & 31, lane); continue; } r -= I_SQ;
            if (r < I_SQ) { conv_item<0>(scr, w_mo, Wt_mo, nullptr, 1024, 1024, 1024, r >> 5, r & 31, lane); continue; } r -= I_SQ;
            { conv_item<0>(scr, w_router, Wt_r, g_ffn, 32, 1024, 32, r, 0, lane); } }
        __syncthreads(); }
    SEAM(0);
    if (IN(1)) REP(1) { DenseSched S{(const char*)xn, (const char*)Wt_in, 2048u, 2048u, 1024, 64, 12, 1 << 30, 0, G, vb}; EpiBf16 E{proj, PROJ_LD, 0}; gemm_run_host<true, 1>(lds, S, E, w_gu, ws, 0, 24576, ch_gw, ch_nW); }
    SEAM(1);
    if (IN(2)) REP(2) {
        for (int t = vb; t < 256; t += G) gla_pass_a(lds, t, xn, Wt_in + (size_t)3072 * 1024, proj, w_gla_gate, b_gla_gate, UT, decay);
        { TIDS(); for (int t = vb * 8 + wid; t < 4096; t += G * 8) sb_task(lds + wid * 4096, t, proj, mix, lane); }
        { TIDS(); for (int t = vb + G * wid; t < 1024; t += G * 8) memkv_task(t, lane, memn, Wt_kv, kv); } }
    SEAM(2);
    if (IN(3)) REP(3) {
        { TIDS(); for (int e = vb * 512 + tid; e < 65536; e += G * 512) gla_pass_b(e, UT, decay, ST); }
        { SchedWqk S{(const char*)kv, (const char*)Wq, 4096u, 2048u, 256, G / 2, vb - G / 2, 0}; EpiBf16 E{Bs, 1024, 0}; gemm_run<false>(lds, S, E); }
        { SchedVo S{(const char*)Wt_mo, (const char*)kv, 2048u, 4096u, 256, G / 2, vb - G / 2 - 32, 0}; EpiBf16 E{Bo, 1024, 0}; gemm_run<false>(lds, S, E); } }
    SEAM(3);
    if (IN(4)) REP(4) { TIDS(); for (int t = vb * 8 + wid; t < 2048; t += G * 8) gla_pass_c(lds + wid * 32 * GC_PITCH, t, ST, proj, g_gla_head, mix, lane); }
    SEAM(4);
#if PROBE_BARRIERS
    for (int pb_ = 0; pb_ < 8; ++pb_) xcd_barrier(bar, bar_st);
#endif
    if (IN(5)) REP(5) { DenseSched S{(const char*)mix, (const char*)Wt_out, 2048u, 2048u, 1024, 64, 4, 1 << 30, 0, G, vb}; EpiResidSS<false> E{x, rep_ ? (bf16_t*)dmy : xn, rep_ ? dmy + 16 * 1024 * 1024 : ss1, nullptr, nullptr}; gemm_run_host<false, 1>(lds, S, E, w_gu, ws, 24576, CH_GU_ITEMS, ch_gw, ch_nW); }
    SEAM(5);
    if (IN(6)) REP(6) { DenseSched S{(const char*)xn, (const char*)Bs, 2048u, 2048u, 1024, 64, 4, 32, (size_t)1024 * 2048, G, vb}; EpiSoftmax E{ss1, P}; gemm_run_host<false, 2>(lds, S, E, w_down, ws, CH_GU_ITEMS, CH_GU_ITEMS + 8192, ch_gw, ch_nW); }
    SEAM(6);
    if (IN(7)) REP(7) { DenseSched S{(const char*)P, (const char*)Bo, 2048u, 2048u, 1024, 64, 4, 32, (size_t)1024 * 2048, G, vb}; EpiResidSS<true> E{xn, rep_ ? (bf16_t*)dmy : xn, rep_ ? dmy + 16 * 1024 * 1024 : ss2, rep_ ? (unsigned char*)dmy + 40 * 1024 * 1024 : x2q, g_ffn}; gemm_run_host<false, 2>(lds, S, E, w_down, ws, CH_GU_ITEMS + 8192, CH_ITEMS, ch_gw, ch_nW); }
    SEAM(7);
    if (IN(8)) REP(8) { TIDS(); int* cntp = rep_ ? (int*)ctl + 2048 : cnt; int* listp = rep_ ? (int*)dmy + 1024 : list; float* lrsp = rep_ ? dmy + 4096 * 1024 : lrs; int* tokep = rep_ ? (int*)dmy + 1024 * 1024 : toke; int* tokrp = rep_ ? (int*)dmy + 2048 * 1024 : tokr; float* tokwp = rep_ ? dmy + 3072 * 1024 : tokw;
        int* lcnt = (int*)lds; int* gbase = (int*)lds + 32;
        for (int tb = vb; tb < NTOK / 64; tb += G) {
            if (tid < 32) lcnt[tid] = 0;
            __syncthreads();
            int oe[4] = {0, 0, 0, 0}; float ow[4] = {0.f, 0.f, 0.f, 0.f}; int lr[4] = {0, 0, 0, 0};
            if (wid < 2) { router_task(tb * 2 + wid, lane, xn, ss2, Wt_r, b_router, oe, ow);
                if (lane < 32) {
#pragma unroll
                    for (int k = 0; k < 4; ++k) lr[k] = atomicAdd(&lcnt[oe[k]], 1); } }
            __syncthreads();
            if (tid < 32) gbase[tid] = atomicAdd(&cntp[tid * 32], lcnt[tid]);
            __syncthreads();
            if (wid < 2 && lane < 32) { const int t = (tb * 2 + wid) * 32 + lane;
                const float rstd_t = row_rstd(ss2, t);
#pragma unroll
                for (int k = 0; k < 4; ++k) { const int r = gbase[oe[k]] + lr[k]; listp[oe[k] * NTOK + r] = t; lrsp[oe[k] * NTOK + r] = rstd_t; tokep[t * 4 + k] = oe[k]; tokrp[t * 4 + k] = r; tokwp[t * 4 + k] = ow[k]; } }
            __syncthreads(); } }
    SEAM(8);
    if (IN(9)) REP(9) { int* tab = (int*)(lds + 131072); { TIDS(); moe_build_table(tab, cnt, tid); }
        MoeSched<true> S{(const char*)x2q, (const char*)Wq_gu, 1024u, 1024u, 512, 8, (size_t)2048 * 1024, tab, list, 1, G, vb, 0}; EpiGU E{b_gu, act8, lrs}; gemm_run_fp8<true>(lds, S, E); }
    SEAM(9);
    if (IN(10)) REP(10) { int* tab = (int*)(lds + 131072); { TIDS(); moe_build_table(tab, cnt, tid); }
        MoeSched<false> S{(const char*)act8, (const char*)Wq_dn, 1024u, 1024u, 512, 4, (size_t)1024 * 1024, tab, list, 0, G, vb, 0}; EpiDown E{b_down, ys}; gemm_run_fp8<true>(lds, S, E); }
    SEAM(10);
    if (IN(11)) REP(11) { TIDS(); int* tab = (int*)(lds + 131072); moe_build_table(tab, cnt, tid);
        for (int t = vb * 8 + wid; t < NTOK; t += G * 8) combine_task(t, lane, xn, rep_ ? dmy : out, ys, tab, toke, tokr, tokw, g_final); }
#undef IN
#undef SEAM
#undef TIDS
}

#ifndef MK_PER_PHASE
#define MK_PER_PHASE 0
#endif
extern "C" void kernel_launch(void* const* d_in, const int* in_sizes, int n_in, void* d_out, int out_size, void* d_ws, size_t ws_size, hipStream_t stream) {
    static int grid = 0;
    if (grid == 0) {
        if (n_in != 22 || in_sizes[0] != NTOK * DM || out_size != NTOK * DM || ws_size < WS_END) { fprintf(stderr, "kernel_launch: unexpected shapes (n_in %d, ws %zu)\n", n_in, ws_size); grid = -1; return; }
        int dev = 0, cus = 0, per_cu = 0;
        if (hipGetDevice(&dev) != hipSuccess || hipDeviceGetAttribute(&cus, hipDeviceAttributeMultiprocessorCount, dev) != hipSuccess) { grid = -1; return; }
        if (hipFuncSetAttribute((const void*)mega, hipFuncAttributeMaxDynamicSharedMemorySize, LDS_BYTES) != hipSuccess) { fprintf(stderr, "kernel_launch: hipFuncSetAttribute failed\n"); grid = -1; return; }
        if (hipOccupancyMaxActiveBlocksPerMultiprocessor(&per_cu, (const void*)mega, 512, LDS_BYTES) != hipSuccess || per_cu < 1) fprintf(stderr, "kernel_launch: occupancy query says %d blocks/CU\n", per_cu);
        (void)hipGetLastError();
        grid = cus;
    }
    if (grid < 0) return;
    (void)hipMemsetAsync((char*)d_ws + WS_CTL, 0, CTL_ZERO_BYTES, stream);
    Args a{};
    for (int i = 0; i < 22; ++i) a.in[i] = (const float*)d_in[i];
    a.out = (float*)d_out; a.ws = (unsigned char*)d_ws;
#if MK_PER_PHASE
    for (int p = 0; p < NPHASE; ++p) { a.ph_lo = p; a.ph_hi = p + 1; hipLaunchKernelGGL(mega, dim3(grid), dim3(512), LDS_BYTES, stream, a); }
#else
    a.ph_lo = 0; a.ph_hi = NPHASE; hipLaunchKernelGGL(mega, dim3(grid), dim3(512), LDS_BYTES, stream, a);
#endif
}
```

```cpp
#include <hip/hip_runtime.h>
#include <cstdio>
#include <cstdint>
#ifndef PROBE_BARRIERS
#define PROBE_BARRIERS 0
#endif

typedef unsigned short bf16_t;
typedef short bf16x8 __attribute__((ext_vector_type(8)));
typedef float f32x4 __attribute__((ext_vector_type(4)));
typedef unsigned u32x4 __attribute__((ext_vector_type(4)));
typedef unsigned u32x2 __attribute__((ext_vector_type(2)));
typedef float f32x2 __attribute__((ext_vector_type(2)));
#define LDSP __attribute__((address_space(3)))
#define LAUNDER(x) asm volatile("" : "+v"(x))

constexpr int NB = 2, SEQ = 8192, NTOK = NB * SEQ, DM = 1024, MEML = 256;
constexpr int NEXP = 32, TOPK = 4, NASSIGN = NTOK * TOPK;
constexpr int PROJ_LD = 3072;
constexpr int C_QG = 0, C_KG = 256, C_VG = 512, C_RG = 1024, C_QS = 1536, C_KS = 2048, C_VS = 2560, C_GLR = 3072;
constexpr float LOG2E = 1.4426950408889634f;
constexpr float EPS = 1e-5f;

__device__ __forceinline__ unsigned f2bf(float f) { unsigned u = __float_as_uint(f); return (u + 0x7fffu + ((u >> 16) & 1u)) >> 16; }
__device__ __forceinline__ unsigned pk2(float lo, float hi) { return f2bf(lo) | (f2bf(hi) << 16); }
__device__ __forceinline__ float bf2f(bf16_t h) { return __uint_as_float(((unsigned)h) << 16); }
__device__ __forceinline__ float bflo(unsigned w) { return __uint_as_float(w << 16); }
__device__ __forceinline__ float bfhi(unsigned w) { return __uint_as_float(w & 0xffff0000u); }

constexpr size_t MiB = 1u << 20;
constexpr size_t WS_CTL = 0;
constexpr size_t WS_WIN = 1 * MiB;
constexpr size_t WS_WOUT = 8 * MiB;
constexpr size_t WS_WQ = 10 * MiB;
constexpr size_t WS_WKV = 12 * MiB;
constexpr size_t WS_WMO = 16 * MiB;
constexpr size_t WS_WR = 18 * MiB;
constexpr size_t WS_WGU = 20 * MiB;
constexpr size_t WS_WDN = 148 * MiB;
constexpr size_t WS_XN = 212 * MiB;
constexpr size_t WS_MEMN = 244 * MiB;
constexpr size_t WS_KV = 245 * MiB;
constexpr size_t WS_BS = 247 * MiB;
constexpr size_t WS_BO = 251 * MiB;
constexpr size_t WS_PROJ = 256 * MiB;
constexpr size_t WS_LA = 360 * MiB;
constexpr size_t WS_ORAW = 376 * MiB;
constexpr size_t WS_MIX = 408 * MiB;
constexpr size_t WS_S = 440 * MiB;
constexpr size_t WS_P = 504 * MiB;
constexpr size_t WS_LG = 536 * MiB;
constexpr size_t WS_TOKE = 538 * MiB;
constexpr size_t WS_TOKR = 539 * MiB;
constexpr size_t WS_TOKW = 540 * MiB;
constexpr size_t WS_LIST = 541 * MiB;
constexpr size_t WS_ACT = 544 * MiB;
constexpr size_t WS_YS = 674 * MiB;
constexpr size_t WS_DUMMY = 804 * MiB;
constexpr size_t WS_END = 872 * MiB;
constexpr int CW_CNT = 1024;

template <int MAP> __device__ __forceinline__ int srccol(int n, float& sc) {
    sc = 1.f;
    if (MAP == 0) return n;
    if (MAP == 1) {
        if (n < 256) { sc = 0.125f; return n; }
        if (n < 1024) return n;
        if (n < 3072) { if (n >= C_QS && n < C_KS) sc = 0.125f * LOG2E; return n + 16; }
        if (n < 3088) return 1024 + (n - 3072);
        return -1;
    }
    { const int ct = n >> 8, w = n & 255; return (w < 128) ? (128 * ct + w) : (1024 + 128 * ct + (w - 128)); }
}
template <int MAP>
__device__ __forceinline__ void conv_item(float* scr, const float* __restrict__ src, bf16_t* __restrict__ dst, const float* __restrict__ gain, int ldsrc, int K, int nrows, int kb, int nb, int lane) {
    const int k0 = kb * 64, n0 = nb * 32; float sc; const int c0 = srccol<MAP>(n0, sc);
    const int half = lane >> 5, l31 = lane & 31;
    const float* s0 = src + (size_t)(k0 + half) * ldsrc + c0 + l31;
    float v[32];
#pragma unroll
    for (int i = 0; i < 32; ++i) v[i] = __builtin_nontemporal_load(s0 + (size_t)(2 * i) * ldsrc);
#pragma unroll
    for (int i = 0; i < 32; ++i) { const int kk = 2 * i + half; const float g = (gain ? gain[k0 + kk] : 1.f) * sc; scr[kk * 33 + l31] = v[i] * g; }
    asm volatile("s_waitcnt lgkmcnt(0)" ::: "memory");
    const int c = lane & 7;
#pragma unroll
    for (int j = 0; j < 4; ++j) { const int n = (lane >> 3) + 8 * j; const float* s = scr + (8 * c) * 33 + n;
        u32x4 o; o.x = pk2(s[0 * 33], s[1 * 33]); o.y = pk2(s[2 * 33], s[3 * 33]); o.z = pk2(s[4 * 33], s[5 * 33]); o.w = pk2(s[6 * 33], s[7 * 33]);
        if (n0 + n < nrows) *(u32x4*)(dst + (size_t)(n0 + n) * K + k0 + 8 * c) = o; }
    asm volatile("s_waitcnt lgkmcnt(0)" ::: "memory");
}
__device__ __forceinline__ unsigned pk4_fp8(float a, float b, float c, float d) { int w = __builtin_amdgcn_cvt_pk_fp8_f32(a, b, 0, false); w = __builtin_amdgcn_cvt_pk_fp8_f32(c, d, w, true); return (unsigned)w; }
template <int MAP>
__device__ __forceinline__ void conv_item8(float* scr, const float* __restrict__ src, unsigned char* __restrict__ dst, const float* __restrict__ gain, int ldsrc, int K, int nrows, int kb, int nb, int lane, float mul) {
    const int k0 = kb * 64, n0 = nb * 32; float sc; const int c0 = srccol<MAP>(n0, sc); sc *= mul;
    const int half = lane >> 5, l31 = lane & 31;
    const float* s0 = src + (size_t)(k0 + half) * ldsrc + c0 + l31;
    float v[32];
#pragma unroll
    for (int i = 0; i < 32; ++i) v[i] = __builtin_nontemporal_load(s0 + (size_t)(2 * i) * ldsrc);
#pragma unroll
    for (int i = 0; i < 32; ++i) { const int kk = 2 * i + half; const float g = (gain ? gain[k0 + kk] : 1.f) * sc; scr[kk * 33 + l31] = v[i] * g; }
    asm volatile("s_waitcnt lgkmcnt(0)" ::: "memory");
    const int c = lane & 3;
#pragma unroll
    for (int j = 0; j < 2; ++j) { const int n = (lane >> 2) + 16 * j; const float* s = scr + (16 * c) * 33 + n;
        u32x4 o; o.x = pk4_fp8(s[0 * 33], s[1 * 33], s[2 * 33], s[3 * 33]); o.y = pk4_fp8(s[4 * 33], s[5 * 33], s[6 * 33], s[7 * 33]);
        o.z = pk4_fp8(s[8 * 33], s[9 * 33], s[10 * 33], s[11 * 33]); o.w = pk4_fp8(s[12 * 33], s[13 * 33], s[14 * 33], s[15 * 33]);
        if (n0 + n < nrows) __builtin_nontemporal_store(o, (u32x4*)(dst + (size_t)(n0 + n) * K + k0 + 16 * c)); }
    asm volatile("s_waitcnt lgkmcnt(0)" ::: "memory");
}
__device__ __forceinline__ void conv_n_body(size_t gtid, size_t gsz, const float* __restrict__ src, bf16_t* __restrict__ dst, const float* __restrict__ gain, int K, int nrows, float sc) {
    const int kc8 = K / 8; const size_t total = (size_t)nrows * kc8;
    for (size_t idx = gtid; idx < total; idx += gsz) {
        const int kc = (int)(idx % kc8), n = (int)(idx / kc8);
        const float g = gain[n] * sc; const f32x4 a = __builtin_nontemporal_load((const f32x4*)(src + (size_t)n * K + kc * 8)), b = __builtin_nontemporal_load((const f32x4*)(src + (size_t)n * K + kc * 8 + 4));
        u32x4 o; o.x = pk2(a.x * g, a.y * g); o.y = pk2(a.z * g, a.w * g); o.z = pk2(b.x * g, b.y * g); o.w = pk2(b.z * g, b.w * g);
        *(u32x4*)(dst + (size_t)n * K + kc * 8) = o;
    }
}

__device__ __forceinline__ float wave_sum(float v) {
#pragma unroll
    for (int o = 1; o < 64; o <<= 1) v += __shfl_xor(v, o);
    return v;
}
__device__ __forceinline__ void rms_body(int gw, int ngw, int lane, const float* __restrict__ x, bf16_t* __restrict__ out, int nrows) {
    for (int row = gw; row < nrows; row += ngw) {
        const f32x4* xr = (const f32x4*)(x + (size_t)row * DM) + lane; f32x4 v[4]; float s = 0.f;
#pragma unroll
        for (int j = 0; j < 4; ++j) { v[j] = __builtin_nontemporal_load(xr + 64 * j); s += v[j].x * v[j].x + v[j].y * v[j].y + v[j].z * v[j].z + v[j].w * v[j].w; }
        const float rstd = 1.0f / sqrtf(wave_sum(s) * (1.f / DM) + EPS);
        u32x2* o = (u32x2*)(out + (size_t)row * DM) + lane;
#pragma unroll
        for (int j = 0; j < 4; ++j) { u32x2 w; w.x = pk2(v[j].x * rstd, v[j].y * rstd); w.y = pk2(v[j].z * rstd, v[j].w * rstd); o[64 * j] = w; }
    }
}

constexpr int CH_GU_ITEMS = 32 * 32 * 32;
constexpr int CH_ITEMS = CH_GU_ITEMS + 32 * 16 * 32;
constexpr int CH_LDS = 131072;
typedef unsigned v2u __attribute__((ext_vector_type(2)));
typedef unsigned v4u __attribute__((ext_vector_type(4)));
struct ConvHost { const float* src; unsigned char* ws; int it0, nW, hi, q; };
template <bool GU> __device__ __forceinline__ void ch_decode(int it, unsigned& soff, unsigned& doff) {
    if (GU) { const unsigned e = (unsigned)it >> 10, nb = ((unsigned)it >> 5) & 31u, k32 = (unsigned)it & 31u;
        soff = (e << 23) | (k32 << 18) | ((nb & 2u) << 11) | ((nb >> 2) << 9) | ((nb & 1u) << 8);
        doff = (unsigned)WS_WGU + (e << 21) + (nb << 16) + (k32 << 5); }
    else { const unsigned t = (unsigned)(it - CH_GU_ITEMS), e = t >> 9, nb = (t >> 5) & 15u, k32 = t & 31u;
        soff = (e << 22) | (k32 << 17) | (nb << 8);
        doff = (unsigned)WS_WDN + (e << 20) + (nb << 16) + (k32 << 5); }
}
template <bool GU> __device__ __forceinline__ void ch_issue(ConvHost& H, f32x2 (&cv)[4], unsigned voffL) {
    constexpr unsigned LD4 = GU ? 8192u : 4096u;
    const int q = __builtin_amdgcn_readfirstlane(H.q); const int it = H.it0 + H.nW * (q >> 2), itc = it < H.hi ? it : H.hi - 1;
    unsigned soff, doff; ch_decode<GU>(itc, soff, doff); soff += (unsigned)(q & 3) * 8u * LD4;
    const __amdgpu_buffer_rsrc_t r = __builtin_amdgcn_make_buffer_rsrc((void*)H.src, 0, 0x7fffffff, 0x00020000);
#pragma unroll
    for (int i = 0; i < 4; ++i) cv[i] = __builtin_bit_cast(f32x2, __builtin_amdgcn_raw_buffer_load_b64(r, (int)voffL, (int)(soff + (unsigned)i * LD4), 2));
    H.q = q + 1;
}
template <bool GU> __device__ __forceinline__ void ch_finish(const ConvHost& H, int qf, const f32x2 (&cv)[4], LDSP unsigned char* tile, int lane) {
    constexpr float SC = (float)(1 << 6);
    const int sf = qf & 3, itf = H.it0 + H.nW * (qf >> 2);
    v2u o; o.x = pk4_fp8(cv[0].x * SC, cv[1].x * SC, cv[2].x * SC, cv[3].x * SC); o.y = pk4_fp8(cv[0].y * SC, cv[1].y * SC, cv[2].y * SC, cv[3].y * SC);
    *(LDSP v2u*)(tile + (unsigned)((2 * sf + (lane >> 5)) * 64 + 2 * (lane & 31)) * 4u) = o;
    if (qf >= 0 && sf == 3 && itf < H.hi) {
        unsigned soff, doff; ch_decode<GU>(itf, soff, doff);
        const int r = lane >> 1, c = lane & 1; const LDSP unsigned* tw = (const LDSP unsigned*)tile + (4 * c) * 64 + r;
        v4u a, b; a.x = tw[0]; a.y = tw[64]; a.z = tw[128]; a.w = tw[192]; b.x = tw[32]; b.y = tw[96]; b.z = tw[160]; b.w = tw[224];
        const __amdgpu_buffer_rsrc_t w = __builtin_amdgcn_make_buffer_rsrc((void*)H.ws, 0, 0x7fffffff, 0x00020000);
        const unsigned voffS = (unsigned)r * 1024u + (unsigned)c * 16u;
        __builtin_amdgcn_raw_buffer_store_b128(a, w, (int)voffS, (int)doff, 0);
        __builtin_amdgcn_raw_buffer_store_b128(b, w, (int)voffS, (int)(doff + 32768u), 0); }
}

struct GUnit { unsigned ao, bo; int row0, col0, e, valid, aux; };

__host__ __device__ __forceinline__ int lds_byte(int r, int c) { const int st = (r >> 4) * 2 + (c >> 5), rr = r & 15, cc = c & 31, ob = rr * 64 + cc * 2; return st * 1024 + (ob ^ (((ob >> 9) & 1) << 5)); }
__host__ __device__ __forceinline__ void stage_rc(int b, int& R, int& C) { const int st = b / 1024, sb = b % 1024, swz = sb ^ (((sb >> 9) & 1) << 5); R = (st >> 1) * 16 + swz / 64; C = (st & 1) * 32 + (swz % 64) / 2; }
__host__ __device__ __forceinline__ int perm32(int rho) { const int n = rho >> 4, i = rho & 15; return 8 * (i >> 2) + 4 * n + (i & 3); }
constexpr int HTB = 128 * 64 * 2;
typedef int v8i __attribute__((ext_vector_type(8)));
typedef int v4i __attribute__((ext_vector_type(4)));
struct Frag2 { bf16x8 h[2]; };
template <bool F> struct FragT { typedef Frag2 T; };
template <> struct FragT<true> { typedef v8i T; };
template <class Sched, class Epi, bool ALIGN_EPI, bool FP8 = false, int SCALE_B = 0x7f, int HOSTM = 0>
__device__ __forceinline__ void gemm_phase(unsigned char* lds_flat, const Sched& S, const Epi& E, ConvHost& H) {
    LDSP unsigned char* lds = (LDSP unsigned char*)(unsigned)(uintptr_t)lds_flat;
    int tid = threadIdx.x; LAUNDER(tid);
    const int wid = __builtin_amdgcn_readfirstlane(tid >> 6), lane = tid & 63, wr = wid >> 2, wc = wid & 3, fr = lane & 15, fq = lane >> 4;
    const int nt = S.K / 64;
    int Rr[2], Cc[2];
#pragma unroll
    for (int i = 0; i < 2; ++i) stage_rc(tid * 16 + i * 8192, Rr[i], Cc[i]);
    unsigned voffB[2][2];
#pragma unroll
    for (int h = 0; h < 2; ++h)
#pragma unroll
        for (int i = 0; i < 2; ++i) voffB[h][i] = (unsigned)(128 * h + (Rr[i] & ~31) + perm32(Rr[i] & 31)) * S.ldb + (unsigned)Cc[i] * 2u;
    const unsigned ldsw = (unsigned)wid * 1024u;
    constexpr bool HOST = HOSTM != 0, HGU = HOSTM == 1;
    const int aoff = lds_byte(wr * 64 + fr, fq * 8), boff = lds_byte(wc * 32 + fr, fq * 8);
    constexpr int KSUB = 1024;
#define PG8_SA(b, h) (((b) * 2 + (h)) * HTB)
#define PG8_SB(b, h) ((4 + (b) * 2 + (h)) * HTB)
#define PG8_STAGE(bufoff, rsrc, voff, soff) do { _Pragma("unroll") for (int _i = 0; _i < 2; ++_i) \
        __builtin_amdgcn_raw_ptr_buffer_load_lds(rsrc, (LDSP unsigned*)(lds + (bufoff) + ldsw + _i * 8192), 16, (int)(voff)[_i], (int)(soff), 0, 0); } while (0)
#define PG8_LDF(dst, addr) do { const bf16x8 lo_ = *(const LDSP bf16x8*)(addr); const bf16x8 hi_ = *(const LDSP bf16x8*)((addr) + KSUB); \
        if constexpr (FP8) dst = __builtin_shufflevector(__builtin_bit_cast(v4i, lo_), __builtin_bit_cast(v4i, hi_), 0, 1, 2, 3, 4, 5, 6, 7); else { dst.h[0] = lo_; dst.h[1] = hi_; } } while (0)
#define PG8_LDA(dst, b, h) do { _Pragma("unroll") for (int m = 0; m < 4; ++m) PG8_LDF(dst[m], lds + PG8_SA(b, h) + aoff + m * 2048); } while (0)
#define PG8_LDB(dst, b, h) do { _Pragma("unroll") for (int n = 0; n < 2; ++n) PG8_LDF(dst[n], lds + PG8_SB(b, h) + boff + n * 2048); } while (0)
#define PG8_MMA(ai, bj, At, Bt) do { __builtin_amdgcn_s_setprio(1); _Pragma("unroll") for (int m = 0; m < 4; ++m) _Pragma("unroll") for (int n = 0; n < 2; ++n) { \
        if constexpr (FP8) asm volatile("v_mfma_scale_f32_16x16x128_f8f6f4 %0, %1, %2, %0, %3, %4 op_sel_hi:[0,0,0]" : "+v"(acc[ai][bj][m][n]) : "v"(Bt[n]), "v"(At[m]), "v"(sclB), "v"(sclA)); \
        else { _Pragma("unroll") for (int k = 0; k < 2; ++k) acc[ai][bj][m][n] = __builtin_amdgcn_mfma_f32_16x16x32_bf16(Bt[n].h[k], At[m].h[k], acc[ai][bj][m][n], 0, 0, 0); } } \
        __builtin_amdgcn_s_setprio(0); } while (0)
#define PG8_MMA_M(ai, bj, m, At, Bt) do { _Pragma("unroll") for (int n = 0; n < 2; ++n) _Pragma("unroll") for (int k = 0; k < 2; ++k) \
        acc[ai][bj][m][n] = __builtin_amdgcn_mfma_f32_16x16x32_bf16(Bt[n].h[k], At[m].h[k], acc[ai][bj][m][n], 0, 0, 0); } while (0)
#define PG8_MMA_H(cv) do { if constexpr (!FP8) { PG8_MMA(0, 0, At, B0); PG8_MMA(0, 1, At, B1); PG8_SCHED; \
        { CH_LANE(); ch_finish<HGU>(H, __builtin_amdgcn_readfirstlane(H.q) - 2, cv, ctile, cl_); } PG8_SCHED; ch_issue<HGU>(H, cv, voffL); PG8_SCHED; } } while (0)
#define CH_LANE() int cl_ = threadIdx.x; LAUNDER(cl_); cl_ &= 63
#define PG8_WAIT_V(n) asm volatile("s_waitcnt vmcnt(" #n ")" ::: "memory")
#define PG8_WAIT_L(n) asm volatile("s_waitcnt lgkmcnt(" #n ")" ::: "memory")
#define PG8_BAR __builtin_amdgcn_s_barrier()
#define PG8_SCHED __builtin_amdgcn_sched_barrier(0)
    GUnit cur, nxt; int ui = 0;
    f32x2 cvx[4], cvy[4]; unsigned voffL = 0; (void)voffL; LDSP unsigned char* const ctile = lds + CH_LDS + wid * 2048; (void)ctile;
    if constexpr (HOST) { voffL = (unsigned)(lane >> 5) * 4u * (HGU ? 8192u : 4096u) + (unsigned)(lane & 31) * 8u;
#pragma unroll
        for (int i = 0; i < 4; ++i) { cvx[i] = (f32x2){0.f, 0.f}; cvy[i] = (f32x2){0.f, 0.f}; } }
    if (S.next(0, cur)) {
    const __amdgpu_buffer_rsrc_t rA = __builtin_amdgcn_make_buffer_rsrc((void*)S.A, 0, 0x7fffffff, 0x00020000);
    const __amdgpu_buffer_rsrc_t rB = __builtin_amdgcn_make_buffer_rsrc((void*)S.Bt, 0, 0x7fffffff, 0x00020000);
    unsigned oc[2][2], on[2][2];
#pragma unroll
    for (int h = 0; h < 2; ++h)
#pragma unroll
        for (int i = 0; i < 2; ++i) oc[h][i] = S.a_off(cur, 128 * h + Rr[i]) + (unsigned)Cc[i] * 2u;
    f32x4 acc[2][2][4][2];
#pragma unroll
    for (int a = 0; a < 2; ++a)
#pragma unroll
        for (int b = 0; b < 2; ++b)
#pragma unroll
            for (int m = 0; m < 4; ++m)
#pragma unroll
                for (int n = 0; n < 2; ++n) acc[a][b][m][n] = (f32x4){0.f, 0.f, 0.f, 0.f};
    typedef typename FragT<FP8>::T frag_t;
    frag_t At[4], B0[2], B1[2];
    const unsigned kstep = 128;
    const int sclB = SCALE_B * 0x01010101, sclA = 0x7f7f7f7f; (void)sclA; (void)sclB;
    PG8_STAGE(PG8_SB(0, 0), rB, voffB[0], cur.bo); PG8_STAGE(PG8_SB(0, 1), rB, voffB[1], cur.bo); PG8_STAGE(PG8_SA(0, 0), rA, oc[0], cur.ao); PG8_STAGE(PG8_SA(0, 1), rA, oc[1], cur.ao);
    if (wr == 1) PG8_BAR;
    PG8_WAIT_V(2); PG8_BAR;
    PG8_STAGE(PG8_SB(1, 0), rB, voffB[0], cur.bo + kstep); PG8_STAGE(PG8_SA(1, 0), rA, oc[0], cur.ao + kstep); PG8_STAGE(PG8_SB(1, 1), rB, voffB[1], cur.bo + kstep);
    PG8_WAIT_V(6); PG8_BAR;
    for (;;) {
        const bool has_next = S.next(ui + 1, nxt);
        if (!has_next) nxt = cur;
        const unsigned nA = nxt.ao, nB = nxt.bo;
        { int t2 = threadIdx.x; LAUNDER(t2);
#pragma unroll
          for (int i = 0; i < 2; ++i) { int R_, C_; stage_rc(t2 * 16 + i * 8192, R_, C_);
#pragma unroll
              for (int h = 0; h < 2; ++h) on[h][i] = S.a_off(nxt, 128 * h + R_) + (unsigned)C_ * 2u; } }
        for (int t = 0; t < nt; t += 2) {
            const bool last = (t == nt - 2);
            const unsigned k1 = cur.ao + (unsigned)(t + 1) * kstep;
            const unsigned a2 = last ? nA : cur.ao + (unsigned)(t + 2) * kstep, b2 = last ? nB : cur.bo + (unsigned)(t + 2) * kstep, a3 = a2 + kstep, b3 = b2 + kstep;
            unsigned o2[2][2];
#pragma unroll
            for (int h = 0; h < 2; ++h)
#pragma unroll
                for (int i = 0; i < 2; ++i) o2[h][i] = last ? on[h][i] : oc[h][i];
            PG8_LDB(B0, 0, 0); PG8_LDB(B1, 0, 1); PG8_SCHED; PG8_LDA(At, 0, 0); PG8_STAGE(PG8_SA(1, 1), rA, oc[1], k1);
            if constexpr (HOST) PG8_WAIT_V(12); else PG8_WAIT_V(8);
            PG8_WAIT_L(0); PG8_BAR;
            if constexpr (HOST) { PG8_MMA_H(cvx); } else { PG8_MMA(0, 0, At, B0); PG8_MMA(0, 1, At, B1); }
            PG8_BAR; PG8_SCHED;
            PG8_LDA(At, 0, 1); PG8_STAGE(PG8_SB(0, 0), rB, voffB[0], b2); PG8_STAGE(PG8_SB(0, 1), rB, voffB[1], b2); PG8_STAGE(PG8_SA(0, 0), rA, o2[0], a2);
            if constexpr (HOST) PG8_WAIT_V(12); else PG8_WAIT_V(8);
            PG8_WAIT_L(0); PG8_BAR; PG8_MMA(1, 0, At, B0); PG8_MMA(1, 1, At, B1); PG8_BAR; PG8_SCHED;
            PG8_LDB(B0, 1, 0); PG8_LDB(B1, 1, 1); PG8_SCHED; PG8_LDA(At, 1, 0); PG8_STAGE(PG8_SA(0, 1), rA, o2[1], a2);
            if constexpr (HOST) PG8_WAIT_V(12); else PG8_WAIT_V(8);
            PG8_WAIT_L(0); PG8_BAR;
            if constexpr (HOST) { PG8_MMA_H(cvy); } else { PG8_MMA(0, 0, At, B0); PG8_MMA(0, 1, At, B1); }
            PG8_BAR; PG8_SCHED;
            PG8_LDA(At, 1, 1); PG8_STAGE(PG8_SB(1, 0), rB, voffB[0], b3); PG8_STAGE(PG8_SB(1, 1), rB, voffB[1], b3); PG8_STAGE(PG8_SA(1, 0), rA, o2[0], a3);
            if constexpr (HOST) PG8_WAIT_V(12); else PG8_WAIT_V(8);
            PG8_WAIT_L(0); PG8_BAR; PG8_MMA(1, 0, At, B0); PG8_MMA(1, 1, At, B1); PG8_BAR; PG8_SCHED;
        }
        if constexpr (FP8) asm volatile("s_nop 15\n\ts_nop 15" ::: "memory");
        if constexpr (ALIGN_EPI) { if (wr == 0) PG8_BAR; }
        if constexpr (!Epi::AFTER_DRAIN) E(acc, cur, wr, wc, fr, fq);
        if (!has_next) break;
#pragma unroll
        for (int a = 0; a < 2; ++a)
#pragma unroll
            for (int b = 0; b < 2; ++b)
#pragma unroll
                for (int m = 0; m < 4; ++m)
#pragma unroll
                    for (int n = 0; n < 2; ++n) acc[a][b][m][n] = (f32x4){0.f, 0.f, 0.f, 0.f};
        cur = nxt; ++ui;
#pragma unroll
        for (int h = 0; h < 2; ++h)
#pragma unroll
            for (int i = 0; i < 2; ++i) oc[h][i] = on[h][i];
        if constexpr (ALIGN_EPI) { if (wr == 1) PG8_BAR; }
    }
    PG8_WAIT_V(0);
    if constexpr (HOST) { CH_LANE(); const int q_ = __builtin_amdgcn_readfirstlane(H.q); if (q_ >= 2) { ch_finish<HGU>(H, q_ - 2, cvx, ctile, cl_); ch_finish<HGU>(H, q_ - 1, cvy, ctile, cl_); } }
    if constexpr (!ALIGN_EPI) { if (wr == 0) PG8_BAR; }
    PG8_BAR;
    if constexpr (Epi::AFTER_DRAIN) E.fused(acc, cur, wr, wc, fr, fq, lds_flat, wid, lane);
    }
    if constexpr (HOST) {
        CH_LANE(); H.q = (__builtin_amdgcn_readfirstlane(H.q) + 3) & ~3;
        while (H.it0 + H.nW * (__builtin_amdgcn_readfirstlane(H.q) >> 2) < H.hi) { const int q_ = __builtin_amdgcn_readfirstlane(H.q); ch_issue<HGU>(H, cvx, voffL); ch_finish<HGU>(H, q_, cvx, ctile, cl_); } }
#undef PG8_SA
#undef PG8_SB
#undef PG8_STAGE
#undef PG8_LDA
#undef PG8_LDF
#undef PG8_LDB
#undef PG8_MMA
#undef PG8_WAIT_V
#undef PG8_WAIT_L
#undef PG8_BAR
#undef PG8_SCHED
#undef PG8_MMA_M
#undef PG8_MMA_H
#undef CH_LANE
}
template <bool ALIGN, class Sched, class Epi> __device__ __forceinline__ void gemm_run(unsigned char* lds, const Sched& S, const Epi& E) {
    ConvHost none{}; gemm_phase<Sched, Epi, ALIGN>(lds, S, E, none);
}
template <bool ALIGN, int HOSTM, class Sched, class Epi> __device__ __forceinline__ void gemm_run_host(unsigned char* lds, const Sched& S, const Epi& E, const float* src, unsigned char* ws, int lo, int hi, int gw, int nW) {
    ConvHost H{src, ws, lo + gw, nW, hi, 0}; gemm_phase<Sched, Epi, ALIGN, false, 0x7f, HOSTM>(lds, S, E, H);
}
constexpr int WSCALE_LOG2 = 6;
template <bool ALIGN, class Sched, class Epi> __device__ __forceinline__ void gemm_run_fp8(unsigned char* lds, const Sched& S, const Epi& E) {
    ConvHost none{}; gemm_phase<Sched, Epi, ALIGN, true, 127 - WSCALE_LOG2>(lds, S, E, none);
}

struct DenseSched {
    const char* A; const char* Bt; unsigned lda, ldb; int K; int nM, nN; int pm_per_b; size_t zB; int G, c;
    __device__ __forceinline__ bool next(int i, GUnit& u) const {
        int pm, pn;
        if (G == 256 && (nN & 3) == 0 && nM * nN >= 256) {
            const int j = c & 7, q = c >> 3, s = i * 8 + j, ncg = nN >> 2; pm = (s / ncg) * 8 + (q >> 2); pn = (s % ncg) * 4 + (q & 3); if (c < 0 || pm >= nM) return false; }
        else { const long L = (long)i * G + c; if (c < 0 || L >= (long)nM * nN) return false; pm = (int)(L / nN); pn = (int)(L % nN); }
        u.ao = (unsigned)pm * 256u * lda; u.bo = (unsigned)((size_t)(pm / pm_per_b) * zB) + (unsigned)pn * 256u * ldb; u.row0 = pm * 256; u.col0 = pn * 256; u.e = 0; u.valid = 256; u.aux = 0; return true;
    }
    __device__ __forceinline__ unsigned a_off(const GUnit&, int r) const { return (unsigned)r * lda; }
};
struct SchedWqk {
    const char* A; const char* Bt; unsigned lda, ldb; int K; int G, c, pad;
    __device__ __forceinline__ bool next(int i, GUnit& u) const {
        const int L = i * G + c; if (c < 0 || L >= 32) return false; const int z = L >> 2, pn = L & 3, b = z >> 2, h = z & 3;
        u.ao = (unsigned)b * 256u * 4096u + h * 512u; u.bo = (unsigned)pn * 256u * 2048u + h * 512u; u.row0 = z * 256; u.col0 = pn * 256; u.e = 0; u.valid = 256; u.aux = 0; return true;
    }
    __device__ __forceinline__ unsigned a_off(const GUnit&, int r) const { return (unsigned)r * lda; }
};
struct SchedVo {
    const char* A; const char* Bt; unsigned lda, ldb; int K; int G, c, pad;
    __device__ __forceinline__ bool next(int i, GUnit& u) const {
        const int L = i * G + c; if (c < 0 || L >= 32) return false; const int z = L >> 2, pm = L & 3, b = z >> 2, h = z & 3;
        u.ao = (unsigned)pm * 256u * 2048u + h * 512u; u.bo = (unsigned)b * 256u * 4096u + 2048u + h * 512u; u.row0 = b * 1024 + pm * 256; u.col0 = h * 256; u.e = 0; u.valid = 256; u.aux = 0; return true;
    }
    __device__ __forceinline__ unsigned a_off(const GUnit&, int r) const { return (unsigned)r * lda; }
};
template <bool GATHER> struct MoeSched {
    const char* A; const char* Bt; unsigned lda, ldb; int K; int nN; size_t zB;
    const int* tab; const int* list; int gather; int G, c, pad;
    __device__ __forceinline__ bool next(int i, GUnit& u) const {
        int T, pn;
        if (G == 256) { const int j = c & 7, q = c >> 3, s = i * 8 + j;
            if (nN == 8) { T = 4 * s + (q >> 3); pn = q & 7; } else { T = 8 * s + (q >> 2); pn = q & 3; } }
        else { const int L = i * G + c; T = L / nN; pn = L % nN; }
        if (T >= __builtin_amdgcn_readfirstlane(tab[64])) return false;
        const int w = __builtin_amdgcn_readfirstlane(tab[128 + T]); const int e = w & 255, rt = w >> 8; const int ce = __builtin_amdgcn_readfirstlane(tab[e]), start = __builtin_amdgcn_readfirstlane(tab[32 + e]);
        u.e = e; u.valid = min(256, ce - rt * 256); u.row0 = start + rt * 256; u.col0 = pn * 256; u.aux = rt * 256;
        u.ao = GATHER ? 0u : (unsigned)u.row0 * lda; u.bo = (unsigned)((size_t)e * zB) + (unsigned)pn * 256u * ldb; return true;
    }
    __device__ __forceinline__ unsigned a_off(const GUnit& u, int r) const {
        if (!GATHER) return (unsigned)r * lda;
        const int rr = r < u.valid ? r : 0; const int tok = list[u.e * NTOK + u.aux + rr]; return (unsigned)tok * lda;
    }
};
__device__ __forceinline__ void moe_build_table(int* tab, const int* __restrict__ cnt, int tid) {
    if (tid < 32) tab[tid] = cnt[tid * 32];
    __syncthreads();
    if (tid < 32) { int s = 0; for (int e = 0; e < tid; ++e) s += tab[e]; tab[32 + tid] = s; }
    if (tid < 320) { int tiles = 0, found = -1;
        for (int e = 0; e < NEXP; ++e) { const int te = (tab[e] + 255) >> 8; if (found < 0 && tid < tiles + te) found = e | ((tid - tiles) << 8); tiles += te; }
        if (found >= 0) tab[128 + tid] = found; if (tid == 0) tab[64] = tiles; }
    __syncthreads();
}

__device__ __forceinline__ u32x4 pack8(const f32x4& a, const f32x4& b) { u32x4 w; w.x = pk2(a[0], a[1]); w.y = pk2(a[2], a[3]); w.z = pk2(b[0], b[1]); w.w = pk2(b[2], b[3]); return w; }
struct EpiBf16 { static constexpr bool AFTER_DRAIN = false; bf16_t* O; int ldc, pad;
    __device__ __forceinline__ void operator()(const f32x4 (&acc)[2][2][4][2], const GUnit& u, int wr, int wc, int fr, int fq) const {
        LAUNDER(fr); LAUNDER(fq);
#pragma unroll
        for (int ai = 0; ai < 2; ++ai)
#pragma unroll
            for (int m = 0; m < 4; ++m) { const int r = 128 * ai + 64 * wr + 16 * m + fr;
#pragma unroll
                for (int bj = 0; bj < 2; ++bj) *(u32x4*)(O + (size_t)(u.row0 + r) * ldc + u.col0 + 128 * bj + 32 * wc + 8 * fq) = pack8(acc[ai][bj][m][0], acc[ai][bj][m][1]); } } };
__device__ __forceinline__ float row_rstd(const float* __restrict__ ssp, int row) { const f32x4* p = (const f32x4*)(ssp + (size_t)row * 16); const f32x4 a = p[0], b = p[1], c = p[2], d = p[3];
    const float s = (((a[0] + a[1]) + (a[2] + a[3])) + ((b[0] + b[1]) + (b[2] + b[3]))) + (((c[0] + c[1]) + (c[2] + c[3])) + ((d[0] + d[1]) + (d[2] + d[3]))); return 1.0f / sqrtf(s * (1.0f / 1024.0f) + EPS); }
template <bool BASE_BF16> struct EpiResidSS { static constexpr bool AFTER_DRAIN = false; const void* base; bf16_t* xb; float* ss; unsigned char* xq; const float* qg;
    __device__ __forceinline__ void operator()(const f32x4 (&acc)[2][2][4][2], const GUnit& u, int wr, int wc, int fr, int fq) const {
        LAUNDER(fr); LAUNDER(fq);
#pragma unroll
        for (int ai = 0; ai < 2; ++ai) {
            f32x4 b[4][2][2];
#pragma unroll
            for (int m = 0; m < 4; ++m)
#pragma unroll
                for (int bj = 0; bj < 2; ++bj) { const size_t o = (size_t)(u.row0 + 128 * ai + 64 * wr + 16 * m + fr) * 1024 + u.col0 + 128 * bj + 32 * wc + 8 * fq;
                    if (BASE_BF16) { const u32x4 w = *(const u32x4*)((const bf16_t*)base + o); b[m][bj][0] = (f32x4){bflo(w.x), bfhi(w.x), bflo(w.y), bfhi(w.y)}; b[m][bj][1] = (f32x4){bflo(w.z), bfhi(w.z), bflo(w.w), bfhi(w.w)}; }
                    else { b[m][bj][0] = __builtin_nontemporal_load((const f32x4*)((const float*)base + o)); b[m][bj][1] = __builtin_nontemporal_load((const f32x4*)((const float*)base + o + 4)); } }
#pragma unroll
            for (int m = 0; m < 4; ++m) { const int r = 128 * ai + 64 * wr + 16 * m + fr; float part = 0.f;
#pragma unroll
                for (int bj = 0; bj < 2; ++bj) { const size_t o = (size_t)(u.row0 + r) * 1024 + u.col0 + 128 * bj + 32 * wc + 8 * fq;
                    const f32x4 y0 = b[m][bj][0] + acc[ai][bj][m][0], y1 = b[m][bj][1] + acc[ai][bj][m][1]; *(u32x4*)(xb + o) = pack8(y0, y1);
                    if (xq) { const int cq = u.col0 + 128 * bj + 32 * wc + 8 * fq; const f32x4 g0 = *(const f32x4*)(qg + cq), g1 = *(const f32x4*)(qg + cq + 4); const f32x4 z0 = y0 * g0, z1 = y1 * g1;
                        u32x2 q; q.x = pk4_fp8(z0[0], z0[1], z0[2], z0[3]); q.y = pk4_fp8(z1[0], z1[1], z1[2], z1[3]); *(u32x2*)(xq + o) = q; }
                    part += (y0[0] * y0[0] + y0[1] * y0[1] + y0[2] * y0[2] + y0[3] * y0[3]) + (y1[0] * y1[0] + y1[1] * y1[1] + y1[2] * y1[2] + y1[3] * y1[3]); }
                part += __shfl_xor(part, 16); part += __shfl_xor(part, 32);
                if (fq == 0) ss[(size_t)(u.row0 + r) * 16 + (u.col0 >> 8) * 4 + wc] = part; } } } };
struct EpiSoftmax { static constexpr bool AFTER_DRAIN = true; const float* ss; bf16_t* P;
    __device__ __forceinline__ void operator()(const f32x4 (&)[2][2][4][2], const GUnit&, int, int, int, int) const {}
    __device__ __forceinline__ void fused(f32x4 (&acc)[2][2][4][2], const GUnit& u, int wr, int wc, int fr, int fq, unsigned char* lds, int wid, int lane) const {
        float* Pm = (float*)lds; float* Ps = (float*)(lds + 4096);
        LAUNDER(fr); LAUNDER(fq);
#pragma unroll
        for (int ai = 0; ai < 2; ++ai)
#pragma unroll
            for (int m = 0; m < 4; ++m) { const int r = 128 * ai + 64 * wr + 16 * m + fr; const float rstd = row_rstd(ss, u.row0 + r); float mv = -INFINITY;
#pragma unroll
                for (int bj = 0; bj < 2; ++bj)
#pragma unroll
                    for (int n = 0; n < 2; ++n) { f32x4 s = acc[ai][bj][m][n] * rstd; acc[ai][bj][m][n] = s; mv = fmaxf(mv, fmaxf(fmaxf(s[0], s[1]), fmaxf(s[2], s[3]))); }
                mv = fmaxf(mv, __shfl_xor(mv, 16)); mv = fmaxf(mv, __shfl_xor(mv, 32));
                if (fq == 0) Pm[r * 4 + wc] = mv; }
        __syncthreads();
#pragma unroll
        for (int ai = 0; ai < 2; ++ai)
#pragma unroll
            for (int m = 0; m < 4; ++m) { const int r = 128 * ai + 64 * wr + 16 * m + fr; const f32x4 pm = *(const f32x4*)(Pm + r * 4); const float mv = fmaxf(fmaxf(pm[0], pm[1]), fmaxf(pm[2], pm[3])); float sum = 0.f;
#pragma unroll
                for (int bj = 0; bj < 2; ++bj)
#pragma unroll
                    for (int n = 0; n < 2; ++n) { f32x4 s = acc[ai][bj][m][n]; s[0] = __builtin_amdgcn_exp2f(s[0] - mv); s[1] = __builtin_amdgcn_exp2f(s[1] - mv); s[2] = __builtin_amdgcn_exp2f(s[2] - mv); s[3] = __builtin_amdgcn_exp2f(s[3] - mv);
                        acc[ai][bj][m][n] = s; sum += (s[0] + s[1]) + (s[2] + s[3]); }
                sum += __shfl_xor(sum, 16); sum += __shfl_xor(sum, 32);
                if (fq == 0) Ps[r * 4 + wc] = sum; }
        __syncthreads();
#pragma unroll
        for (int ai = 0; ai < 2; ++ai)
#pragma unroll
            for (int m = 0; m < 4; ++m) { const int r = 128 * ai + 64 * wr + 16 * m + fr; const f32x4 ps = *(const f32x4*)(Ps + r * 4); const float inv = 1.0f / ((ps[0] + ps[1]) + (ps[2] + ps[3]));
#pragma unroll
                for (int bj = 0; bj < 2; ++bj) *(u32x4*)(P + (size_t)(u.row0 + r) * 1024 + u.col0 + 128 * bj + 32 * wc + 8 * fq) = pack8(acc[ai][bj][m][0] * inv, acc[ai][bj][m][1] * inv); }
        (void)wid; (void)lane;
        __syncthreads();
    } };
struct EpiGU { static constexpr bool AFTER_DRAIN = false; const float* bgu; unsigned char* act  ; const float* lrs  ;
    __device__ __forceinline__ void operator()(const f32x4 (&acc)[2][2][4][2], const GUnit& u, int wr, int wc, int fr, int fq) const {
        const int pn = u.col0 >> 8; const float* bg = bgu + (size_t)u.e * 2048; LAUNDER(fr); LAUNDER(fq);
        float rs[8];
#pragma unroll
        for (int i = 0; i < 8; ++i) { const int r = 128 * (i >> 2) + 64 * wr + 16 * (i & 3) + fr; rs[i] = lrs[(size_t)u.e * NTOK + u.aux + (r < u.valid ? r : 0)]; }
        const int col = 128 * pn + 32 * wc + 8 * fq;
        f32x4 bgv[2], blv[2];
#pragma unroll
        for (int n = 0; n < 2; ++n) { bgv[n] = *(const f32x4*)(bg + col + 4 * n); blv[n] = *(const f32x4*)(bg + 1024 + col + 4 * n); }
#pragma unroll
        for (int ai = 0; ai < 2; ++ai)
#pragma unroll
            for (int m = 0; m < 4; ++m) { const int r = 128 * ai + 64 * wr + 16 * m + fr; const float rstd = rs[ai * 4 + m]; u32x2 q;
#pragma unroll
                for (int n = 0; n < 2; ++n) { const f32x4 g = acc[ai][0][m][n] * rstd + bgv[n], l = acc[ai][1][m][n] * rstd + blv[n]; float o[4];
#pragma unroll
                    for (int j = 0; j < 4; ++j) { const float gg = fminf(g[j], 7.0f), ll = fminf(fmaxf(l[j], -7.0f), 7.0f); o[j] = (ll + 1.0f) * (gg * __builtin_amdgcn_rcpf(1.0f + __builtin_amdgcn_exp2f(-1.702f * LOG2E * gg))); }
                    const unsigned w = pk4_fp8(o[0], o[1], o[2], o[3]); if (n == 0) q.x = w; else q.y = w; }
                if (r < u.valid) *(u32x2*)(act + (size_t)(u.row0 + r) * 1024 + col) = q; } } };
struct EpiDown { static constexpr bool AFTER_DRAIN = false; const float* bdn; unsigned char* ys  ;
    __device__ __forceinline__ void operator()(const f32x4 (&acc)[2][2][4][2], const GUnit& u, int wr, int wc, int fr, int fq) const {
        const float* bd = bdn + (size_t)u.e * 1024; LAUNDER(fr); LAUNDER(fq);
        f32x4 bv[2][2];
#pragma unroll
        for (int bj = 0; bj < 2; ++bj)
#pragma unroll
            for (int n = 0; n < 2; ++n) bv[bj][n] = *(const f32x4*)(bd + u.col0 + 128 * bj + 32 * wc + 8 * fq + 4 * n);
#pragma unroll
        for (int ai = 0; ai < 2; ++ai)
#pragma unroll
            for (int m = 0; m < 4; ++m) { const int r = 128 * ai + 64 * wr + 16 * m + fr; if (r < u.valid) {
#pragma unroll
                for (int bj = 0; bj < 2; ++bj) { const f32x4 y0 = acc[ai][bj][m][0] + bv[bj][0], y1 = acc[ai][bj][m][1] + bv[bj][1]; u32x2 q; q.x = pk4_fp8(y0[0], y0[1], y0[2], y0[3]); q.y = pk4_fp8(y1[0], y1[1], y1[2], y1[3]);
                    *(u32x2*)(ys + (size_t)(u.row0 + r) * 1024 + u.col0 + 128 * bj + 32 * wc + 8 * fq) = q; } } } } };


typedef float f32x16 __attribute__((ext_vector_type(16)));
typedef short s16x4 __attribute__((ext_vector_type(4)));
__device__ __forceinline__ int crow(int r, int hi) { return (r & 3) + 8 * (r >> 2) + 4 * hi; }
__device__ __forceinline__ s16x4 tr_read(const unsigned char* p) { return __builtin_bit_cast(s16x4, __builtin_amdgcn_ds_read_tr16_b64_v4i16((LDSP s16x4*)(unsigned)(uintptr_t)p)); }
__device__ __forceinline__ bf16x8 tr_frag(const unsigned char* img, int pitch, int k0, int f0, int lane) {
    const unsigned char* p = img + (k0 + 8 * (lane >> 5) + ((lane & 15) >> 2)) * pitch + (f0 + 16 * ((lane >> 4) & 1) + 4 * (lane & 3)) * 2;
    const s16x4 lo = tr_read(p), hi = tr_read(p + 4 * pitch);
    return (bf16x8){lo[0], lo[1], lo[2], lo[3], hi[0], hi[1], hi[2], hi[3]};
}
constexpr int GA_PK = 576, GA_PV = 1088;
constexpr int GA_V = 0, GA_PART = 0, GA_GLR = 69632, GA_TOT = 73728, GA_KD = 75776, GA_END = GA_KD + 64 * GA_PK;
__device__ __forceinline__ void gla_pass_a(unsigned char* lds, int task, const bf16_t* __restrict__ xn, const bf16_t* __restrict__ wglr  , const bf16_t* __restrict__ proj,
                                           const float* __restrict__ wg, const float* __restrict__ bg, float* __restrict__ UT, float* __restrict__ decay) {
    int tid = threadIdx.x; LAUNDER(tid); int wid = tid >> 6, lane = tid & 63, fr = lane & 15, fq = lane >> 4;
    const size_t t0 = (size_t)task * 64;
    { f32x4 acc[4];
#pragma unroll
      for (int m = 0; m < 4; ++m) acc[m] = (f32x4){0.f, 0.f, 0.f, 0.f};
#pragma unroll
      for (int ks = 0; ks < 4; ++ks) { const int k = 128 * wid + 32 * ks + 8 * fq; const bf16x8 bfr = *(const bf16x8*)(wglr + (size_t)fr * 1024 + k);
#pragma unroll
          for (int m = 0; m < 4; ++m) { const bf16x8 afr = *(const bf16x8*)(xn + (t0 + 16 * m + fr) * DM + k); acc[m] = __builtin_amdgcn_mfma_f32_16x16x32_bf16(afr, bfr, acc[m], 0, 0, 0); } }
      float* part = (float*)(lds + GA_PART) + wid * 1024;
#pragma unroll
      for (int m = 0; m < 4; ++m)
#pragma unroll
          for (int j = 0; j < 4; ++j) part[(16 * m + 4 * fq + j) * 16 + fr] = acc[m][j]; }
    __syncthreads();
    { float* glr = (float*)(lds + GA_GLR); const float* part = (const float*)(lds + GA_PART);
      for (int i = tid; i < 1024; i += 512) { float s = 0.f;
#pragma unroll
          for (int w = 0; w < 8; ++w) s += part[w * 1024 + i];
          glr[i] = s; } }
    __syncthreads();
    LAUNDER(tid);
    { const int cv = tid & 63, tk = tid >> 6;
#pragma unroll
      for (int i = 0; i < 8; ++i) { const int tok = tk + 8 * i; const u32x4 v = *(const u32x4*)(proj + (t0 + tok) * PROJ_LD + C_VG + cv * 8); *(u32x4*)(lds + GA_V + tok * GA_PV + cv * 16) = v; } }
    LAUNDER(tid);
    { const int j = tid & 255, half = tid >> 8; const float* glr = (const float*)(lds + GA_GLR); float* tot = (float*)(lds + GA_TOT);
      float w[16];
#pragma unroll
      for (int i = 0; i < 16; ++i) w[i] = wg[i * 256 + j];
      const float bj = bg[j]; float run = 0.f;
      bf16_t kk16[32];
#pragma unroll
      for (int s = 0; s < 32; ++s) kk16[s] = proj[(t0 + 32 * half + s) * PROJ_LD + C_KG + j];
      float Gc[32];
#pragma unroll
      for (int s = 0; s < 32; ++s) { const float* gl = glr + (32 * half + s) * 16; float u = bj;
#pragma unroll
          for (int i = 0; i < 16; ++i) u += gl[i] * w[i];
          const float ls = fminf(u, 0.f) - __logf(1.0f + __expf(-fabsf(u)));
          run += ls * (1.0f / 16.0f); Gc[s] = run; }
      tot[half * 256 + j] = run;
      __syncthreads();
      const float t0v = tot[j], t1v = tot[256 + j]; const float gend = t0v + t1v;
      if (half == 0) decay[(size_t)task * 256 + j] = __expf(gend);
      const float rel = gend - (half ? t0v : 0.f);
#pragma unroll
      for (int s = 0; s < 32; ++s) { const int tok = 32 * half + s;
          *(bf16_t*)(lds + GA_KD + tok * GA_PK + j * 2) = (bf16_t)f2bf(bf2f(kk16[s]) * __expf(rel - Gc[s])); } }
    __syncthreads();
    LAUNDER(tid); wid = __builtin_amdgcn_readfirstlane(tid >> 6); lane = tid & 63;
    { const int h = wid >> 1, nt = wid & 1, hi = lane >> 5, c32 = lane & 31; f32x16 acc[4];
#pragma unroll
      for (int m = 0; m < 4; ++m)
#pragma unroll
          for (int r = 0; r < 16; ++r) acc[m][r] = 0.f;
#pragma unroll
      for (int ks = 0; ks < 4; ++ks) { const bf16x8 bfr = tr_frag(lds + GA_KD, GA_PK, 16 * ks, h * 64 + 32 * nt, lane);
#pragma unroll
          for (int m = 0; m < 4; ++m) { const bf16x8 afr = tr_frag(lds + GA_V, GA_PV, 16 * ks, h * 128 + 32 * m, lane); acc[m] = __builtin_amdgcn_mfma_f32_32x32x16_bf16(afr, bfr, acc[m], 0, 0, 0); } }
      float* u = UT + ((size_t)task * 4 + h) * 8192;
#pragma unroll
      for (int m = 0; m < 4; ++m)
#pragma unroll
          for (int r = 0; r < 16; ++r) __builtin_nontemporal_store(acc[m][r], u + (32 * m + crow(r, hi)) * 64 + 32 * nt + c32); }
    __syncthreads();
}
__device__ __forceinline__ void gla_pass_b(int e, const float* __restrict__ UT, const float* __restrict__ decay, bf16_t* __restrict__ ST) {
    const int dk = e & 63, dv = (e >> 6) & 127, h = (e >> 13) & 3, b = e >> 15; float s = 0.f;
    const size_t base = ((size_t)b * 128 * 4 + h) * 8192 + dv * 64 + dk; const size_t dbase = (size_t)b * 128 * 256 + h * 64 + dk;
    for (int c0 = 0; c0 < 128; c0 += 32) { float u[32], d[32];
#pragma unroll
        for (int i = 0; i < 32; ++i) { u[i] = __builtin_nontemporal_load(UT + base + (size_t)(c0 + i) * 4 * 8192); d[i] = decay[dbase + (size_t)(c0 + i) * 256]; }
#pragma unroll
        for (int i = 0; i < 32; ++i) { s = d[i] * s + u[i]; __builtin_nontemporal_store((bf16_t)f2bf(s), ST + base + (size_t)(c0 + i) * 4 * 8192); } }
}
constexpr int GC_PITCH = 520;
__device__ __forceinline__ void gla_pass_c(unsigned char* wlds  , int wtask, const bf16_t* __restrict__ ST, const bf16_t* __restrict__ proj, const float* __restrict__ ghead, bf16_t* __restrict__ mix, int lane) {
    const int nh = wtask & 1, h = (wtask >> 1) & 3, bc = wtask >> 3; const int c32 = lane & 31, hi = lane >> 5;
    const size_t t0 = (size_t)bc * 64 + 32 * nh; const bf16_t* st = ST + ((size_t)bc * 4 + h) * 8192;
    f32x16 acc[4];
#pragma unroll
    for (int m = 0; m < 4; ++m)
#pragma unroll
        for (int r = 0; r < 16; ++r) acc[m][r] = 0.f;
#pragma unroll
    for (int ks = 0; ks < 4; ++ks) { const bf16x8 bfr = *(const bf16x8*)(proj + (t0 + c32) * PROJ_LD + C_QG + h * 64 + 16 * ks + 8 * hi);
#pragma unroll
        for (int m = 0; m < 4; ++m) { const bf16x8 afr = *(const bf16x8*)(st + (32 * m + c32) * 64 + 16 * ks + 8 * hi); acc[m] = __builtin_amdgcn_mfma_f32_32x32x16_bf16(afr, bfr, acc[m], 0, 0, 0); } }
    float ss = 0.f;
#pragma unroll
    for (int m = 0; m < 4; ++m)
#pragma unroll
        for (int r = 0; r < 16; ++r) ss += acc[m][r] * acc[m][r];
    ss += __shfl_xor(ss, 32);
    const float rstd = 1.0f / sqrtf(ss * (1.0f / 128.0f) + EPS);
#pragma unroll
    for (int m = 0; m < 4; ++m)
#pragma unroll
        for (int r = 0; r < 16; ++r) *(float*)(wlds + c32 * GC_PITCH + (32 * m + crow(r, hi)) * 4) = acc[m][r] * rstd;
#pragma unroll
    for (int i = 0; i < 8; ++i) { const int q = lane + 64 * i, tok = q >> 4, dv0 = (q & 15) * 8; const float* src = (const float*)(wlds + tok * GC_PITCH + dv0 * 4);
        const u32x4 rgw = *(const u32x4*)(proj + (t0 + tok) * PROJ_LD + C_RG + h * 128 + dv0); const f32x4 g0 = *(const f32x4*)(ghead + dv0), g1 = *(const f32x4*)(ghead + dv0 + 4);
        const float rg[8] = {bflo(rgw.x), bfhi(rgw.x), bflo(rgw.y), bfhi(rgw.y), bflo(rgw.z), bfhi(rgw.z), bflo(rgw.w), bfhi(rgw.w)}; const float gg[8] = {g0.x, g0.y, g0.z, g0.w, g1.x, g1.y, g1.z, g1.w}; float y[8];
#pragma unroll
        for (int k = 0; k < 8; ++k) y[k] = src[k] * gg[k] * (rg[k] / (1.0f + __expf(-rg[k])));
        u32x4 o; o.x = pk2(y[0], y[1]); o.y = pk2(y[2], y[3]); o.z = pk2(y[4], y[5]); o.w = pk2(y[6], y[7]);
        *(u32x4*)(mix + (t0 + tok) * 1024 + h * 128 + dv0) = o; }
}
__device__ __forceinline__ void sb_task(unsigned char* vl  , int wtask, const bf16_t* __restrict__ proj, bf16_t* __restrict__ mix, int lane) {
    const int qt = wtask & 255, h = (wtask >> 8) & 7, b = wtask >> 11; const int c = lane & 31, hi = lane >> 5;
    const int t0 = qt * 32; const size_t rowb = (size_t)b * SEQ;
    bf16x8 qf[4];
#pragma unroll
    for (int d0 = 0; d0 < 4; ++d0) qf[d0] = *(const bf16x8*)(proj + (rowb + t0 + c) * PROJ_LD + C_QS + h * 64 + 16 * d0 + 8 * hi);
    const int kap = 16 * ((c >> 2) & 1) + (c & 3) + 4 * (c >> 3);
    f32x16 o0, o1;
#pragma unroll
    for (int r = 0; r < 16; ++r) { o0[r] = 0.f; o1[r] = 0.f; }
    float Dc = 1.0f;
    const bf16_t* kbase = proj + rowb * PROJ_LD + C_KS + h * 64 + 8 * hi + (size_t)kap * PROJ_LD;
    const bf16_t* vbase = proj + rowb * PROJ_LD + C_VS + h * 64 + (lane & 7) * 8 + (size_t)(lane >> 3) * PROJ_LD;
    bf16x8 kf[4]; u32x4 vr[4];
#pragma unroll
    for (int d0 = 0; d0 < 4; ++d0) kf[d0] = *(const bf16x8*)(kbase + (size_t)t0 * PROJ_LD + 16 * d0);
#pragma unroll
    for (int i = 0; i < 4; ++i) vr[i] = *(const u32x4*)(vbase + (size_t)(t0 + 8 * i) * PROJ_LD);
    for (int j0 = t0; j0 >= 0; j0 -= 32) {
#pragma unroll
        for (int i = 0; i < 4; ++i) { const int key = (lane >> 3) + 8 * i, ch = lane & 7; *(u32x4*)(vl + (ch >> 2) * 2048 + key * 64 + (ch & 3) * 16) = vr[i]; }
        f32x16 z;
#pragma unroll
        for (int r = 0; r < 16; ++r) z[r] = 0.f;
#pragma unroll
        for (int d0 = 0; d0 < 4; ++d0) z = __builtin_amdgcn_mfma_f32_32x32x16_bf16(kf[d0], qf[d0], z, 0, 0, 0);
        asm volatile("" ::: "memory");
        { const int jn = (j0 >= 32) ? j0 - 32 : j0;
#pragma unroll
          for (int d0 = 0; d0 < 4; ++d0) kf[d0] = *(const bf16x8*)(kbase + (size_t)jn * PROJ_LD + 16 * d0);
#pragma unroll
          for (int i = 0; i < 4; ++i) vr[i] = *(const u32x4*)(vbase + (size_t)(jn + 8 * i) * PROJ_LD); }
        asm volatile("" ::: "memory");
        float e[16], Dl[16];
        const bool diag = (j0 == t0);
#pragma unroll
        for (int r = 0; r < 16; ++r) { float ev = __builtin_amdgcn_exp2f(fminf(z[r], 126.0f)); if (diag && (16 * hi + r >= c)) ev = 0.f; e[r] = ev; }
        float D = hi ? Dc : 1.0f;
#pragma unroll
        for (int r = 15; r >= 0; --r) { D = fmaf(D, e[r], D); Dl[r] = D; }
        const float other = __shfl_xor(D, 32);
        const float mult = hi ? 1.0f : other;
        Dc = D * other;
        unsigned pw[8];
#pragma unroll
        for (int r = 0; r < 16; r += 2) { const float a0 = e[r] * __builtin_amdgcn_rcpf(Dl[r] * mult), a1 = e[r + 1] * __builtin_amdgcn_rcpf(Dl[r + 1] * mult); pw[r >> 1] = pk2(a0, a1); }
#pragma unroll
        for (int ks = 0; ks < 2; ++ks) { const bf16x8 pa = __builtin_bit_cast(bf16x8, (u32x4){pw[4 * ks], pw[4 * ks + 1], pw[4 * ks + 2], pw[4 * ks + 3]});
            const unsigned char* vb = vl + (16 * hi + 8 * ks + ((lane & 15) >> 2)) * 64 + (16 * ((lane >> 4) & 1) + 4 * (lane & 3)) * 2;
            { const s16x4 lo = tr_read(vb), hh = tr_read(vb + 256); o0 = __builtin_amdgcn_mfma_f32_32x32x16_bf16(pa, (bf16x8){lo[0], lo[1], lo[2], lo[3], hh[0], hh[1], hh[2], hh[3]}, o0, 0, 0, 0); }
            { const s16x4 lo = tr_read(vb + 2048), hh = tr_read(vb + 2048 + 256); o1 = __builtin_amdgcn_mfma_f32_32x32x16_bf16(pa, (bf16x8){lo[0], lo[1], lo[2], lo[3], hh[0], hh[1], hh[2], hh[3]}, o1, 0, 0, 0); } }
        if (__all(!(Dc < 3.0e38f))) break;
    }
    bf16_t* ob = mix + (rowb + t0) * 1024 + 512 + h * 64 + c;
#pragma unroll
    for (int r = 0; r < 16; ++r) { const int q = crow(r, hi); ob[(size_t)q * 1024] = (bf16_t)f2bf(o0[r]); ob[(size_t)q * 1024 + 32] = (bf16_t)f2bf(o1[r]); }
}
__device__ __forceinline__ void memkv_task(int wtask, int lane, const bf16_t* __restrict__ memn, const bf16_t* __restrict__ wkv, bf16_t* __restrict__ kv) {
    const int tm = wtask >> 6, tn = wtask & 63; const int c = lane & 31, hi = lane >> 5;
    const bf16_t* ap = memn + (size_t)(tm * 32 + c) * DM + 8 * hi; const bf16_t* bp = wkv + (size_t)(tn * 32 + c) * DM + 8 * hi;
    f32x16 acc;
#pragma unroll
    for (int r = 0; r < 16; ++r) acc[r] = 0.f;
#pragma unroll 16
    for (int ks = 0; ks < 64; ++ks) { const bf16x8 a = *(const bf16x8*)(ap + 16 * ks), b = *(const bf16x8*)(bp + 16 * ks); acc = __builtin_amdgcn_mfma_f32_32x32x16_bf16(a, b, acc, 0, 0, 0); }
    bf16_t* o = kv + (size_t)(tm * 32) * 2048 + tn * 32 + c;
#pragma unroll
    for (int r = 0; r < 16; ++r) o[(size_t)crow(r, hi) * 2048] = (bf16_t)f2bf(acc[r]);
}
__device__ __forceinline__ void router_task(int wtask, int lane, const bf16_t* __restrict__ xn, const float* __restrict__ ss, const bf16_t* __restrict__ wr, const float* __restrict__ br,
                                            int (&oe)[4], float (&ow)[4]) {
    const int c = lane & 31, hi = lane >> 5; const int t = wtask * 32 + c;
    const bf16_t* ap = wr + (size_t)c * DM + 8 * hi; const bf16_t* bp = xn + (size_t)t * DM + 8 * hi;
    f32x16 acc;
#pragma unroll
    for (int r = 0; r < 16; ++r) acc[r] = 0.f;
#pragma unroll 16
    for (int ks = 0; ks < 64; ++ks) { const bf16x8 a = *(const bf16x8*)(ap + 16 * ks), b = *(const bf16x8*)(bp + 16 * ks); acc = __builtin_amdgcn_mfma_f32_32x32x16_bf16(a, b, acc, 0, 0, 0); }
    float v[16]; const float rstd = row_rstd(ss, t);
#pragma unroll
    for (int r = 0; r < 16; ++r) v[r] = acc[r] * rstd + br[crow(r, hi)];
    float tv[4]; int ti[4];
#pragma unroll
    for (int k = 0; k < 4; ++k) { float best = -INFINITY; int bi = 64;
#pragma unroll
        for (int r = 0; r < 16; ++r) { if (v[r] > best) { best = v[r]; bi = crow(r, hi); } }
        tv[k] = best; ti[k] = bi;
#pragma unroll
        for (int r = 0; r < 16; ++r) if (crow(r, hi) == bi) v[r] = -INFINITY; }
    float cv[8]; int ci[8];
#pragma unroll
    for (int k = 0; k < 4; ++k) { cv[k] = tv[k]; ci[k] = ti[k]; cv[4 + k] = __shfl_xor(tv[k], 32); ci[4 + k] = __shfl_xor(ti[k], 32); }
#pragma unroll
    for (int k = 0; k < 4; ++k) { float best = -INFINITY; int bi = 64;
#pragma unroll
        for (int q = 0; q < 8; ++q) { if (cv[q] > best || (cv[q] == best && ci[q] < bi)) { best = cv[q]; bi = ci[q]; } }
        tv[k] = best; ti[k] = bi;
#pragma unroll
        for (int q = 0; q < 8; ++q) if (ci[q] == bi) cv[q] = -INFINITY; }
    const float e1 = __expf(tv[1] - tv[0]), e2 = __expf(tv[2] - tv[0]), e3 = __expf(tv[3] - tv[0]); const float inv = 1.0f / (1.0f + e1 + e2 + e3);
    const float g[4] = {inv, e1 * inv, e2 * inv, e3 * inv};
#pragma unroll
    for (int k = 0; k < 4; ++k) { oe[k] = ti[k]; ow[k] = g[k]; }
}
__device__ __forceinline__ void combine_task(int t, int lane, const bf16_t* xin, float* xout, const unsigned char* __restrict__ ys, const int* tab, const int* __restrict__ toke, const int* __restrict__ tokr,
                                                 const float* __restrict__ tokw, const float* __restrict__ gfin) {
    const u32x2* xr = (const u32x2*)(xin + (size_t)t * DM) + lane; f32x4* xo = (f32x4*)(xout + (size_t)t * DM) + lane; f32x4 v[4];
#pragma unroll
    for (int j = 0; j < 4; ++j) { const u32x2 w = __builtin_nontemporal_load(xr + 64 * j); v[j] = (f32x4){bflo(w.x), bfhi(w.x), bflo(w.y), bfhi(w.y)}; }
    for (int k = 0; k < 4; ++k) { const int e = toke[t * 4 + k], r = tokr[t * 4 + k]; const float w = tokw[t * 4 + k]; const int start = tab[32 + e];
        const unsigned* yr = (const unsigned*)(ys + (size_t)(start + r) * DM) + lane;
#pragma unroll
        for (int j = 0; j < 4; ++j) { const int y = (int)__builtin_nontemporal_load(yr + 64 * j); const f32x2 lo = __builtin_amdgcn_cvt_pk_f32_fp8(y, false), hi = __builtin_amdgcn_cvt_pk_f32_fp8(y, true);
            v[j].x += w * lo.x; v[j].y += w * lo.y; v[j].z += w * hi.x; v[j].w += w * hi.y; } }
    float s = 0.f;
#pragma unroll
    for (int j = 0; j < 4; ++j) s += v[j].x * v[j].x + v[j].y * v[j].y + v[j].z * v[j].z + v[j].w * v[j].w;
    const float rstd = 1.0f / sqrtf(wave_sum(s) * (1.f / DM) + EPS);
#pragma unroll
    for (int j = 0; j < 4; ++j) { const f32x4 g = *((const f32x4*)gfin + lane + 64 * j); __builtin_nontemporal_store(v[j] * rstd * g, xo + 64 * j); }
}

#define GAS __attribute__((address_space(1)))
#define RLX_AGENT __ATOMIC_RELAXED, __HIP_MEMORY_SCOPE_AGENT
#define XB_TMO      128
#define XB_XCNT(j)  (256  + 64 * (j))
#define XB_XSUB(j)  (1280 + 64 * (j))
#define XB_XGEN(j)  (2304 + 64 * (j))
#define XB_TOP      3328
#define XB_TOPGEN   3392
#define XCD_BAR_WORDS 3456
#define XB_SPIN_CAP (1u << 18)
__device__ __forceinline__ unsigned xb_ld(unsigned* p)              { return __hip_atomic_load(p, __ATOMIC_RELAXED, __HIP_MEMORY_SCOPE_AGENT); }
__device__ __forceinline__ unsigned xb_add(unsigned* p, unsigned v) { return __hip_atomic_fetch_add(p, v, __ATOMIC_RELAXED, __HIP_MEMORY_SCOPE_AGENT); }
__device__ __forceinline__ unsigned xb_xcc_id() { return (unsigned)__builtin_amdgcn_s_getreg((3 << 11) | 20) & 0xFu; }
#define XB_SPIN(cond, bar) do { unsigned _sp = 0; while (cond) { __builtin_amdgcn_s_sleep(1); \
    if ((++_sp & 255u) == 0u) { if (xb_ld(&(bar)[XB_TMO])) break; if (_sp > XB_SPIN_CAP) { atomicAdd(&(bar)[XB_TMO], 1u); break; } } } } while (0)
struct XcdBarrier { unsigned* bar; unsigned x; };
__device__ __forceinline__ XcdBarrier xcd_barrier_post(unsigned* bar) {
    XcdBarrier b; b.bar = bar; b.x = xb_xcc_id();
    if (threadIdx.x == 0) (void)xb_add(&bar[XB_XCNT(b.x)], 1u);
    return b;
}
__device__ __forceinline__ void xcd_barrier_complete(unsigned* bar, unsigned x, unsigned& nloc, unsigned& nx) {
    const unsigned G = gridDim.x * gridDim.y * gridDim.z;
    unsigned sum, cnt, mine, sp = 0u;
    for (;;) {
        sum = 0u; cnt = 0u; mine = 0u;
#pragma unroll
        for (unsigned j = 0; j < 16; ++j) { const unsigned c = xb_ld(&bar[XB_XCNT(j)]); sum += c; cnt += (c > 0u) ? 1u : 0u; mine = (j == x) ? c : mine; }
        if (sum == G) break;
        __builtin_amdgcn_s_sleep(1);
        if ((++sp & 255u) == 0u) { if (xb_ld(&bar[XB_TMO])) break; if (sp > XB_SPIN_CAP) { atomicAdd(&bar[XB_TMO], 1u); break; } }
    }
    nloc = mine > 0u ? mine : 1u; nx = cnt > 0u ? cnt : 1u;
}
__device__ __forceinline__ void xcd_barrier(const XcdBarrier& b, unsigned& st  ) {
    asm volatile("s_waitcnt vmcnt(0)" ::: "memory");
    __syncthreads();
    unsigned stv = st;
    if (threadIdx.x == 0) {
        unsigned* bar = b.bar;
        __builtin_amdgcn_s_waitcnt(0);
        unsigned nloc = st & 0xffffu, nx = st >> 16;
        if (nloc == 0u) { xcd_barrier_complete(bar, b.x, nloc, nx); stv = nloc | (nx << 16); }
        const unsigned old = xb_add(&bar[XB_XSUB(b.x)], 1u);
        const unsigned gen = old / nloc;
        if (old + 1u == (gen + 1u) * nloc) {
            __builtin_amdgcn_fence(__ATOMIC_RELEASE, "agent");
            asm volatile("s_waitcnt vmcnt(0)" ::: "memory");
            const unsigned og = xb_add(&bar[XB_TOP], 1u);
            const unsigned tg = og / nx;
            if (og + 1u == (tg + 1u) * nx) xb_add(&bar[XB_TOPGEN], 1u);
            else XB_SPIN(xb_ld(&bar[XB_TOPGEN]) == tg, bar);
            __builtin_amdgcn_fence(__ATOMIC_ACQUIRE, "agent");
            xb_add(&bar[XB_XGEN(b.x)], 1u);
            asm volatile("s_waitcnt vmcnt(0)" ::: "memory");
        } else {
            XB_SPIN(xb_ld(&bar[XB_XGEN(b.x)]) == gen, bar);
            __builtin_amdgcn_fence(__ATOMIC_ACQUIRE, "agent");
            asm volatile("s_waitcnt vmcnt(0)" ::: "memory");
        }
    }
    st = __builtin_amdgcn_readfirstlane(stv);
    __syncthreads();
}

constexpr int LDS_BYTES = 147456;
constexpr int CW_BAR = 4096;
constexpr size_t CTL_ZERO_BYTES = 65536;
constexpr int NPHASE = 12;
struct Args { const float* in[22]; float* out; unsigned char* ws; int ph_lo, ph_hi; };

__global__ void __launch_bounds__(512, 2) mega(Args a) {
    extern __shared__ __attribute__((aligned(16))) unsigned char lds[];
    unsigned char* ws = a.ws; float* out = a.out;
    const float* x = a.in[0]; const float* mem = a.in[1]; const float* g_mix = a.in[2]; const float* w_in = a.in[3];
    const float* w_gla_gate = a.in[4]; const float* b_gla_gate = a.in[5]; const float* g_gla_head = a.in[6]; const float* w_out = a.in[7];
    const float* g_mem_q = a.in[8]; const float* g_mem_kv = a.in[9]; const float* w_mq = a.in[10]; const float* w_mk = a.in[11];
    const float* w_mv = a.in[12]; const float* w_mo = a.in[13]; const float* g_ffn = a.in[14]; const float* w_router = a.in[15];
    const float* b_router = a.in[16]; const float* w_gu = a.in[17]; const float* b_gu = a.in[18]; const float* w_down = a.in[19];
    const float* b_down = a.in[20]; const float* g_final = a.in[21];
    bf16_t* Wt_in = (bf16_t*)(ws + WS_WIN); bf16_t* Wt_out = (bf16_t*)(ws + WS_WOUT); bf16_t* Wq = (bf16_t*)(ws + WS_WQ); bf16_t* Wt_kv = (bf16_t*)(ws + WS_WKV);
    bf16_t* Wt_mo = (bf16_t*)(ws + WS_WMO); bf16_t* Wt_r = (bf16_t*)(ws + WS_WR); bf16_t* Wt_gu = (bf16_t*)(ws + WS_WGU); bf16_t* Wt_dn = (bf16_t*)(ws + WS_WDN);
    bf16_t* xn = (bf16_t*)(ws + WS_XN); bf16_t* memn = (bf16_t*)(ws + WS_MEMN); bf16_t* kv = (bf16_t*)(ws + WS_KV); bf16_t* Bs = (bf16_t*)(ws + WS_BS); bf16_t* Bo = (bf16_t*)(ws + WS_BO);
    bf16_t* proj = (bf16_t*)(ws + WS_PROJ); bf16_t* mix = (bf16_t*)(ws + WS_MIX);
    float* Sc = (float*)(ws + WS_S); bf16_t* P = (bf16_t*)(ws + WS_P); float* lg = (float*)(ws + WS_LG); int* toke = (int*)(ws + WS_TOKE); int* tokr = (int*)(ws + WS_TOKR);
    float* tokw = (float*)(ws + WS_TOKW); int* list = (int*)(ws + WS_LIST); unsigned char* ys = ws + WS_YS;
    unsigned char* Wq_gu = ws + WS_WGU; unsigned char* Wq_dn = ws + WS_WDN; unsigned char* x2q = ws + WS_S; unsigned char* act8 = ws + WS_ACT;
    float* lrs = (float*)(ws + WS_LG);
    float* UT = (float*)(ws + WS_S); float* decay = (float*)(ws + WS_LA); bf16_t* ST = (bf16_t*)(ws + WS_ORAW);
    unsigned* ctl = (unsigned*)(ws + WS_CTL); int* cnt = (int*)ctl + CW_CNT; float* ss1 = (float*)(ws + WS_LA + 8 * MiB); float* ss2 = (float*)(ws + WS_LA + 9 * MiB);

    const int G = gridDim.x, vb = blockIdx.x;
    XcdBarrier bar = xcd_barrier_post(ctl + CW_BAR); unsigned bar_st = 0u;
    const int ch_gw = __builtin_amdgcn_readfirstlane(vb * 8 + (int)(threadIdx.x >> 6)), ch_nW = G * 8;
    const int lo = a.ph_lo, hi = a.ph_hi;
    float* dmy = (float*)(ws + WS_DUMMY); (void)dmy;
#ifndef REPEAT_MASK
#define REPEAT_MASK 0
#endif
#define IN(k) (lo <= (k) && (k) < hi)
#define REP(k) for (int rep_ = 0; rep_ < 1 + ((REPEAT_MASK >> (k)) & 1); ++rep_)
#define SEAM(k) do { if (IN(k) && IN((k) + 1)) xcd_barrier(bar, bar_st); } while (0)
#define TIDS() int tid = threadIdx.x; LAUNDER(tid); const int lane = tid & 63; const int wid = __builtin_amdgcn_readfirstlane(tid >> 6); (void)lane; (void)wid

    if (IN(0)) REP(0) { TIDS(); const size_t gt = (size_t)vb * 512 + tid, gs = (size_t)G * 512;
        float* scr = (float*)(lds + wid * 8448);
        const int gw = vb * 8 + wid, ngw = G * 8;
        rms_body(gw, ngw, lane, x, xn, NTOK);
        rms_body(gw, ngw, lane, mem, memn, NB * MEML);
        conv_n_body(gt, gs, w_mq, Wq, g_mem_q, 1024, 1024, LOG2E / 16.0f);
        constexpr int I_IN = 16 * 97, I_SQ = 16 * 32, I_R = 16;
        constexpr int NITEMS = I_IN + 4 * I_SQ + I_R;
        for (int it = gw; it < NITEMS; it += ngw) { int r = it;
            if (r < I_IN) { conv_item<1>(scr, w_in, Wt_in, g_mix, 3088, 1024, 3088, r / 97, r % 97, lane); continue; } r -= I_IN;
            if (r < I_SQ) { conv_item<0>(scr, w_out, Wt_out, nullptr, 1024, 1024, 1024, r >> 5, r & 31, lane); continue; } r -= I_SQ;
            if (r < I_SQ) { conv_item<0>(scr, w_mk, Wt_kv, g_mem_kv, 1024, 1024, 1024, r >> 5, r & 31, lane); continue; } r -= I_SQ;
            if (r < I_SQ) { conv_item<0>(scr, w_mv, Wt_kv + (size_t)1024 * 1024, g_mem_kv, 1024, 1024, 1024, r >> 5, r & 31, lane); continue; } r -= I_SQ;
            if (r < I_SQ) { conv_item<0>(scr, w_mo, Wt_mo, nullptr, 1024, 1024, 1024, r >> 5, r & 31, lane); continue; } r -= I_SQ;
            { conv_item<0>(scr, w_router, Wt_r, g_ffn, 32, 1024, 32, r, 0, lane); } }
        __syncthreads(); }
    SEAM(0);
    if (IN(1)) REP(1) { DenseSched S{(const char*)xn, (const char*)Wt_in, 2048u, 2048u, 1024, 64, 12, 1 << 30, 0, G, vb}; EpiBf16 E{proj, PROJ_LD, 0}; gemm_run_host<true, 1>(lds, S, E, w_gu, ws, 0, 24576, ch_gw, ch_nW); }
    SEAM(1);
    if (IN(2)) REP(2) {
        for (int t = vb; t < 256; t += G) gla_pass_a(lds, t, xn, Wt_in + (size_t)3072 * 1024, proj, w_gla_gate, b_gla_gate, UT, decay);
        { TIDS(); for (int t = vb * 8 + wid; t < 4096; t += G * 8) sb_task(lds + wid * 4096, t, proj, mix, lane); }
        { TIDS(); for (int t = vb + G * wid; t < 1024; t += G * 8) memkv_task(t, lane, memn, Wt_kv, kv); } }
    SEAM(2);
    if (IN(3)) REP(3) {
        { TIDS(); for (int e = vb * 512 + tid; e < 65536; e += G * 512) gla_pass_b(e, UT, decay, ST); }
        { SchedWqk S{(const char*)kv, (const char*)Wq, 4096u, 2048u, 256, G / 2, vb - G / 2, 0}; EpiBf16 E{Bs, 1024, 0}; gemm_run<false>(lds, S, E); }
        { SchedVo S{(const char*)Wt_mo, (const char*)kv, 2048u, 4096u, 256, G / 2, vb - G / 2 - 32, 0}; EpiBf16 E{Bo, 1024, 0}; gemm_run<false>(lds, S, E); } }
    SEAM(3);
    if (IN(4)) REP(4) { TIDS(); for (int t = vb * 8 + wid; t < 2048; t += G * 8) gla_pass_c(lds + wid * 32 * GC_PITCH, t, ST, proj, g_gla_head, mix, lane); }
    SEAM(4);
#if PROBE_BARRIERS
    for (int pb_ = 0; pb_ < 8; ++pb_) xcd_barrier(bar, bar_st);
#endif
    if (IN(5)) REP(5) { DenseSched S{(const char*)mix, (const char*)Wt_out, 2048u, 2048u, 1024, 64, 4, 1 << 30, 0, G, vb}; EpiResidSS<false> E{x, rep_ ? (bf16_t*)dmy : xn, rep_ ? dmy + 16 * 1024 * 1024 : ss1, nullptr, nullptr}; gemm_run_host<false, 1>(lds, S, E, w_gu, ws, 24576, CH_GU_ITEMS, ch_gw, ch_nW); }
    SEAM(5);
    if (IN(6)) REP(6) { DenseSched S{(const char*)xn, (const char*)Bs, 2048u, 2048u, 1024, 64, 4, 32, (size_t)1024 * 2048, G, vb}; EpiSoftmax E{ss1, P}; gemm_run_host<false, 2>(lds, S, E, w_down, ws, CH_GU_ITEMS, CH_GU_ITEMS + 8192, ch_gw, ch_nW); }
    SEAM(6);
    if (IN(7)) REP(7) { DenseSched S{(const char*)P, (const char*)Bo, 2048u, 2048u, 1024, 64, 4, 32, (size_t)1024 * 2048, G, vb}; EpiResidSS<true> E{xn, rep_ ? (bf16_t*)dmy : xn, rep_ ? dmy + 16 * 1024 * 1024 : ss2, rep_ ? (unsigned char*)dmy + 40 * 1024 * 1024 : x2q, g_ffn}; gemm_run_host<false, 2>(lds, S, E, w_down, ws, CH_GU_ITEMS + 8192, CH_ITEMS, ch_gw, ch_nW); }
    SEAM(7);
    if (IN(8)) REP(8) { TIDS(); int* cntp = rep_ ? (int*)ctl + 2048 : cnt; int* listp = rep_ ? (int*)dmy + 1024 : list; float* lrsp = rep_ ? dmy + 4096 * 1024 : lrs; int* tokep = rep_ ? (int*)dmy + 1024 * 1024 : toke; int* tokrp = rep_ ? (int*)dmy + 2048 * 1024 : tokr; float* tokwp = rep_ ? dmy + 3072 * 1024 : tokw;
        int* lcnt = (int*)lds; int* gbase = (int*)lds + 32;
        for (int tb = vb; tb < NTOK / 64; tb += G) {
            if (tid < 32) lcnt[tid] = 0;
            __syncthreads();
            int oe[4] = {0, 0, 0, 0}; float ow[4] = {0.f, 0.f, 0.f, 0.f}; int lr[4] = {0, 0, 0, 0};
            if (wid < 2) { router_task(tb * 2 + wid, lane, xn, ss2, Wt_r, b_router, oe, ow);
                if (lane < 32) {
#pragma unroll
                    for (int k = 0; k < 4; ++k) lr[k] = atomicAdd(&lcnt[oe[k]], 1); } }
            __syncthreads();
            if (tid < 32) gbase[tid] = atomicAdd(&cntp[tid * 32], lcnt[tid]);
            __syncthreads();
            if (wid < 2 && lane < 32) { const int t = (tb * 2 + wid) * 32 + lane;
                const float rstd_t = row_rstd(ss2, t);
#pragma unroll
                for (int k = 0; k < 4; ++k) { const int r = gbase[oe[k]] + lr[k]; listp[oe[k] * NTOK + r] = t; lrsp[oe[k] * NTOK + r] = rstd_t; tokep[t * 4 + k] = oe[k]; tokrp[t * 4 + k] = r; tokwp[t * 4 + k] = ow[k]; } }
            __syncthreads(); } }
    SEAM(8);
    if (IN(9)) REP(9) { int* tab = (int*)(lds + 131072); { TIDS(); moe_build_table(tab, cnt, tid); }
        MoeSched<true> S{(const char*)x2q, (const char*)Wq_gu, 1024u, 1024u, 512, 8, (size_t)2048 * 1024, tab, list, 1, G, vb, 0}; EpiGU E{b_gu, act8, lrs}; gemm_run_fp8<true>(lds, S, E); }
    SEAM(9);
    if (IN(10)) REP(10) { int* tab = (int*)(lds + 131072); { TIDS(); moe_build_table(tab, cnt, tid); }
        MoeSched<false> S{(const char*)act8, (const char*)Wq_dn, 1024u, 1024u, 512, 4, (size_t)1024 * 1024, tab, list, 0, G, vb, 0}; EpiDown E{b_down, ys}; gemm_run_fp8<true>(lds, S, E); }
    SEAM(10);
    if (IN(11)) REP(11) { TIDS(); int* tab = (int*)(lds + 131072); moe_build_table(tab, cnt, tid);
        for (int t = vb * 8 + wid; t < NTOK; t += G * 8) combine_task(t, lane, xn, rep_ ? dmy : out, ys, tab, toke, tokr, tokw, g_final); }
#undef IN
#undef SEAM
#undef TIDS
}

#ifndef MK_PER_PHASE
#define MK_PER_PHASE 0
#endif
extern "C" void kernel_launch(void* const* d_in, const int* in_sizes, int n_in, void* d_out, int out_size, void* d_ws, size_t ws_size, hipStream_t stream) {
    static int grid = 0;
    if (grid == 0) {
        if (n_in != 22 || in_sizes[0] != NTOK * DM || out_size != NTOK * DM || ws_size < WS_END) { fprintf(stderr, "kernel_launch: unexpected shapes (n_in %d, ws %zu)\n", n_in, ws_size); grid = -1; return; }
        int dev = 0, cus = 0, per_cu = 0;
        if (hipGetDevice(&dev) != hipSuccess || hipDeviceGetAttribute(&cus, hipDeviceAttributeMultiprocessorCount, dev) != hipSuccess) { grid = -1; return; }
        if (hipFuncSetAttribute((const void*)mega, hipFuncAttributeMaxDynamicSharedMemorySize, LDS_BYTES) != hipSuccess) { fprintf(stderr, "kernel_launch: hipFuncSetAttribute failed\n"); grid = -1; return; }
        if (hipOccupancyMaxActiveBlocksPerMultiprocessor(&per_cu, (const void*)mega, 512, LDS_BYTES) != hipSuccess || per_cu < 1) fprintf(stderr, "kernel_launch: occupancy query says %d blocks/CU\n", per_cu);
        (void)hipGetLastError();
        grid = cus;
    }
    if (grid < 0) return;
    (void)hipMemsetAsync((char*)d_ws + WS_CTL, 0, CTL_ZERO_BYTES, stream);
    Args a{};
    for (int i = 0; i < 22; ++i) a.in[i] = (const float*)d_in[i];
    a.out = (float*)d_out; a.ws = (unsigned char*)d_ws;
#if MK_PER_PHASE
    for (int p = 0; p < NPHASE; ++p) { a.ph_lo = p; a.ph_hi = p + 1; hipLaunchKernelGGL(mega, dim3(grid), dim3(512), LDS_BYTES, stream, a); }
#else
    a.ph_lo = 0; a.ph_hi = NPHASE; hipLaunchKernelGGL(mega, dim3(grid), dim3(512), LDS_BYTES, stream, a);
#endif
}
```

```cpp
#include <hip/hip_runtime.h>
#include <cstdio>
#include <cstdint>
#ifndef PROBE_BARRIERS
#define PROBE_BARRIERS 0
#endif

typedef unsigned short bf16_t;
typedef short bf16x8 __attribute__((ext_vector_type(8)));
typedef float f32x4 __attribute__((ext_vector_type(4)));
typedef unsigned u32x4 __attribute__((ext_vector_type(4)));
typedef unsigned u32x2 __attribute__((ext_vector_type(2)));
typedef float f32x2 __attribute__((ext_vector_type(2)));
#define LDSP __attribute__((address_space(3)))
#define LAUNDER(x) asm volatile("" : "+v"(x))

constexpr int NB = 2, SEQ = 8192, NTOK = NB * SEQ, DM = 1024, MEML = 256;
constexpr int NEXP = 32, TOPK = 4, NASSIGN = NTOK * TOPK;
constexpr int PROJ_LD = 3072;
constexpr int C_QG = 0, C_KG = 256, C_VG = 512, C_RG = 1024, C_QS = 1536, C_KS = 2048, C_VS = 2560, C_GLR = 3072;
constexpr float LOG2E = 1.4426950408889634f;
constexpr float EPS = 1e-5f;

__device__ __forceinline__ unsigned f2bf(float f) { unsigned u = __float_as_uint(f); return (u + 0x7fffu + ((u >> 16) & 1u)) >> 16; }
__device__ __forceinline__ unsigned pk2(float lo, float hi) { return f2bf(lo) | (f2bf(hi) << 16); }
__device__ __forceinline__ float bf2f(bf16_t h) { return __uint_as_float(((unsigned)h) << 16); }
__device__ __forceinline__ float bflo(unsigned w) { return __uint_as_float(w << 16); }
__device__ __forceinline__ float bfhi(unsigned w) { return __uint_as_float(w & 0xffff0000u); }

constexpr size_t MiB = 1u << 20;
constexpr size_t WS_CTL = 0;
constexpr size_t WS_WIN = 1 * MiB;
constexpr size_t WS_WOUT = 8 * MiB;
constexpr size_t WS_WQ = 10 * MiB;
constexpr size_t WS_WKV = 12 * MiB;
constexpr size_t WS_WMO = 16 * MiB;
constexpr size_t WS_WR = 18 * MiB;
constexpr size_t WS_WGU = 20 * MiB;
constexpr size_t WS_WDN = 148 * MiB;
constexpr size_t WS_XN = 212 * MiB;
constexpr size_t WS_MEMN = 244 * MiB;
constexpr size_t WS_KV = 245 * MiB;
constexpr size_t WS_BS = 247 * MiB;
constexpr size_t WS_BO = 251 * MiB;
constexpr size_t WS_PROJ = 256 * MiB;
constexpr size_t WS_LA = 360 * MiB;
constexpr size_t WS_ORAW = 376 * MiB;
constexpr size_t WS_MIX = 408 * MiB;
constexpr size_t WS_S = 440 * MiB;
constexpr size_t WS_P = 504 * MiB;
constexpr size_t WS_LG = 536 * MiB;
constexpr size_t WS_TOKE = 538 * MiB;
constexpr size_t WS_TOKR = 539 * MiB;
constexpr size_t WS_TOKW = 540 * MiB;
constexpr size_t WS_LIST = 541 * MiB;
constexpr size_t WS_ACT = 544 * MiB;
constexpr size_t WS_YS = 674 * MiB;
constexpr size_t WS_DUMMY = 804 * MiB;
constexpr size_t WS_END = 872 * MiB;
constexpr int CW_CNT = 1024;

template <int MAP> __device__ __forceinline__ int srccol(int n, float& sc) {
    sc = 1.f;
    if (MAP == 0) return n;
    if (MAP == 1) {
        if (n < 256) { sc = 0.125f; return n; }
        if (n < 1024) return n;
        if (n < 3072) { if (n >= C_QS && n < C_KS) sc = 0.125f * LOG2E; return n + 16; }
        if (n < 3088) return 1024 + (n - 3072);
        return -1;
    }
    { const int ct = n >> 8, w = n & 255; return (w < 128) ? (128 * ct + w) : (1024 + 128 * ct + (w - 128)); }
}
template <int MAP>
__device__ __forceinline__ void conv_item(float* scr, const float* __restrict__ src, bf16_t* __restrict__ dst, const float* __restrict__ gain, int ldsrc, int K, int nrows, int kb, int nb, int lane) {
    const int k0 = kb * 64, n0 = nb * 32; float sc; const int c0 = srccol<MAP>(n0, sc);
    const int half = lane >> 5, l31 = lane & 31;
    const float* s0 = src + (size_t)(k0 + half) * ldsrc + c0 + l31;
    float v[32];
#pragma unroll
    for (int i = 0; i < 32; ++i) v[i] = __builtin_nontemporal_load(s0 + (size_t)(2 * i) * ldsrc);
#pragma unroll
    for (int i = 0; i < 32; ++i) { const int kk = 2 * i + half; const float g = (gain ? gain[k0 + kk] : 1.f) * sc; scr[kk * 33 + l31] = v[i] * g; }
    asm volatile("s_waitcnt lgkmcnt(0)" ::: "memory");
    const int c = lane & 7;
#pragma unroll
    for (int j = 0; j < 4; ++j) { const int n = (lane >> 3) + 8 * j; const float* s = scr + (8 * c) * 33 + n;
        u32x4 o; o.x = pk2(s[0 * 33], s[1 * 33]); o.y = pk2(s[2 * 33], s[3 * 33]); o.z = pk2(s[4 * 33], s[5 * 33]); o.w = pk2(s[6 * 33], s[7 * 33]);
        if (n0 + n < nrows) *(u32x4*)(dst + (size_t)(n0 + n) * K + k0 + 8 * c) = o; }
    asm volatile("s_waitcnt lgkmcnt(0)" ::: "memory");
}
__device__ __forceinline__ unsigned pk4_fp8(float a, float b, float c, float d) { int w = __builtin_amdgcn_cvt_pk_fp8_f32(a, b, 0, false); w = __builtin_amdgcn_cvt_pk_fp8_f32(c, d, w, true); return (unsigned)w; }
template <int MAP>
__device__ __forceinline__ void conv_item8(float* scr, const float* __restrict__ src, unsigned char* __restrict__ dst, const float* __restrict__ gain, int ldsrc, int K, int nrows, int kb, int nb, int lane, float mul) {
    const int k0 = kb * 64, n0 = nb * 32; float sc; const int c0 = srccol<MAP>(n0, sc); sc *= mul;
    const int half = lane >> 5, l31 = lane & 31;
    const float* s0 = src + (size_t)(k0 + half) * ldsrc + c0 + l31;
    float v[32];
#pragma unroll
    for (int i = 0; i < 32; ++i) v[i] = __builtin_nontemporal_load(s0 + (size_t)(2 * i) * ldsrc);
#pragma unroll
    for (int i = 0; i < 32; ++i) { const int kk = 2 * i + half; const float g = (gain ? gain[k0 + kk] : 1.f) * sc; scr[kk * 33 + l31] = v[i] * g; }
    asm volatile("s_waitcnt lgkmcnt(0)" ::: "memory");
    const int c = lane & 3;
#pragma unroll
    for (int j = 0; j < 2; ++j) { const int n = (lane >> 2) + 16 * j; const float* s = scr + (16 * c) * 33 + n;
        u32x4 o; o.x = pk4_fp8(s[0 * 33], s[1 * 33], s[2 * 33], s[3 * 33]); o.y = pk4_fp8(s[4 * 33], s[5 * 33], s[6 * 33], s[7 * 33]);
        o.z = pk4_fp8(s[8 * 33], s[9 * 33], s[10 * 33], s[11 * 33]); o.w = pk4_fp8(s[12 * 33], s[13 * 33], s[14 * 33], s[15 * 33]);
        if (n0 + n < nrows) __builtin_nontemporal_store(o, (u32x4*)(dst + (size_t)(n0 + n) * K + k0 + 16 * c)); }
    asm volatile("s_waitcnt lgkmcnt(0)" ::: "memory");
}
__device__ __forceinline__ void conv_n_body(size_t gtid, size_t gsz, const float* __restrict__ src, bf16_t* __restrict__ dst, const float* __restrict__ gain, int K, int nrows, float sc) {
    const int kc8 = K / 8; const size_t total = (size_t)nrows * kc8;
    for (size_t idx = gtid; idx < total; idx += gsz) {
        const int kc = (int)(idx % kc8), n = (int)(idx / kc8);
        const float g = gain[n] * sc; const f32x4 a = __builtin_nontemporal_load((const f32x4*)(src + (size_t)n * K + kc * 8)), b = __builtin_nontemporal_load((const f32x4*)(src + (size_t)n * K + kc * 8 + 4));
        u32x4 o; o.x = pk2(a.x * g, a.y * g); o.y = pk2(a.z * g, a.w * g); o.z = pk2(b.x * g, b.y * g); o.w = pk2(b.z * g, b.w * g);
        *(u32x4*)(dst + (size_t)n * K + kc * 8) = o;
    }
}

__device__ __forceinline__ float wave_sum(float v) {
#pragma unroll
    for (int o = 1; o < 64; o <<= 1) v += __shfl_xor(v, o);
    return v;
}
__device__ __forceinline__ void rms_body(int gw, int ngw, int lane, const float* __restrict__ x, bf16_t* __restrict__ out, int nrows) {
    for (int row = gw; row < nrows; row += ngw) {
        const f32x4* xr = (const f32x4*)(x + (size_t)row * DM) + lane; f32x4 v[4]; float s = 0.f;
#pragma unroll
        for (int j = 0; j < 4; ++j) { v[j] = __builtin_nontemporal_load(xr + 64 * j); s += v[j].x * v[j].x + v[j].y * v[j].y + v[j].z * v[j].z + v[j].w * v[j].w; }
        const float rstd = 1.0f / sqrtf(wave_sum(s) * (1.f / DM) + EPS);
        u32x2* o = (u32x2*)(out + (size_t)row * DM) + lane;
#pragma unroll
        for (int j = 0; j < 4; ++j) { u32x2 w; w.x = pk2(v[j].x * rstd, v[j].y * rstd); w.y = pk2(v[j].z * rstd, v[j].w * rstd); o[64 * j] = w; }
    }
}

constexpr int CH_GU_ITEMS = 32 * 32 * 32;
constexpr int CH_ITEMS = CH_GU_ITEMS + 32 * 16 * 32;
constexpr int CH_LDS = 131072;
typedef unsigned v2u __attribute__((ext_vector_type(2)));
typedef unsigned v4u __attribute__((ext_vector_type(4)));
struct ConvHost { const float* src; unsigned char* ws; int it0, nW, hi, q; };
template <bool GU> __device__ __forceinline__ void ch_decode(int it, unsigned& soff, unsigned& doff) {
    if (GU) { const unsigned e = (unsigned)it >> 10, nb = ((unsigned)it >> 5) & 31u, k32 = (unsigned)it & 31u;
        soff = (e << 23) | (k32 << 18) | ((nb & 2u) << 11) | ((nb >> 2) << 9) | ((nb & 1u) << 8);
        doff = (unsigned)WS_WGU + (e << 21) + (nb << 16) + (k32 << 5); }
    else { const unsigned t = (unsigned)(it - CH_GU_ITEMS), e = t >> 9, nb = (t >> 5) & 15u, k32 = t & 31u;
        soff = (e << 22) | (k32 << 17) | (nb << 8);
        doff = (unsigned)WS_WDN + (e << 20) + (nb << 16) + (k32 << 5); }
}
template <bool GU> __device__ __forceinline__ void ch_issue(ConvHost& H, f32x2 (&cv)[8], unsigned voffL) {
    constexpr unsigned LD4 = GU ? 8192u : 4096u;
    const int q = __builtin_amdgcn_readfirstlane(H.q); const int it = H.it0 + H.nW * (q >> 1), itc = it < H.hi ? it : H.hi - 1;
    unsigned soff, doff; ch_decode<GU>(itc, soff, doff); soff += (unsigned)(q & 1) * 16u * LD4;
    const __amdgpu_buffer_rsrc_t r = __builtin_amdgcn_make_buffer_rsrc((void*)H.src, 0, 0x7fffffff, 0x00020000);
#pragma unroll
    for (int i = 0; i < 8; ++i) cv[i] = __builtin_bit_cast(f32x2, __builtin_amdgcn_raw_buffer_load_b64(r, (int)voffL, (int)(soff + (unsigned)((i >> 2) * 8 + (i & 3)) * LD4), 2));
    H.q = q + 1;
}
template <bool GU> __device__ __forceinline__ void ch_finish(const ConvHost& H, int qf, const f32x2 (&cv)[8], LDSP unsigned char* tile, int lane) {
    constexpr float SC = (float)(1 << 6);
    const int hb = qf & 1, itf = H.it0 + H.nW * (qf >> 1);
#pragma unroll
    for (int s = 0; s < 2; ++s) { v2u o; o.x = pk4_fp8(cv[4 * s].x * SC, cv[4 * s + 1].x * SC, cv[4 * s + 2].x * SC, cv[4 * s + 3].x * SC); o.y = pk4_fp8(cv[4 * s].y * SC, cv[4 * s + 1].y * SC, cv[4 * s + 2].y * SC, cv[4 * s + 3].y * SC);
        *(LDSP v2u*)(tile + (unsigned)((2 * (2 * hb + s) + (lane >> 5)) * 64 + 2 * (lane & 31)) * 4u) = o; }
    if (qf >= 0 && hb == 1 && itf < H.hi) {
        unsigned soff, doff; ch_decode<GU>(itf, soff, doff);
        const int r = lane >> 1, c = lane & 1; const LDSP unsigned* tw = (const LDSP unsigned*)tile + (4 * c) * 64 + r;
        v4u a, b; a.x = tw[0]; a.y = tw[64]; a.z = tw[128]; a.w = tw[192]; b.x = tw[32]; b.y = tw[96]; b.z = tw[160]; b.w = tw[224];
        const __amdgpu_buffer_rsrc_t w = __builtin_amdgcn_make_buffer_rsrc((void*)H.ws, 0, 0x7fffffff, 0x00020000);
        const unsigned voffS = (unsigned)r * 1024u + (unsigned)c * 16u;
        __builtin_amdgcn_raw_buffer_store_b128(a, w, (int)voffS, (int)doff, 0);
        __builtin_amdgcn_raw_buffer_store_b128(b, w, (int)voffS, (int)(doff + 32768u), 0); }
}

struct GUnit { unsigned ao, bo; int row0, col0, e, valid, aux; };

__host__ __device__ __forceinline__ int lds_byte(int r, int c) { const int st = (r >> 4) * 2 + (c >> 5), rr = r & 15, cc = c & 31, ob = rr * 64 + cc * 2; return st * 1024 + (ob ^ (((ob >> 9) & 1) << 5)); }
__host__ __device__ __forceinline__ void stage_rc(int b, int& R, int& C) { const int st = b / 1024, sb = b % 1024, swz = sb ^ (((sb >> 9) & 1) << 5); R = (st >> 1) * 16 + swz / 64; C = (st & 1) * 32 + (swz % 64) / 2; }
__host__ __device__ __forceinline__ int perm32(int rho) { const int n = rho >> 4, i = rho & 15; return 8 * (i >> 2) + 4 * n + (i & 3); }
constexpr int HTB = 128 * 64 * 2;
typedef int v8i __attribute__((ext_vector_type(8)));
typedef int v4i __attribute__((ext_vector_type(4)));
struct Frag2 { bf16x8 h[2]; };
template <bool F> struct FragT { typedef Frag2 T; };
template <> struct FragT<true> { typedef v8i T; };
template <class Sched, class Epi, bool ALIGN_EPI, bool FP8 = false, int SCALE_B = 0x7f, int HOSTM = 0>
__device__ __forceinline__ void gemm_phase(unsigned char* lds_flat, const Sched& S, const Epi& E, ConvHost& H) {
    LDSP unsigned char* lds = (LDSP unsigned char*)(unsigned)(uintptr_t)lds_flat;
    int tid = threadIdx.x; LAUNDER(tid);
    const int wid = __builtin_amdgcn_readfirstlane(tid >> 6), lane = tid & 63, wr = wid >> 2, wc = wid & 3, fr = lane & 15, fq = lane >> 4;
    const int nt = S.K / 64;
    int Rr[2], Cc[2];
#pragma unroll
    for (int i = 0; i < 2; ++i) stage_rc(tid * 16 + i * 8192, Rr[i], Cc[i]);
    unsigned voffB[2][2];
#pragma unroll
    for (int h = 0; h < 2; ++h)
#pragma unroll
        for (int i = 0; i < 2; ++i) voffB[h][i] = (unsigned)(128 * h + (Rr[i] & ~31) + perm32(Rr[i] & 31)) * S.ldb + (unsigned)Cc[i] * 2u;
    const unsigned ldsw = (unsigned)wid * 1024u;
    constexpr bool HOST = HOSTM != 0, HGU = HOSTM == 1;
    const int aoff = lds_byte(wr * 64 + fr, fq * 8), boff = lds_byte(wc * 32 + fr, fq * 8);
    constexpr int KSUB = 1024;
#define PG8_SA(b, h) (((b) * 2 + (h)) * HTB)
#define PG8_SB(b, h) ((4 + (b) * 2 + (h)) * HTB)
#define PG8_STAGE(bufoff, rsrc, voff, soff) do { _Pragma("unroll") for (int _i = 0; _i < 2; ++_i) \
        __builtin_amdgcn_raw_ptr_buffer_load_lds(rsrc, (LDSP unsigned*)(lds + (bufoff) + ldsw + _i * 8192), 16, (int)(voff)[_i], (int)(soff), 0, 0); } while (0)
#define PG8_LDF(dst, addr) do { const bf16x8 lo_ = *(const LDSP bf16x8*)(addr); const bf16x8 hi_ = *(const LDSP bf16x8*)((addr) + KSUB); \
        if constexpr (FP8) dst = __builtin_shufflevector(__builtin_bit_cast(v4i, lo_), __builtin_bit_cast(v4i, hi_), 0, 1, 2, 3, 4, 5, 6, 7); else { dst.h[0] = lo_; dst.h[1] = hi_; } } while (0)
#define PG8_LDA(dst, b, h) do { _Pragma("unroll") for (int m = 0; m < 4; ++m) PG8_LDF(dst[m], lds + PG8_SA(b, h) + aoff + m * 2048); } while (0)
#define PG8_LDB(dst, b, h) do { _Pragma("unroll") for (int n = 0; n < 2; ++n) PG8_LDF(dst[n], lds + PG8_SB(b, h) + boff + n * 2048); } while (0)
#define PG8_MMA(ai, bj, At, Bt) do { __builtin_amdgcn_s_setprio(1); _Pragma("unroll") for (int m = 0; m < 4; ++m) _Pragma("unroll") for (int n = 0; n < 2; ++n) { \
        if constexpr (FP8) asm volatile("v_mfma_scale_f32_16x16x128_f8f6f4 %0, %1, %2, %0, %3, %4 op_sel_hi:[0,0,0]" : "+v"(acc[ai][bj][m][n]) : "v"(Bt[n]), "v"(At[m]), "v"(sclB), "v"(sclA)); \
        else { _Pragma("unroll") for (int k = 0; k < 2; ++k) acc[ai][bj][m][n] = __builtin_amdgcn_mfma_f32_16x16x32_bf16(Bt[n].h[k], At[m].h[k], acc[ai][bj][m][n], 0, 0, 0); } } \
        __builtin_amdgcn_s_setprio(0); } while (0)
#define PG8_MMA_M(ai, bj, m, At, Bt) do { _Pragma("unroll") for (int n = 0; n < 2; ++n) _Pragma("unroll") for (int k = 0; k < 2; ++k) \
        acc[ai][bj][m][n] = __builtin_amdgcn_mfma_f32_16x16x32_bf16(Bt[n].h[k], At[m].h[k], acc[ai][bj][m][n], 0, 0, 0); } while (0)
#define PG8_MMA_H(cv) do { if constexpr (!FP8) { PG8_MMA(0, 0, At, B0); PG8_MMA(0, 1, At, B1); PG8_SCHED; \
        { CH_LANE(); ch_finish<HGU>(H, __builtin_amdgcn_readfirstlane(H.q) - 1, cv, ctile, cl_); } PG8_SCHED; ch_issue<HGU>(H, cv, voffL); PG8_SCHED; } } while (0)
#define CH_LANE() int cl_ = threadIdx.x; LAUNDER(cl_); cl_ &= 63
#define PG8_WAIT_V(n) asm volatile("s_waitcnt vmcnt(" #n ")" ::: "memory")
#define PG8_WAIT_L(n) asm volatile("s_waitcnt lgkmcnt(" #n ")" ::: "memory")
#define PG8_BAR __builtin_amdgcn_s_barrier()
#define PG8_SCHED __builtin_amdgcn_sched_barrier(0)
    GUnit cur, nxt; int ui = 0;
    f32x2 cvx[8]; unsigned voffL = 0; (void)voffL; LDSP unsigned char* const ctile = lds + CH_LDS + wid * 2048; (void)ctile;
    if constexpr (HOST) { voffL = (unsigned)(lane >> 5) * 4u * (HGU ? 8192u : 4096u) + (unsigned)(lane & 31) * 8u;
#pragma unroll
        for (int i = 0; i < 8; ++i) cvx[i] = (f32x2){0.f, 0.f}; }
    if (S.next(0, cur)) {
    const __amdgpu_buffer_rsrc_t rA = __builtin_amdgcn_make_buffer_rsrc((void*)S.A, 0, 0x7fffffff, 0x00020000);
    const __amdgpu_buffer_rsrc_t rB = __builtin_amdgcn_make_buffer_rsrc((void*)S.Bt, 0, 0x7fffffff, 0x00020000);
    unsigned oc[2][2], on[2][2];
#pragma unroll
    for (int h = 0; h < 2; ++h)
#pragma unroll
        for (int i = 0; i < 2; ++i) oc[h][i] = S.a_off(cur, 128 * h + Rr[i]) + (unsigned)Cc[i] * 2u;
    f32x4 acc[2][2][4][2];
#pragma unroll
    for (int a = 0; a < 2; ++a)
#pragma unroll
        for (int b = 0; b < 2; ++b)
#pragma unroll
            for (int m = 0; m < 4; ++m)
#pragma unroll
                for (int n = 0; n < 2; ++n) acc[a][b][m][n] = (f32x4){0.f, 0.f, 0.f, 0.f};
    typedef typename FragT<FP8>::T frag_t;
    frag_t At[4], B0[2], B1[2];
    const unsigned kstep = 128;
    const int sclB = SCALE_B * 0x01010101, sclA = 0x7f7f7f7f; (void)sclA; (void)sclB;
    PG8_STAGE(PG8_SB(0, 0), rB, voffB[0], cur.bo); PG8_STAGE(PG8_SB(0, 1), rB, voffB[1], cur.bo); PG8_STAGE(PG8_SA(0, 0), rA, oc[0], cur.ao); PG8_STAGE(PG8_SA(0, 1), rA, oc[1], cur.ao);
    if (wr == 1) PG8_BAR;
    PG8_WAIT_V(2); PG8_BAR;
    PG8_STAGE(PG8_SB(1, 0), rB, voffB[0], cur.bo + kstep); PG8_STAGE(PG8_SA(1, 0), rA, oc[0], cur.ao + kstep); PG8_STAGE(PG8_SB(1, 1), rB, voffB[1], cur.bo + kstep);
    PG8_WAIT_V(6); PG8_BAR;
    for (;;) {
        const bool has_next = S.next(ui + 1, nxt);
        if (!has_next) nxt = cur;
        const unsigned nA = nxt.ao, nB = nxt.bo;
        { int t2 = threadIdx.x; LAUNDER(t2);
#pragma unroll
          for (int i = 0; i < 2; ++i) { int R_, C_; stage_rc(t2 * 16 + i * 8192, R_, C_);
#pragma unroll
              for (int h = 0; h < 2; ++h) on[h][i] = S.a_off(nxt, 128 * h + R_) + (unsigned)C_ * 2u; } }
        for (int t = 0; t < nt; t += 2) {
            const bool last = (t == nt - 2);
            const unsigned k1 = cur.ao + (unsigned)(t + 1) * kstep;
            const unsigned a2 = last ? nA : cur.ao + (unsigned)(t + 2) * kstep, b2 = last ? nB : cur.bo + (unsigned)(t + 2) * kstep, a3 = a2 + kstep, b3 = b2 + kstep;
            unsigned o2[2][2];
#pragma unroll
            for (int h = 0; h < 2; ++h)
#pragma unroll
                for (int i = 0; i < 2; ++i) o2[h][i] = last ? on[h][i] : oc[h][i];
            PG8_LDB(B0, 0, 0); PG8_LDB(B1, 0, 1); PG8_SCHED; PG8_LDA(At, 0, 0); PG8_STAGE(PG8_SA(1, 1), rA, oc[1], k1);
            PG8_WAIT_V(8); PG8_WAIT_L(0); PG8_BAR;
            bool cst = false; (void)cst;
            if constexpr (HOST) { const int q_ = __builtin_amdgcn_readfirstlane(H.q); cst = q_ >= 2 && !(q_ & 1) && H.it0 + H.nW * ((q_ - 1) >> 1) < H.hi; PG8_MMA_H(cvx); } else { PG8_MMA(0, 0, At, B0); PG8_MMA(0, 1, At, B1); }
            PG8_BAR; PG8_SCHED;
            PG8_LDA(At, 0, 1); PG8_STAGE(PG8_SB(0, 0), rB, voffB[0], b2); PG8_STAGE(PG8_SB(0, 1), rB, voffB[1], b2); PG8_STAGE(PG8_SA(0, 0), rA, o2[0], a2);
            if constexpr (HOST) { if (cst) PG8_WAIT_V(18); else PG8_WAIT_V(16); } else PG8_WAIT_V(8);
            PG8_WAIT_L(0); PG8_BAR; PG8_MMA(1, 0, At, B0); PG8_MMA(1, 1, At, B1); PG8_BAR; PG8_SCHED;
            PG8_LDB(B0, 1, 0); PG8_LDB(B1, 1, 1); PG8_SCHED; PG8_LDA(At, 1, 0); PG8_STAGE(PG8_SA(0, 1), rA, o2[1], a2);
            if constexpr (HOST) { if (cst) PG8_WAIT_V(18); else PG8_WAIT_V(16); } else PG8_WAIT_V(8);
            PG8_WAIT_L(0); PG8_BAR; PG8_MMA(0, 0, At, B0); PG8_MMA(0, 1, At, B1); PG8_BAR; PG8_SCHED;
            PG8_LDA(At, 1, 1); PG8_STAGE(PG8_SB(1, 0), rB, voffB[0], b3); PG8_STAGE(PG8_SB(1, 1), rB, voffB[1], b3); PG8_STAGE(PG8_SA(1, 0), rA, o2[0], a3);
            PG8_WAIT_V(8);
            PG8_WAIT_L(0); PG8_BAR; PG8_MMA(1, 0, At, B0); PG8_MMA(1, 1, At, B1); PG8_BAR; PG8_SCHED;
        }
        if constexpr (FP8) asm volatile("s_nop 15\n\ts_nop 15" ::: "memory");
        if constexpr (ALIGN_EPI) { if (wr == 0) PG8_BAR; }
        if constexpr (!Epi::AFTER_DRAIN) E(acc, cur, wr, wc, fr, fq);
        if (!has_next) break;
#pragma unroll
        for (int a = 0; a < 2; ++a)
#pragma unroll
            for (int b = 0; b < 2; ++b)
#pragma unroll
                for (int m = 0; m < 4; ++m)
#pragma unroll
                    for (int n = 0; n < 2; ++n) acc[a][b][m][n] = (f32x4){0.f, 0.f, 0.f, 0.f};
        cur = nxt; ++ui;
#pragma unroll
        for (int h = 0; h < 2; ++h)
#pragma unroll
            for (int i = 0; i < 2; ++i) oc[h][i] = on[h][i];
        if constexpr (ALIGN_EPI) { if (wr == 1) PG8_BAR; }
    }
    PG8_WAIT_V(0);
    if constexpr (HOST) { CH_LANE(); const int q_ = __builtin_amdgcn_readfirstlane(H.q); if (q_ >= 1) ch_finish<HGU>(H, q_ - 1, cvx, ctile, cl_); }
    if constexpr (!ALIGN_EPI) { if (wr == 0) PG8_BAR; }
    PG8_BAR;
    if constexpr (Epi::AFTER_DRAIN) E.fused(acc, cur, wr, wc, fr, fq, lds_flat, wid, lane);
    }
    if constexpr (HOST) {
        CH_LANE(); H.q = (__builtin_amdgcn_readfirstlane(H.q) + 1) & ~1;
        while (H.it0 + H.nW * (__builtin_amdgcn_readfirstlane(H.q) >> 1) < H.hi) { const int q_ = __builtin_amdgcn_readfirstlane(H.q); ch_issue<HGU>(H, cvx, voffL); ch_finish<HGU>(H, q_, cvx, ctile, cl_); } }
#undef PG8_SA
#undef PG8_SB
#undef PG8_STAGE
#undef PG8_LDA
#undef PG8_LDF
#undef PG8_LDB
#undef PG8_MMA
#undef PG8_WAIT_V
#undef PG8_WAIT_L
#undef PG8_BAR
#undef PG8_SCHED
#undef PG8_MMA_M
#undef PG8_MMA_H
#undef CH_LANE
}
template <bool ALIGN, class Sched, class Epi> __device__ __forceinline__ void gemm_run(unsigned char* lds, const Sched& S, const Epi& E) {
    ConvHost none{}; gemm_phase<Sched, Epi, ALIGN>(lds, S, E, none);
}
template <bool ALIGN, int HOSTM, class Sched, class Epi> __device__ __forceinline__ void gemm_run_host(unsigned char* lds, const Sched& S, const Epi& E, const float* src, unsigned char* ws, int lo, int hi, int gw, int nW) {
    ConvHost H{src, ws, lo + gw, nW, hi, 0}; gemm_phase<Sched, Epi, ALIGN, false, 0x7f, HOSTM>(lds, S, E, H);
}
constexpr int WSCALE_LOG2 = 6;
template <bool ALIGN, class Sched, class Epi> __device__ __forceinline__ void gemm_run_fp8(unsigned char* lds, const Sched& S, const Epi& E) {
    ConvHost none{}; gemm_phase<Sched, Epi, ALIGN, true, 127 - WSCALE_LOG2>(lds, S, E, none);
}

struct DenseSched {
    const char* A; const char* Bt; unsigned lda, ldb; int K; int nM, nN; int pm_per_b; size_t zB; int G, c;
    __device__ __forceinline__ bool next(int i, GUnit& u) const {
        int pm, pn;
        if (G == 256 && (nN & 3) == 0 && nM * nN >= 256) {
            const int j = c & 7, q = c >> 3, s = i * 8 + j, ncg = nN >> 2; pm = (s / ncg) * 8 + (q >> 2); pn = (s % ncg) * 4 + (q & 3); if (c < 0 || pm >= nM) return false; }
        else { const long L = (long)i * G + c; if (c < 0 || L >= (long)nM * nN) return false; pm = (int)(L / nN); pn = (int)(L % nN); }
        u.ao = (unsigned)pm * 256u * lda; u.bo = (unsigned)((size_t)(pm / pm_per_b) * zB) + (unsigned)pn * 256u * ldb; u.row0 = pm * 256; u.col0 = pn * 256; u.e = 0; u.valid = 256; u.aux = 0; return true;
    }
    __device__ __forceinline__ unsigned a_off(const GUnit&, int r) const { return (unsigned)r * lda; }
};
struct SchedWqk {
    const char* A; const char* Bt; unsigned lda, ldb; int K; int G, c, pad;
    __device__ __forceinline__ bool next(int i, GUnit& u) const {
        const int L = i * G + c; if (c < 0 || L >= 32) return false; const int z = L >> 2, pn = L & 3, b = z >> 2, h = z & 3;
        u.ao = (unsigned)b * 256u * 4096u + h * 512u; u.bo = (unsigned)pn * 256u * 2048u + h * 512u; u.row0 = z * 256; u.col0 = pn * 256; u.e = 0; u.valid = 256; u.aux = 0; return true;
    }
    __device__ __forceinline__ unsigned a_off(const GUnit&, int r) const { return (unsigned)r * lda; }
};
struct SchedVo {
    const char* A; const char* Bt; unsigned lda, ldb; int K; int G, c, pad;
    __device__ __forceinline__ bool next(int i, GUnit& u) const {
        const int L = i * G + c; if (c < 0 || L >= 32) return false; const int z = L >> 2, pm = L & 3, b = z >> 2, h = z & 3;
        u.ao = (unsigned)pm * 256u * 2048u + h * 512u; u.bo = (unsigned)b * 256u * 4096u + 2048u + h * 512u; u.row0 = b * 1024 + pm * 256; u.col0 = h * 256; u.e = 0; u.valid = 256; u.aux = 0; return true;
    }
    __device__ __forceinline__ unsigned a_off(const GUnit&, int r) const { return (unsigned)r * lda; }
};
template <bool GATHER> struct MoeSched {
    const char* A; const char* Bt; unsigned lda, ldb; int K; int nN; size_t zB;
    const int* tab; const int* list; int gather; int G, c, pad;
    __device__ __forceinline__ bool next(int i, GUnit& u) const {
        int T, pn;
        if (G == 256) { const int j = c & 7, q = c >> 3, s = i * 8 + j;
            if (nN == 8) { T = 4 * s + (q >> 3); pn = q & 7; } else { T = 8 * s + (q >> 2); pn = q & 3; } }
        else { const int L = i * G + c; T = L / nN; pn = L % nN; }
        if (T >= __builtin_amdgcn_readfirstlane(tab[64])) return false;
        const int w = __builtin_amdgcn_readfirstlane(tab[128 + T]); const int e = w & 255, rt = w >> 8; const int ce = __builtin_amdgcn_readfirstlane(tab[e]), start = __builtin_amdgcn_readfirstlane(tab[32 + e]);
        u.e = e; u.valid = min(256, ce - rt * 256); u.row0 = start + rt * 256; u.col0 = pn * 256; u.aux = rt * 256;
        u.ao = GATHER ? 0u : (unsigned)u.row0 * lda; u.bo = (unsigned)((size_t)e * zB) + (unsigned)pn * 256u * ldb; return true;
    }
    __device__ __forceinline__ unsigned a_off(const GUnit& u, int r) const {
        if (!GATHER) return (unsigned)r * lda;
        const int rr = r < u.valid ? r : 0; const int tok = list[u.e * NTOK + u.aux + rr]; return (unsigned)tok * lda;
    }
};
__device__ __forceinline__ void moe_build_table(int* tab, const int* __restrict__ cnt, int tid) {
    if (tid < 32) tab[tid] = cnt[tid * 32];
    __syncthreads();
    if (tid < 32) { int s = 0; for (int e = 0; e < tid; ++e) s += tab[e]; tab[32 + tid] = s; }
    if (tid < 320) { int tiles = 0, found = -1;
        for (int e = 0; e < NEXP; ++e) { const int te = (tab[e] + 255) >> 8; if (found < 0 && tid < tiles + te) found = e | ((tid - tiles) << 8); tiles += te; }
        if (found >= 0) tab[128 + tid] = found; if (tid == 0) tab[64] = tiles; }
    __syncthreads();
}

__device__ __forceinline__ u32x4 pack8(const f32x4& a, const f32x4& b) { u32x4 w; w.x = pk2(a[0], a[1]); w.y = pk2(a[2], a[3]); w.z = pk2(b[0], b[1]); w.w = pk2(b[2], b[3]); return w; }
struct EpiBf16 { static constexpr bool AFTER_DRAIN = false; bf16_t* O; int ldc, pad;
    __device__ __forceinline__ void operator()(const f32x4 (&acc)[2][2][4][2], const GUnit& u, int wr, int wc, int fr, int fq) const {
        LAUNDER(fr); LAUNDER(fq);
#pragma unroll
        for (int ai = 0; ai < 2; ++ai)
#pragma unroll
            for (int m = 0; m < 4; ++m) { const int r = 128 * ai + 64 * wr + 16 * m + fr;
#pragma unroll
                for (int bj = 0; bj < 2; ++bj) *(u32x4*)(O + (size_t)(u.row0 + r) * ldc + u.col0 + 128 * bj + 32 * wc + 8 * fq) = pack8(acc[ai][bj][m][0], acc[ai][bj][m][1]); } } };
__device__ __forceinline__ float row_rstd(const float* __restrict__ ssp, int row) { const f32x4* p = (const f32x4*)(ssp + (size_t)row * 16); const f32x4 a = p[0], b = p[1], c = p[2], d = p[3];
    const float s = (((a[0] + a[1]) + (a[2] + a[3])) + ((b[0] + b[1]) + (b[2] + b[3]))) + (((c[0] + c[1]) + (c[2] + c[3])) + ((d[0] + d[1]) + (d[2] + d[3]))); return 1.0f / sqrtf(s * (1.0f / 1024.0f) + EPS); }
template <bool BASE_BF16> struct EpiResidSS { static constexpr bool AFTER_DRAIN = false; const void* base; bf16_t* xb; float* ss; unsigned char* xq; const float* qg;
    __device__ __forceinline__ void operator()(const f32x4 (&acc)[2][2][4][2], const GUnit& u, int wr, int wc, int fr, int fq) const {
        LAUNDER(fr); LAUNDER(fq);
#pragma unroll
        for (int ai = 0; ai < 2; ++ai) {
            f32x4 b[4][2][2];
#pragma unroll
            for (int m = 0; m < 4; ++m)
#pragma unroll
                for (int bj = 0; bj < 2; ++bj) { const size_t o = (size_t)(u.row0 + 128 * ai + 64 * wr + 16 * m + fr) * 1024 + u.col0 + 128 * bj + 32 * wc + 8 * fq;
                    if (BASE_BF16) { const u32x4 w = *(const u32x4*)((const bf16_t*)base + o); b[m][bj][0] = (f32x4){bflo(w.x), bfhi(w.x), bflo(w.y), bfhi(w.y)}; b[m][bj][1] = (f32x4){bflo(w.z), bfhi(w.z), bflo(w.w), bfhi(w.w)}; }
                    else { b[m][bj][0] = __builtin_nontemporal_load((const f32x4*)((const float*)base + o)); b[m][bj][1] = __builtin_nontemporal_load((const f32x4*)((const float*)base + o + 4)); } }
#pragma unroll
            for (int m = 0; m < 4; ++m) { const int r = 128 * ai + 64 * wr + 16 * m + fr; float part = 0.f;
#pragma unroll
                for (int bj = 0; bj < 2; ++bj) { const size_t o = (size_t)(u.row0 + r) * 1024 + u.col0 + 128 * bj + 32 * wc + 8 * fq;
                    const f32x4 y0 = b[m][bj][0] + acc[ai][bj][m][0], y1 = b[m][bj][1] + acc[ai][bj][m][1]; *(u32x4*)(xb + o) = pack8(y0, y1);
                    if (xq) { const int cq = u.col0 + 128 * bj + 32 * wc + 8 * fq; const f32x4 g0 = *(const f32x4*)(qg + cq), g1 = *(const f32x4*)(qg + cq + 4); const f32x4 z0 = y0 * g0, z1 = y1 * g1;
                        u32x2 q; q.x = pk4_fp8(z0[0], z0[1], z0[2], z0[3]); q.y = pk4_fp8(z1[0], z1[1], z1[2], z1[3]); *(u32x2*)(xq + o) = q; }
                    part += (y0[0] * y0[0] + y0[1] * y0[1] + y0[2] * y0[2] + y0[3] * y0[3]) + (y1[0] * y1[0] + y1[1] * y1[1] + y1[2] * y1[2] + y1[3] * y1[3]); }
                part += __shfl_xor(part, 16); part += __shfl_xor(part, 32);
                if (fq == 0) ss[(size_t)(u.row0 + r) * 16 + (u.col0 >> 8) * 4 + wc] = part; } } } };
struct EpiSoftmax { static constexpr bool AFTER_DRAIN = true; const float* ss; bf16_t* P;
    __device__ __forceinline__ void operator()(const f32x4 (&)[2][2][4][2], const GUnit&, int, int, int, int) const {}
    __device__ __forceinline__ void fused(f32x4 (&acc)[2][2][4][2], const GUnit& u, int wr, int wc, int fr, int fq, unsigned char* lds, int wid, int lane) const {
        float* Pm = (float*)lds; float* Ps = (float*)(lds + 4096);
        LAUNDER(fr); LAUNDER(fq);
#pragma unroll
        for (int ai = 0; ai < 2; ++ai)
#pragma unroll
            for (int m = 0; m < 4; ++m) { const int r = 128 * ai + 64 * wr + 16 * m + fr; const float rstd = row_rstd(ss, u.row0 + r); float mv = -INFINITY;
#pragma unroll
                for (int bj = 0; bj < 2; ++bj)
#pragma unroll
                    for (int n = 0; n < 2; ++n) { f32x4 s = acc[ai][bj][m][n] * rstd; acc[ai][bj][m][n] = s; mv = fmaxf(mv, fmaxf(fmaxf(s[0], s[1]), fmaxf(s[2], s[3]))); }
                mv = fmaxf(mv, __shfl_xor(mv, 16)); mv = fmaxf(mv, __shfl_xor(mv, 32));
                if (fq == 0) Pm[r * 4 + wc] = mv; }
        __syncthreads();
#pragma unroll
        for (int ai = 0; ai < 2; ++ai)
#pragma unroll
            for (int m = 0; m < 4; ++m) { const int r = 128 * ai + 64 * wr + 16 * m + fr; const f32x4 pm = *(const f32x4*)(Pm + r * 4); const float mv = fmaxf(fmaxf(pm[0], pm[1]), fmaxf(pm[2], pm[3])); float sum = 0.f;
#pragma unroll
                for (int bj = 0; bj < 2; ++bj)
#pragma unroll
                    for (int n = 0; n < 2; ++n) { f32x4 s = acc[ai][bj][m][n]; s[0] = __builtin_amdgcn_exp2f(s[0] - mv); s[1] = __builtin_amdgcn_exp2f(s[1] - mv); s[2] = __builtin_amdgcn_exp2f(s[2] - mv); s[3] = __builtin_amdgcn_exp2f(s[3] - mv);
                        acc[ai][bj][m][n] = s; sum += (s[0] + s[1]) + (s[2] + s[3]); }
                sum += __shfl_xor(sum, 16); sum += __shfl_xor(sum, 32);
                if (fq == 0) Ps[r * 4 + wc] = sum; }
        __syncthreads();
#pragma unroll
        for (int ai = 0; ai < 2; ++ai)
#pragma unroll
            for (int m = 0; m < 4; ++m) { const int r = 128 * ai + 64 * wr + 16 * m + fr; const f32x4 ps = *(const f32x4*)(Ps + r * 4); const float inv = 1.0f / ((ps[0] + ps[1]) + (ps[2] + ps[3]));
#pragma unroll
                for (int bj = 0; bj < 2; ++bj) *(u32x4*)(P + (size_t)(u.row0 + r) * 1024 + u.col0 + 128 * bj + 32 * wc + 8 * fq) = pack8(acc[ai][bj][m][0] * inv, acc[ai][bj][m][1] * inv); }
        (void)wid; (void)lane;
        __syncthreads();
    } };
struct EpiGU { static constexpr bool AFTER_DRAIN = false; const float* bgu; unsigned char* act  ; const float* lrs  ;
    __device__ __forceinline__ void operator()(const f32x4 (&acc)[2][2][4][2], const GUnit& u, int wr, int wc, int fr, int fq) const {
        const int pn = u.col0 >> 8; const float* bg = bgu + (size_t)u.e * 2048; LAUNDER(fr); LAUNDER(fq);
        float rs[8];
#pragma unroll
        for (int i = 0; i < 8; ++i) { const int r = 128 * (i >> 2) + 64 * wr + 16 * (i & 3) + fr; rs[i] = lrs[(size_t)u.e * NTOK + u.aux + (r < u.valid ? r : 0)]; }
        const int col = 128 * pn + 32 * wc + 8 * fq;
        f32x4 bgv[2], blv[2];
#pragma unroll
        for (int n = 0; n < 2; ++n) { bgv[n] = *(const f32x4*)(bg + col + 4 * n); blv[n] = *(const f32x4*)(bg + 1024 + col + 4 * n); }
#pragma unroll
        for (int ai = 0; ai < 2; ++ai)
#pragma unroll
            for (int m = 0; m < 4; ++m) { const int r = 128 * ai + 64 * wr + 16 * m + fr; const float rstd = rs[ai * 4 + m]; u32x2 q;
#pragma unroll
                for (int n = 0; n < 2; ++n) { const f32x4 g = acc[ai][0][m][n] * rstd + bgv[n], l = acc[ai][1][m][n] * rstd + blv[n]; float o[4];
#pragma unroll
                    for (int j = 0; j < 4; ++j) { const float gg = fminf(g[j], 7.0f), ll = fminf(fmaxf(l[j], -7.0f), 7.0f); o[j] = (ll + 1.0f) * (gg * __builtin_amdgcn_rcpf(1.0f + __builtin_amdgcn_exp2f(-1.702f * LOG2E * gg))); }
                    const unsigned w = pk4_fp8(o[0], o[1], o[2], o[3]); if (n == 0) q.x = w; else q.y = w; }
                if (r < u.valid) *(u32x2*)(act + (size_t)(u.row0 + r) * 1024 + col) = q; } } };
struct EpiDown { static constexpr bool AFTER_DRAIN = false; const float* bdn; unsigned char* ys  ;
    __device__ __forceinline__ void operator()(const f32x4 (&acc)[2][2][4][2], const GUnit& u, int wr, int wc, int fr, int fq) const {
        const float* bd = bdn + (size_t)u.e * 1024; LAUNDER(fr); LAUNDER(fq);
        f32x4 bv[2][2];
#pragma unroll
        for (int bj = 0; bj < 2; ++bj)
#pragma unroll
            for (int n = 0; n < 2; ++n) bv[bj][n] = *(const f32x4*)(bd + u.col0 + 128 * bj + 32 * wc + 8 * fq + 4 * n);
#pragma unroll
        for (int ai = 0; ai < 2; ++ai)
#pragma unroll
            for (int m = 0; m < 4; ++m) { const int r = 128 * ai + 64 * wr + 16 * m + fr; if (r < u.valid) {
#pragma unroll
                for (int bj = 0; bj < 2; ++bj) { const f32x4 y0 = acc[ai][bj][m][0] + bv[bj][0], y1 = acc[ai][bj][m][1] + bv[bj][1]; u32x2 q; q.x = pk4_fp8(y0[0], y0[1], y0[2], y0[3]); q.y = pk4_fp8(y1[0], y1[1], y1[2], y1[3]);
                    *(u32x2*)(ys + (size_t)(u.row0 + r) * 1024 + u.col0 + 128 * bj + 32 * wc + 8 * fq) = q; } } } } };


typedef float f32x16 __attribute__((ext_vector_type(16)));
typedef short s16x4 __attribute__((ext_vector_type(4)));
__device__ __forceinline__ int crow(int r, int hi) { return (r & 3) + 8 * (r >> 2) + 4 * hi; }
__device__ __forceinline__ s16x4 tr_read(const unsigned char* p) { return __builtin_bit_cast(s16x4, __builtin_amdgcn_ds_read_tr16_b64_v4i16((LDSP s16x4*)(unsigned)(uintptr_t)p)); }
__device__ __forceinline__ bf16x8 tr_frag(const unsigned char* img, int pitch, int k0, int f0, int lane) {
    const unsigned char* p = img + (k0 + 8 * (lane >> 5) + ((lane & 15) >> 2)) * pitch + (f0 + 16 * ((lane >> 4) & 1) + 4 * (lane & 3)) * 2;
    const s16x4 lo = tr_read(p), hi = tr_read(p + 4 * pitch);
    return (bf16x8){lo[0], lo[1], lo[2], lo[3], hi[0], hi[1], hi[2], hi[3]};
}
constexpr int GA_PK = 576, GA_PV = 1088;
constexpr int GA_V = 0, GA_PART = 0, GA_GLR = 69632, GA_TOT = 73728, GA_KD = 75776, GA_END = GA_KD + 64 * GA_PK;
__device__ __forceinline__ void gla_pass_a(unsigned char* lds, int task, const bf16_t* __restrict__ xn, const bf16_t* __restrict__ wglr  , const bf16_t* __restrict__ proj,
                                           const float* __restrict__ wg, const float* __restrict__ bg, float* __restrict__ UT, float* __restrict__ decay) {
    int tid = threadIdx.x; LAUNDER(tid); int wid = tid >> 6, lane = tid & 63, fr = lane & 15, fq = lane >> 4;
    const size_t t0 = (size_t)task * 64;
    { f32x4 acc[4];
#pragma unroll
      for (int m = 0; m < 4; ++m) acc[m] = (f32x4){0.f, 0.f, 0.f, 0.f};
#pragma unroll
      for (int ks = 0; ks < 4; ++ks) { const int k = 128 * wid + 32 * ks + 8 * fq; const bf16x8 bfr = *(const bf16x8*)(wglr + (size_t)fr * 1024 + k);
#pragma unroll
          for (int m = 0; m < 4; ++m) { const bf16x8 afr = *(const bf16x8*)(xn + (t0 + 16 * m + fr) * DM + k); acc[m] = __builtin_amdgcn_mfma_f32_16x16x32_bf16(afr, bfr, acc[m], 0, 0, 0); } }
      float* part = (float*)(lds + GA_PART) + wid * 1024;
#pragma unroll
      for (int m = 0; m < 4; ++m)
#pragma unroll
          for (int j = 0; j < 4; ++j) part[(16 * m + 4 * fq + j) * 16 + fr] = acc[m][j]; }
    __syncthreads();
    { float* glr = (float*)(lds + GA_GLR); const float* part = (const float*)(lds + GA_PART);
      for (int i = tid; i < 1024; i += 512) { float s = 0.f;
#pragma unroll
          for (int w = 0; w < 8; ++w) s += part[w * 1024 + i];
          glr[i] = s; } }
    __syncthreads();
    LAUNDER(tid);
    { const int cv = tid & 63, tk = tid >> 6;
#pragma unroll
      for (int i = 0; i < 8; ++i) { const int tok = tk + 8 * i; const u32x4 v = *(const u32x4*)(proj + (t0 + tok) * PROJ_LD + C_VG + cv * 8); *(u32x4*)(lds + GA_V + tok * GA_PV + cv * 16) = v; } }
    LAUNDER(tid);
    { const int j = tid & 255, half = tid >> 8; const float* glr = (const float*)(lds + GA_GLR); float* tot = (float*)(lds + GA_TOT);
      float w[16];
#pragma unroll
      for (int i = 0; i < 16; ++i) w[i] = wg[i * 256 + j];
      const float bj = bg[j]; float run = 0.f;
      bf16_t kk16[32];
#pragma unroll
      for (int s = 0; s < 32; ++s) kk16[s] = proj[(t0 + 32 * half + s) * PROJ_LD + C_KG + j];
      float Gc[32];
#pragma unroll
      for (int s = 0; s < 32; ++s) { const float* gl = glr + (32 * half + s) * 16; float u = bj;
#pragma unroll
          for (int i = 0; i < 16; ++i) u += gl[i] * w[i];
          const float ls = fminf(u, 0.f) - __logf(1.0f + __expf(-fabsf(u)));
          run += ls * (1.0f / 16.0f); Gc[s] = run; }
      tot[half * 256 + j] = run;
      __syncthreads();
      const float t0v = tot[j], t1v = tot[256 + j]; const float gend = t0v + t1v;
      if (half == 0) decay[(size_t)task * 256 + j] = __expf(gend);
      const float rel = gend - (half ? t0v : 0.f);
#pragma unroll
      for (int s = 0; s < 32; ++s) { const int tok = 32 * half + s;
          *(bf16_t*)(lds + GA_KD + tok * GA_PK + j * 2) = (bf16_t)f2bf(bf2f(kk16[s]) * __expf(rel - Gc[s])); } }
    __syncthreads();
    LAUNDER(tid); wid = __builtin_amdgcn_readfirstlane(tid >> 6); lane = tid & 63;
    { const int h = wid >> 1, nt = wid & 1, hi = lane >> 5, c32 = lane & 31; f32x16 acc[4];
#pragma unroll
      for (int m = 0; m < 4; ++m)
#pragma unroll
          for (int r = 0; r < 16; ++r) acc[m][r] = 0.f;
#pragma unroll
      for (int ks = 0; ks < 4; ++ks) { const bf16x8 bfr = tr_frag(lds + GA_KD, GA_PK, 16 * ks, h * 64 + 32 * nt, lane);
#pragma unroll
          for (int m = 0; m < 4; ++m) { const bf16x8 afr = tr_frag(lds + GA_V, GA_PV, 16 * ks, h * 128 + 32 * m, lane); acc[m] = __builtin_amdgcn_mfma_f32_32x32x16_bf16(afr, bfr, acc[m], 0, 0, 0); } }
      float* u = UT + ((size_t)task * 4 + h) * 8192;
#pragma unroll
      for (int m = 0; m < 4; ++m)
#pragma unroll
          for (int r = 0; r < 16; ++r) __builtin_nontemporal_store(acc[m][r], u + (32 * m + crow(r, hi)) * 64 + 32 * nt + c32); }
    __syncthreads();
}
__device__ __forceinline__ void gla_pass_b(int e, const float* __restrict__ UT, const float* __restrict__ decay, bf16_t* __restrict__ ST) {
    const int dk = e & 63, dv = (e >> 6) & 127, h = (e >> 13) & 3, b = e >> 15; float s = 0.f;
    const size_t base = ((size_t)b * 128 * 4 + h) * 8192 + dv * 64 + dk; const size_t dbase = (size_t)b * 128 * 256 + h * 64 + dk;
    for (int c0 = 0; c0 < 128; c0 += 32) { float u[32], d[32];
#pragma unroll
        for (int i = 0; i < 32; ++i) { u[i] = __builtin_nontemporal_load(UT + base + (size_t)(c0 + i) * 4 * 8192); d[i] = decay[dbase + (size_t)(c0 + i) * 256]; }
#pragma unroll
        for (int i = 0; i < 32; ++i) { s = d[i] * s + u[i]; __builtin_nontemporal_store((bf16_t)f2bf(s), ST + base + (size_t)(c0 + i) * 4 * 8192); } }
}
constexpr int GC_PITCH = 520;
__device__ __forceinline__ void gla_pass_c(unsigned char* wlds  , int wtask, const bf16_t* __restrict__ ST, const bf16_t* __restrict__ proj, const float* __restrict__ ghead, bf16_t* __restrict__ mix, int lane) {
    const int nh = wtask & 1, h = (wtask >> 1) & 3, bc = wtask >> 3; const int c32 = lane & 31, hi = lane >> 5;
    const size_t t0 = (size_t)bc * 64 + 32 * nh; const bf16_t* st = ST + ((size_t)bc * 4 + h) * 8192;
    f32x16 acc[4];
#pragma unroll
    for (int m = 0; m < 4; ++m)
#pragma unroll
        for (int r = 0; r < 16; ++r) acc[m][r] = 0.f;
#pragma unroll
    for (int ks = 0; ks < 4; ++ks) { const bf16x8 bfr = *(const bf16x8*)(proj + (t0 + c32) * PROJ_LD + C_QG + h * 64 + 16 * ks + 8 * hi);
#pragma unroll
        for (int m = 0; m < 4; ++m) { const bf16x8 afr = *(const bf16x8*)(st + (32 * m + c32) * 64 + 16 * ks + 8 * hi); acc[m] = __builtin_amdgcn_mfma_f32_32x32x16_bf16(afr, bfr, acc[m], 0, 0, 0); } }
    float ss = 0.f;
#pragma unroll
    for (int m = 0; m < 4; ++m)
#pragma unroll
        for (int r = 0; r < 16; ++r) ss += acc[m][r] * acc[m][r];
    ss += __shfl_xor(ss, 32);
    const float rstd = 1.0f / sqrtf(ss * (1.0f / 128.0f) + EPS);
#pragma unroll
    for (int m = 0; m < 4; ++m)
#pragma unroll
        for (int r = 0; r < 16; ++r) *(float*)(wlds + c32 * GC_PITCH + (32 * m + crow(r, hi)) * 4) = acc[m][r] * rstd;
#pragma unroll
    for (int i = 0; i < 8; ++i) { const int q = lane + 64 * i, tok = q >> 4, dv0 = (q & 15) * 8; const float* src = (const float*)(wlds + tok * GC_PITCH + dv0 * 4);
        const u32x4 rgw = *(const u32x4*)(proj + (t0 + tok) * PROJ_LD + C_RG + h * 128 + dv0); const f32x4 g0 = *(const f32x4*)(ghead + dv0), g1 = *(const f32x4*)(ghead + dv0 + 4);
        const float rg[8] = {bflo(rgw.x), bfhi(rgw.x), bflo(rgw.y), bfhi(rgw.y), bflo(rgw.z), bfhi(rgw.z), bflo(rgw.w), bfhi(rgw.w)}; const float gg[8] = {g0.x, g0.y, g0.z, g0.w, g1.x, g1.y, g1.z, g1.w}; float y[8];
#pragma unroll
        for (int k = 0; k < 8; ++k) y[k] = src[k] * gg[k] * (rg[k] / (1.0f + __expf(-rg[k])));
        u32x4 o; o.x = pk2(y[0], y[1]); o.y = pk2(y[2], y[3]); o.z = pk2(y[4], y[5]); o.w = pk2(y[6], y[7]);
        *(u32x4*)(mix + (t0 + tok) * 1024 + h * 128 + dv0) = o; }
}
__device__ __forceinline__ void sb_task(unsigned char* vl  , int wtask, const bf16_t* __restrict__ proj, bf16_t* __restrict__ mix, int lane) {
    const int qt = wtask & 255, h = (wtask >> 8) & 7, b = wtask >> 11; const int c = lane & 31, hi = lane >> 5;
    const int t0 = qt * 32; const size_t rowb = (size_t)b * SEQ;
    bf16x8 qf[4];
#pragma unroll
    for (int d0 = 0; d0 < 4; ++d0) qf[d0] = *(const bf16x8*)(proj + (rowb + t0 + c) * PROJ_LD + C_QS + h * 64 + 16 * d0 + 8 * hi);
    const int kap = 16 * ((c >> 2) & 1) + (c & 3) + 4 * (c >> 3);
    f32x16 o0, o1;
#pragma unroll
    for (int r = 0; r < 16; ++r) { o0[r] = 0.f; o1[r] = 0.f; }
    float Dc = 1.0f;
    const bf16_t* kbase = proj + rowb * PROJ_LD + C_KS + h * 64 + 8 * hi + (size_t)kap * PROJ_LD;
    const bf16_t* vbase = proj + rowb * PROJ_LD + C_VS + h * 64 + (lane & 7) * 8 + (size_t)(lane >> 3) * PROJ_LD;
    bf16x8 kf[4]; u32x4 vr[4];
#pragma unroll
    for (int d0 = 0; d0 < 4; ++d0) kf[d0] = *(const bf16x8*)(kbase + (size_t)t0 * PROJ_LD + 16 * d0);
#pragma unroll
    for (int i = 0; i < 4; ++i) vr[i] = *(const u32x4*)(vbase + (size_t)(t0 + 8 * i) * PROJ_LD);
    for (int j0 = t0; j0 >= 0; j0 -= 32) {
#pragma unroll
        for (int i = 0; i < 4; ++i) { const int key = (lane >> 3) + 8 * i, ch = lane & 7; *(u32x4*)(vl + (ch >> 2) * 2048 + key * 64 + (ch & 3) * 16) = vr[i]; }
        f32x16 z;
#pragma unroll
        for (int r = 0; r < 16; ++r) z[r] = 0.f;
#pragma unroll
        for (int d0 = 0; d0 < 4; ++d0) z = __builtin_amdgcn_mfma_f32_32x32x16_bf16(kf[d0], qf[d0], z, 0, 0, 0);
        asm volatile("" ::: "memory");
        { const int jn = (j0 >= 32) ? j0 - 32 : j0;
#pragma unroll
          for (int d0 = 0; d0 < 4; ++d0) kf[d0] = *(const bf16x8*)(kbase + (size_t)jn * PROJ_LD + 16 * d0);
#pragma unroll
          for (int i = 0; i < 4; ++i) vr[i] = *(const u32x4*)(vbase + (size_t)(jn + 8 * i) * PROJ_LD); }
        asm volatile("" ::: "memory");
        float e[16], Dl[16];
        const bool diag = (j0 == t0);
#pragma unroll
        for (int r = 0; r < 16; ++r) { float ev = __builtin_amdgcn_exp2f(fminf(z[r], 126.0f)); if (diag && (16 * hi + r >= c)) ev = 0.f; e[r] = ev; }
        float D = hi ? Dc : 1.0f;
#pragma unroll
        for (int r = 15; r >= 0; --r) { D = fmaf(D, e[r], D); Dl[r] = D; }
        const float other = __shfl_xor(D, 32);
        const float mult = hi ? 1.0f : other;
        Dc = D * other;
        unsigned pw[8];
#pragma unroll
        for (int r = 0; r < 16; r += 2) { const float a0 = e[r] * __builtin_amdgcn_rcpf(Dl[r] * mult), a1 = e[r + 1] * __builtin_amdgcn_rcpf(Dl[r + 1] * mult); pw[r >> 1] = pk2(a0, a1); }
#pragma unroll
        for (int ks = 0; ks < 2; ++ks) { const bf16x8 pa = __builtin_bit_cast(bf16x8, (u32x4){pw[4 * ks], pw[4 * ks + 1], pw[4 * ks + 2], pw[4 * ks + 3]});
            const unsigned char* vb = vl + (16 * hi + 8 * ks + ((lane & 15) >> 2)) * 64 + (16 * ((lane >> 4) & 1) + 4 * (lane & 3)) * 2;
            { const s16x4 lo = tr_read(vb), hh = tr_read(vb + 256); o0 = __builtin_amdgcn_mfma_f32_32x32x16_bf16(pa, (bf16x8){lo[0], lo[1], lo[2], lo[3], hh[0], hh[1], hh[2], hh[3]}, o0, 0, 0, 0); }
            { const s16x4 lo = tr_read(vb + 2048), hh = tr_read(vb + 2048 + 256); o1 = __builtin_amdgcn_mfma_f32_32x32x16_bf16(pa, (bf16x8){lo[0], lo[1], lo[2], lo[3], hh[0], hh[1], hh[2], hh[3]}, o1, 0, 0, 0); } }
        if (__all(!(Dc < 3.0e38f))) break;
    }
    bf16_t* ob = mix + (rowb + t0) * 1024 + 512 + h * 64 + c;
#pragma unroll
    for (int r = 0; r < 16; ++r) { const int q = crow(r, hi); ob[(size_t)q * 1024] = (bf16_t)f2bf(o0[r]); ob[(size_t)q * 1024 + 32] = (bf16_t)f2bf(o1[r]); }
}
__device__ __forceinline__ void memkv_task(int wtask, int lane, const bf16_t* __restrict__ memn, const bf16_t* __restrict__ wkv, bf16_t* __restrict__ kv) {
    const int tm = wtask >> 6, tn = wtask & 63; const int c = lane & 31, hi = lane >> 5;
    const bf16_t* ap = memn + (size_t)(tm * 32 + c) * DM + 8 * hi; const bf16_t* bp = wkv + (size_t)(tn * 32 + c) * DM + 8 * hi;
    f32x16 acc;
#pragma unroll
    for (int r = 0; r < 16; ++r) acc[r] = 0.f;
#pragma unroll 16
    for (int ks = 0; ks < 64; ++ks) { const bf16x8 a = *(const bf16x8*)(ap + 16 * ks), b = *(const bf16x8*)(bp + 16 * ks); acc = __builtin_amdgcn_mfma_f32_32x32x16_bf16(a, b, acc, 0, 0, 0); }
    bf16_t* o = kv + (size_t)(tm * 32) * 2048 + tn * 32 + c;
#pragma unroll
    for (int r = 0; r < 16; ++r) o[(size_t)crow(r, hi) * 2048] = (bf16_t)f2bf(acc[r]);
}
__device__ __forceinline__ void router_task(int wtask, int lane, const bf16_t* __restrict__ xn, const float* __restrict__ ss, const bf16_t* __restrict__ wr, const float* __restrict__ br,
                                            int (&oe)[4], float (&ow)[4]) {
    const int c = lane & 31, hi = lane >> 5; const int t = wtask * 32 + c;
    const bf16_t* ap = wr + (size_t)c * DM + 8 * hi; const bf16_t* bp = xn + (size_t)t * DM + 8 * hi;
    f32x16 acc;
#pragma unroll
    for (int r = 0; r < 16; ++r) acc[r] = 0.f;
#pragma unroll 16
    for (int ks = 0; ks < 64; ++ks) { const bf16x8 a = *(const bf16x8*)(ap + 16 * ks), b = *(const bf16x8*)(bp + 16 * ks); acc = __builtin_amdgcn_mfma_f32_32x32x16_bf16(a, b, acc, 0, 0, 0); }
    float v[16]; const float rstd = row_rstd(ss, t);
#pragma unroll
    for (int r = 0; r < 16; ++r) v[r] = acc[r] * rstd + br[crow(r, hi)];
    float tv[4]; int ti[4];
#pragma unroll
    for (int k = 0; k < 4; ++k) { float best = -INFINITY; int bi = 64;
#pragma unroll
        for (int r = 0; r < 16; ++r) { if (v[r] > best) { best = v[r]; bi = crow(r, hi); } }
        tv[k] = best; ti[k] = bi;
#pragma unroll
        for (int r = 0; r < 16; ++r) if (crow(r, hi) == bi) v[r] = -INFINITY; }
    float cv[8]; int ci[8];
#pragma unroll
    for (int k = 0; k < 4; ++k) { cv[k] = tv[k]; ci[k] = ti[k]; cv[4 + k] = __shfl_xor(tv[k], 32); ci[4 + k] = __shfl_xor(ti[k], 32); }
#pragma unroll
    for (int k = 0; k < 4; ++k) { float best = -INFINITY; int bi = 64;
#pragma unroll
        for (int q = 0; q < 8; ++q) { if (cv[q] > best || (cv[q] == best && ci[q] < bi)) { best = cv[q]; bi = ci[q]; } }
        tv[k] = best; ti[k] = bi;
#pragma unroll
        for (int q = 0; q < 8; ++q) if (ci[q] == bi) cv[q] = -INFINITY; }
    const float e1 = __expf(tv[1] - tv[0]), e2 = __expf(tv[2] - tv[0]), e3 = __expf(tv[3] - tv[0]); const float inv = 1.0f / (1.0f + e1 + e2 + e3);
    const float g[4] = {inv, e1 * inv, e2 * inv, e3 * inv};
#pragma unroll
    for (int k = 0; k < 4; ++k) { oe[k] = ti[k]; ow[k] = g[k]; }
}
__device__ __forceinline__ void combine_task(int t, int lane, const bf16_t* xin, float* xout, const unsigned char* __restrict__ ys, const int* tab, const int* __restrict__ toke, const int* __restrict__ tokr,
                                                 const float* __restrict__ tokw, const float* __restrict__ gfin) {
    const u32x2* xr = (const u32x2*)(xin + (size_t)t * DM) + lane; f32x4* xo = (f32x4*)(xout + (size_t)t * DM) + lane; f32x4 v[4];
#pragma unroll
    for (int j = 0; j < 4; ++j) { const u32x2 w = __builtin_nontemporal_load(xr + 64 * j); v[j] = (f32x4){bflo(w.x), bfhi(w.x), bflo(w.y), bfhi(w.y)}; }
    for (int k = 0; k < 4; ++k) { const int e = toke[t * 4 + k], r = tokr[t * 4 + k]; const float w = tokw[t * 4 + k]; const int start = tab[32 + e];
        const unsigned* yr = (const unsigned*)(ys + (size_t)(start + r) * DM) + lane;
#pragma unroll
        for (int j = 0; j < 4; ++j) { const int y = (int)__builtin_nontemporal_load(yr + 64 * j); const f32x2 lo = __builtin_amdgcn_cvt_pk_f32_fp8(y, false), hi = __builtin_amdgcn_cvt_pk_f32_fp8(y, true);
            v[j].x += w * lo.x; v[j].y += w * lo.y; v[j].z += w * hi.x; v[j].w += w * hi.y; } }
    float s = 0.f;
#pragma unroll
    for (int j = 0; j < 4; ++j) s += v[j].x * v[j].x + v[j].y * v[j].y + v[j].z * v[j].z + v[j].w * v[j].w;
    const float rstd = 1.0f / sqrtf(wave_sum(s) * (1.f / DM) + EPS);
#pragma unroll
    for (int j = 0; j < 4; ++j) { const f32x4 g = *((const f32x4*)gfin + lane + 64 * j); __builtin_nontemporal_store(v[j] * rstd * g, xo + 64 * j); }
}

#define GAS __attribute__((address_space(1)))
#define RLX_AGENT __ATOMIC_RELAXED, __HIP_MEMORY_SCOPE_AGENT
#define XB_TMO      128
#define XB_XCNT(j)  (256  + 64 * (j))
#define XB_XSUB(j)  (1280 + 64 * (j))
#define XB_XGEN(j)  (2304 + 64 * (j))
#define XB_TOP      3328
#define XB_TOPGEN   3392
#define XCD_BAR_WORDS 3456
#define XB_SPIN_CAP (1u << 18)
__device__ __forceinline__ unsigned xb_ld(unsigned* p)              { return __hip_atomic_load(p, __ATOMIC_RELAXED, __HIP_MEMORY_SCOPE_AGENT); }
__device__ __forceinline__ unsigned xb_add(unsigned* p, unsigned v) { return __hip_atomic_fetch_add(p, v, __ATOMIC_RELAXED, __HIP_MEMORY_SCOPE_AGENT); }
__device__ __forceinline__ unsigned xb_xcc_id() { return (unsigned)__builtin_amdgcn_s_getreg((3 << 11) | 20) & 0xFu; }
#define XB_SPIN(cond, bar) do { unsigned _sp = 0; while (cond) { __builtin_amdgcn_s_sleep(1); \
    if ((++_sp & 255u) == 0u) { if (xb_ld(&(bar)[XB_TMO])) break; if (_sp > XB_SPIN_CAP) { atomicAdd(&(bar)[XB_TMO], 1u); break; } } } } while (0)
struct XcdBarrier { unsigned* bar; unsigned x; };
__device__ __forceinline__ XcdBarrier xcd_barrier_post(unsigned* bar) {
    XcdBarrier b; b.bar = bar; b.x = xb_xcc_id();
    if (threadIdx.x == 0) (void)xb_add(&bar[XB_XCNT(b.x)], 1u);
    return b;
}
__device__ __forceinline__ void xcd_barrier_complete(unsigned* bar, unsigned x, unsigned& nloc, unsigned& nx) {
    const unsigned G = gridDim.x * gridDim.y * gridDim.z;
    unsigned sum, cnt, mine, sp = 0u;
    for (;;) {
        sum = 0u; cnt = 0u; mine = 0u;
#pragma unroll
        for (unsigned j = 0; j < 16; ++j) { const unsigned c = xb_ld(&bar[XB_XCNT(j)]); sum += c; cnt += (c > 0u) ? 1u : 0u; mine = (j == x) ? c : mine; }
        if (sum == G) break;
        __builtin_amdgcn_s_sleep(1);
        if ((++sp & 255u) == 0u) { if (xb_ld(&bar[XB_TMO])) break; if (sp > XB_SPIN_CAP) { atomicAdd(&bar[XB_TMO], 1u); break; } }
    }
    nloc = mine > 0u ? mine : 1u; nx = cnt > 0u ? cnt : 1u;
}
__device__ __forceinline__ void xcd_barrier(const XcdBarrier& b, unsigned& st  ) {
    asm volatile("s_waitcnt vmcnt(0)" ::: "memory");
    __syncthreads();
    unsigned stv = st;
    if (threadIdx.x == 0) {
        unsigned* bar = b.bar;
        __builtin_amdgcn_s_waitcnt(0);
        unsigned nloc = st & 0xffffu, nx = st >> 16;
        if (nloc == 0u) { xcd_barrier_complete(bar, b.x, nloc, nx); stv = nloc | (nx << 16); }
        const unsigned old = xb_add(&bar[XB_XSUB(b.x)], 1u);
        const unsigned gen = old / nloc;
        if (old + 1u == (gen + 1u) * nloc) {
            __builtin_amdgcn_fence(__ATOMIC_RELEASE, "agent");
            asm volatile("s_waitcnt vmcnt(0)" ::: "memory");
            const unsigned og = xb_add(&bar[XB_TOP], 1u);
            const unsigned tg = og / nx;
            if (og + 1u == (tg + 1u) * nx) xb_add(&bar[XB_TOPGEN], 1u);
            else XB_SPIN(xb_ld(&bar[XB_TOPGEN]) == tg, bar);
            __builtin_amdgcn_fence(__ATOMIC_ACQUIRE, "agent");
            xb_add(&bar[XB_XGEN(b.x)], 1u);
            asm volatile("s_waitcnt vmcnt(0)" ::: "memory");
        } else {
            XB_SPIN(xb_ld(&bar[XB_XGEN(b.x)]) == gen, bar);
            __builtin_amdgcn_fence(__ATOMIC_ACQUIRE, "agent");
            asm volatile("s_waitcnt vmcnt(0)" ::: "memory");
        }
    }
    st = __builtin_amdgcn_readfirstlane(stv);
    __syncthreads();
}

constexpr int LDS_BYTES = 147456;
constexpr int CW_BAR = 4096;
constexpr size_t CTL_ZERO_BYTES = 65536;
constexpr int NPHASE = 12;
struct Args { const float* in[22]; float* out; unsigned char* ws; int ph_lo, ph_hi; };

__global__ void __launch_bounds__(512, 2) mega(Args a) {
    extern __shared__ __attribute__((aligned(16))) unsigned char lds[];
    unsigned char* ws = a.ws; float* out = a.out;
    const float* x = a.in[0]; const float* mem = a.in[1]; const float* g_mix = a.in[2]; const float* w_in = a.in[3];
    const float* w_gla_gate = a.in[4]; const float* b_gla_gate = a.in[5]; const float* g_gla_head = a.in[6]; const float* w_out = a.in[7];
    const float* g_mem_q = a.in[8]; const float* g_mem_kv = a.in[9]; const float* w_mq = a.in[10]; const float* w_mk = a.in[11];
    const float* w_mv = a.in[12]; const float* w_mo = a.in[13]; const float* g_ffn = a.in[14]; const float* w_router = a.in[15];
    const float* b_router = a.in[16]; const float* w_gu = a.in[17]; const float* b_gu = a.in[18]; const float* w_down = a.in[19];
    const float* b_down = a.in[20]; const float* g_final = a.in[21];
    bf16_t* Wt_in = (bf16_t*)(ws + WS_WIN); bf16_t* Wt_out = (bf16_t*)(ws + WS_WOUT); bf16_t* Wq = (bf16_t*)(ws + WS_WQ); bf16_t* Wt_kv = (bf16_t*)(ws + WS_WKV);
    bf16_t* Wt_mo = (bf16_t*)(ws + WS_WMO); bf16_t* Wt_r = (bf16_t*)(ws + WS_WR); bf16_t* Wt_gu = (bf16_t*)(ws + WS_WGU); bf16_t* Wt_dn = (bf16_t*)(ws + WS_WDN);
    bf16_t* xn = (bf16_t*)(ws + WS_XN); bf16_t* memn = (bf16_t*)(ws + WS_MEMN); bf16_t* kv = (bf16_t*)(ws + WS_KV); bf16_t* Bs = (bf16_t*)(ws + WS_BS); bf16_t* Bo = (bf16_t*)(ws + WS_BO);
    bf16_t* proj = (bf16_t*)(ws + WS_PROJ); bf16_t* mix = (bf16_t*)(ws + WS_MIX);
    float* Sc = (float*)(ws + WS_S); bf16_t* P = (bf16_t*)(ws + WS_P); float* lg = (float*)(ws + WS_LG); int* toke = (int*)(ws + WS_TOKE); int* tokr = (int*)(ws + WS_TOKR);
    float* tokw = (float*)(ws + WS_TOKW); int* list = (int*)(ws + WS_LIST); unsigned char* ys = ws + WS_YS;
    unsigned char* Wq_gu = ws + WS_WGU; unsigned char* Wq_dn = ws + WS_WDN; unsigned char* x2q = ws + WS_S; unsigned char* act8 = ws + WS_ACT;
    float* lrs = (float*)(ws + WS_LG);
    float* UT = (float*)(ws + WS_S); float* decay = (float*)(ws + WS_LA); bf16_t* ST = (bf16_t*)(ws + WS_ORAW);
    unsigned* ctl = (unsigned*)(ws + WS_CTL); int* cnt = (int*)ctl + CW_CNT; float* ss1 = (float*)(ws + WS_LA + 8 * MiB); float* ss2 = (float*)(ws + WS_LA + 9 * MiB);

    const int G = gridDim.x, vb = blockIdx.x;
    XcdBarrier bar = xcd_barrier_post(ctl + CW_BAR); unsigned bar_st = 0u;
    const int ch_gw = __builtin_amdgcn_readfirstlane(vb * 8 + (int)(threadIdx.x >> 6)), ch_nW = G * 8;
    const int lo = a.ph_lo, hi = a.ph_hi;
    float* dmy = (float*)(ws + WS_DUMMY); (void)dmy;
#ifndef REPEAT_MASK
#define REPEAT_MASK 0
#endif
#define IN(k) (lo <= (k) && (k) < hi)
#define REP(k) for (int rep_ = 0; rep_ < 1 + ((REPEAT_MASK >> (k)) & 1); ++rep_)
#define SEAM(k) do { if (IN(k) && IN((k) + 1)) xcd_barrier(bar, bar_st); } while (0)
#define TIDS() int tid = threadIdx.x; LAUNDER(tid); const int lane = tid & 63; const int wid = __builtin_amdgcn_readfirstlane(tid >> 6); (void)lane; (void)wid

    if (IN(0)) REP(0) { TIDS(); const size_t gt = (size_t)vb * 512 + tid, gs = (size_t)G * 512;
        float* scr = (float*)(lds + wid * 8448);
        const int gw = vb * 8 + wid, ngw = G * 8;
        rms_body(gw, ngw, lane, x, xn, NTOK);
        rms_body(gw, ngw, lane, mem, memn, NB * MEML);
        conv_n_body(gt, gs, w_mq, Wq, g_mem_q, 1024, 1024, LOG2E / 16.0f);
        constexpr int I_IN = 16 * 97, I_SQ = 16 * 32, I_R = 16;
        constexpr int NITEMS = I_IN + 4 * I_SQ + I_R;
        for (int it = gw; it < NITEMS; it += ngw) { int r = it;
            if (r < I_IN) { conv_item<1>(scr, w_in, Wt_in, g_mix, 3088, 1024, 3088, r / 97, r % 97, lane); continue; } r -= I_IN;
            if (r < I_SQ) { conv_item<0>(scr, w_out, Wt_out, nullptr, 1024, 1024, 1024, r >> 5, r & 31, lane); continue; } r -= I_SQ;
            if (r < I_SQ) { conv_item<0>(scr, w_mk, Wt_kv, g_mem_kv, 1024, 1024, 1024, r >> 5, r & 31, lane); continue; } r -= I_SQ;
            if (r < I_SQ) { conv_item<0>(scr, w_mv, Wt_kv + (size_t)1024 * 1024, g_mem_kv, 1024, 1024, 1024, r >> 5, r & 31, lane); continue; } r -= I_SQ;
            if (r < I_SQ) { conv_item<0>(scr, w_mo, Wt_mo, nullptr, 1024, 1024, 1024, r >> 5, r & 31, lane); continue; } r -= I_SQ;
            { conv_item<0>(scr, w_router, Wt_r, g_ffn, 32, 1024, 32, r, 0, lane); } }
        __syncthreads(); }
    SEAM(0);
    if (IN(1)) REP(1) { DenseSched S{(const char*)xn, (const char*)Wt_in, 2048u, 2048u, 1024, 64, 12, 1 << 30, 0, G, vb}; EpiBf16 E{proj, PROJ_LD, 0}; gemm_run_host<true, 1>(lds, S, E, w_gu, ws, 0, 24576, ch_gw, ch_nW); }
    SEAM(1);
    if (IN(2)) REP(2) {
        for (int t = vb; t < 256; t += G) gla_pass_a(lds, t, xn, Wt_in + (size_t)3072 * 1024, proj, w_gla_gate, b_gla_gate, UT, decay);
        { TIDS(); for (int t = vb * 8 + wid; t < 4096; t += G * 8) sb_task(lds + wid * 4096, t, proj, mix, lane); }
        { TIDS(); for (int t = vb + G * wid; t < 1024; t += G * 8) memkv_task(t, lane, memn, Wt_kv, kv); } }
    SEAM(2);
    if (IN(3)) REP(3) {
        { TIDS(); for (int e = vb * 512 + tid; e < 65536; e += G * 512) gla_pass_b(e, UT, decay, ST); }
        { SchedWqk S{(const char*)kv, (const char*)Wq, 4096u, 2048u, 256, G / 2, vb - G / 2, 0}; EpiBf16 E{Bs, 1024, 0}; gemm_run<false>(lds, S, E); }
        { SchedVo S{(const char*)Wt_mo, (const char*)kv, 2048u, 4096u, 256, G / 2, vb - G / 2 - 32, 0}; EpiBf16 E{Bo, 1024, 0}; gemm_run<false>(lds, S, E); } }
    SEAM(3);
    if (IN(4)) REP(4) { TIDS(); for (int t = vb * 8 + wid; t < 2048; t += G * 8) gla_pass_c(lds + wid * 32 * GC_PITCH, t, ST, proj, g_gla_head, mix, lane); }
    SEAM(4);
#if PROBE_BARRIERS
    for (int pb_ = 0; pb_ < 8; ++pb_) xcd_barrier(bar, bar_st);
#endif
    if (IN(5)) REP(5) { DenseSched S{(const char*)mix, (const char*)Wt_out, 2048u, 2048u, 1024, 64, 4, 1 << 30, 0, G, vb}; EpiResidSS<false> E{x, rep_ ? (bf16_t*)dmy : xn, rep_ ? dmy + 16 * 1024 * 1024 : ss1, nullptr, nullptr}; gemm_run_host<false, 1>(lds, S, E, w_gu, ws, 24576, CH_GU_ITEMS, ch_gw, ch_nW); }
    SEAM(5);
    if (IN(6)) REP(6) { DenseSched S{(const char*)xn, (const char*)Bs, 2048u, 2048u, 1024, 64, 4, 32, (size_t)1024 * 2048, G, vb}; EpiSoftmax E{ss1, P}; gemm_run_host<false, 2>(lds, S, E, w_down, ws, CH_GU_ITEMS, CH_GU_ITEMS + 8192, ch_gw, ch_nW); }
    SEAM(6);
    if (IN(7)) REP(7) { DenseSched S{(const char*)P, (const char*)Bo, 2048u, 2048u, 1024, 64, 4, 32, (size_t)1024 * 2048, G, vb}; EpiResidSS<true> E{xn, rep_ ? (bf16_t*)dmy : xn, rep_ ? dmy + 16 * 1024 * 1024 : ss2, rep_ ? (unsigned char*)dmy + 40 * 1024 * 1024 : x2q, g_ffn}; gemm_run_host<false, 2>(lds, S, E, w_down, ws, CH_GU_ITEMS + 8192, CH_ITEMS, ch_gw, ch_nW); }
    SEAM(7);
    if (IN(8)) REP(8) { TIDS(); int* cntp = rep_ ? (int*)ctl + 2048 : cnt; int* listp = rep_ ? (int*)dmy + 1024 : list; float* lrsp = rep_ ? dmy + 4096 * 1024 : lrs; int* tokep = rep_ ? (int*)dmy + 1024 * 1024 : toke; int* tokrp = rep_ ? (int*)dmy + 2048 * 1024 : tokr; float* tokwp = rep_ ? dmy + 3072 * 1024 : tokw;
        int* lcnt = (int*)lds; int* gbase = (int*)lds + 32;
        for (int tb = vb; tb < NTOK / 64; tb += G) {
            if (tid < 32) lcnt[tid] = 0;
            __syncthreads();
            int oe[4] = {0, 0, 0, 0}; float ow[4] = {0.f, 0.f, 0.f, 0.f}; int lr[4] = {0, 0, 0, 0};
            if (wid < 2) { router_task(tb * 2 + wid, lane, xn, ss2, Wt_r, b_router, oe, ow);
                if (lane < 32) {
#pragma unroll
                    for (int k = 0; k < 4; ++k) lr[k] = atomicAdd(&lcnt[oe[k]], 1); } }
            __syncthreads();
            if (tid < 32) gbase[tid] = atomicAdd(&cntp[tid * 32], lcnt[tid]);
            __syncthreads();
            if (wid < 2 && lane < 32) { const int t = (tb * 2 + wid) * 32 + lane;
                const float rstd_t = row_rstd(ss2, t);
#pragma unroll
                for (int k = 0; k < 4; ++k) { const int r = gbase[oe[k]] + lr[k]; listp[oe[k] * NTOK + r] = t; lrsp[oe[k] * NTOK + r] = rstd_t; tokep[t * 4 + k] = oe[k]; tokrp[t * 4 + k] = r; tokwp[t * 4 + k] = ow[k]; } }
            __syncthreads(); } }
    SEAM(8);
    if (IN(9)) REP(9) { int* tab = (int*)(lds + 131072); { TIDS(); moe_build_table(tab, cnt, tid); }
        MoeSched<true> S{(const char*)x2q, (const char*)Wq_gu, 1024u, 1024u, 512, 8, (size_t)2048 * 1024, tab, list, 1, G, vb, 0}; EpiGU E{b_gu, act8, lrs}; gemm_run_fp8<true>(lds, S, E); }
    SEAM(9);
    if (IN(10)) REP(10) { int* tab = (int*)(lds + 131072); { TIDS(); moe_build_table(tab, cnt, tid); }
        MoeSched<false> S{(const char*)act8, (const char*)Wq_dn, 1024u, 1024u, 512, 4, (size_t)1024 * 1024, tab, list, 0, G, vb, 0}; EpiDown E{b_down, ys}; gemm_run_fp8<true>(lds, S, E); }
    SEAM(10);
    if (IN(11)) REP(11) { TIDS(); int* tab = (int*)(lds + 131072); moe_build_table(tab, cnt, tid);
        for (int t = vb * 8 + wid; t < NTOK; t += G * 8) combine_task(t, lane, xn, rep_ ? dmy : out, ys, tab, toke, tokr, tokw, g_final); }
#undef IN
#undef SEAM
#undef TIDS
}

#ifndef MK_PER_PHASE
#define MK_PER_PHASE 0
#endif
extern "C" void kernel_launch(void* const* d_in, const int* in_sizes, int n_in, void* d_out, int out_size, void* d_ws, size_t ws_size, hipStream_t stream) {
    static int grid = 0;
    if (grid == 0) {
        if (n_in != 22 || in_sizes[0] != NTOK * DM || out_size != NTOK * DM || ws_size < WS_END) { fprintf(stderr, "kernel_launch: unexpected shapes (n_in %d, ws %zu)\n", n_in, ws_size); grid = -1; return; }
        int dev = 0, cus = 0, per_cu = 0;
        if (hipGetDevice(&dev) != hipSuccess || hipDeviceGetAttribute(&cus, hipDeviceAttributeMultiprocessorCount, dev) != hipSuccess) { grid = -1; return; }
        if (hipFuncSetAttribute((const void*)mega, hipFuncAttributeMaxDynamicSharedMemorySize, LDS_BYTES) != hipSuccess) { fprintf(stderr, "kernel_launch: hipFuncSetAttribute failed\n"); grid = -1; return; }
        if (hipOccupancyMaxActiveBlocksPerMultiprocessor(&per_cu, (const void*)mega, 512, LDS_BYTES) != hipSuccess || per_cu < 1) fprintf(stderr, "kernel_launch: occupancy query says %d blocks/CU\n", per_cu);
        (void)hipGetLastError();
        grid = cus;
    }
    if (grid < 0) return;
    (void)hipMemsetAsync((char*)d_ws + WS_CTL, 0, CTL_ZERO_BYTES, stream);
    Args a{};
    for (int i = 0; i < 22; ++i) a.in[i] = (const float*)d_in[i];
    a.out = (float*)d_out; a.ws = (unsigned char*)d_ws;
#if MK_PER_PHASE
    for (int p = 0; p < NPHASE; ++p) { a.ph_lo = p; a.ph_hi = p + 1; hipLaunchKernelGGL(mega, dim3(grid), dim3(512), LDS_BYTES, stream, a); }
#else
    a.ph_lo = 0; a.ph_hi = NPHASE; hipLaunchKernelGGL(mega, dim3(grid), dim3(512), LDS_BYTES, stream, a);
#endif
}
```

```cpp
#include <hip/hip_runtime.h>
#include <cstdio>
#include <cstdint>
#ifndef PROBE_BARRIERS
#define PROBE_BARRIERS 0
#endif

typedef unsigned short bf16_t;
typedef short bf16x8 __attribute__((ext_vector_type(8)));
typedef float f32x4 __attribute__((ext_vector_type(4)));
typedef unsigned u32x4 __attribute__((ext_vector_type(4)));
typedef unsigned u32x2 __attribute__((ext_vector_type(2)));
typedef float f32x2 __attribute__((ext_vector_type(2)));
#define LDSP __attribute__((address_space(3)))
#define LAUNDER(x) asm volatile("" : "+v"(x))

constexpr int NB = 2, SEQ = 8192, NTOK = NB * SEQ, DM = 1024, MEML = 256;
constexpr int NEXP = 32, TOPK = 4, NASSIGN = NTOK * TOPK;
constexpr int PROJ_LD = 3072;
constexpr int C_QG = 0, C_KG = 256, C_VG = 512, C_RG = 1024, C_QS = 1536, C_KS = 2048, C_VS = 2560, C_GLR = 3072;
constexpr float LOG2E = 1.4426950408889634f;
constexpr float EPS = 1e-5f;

__device__ __forceinline__ unsigned f2bf(float f) { unsigned u = __float_as_uint(f); return (u + 0x7fffu + ((u >> 16) & 1u)) >> 16; }
__device__ __forceinline__ unsigned pk2(float lo, float hi) { return f2bf(lo) | (f2bf(hi) << 16); }
__device__ __forceinline__ float bf2f(bf16_t h) { return __uint_as_float(((unsigned)h) << 16); }
__device__ __forceinline__ float bflo(unsigned w) { return __uint_as_float(w << 16); }
__device__ __forceinline__ float bfhi(unsigned w) { return __uint_as_float(w & 0xffff0000u); }

constexpr size_t MiB = 1u << 20;
constexpr size_t WS_CTL = 0;
constexpr size_t WS_WIN = 1 * MiB;
constexpr size_t WS_WOUT = 8 * MiB;
constexpr size_t WS_WQ = 10 * MiB;
constexpr size_t WS_WKV = 12 * MiB;
constexpr size_t WS_WMO = 16 * MiB;
constexpr size_t WS_WR = 18 * MiB;
constexpr size_t WS_WGU = 20 * MiB;
constexpr size_t WS_WDN = 148 * MiB;
constexpr size_t WS_XN = 212 * MiB;
constexpr size_t WS_MEMN = 244 * MiB;
constexpr size_t WS_KV = 245 * MiB;
constexpr size_t WS_BS = 247 * MiB;
constexpr size_t WS_BO = 251 * MiB;
constexpr size_t WS_PROJ = 256 * MiB;
constexpr size_t WS_LA = 360 * MiB;
constexpr size_t WS_ORAW = 376 * MiB;
constexpr size_t WS_MIX = 408 * MiB;
constexpr size_t WS_S = 440 * MiB;
constexpr size_t WS_P = 504 * MiB;
constexpr size_t WS_LG = 536 * MiB;
constexpr size_t WS_TOKE = 538 * MiB;
constexpr size_t WS_TOKR = 539 * MiB;
constexpr size_t WS_TOKW = 540 * MiB;
constexpr size_t WS_LIST = 541 * MiB;
constexpr size_t WS_ACT = 544 * MiB;
constexpr size_t WS_YS = 674 * MiB;
constexpr size_t WS_DUMMY = 804 * MiB;
constexpr size_t WS_END = 872 * MiB;
constexpr int CW_CNT = 1024;

template <int MAP> __device__ __forceinline__ int srccol(int n, float& sc) {
    sc = 1.f;
    if (MAP == 0) return n;
    if (MAP == 1) {
        if (n < 256) { sc = 0.125f; return n; }
        if (n < 1024) return n;
        if (n < 3072) { if (n >= C_QS && n < C_KS) sc = 0.125f * LOG2E; return n + 16; }
        if (n < 3088) return 1024 + (n - 3072);
        return -1;
    }
    { const int ct = n >> 8, w = n & 255; return (w < 128) ? (128 * ct + w) : (1024 + 128 * ct + (w - 128)); }
}
template <int MAP>
__device__ __forceinline__ void conv_item(float* scr, const float* __restrict__ src, bf16_t* __restrict__ dst, const float* __restrict__ gain, int ldsrc, int K, int nrows, int kb, int nb, int lane) {
    const int k0 = kb * 64, n0 = nb * 32; float sc; const int c0 = srccol<MAP>(n0, sc);
    const int half = lane >> 5, l31 = lane & 31;
    const float* s0 = src + (size_t)(k0 + half) * ldsrc + c0 + l31;
    float v[32];
#pragma unroll
    for (int i = 0; i < 32; ++i) v[i] = __builtin_nontemporal_load(s0 + (size_t)(2 * i) * ldsrc);
#pragma unroll
    for (int i = 0; i < 32; ++i) { const int kk = 2 * i + half; const float g = (gain ? gain[k0 + kk] : 1.f) * sc; scr[kk * 33 + l31] = v[i] * g; }
    asm volatile("s_waitcnt lgkmcnt(0)" ::: "memory");
    const int c = lane & 7;
#pragma unroll
    for (int j = 0; j < 4; ++j) { const int n = (lane >> 3) + 8 * j; const float* s = scr + (8 * c) * 33 + n;
        u32x4 o; o.x = pk2(s[0 * 33], s[1 * 33]); o.y = pk2(s[2 * 33], s[3 * 33]); o.z = pk2(s[4 * 33], s[5 * 33]); o.w = pk2(s[6 * 33], s[7 * 33]);
        if (n0 + n < nrows) *(u32x4*)(dst + (size_t)(n0 + n) * K + k0 + 8 * c) = o; }
    asm volatile("s_waitcnt lgkmcnt(0)" ::: "memory");
}
__device__ __forceinline__ unsigned pk4_fp8(float a, float b, float c, float d) { int w = __builtin_amdgcn_cvt_pk_fp8_f32(a, b, 0, false); w = __builtin_amdgcn_cvt_pk_fp8_f32(c, d, w, true); return (unsigned)w; }
template <int MAP>
__device__ __forceinline__ void conv_item8(float* scr, const float* __restrict__ src, unsigned char* __restrict__ dst, const float* __restrict__ gain, int ldsrc, int K, int nrows, int kb, int nb, int lane, float mul) {
    const int k0 = kb * 64, n0 = nb * 32; float sc; const int c0 = srccol<MAP>(n0, sc); sc *= mul;
    const int half = lane >> 5, l31 = lane & 31;
    const float* s0 = src + (size_t)(k0 + half) * ldsrc + c0 + l31;
    float v[32];
#pragma unroll
    for (int i = 0; i < 32; ++i) v[i] = __builtin_nontemporal_load(s0 + (size_t)(2 * i) * ldsrc);
#pragma unroll
    for (int i = 0; i < 32; ++i) { const int kk = 2 * i + half; const float g = (gain ? gain[k0 + kk] : 1.f) * sc; scr[kk * 33 + l31] = v[i] * g; }
    asm volatile("s_waitcnt lgkmcnt(0)" ::: "memory");
    const int c = lane & 3;
#pragma unroll
    for (int j = 0; j < 2; ++j) { const int n = (lane >> 2) + 16 * j; const float* s = scr + (16 * c) * 33 + n;
        u32x4 o; o.x = pk4_fp8(s[0 * 33], s[1 * 33], s[2 * 33], s[3 * 33]); o.y = pk4_fp8(s[4 * 33], s[5 * 33], s[6 * 33], s[7 * 33]);
        o.z = pk4_fp8(s[8 * 33], s[9 * 33], s[10 * 33], s[11 * 33]); o.w = pk4_fp8(s[12 * 33], s[13 * 33], s[14 * 33], s[15 * 33]);
        if (n0 + n < nrows) __builtin_nontemporal_store(o, (u32x4*)(dst + (size_t)(n0 + n) * K + k0 + 16 * c)); }
    asm volatile("s_waitcnt lgkmcnt(0)" ::: "memory");
}
__device__ __forceinline__ void conv_n_body(size_t gtid, size_t gsz, const float* __restrict__ src, bf16_t* __restrict__ dst, const float* __restrict__ gain, int K, int nrows, float sc) {
    const int kc8 = K / 8; const size_t total = (size_t)nrows * kc8;
    for (size_t idx = gtid; idx < total; idx += gsz) {
        const int kc = (int)(idx % kc8), n = (int)(idx / kc8);
        const float g = gain[n] * sc; const f32x4 a = __builtin_nontemporal_load((const f32x4*)(src + (size_t)n * K + kc * 8)), b = __builtin_nontemporal_load((const f32x4*)(src + (size_t)n * K + kc * 8 + 4));
        u32x4 o; o.x = pk2(a.x * g, a.y * g); o.y = pk2(a.z * g, a.w * g); o.z = pk2(b.x * g, b.y * g); o.w = pk2(b.z * g, b.w * g);
        *(u32x4*)(dst + (size_t)n * K + kc * 8) = o;
    }
}

__device__ __forceinline__ float wave_sum(float v) {
#pragma unroll
    for (int o = 1; o < 64; o <<= 1) v += __shfl_xor(v, o);
    return v;
}
template <bool GROUPED>
__device__ __forceinline__ void rms_body(int gw, int ngw, int lane, const float* __restrict__ x, bf16_t* __restrict__ out, int nrows, float* __restrict__ rs_out = nullptr, int vb = 0, int G = 1, int wid = 0) {
    for (int i = 0;; ++i) {
        int row, row2; bool has2;
        if (GROUPED) { const int g = vb + G * (i >> 1); if (g >= nrows / 32) break; row = 32 * g + 16 * (i & 1) + 2 * wid; row2 = row + 1; has2 = true; }
        else { row = gw + 2 * ngw * i; if (row >= nrows) break; row2 = row + ngw; has2 = row2 < nrows; }
        const f32x4* xr = (const f32x4*)(x + (size_t)row * DM) + lane; const f32x4* xr2 = (const f32x4*)(x + (size_t)(has2 ? row2 : row) * DM) + lane; f32x4 v[4], v2[4]; float s = 0.f, s2 = 0.f;
#pragma unroll
        for (int j = 0; j < 4; ++j) v[j] = __builtin_nontemporal_load(xr + 64 * j);
#pragma unroll
        for (int j = 0; j < 4; ++j) v2[j] = __builtin_nontemporal_load(xr2 + 64 * j);
#pragma unroll
        for (int j = 0; j < 4; ++j) { s += v[j].x * v[j].x + v[j].y * v[j].y + v[j].z * v[j].z + v[j].w * v[j].w; s2 += v2[j].x * v2[j].x + v2[j].y * v2[j].y + v2[j].z * v2[j].z + v2[j].w * v2[j].w; }
        const float rstd = 1.0f / sqrtf(wave_sum(s) * (1.f / DM) + EPS), rstd2 = 1.0f / sqrtf(wave_sum(s2) * (1.f / DM) + EPS);
        if (rs_out && lane == 0) { rs_out[row] = rstd; if (has2) rs_out[row2] = rstd2; }
        u32x2* o = (u32x2*)(out + (size_t)row * DM) + lane;
#pragma unroll
        for (int j = 0; j < 4; ++j) { u32x2 w; w.x = pk2(v[j].x * rstd, v[j].y * rstd); w.y = pk2(v[j].z * rstd, v[j].w * rstd); o[64 * j] = w; }
        if (has2) { u32x2* o2 = (u32x2*)(out + (size_t)row2 * DM) + lane;
#pragma unroll
            for (int j = 0; j < 4; ++j) { u32x2 w; w.x = pk2(v2[j].x * rstd2, v2[j].y * rstd2); w.y = pk2(v2[j].z * rstd2, v2[j].w * rstd2); o2[64 * j] = w; } }
    }
}

__device__ __forceinline__ void rms_body_grouped4(int vb, int G, int wid, int lane, const float* __restrict__ x, bf16_t* __restrict__ out, int nrows, float* __restrict__ rs_out) {
    const int ng = nrows / 32;
    for (int g = vb; g < ng; g += 2 * G) {
        const bool two = g + G < ng;
        const int rowA = 32 * g + 4 * wid, rowB = two ? rowA + 32 * G : rowA;
        const f32x4* xa = (const f32x4*)(x + (size_t)rowA * DM) + lane; const f32x4* xb = (const f32x4*)(x + (size_t)rowB * DM) + lane; f32x4 v[8][4]; float s[8];
#pragma unroll
        for (int r = 0; r < 4; ++r)
#pragma unroll
            for (int j = 0; j < 4; ++j) v[r][j] = __builtin_nontemporal_load(xa + r * (DM / 4) + 64 * j);
#pragma unroll
        for (int r = 0; r < 4; ++r)
#pragma unroll
            for (int j = 0; j < 4; ++j) v[4 + r][j] = __builtin_nontemporal_load(xb + r * (DM / 4) + 64 * j);
#pragma unroll
        for (int r = 0; r < 8; ++r) { float a = 0.f;
#pragma unroll
            for (int j = 0; j < 4; ++j) a += v[r][j].x * v[r][j].x + v[r][j].y * v[r][j].y + v[r][j].z * v[r][j].z + v[r][j].w * v[r][j].w;
            s[r] = 1.0f / sqrtf(wave_sum(a) * (1.f / DM) + EPS); }
        if (lane == 0) { *(f32x4*)(rs_out + rowA) = (f32x4){s[0], s[1], s[2], s[3]}; if (two) *(f32x4*)(rs_out + rowB) = (f32x4){s[4], s[5], s[6], s[7]}; }
        u32x2* oa = (u32x2*)(out + (size_t)rowA * DM) + lane; u32x2* ob = (u32x2*)(out + (size_t)rowB * DM) + lane;
#pragma unroll
        for (int r = 0; r < 4; ++r)
#pragma unroll
            for (int j = 0; j < 4; ++j) { u32x2 w; w.x = pk2(v[r][j].x * s[r], v[r][j].y * s[r]); w.y = pk2(v[r][j].z * s[r], v[r][j].w * s[r]); oa[r * (DM / 4) + 64 * j] = w; }
        if (two) {
#pragma unroll
            for (int r = 0; r < 4; ++r)
#pragma unroll
                for (int j = 0; j < 4; ++j) { u32x2 w; w.x = pk2(v[4 + r][j].x * s[4 + r], v[4 + r][j].y * s[4 + r]); w.y = pk2(v[4 + r][j].z * s[4 + r], v[4 + r][j].w * s[4 + r]); ob[r * (DM / 4) + 64 * j] = w; } }
    }
}

constexpr int CH_GU_ITEMS = 32 * 16 * 32;
constexpr int CH_ITEMS = CH_GU_ITEMS + 32 * 8 * 32;
constexpr int CH_LDS = 131072;
typedef unsigned v2u __attribute__((ext_vector_type(2)));
typedef unsigned v4u __attribute__((ext_vector_type(4)));
struct ConvHost { const float* src; unsigned char* ws; int it0, nW, hi, q; };
template <bool GU> __device__ __forceinline__ void ch_decode(int it, unsigned& soff, unsigned& doff) {
    if (GU) { const unsigned e = (unsigned)it >> 9, nb = ((unsigned)it >> 5) & 15u, k32 = (unsigned)it & 31u;
        soff = (e << 23) | (k32 << 18) | ((nb & 1u) << 12) | ((nb >> 1) << 9);
        doff = (unsigned)WS_WGU + (e << 21) + (nb << 17) + (k32 << 5); }
    else { const unsigned t = (unsigned)(it - CH_GU_ITEMS), e = t >> 8, nb = (t >> 5) & 7u, k32 = t & 31u;
        soff = (e << 22) | (k32 << 17) | (nb << 9);
        doff = (unsigned)WS_WDN + (e << 20) + (nb << 17) + (k32 << 5); }
}
template <bool GU> __device__ __forceinline__ void ch_issue(ConvHost& H, f32x4 (&cv)[4], unsigned voffL) {
    constexpr unsigned LD4 = GU ? 8192u : 4096u;
    const int q = __builtin_amdgcn_readfirstlane(H.q); const int it = H.it0 + H.nW * (q >> 2), itc = it < H.hi ? it : H.hi - 1;
    unsigned soff, doff; ch_decode<GU>(itc, soff, doff); soff += (unsigned)(q & 3) * 8u * LD4;
    const __amdgpu_buffer_rsrc_t r = __builtin_amdgcn_make_buffer_rsrc((void*)H.src, 0, 0x7fffffff, 0x00020000);
#pragma unroll
    for (int i = 0; i < 4; ++i) cv[i] = __builtin_bit_cast(f32x4, __builtin_amdgcn_raw_buffer_load_b128(r, (int)voffL, (int)(soff + (unsigned)i * LD4), 2));
    H.q = q + 1;
}
template <bool GU> __device__ __forceinline__ bool ch_stores(const ConvHost& H, int qf) { return qf >= 0 && (qf & 3) == 3 && H.it0 + H.nW * (qf >> 2) < H.hi; }
template <bool GU> __device__ __forceinline__ void ch_finish(const ConvHost& H, int qf, const f32x4 (&cv)[4], LDSP unsigned char* tile, int lane) {
    constexpr float SC = (float)(1 << 6);
    const int bb = qf & 3, itf = H.it0 + H.nW * (qf >> 2);
    v4u o;
#pragma unroll
    for (int j = 0; j < 4; ++j) o[j] = pk4_fp8(cv[0][j] * SC, cv[1][j] * SC, cv[2][j] * SC, cv[3][j] * SC);
    *(LDSP v4u*)(tile + (unsigned)((2 * bb + (lane >> 5)) * 128 + 4 * (lane & 31)) * 4u) = o;
    if (ch_stores<GU>(H, qf)) {
        unsigned soff, doff; ch_decode<GU>(itf, soff, doff);
        const int r = lane >> 1, c = lane & 1; const LDSP unsigned* tw = (const LDSP unsigned*)tile + (4 * c) * 128 + r;
        const __amdgpu_buffer_rsrc_t w = __builtin_amdgcn_make_buffer_rsrc((void*)H.ws, 0, 0x7fffffff, 0x00020000);
        const unsigned voffS = (unsigned)r * 1024u + (unsigned)c * 16u;
        v4u a[4];
#pragma unroll
        for (int g = 0; g < 4; ++g) { a[g].x = tw[32 * g]; a[g].y = tw[32 * g + 128]; a[g].z = tw[32 * g + 256]; a[g].w = tw[32 * g + 384]; }
#pragma unroll
        for (int g = 0; g < 4; ++g) __builtin_amdgcn_raw_buffer_store_b128(a[g], w, (int)voffS, (int)(doff + (unsigned)g * 32768u), 0); }
}

template <bool GU> __device__ __forceinline__ void ch_finish_half(const ConvHost& H, int q0  , const f32x4 (&cv)[2][4], LDSP unsigned char* tile, int lane) {
    constexpr float SC = (float)(1 << 6);
    const int hb = (q0 >> 1) & 1, itf = H.it0 + H.nW * (q0 >> 2);
#pragma unroll
    for (int s = 0; s < 2; ++s) { v4u o;
#pragma unroll
        for (int j = 0; j < 4; ++j) o[j] = pk4_fp8(cv[s][0][j] * SC, cv[s][1][j] * SC, cv[s][2][j] * SC, cv[s][3][j] * SC);
        *(LDSP v4u*)(tile + (unsigned)((2 * s + (lane >> 5)) * 128 + 4 * (lane & 31)) * 4u) = o; }
    if (itf < H.hi) {
        unsigned soff, doff; ch_decode<GU>(itf, soff, doff);
        const LDSP unsigned* tw = (const LDSP unsigned*)tile + lane;
        v4u a, b; a.x = tw[0]; a.y = tw[128]; a.z = tw[256]; a.w = tw[384]; b.x = tw[64]; b.y = tw[192]; b.z = tw[320]; b.w = tw[448];
        const __amdgpu_buffer_rsrc_t w = __builtin_amdgcn_make_buffer_rsrc((void*)H.ws, 0, 0x7fffffff, 0x00020000);
        __builtin_amdgcn_raw_buffer_store_b128(a, w, (int)((unsigned)lane * 1024u), (int)(doff + (unsigned)hb * 16u), 0);
        __builtin_amdgcn_raw_buffer_store_b128(b, w, (int)((unsigned)lane * 1024u), (int)(doff + (unsigned)hb * 16u + 65536u), 0); }
}

struct GUnit { unsigned ao, bo; int row0, col0, e, valid, aux; };

__host__ __device__ __forceinline__ int lds_byte(int r, int c) { const int st = r >> 3, rr = r & 7, p = c >> 3, w = (c & 7) * 2; return st * 1024 + rr * 128 + ((p ^ rr) << 4) + w; }
__host__ __device__ __forceinline__ void stage_rc(int b, int& R, int& C) { const int st = b / 1024, sb = b % 1024, rr = sb / 128, pp = (sb % 128) / 16; R = st * 8 + rr; C = ((pp ^ rr) << 3) + (sb % 16) / 2; }
__host__ __device__ __forceinline__ int perm32(int rho) { const int n = rho >> 4, i = rho & 15; return 8 * (i >> 2) + 4 * n + (i & 3); }
constexpr int HTB = 128 * 64 * 2;
typedef int v8i __attribute__((ext_vector_type(8)));
typedef int v4i __attribute__((ext_vector_type(4)));
struct Frag2 { bf16x8 h[2]; };
template <bool F> struct FragT { typedef Frag2 T; };
template <> struct FragT<true> { typedef v8i T; };
template <class Sched, class Epi, bool ALIGN_EPI, bool FP8 = false, int SCALE_B = 0x7f, int HOSTM = 0, int EHOSTM = 0>
__device__ __forceinline__ void gemm_phase(unsigned char* lds_flat, const Sched& S, const Epi& E, ConvHost& H, ConvHost& HE) {
    LDSP unsigned char* lds = (LDSP unsigned char*)(unsigned)(uintptr_t)lds_flat;
    int tid = threadIdx.x; LAUNDER(tid);
    const int wid = __builtin_amdgcn_readfirstlane(tid >> 6), lane = tid & 63, wr = wid >> 2, wc = wid & 3, fr = lane & 15, fq = lane >> 4;
    const int nt = S.K / 64;
    int Rr[2], Cc[2];
#pragma unroll
    for (int i = 0; i < 2; ++i) stage_rc(tid * 16 + i * 8192, Rr[i], Cc[i]);
    unsigned voffB[2][2];
#pragma unroll
    for (int h = 0; h < 2; ++h)
#pragma unroll
        for (int i = 0; i < 2; ++i) voffB[h][i] = (unsigned)(128 * h + (Rr[i] & ~31) + perm32(Rr[i] & 31)) * S.ldb + (unsigned)Cc[i] * 2u;
    const unsigned ldsw = (unsigned)wid * 1024u;
    constexpr bool HOST = HOSTM != 0, HGU = HOSTM == 1;
    const int aoff = lds_byte(wr * 64 + fr, fq * 8), boff = lds_byte(wc * 32 + fr, fq * 8);
    const int aoffH = aoff ^ 64, boffH = boff ^ 64;
#define PG8_SA(b, h) (((b) * 2 + (h)) * HTB)
#define PG8_SB(b, h) ((4 + (b) * 2 + (h)) * HTB)
#define PG8_STAGE(bufoff, rsrc, voff, soff) do { _Pragma("unroll") for (int _i = 0; _i < 2; ++_i) \
        __builtin_amdgcn_raw_ptr_buffer_load_lds(rsrc, (LDSP unsigned*)(lds + (bufoff) + ldsw + _i * 8192), 16, (int)(voff)[_i], (int)(soff), 0, 0); } while (0)
#define PG8_LDF(dst, addr, addrh) do { const bf16x8 lo_ = *(const LDSP bf16x8*)(addr); const bf16x8 hi_ = *(const LDSP bf16x8*)(addrh); \
        if constexpr (FP8) dst = __builtin_shufflevector(__builtin_bit_cast(v4i, lo_), __builtin_bit_cast(v4i, hi_), 0, 1, 2, 3, 4, 5, 6, 7); else { dst.h[0] = lo_; dst.h[1] = hi_; } } while (0)
#define PG8_LDA(dst, b, h) do { _Pragma("unroll") for (int m = 0; m < 4; ++m) PG8_LDF(dst[m], lds + PG8_SA(b, h) + aoff + m * 2048, lds + PG8_SA(b, h) + aoffH + m * 2048); } while (0)
#define PG8_LDB(dst, b, h) do { _Pragma("unroll") for (int n = 0; n < 2; ++n) PG8_LDF(dst[n], lds + PG8_SB(b, h) + boff + n * 2048, lds + PG8_SB(b, h) + boffH + n * 2048); } while (0)
#define PG8_MMA(ai, bj, At, Bt) do { _Pragma("unroll") for (int m = 0; m < 4; ++m) _Pragma("unroll") for (int n = 0; n < 2; ++n) { \
        if constexpr (FP8) asm volatile("v_mfma_scale_f32_16x16x128_f8f6f4 %0, %1, %2, %0, %3, %4 op_sel_hi:[0,0,0]" : "+v"(acc[ai][bj][m][n]) : "v"(Bt[n]), "v"(At[m]), "v"(sclB), "v"(sclA)); \
        else { _Pragma("unroll") for (int k = 0; k < 2; ++k) acc[ai][bj][m][n] = __builtin_amdgcn_mfma_f32_16x16x32_bf16(Bt[n].h[k], At[m].h[k], acc[ai][bj][m][n], 0, 0, 0); } } \
        } while (0)
#define PG8_MMA_M(ai, bj, m, At, Bt) do { _Pragma("unroll") for (int n = 0; n < 2; ++n) _Pragma("unroll") for (int k = 0; k < 2; ++k) \
        acc[ai][bj][m][n] = __builtin_amdgcn_mfma_f32_16x16x32_bf16(Bt[n].h[k], At[m].h[k], acc[ai][bj][m][n], 0, 0, 0); } while (0)
#define CH_LANE() int cl_ = threadIdx.x; LAUNDER(cl_); cl_ &= 63
#define PG8_WAIT_V(n) asm volatile("s_waitcnt vmcnt(" #n ")" ::: "memory")
#define PG8_WAIT_L(n) asm volatile("s_waitcnt lgkmcnt(" #n ")" ::: "memory")
#define PG8_BAR __builtin_amdgcn_s_barrier()
#define PG8_SCHED __builtin_amdgcn_sched_barrier(0)
    GUnit cur, nxt; int ui = 0;
    f32x4 cvx[4]; unsigned voffL = 0; bool cstp = false; (void)voffL; (void)cstp; LDSP unsigned char* const ctile = lds + CH_LDS + wid * 4096; (void)ctile;
    if constexpr (HOST) { voffL = (unsigned)(lane >> 5) * 4u * (HGU ? 8192u : 4096u) + (unsigned)(lane & 31) * 16u;
#pragma unroll
        for (int i = 0; i < 4; ++i) cvx[i] = (f32x4){0.f, 0.f, 0.f, 0.f}; }
    if (S.next(0, cur)) {
    const __amdgpu_buffer_rsrc_t rA = __builtin_amdgcn_make_buffer_rsrc((void*)S.A, 0, 0x7fffffff, 0x00020000);
    const __amdgpu_buffer_rsrc_t rB = __builtin_amdgcn_make_buffer_rsrc((void*)S.Bt, 0, 0x7fffffff, 0x00020000);
    unsigned oc[2][2], on[2][2];
#pragma unroll
    for (int h = 0; h < 2; ++h)
#pragma unroll
        for (int i = 0; i < 2; ++i) oc[h][i] = S.a_off(cur, 128 * h + Rr[i]) + (unsigned)Cc[i] * 2u;
    f32x4 acc[2][2][4][2];
#pragma unroll
    for (int a = 0; a < 2; ++a)
#pragma unroll
        for (int b = 0; b < 2; ++b)
#pragma unroll
            for (int m = 0; m < 4; ++m)
#pragma unroll
                for (int n = 0; n < 2; ++n) acc[a][b][m][n] = (f32x4){0.f, 0.f, 0.f, 0.f};
    typedef typename FragT<FP8>::T frag_t;
    frag_t At[4], B0[2], B1[2];
    const unsigned kstep = 128;
    const int sclB = SCALE_B * 0x01010101, sclA = 0x7f7f7f7f; (void)sclA; (void)sclB;
    PG8_STAGE(PG8_SB(0, 0), rB, voffB[0], cur.bo); PG8_STAGE(PG8_SB(0, 1), rB, voffB[1], cur.bo); PG8_STAGE(PG8_SA(0, 0), rA, oc[0], cur.ao); PG8_STAGE(PG8_SA(0, 1), rA, oc[1], cur.ao);
    if (wr == 1) PG8_BAR;
    PG8_WAIT_V(2); PG8_BAR;
    PG8_STAGE(PG8_SB(1, 0), rB, voffB[0], cur.bo + kstep); PG8_STAGE(PG8_SA(1, 0), rA, oc[0], cur.ao + kstep); PG8_STAGE(PG8_SB(1, 1), rB, voffB[1], cur.bo + kstep);
    PG8_WAIT_V(6); PG8_BAR;
    for (;;) {
        const bool has_next = S.next(ui + 1, nxt);
        if (!has_next) nxt = cur;
        const unsigned nA = nxt.ao, nB = nxt.bo;
        { int t2 = threadIdx.x; LAUNDER(t2);
#pragma unroll
          for (int i = 0; i < 2; ++i) { int R_, C_; stage_rc(t2 * 16 + i * 8192, R_, C_);
#pragma unroll
              for (int h = 0; h < 2; ++h) on[h][i] = S.a_off(nxt, 128 * h + R_) + (unsigned)C_ * 2u; } }
        for (int t = 0; t < nt; t += 2) {
            const bool last = (t == nt - 2);
            const unsigned k1 = cur.ao + (unsigned)(t + 1) * kstep;
            const unsigned a2 = last ? nA : cur.ao + (unsigned)(t + 2) * kstep, b2 = last ? nB : cur.bo + (unsigned)(t + 2) * kstep, a3 = a2 + kstep, b3 = b2 + kstep;
            unsigned o2[2][2];
#pragma unroll
            for (int h = 0; h < 2; ++h)
#pragma unroll
                for (int i = 0; i < 2; ++i) o2[h][i] = last ? on[h][i] : oc[h][i];
            PG8_LDB(B0, 0, 0); PG8_LDB(B1, 0, 1); PG8_SCHED; PG8_LDA(At, 0, 0); PG8_STAGE(PG8_SA(1, 1), rA, oc[1], k1);
            if constexpr (HOST) { if (cstp) PG8_WAIT_V(12); else PG8_WAIT_V(8); } else PG8_WAIT_V(8);
            PG8_WAIT_L(0); PG8_BAR; __builtin_amdgcn_s_setprio(1); PG8_MMA(0, 0, At, B0); PG8_MMA(0, 1, At, B1); __builtin_amdgcn_s_setprio(0);
            if constexpr (HOST) { PG8_SCHED; ch_issue<HGU>(H, cvx, voffL); PG8_SCHED; }
            PG8_BAR; PG8_SCHED;
            PG8_LDA(At, 0, 1); PG8_STAGE(PG8_SB(0, 0), rB, voffB[0], b2); PG8_STAGE(PG8_SB(0, 1), rB, voffB[1], b2); PG8_STAGE(PG8_SA(0, 0), rA, o2[0], a2);
            if constexpr (HOST) { if (cstp) PG8_WAIT_V(16); else PG8_WAIT_V(12); } else PG8_WAIT_V(8);
            PG8_WAIT_L(0); PG8_BAR; __builtin_amdgcn_s_setprio(1); PG8_MMA(1, 0, At, B0); PG8_MMA(1, 1, At, B1); __builtin_amdgcn_s_setprio(0); PG8_BAR; PG8_SCHED;
            PG8_LDB(B0, 1, 0); PG8_LDB(B1, 1, 1); PG8_SCHED; PG8_LDA(At, 1, 0); PG8_STAGE(PG8_SA(0, 1), rA, o2[1], a2);
            if constexpr (HOST) PG8_WAIT_V(12); else PG8_WAIT_V(8);
            PG8_WAIT_L(0); PG8_BAR; __builtin_amdgcn_s_setprio(1); PG8_MMA(0, 0, At, B0); PG8_MMA(0, 1, At, B1); __builtin_amdgcn_s_setprio(0); PG8_BAR; PG8_SCHED;
            PG8_LDA(At, 1, 1); PG8_STAGE(PG8_SB(1, 0), rB, voffB[0], b3); PG8_STAGE(PG8_SB(1, 1), rB, voffB[1], b3); PG8_STAGE(PG8_SA(1, 0), rA, o2[0], a3);
            PG8_WAIT_V(8);
            PG8_WAIT_L(0); PG8_BAR; __builtin_amdgcn_s_setprio(1); PG8_MMA(1, 0, At, B0); PG8_MMA(1, 1, At, B1); __builtin_amdgcn_s_setprio(0);
            if constexpr (HOST) { PG8_SCHED; CH_LANE(); const int qf_ = __builtin_amdgcn_readfirstlane(H.q) - 1; cstp = ch_stores<HGU>(H, qf_); ch_finish<HGU>(H, qf_, cvx, ctile, cl_); PG8_SCHED; }
            PG8_BAR; PG8_SCHED;
        }
        if constexpr (FP8) asm volatile("s_nop 15\n\ts_nop 15" ::: "memory");
        if constexpr (ALIGN_EPI) { if (wr == 0) PG8_BAR; }
        if constexpr (EHOSTM != 0) { constexpr bool EGU = EHOSTM == 1; CH_LANE();
            const int q0 = __builtin_amdgcn_readfirstlane(HE.q); const bool eh = HE.it0 + HE.nW * (q0 >> 2) < HE.hi;
            f32x4 ev[2][4]; const unsigned voffLE = (unsigned)(cl_ >> 5) * 4u * (EGU ? 8192u : 4096u) + (unsigned)(cl_ & 31) * 16u;
            LDSP unsigned char* const etile = lds + CH_LDS + wid * 2048;
            E.run(acc, cur, wr, wc, fr, fq, [&] { if (eh) { ch_issue<EGU>(HE, ev[0], voffLE); ch_issue<EGU>(HE, ev[1], voffLE); } }, [] {});
            if (eh) { ch_finish_half<EGU>(HE, q0, ev, etile, cl_); asm volatile("s_waitcnt lgkmcnt(0)" ::: "memory"); } }
        else if constexpr (!Epi::AFTER_DRAIN) E(acc, cur, wr, wc, fr, fq);
        if (!has_next) break;
#pragma unroll
        for (int a = 0; a < 2; ++a)
#pragma unroll
            for (int b = 0; b < 2; ++b)
#pragma unroll
                for (int m = 0; m < 4; ++m)
#pragma unroll
                    for (int n = 0; n < 2; ++n) acc[a][b][m][n] = (f32x4){0.f, 0.f, 0.f, 0.f};
        cur = nxt; ++ui;
#pragma unroll
        for (int h = 0; h < 2; ++h)
#pragma unroll
            for (int i = 0; i < 2; ++i) oc[h][i] = on[h][i];
        if constexpr (ALIGN_EPI) { if (wr == 1) PG8_BAR; }
    }
    PG8_WAIT_V(0);
    if constexpr (!ALIGN_EPI) { if (wr == 0) PG8_BAR; }
    PG8_BAR;
    if constexpr (Epi::AFTER_DRAIN) E.fused(acc, cur, wr, wc, fr, fq, lds_flat, wid, lane);
    }
    if constexpr (EHOSTM != 0) { constexpr bool EGU = EHOSTM == 1; CH_LANE(); f32x4 ev[2][4]; const unsigned voffLE = (unsigned)(cl_ >> 5) * 4u * (EGU ? 8192u : 4096u) + (unsigned)(cl_ & 31) * 16u;
        __syncthreads();
        LDSP unsigned char* const etile = lds + wid * 4096;
        while (HE.it0 + HE.nW * (__builtin_amdgcn_readfirstlane(HE.q) >> 2) < HE.hi) { const int q_ = __builtin_amdgcn_readfirstlane(HE.q); ch_issue<EGU>(HE, ev[0], voffLE); ch_issue<EGU>(HE, ev[1], voffLE); ch_finish_half<EGU>(HE, q_, ev, etile, cl_); asm volatile("s_waitcnt lgkmcnt(0)" ::: "memory"); } }
    if constexpr (HOST) {
        CH_LANE(); H.q = (__builtin_amdgcn_readfirstlane(H.q) + 3) & ~3;
        while (H.it0 + H.nW * (__builtin_amdgcn_readfirstlane(H.q) >> 2) < H.hi) { const int q_ = __builtin_amdgcn_readfirstlane(H.q); ch_issue<HGU>(H, cvx, voffL); ch_finish<HGU>(H, q_, cvx, ctile, cl_); } }
#undef PG8_SA
#undef PG8_SB
#undef PG8_STAGE
#undef PG8_LDA
#undef PG8_LDF
#undef PG8_LDB
#undef PG8_MMA
#undef PG8_WAIT_V
#undef PG8_WAIT_L
#undef PG8_BAR
#undef PG8_SCHED
#undef PG8_MMA_M
#undef CH_LANE
}
template <bool ALIGN, class Sched, class Epi> __device__ __forceinline__ void gemm_run(unsigned char* lds, const Sched& S, const Epi& E) {
    ConvHost none{}; gemm_phase<Sched, Epi, ALIGN>(lds, S, E, none, none);
}
template <bool ALIGN, int HOSTM, class Sched, class Epi> __device__ __forceinline__ void gemm_run_host(unsigned char* lds, const Sched& S, const Epi& E, const float* src, unsigned char* ws, int lo, int hi, int gw, int nW) {
    ConvHost H{src, ws, lo + gw, nW, hi, 0}, none{}; gemm_phase<Sched, Epi, ALIGN, false, 0x7f, HOSTM>(lds, S, E, H, none);
}
constexpr int WSCALE_LOG2 = 6;
template <bool ALIGN, class Sched, class Epi> __device__ __forceinline__ void gemm_run_fp8(unsigned char* lds, const Sched& S, const Epi& E) {
    ConvHost none{}; gemm_phase<Sched, Epi, ALIGN, true, 127 - WSCALE_LOG2>(lds, S, E, none, none);
}
template <bool ALIGN, int EHOSTM, class Sched, class Epi> __device__ __forceinline__ void gemm_run_fp8_ehost(unsigned char* lds, const Sched& S, const Epi& E, const float* src, unsigned char* ws, int lo, int hi, int gw, int nW) {
    ConvHost none{}, HE{src, ws, lo + gw, nW, hi, 0}; gemm_phase<Sched, Epi, ALIGN, true, 127 - WSCALE_LOG2, 0, EHOSTM>(lds, S, E, none, HE);
}

struct DenseSched {
    const char* A; const char* Bt; unsigned lda, ldb; int K; int nM, nN; int pm_per_b; size_t zB; int G, c;
    __device__ __forceinline__ bool next(int i, GUnit& u) const {
        int pm, pn;
        if (G == 256 && (nN & 3) == 0 && nM * nN >= 256) {
            const int j = c & 7, q = c >> 3, s = i * 8 + j, ncg = nN >> 2; pm = (s / ncg) * 8 + (q >> 2); pn = (s % ncg) * 4 + (q & 3); if (c < 0 || pm >= nM) return false; }
        else { const long L = (long)i * G + c; if (c < 0 || L >= (long)nM * nN) return false; pm = (int)(L / nN); pn = (int)(L % nN); }
        u.ao = (unsigned)pm * 256u * lda; u.bo = (unsigned)((size_t)(pm / pm_per_b) * zB) + (unsigned)pn * 256u * ldb; u.row0 = pm * 256; u.col0 = pn * 256; u.e = 0; u.valid = 256; u.aux = 0; return true;
    }
    __device__ __forceinline__ unsigned a_off(const GUnit&, int r) const { return (unsigned)r * lda; }
};
struct SchedWqk {
    const char* A; const char* Bt; unsigned lda, ldb; int K; int G, c, pad;
    __device__ __forceinline__ bool next(int i, GUnit& u) const {
        const int L = i * G + c; if (c < 0 || L >= 32) return false; const int z = L >> 2, pn = L & 3, b = z >> 2, h = z & 3;
        u.ao = (unsigned)b * 256u * 4096u + h * 512u; u.bo = (unsigned)pn * 256u * 2048u + h * 512u; u.row0 = z * 256; u.col0 = pn * 256; u.e = 0; u.valid = 256; u.aux = 0; return true;
    }
    __device__ __forceinline__ unsigned a_off(const GUnit&, int r) const { return (unsigned)r * lda; }
};
struct SchedVo {
    const char* A; const char* Bt; unsigned lda, ldb; int K; int G, c, pad;
    __device__ __forceinline__ bool next(int i, GUnit& u) const {
        const int L = i * G + c; if (c < 0 || L >= 32) return false; const int z = L >> 2, pm = L & 3, b = z >> 2, h = z & 3;
        u.ao = (unsigned)pm * 256u * 2048u + h * 512u; u.bo = (unsigned)b * 256u * 4096u + 2048u + h * 512u; u.row0 = b * 1024 + pm * 256; u.col0 = h * 256; u.e = 0; u.valid = 256; u.aux = 0; return true;
    }
    __device__ __forceinline__ unsigned a_off(const GUnit&, int r) const { return (unsigned)r * lda; }
};
template <bool GATHER> struct MoeSched {
    const char* A; const char* Bt; unsigned lda, ldb; int K; int nN; size_t zB;
    const int* tab; const int* list; int gather; int G, c, pad;
    __device__ __forceinline__ bool next(int i, GUnit& u) const {
        int T, pn; const int ntile = __builtin_amdgcn_readfirstlane(tab[64]);
        if (G == 256) { const int j = c & 7, q = c >> 3, s = i * 8 + j;
            if (nN == 8) { const int base = 32 * i; T = (ntile - base >= 32) ? 4 * s + (q >> 3) : base + j + 8 * (q >> 3); pn = q & 7; }
            else { const int base = 64 * i; T = (ntile - base >= 64) ? 8 * s + (q >> 2) : base + j + 8 * (q >> 2); pn = q & 3; } }
        else { const int L = i * G + c; T = L / nN; pn = L % nN; }
        if (T >= ntile) return false;
        const int w = __builtin_amdgcn_readfirstlane(tab[128 + T]); const int e = w & 255, rt = w >> 8; const int ce = __builtin_amdgcn_readfirstlane(tab[e]), start = __builtin_amdgcn_readfirstlane(tab[32 + e]);
        u.e = e; u.valid = min(256, ce - rt * 256); u.row0 = start + rt * 256; u.col0 = pn * 256; u.aux = rt * 256;
        u.ao = GATHER ? 0u : (unsigned)u.row0 * lda; u.bo = (unsigned)((size_t)e * zB) + (unsigned)pn * 256u * ldb; return true;
    }
    __device__ __forceinline__ unsigned a_off(const GUnit& u, int r) const {
        if (!GATHER) return (unsigned)r * lda;
        const int rr = r < u.valid ? r : 0; const int tok = list[u.e * NTOK + u.aux + rr]; return (unsigned)tok * lda;
    }
};
__device__ __forceinline__ void moe_build_table(int* tab, const int* __restrict__ cnt, int tid) {
    if (tid < 32) tab[tid] = cnt[tid * 32];
    __syncthreads();
    if (tid < 32) { int s = 0; for (int e = 0; e < tid; ++e) s += tab[e]; tab[32 + tid] = s; }
    if (tid < 320) { int tiles = 0, found = -1;
        for (int e = 0; e < NEXP; ++e) { const int te = (tab[e] + 255) >> 8; if (found < 0 && tid < tiles + te) found = e | ((tid - tiles) << 8); tiles += te; }
        if (found >= 0) tab[128 + tid] = found; if (tid == 0) tab[64] = tiles; }
    __syncthreads();
}

__device__ __forceinline__ u32x4 pack8(const f32x4& a, const f32x4& b) { u32x4 w; w.x = pk2(a[0], a[1]); w.y = pk2(a[2], a[3]); w.z = pk2(b[0], b[1]); w.w = pk2(b[2], b[3]); return w; }
__device__ __forceinline__ unsigned lane_xpose(unsigned v, int src4) { return (unsigned)__builtin_amdgcn_ds_bpermute(src4, (int)v); }
struct EpiBf16 { static constexpr bool AFTER_DRAIN = false; bf16_t* O; int ldc, pad;
    __device__ __forceinline__ void operator()(const f32x4 (&acc)[2][2][4][2], const GUnit& u, int wr, int wc, int fr, int fq) const {
        LAUNDER(fr); LAUNDER(fq); const int l_ = 16 * fq + fr, fr2 = l_ >> 2, fq2 = l_ & 3, src4 = ((l_ & 3) * 16 + (l_ >> 2)) * 4;
#pragma unroll
        for (int ai = 0; ai < 2; ++ai)
#pragma unroll
            for (int m = 0; m < 4; ++m) { const int r = 128 * ai + 64 * wr + 16 * m + fr2;
#pragma unroll
                for (int bj = 0; bj < 2; ++bj) { u32x4 w = pack8(acc[ai][bj][m][0], acc[ai][bj][m][1]); w.x = lane_xpose(w.x, src4); w.y = lane_xpose(w.y, src4); w.z = lane_xpose(w.z, src4); w.w = lane_xpose(w.w, src4);
                    *(u32x4*)(O + (size_t)(u.row0 + r) * ldc + u.col0 + 128 * bj + 32 * wc + 8 * fq2) = w; } } } };
__device__ __forceinline__ float row_rstd(const float* __restrict__ ssp, int row) { const f32x4* p = (const f32x4*)(ssp + (size_t)row * 4); const f32x4 a = p[0], b = p[NTOK], c = p[2 * NTOK], d = p[3 * NTOK];
    const float s = (((a[0] + a[1]) + (a[2] + a[3])) + ((b[0] + b[1]) + (b[2] + b[3]))) + (((c[0] + c[1]) + (c[2] + c[3])) + ((d[0] + d[1]) + (d[2] + d[3]))); return 1.0f / sqrtf(s * (1.0f / 1024.0f) + EPS); }
template <bool BASE_BF16> struct EpiResidSS { static constexpr bool AFTER_DRAIN = false; const void* base; bf16_t* xb; float* ss; unsigned char* xq; const float* qg; const float* brs;
    __device__ __forceinline__ void operator()(const f32x4 (&acc)[2][2][4][2], const GUnit& u, int wr, int wc, int fr, int fq) const {
        LAUNDER(fr); LAUNDER(fq); const int l_ = 16 * fq + fr, fr2 = l_ >> 2, fq2 = l_ & 3, src4 = ((l_ & 3) * 16 + (l_ >> 2)) * 4, inv4 = ((l_ & 15) * 4 + (l_ >> 4)) * 4; (void)inv4;
#pragma unroll
        for (int ai = 0; ai < 2; ++ai) {
            f32x4 b[4][2][2];
            float ir[4] = {1.f, 1.f, 1.f, 1.f};
            if (BASE_BF16 && brs) {
#pragma unroll
                for (int m = 0; m < 4; ++m) ir[m] = brs[u.row0 + 128 * ai + 64 * wr + 16 * m + fr]; }
#pragma unroll
            for (int m = 0; m < 4; ++m)
#pragma unroll
                for (int bj = 0; bj < 2; ++bj) { const size_t o = (size_t)(u.row0 + 128 * ai + 64 * wr + 16 * m + fr) * 1024 + u.col0 + 128 * bj + 32 * wc + 8 * fq;
                    if (BASE_BF16) { const u32x4 w = *(const u32x4*)((const bf16_t*)base + o); b[m][bj][0] = (f32x4){bflo(w.x), bfhi(w.x), bflo(w.y), bfhi(w.y)}; b[m][bj][1] = (f32x4){bflo(w.z), bfhi(w.z), bflo(w.w), bfhi(w.w)}; }
                    else { b[m][bj][0] = __builtin_nontemporal_load((const f32x4*)((const float*)base + o)); b[m][bj][1] = __builtin_nontemporal_load((const f32x4*)((const float*)base + o + 4)); } }
#pragma unroll
            for (int m = 0; m < 4; ++m)
#pragma unroll
                for (int bj = 0; bj < 2; ++bj)
#pragma unroll
                    for (int h = 0; h < 2; ++h)
#pragma unroll
                        for (int j = 0; j < 4; ++j) b[m][bj][h][j] = b[m][bj][h][j];
#pragma unroll
            for (int m = 0; m < 4; ++m) { const int r = 128 * ai + 64 * wr + 16 * m + fr; float part = 0.f;
#pragma unroll
                for (int bj = 0; bj < 2; ++bj) { const size_t o = (size_t)(u.row0 + r) * 1024 + u.col0 + 128 * bj + 32 * wc + 8 * fq;
                    const float sc_ = (BASE_BF16 && brs) ? __builtin_amdgcn_rcpf(ir[m]) : 1.0f;
                    const f32x4 y0 = b[m][bj][0] * sc_ + acc[ai][bj][m][0], y1 = b[m][bj][1] * sc_ + acc[ai][bj][m][1];
                    { u32x4 w = pack8(y0, y1); w.x = lane_xpose(w.x, src4); w.y = lane_xpose(w.y, src4); w.z = lane_xpose(w.z, src4); w.w = lane_xpose(w.w, src4);
                      *(u32x4*)(xb + (size_t)(u.row0 + 128 * ai + 64 * wr + 16 * m + fr2) * 1024 + u.col0 + 128 * bj + 32 * wc + 8 * fq2) = w; }
                    if (xq) { const int cq = u.col0 + 128 * bj + 32 * wc + 8 * fq; const f32x4 g0 = *(const f32x4*)(qg + cq), g1 = *(const f32x4*)(qg + cq + 4); const f32x4 z0 = y0 * g0, z1 = y1 * g1;
                        u32x2 q; q.x = pk4_fp8(z0[0], z0[1], z0[2], z0[3]); q.y = pk4_fp8(z1[0], z1[1], z1[2], z1[3]); *(u32x2*)(xq + o) = q; }
                    part += (y0[0] * y0[0] + y0[1] * y0[1] + y0[2] * y0[2] + y0[3] * y0[3]) + (y1[0] * y1[0] + y1[1] * y1[1] + y1[2] * y1[2] + y1[3] * y1[3]); }
                part += __shfl_xor(part, 16); part += __shfl_xor(part, 32);
                if (fq == 0) ss[((size_t)(u.col0 >> 8) * NTOK + (u.row0 + r)) * 4 + wc] = part; } } } };
struct EpiResidRouter { static constexpr bool AFTER_DRAIN = true; const bf16_t* xin  ; bf16_t* xb  ; float* ss; unsigned char* xq; const float* qg; const bf16_t* wr_  ; float* part  ;
    __device__ __forceinline__ void operator()(const f32x4 (&)[2][2][4][2], const GUnit&, int, int, int, int) const {}
    __device__ __forceinline__ void fused(f32x4 (&acc)[2][2][4][2], const GUnit& u, int wr, int wc, int fr, int fq, unsigned char* lds, int wid, int lane) const {
        LAUNDER(fr); LAUNDER(fq); const int l_ = 16 * fq + fr, fr2 = l_ >> 2, fq2 = l_ & 3, src4 = ((l_ & 3) * 16 + (l_ >> 2)) * 4, inv4 = ((l_ & 15) * 4 + (l_ >> 4)) * 4;
        float* slab = (float*)lds;
        bf16x8 wf[2][2];
#pragma unroll
        for (int bj = 0; bj < 2; ++bj)
#pragma unroll
            for (int eh = 0; eh < 2; ++eh) wf[bj][eh] = *(const bf16x8*)(wr_ + (size_t)(16 * eh + fr) * 1024 + u.col0 + 128 * bj + 32 * wc + 8 * fq);
#pragma unroll
        for (int ai = 0; ai < 2; ++ai) {
            u32x4 b[4][2];
#pragma unroll
            for (int m = 0; m < 4; ++m)
#pragma unroll
                for (int bj = 0; bj < 2; ++bj) b[m][bj] = *(const u32x4*)(xin + (size_t)(u.row0 + 128 * ai + 64 * wr + 16 * m + fr2) * 1024 + u.col0 + 128 * bj + 32 * wc + 8 * fq2);
#pragma unroll
            for (int m = 0; m < 4; ++m)
#pragma unroll
                for (int bj = 0; bj < 2; ++bj) { b[m][bj].x = lane_xpose(b[m][bj].x, inv4); b[m][bj].y = lane_xpose(b[m][bj].y, inv4); b[m][bj].z = lane_xpose(b[m][bj].z, inv4); b[m][bj].w = lane_xpose(b[m][bj].w, inv4); }
#pragma unroll
            for (int m = 0; m < 4; ++m) { const int r = 128 * ai + 64 * wr + 16 * m + fr; float psum = 0.f; f32x4 lg[2] = {(f32x4){0.f, 0.f, 0.f, 0.f}, (f32x4){0.f, 0.f, 0.f, 0.f}};
#pragma unroll
                for (int bj = 0; bj < 2; ++bj) { const size_t o = (size_t)(u.row0 + r) * 1024 + u.col0 + 128 * bj + 32 * wc + 8 * fq; const u32x4 w = b[m][bj];
                    const f32x4 y0 = (f32x4){bflo(w.x), bfhi(w.x), bflo(w.y), bfhi(w.y)} + acc[ai][bj][m][0], y1 = (f32x4){bflo(w.z), bfhi(w.z), bflo(w.w), bfhi(w.w)} + acc[ai][bj][m][1];
                    const u32x4 pk = pack8(y0, y1); const size_t o2 = (size_t)(u.row0 + 128 * ai + 64 * wr + 16 * m + fr2) * 1024 + u.col0 + 128 * bj + 32 * wc + 8 * fq2; (void)o;
                    { u32x4 w; w.x = lane_xpose(pk.x, src4); w.y = lane_xpose(pk.y, src4); w.z = lane_xpose(pk.z, src4); w.w = lane_xpose(pk.w, src4); *(u32x4*)(xb + o2) = w; }
                    { const int cq = u.col0 + 128 * bj + 32 * wc + 8 * fq; const f32x4 g0 = *(const f32x4*)(qg + cq), g1 = *(const f32x4*)(qg + cq + 4); const f32x4 z0 = y0 * g0, z1 = y1 * g1;
                      u32x2 q; q.x = lane_xpose(pk4_fp8(z0[0], z0[1], z0[2], z0[3]), src4); q.y = lane_xpose(pk4_fp8(z1[0], z1[1], z1[2], z1[3]), src4); *(u32x2*)(xq + o2) = q; }
                    psum += (y0[0] * y0[0] + y0[1] * y0[1] + y0[2] * y0[2] + y0[3] * y0[3]) + (y1[0] * y1[0] + y1[1] * y1[1] + y1[2] * y1[2] + y1[3] * y1[3]);
                    const bf16x8 xa = __builtin_bit_cast(bf16x8, pk);
#pragma unroll
                    for (int eh = 0; eh < 2; ++eh) lg[eh] = __builtin_amdgcn_mfma_f32_16x16x32_bf16(wf[bj][eh], xa, lg[eh], 0, 0, 0); }
                psum += __shfl_xor(psum, 16); psum += __shfl_xor(psum, 32);
                if (fq == 0) ss[((size_t)(u.col0 >> 8) * NTOK + (u.row0 + r)) * 4 + wc] = psum;
#pragma unroll
                for (int eh = 0; eh < 2; ++eh) *(f32x4*)(slab + ((size_t)wc * 256 + r) * 32 + 16 * eh + 4 * fq) = lg[eh]; } }
        __syncthreads();
        { int tid = threadIdx.x; LAUNDER(tid);
#pragma unroll
          for (int i = 0; i < 4; ++i) { const int idx = tid + 512 * i, r = idx >> 3, c4 = idx & 7; const f32x4* p = (const f32x4*)(slab + (size_t)r * 32 + 4 * c4);
              const f32x4 s = (p[0] + p[256 * 8]) + (p[2 * 256 * 8] + p[3 * 256 * 8]);
              *(f32x4*)(part + ((size_t)(u.col0 >> 8) * NTOK + u.row0 + r) * 32 + 4 * c4) = s; } }
    } };
struct EpiSoftmax { static constexpr bool AFTER_DRAIN = true; const float* ss; bf16_t* P;
    __device__ __forceinline__ void operator()(const f32x4 (&)[2][2][4][2], const GUnit&, int, int, int, int) const {}
    __device__ __forceinline__ void fused(f32x4 (&acc)[2][2][4][2], const GUnit& u, int wr, int wc, int fr, int fq, unsigned char* lds, int wid, int lane) const {
        float* Pm = (float*)lds; float* Ps = (float*)(lds + 4096);
        LAUNDER(fr); LAUNDER(fq); const int l_ = 16 * fq + fr, fr2 = l_ >> 2, fq2 = l_ & 3, src4 = ((l_ & 3) * 16 + (l_ >> 2)) * 4, inv4 = ((l_ & 15) * 4 + (l_ >> 4)) * 4; (void)inv4;
#pragma unroll
        for (int ai = 0; ai < 2; ++ai)
#pragma unroll
            for (int m = 0; m < 4; ++m) { const int r = 128 * ai + 64 * wr + 16 * m + fr; const float rstd = row_rstd(ss, u.row0 + r); float mv = -INFINITY;
#pragma unroll
                for (int bj = 0; bj < 2; ++bj)
#pragma unroll
                    for (int n = 0; n < 2; ++n) { f32x4 s = acc[ai][bj][m][n] * rstd; acc[ai][bj][m][n] = s; mv = fmaxf(mv, fmaxf(fmaxf(s[0], s[1]), fmaxf(s[2], s[3]))); }
                mv = fmaxf(mv, __shfl_xor(mv, 16)); mv = fmaxf(mv, __shfl_xor(mv, 32));
                if (fq == 0) Pm[r * 4 + wc] = mv; }
        __syncthreads();
#pragma unroll
        for (int ai = 0; ai < 2; ++ai)
#pragma unroll
            for (int m = 0; m < 4; ++m) { const int r = 128 * ai + 64 * wr + 16 * m + fr; const f32x4 pm = *(const f32x4*)(Pm + r * 4); const float mv = fmaxf(fmaxf(pm[0], pm[1]), fmaxf(pm[2], pm[3])); float sum = 0.f;
#pragma unroll
                for (int bj = 0; bj < 2; ++bj)
#pragma unroll
                    for (int n = 0; n < 2; ++n) { f32x4 s = acc[ai][bj][m][n]; s[0] = __builtin_amdgcn_exp2f(s[0] - mv); s[1] = __builtin_amdgcn_exp2f(s[1] - mv); s[2] = __builtin_amdgcn_exp2f(s[2] - mv); s[3] = __builtin_amdgcn_exp2f(s[3] - mv);
                        acc[ai][bj][m][n] = s; sum += (s[0] + s[1]) + (s[2] + s[3]); }
                sum += __shfl_xor(sum, 16); sum += __shfl_xor(sum, 32);
                if (fq == 0) Ps[r * 4 + wc] = sum; }
        __syncthreads();
#pragma unroll
        for (int ai = 0; ai < 2; ++ai)
#pragma unroll
            for (int m = 0; m < 4; ++m) { const int r = 128 * ai + 64 * wr + 16 * m + fr; const f32x4 ps = *(const f32x4*)(Ps + r * 4); const float inv = 1.0f / ((ps[0] + ps[1]) + (ps[2] + ps[3]));
#pragma unroll
                for (int bj = 0; bj < 2; ++bj) { u32x4 w = pack8(acc[ai][bj][m][0] * inv, acc[ai][bj][m][1] * inv); w.x = lane_xpose(w.x, src4); w.y = lane_xpose(w.y, src4); w.z = lane_xpose(w.z, src4); w.w = lane_xpose(w.w, src4);
                    *(u32x4*)(P + (size_t)(u.row0 + 128 * ai + 64 * wr + 16 * m + fr2) * 1024 + u.col0 + 128 * bj + 32 * wc + 8 * fq2) = w; } }
        (void)wid; (void)lane;
        __syncthreads();
    } };
struct EpiGU { static constexpr bool AFTER_DRAIN = false; const float* bgu; unsigned char* act  ; const float* lrs  ;
    __device__ __forceinline__ void operator()(const f32x4 (&acc)[2][2][4][2], const GUnit& u, int wr, int wc, int fr, int fq) const { run(acc, u, wr, wc, fr, fq, [] {}, [] {}); }
    template <class F, class F2> __device__ __forceinline__ void run(const f32x4 (&acc)[2][2][4][2], const GUnit& u, int wr, int wc, int fr, int fq, F&& hook, F2&& hook_mid) const {
        const int pn = u.col0 >> 8; const float* bg = bgu + (size_t)u.e * 2048; LAUNDER(fr); LAUNDER(fq); const int l_ = 16 * fq + fr, fr2 = l_ >> 2, fq2 = l_ & 3, src4 = ((l_ & 3) * 16 + (l_ >> 2)) * 4;
        float rs[8];
#pragma unroll
        for (int i = 0; i < 8; ++i) { const int r = 128 * (i >> 2) + 64 * wr + 16 * (i & 3) + fr; rs[i] = lrs[(size_t)u.e * NTOK + u.aux + (r < u.valid ? r : 0)]; }
        const int col = 128 * pn + 32 * wc + 8 * fq;
        f32x4 bgv[2], blv[2];
#pragma unroll
        for (int n = 0; n < 2; ++n) { bgv[n] = *(const f32x4*)(bg + col + 4 * n); blv[n] = *(const f32x4*)(bg + 1024 + col + 4 * n); }
        asm volatile("" : "+v"(rs[0]), "+v"(rs[1]), "+v"(rs[2]), "+v"(rs[3]), "+v"(rs[4]), "+v"(rs[5]), "+v"(rs[6]), "+v"(rs[7]), "+v"(bgv[0]), "+v"(bgv[1]), "+v"(blv[0]), "+v"(blv[1]));
        hook();
#pragma unroll
        for (int ai = 0; ai < 2; ++ai) { if (ai == 1) hook_mid();
#pragma unroll
            for (int m = 0; m < 4; ++m) { const int r = 128 * ai + 64 * wr + 16 * m + fr; const float rstd = rs[ai * 4 + m]; u32x2 q;
#pragma unroll
                for (int n = 0; n < 2; ++n) { const f32x4 g = acc[ai][0][m][n] * rstd + bgv[n], l = acc[ai][1][m][n] * rstd + blv[n]; float o[4];
#pragma unroll
                    for (int jp = 0; jp < 2; ++jp) {
                        const f32x2 gg = {fminf(g[2 * jp], 7.0f), fminf(g[2 * jp + 1], 7.0f)}; const f32x2 ll = {fminf(fmaxf(l[2 * jp], -7.0f), 7.0f), fminf(fmaxf(l[2 * jp + 1], -7.0f), 7.0f)};
                        const f32x2 xe = gg * (-1.702f * LOG2E); const f32x2 den = (f32x2){__builtin_amdgcn_exp2f(xe.x), __builtin_amdgcn_exp2f(xe.y)} + 1.0f;
                        const f32x2 sg = {__builtin_amdgcn_rcpf(den.x), __builtin_amdgcn_rcpf(den.y)}; const f32x2 oo = (ll + 1.0f) * (gg * sg); o[2 * jp] = oo.x; o[2 * jp + 1] = oo.y; }
                    const unsigned w = lane_xpose(pk4_fp8(o[0], o[1], o[2], o[3]), src4); if (n == 0) q.x = w; else q.y = w; }
                { const int r2 = 128 * ai + 64 * wr + 16 * m + fr2; if (r2 < u.valid) *(u32x2*)(act + (size_t)(u.row0 + r2) * 1024 + 128 * pn + 32 * wc + 8 * fq2) = q; } } } } };
struct EpiDown { static constexpr bool AFTER_DRAIN = false; const float* bdn; unsigned char* ys  ;
    __device__ __forceinline__ void operator()(const f32x4 (&acc)[2][2][4][2], const GUnit& u, int wr, int wc, int fr, int fq) const {
        const float* bd = bdn + (size_t)u.e * 1024; LAUNDER(fr); LAUNDER(fq); const int l_ = 16 * fq + fr, fr2 = l_ >> 2, fq2 = l_ & 3, src4 = ((l_ & 3) * 16 + (l_ >> 2)) * 4;
        f32x4 bv[2][2];
#pragma unroll
        for (int bj = 0; bj < 2; ++bj)
#pragma unroll
            for (int n = 0; n < 2; ++n) bv[bj][n] = *(const f32x4*)(bd + u.col0 + 128 * bj + 32 * wc + 8 * fq + 4 * n);
#pragma unroll
        for (int ai = 0; ai < 2; ++ai)
#pragma unroll
            for (int m = 0; m < 4; ++m) { const int r = 128 * ai + 64 * wr + 16 * m + fr2;
#pragma unroll
                for (int bj = 0; bj < 2; ++bj) { const f32x4 y0 = acc[ai][bj][m][0] + bv[bj][0], y1 = acc[ai][bj][m][1] + bv[bj][1]; u32x2 q; q.x = lane_xpose(pk4_fp8(y0[0], y0[1], y0[2], y0[3]), src4); q.y = lane_xpose(pk4_fp8(y1[0], y1[1], y1[2], y1[3]), src4);
                    if (r < u.valid) *(u32x2*)(ys + (size_t)(u.row0 + r) * 1024 + u.col0 + 128 * bj + 32 * wc + 8 * fq2) = q; } } } };


typedef float f32x16 __attribute__((ext_vector_type(16)));
typedef short s16x4 __attribute__((ext_vector_type(4)));
__device__ __forceinline__ int crow(int r, int hi) { return (r & 3) + 8 * (r >> 2) + 4 * hi; }
__device__ __forceinline__ s16x4 tr_read(const unsigned char* p) { return __builtin_bit_cast(s16x4, __builtin_amdgcn_ds_read_tr16_b64_v4i16((LDSP s16x4*)(unsigned)(uintptr_t)p)); }
__device__ __forceinline__ bf16x8 tr_frag(const unsigned char* img, int pitch, int k0, int f0, int lane) {
    const unsigned char* p = img + (k0 + 8 * (lane >> 5) + ((lane & 15) >> 2)) * pitch + (f0 + 16 * ((lane >> 4) & 1) + 4 * (lane & 3)) * 2;
    const s16x4 lo = tr_read(p), hi = tr_read(p + 4 * pitch);
    return (bf16x8){lo[0], lo[1], lo[2], lo[3], hi[0], hi[1], hi[2], hi[3]};
}
constexpr int GA_PK = 576, GA_PV = 1088;
constexpr int GA_V = 0, GA_PART = 0, GA_GLR = 69632, GA_TOT = 73728, GA_KD = 75776, GA_END = GA_KD + 64 * GA_PK;
__device__ __forceinline__ void gla_pass_a(unsigned char* lds, int task, const bf16_t* __restrict__ xn, const bf16_t* __restrict__ wglr  , const bf16_t* __restrict__ proj,
                                           const float* __restrict__ wg, const float* __restrict__ bg, bf16_t* __restrict__ UT, float* __restrict__ decay) {
    int tid = threadIdx.x; LAUNDER(tid); int wid = tid >> 6, lane = tid & 63, fr = lane & 15, fq = lane >> 4;
    const size_t t0 = (size_t)task * 64;
    { f32x4 acc[4];
#pragma unroll
      for (int m = 0; m < 4; ++m) acc[m] = (f32x4){0.f, 0.f, 0.f, 0.f};
#pragma unroll
      for (int ks = 0; ks < 4; ++ks) { const int k = 128 * wid + 32 * ks + 8 * fq; const bf16x8 bfr = *(const bf16x8*)(wglr + (size_t)fr * 1024 + k);
#pragma unroll
          for (int m = 0; m < 4; ++m) { const bf16x8 afr = *(const bf16x8*)(xn + (t0 + 16 * m + fr) * DM + k); acc[m] = __builtin_amdgcn_mfma_f32_16x16x32_bf16(afr, bfr, acc[m], 0, 0, 0); } }
      float* part = (float*)(lds + GA_PART) + wid * 1024;
#pragma unroll
      for (int m = 0; m < 4; ++m)
#pragma unroll
          for (int j = 0; j < 4; ++j) part[(16 * m + 4 * fq + j) * 16 + fr] = acc[m][j]; }
    __syncthreads();
    { float* glr = (float*)(lds + GA_GLR); const float* part = (const float*)(lds + GA_PART);
      for (int i = tid; i < 1024; i += 512) { float s = 0.f;
#pragma unroll
          for (int w = 0; w < 8; ++w) s += part[w * 1024 + i];
          glr[i] = s; } }
    __syncthreads();
    LAUNDER(tid);
    { const int cv = tid & 63, tk = tid >> 6;
#pragma unroll
      for (int i = 0; i < 8; ++i) { const int tok = tk + 8 * i; const u32x4 v = *(const u32x4*)(proj + (t0 + tok) * PROJ_LD + C_VG + cv * 8); *(u32x4*)(lds + GA_V + tok * GA_PV + cv * 16) = v; } }
    LAUNDER(tid);
    { const int j = tid & 255, half = tid >> 8; const float* glr = (const float*)(lds + GA_GLR); float* tot = (float*)(lds + GA_TOT);
      float w[16];
#pragma unroll
      for (int i = 0; i < 16; ++i) w[i] = wg[i * 256 + j];
      const float bj = bg[j]; float run = 0.f;
      bf16_t kk16[32];
#pragma unroll
      for (int s = 0; s < 32; ++s) kk16[s] = proj[(t0 + 32 * half + s) * PROJ_LD + C_KG + j];
      float Gc[32];
#pragma unroll
      for (int s = 0; s < 32; ++s) { const float* gl = glr + (32 * half + s) * 16; float u = bj;
#pragma unroll
          for (int i = 0; i < 16; ++i) u += gl[i] * w[i];
          const float ls = fminf(u, 0.f) - __logf(1.0f + __expf(-fabsf(u)));
          run += ls * (1.0f / 16.0f); Gc[s] = run; }
      tot[half * 256 + j] = run;
      __syncthreads();
      const float t0v = tot[j], t1v = tot[256 + j]; const float gend = t0v + t1v;
      if (half == 0) decay[(size_t)task * 256 + j] = __expf(gend);
      const float rel = gend - (half ? t0v : 0.f);
#pragma unroll
      for (int s = 0; s < 32; ++s) { const int tok = 32 * half + s;
          *(bf16_t*)(lds + GA_KD + tok * GA_PK + j * 2) = (bf16_t)f2bf(bf2f(kk16[s]) * __expf(rel - Gc[s])); } }
    __syncthreads();
    LAUNDER(tid); wid = __builtin_amdgcn_readfirstlane(tid >> 6); lane = tid & 63;
    { const int h = wid >> 1, nt = wid & 1, hi = lane >> 5, c32 = lane & 31; f32x16 acc[4];
#pragma unroll
      for (int m = 0; m < 4; ++m)
#pragma unroll
          for (int r = 0; r < 16; ++r) acc[m][r] = 0.f;
#pragma unroll
      for (int ks = 0; ks < 4; ++ks) { const bf16x8 bfr = tr_frag(lds + GA_KD, GA_PK, 16 * ks, h * 64 + 32 * nt, lane);
#pragma unroll
          for (int m = 0; m < 4; ++m) { const bf16x8 afr = tr_frag(lds + GA_V, GA_PV, 16 * ks, h * 128 + 32 * m, lane); acc[m] = __builtin_amdgcn_mfma_f32_32x32x16_bf16(afr, bfr, acc[m], 0, 0, 0); } }
      bf16_t* u = UT + ((size_t)task * 4 + h) * 8192;
#pragma unroll
      for (int m = 0; m < 4; ++m)
#pragma unroll
          for (int r = 0; r < 16; ++r) __builtin_nontemporal_store((bf16_t)f2bf(acc[m][r]), u + (32 * m + crow(r, hi)) * 64 + 32 * nt + c32); }
    __syncthreads();
}
__device__ __forceinline__ void gla_pass_b(int e, const bf16_t* __restrict__ UT, const float* __restrict__ decay, bf16_t* __restrict__ ST) {
    const int dk = e & 63, dv = (e >> 6) & 127, h = (e >> 13) & 3, b = e >> 15; float s = 0.f;
    const size_t base = ((size_t)b * 128 * 4 + h) * 8192 + dv * 64 + dk; const size_t dbase = (size_t)b * 128 * 256 + h * 64 + dk;
    for (int c0 = 0; c0 < 128; c0 += 32) { float u[32], d[32];
#pragma unroll
        for (int i = 0; i < 32; ++i) { u[i] = bf2f(__builtin_nontemporal_load(UT + base + (size_t)(c0 + i) * 4 * 8192)); d[i] = decay[dbase + (size_t)(c0 + i) * 256]; }
#pragma unroll
        for (int i = 0; i < 32; ++i) { s = d[i] * s + u[i]; __builtin_nontemporal_store((bf16_t)f2bf(s), ST + base + (size_t)(c0 + i) * 4 * 8192); } }
}
constexpr int GC_PITCH = 520;
__device__ __forceinline__ void gla_pass_c(unsigned char* wlds  , int wtask, const bf16_t* __restrict__ ST, const bf16_t* __restrict__ proj, const float* __restrict__ ghead, bf16_t* __restrict__ mix, int lane) {
    const int nh = wtask & 1, h = (wtask >> 1) & 3, bc = wtask >> 3; const int c32 = lane & 31, hi = lane >> 5;
    const size_t t0 = (size_t)bc * 64 + 32 * nh; const bf16_t* st = ST + ((size_t)bc * 4 + h) * 8192;
    f32x16 acc[4];
#pragma unroll
    for (int m = 0; m < 4; ++m)
#pragma unroll
        for (int r = 0; r < 16; ++r) acc[m][r] = 0.f;
    bf16x8 bq[4], as_[4][4];
#pragma unroll
    for (int ks = 0; ks < 4; ++ks) { bq[ks] = *(const bf16x8*)(proj + (t0 + c32) * PROJ_LD + C_QG + h * 64 + 16 * ks + 8 * hi);
#pragma unroll
        for (int m = 0; m < 4; ++m) as_[ks][m] = *(const bf16x8*)(st + (32 * m + c32) * 64 + 16 * ks + 8 * hi); }
    asm volatile("" ::: "memory");
    u32x4 rgw8[8]; const int dv0_ = (lane & 15) * 8; const f32x4 g0 = *(const f32x4*)(ghead + dv0_), g1 = *(const f32x4*)(ghead + dv0_ + 4);
#pragma unroll
    for (int i = 0; i < 8; ++i) rgw8[i] = *(const u32x4*)(proj + (t0 + ((lane + 64 * i) >> 4)) * PROJ_LD + C_RG + h * 128 + dv0_);
    asm volatile("" ::: "memory");
#pragma unroll
    for (int ks = 0; ks < 4; ++ks)
#pragma unroll
        for (int m = 0; m < 4; ++m) acc[m] = __builtin_amdgcn_mfma_f32_32x32x16_bf16(as_[ks][m], bq[ks], acc[m], 0, 0, 0);
    float ss = 0.f;
#pragma unroll
    for (int m = 0; m < 4; ++m)
#pragma unroll
        for (int r = 0; r < 16; ++r) ss += acc[m][r] * acc[m][r];
    ss += __shfl_xor(ss, 32);
    const float rstd = 1.0f / sqrtf(ss * (1.0f / 128.0f) + EPS);
#pragma unroll
    for (int m = 0; m < 4; ++m)
#pragma unroll
        for (int r = 0; r < 16; ++r) *(float*)(wlds + c32 * GC_PITCH + (32 * m + crow(r, hi)) * 4) = acc[m][r] * rstd;
#pragma unroll
    for (int i = 0; i < 8; ++i) { const int q = lane + 64 * i, tok = q >> 4, dv0 = (q & 15) * 8; const float* src = (const float*)(wlds + tok * GC_PITCH + dv0 * 4);
        const u32x4 rgw = rgw8[i];
        const float rg[8] = {bflo(rgw.x), bfhi(rgw.x), bflo(rgw.y), bfhi(rgw.y), bflo(rgw.z), bfhi(rgw.z), bflo(rgw.w), bfhi(rgw.w)}; const float gg[8] = {g0.x, g0.y, g0.z, g0.w, g1.x, g1.y, g1.z, g1.w}; float y[8];
#pragma unroll
        for (int k = 0; k < 8; ++k) y[k] = src[k] * gg[k] * (rg[k] / (1.0f + __expf(-rg[k])));
        u32x4 o; o.x = pk2(y[0], y[1]); o.y = pk2(y[2], y[3]); o.z = pk2(y[4], y[5]); o.w = pk2(y[6], y[7]);
        *(u32x4*)(mix + (t0 + tok) * 1024 + h * 128 + dv0) = o; }
}
__device__ __forceinline__ void sb_task(unsigned char* vl  , int wtask, const bf16_t* __restrict__ proj, bf16_t* __restrict__ mix, int lane) {
    const int qt = wtask & 255, h = (wtask >> 8) & 7, b = wtask >> 11; const int c = lane & 31, hi = lane >> 5;
    const int t0 = qt * 32; const size_t rowb = (size_t)b * SEQ;
    bf16x8 qf[4];
#pragma unroll
    for (int d0 = 0; d0 < 4; ++d0) qf[d0] = *(const bf16x8*)(proj + (rowb + t0 + c) * PROJ_LD + C_QS + h * 64 + 16 * d0 + 8 * hi);
    const int kap = 16 * ((c >> 2) & 1) + (c & 3) + 4 * (c >> 3);
    f32x16 o0, o1;
#pragma unroll
    for (int r = 0; r < 16; ++r) { o0[r] = 0.f; o1[r] = 0.f; }
    float Dc = 1.0f;
    const bf16_t* kbase = proj + rowb * PROJ_LD + C_KS + h * 64 + 8 * hi + (size_t)kap * PROJ_LD;
    const bf16_t* vbase = proj + rowb * PROJ_LD + C_VS + h * 64 + (lane & 7) * 8 + (size_t)(lane >> 3) * PROJ_LD;
    bf16x8 kf[4]; u32x4 vr[4];
#pragma unroll
    for (int d0 = 0; d0 < 4; ++d0) kf[d0] = *(const bf16x8*)(kbase + (size_t)t0 * PROJ_LD + 16 * d0);
#pragma unroll
    for (int i = 0; i < 4; ++i) vr[i] = *(const u32x4*)(vbase + (size_t)(t0 + 8 * i) * PROJ_LD);
    for (int j0 = t0; j0 >= 0; j0 -= 32) {
#pragma unroll
        for (int i = 0; i < 4; ++i) { const int key = (lane >> 3) + 8 * i, ch = lane & 7; *(u32x4*)(vl + (ch >> 2) * 2048 + key * 64 + (ch & 3) * 16) = vr[i]; }
        f32x16 z;
#pragma unroll
        for (int r = 0; r < 16; ++r) z[r] = 0.f;
#pragma unroll
        for (int d0 = 0; d0 < 4; ++d0) z = __builtin_amdgcn_mfma_f32_32x32x16_bf16(kf[d0], qf[d0], z, 0, 0, 0);
        asm volatile("" ::: "memory");
        { const int jn = (j0 >= 32) ? j0 - 32 : j0;
#pragma unroll
          for (int d0 = 0; d0 < 4; ++d0) kf[d0] = *(const bf16x8*)(kbase + (size_t)jn * PROJ_LD + 16 * d0);
#pragma unroll
          for (int i = 0; i < 4; ++i) vr[i] = *(const u32x4*)(vbase + (size_t)(jn + 8 * i) * PROJ_LD); }
        asm volatile("" ::: "memory");
        float e[16], Dl[16];
        const bool diag = (j0 == t0);
#pragma unroll
        for (int r = 0; r < 16; ++r) { float ev = __builtin_amdgcn_exp2f(fminf(z[r], 126.0f)); if (diag && (16 * hi + r >= c)) ev = 0.f; e[r] = ev; }
        float D = hi ? Dc : 1.0f;
#pragma unroll
        for (int r = 15; r >= 0; --r) { D = fmaf(D, e[r], D); Dl[r] = D; }
        const float other = __shfl_xor(D, 32);
        const float mult = hi ? 1.0f : other;
        Dc = D * other;
        unsigned pw[8];
#pragma unroll
        for (int r = 0; r < 16; r += 2) { const float a0 = e[r] * __builtin_amdgcn_rcpf(Dl[r] * mult), a1 = e[r + 1] * __builtin_amdgcn_rcpf(Dl[r + 1] * mult); pw[r >> 1] = pk2(a0, a1); }
#pragma unroll
        for (int ks = 0; ks < 2; ++ks) { const bf16x8 pa = __builtin_bit_cast(bf16x8, (u32x4){pw[4 * ks], pw[4 * ks + 1], pw[4 * ks + 2], pw[4 * ks + 3]});
            const unsigned char* vb = vl + (16 * hi + 8 * ks + ((lane & 15) >> 2)) * 64 + (16 * ((lane >> 4) & 1) + 4 * (lane & 3)) * 2;
            { const s16x4 lo = tr_read(vb), hh = tr_read(vb + 256); o0 = __builtin_amdgcn_mfma_f32_32x32x16_bf16(pa, (bf16x8){lo[0], lo[1], lo[2], lo[3], hh[0], hh[1], hh[2], hh[3]}, o0, 0, 0, 0); }
            { const s16x4 lo = tr_read(vb + 2048), hh = tr_read(vb + 2048 + 256); o1 = __builtin_amdgcn_mfma_f32_32x32x16_bf16(pa, (bf16x8){lo[0], lo[1], lo[2], lo[3], hh[0], hh[1], hh[2], hh[3]}, o1, 0, 0, 0); } }
        if (__all(!(Dc < 3.0e38f))) break;
    }
    bf16_t* ob = mix + (rowb + t0) * 1024 + 512 + h * 64 + c;
#pragma unroll
    for (int r = 0; r < 16; ++r) { const int q = crow(r, hi); ob[(size_t)q * 1024] = (bf16_t)f2bf(o0[r]); ob[(size_t)q * 1024 + 32] = (bf16_t)f2bf(o1[r]); }
}
__device__ __forceinline__ void memkv_task(int wtask, int lane, const bf16_t* __restrict__ memn, const bf16_t* __restrict__ wkv, bf16_t* __restrict__ kv) {
    const int tm = ((wtask >> 5) & 7) | ((wtask >> 9) << 3), tn = ((wtask >> 8) & 1) | ((wtask & 31) << 1); const int c = lane & 31, hi = lane >> 5;
    const bf16_t* ap = memn + (size_t)(tm * 32 + c) * DM + 8 * hi; const bf16_t* bp = wkv + (size_t)(tn * 32 + c) * DM + 8 * hi;
    f32x16 acc;
#pragma unroll
    for (int r = 0; r < 16; ++r) acc[r] = 0.f;
#pragma unroll 16
    for (int ks = 0; ks < 64; ++ks) { const bf16x8 a = *(const bf16x8*)(ap + 16 * ks), b = *(const bf16x8*)(bp + 16 * ks); acc = __builtin_amdgcn_mfma_f32_32x32x16_bf16(a, b, acc, 0, 0, 0); }
    bf16_t* o = kv + (size_t)(tm * 32) * 2048 + tn * 32 + c;
#pragma unroll
    for (int r = 0; r < 16; ++r) o[(size_t)crow(r, hi) * 2048] = (bf16_t)f2bf(acc[r]);
}
__device__ __forceinline__ void memkv_split(int wtask, int kh, int lane, const bf16_t* __restrict__ memn, const bf16_t* __restrict__ wkv, bf16_t* __restrict__ kv, float* red  ) {
    const int tm = ((wtask >> 5) & 7) | ((wtask >> 9) << 3), tn = ((wtask >> 8) & 1) | ((wtask & 31) << 1); const int c = lane & 31, hi = lane >> 5;
    const bf16_t* ap = memn + (size_t)(tm * 32 + c) * DM + 8 * hi + 512 * kh; const bf16_t* bp = wkv + (size_t)(tn * 32 + c) * DM + 8 * hi + 512 * kh;
    f32x16 acc;
#pragma unroll
    for (int r = 0; r < 16; ++r) acc[r] = 0.f;
#pragma unroll 16
    for (int ks = 0; ks < 32; ++ks) { const bf16x8 a = *(const bf16x8*)(ap + 16 * ks), b = *(const bf16x8*)(bp + 16 * ks); acc = __builtin_amdgcn_mfma_f32_32x32x16_bf16(a, b, acc, 0, 0, 0); }
    if (kh) {
#pragma unroll
        for (int r = 0; r < 16; ++r) red[r * 64 + lane] = acc[r]; }
    __syncthreads();
    if (!kh) { bf16_t* o = kv + (size_t)(tm * 32) * 2048 + tn * 32 + c;
#pragma unroll
        for (int r = 0; r < 16; ++r) o[(size_t)crow(r, hi) * 2048] = (bf16_t)f2bf(acc[r] + red[r * 64 + lane]); }
}
__device__ __forceinline__ void router_task(int wtask, int lane, const bf16_t* __restrict__ xn, const float* __restrict__ ss, const bf16_t* __restrict__ wr, const float* __restrict__ br,
                                            int (&oe)[4], float (&ow)[4]) {
    const int c = lane & 31, hi = lane >> 5; const int t = wtask * 32 + c;
    const bf16_t* ap = wr + (size_t)c * DM + 8 * hi; const bf16_t* bp = xn + (size_t)t * DM + 8 * hi;
    f32x16 acc;
#pragma unroll
    for (int r = 0; r < 16; ++r) acc[r] = 0.f;
#pragma unroll 16
    for (int ks = 0; ks < 64; ++ks) { const bf16x8 a = *(const bf16x8*)(ap + 16 * ks), b = *(const bf16x8*)(bp + 16 * ks); acc = __builtin_amdgcn_mfma_f32_32x32x16_bf16(a, b, acc, 0, 0, 0); }
    float v[16]; const float rstd = row_rstd(ss, t);
#pragma unroll
    for (int r = 0; r < 16; ++r) v[r] = acc[r] * rstd + br[crow(r, hi)];
    float tv[4]; int ti[4];
#pragma unroll
    for (int k = 0; k < 4; ++k) { float best = -INFINITY; int bi = 64;
#pragma unroll
        for (int r = 0; r < 16; ++r) { if (v[r] > best) { best = v[r]; bi = crow(r, hi); } }
        tv[k] = best; ti[k] = bi;
#pragma unroll
        for (int r = 0; r < 16; ++r) if (crow(r, hi) == bi) v[r] = -INFINITY; }
    float cv[8]; int ci[8];
#pragma unroll
    for (int k = 0; k < 4; ++k) { cv[k] = tv[k]; ci[k] = ti[k]; cv[4 + k] = __shfl_xor(tv[k], 32); ci[4 + k] = __shfl_xor(ti[k], 32); }
#pragma unroll
    for (int k = 0; k < 4; ++k) { float best = -INFINITY; int bi = 64;
#pragma unroll
        for (int q = 0; q < 8; ++q) { if (cv[q] > best || (cv[q] == best && ci[q] < bi)) { best = cv[q]; bi = ci[q]; } }
        tv[k] = best; ti[k] = bi;
#pragma unroll
        for (int q = 0; q < 8; ++q) if (ci[q] == bi) cv[q] = -INFINITY; }
    const float e1 = __expf(tv[1] - tv[0]), e2 = __expf(tv[2] - tv[0]), e3 = __expf(tv[3] - tv[0]); const float inv = 1.0f / (1.0f + e1 + e2 + e3);
    const float g[4] = {inv, e1 * inv, e2 * inv, e3 * inv};
#pragma unroll
    for (int k = 0; k < 4; ++k) { oe[k] = ti[k]; ow[k] = g[k]; }
}
__device__ __forceinline__ void router_from_parts(int t, const float* __restrict__ part, const float* __restrict__ ss, const float* __restrict__ br, int (&oe)[4], float (&ow)[4]) {
    float v[32]; const float rstd = row_rstd(ss, t);
#pragma unroll
    for (int c4 = 0; c4 < 8; ++c4) { const f32x4* p = (const f32x4*)(part + (size_t)t * 32 + 4 * c4); const f32x4 s = (p[0] + p[(size_t)NTOK * 8]) + (p[(size_t)2 * NTOK * 8] + p[(size_t)3 * NTOK * 8]);
        const f32x4 bb = *(const f32x4*)(br + 4 * c4);
#pragma unroll
        for (int j = 0; j < 4; ++j) v[4 * c4 + j] = s[j] * rstd + bb[j]; }
    float tv[4]; int ti[4];
#pragma unroll
    for (int k = 0; k < 4; ++k) { float best = -INFINITY; int bi = 64;
#pragma unroll
        for (int e = 0; e < 32; ++e) { if (v[e] > best) { best = v[e]; bi = e; } }
        tv[k] = best; ti[k] = bi;
#pragma unroll
        for (int e = 0; e < 32; ++e) if (e == bi) v[e] = -INFINITY; }
    const float e1 = __expf(tv[1] - tv[0]), e2 = __expf(tv[2] - tv[0]), e3 = __expf(tv[3] - tv[0]); const float inv = 1.0f / (1.0f + e1 + e2 + e3);
    const float g[4] = {inv, e1 * inv, e2 * inv, e3 * inv};
#pragma unroll
    for (int k = 0; k < 4; ++k) { oe[k] = ti[k]; ow[k] = g[k]; }
}
#define RT_BETTER(va, ia, vb, ib) ((va) > (vb) || ((va) == (vb) && (ia) < (ib)))
#define RT_CE(a, b) do { const bool sw_ = RT_BETTER(v[b], ix[b], v[a], ix[a]); const float tv_ = sw_ ? v[b] : v[a], tw_ = sw_ ? v[a] : v[b]; const int ti_ = sw_ ? ix[b] : ix[a], tj_ = sw_ ? ix[a] : ix[b]; \
        v[a] = tv_; v[b] = tw_; ix[a] = ti_; ix[b] = tj_; } while (0)
__device__ __forceinline__ void router_top4_8lanes(int t, int sub, const float* __restrict__ part, const float* __restrict__ ss, const float* __restrict__ br, float& rstd_out, float (&tv)[4], int (&ti)[4]) {
    const f32x4* p = (const f32x4*)(part + (size_t)t * 32 + 4 * sub); const f32x4 s = (p[0] + p[(size_t)NTOK * 8]) + (p[(size_t)2 * NTOK * 8] + p[(size_t)3 * NTOK * 8]);
    const f32x4 bb = *(const f32x4*)(br + 4 * sub); const float rstd = row_rstd(ss, t); rstd_out = rstd;
    float v[4] = {s.x * rstd + bb.x, s.y * rstd + bb.y, s.z * rstd + bb.z, s.w * rstd + bb.w}; int ix[4] = {4 * sub, 4 * sub + 1, 4 * sub + 2, 4 * sub + 3};
    RT_CE(0, 1); RT_CE(2, 3); RT_CE(0, 2); RT_CE(1, 3); RT_CE(1, 2);
#pragma unroll
    for (int d = 1; d < 8; d <<= 1) {
        float ov[4]; int oi[4];
#pragma unroll
        for (int k = 0; k < 4; ++k) { ov[k] = __shfl_xor(v[3 - k], d); oi[k] = __shfl_xor(ix[3 - k], d); }
#pragma unroll
        for (int k = 0; k < 4; ++k) { const bool tk_ = RT_BETTER(ov[k], oi[k], v[k], ix[k]); v[k] = tk_ ? ov[k] : v[k]; ix[k] = tk_ ? oi[k] : ix[k]; }
        RT_CE(0, 2); RT_CE(1, 3); RT_CE(0, 1); RT_CE(2, 3); }
#pragma unroll
    for (int k = 0; k < 4; ++k) { tv[k] = v[k]; ti[k] = ix[k]; }
}
__device__ __forceinline__ void combine_task(int t, int lane, const bf16_t* xin, float* xout, const unsigned char* __restrict__ ys, const int* tab, const int* __restrict__ toke, const int* __restrict__ tokr,
                                                 const float* __restrict__ tokw, const float* __restrict__ gfin) {
    const u32x2* xr = (const u32x2*)(xin + (size_t)t * DM) + lane; f32x4* xo = (f32x4*)(xout + (size_t)t * DM) + lane; f32x4 v[4];
#pragma unroll
    for (int j = 0; j < 4; ++j) { const u32x2 w = __builtin_nontemporal_load(xr + 64 * j); v[j] = (f32x4){bflo(w.x), bfhi(w.x), bflo(w.y), bfhi(w.y)}; }
    for (int k = 0; k < 4; ++k) { const int e = toke[t * 4 + k], r = tokr[t * 4 + k]; const float w = tokw[t * 4 + k]; const int start = tab[32 + e];
        const unsigned* yr = (const unsigned*)(ys + (size_t)(start + r) * DM) + lane;
#pragma unroll
        for (int j = 0; j < 4; ++j) { const int y = (int)__builtin_nontemporal_load(yr + 64 * j); const f32x2 lo = __builtin_amdgcn_cvt_pk_f32_fp8(y, false), hi = __builtin_amdgcn_cvt_pk_f32_fp8(y, true);
            v[j].x += w * lo.x; v[j].y += w * lo.y; v[j].z += w * hi.x; v[j].w += w * hi.y; } }
    float s = 0.f;
#pragma unroll
    for (int j = 0; j < 4; ++j) s += v[j].x * v[j].x + v[j].y * v[j].y + v[j].z * v[j].z + v[j].w * v[j].w;
    const float rstd = 1.0f / sqrtf(wave_sum(s) * (1.f / DM) + EPS);
#pragma unroll
    for (int j = 0; j < 4; ++j) { const f32x4 g = *((const f32x4*)gfin + lane + 64 * j); __builtin_nontemporal_store(v[j] * rstd * g, xo + 64 * j); }
}

__device__ __forceinline__ void combine_pair(const int (&t)[2], const int (&slot)[2][4], const float (&wk)[2][4], int lane, const bf16_t* xin, float* xout, const unsigned char* __restrict__ ys, const float* __restrict__ gfin) {
    u32x2 xw[2][4]; int y[2][4][4];
#pragma unroll
    for (int a = 0; a < 2; ++a) { const u32x2* xr = (const u32x2*)(xin + (size_t)t[a] * DM) + lane;
#pragma unroll
        for (int j = 0; j < 4; ++j) xw[a][j] = __builtin_nontemporal_load(xr + 64 * j); }
#pragma unroll
    for (int a = 0; a < 2; ++a)
#pragma unroll
        for (int k = 0; k < 4; ++k) { const unsigned* yr = (const unsigned*)(ys + (size_t)slot[a][k] * DM) + lane;
#pragma unroll
            for (int j = 0; j < 4; ++j) y[a][k][j] = (int)__builtin_nontemporal_load(yr + 64 * j); }
#pragma unroll
    for (int a = 0; a < 2; ++a) { f32x4 v[4];
#pragma unroll
        for (int j = 0; j < 4; ++j) { const u32x2 w = xw[a][j]; v[j] = (f32x4){bflo(w.x), bfhi(w.x), bflo(w.y), bfhi(w.y)}; }
#pragma unroll
        for (int k = 0; k < 4; ++k) { const float w = wk[a][k];
#pragma unroll
            for (int j = 0; j < 4; ++j) { const f32x2 lo = __builtin_amdgcn_cvt_pk_f32_fp8(y[a][k][j], false), hi = __builtin_amdgcn_cvt_pk_f32_fp8(y[a][k][j], true);
                v[j].x += w * lo.x; v[j].y += w * lo.y; v[j].z += w * hi.x; v[j].w += w * hi.y; } }
        float s = 0.f;
#pragma unroll
        for (int j = 0; j < 4; ++j) s += v[j].x * v[j].x + v[j].y * v[j].y + v[j].z * v[j].z + v[j].w * v[j].w;
        const float rstd = 1.0f / sqrtf(wave_sum(s) * (1.f / DM) + EPS);
        f32x4* xo = (f32x4*)(xout + (size_t)t[a] * DM) + lane;
#pragma unroll
        for (int j = 0; j < 4; ++j) { const f32x4 g = *((const f32x4*)gfin + lane + 64 * j); __builtin_nontemporal_store(v[j] * rstd * g, xo + 64 * j); } }
}

#define GAS __attribute__((address_space(1)))
#define RLX_AGENT __ATOMIC_RELAXED, __HIP_MEMORY_SCOPE_AGENT
#define XB_TMO      128
#define XB_XCNT(j)  (256  + 64 * (j))
#define XB_XSUB(j)  (1280 + 64 * (j))
#define XB_XGEN(j)  (2304 + 64 * (j))
#define XB_TOP      3328
#define XB_TOPGEN   3392
#define XCD_BAR_WORDS 3456
#define XB_SPIN_CAP (1u << 18)
__device__ __forceinline__ unsigned xb_ld(unsigned* p)              { return __hip_atomic_load(p, __ATOMIC_RELAXED, __HIP_MEMORY_SCOPE_AGENT); }
__device__ __forceinline__ unsigned xb_add(unsigned* p, unsigned v) { return __hip_atomic_fetch_add(p, v, __ATOMIC_RELAXED, __HIP_MEMORY_SCOPE_AGENT); }
__device__ __forceinline__ unsigned xb_xcc_id() { return (unsigned)__builtin_amdgcn_s_getreg((3 << 11) | 20) & 0xFu; }
#define XB_SPIN(cond, bar) do { unsigned _sp = 0; while (cond) { __builtin_amdgcn_s_sleep(1); \
    if ((++_sp & 255u) == 0u) { if (xb_ld(&(bar)[XB_TMO])) break; if (_sp > XB_SPIN_CAP) { atomicAdd(&(bar)[XB_TMO], 1u); break; } } } } while (0)
struct XcdBarrier { unsigned* bar; unsigned x; };
__device__ __forceinline__ XcdBarrier xcd_barrier_post(unsigned* bar) {
    XcdBarrier b; b.bar = bar; b.x = xb_xcc_id();
    if (threadIdx.x == 0) (void)xb_add(&bar[XB_XCNT(b.x)], 1u);
    return b;
}
__device__ __forceinline__ void xcd_barrier_complete(unsigned* bar, unsigned x, unsigned& nloc, unsigned& nx) {
    const unsigned G = gridDim.x * gridDim.y * gridDim.z;
    unsigned sum, cnt, mine, sp = 0u;
    for (;;) {
        sum = 0u; cnt = 0u; mine = 0u;
#pragma unroll
        for (unsigned j = 0; j < 16; ++j) { const unsigned c = xb_ld(&bar[XB_XCNT(j)]); sum += c; cnt += (c > 0u) ? 1u : 0u; mine = (j == x) ? c : mine; }
        if (sum == G) break;
        __builtin_amdgcn_s_sleep(1);
        if ((++sp & 255u) == 0u) { if (xb_ld(&bar[XB_TMO])) break; if (sp > XB_SPIN_CAP) { atomicAdd(&bar[XB_TMO], 1u); break; } }
    }
    nloc = mine > 0u ? mine : 1u; nx = cnt > 0u ? cnt : 1u;
}
__device__ __forceinline__ void xcd_barrier(const XcdBarrier& b, unsigned& st  , bool acq = true) {
    asm volatile("s_waitcnt vmcnt(0)" ::: "memory");
    __syncthreads();
    unsigned stv = st;
    if (threadIdx.x == 0) {
        unsigned* bar = b.bar;
        __builtin_amdgcn_s_waitcnt(0);
        unsigned nloc = st & 0xffffu, nx = st >> 16;
        if (nloc == 0u) { xcd_barrier_complete(bar, b.x, nloc, nx); stv = nloc | (nx << 16); }
        const unsigned old = xb_add(&bar[XB_XSUB(b.x)], 1u);
        const unsigned gen = old / nloc;
        if (old + 1u == (gen + 1u) * nloc) {
            __builtin_amdgcn_fence(__ATOMIC_RELEASE, "agent");
            asm volatile("s_waitcnt vmcnt(0)" ::: "memory");
            const unsigned og = xb_add(&bar[XB_TOP], 1u);
            const unsigned tg = og / nx;
            if (og + 1u == (tg + 1u) * nx) xb_add(&bar[XB_TOPGEN], 1u);
            else XB_SPIN(xb_ld(&bar[XB_TOPGEN]) == tg, bar);
            if (acq) __builtin_amdgcn_fence(__ATOMIC_ACQUIRE, "agent");
            xb_add(&bar[XB_XGEN(b.x)], 1u);
            asm volatile("s_waitcnt vmcnt(0)" ::: "memory");
        } else {
            XB_SPIN(xb_ld(&bar[XB_XGEN(b.x)]) == gen, bar);
            if (acq) __builtin_amdgcn_fence(__ATOMIC_ACQUIRE, "agent");
            asm volatile("s_waitcnt vmcnt(0)" ::: "memory");
        }
    }
    st = __builtin_amdgcn_readfirstlane(stv);
    __syncthreads();
}

constexpr int LDS_BYTES = 163840;
constexpr int CW_BAR = 4096;
constexpr size_t CTL_ZERO_BYTES = 65536;
constexpr int NPHASE = 12;
constexpr int MOE_TAB_OFF = CH_LDS + 7 * 4096;
struct Args { const float* in[22]; float* out; unsigned char* ws; int ph_lo, ph_hi; };

__global__ void __launch_bounds__(512, 2) mega(Args a) {
    extern __shared__ __attribute__((aligned(16))) unsigned char lds[];
    unsigned char* ws = a.ws; float* out = a.out;
    const float* x = a.in[0]; const float* mem = a.in[1]; const float* g_mix = a.in[2]; const float* w_in = a.in[3];
    const float* w_gla_gate = a.in[4]; const float* b_gla_gate = a.in[5]; const float* g_gla_head = a.in[6]; const float* w_out = a.in[7];
    const float* g_mem_q = a.in[8]; const float* g_mem_kv = a.in[9]; const float* w_mq = a.in[10]; const float* w_mk = a.in[11];
    const float* w_mv = a.in[12]; const float* w_mo = a.in[13]; const float* g_ffn = a.in[14]; const float* w_router = a.in[15];
    const float* b_router = a.in[16]; const float* w_gu = a.in[17]; const float* b_gu = a.in[18]; const float* w_down = a.in[19];
    const float* b_down = a.in[20]; const float* g_final = a.in[21];
    bf16_t* Wt_in = (bf16_t*)(ws + WS_WIN); bf16_t* Wt_out = (bf16_t*)(ws + WS_WOUT); bf16_t* Wq = (bf16_t*)(ws + WS_WQ); bf16_t* Wt_kv = (bf16_t*)(ws + WS_WKV);
    bf16_t* Wt_mo = (bf16_t*)(ws + WS_WMO); bf16_t* Wt_r = (bf16_t*)(ws + WS_WR); bf16_t* Wt_gu = (bf16_t*)(ws + WS_WGU); bf16_t* Wt_dn = (bf16_t*)(ws + WS_WDN);
    bf16_t* xn = (bf16_t*)(ws + WS_XN); bf16_t* memn = (bf16_t*)(ws + WS_MEMN); bf16_t* kv = (bf16_t*)(ws + WS_KV); bf16_t* Bs = (bf16_t*)(ws + WS_BS); bf16_t* Bo = (bf16_t*)(ws + WS_BO);
    bf16_t* proj = (bf16_t*)(ws + WS_PROJ); bf16_t* mix = (bf16_t*)(ws + WS_MIX);
    float* Sc = (float*)(ws + WS_S); bf16_t* P = (bf16_t*)(ws + WS_P); float* lg = (float*)(ws + WS_LG); int* toke = (int*)(ws + WS_TOKE); int* tokr = (int*)(ws + WS_TOKR);
    float* tokw = (float*)(ws + WS_TOKW); int* list = (int*)(ws + WS_LIST); unsigned char* ys = ws + WS_YS;
    unsigned char* Wq_gu = ws + WS_WGU; unsigned char* Wq_dn = ws + WS_WDN; unsigned char* x2q = ws + WS_S + 16 * MiB; unsigned char* act8 = ws + WS_ACT;
    bf16_t* x1b = (bf16_t*)(ws + WS_DUMMY); bf16_t* x2b = (bf16_t*)(ws + WS_DUMMY + 32 * MiB);
    float* rpart = (float*)(ws + WS_S + 32 * MiB);
    float* rs0 = (float*)(ws + WS_LA + 10 * MiB);
    float* lrs = (float*)(ws + WS_LG);
    bf16_t* UT = (bf16_t*)(ws + WS_S); float* decay = (float*)(ws + WS_LA); bf16_t* ST = (bf16_t*)(ws + WS_ORAW);
    unsigned* ctl = (unsigned*)(ws + WS_CTL); int* cnt = (int*)ctl + CW_CNT; float* ss1 = (float*)(ws + WS_LA + 8 * MiB); float* ss2 = (float*)(ws + WS_LA + 9 * MiB);

    const int G = gridDim.x, vb = blockIdx.x;
    XcdBarrier bar = xcd_barrier_post(ctl + CW_BAR); unsigned bar_st = 0u;
    const int ch_gw = __builtin_amdgcn_readfirstlane(vb * 8 + (int)(threadIdx.x >> 6)), ch_nW = G * 8;
    const int lo = a.ph_lo, hi = a.ph_hi;
    float* dmy = (float*)(ws + WS_DUMMY); (void)dmy;
#ifndef REPEAT_MASK
#define REPEAT_MASK 0
#endif
#define IN(k) (lo <= (k) && (k) < hi)
#define REP(k) for (int rep_ = 0; rep_ < 1 + ((REPEAT_MASK >> (k)) & 1); ++rep_)
#define SEAM_ACQ_MASK (G == 256 ? 0x100 : 0x104)
#define SEAM(k) do { if (IN(k) && IN((k) + 1)) xcd_barrier(bar, bar_st, ((SEAM_ACQ_MASK >> (k)) & 1) != 0); } while (0)
#define TIDS() int tid = threadIdx.x; LAUNDER(tid); const int lane = tid & 63; const int wid = __builtin_amdgcn_readfirstlane(tid >> 6); (void)lane; (void)wid

    if (IN(0)) REP(0) { TIDS(); const size_t gt = (size_t)vb * 512 + tid, gs = (size_t)G * 512;
        float* scr = (float*)(lds + wid * 8448);
        const int gw = vb * 8 + wid, ngw = G * 8;
        rms_body_grouped4(vb, G, wid, lane, x, xn, NTOK, rs0);
        rms_body<false>(gw, ngw, lane, mem, memn, NB * MEML);
        conv_n_body(gt, gs, w_mq, Wq, g_mem_q, 1024, 1024, LOG2E / 16.0f);
        constexpr int I_IN = 16 * 97, I_SQ = 16 * 32, I_R = 16;
        constexpr int NITEMS = I_IN + 4 * I_SQ + I_R;
        for (int it = gw; it < NITEMS; it += ngw) { int r = it;
            if (r < I_IN) { conv_item<1>(scr, w_in, Wt_in, g_mix, 3088, 1024, 3088, r / 97, r % 97, lane); continue; } r -= I_IN;
            const float* s_; bf16_t* d_; const float* g_; int ld_ = 1024, nr_ = 1024, kb_ = r >> 5, nb_ = r & 31;
            if (r < I_SQ) { s_ = w_out; d_ = Wt_out; g_ = nullptr; }
            else if (r < 2 * I_SQ) { s_ = w_mk; d_ = Wt_kv; g_ = g_mem_kv; }
            else if (r < 3 * I_SQ) { s_ = w_mv; d_ = Wt_kv + (size_t)1024 * 1024; g_ = g_mem_kv; }
            else if (r < 4 * I_SQ) { s_ = w_mo; d_ = Wt_mo; g_ = nullptr; }
            else { s_ = w_router; d_ = Wt_r; g_ = g_ffn; ld_ = 32; nr_ = 32; kb_ = r - 4 * I_SQ; nb_ = 0; }
            if (r < 4 * I_SQ) { kb_ = (r & (I_SQ - 1)) >> 5; nb_ = r & 31; }
            conv_item<0>(scr, s_, d_, g_, ld_, 1024, nr_, kb_, nb_, lane); }
        __syncthreads(); }
    SEAM(0);
    if (IN(1)) REP(1) { DenseSched S{(const char*)xn, (const char*)Wt_in, 2048u, 2048u, 1024, 64, 12, 1 << 30, 0, G, vb}; EpiBf16 E{proj, PROJ_LD, 0}; gemm_run_host<false, 1>(lds, S, E, w_gu, ws, 0, 12288, ch_gw, ch_nW); }
    SEAM(1);
    if (IN(2)) REP(2) {
        for (int t = vb; t < 256; t += G) gla_pass_a(lds, t, xn, Wt_in + (size_t)3072 * 1024, proj, w_gla_gate, b_gla_gate, UT, decay);
        { TIDS(); for (int t = vb * 8 + wid; t < 4096; t += G * 8) sb_task(lds + wid * 4096, t ^ ((t & 2048) ? (7 << 8) : 0), proj, mix, lane); }
        { TIDS(); if (G == 256) memkv_split(vb + 256 * (wid & 3), wid >> 2, lane, memn, Wt_kv, kv, (float*)(lds + 32768 + (wid & 3) * 4096));
          else for (int t = vb + G * wid; t < 1024; t += G * 8) memkv_task(t, lane, memn, Wt_kv, kv); } }
    SEAM(2);
    if (IN(3)) REP(3) {
        { TIDS();
          if (G == 256) { if (vb < 128) { if (tid < 256) gla_pass_b(vb * 256 + tid, UT, decay, ST); } else if (vb >= 192) gla_pass_b(32768 + (vb - 192) * 512 + tid, UT, decay, ST); }
          else for (int e = vb * 512 + tid; e < 65536; e += G * 512) gla_pass_b(e, UT, decay, ST); }
        { SchedWqk S{(const char*)kv, (const char*)Wq, 4096u, 2048u, 256, G / 2, vb - G / 2, 0}; EpiBf16 E{Bs, 1024, 0}; gemm_run<false>(lds, S, E); }
        { SchedVo S{(const char*)Wt_mo, (const char*)kv, 2048u, 4096u, 256, G / 2, vb - G / 2 - 32, 0}; EpiBf16 E{Bo, 1024, 0}; gemm_run<false>(lds, S, E); } }
    SEAM(3);
    if (IN(4)) REP(4) { TIDS(); const int cb = G == 256 ? (vb & 7) * 32 + (vb >> 3) : vb;
        for (int t = cb * 8 + wid; t < 2048; t += G * 8) gla_pass_c(lds + wid * 32 * GC_PITCH, t, ST, proj, g_gla_head, mix, lane); }
    SEAM(4);
#if PROBE_BARRIERS
    for (int pb_ = 0; pb_ < 8; ++pb_) xcd_barrier(bar, bar_st);
#endif
    if (IN(5)) REP(5) { DenseSched S{(const char*)mix, (const char*)Wt_out, 2048u, 2048u, 1024, 64, 4, 1 << 30, 0, G, vb}; EpiResidSS<true> E{xn, x1b, ss1, nullptr, nullptr, rs0};     gemm_run_host<false, 1>(lds, S, E, w_gu, ws, 12288, CH_GU_ITEMS, ch_gw, ch_nW); }
    SEAM(5);
    if (IN(6)) REP(6) { DenseSched S{(const char*)x1b, (const char*)Bs, 2048u, 2048u, 1024, 64, 4, 32, (size_t)1024 * 2048, G, vb}; EpiSoftmax E{ss1, P}; gemm_run<false>(lds, S, E); }
    SEAM(6);
    if (IN(7)) REP(7) { DenseSched S{(const char*)P, (const char*)Bo, 2048u, 2048u, 1024, 64, 4, 32, (size_t)1024 * 2048, G, vb}; EpiResidRouter E{x1b, x2b, ss2, x2q, g_ffn, Wt_r, rpart}; gemm_run<false>(lds, S, E); }
    SEAM(7);
    if (IN(8)) REP(8) { TIDS(); int* cntp = rep_ ? (int*)ctl + 2048 : cnt; int* listp = rep_ ? (int*)dmy + 1024 : list; float* lrsp = rep_ ? dmy + 4096 * 1024 : lrs; int* tokep = rep_ ? (int*)dmy + 1024 * 1024 : toke; int* tokrp = rep_ ? (int*)dmy + 2048 * 1024 : tokr; float* tokwp = rep_ ? dmy + 3072 * 1024 : tokw;
        int* lcnt = (int*)lds; int* gbase = (int*)lds + 32;
        for (int tb = vb; tb < NTOK / 64; tb += G) {
            if (tid < 32) lcnt[tid] = 0;
            __syncthreads();
            const int t = tb * 64 + (tid >> 3), sub = tid & 7; float tv[4], rstd_t; int ti[4];
            router_top4_8lanes(t, sub, rpart, ss2, b_router, rstd_t, tv, ti);
            const float e1 = __expf(tv[1] - tv[0]), e2 = __expf(tv[2] - tv[0]), e3 = __expf(tv[3] - tv[0]); const float inv = 1.0f / (1.0f + e1 + e2 + e3);
            const int oe = sub == 0 ? ti[0] : sub == 1 ? ti[1] : sub == 2 ? ti[2] : ti[3]; const float ow = (sub == 0 ? 1.0f : sub == 1 ? e1 : sub == 2 ? e2 : e3) * inv; int lr = 0;
            if (sub < 4) lr = atomicAdd(&lcnt[oe], 1);
            __syncthreads();
            if (tid < 32) gbase[tid] = atomicAdd(&cntp[tid * 32], lcnt[tid]);
            __syncthreads();
            if (sub < 4) { const int r = gbase[oe] + lr; listp[oe * NTOK + r] = t; lrsp[oe * NTOK + r] = rstd_t; tokep[t * 4 + sub] = oe; tokrp[t * 4 + sub] = r; tokwp[t * 4 + sub] = ow; }
            __syncthreads(); } }
    SEAM(8);
    if (IN(9)) REP(9) { int* tab = (int*)(lds + MOE_TAB_OFF); { TIDS(); moe_build_table(tab, cnt, tid); }
        MoeSched<true> S{(const char*)x2q, (const char*)Wq_gu, 1024u, 1024u, 512, 8, (size_t)2048 * 1024, tab, list, 1, G, vb, 0}; EpiGU E{b_gu, act8, lrs}; gemm_run_fp8_ehost<true, 2>(lds, S, E, w_down, ws, CH_GU_ITEMS, rep_ ? 0 : CH_ITEMS, ch_gw, ch_nW); }
    SEAM(9);
    if (IN(10)) REP(10) { int* tab = (int*)(lds + MOE_TAB_OFF); if (!IN(9)) { TIDS(); moe_build_table(tab, cnt, tid); }
        MoeSched<false> S{(const char*)act8, (const char*)Wq_dn, 1024u, 1024u, 512, 4, (size_t)1024 * 1024, tab, list, 0, G, vb, 0}; EpiDown E{b_down, ys}; gemm_run_fp8<true>(lds, S, E); }
    SEAM(10);
    if (IN(11)) REP(11) { TIDS(); int* tab = (int*)(lds + MOE_TAB_OFF); if (!IN(9)) moe_build_table(tab, cnt, tid);
        if (G == 256 && !rep_) {
            const int tb0 = vb * 8 + wid; const int tt = tb0 + ((lane >> 2) & 7) * 2048, lk = lane & 3;
            const int e_ = toke[tt * 4 + lk], r_ = tokr[tt * 4 + lk]; const float w_ = tokw[tt * 4 + lk]; const int slot_ = tab[32 + e_] + r_;
            for (int i = 0; i < 8; i += 2) { int t2[2] = {tb0 + i * 2048, tb0 + (i + 1) * 2048}; int sl[2][4]; float wk[2][4];
#pragma unroll
                for (int a = 0; a < 2; ++a)
#pragma unroll
                    for (int k = 0; k < 4; ++k) { sl[a][k] = __builtin_amdgcn_readfirstlane(__shfl(slot_, 4 * (i + a) + k)); wk[a][k] = __shfl(w_, 4 * (i + a) + k); }
                combine_pair(t2, sl, wk, lane, x2b, out, ys, g_final); } }
        else for (int t = vb * 8 + wid; t < NTOK; t += G * 8) combine_task(t, lane, x2b, rep_ ? dmy : out, ys, tab, toke, tokr, tokw, g_final); }
#undef IN
#undef SEAM
#undef TIDS
}

#ifndef MK_PER_PHASE
#define MK_PER_PHASE 0
#endif
extern "C" void kernel_launch(void* const* d_in, const int* in_sizes, int n_in, void* d_out, int out_size, void* d_ws, size_t ws_size, hipStream_t stream) {
    static int grid = 0;
    if (grid == 0) {
        if (n_in != 22 || in_sizes[0] != NTOK * DM || out_size != NTOK * DM || ws_size < WS_END) { fprintf(stderr, "kernel_launch: unexpected shapes (n_in %d, ws %zu)\n", n_in, ws_size); grid = -1; return; }
        int dev = 0, cus = 0, per_cu = 0;
        if (hipGetDevice(&dev) != hipSuccess || hipDeviceGetAttribute(&cus, hipDeviceAttributeMultiprocessorCount, dev) != hipSuccess) { grid = -1; return; }
        if (hipFuncSetAttribute((const void*)mega, hipFuncAttributeMaxDynamicSharedMemorySize, LDS_BYTES) != hipSuccess) { fprintf(stderr, "kernel_launch: hipFuncSetAttribute failed\n"); grid = -1; return; }
        if (hipOccupancyMaxActiveBlocksPerMultiprocessor(&per_cu, (const void*)mega, 512, LDS_BYTES) != hipSuccess || per_cu < 1) fprintf(stderr, "kernel_launch: occupancy query says %d blocks/CU\n", per_cu);
        (void)hipGetLastError();
        grid = cus;
    }
    if (grid < 0) return;
    (void)hipMemsetAsync((char*)d_ws + WS_CTL, 0, CTL_ZERO_BYTES, stream);
    Args a{};
    for (int i = 0; i < 22; ++i) a.in[i] = (const float*)d_in[i];
    a.out = (float*)d_out; a.ws = (unsigned char*)d_ws;
#if MK_PER_PHASE
    for (int p = 0; p < NPHASE; ++p) { a.ph_lo = p; a.ph_hi = p + 1; hipLaunchKernelGGL(mega, dim3(grid), dim3(512), LDS_BYTES, stream, a); }
#else
    a.ph_lo = 0; a.ph_hi = NPHASE; hipLaunchKernelGGL(mega, dim3(grid), dim3(512), LDS_BYTES, stream, a);
#endif
}
```
